# Optimizing an MI355X kernel written in HIP

```python
import jax, jax.numpy as jnp
from jax import lax
import numpy as np

D_MODEL = 2048
BATCH = 2
SEQ = 8192
DEPTH = 1

GLA_HEADS = 4
GLA_DK = 128
GLA_DV = 256
GLA_WIDTH = GLA_HEADS * GLA_DV
GLA_KW = GLA_HEADS * GLA_DK
GLA_GATE_RANK = 16
GLA_GATE_NORM = 16.0
GLA_CHUNK = 64

LRU_HEADS = 4
LRU_WIDTH = 1024
LRU_BLOCK = LRU_WIDTH // LRU_HEADS
LRU_CONV = 4
LRU_C = 8.0

MIX_WIDTH = GLA_WIDTH + LRU_WIDTH
IN_COLS = GLA_KW + GLA_KW + GLA_WIDTH + GLA_WIDTH + GLA_GATE_RANK + LRU_WIDTH + LRU_WIDTH

N_EXPERTS = 32
TOP_K = 4
D_FF = D_MODEL
SWIGLU_LIMIT = 7.0
SWIGLU_ALPHA = 1.702
MOE_BLOCK = 256

EPS = 1e-6

kernel_name = "hymba_gla_rglru_moe_layer"


def rms_norm(x, g):
    xf = x.astype(jnp.float32)
    y = xf * lax.rsqrt(jnp.mean(xf * xf, axis=-1, keepdims=True) + EPS)
    return (y * g.astype(jnp.float32)).astype(x.dtype)


def gla_chunked(q, k, v, log_g):
    B, S, H, DK = q.shape
    DV = v.shape[-1]
    N = S // GLA_CHUNK

    def chunks(t):
        return t.astype(jnp.float32).reshape(B, N, GLA_CHUNK, H, t.shape[-1]).transpose(1, 0, 3, 2, 4)

    q, k, v, log_g = chunks(q) * (DK ** -0.5), chunks(k), chunks(v), chunks(log_g)
    b = jnp.cumsum(log_g, axis=3)
    b_last = b[:, :, :, -1:, :]
    qe = q * jnp.exp(b)
    ke = k * jnp.exp(-b)
    kd = k * jnp.exp(b_last - b)
    causal = jnp.tril(jnp.ones((GLA_CHUNK, GLA_CHUNK), dtype=bool))
    scores = jnp.where(causal, jnp.einsum('nbhik,nbhjk->nbhij', qe, ke), 0.0)
    o_intra = jnp.einsum('nbhij,nbhjv->nbhiv', scores, v)
    decay = jnp.exp(b_last[:, :, :, 0, :])

    def step(state, inp):
        qe_n, kd_n, v_n, dec_n = inp
        o_inter = jnp.einsum('bhik,bhkv->bhiv', qe_n, state)
        state = dec_n[..., None] * state + jnp.einsum('bhjk,bhjv->bhkv', kd_n, v_n)
        return state, o_inter

    s0 = jnp.zeros((B, H, DK, DV), jnp.float32)
    _, o_inter = lax.scan(step, s0, (qe, kd, v, decay))
    o = o_intra + o_inter
    return o.transpose(1, 0, 3, 2, 4).reshape(B, S, H, DV)


def causal_depthwise_conv(x, w, b):
    S = x.shape[1]
    xp = jnp.pad(x, ((0, 0), (LRU_CONV - 1, 0), (0, 0)))
    y = b
    for i in range(LRU_CONV):
        y = y + xp[:, i:i + S, :] * w[i]
    return y


def rg_lru(xc, w_a, b_a, w_i, b_i, a_param):
    B, S, W = xc.shape
    xf = xc.astype(jnp.float32)
    xh = xf.reshape(B, S, LRU_HEADS, LRU_BLOCK)
    gate_a = jax.nn.sigmoid(jnp.einsum('bshi,hij->bshj', xh, w_a).reshape(B, S, W) + b_a)
    gate_i = jax.nn.sigmoid(jnp.einsum('bshi,hij->bshj', xh, w_i).reshape(B, S, W) + b_i)
    log_a = -LRU_C * gate_a * jax.nn.softplus(-a_param.astype(jnp.float32))
    a = jnp.exp(log_a)
    u = xf * gate_i * jnp.sqrt(-jnp.expm1(2.0 * log_a))

    def combine(left, right):
        a_l, u_l = left
        a_r, u_r = right
        return a_l * a_r, a_r * u_l + u_r

    _, h = lax.associative_scan(combine, (a, u), axis=1)
    return h


def moe_ffn(h, w_router, b_router, w_gate_up, b_gate_up, w_down, b_down):
    B, S, D = h.shape
    T = B * S
    TK = T * TOP_K
    xt = h.reshape(T, D)
    logits = (xt @ w_router + b_router).astype(jnp.float32)
    top_vals, top_idx = lax.top_k(logits, TOP_K)
    gates = jax.nn.softmax(top_vals, axis=-1)

    flat_e = top_idx.reshape(-1)
    order = jnp.argsort(flat_e)
    sorted_e = flat_e[order]
    sorted_tok = order // TOP_K
    sorted_w = gates.reshape(-1)[order]
    counts = jnp.bincount(flat_e, length=N_EXPERTS)
    starts = jnp.cumsum(counts) - counts
    padded = ((counts + MOE_BLOCK - 1) // MOE_BLOCK) * MOE_BLOCK
    pstarts = jnp.cumsum(padded) - padded
    dest = pstarts[sorted_e] + (jnp.arange(TK) - starts[sorted_e])
    n_blocks = -(-TK // MOE_BLOCK) + N_EXPERTS
    buf = jnp.zeros((n_blocks * MOE_BLOCK, D), xt.dtype).at[dest].set(xt[sorted_tok])
    block_e = jnp.clip(jnp.searchsorted(pstarts, jnp.arange(n_blocks) * MOE_BLOCK, side='right') - 1,
                       0, N_EXPERTS - 1)

    def expert_block(args):
        xb, e = args
        gu = xb @ w_gate_up[e] + b_gate_up[e]
        gate = jnp.minimum(gu[:, :D_FF], SWIGLU_LIMIT)
        up = jnp.clip(gu[:, D_FF:], -SWIGLU_LIMIT, SWIGLU_LIMIT)
        glu = gate * jax.nn.sigmoid(SWIGLU_ALPHA * gate)
        return ((up + 1.0) * glu) @ w_down[e] + b_down[e]

    y_buf = lax.map(expert_block, (buf.reshape(n_blocks, MOE_BLOCK, D), block_e))
    y_sorted = y_buf.reshape(n_blocks * MOE_BLOCK, D)[dest]
    out = jnp.zeros((T, D), y_sorted.dtype).at[sorted_tok].add(y_sorted * sorted_w[:, None].astype(y_sorted.dtype))
    return out.reshape(B, S, D)


def setup_inputs(seed: int = 0) -> dict:
    key = jax.random.key(seed)
    ks = jax.random.split(key, 24)
    f32 = jnp.float32

    def nrm(k, shape, scale):
        return jax.random.normal(k, shape, f32) * scale

    u = jax.random.uniform(ks[13], (DEPTH, LRU_WIDTH), f32, 0.9, 0.999)
    a0 = u ** (1.0 / LRU_C)
    return {
        "x": nrm(ks[0], (BATCH, SEQ, D_MODEL), 1.0),
        "norm_mix_g": 1.0 + nrm(ks[1], (DEPTH, D_MODEL), 0.01),
        "w_in": nrm(ks[2], (DEPTH, D_MODEL, IN_COLS), D_MODEL ** -0.5),
        "gla_w_gate_up": nrm(ks[3], (DEPTH, GLA_GATE_RANK, GLA_KW), GLA_GATE_RANK ** -0.5),
        "gla_b_gate": nrm(ks[4], (DEPTH, GLA_KW), 0.1),
        "gla_norm_g": 1.0 + nrm(ks[5], (DEPTH, GLA_WIDTH), 0.01),
        "lru_conv_w": nrm(ks[6], (DEPTH, LRU_CONV, LRU_WIDTH), LRU_CONV ** -0.5),
        "lru_conv_b": nrm(ks[7], (DEPTH, LRU_WIDTH), 0.01),
        "lru_w_a": nrm(ks[8], (DEPTH, LRU_HEADS, LRU_BLOCK, LRU_BLOCK), LRU_BLOCK ** -0.5),
        "lru_b_a": nrm(ks[9], (DEPTH, LRU_WIDTH), 0.1),
        "lru_w_i": nrm(ks[10], (DEPTH, LRU_HEADS, LRU_BLOCK, LRU_BLOCK), LRU_BLOCK ** -0.5),
        "lru_b_i": nrm(ks[11], (DEPTH, LRU_WIDTH), 0.1),
        "lru_a_param": jnp.log(a0 / (1.0 - a0)),
        "w_out": nrm(ks[12], (DEPTH, MIX_WIDTH, D_MODEL), MIX_WIDTH ** -0.5),
        "norm_ffn_g": 1.0 + nrm(ks[14], (DEPTH, D_MODEL), 0.01),
        "w_router": nrm(ks[15], (DEPTH, D_MODEL, N_EXPERTS), D_MODEL ** -0.5),
        "b_router": nrm(ks[16], (DEPTH, N_EXPERTS), 0.01),
        "w_gate_up": nrm(ks[17], (DEPTH, N_EXPERTS, D_MODEL, 2 * D_FF), D_MODEL ** -0.5),
        "b_gate_up": nrm(ks[18], (DEPTH, N_EXPERTS, 2 * D_FF), 0.01),
        "w_down": nrm(ks[19], (DEPTH, N_EXPERTS, D_FF, D_MODEL), D_FF ** -0.5),
        "b_down": nrm(ks[20], (DEPTH, N_EXPERTS, D_MODEL), 0.01),
        "norm_final_g": 1.0 + nrm(ks[21], (D_MODEL,), 0.01),
    }


def reference(x, norm_mix_g, w_in, gla_w_gate_up, gla_b_gate, gla_norm_g, lru_conv_w, lru_conv_b,
              lru_w_a, lru_b_a, lru_w_i, lru_b_i, lru_a_param, w_out, norm_ffn_g, w_router, b_router,
              w_gate_up, b_gate_up, w_down, b_down, norm_final_g):
    B, S, _ = x.shape
    split_points = np.cumsum([GLA_KW, GLA_KW, GLA_WIDTH, GLA_WIDTH, GLA_GATE_RANK, LRU_WIDTH])
    for l in range(DEPTH):
        h = rms_norm(x, norm_mix_g[l])
        z = h @ w_in[l]
        q, k, v, r, g_low, lx, lgate = jnp.split(z, split_points, axis=-1)

        log_g = jax.nn.log_sigmoid((g_low @ gla_w_gate_up[l] + gla_b_gate[l]).astype(jnp.float32)) / GLA_GATE_NORM
        o = gla_chunked(q.reshape(B, S, GLA_HEADS, GLA_DK), k.reshape(B, S, GLA_HEADS, GLA_DK),
                        v.reshape(B, S, GLA_HEADS, GLA_DV), log_g.reshape(B, S, GLA_HEADS, GLA_DK))
        o = o * lax.rsqrt(jnp.mean(o * o, axis=-1, keepdims=True) + EPS)
        o = o.reshape(B, S, GLA_WIDTH) * gla_norm_g[l]
        gla_out = (jax.nn.silu(r.astype(jnp.float32)) * o).astype(x.dtype)

        xc = causal_depthwise_conv(lx, lru_conv_w[l], lru_conv_b[l])
        hl = rg_lru(xc, lru_w_a[l], lru_b_a[l], lru_w_i[l], lru_b_i[l], lru_a_param[l])
        lru_out = (hl * jax.nn.gelu(lgate.astype(jnp.float32))).astype(x.dtype)

        x = x + jnp.concatenate([gla_out, lru_out], axis=-1) @ w_out[l]

        hf = rms_norm(x, norm_ffn_g[l])
        x = x + moe_ffn(hf, w_router[l], b_router[l], w_gate_up[l], b_gate_up[l], w_down[l], b_down[l])
    return rms_norm(x, norm_final_g)
```

```cpp
#define STAGE 4
#define PER_PHASE_LAUNCH 0
#define REPEAT_MASK 0
#include <hip/hip_runtime.h>
#include <stdint.h>
#include <stdio.h>

#define GAS __attribute__((address_space(1)))
#define LAS __attribute__((address_space(3)))
typedef unsigned short bf16_t;
typedef short bf16x8 __attribute__((ext_vector_type(8)));
typedef short bf16x4 __attribute__((ext_vector_type(4)));
typedef float f32x4 __attribute__((ext_vector_type(4)));
typedef float f32x2 __attribute__((ext_vector_type(2)));
typedef float f32x16 __attribute__((ext_vector_type(16)));
typedef unsigned u32x4 __attribute__((ext_vector_type(4)));
typedef unsigned u32x2 __attribute__((ext_vector_type(2)));

constexpr int T = 16384, SEQL = 8192, DM = 2048, INC = 5136, ZC = 5120, NEXP = 32;
constexpr int ZQ = 0, ZK = 512, ZV = 1024, ZR = 2048, ZLX = 3072, ZLG = 4096;
constexpr int MPAD_MAX = 65536 + NEXP * 256;
constexpr int NCHUNK = 256;

constexpr size_t MiB = 1u << 20;
constexpr size_t WS_CTL = 0, CTL_ZERO_BYTES = 1 * MiB;
constexpr size_t WS_WINT = 1 * MiB;
constexpr size_t WS_WOUTT = WS_WINT + 20 * MiB;
constexpr size_t WS_WGUT = WS_WOUTT + 8 * MiB;
constexpr size_t WS_WDT = WS_WGUT + 512 * MiB;
constexpr size_t WS_WAT = WS_WDT + 256 * MiB;
constexpr size_t WS_WIT = WS_WAT + 512 * 1024;
constexpr size_t WS_WRT = WS_WIT + 512 * 1024;
constexpr size_t WS_H = WS_WRT + 1 * MiB;
constexpr size_t WS_LG = WS_H + 64 * MiB;
constexpr size_t WS_Z = WS_LG + 32 * MiB;
constexpr size_t WS_AN = WS_Z + 160 * MiB;
constexpr size_t WS_DN = WS_AN + 128 * MiB;
constexpr size_t WS_SP = WS_DN + 1 * MiB;
constexpr size_t WS_AUA = WS_SP + 64 * MiB;
constexpr size_t WS_AUU = WS_AUA + 64 * MiB;
constexpr size_t WS_SUMA = WS_AUU + 64 * MiB;
constexpr size_t WS_SUMH = WS_SUMA + 1 * MiB;
constexpr size_t WS_MIX = WS_SUMH + 1 * MiB;
constexpr size_t WS_XMID = WS_MIX + 64 * MiB;
constexpr size_t WS_RSTD = WS_XMID + 128 * MiB;
constexpr size_t WS_TOKE = WS_RSTD + 1 * MiB;
constexpr size_t WS_GATES = WS_TOKE + 1 * MiB;
constexpr size_t WS_ABUF = WS_GATES + 1 * MiB;
constexpr size_t WS_ACT = WS_ABUF + 288 * MiB;
constexpr size_t WS_Y = WS_ACT + 288 * MiB;
constexpr size_t WS_END = WS_Y + 288 * MiB;
constexpr int CW_BAR = 4096;
constexpr int CW_CNT = 16384;

constexpr int RING_BYTES = 131072;
constexpr int SCR_BYTES = 135168;
constexpr int MISC_OFF = SCR_BYTES;
constexpr int LDS_BYTES = 147456;
constexpr int MI_PBASE = 16, MI_NMT = 48, MI_LCNT = 64, MI_LBASE = 96, MI_T2E = 128;

#define LDS_WAIT() asm volatile("s_waitcnt lgkmcnt(0)" ::: "memory")
#define VM_WAIT() asm volatile("s_waitcnt vmcnt(0)" ::: "memory")

__device__ __forceinline__ unsigned f2bf(float f) { unsigned u = __builtin_bit_cast(unsigned, f); return (u + 0x7fffu + ((u >> 16) & 1u)) >> 16; }
__device__ __forceinline__ unsigned pk2(float lo, float hi) { return f2bf(lo) | (f2bf(hi) << 16); }
__device__ __forceinline__ float bf2f(unsigned short b) { return __builtin_bit_cast(float, (unsigned)b << 16); }
__device__ __forceinline__ float bflo(unsigned w) { return __builtin_bit_cast(float, w << 16); }
__device__ __forceinline__ float bfhi(unsigned w) { return __builtin_bit_cast(float, w & 0xffff0000u); }
__device__ __forceinline__ float wave_sum(float v) {
#pragma unroll
    for (int o = 1; o < 64; o <<= 1) v += __shfl_xor(v, o);
    return v;
}
__device__ __forceinline__ float sigmoidf_(float x) { return 1.0f / (1.0f + __expf(-x)); }

#define XB_TMO      128
#define XB_XCNT(j)  (256  + 64 * (j))
#define XB_XSUB(j)  (1280 + 64 * (j))
#define XB_XGEN(j)  (2304 + 64 * (j))
#define XB_TOP      3328
#define XB_TOPGEN   3392
#define XCD_BAR_WORDS 3456
#define XB_SPIN_CAP (1u << 18)

__device__ __forceinline__ unsigned xb_ld(unsigned* p)              { return __hip_atomic_load(p, __ATOMIC_RELAXED, __HIP_MEMORY_SCOPE_AGENT); }
__device__ __forceinline__ unsigned xb_add(unsigned* p, unsigned v) { return __hip_atomic_fetch_add(p, v, __ATOMIC_RELAXED, __HIP_MEMORY_SCOPE_AGENT); }
__device__ __forceinline__ unsigned xb_xcc_id() { return (unsigned)__builtin_amdgcn_s_getreg((3 << 11) | 20) & 0xFu; }
#define XB_SPIN(cond, bar) do { unsigned _sp = 0; while (cond) { __builtin_amdgcn_s_sleep(1); \
    if ((++_sp & 255u) == 0u) { if (xb_ld(&(bar)[XB_TMO])) break; if (_sp > XB_SPIN_CAP) { atomicAdd(&(bar)[XB_TMO], 1u); break; } } } } while (0)

struct XcdBarrier { unsigned* bar; unsigned x; volatile LAS unsigned* st; };

__device__ __forceinline__ XcdBarrier xcd_barrier_post(unsigned* bar, volatile LAS unsigned* st) {
    XcdBarrier b; b.bar = bar; b.x = xb_xcc_id(); b.st = st;
    if (threadIdx.x == 0) (void)xb_add(&bar[XB_XCNT(b.x)], 1u);
    return b;
}
__device__ __forceinline__ void xcd_barrier_complete(unsigned* bar, unsigned x, unsigned& nloc, unsigned& nx) {
    const unsigned G = gridDim.x * gridDim.y * gridDim.z;
    unsigned sum, cnt, mine, sp = 0u;
    for (;;) {
        sum = 0u; cnt = 0u; mine = 0u;
#pragma unroll
        for (unsigned j = 0; j < 16; ++j) { const unsigned c = xb_ld(&bar[XB_XCNT(j)]); sum += c; cnt += (c > 0u) ? 1u : 0u; mine = (j == x) ? c : mine; }
        if (sum == G) break;
        __builtin_amdgcn_s_sleep(1);
        if ((++sp & 255u) == 0u) { if (xb_ld(&bar[XB_TMO])) break; if (sp > XB_SPIN_CAP) { atomicAdd(&bar[XB_TMO], 1u); break; } }
    }
    nloc = mine > 0u ? mine : 1u; nx = cnt > 0u ? cnt : 1u;
}
__device__ __forceinline__ void xcd_barrier(const XcdBarrier& b) {
    asm volatile("s_waitcnt vmcnt(0)" ::: "memory");
    __syncthreads();
    if (threadIdx.x == 0) {
        unsigned* bar = b.bar;
        __builtin_amdgcn_s_waitcnt(0);
        unsigned nloc = b.st[0], nx = b.st[1];
        if (nloc == 0u) { xcd_barrier_complete(bar, b.x, nloc, nx); b.st[0] = nloc; b.st[1] = nx; }
        const unsigned old = xb_add(&bar[XB_XSUB(b.x)], 1u);
        const unsigned gen = old / nloc;
        if (old + 1u == (gen + 1u) * nloc) {
            __builtin_amdgcn_fence(__ATOMIC_RELEASE, "agent");
            asm volatile("s_waitcnt vmcnt(0)" ::: "memory");
            const unsigned og = xb_add(&bar[XB_TOP], 1u);
            const unsigned tg = og / nx;
            if (og + 1u == (tg + 1u) * nx) xb_add(&bar[XB_TOPGEN], 1u);
            else XB_SPIN(xb_ld(&bar[XB_TOPGEN]) == tg, bar);
            __builtin_amdgcn_fence(__ATOMIC_ACQUIRE, "agent");
            xb_add(&bar[XB_XGEN(b.x)], 1u);
            asm volatile("s_waitcnt vmcnt(0)" ::: "memory");
        } else {
            XB_SPIN(xb_ld(&bar[XB_XGEN(b.x)]) == gen, bar);
            __builtin_amdgcn_fence(__ATOMIC_ACQUIRE, "agent");
            asm volatile("s_waitcnt vmcnt(0)" ::: "memory");
        }
    }
    __syncthreads();
}

namespace pg8 {
constexpr int BM = 256, BK = 64, HALF = 128, HTB = HALF * BK * 2, STAGE_BYTES = 8 * HTB, NXCD = 8, WGM = 8;
__host__ __device__ __forceinline__ int lds_byte(int r, int c) { const int st = (r >> 4) * 2 + (c >> 5), rr = r & 15, cc = c & 31, ob = rr * 64 + cc * 2; return st * 1024 + (ob ^ (((ob >> 9) & 1) << 5)); }
__host__ __device__ __forceinline__ void stage_rc(int b, int& R, int& C) { const int st = b / 1024, sb = b % 1024, swz = sb ^ (((sb >> 9) & 1) << 5); R = (st >> 1) * 16 + swz / 64; C = (st & 1) * 32 + (swz % 64) / 2; }
__host__ __device__ __forceinline__ int perm32(int rho) { const int n = rho >> 4, i = rho & 15; return 8 * (i >> 2) + 4 * n + (i & 3); }

struct Unit { int pm, pn, e; };
struct Gemm { const bf16_t* A; const bf16_t* Bt; int lda, ldb, K; size_t strideB; };

__device__ __forceinline__ bool order_map(long L, int nM, int nN, int& pm, int& pn) {
    const int nwg = nM * nN; if (L >= nwg) return false;
    int wgid = (int)L; { const int q = nwg / NXCD, r = nwg % NXCD, xcd = wgid % NXCD, off = wgid / NXCD; wgid = (xcd < r ? xcd * (q + 1) : r * (q + 1) + (xcd - r) * q) + off; }
    const int nig = WGM * nN, gid = wgid / nig, fm = gid * WGM, gsz = (nM - fm) < WGM ? (nM - fm) : WGM;
    pm = fm + ((wgid % nig) % gsz); pn = (wgid % nig) / gsz; return true;
}
struct StaticOrder {
    int nM, nN, G, c;
    __device__ void init(int M, int N, int G_, int c_) { nM = M / BM; nN = N / BM; G = G_; c = c_; }
    __device__ __forceinline__ bool next(int i, Unit& u) const { u.e = 0; return order_map((long)i * G + c, nM, nN, u.pm, u.pn); }
};
struct MoeOrder {
    int nM, nN, G, c; const LAS int* t2e;
    __device__ __forceinline__ bool next(int i, Unit& u) const { if (!order_map((long)i * G + c, nM, nN, u.pm, u.pn)) return false; u.e = t2e[u.pm]; return true; }
};

__device__ __forceinline__ unsigned cvt_pk_bf16(float lo, float hi) { unsigned r; asm volatile("v_cvt_pk_bf16_f32 %0, %1, %2" : "=v"(r) : "v"(lo), "v"(hi)); return r; }

struct EpiBf16 {
    static constexpr bool PERM = true;
    bf16_t* O; int ldc; const float* bias; int bias_stride;
    __device__ __forceinline__ void operator()(const f32x4 (&acc)[2][2][4][2], const Unit& u, int wr, int wc, int fr, int fq) const {
        const int row0 = u.pm * BM + wr * 64 + fr; const int col0 = u.pn * BM + wc * 32 + 8 * fq;
        f32x4 bv[2][2];
#pragma unroll
        for (int bj = 0; bj < 2; ++bj)
#pragma unroll
            for (int n = 0; n < 2; ++n) bv[bj][n] = bias ? *(const f32x4*)(bias + (size_t)u.e * bias_stride + col0 + bj * HALF + 4 * n) : (f32x4){0.f, 0.f, 0.f, 0.f};
#pragma unroll
        for (int ai = 0; ai < 2; ++ai)
#pragma unroll
            for (int m = 0; m < 4; ++m) { bf16_t* rowp = O + (size_t)(row0 + ai * HALF + m * 16) * ldc + col0;
#pragma unroll
                for (int bj = 0; bj < 2; ++bj) { const f32x4 v0 = acc[ai][bj][m][0] + bv[bj][0], v1 = acc[ai][bj][m][1] + bv[bj][1];
                    u32x4 w; w.x = cvt_pk_bf16(v0[0], v0[1]); w.y = cvt_pk_bf16(v0[2], v0[3]); w.z = cvt_pk_bf16(v1[0], v1[1]); w.w = cvt_pk_bf16(v1[2], v1[3]);
                    *(u32x4*)(rowp + bj * HALF) = w; } }
    }
};
struct EpiF32Res {
    static constexpr bool PERM = false;
    float* C; const float* resid; int ldc;
    __device__ __forceinline__ void operator()(const f32x4 (&acc)[2][2][4][2], const Unit& u, int wr, int wc, int fr, int fq) const {
        const int row0 = u.pm * BM + wr * 64 + fr, col0 = u.pn * BM + wc * 32 + 4 * fq;
#pragma unroll
        for (int ai = 0; ai < 2; ++ai)
#pragma unroll
            for (int m = 0; m < 4; ++m) { const size_t off = (size_t)(row0 + ai * HALF + m * 16) * ldc + col0;
#pragma unroll
                for (int bj = 0; bj < 2; ++bj)
#pragma unroll
                    for (int n = 0; n < 2; ++n) { const f32x4 r = *(const f32x4*)(resid + off + bj * HALF + n * 16); *(f32x4*)(C + off + bj * HALF + n * 16) = acc[ai][bj][m][n] + r; } }
    }
};
struct EpiSwiGLU {
    static constexpr bool PERM = true;
    bf16_t* O; int ldc; const float* bias;
    __device__ __forceinline__ void operator()(const f32x4 (&acc)[2][2][4][2], const Unit& u, int wr, int wc, int fr, int fq) const {
        const int row0 = u.pm * BM + wr * 64 + fr; const int j0 = u.pn * HALF + wc * 32 + 8 * fq;
        const float* be = bias + (size_t)u.e * 4096;
        f32x4 bg[2], bu[2];
#pragma unroll
        for (int n = 0; n < 2; ++n) { bg[n] = *(const f32x4*)(be + j0 + 4 * n); bu[n] = *(const f32x4*)(be + 2048 + j0 + 4 * n); }
#pragma unroll
        for (int ai = 0; ai < 2; ++ai)
#pragma unroll
            for (int m = 0; m < 4; ++m) { bf16_t* rowp = O + (size_t)(row0 + ai * HALF + m * 16) * ldc + j0;
                float o[8];
#pragma unroll
                for (int n = 0; n < 2; ++n) { const f32x4 g = acc[ai][0][m][n] + bg[n], up = acc[ai][1][m][n] + bu[n];
#pragma unroll
                    for (int q = 0; q < 4; ++q) { const float gt = fminf(g[q], 7.0f), ut = fminf(fmaxf(up[q], -7.0f), 7.0f);
                        const float glu = gt * __builtin_amdgcn_rcpf(1.0f + __expf(-1.702f * gt)); o[4 * n + q] = (ut + 1.0f) * glu; } }
                u32x4 w; w.x = cvt_pk_bf16(o[0], o[1]); w.y = cvt_pk_bf16(o[2], o[3]); w.z = cvt_pk_bf16(o[4], o[5]); w.w = cvt_pk_bf16(o[6], o[7]);
                *(u32x4*)rowp = w; }
    }
};

template <class Epi, class Sched, bool ALIGN_EPI = true>
__device__ __forceinline__ void gemm_phase(LAS unsigned char* lds, const Gemm g, const Sched& S, const Epi& E) {
    const int tid = threadIdx.x, wid = __builtin_amdgcn_readfirstlane(tid >> 6), lane = tid & 63, wr = wid >> 2, wc = wid & 3, fr = lane & 15, fq = lane >> 4;
    const int K = g.K, nt = K / BK;
    unsigned voffA[2], voffB[2];
#pragma unroll
    for (int i = 0; i < 2; ++i) { int R, C; stage_rc(tid * 16 + i * 8192, R, C); const int Rb = Epi::PERM ? ((R & ~31) + perm32(R & 31)) : R;
        voffA[i] = (unsigned)(R * g.lda + C) * 2u; voffB[i] = (unsigned)(Rb * g.ldb + C) * 2u; }
    const size_t kstep = (size_t)(BK * 2);
    const size_t hstepA = (size_t)HALF * g.lda * 2, hstepB = (size_t)HALF * g.ldb * 2;
    const size_t tstepA = 2 * hstepA, tstepB = 2 * hstepB;
    const unsigned ldsw = (unsigned)wid * 1024u;
    const int aoff = lds_byte(wr * 64 + fr, fq * 8), boff = lds_byte(wc * 32 + fr, fq * 8);
#define PG8_SA(b, h) (((b) * 2 + (h)) * HTB)
#define PG8_SB(b, h) ((4 + (b) * 2 + (h)) * HTB)
#define PG8_STAGE(bufoff, gbase, voff) do { _Pragma("unroll") for (int _i = 0; _i < 2; ++_i) \
        __builtin_amdgcn_global_load_lds((const unsigned*)((const char*)(gbase) + (voff)[_i]), (LAS unsigned*)(lds + (bufoff) + ldsw + _i * 8192), 16, 0, 0); } while (0)
#define PG8_LDA(dst, b, h) do { _Pragma("unroll") for (int m = 0; m < 4; ++m) _Pragma("unroll") for (int k = 0; k < 2; ++k) dst[m][k] = *(const LAS bf16x8*)(lds + PG8_SA(b, h) + aoff + m * 2048 + k * 1024); } while (0)
#define PG8_LDB(dst, b, h) do { _Pragma("unroll") for (int n = 0; n < 2; ++n) _Pragma("unroll") for (int k = 0; k < 2; ++k) dst[n][k] = *(const LAS bf16x8*)(lds + PG8_SB(b, h) + boff + n * 2048 + k * 1024); } while (0)
#define PG8_MMA(ai, bj, At, Bt) do { __builtin_amdgcn_s_setprio(1); _Pragma("unroll") for (int m = 0; m < 4; ++m) _Pragma("unroll") for (int n = 0; n < 2; ++n) _Pragma("unroll") for (int k = 0; k < 2; ++k) \
        acc[ai][bj][m][n] = __builtin_amdgcn_mfma_f32_16x16x32_bf16(Bt[n][k], At[m][k], acc[ai][bj][m][n], 0, 0, 0); __builtin_amdgcn_s_setprio(0); } while (0)
#define PG8_WAIT_V(n) asm volatile("s_waitcnt vmcnt(" #n ")" ::: "memory")
#define PG8_WAIT_L(n) asm volatile("s_waitcnt lgkmcnt(" #n ")" ::: "memory")
#define PG8_BAR __builtin_amdgcn_s_barrier()
#define PG8_SCHED __builtin_amdgcn_sched_barrier(0)
    Unit cur, nxt; int ui = 0;
    if (!S.next(0, cur)) return;
    f32x4 acc[2][2][4][2];
#pragma unroll
    for (int a = 0; a < 2; ++a)
#pragma unroll
        for (int b = 0; b < 2; ++b)
#pragma unroll
            for (int m = 0; m < 4; ++m)
#pragma unroll
                for (int n = 0; n < 2; ++n) acc[a][b][m][n] = (f32x4){0.f, 0.f, 0.f, 0.f};
    bf16x8 At[4][2], B0[2][2], B1[2][2];
    const char* cA = (const char*)g.A + (size_t)cur.pm * tstepA; const char* cB = (const char*)g.Bt + ((size_t)cur.e * g.strideB) * 2 + (size_t)cur.pn * tstepB;
    PG8_STAGE(PG8_SB(0, 0), cB, voffB); PG8_STAGE(PG8_SB(0, 1), cB + hstepB, voffB); PG8_STAGE(PG8_SA(0, 0), cA, voffA); PG8_STAGE(PG8_SA(0, 1), cA + hstepA, voffA);
    if (wr == 1) PG8_BAR;
    PG8_WAIT_V(2); PG8_BAR;
    PG8_STAGE(PG8_SB(1, 0), cB + kstep, voffB); PG8_STAGE(PG8_SA(1, 0), cA + kstep, voffA); PG8_STAGE(PG8_SB(1, 1), cB + hstepB + kstep, voffB);
    PG8_WAIT_V(6); PG8_BAR;
    for (;;) {
        const bool has_next = S.next(ui + 1, nxt);
        const char* nA = has_next ? (const char*)g.A + (size_t)nxt.pm * tstepA : cA;
        const char* nB = has_next ? (const char*)g.Bt + ((size_t)nxt.e * g.strideB) * 2 + (size_t)nxt.pn * tstepB : cB;
        for (int t = 0; t < nt; t += 2) {
            const bool last = (t == nt - 2);
            const char* a1 = cA + (size_t)(t + 1) * kstep;
            const char* a2 = last ? nA : cA + (size_t)(t + 2) * kstep; const char* b2 = last ? nB : cB + (size_t)(t + 2) * kstep;
            const char* a3 = a2 + kstep; const char* b3 = b2 + kstep;
            PG8_LDB(B0, 0, 0); PG8_LDB(B1, 0, 1); PG8_SCHED; PG8_LDA(At, 0, 0); PG8_STAGE(PG8_SA(1, 1), a1 + hstepA, voffA);
            PG8_WAIT_V(8); PG8_WAIT_L(0); PG8_BAR; PG8_MMA(0, 0, At, B0); PG8_MMA(0, 1, At, B1); PG8_BAR; PG8_SCHED;
            PG8_LDA(At, 0, 1); PG8_STAGE(PG8_SB(0, 0), b2, voffB); PG8_STAGE(PG8_SB(0, 1), b2 + hstepB, voffB); PG8_STAGE(PG8_SA(0, 0), a2, voffA);
            PG8_WAIT_V(8); PG8_WAIT_L(0); PG8_BAR; PG8_MMA(1, 0, At, B0); PG8_MMA(1, 1, At, B1); PG8_BAR; PG8_SCHED;
            PG8_LDB(B0, 1, 0); PG8_LDB(B1, 1, 1); PG8_SCHED; PG8_LDA(At, 1, 0); PG8_STAGE(PG8_SA(0, 1), a2 + hstepA, voffA);
            PG8_WAIT_V(8); PG8_WAIT_L(0); PG8_BAR; PG8_MMA(0, 0, At, B0); PG8_MMA(0, 1, At, B1); PG8_BAR; PG8_SCHED;
            PG8_LDA(At, 1, 1); PG8_STAGE(PG8_SB(1, 0), b3, voffB); PG8_STAGE(PG8_SB(1, 1), b3 + hstepB, voffB); PG8_STAGE(PG8_SA(1, 0), a3, voffA);
            PG8_WAIT_V(8); PG8_WAIT_L(0); PG8_BAR; PG8_MMA(1, 0, At, B0); PG8_MMA(1, 1, At, B1); PG8_BAR; PG8_SCHED;
        }
        if constexpr (ALIGN_EPI) { if (wr == 0) PG8_BAR; }
        E(acc, cur, wr, wc, fr, fq);
        if (!has_next) break;
#pragma unroll
        for (int a = 0; a < 2; ++a)
#pragma unroll
            for (int b = 0; b < 2; ++b)
#pragma unroll
                for (int m = 0; m < 4; ++m)
#pragma unroll
                    for (int n = 0; n < 2; ++n) acc[a][b][m][n] = (f32x4){0.f, 0.f, 0.f, 0.f};
        cur = nxt; cA = nA; cB = nB; ++ui;
        if constexpr (ALIGN_EPI) { if (wr == 1) PG8_BAR; }
    }
    PG8_WAIT_V(0);
    if constexpr (!ALIGN_EPI) { if (wr == 0) PG8_BAR; }
    PG8_BAR;
#undef PG8_SA
#undef PG8_SB
#undef PG8_STAGE
#undef PG8_LDA
#undef PG8_LDB
#undef PG8_MMA
#undef PG8_WAIT_V
#undef PG8_WAIT_L
#undef PG8_BAR
#undef PG8_SCHED
}
}
struct Params {
    const float* in[22];
    float* out; unsigned char* ws;
    int ph_lo, ph_hi;
};
enum { I_X = 0, I_NMG, I_WIN, I_GWG, I_GBG, I_GNG, I_CW, I_CB, I_WA, I_BA, I_WI, I_BI, I_AP, I_WOUT, I_NFG, I_WR, I_BR, I_WGU, I_BGU, I_WDN, I_BDN, I_NFINAL };

struct Frame {
    LAS unsigned char* lds; volatile LAS unsigned* MISC;
    int tid, lane, wave, G, gw, NGW;
    unsigned char* ws;
};

__device__ __forceinline__ float gelu_tanh_f(float x) {
    const float u = 0.7978845608028654f * (x + 0.044715f * x * x * x);
    const float e = __expf(2.0f * u);
    const float th = 1.0f - 2.0f * __builtin_amdgcn_rcpf(e + 1.0f);
    return 0.5f * x * (1.0f + th);
}
__device__ __forceinline__ float log_sigmoid_f(float s) { return fminf(s, 0.f) - log1pf(__expf(-fabsf(s))); }

__device__ __forceinline__ void p0_item(const float* W, int ldw, int col0, bf16_t* WT, int ldt, size_t drow0, int k0, LAS float* scr, int lane) {
    (void)scr;
    const float* src = W + (size_t)k0 * ldw + col0 + lane;
    float v[64];
#pragma unroll
    for (int i = 0; i < 64; ++i) v[i] = src[(size_t)i * ldw];
    bf16_t* dst = WT + (drow0 + lane) * (size_t)ldt + k0;
#pragma unroll
    for (int c = 0; c < 8; ++c) { u32x4 o; o.x = pk2(v[8 * c], v[8 * c + 1]); o.y = pk2(v[8 * c + 2], v[8 * c + 3]); o.z = pk2(v[8 * c + 4], v[8 * c + 5]); o.w = pk2(v[8 * c + 6], v[8 * c + 7]);
        *(u32x4*)(dst + 8 * c) = o; }
}

__device__ __forceinline__ void p0a(Frame& F, const Params& p) {
    LAS float* scr = (LAS float*)(F.lds + F.wave * 16640);
    const float* w_in = p.in[I_WIN]; const float* w_out = p.in[I_WOUT]; const float* w_gu = p.in[I_WGU]; const float* w_dn = p.in[I_WDN];
    bf16_t* WinT = (bf16_t*)(F.ws + WS_WINT); bf16_t* WoutT = (bf16_t*)(F.ws + WS_WOUTT); bf16_t* WguT = (bf16_t*)(F.ws + WS_WGUT); bf16_t* WdT = (bf16_t*)(F.ws + WS_WDT);
    bf16_t* WaT = (bf16_t*)(F.ws + WS_WAT); bf16_t* WiT = (bf16_t*)(F.ws + WS_WIT);
    constexpr int N_INA = 32 * 48, N_INB = 32 * 32, N_OUT = 32 * 32, N_LRU = 128, N_GU = 32 * 2048, N_DN = 32 * 1024;
    constexpr int NITEMS = N_INA + N_INB + N_OUT + N_LRU + N_GU + N_DN;
    for (int it = F.gw; it < NITEMS; it += F.NGW) {
        int r = it;
        if (r < N_INA) { const int kb = r / 48, nb = r % 48; p0_item(w_in, INC, 64 * nb, WinT, DM, (size_t)64 * nb, 64 * kb, scr, F.lane); continue; } r -= N_INA;
        if (r < N_INB) { const int kb = r / 32, nb = r % 32; p0_item(w_in, INC, 3088 + 64 * nb, WinT, DM, (size_t)3072 + 64 * nb, 64 * kb, scr, F.lane); continue; } r -= N_INB;
        if (r < N_OUT) { const int kb = r / 32, nb = r % 32; p0_item(w_out, DM, 64 * nb, WoutT, DM, (size_t)64 * nb, 64 * kb, scr, F.lane); continue; } r -= N_OUT;
        if (r < N_LRU) { const int which = r >> 6, h = (r >> 4) & 3, kb = (r >> 2) & 3, nb = r & 3;
            p0_item((which ? p.in[I_WI] : p.in[I_WA]) + (size_t)h * 65536, 256, 64 * nb, (which ? WiT : WaT) + (size_t)h * 65536, 256, (size_t)64 * nb, 64 * kb, scr, F.lane); continue; } r -= N_LRU;
        if (r < N_GU) { const int e = r >> 11, q = r & 2047, kb = q >> 6, nb = q & 63; const int n0 = 64 * nb;
            const int drow0 = (n0 < 2048) ? (256 * (n0 >> 7) + (n0 & 127)) : (256 * ((n0 - 2048) >> 7) + 128 + ((n0 - 2048) & 127));
            p0_item(w_gu + (size_t)e * DM * 4096, 4096, n0, WguT + (size_t)e * 4096 * DM, DM, (size_t)drow0, 64 * kb, scr, F.lane); continue; } r -= N_GU;
        { const int e = r >> 10, q = r & 1023, kb = q >> 5, nb = q & 31;
            p0_item(w_dn + (size_t)e * DM * DM, DM, 64 * nb, WdT + (size_t)e * DM * DM, DM, (size_t)64 * nb, 64 * kb, scr, F.lane); }
    }
    { float* WrT = (float*)(F.ws + WS_WRT); const float* wr = p.in[I_WR]; const float* gf = p.in[I_NFG];
      for (int idx = (int)blockIdx.x * 512 + F.tid; idx < 32 * DM; idx += F.G * 512) { const int n = idx >> 11, k = idx & 2047; WrT[idx] = wr[k * 32 + n] * gf[k]; } }
}
__device__ __forceinline__ void p0b(Frame& F, const Params& p) {
    const float* w_in = p.in[I_WIN];
    __syncthreads();
    { LAS f32x4* Wl = (LAS f32x4*)F.lds;
      for (int idx = F.tid; idx < 8192; idx += 512) { const int l = idx & 63, i = (idx >> 6) & 3, j = (idx >> 8) & 7, c4 = idx >> 11; const int k = 4 * l + 256 * j + i;
          Wl[idx] = *(const f32x4*)(w_in + (size_t)k * INC + 3072 + 4 * c4); }
      __syncthreads();
      const float* x = p.in[I_X]; const float* g1 = p.in[I_NMG]; const float* wg = p.in[I_GWG]; const float* bgp = p.in[I_GBG];
      bf16_t* H = (bf16_t*)(F.ws + WS_H); float* LG = (float*)(F.ws + WS_LG);
      const int l = F.lane;
      f32x4 xn[8];
#pragma unroll
      for (int j = 0; j < 8; ++j) xn[j] = (F.gw < T) ? *(const f32x4*)(x + (size_t)F.gw * DM + 4 * l + 256 * j) : (f32x4){0.f, 0.f, 0.f, 0.f};
      for (int m = F.gw; m < T; m += F.NGW) {
          f32x4 xv[8]; float ss = 0.f;
#pragma unroll
          for (int j = 0; j < 8; ++j) { xv[j] = xn[j]; ss += (xv[j][0] * xv[j][0] + xv[j][1] * xv[j][1]) + (xv[j][2] * xv[j][2] + xv[j][3] * xv[j][3]); }
          if (m + F.NGW < T) {
#pragma unroll
              for (int j = 0; j < 8; ++j) xn[j] = *(const f32x4*)(x + (size_t)(m + F.NGW) * DM + 4 * l + 256 * j); }
          const float rs = 1.0f / sqrtf(wave_sum(ss) * (1.0f / DM) + 1e-6f);
          float acc[16];
#pragma unroll
          for (int c = 0; c < 16; ++c) acc[c] = 0.f;
#pragma unroll
          for (int j = 0; j < 8; ++j) { __builtin_amdgcn_sched_barrier(0); const f32x4 gv = *(const f32x4*)(g1 + 4 * l + 256 * j); xv[j] = xv[j] * rs * gv;
              u32x2 o; o.x = pk2(xv[j][0], xv[j][1]); o.y = pk2(xv[j][2], xv[j][3]); *(u32x2*)(H + (size_t)m * DM + 4 * l + 256 * j) = o;
#pragma unroll
              for (int i = 0; i < 4; ++i)
#pragma unroll
                  for (int c4 = 0; c4 < 4; ++c4) { const f32x4 wv = Wl[((c4 * 8 + j) * 4 + i) * 64 + l];
                      acc[4 * c4 + 0] += xv[j][i] * wv[0]; acc[4 * c4 + 1] += xv[j][i] * wv[1]; acc[4 * c4 + 2] += xv[j][i] * wv[2]; acc[4 * c4 + 3] += xv[j][i] * wv[3]; } }
#pragma unroll
          for (int c = 0; c < 16; ++c) acc[c] = wave_sum(acc[c]);
          f32x4 s0 = *(const f32x4*)(bgp + 8 * l), s1 = *(const f32x4*)(bgp + 8 * l + 4);
#pragma unroll
          for (int jj = 0; jj < 16; ++jj) { const f32x4 w0 = *(const f32x4*)(wg + jj * 512 + 8 * l), w1 = *(const f32x4*)(wg + jj * 512 + 8 * l + 4); s0 += acc[jj] * w0; s1 += acc[jj] * w1; }
          f32x4 o0, o1;
#pragma unroll
          for (int q = 0; q < 4; ++q) { o0[q] = log_sigmoid_f(s0[q]) * 0.0625f; o1[q] = log_sigmoid_f(s1[q]) * 0.0625f; }
          *(f32x4*)(LG + (size_t)m * 512 + 8 * l) = o0; *(f32x4*)(LG + (size_t)m * 512 + 8 * l + 4) = o1;
      }
    }
    __syncthreads();
}

__device__ __forceinline__ void gla_cumsum(const float* LG, int tok0, int h, LAS float* BC, LAS float* SEG, int tid) {
    const int seg = tid >> 7, kk = tid & 127;
    float v[16];
#pragma unroll
    for (int i = 0; i < 16; ++i) v[i] = LG[(size_t)(tok0 + 16 * seg + i) * 512 + h * 128 + kk];
#pragma unroll
    for (int i = 1; i < 16; ++i) v[i] += v[i - 1];
    SEG[seg * 128 + kk] = v[15];
    __syncthreads();
    float off = 0.f;
#pragma unroll
    for (int s = 0; s < 3; ++s) off += (s < seg) ? SEG[s * 128 + kk] : 0.f;
#pragma unroll
    for (int i = 0; i < 16; ++i) BC[(16 * seg + i) * 128 + kk] = v[i] + off;
    __syncthreads();
}
__device__ __forceinline__ bf16x8 as_bf16x8(u32x4 v) { return __builtin_bit_cast(bf16x8, v); }
__device__ __forceinline__ bf16x8 cat4(bf16x4 lo, bf16x4 hi) { return __builtin_shufflevector(lo, hi, 0, 1, 2, 3, 4, 5, 6, 7); }

__device__ __forceinline__ void p2a(Frame& F, const Params& p) {
    const bf16_t* Z = (const bf16_t*)(F.ws + WS_Z); const float* LG = (const float*)(F.ws + WS_LG);
    float* AN = (float*)(F.ws + WS_AN); float* DN = (float*)(F.ws + WS_DN); float* AUA = (float*)(F.ws + WS_AUA); float* AUU = (float*)(F.ws + WS_AUU);
    const bf16_t* WaT = (const bf16_t*)(F.ws + WS_WAT); const bf16_t* WiT = (const bf16_t*)(F.ws + WS_WIT);
    LAS float* BC = (LAS float*)(F.lds); LAS float* SEG = (LAS float*)(F.lds + 32768);
    LAS bf16_t* KDT = (LAS bf16_t*)(F.lds + 34816); LAS bf16_t* VT = (LAS bf16_t*)(F.lds + 53248); LAS bf16_t* XC = (LAS bf16_t*)(F.lds + 90112);
    const int w = F.wave;
    for (int unit = blockIdx.x; unit < NCHUNK; unit += F.G) {
        const int b = unit >> 7, n = unit & 127, tok0 = b * SEQL + 64 * n;
        for (int h = 0; h < 4; ++h) {
            int tid = F.tid; asm volatile("" : "+v"(tid));
            int lane = tid & 63, r = lane & 31, hh = lane >> 5;
            gla_cumsum(LG, tok0, h, BC, SEG, tid);
            const int uh = (b * 4 + h) * 128 + n;
            if (tid < 128) DN[(size_t)uh * 128 + tid] = __expf(BC[63 * 128 + tid]);
#pragma unroll
            for (int it = 0; it < 2; ++it) { const int item = tid + 512 * it, t = item & 63, kk8 = item >> 6;
                const u32x4 kv = *(const u32x4*)(Z + (size_t)(tok0 + t) * ZC + ZK + h * 128 + kk8 * 8);
#pragma unroll
                for (int i = 0; i < 8; ++i) { const int kk = kk8 * 8 + i; const unsigned wv = kv[i >> 1]; const float kf = (i & 1) ? bfhi(wv) : bflo(wv);
                    const float d = __expf(BC[63 * 128 + kk] - BC[t * 128 + kk]); KDT[kk * 72 + t] = (bf16_t)f2bf(kf * d); } }
#pragma unroll
            for (int it = 0; it < 4; ++it) { const int item = tid + 512 * it, t = item & 63, vc8 = item >> 6;
                const u32x4 vv = *(const u32x4*)(Z + (size_t)(tok0 + t) * ZC + ZV + h * 256 + vc8 * 8);
#pragma unroll
                for (int i = 0; i < 8; ++i) { const unsigned wv = vv[i >> 1]; VT[(vc8 * 8 + i) * 72 + t] = (bf16_t)((i & 1) ? (wv >> 16) : (wv & 0xffffu)); } }
            __syncthreads();
            {
                f32x16 acc[4];
#pragma unroll
                for (int mb = 0; mb < 4; ++mb)
#pragma unroll
                    for (int q = 0; q < 16; ++q) acc[mb][q] = 0.f;
#pragma unroll
                for (int s = 0; s < 4; ++s) { const bf16x8 bfr = *(const LAS bf16x8*)(VT + (32 * w + r) * 72 + 16 * s + 8 * hh);
#pragma unroll
                    for (int mb = 0; mb < 4; ++mb) { const bf16x8 afr = *(const LAS bf16x8*)(KDT + (32 * mb + r) * 72 + 16 * s + 8 * hh);
                        acc[mb] = __builtin_amdgcn_mfma_f32_32x32x16_bf16(afr, bfr, acc[mb], 0, 0, 0); } }
                float* base = AN + (size_t)uh * 32768;
#pragma unroll
                for (int mb = 0; mb < 4; ++mb)
#pragma unroll
                    for (int g = 0; g < 4; ++g) *(f32x4*)(base + (((mb * 8 + w) * 4 + g) * 64 + lane) * 4) = (f32x4){acc[mb][4 * g], acc[mb][4 * g + 1], acc[mb][4 * g + 2], acc[mb][4 * g + 3]};
            }
#ifndef P2A_NO_LRU
            {
                tid = F.tid; asm volatile("" : "+v"(tid)); lane = tid & 63; r = lane & 31; hh = lane >> 5;
                const float* cw = p.in[I_CW]; const float* cb = p.in[I_CB];
                {
                    const int c8 = tid & 31, tq = tid >> 5, chc = h * 256 + c8 * 8;
                    u32x4 lv[7];
#pragma unroll
                    for (int i = 0; i < 7; ++i) { const int s = 64 * n + 4 * tq - 3 + i;
                        lv[i] = (s >= 0) ? *(const u32x4*)(Z + (size_t)(tok0 + 4 * tq - 3 + i) * ZC + ZLX + chc) : (u32x4){0u, 0u, 0u, 0u}; }
                    f32x4 wv[4][2], bv[2];
#pragma unroll
                    for (int i = 0; i < 4; ++i) { wv[i][0] = *(const f32x4*)(cw + i * 1024 + chc); wv[i][1] = *(const f32x4*)(cw + i * 1024 + chc + 4); }
                    bv[0] = *(const f32x4*)(cb + chc); bv[1] = *(const f32x4*)(cb + chc + 4);
#pragma unroll
                    for (int it = 0; it < 4; ++it) { float xc[8];
#pragma unroll
                        for (int q = 0; q < 4; ++q) { xc[q] = bv[0][q]; xc[4 + q] = bv[1][q]; }
#pragma unroll
                        for (int i = 0; i < 4; ++i) { const u32x4 l4 = lv[it + i];
                            xc[0] += bflo(l4[0]) * wv[i][0][0]; xc[1] += bfhi(l4[0]) * wv[i][0][1]; xc[2] += bflo(l4[1]) * wv[i][0][2]; xc[3] += bfhi(l4[1]) * wv[i][0][3];
                            xc[4] += bflo(l4[2]) * wv[i][1][0]; xc[5] += bfhi(l4[2]) * wv[i][1][1]; xc[6] += bflo(l4[3]) * wv[i][1][2]; xc[7] += bfhi(l4[3]) * wv[i][1][3]; }
                        u32x4 o; o.x = pk2(xc[0], xc[1]); o.y = pk2(xc[2], xc[3]); o.z = pk2(xc[4], xc[5]); o.w = pk2(xc[6], xc[7]);
                        *(LAS u32x4*)(XC + (4 * tq + it) * 264 + c8 * 8) = o; }
                }
                __builtin_amdgcn_sched_barrier(0);
                bf16x8 ba[16], bi[16];
                { const bf16_t* wa = WaT + (size_t)h * 65536 + (size_t)(32 * w + r) * 256 + 8 * hh;
                  const bf16_t* wi = WiT + (size_t)h * 65536 + (size_t)(32 * w + r) * 256 + 8 * hh;
#pragma unroll
                  for (int s = 0; s < 16; ++s) { ba[s] = *(const bf16x8*)(wa + 16 * s); bi[s] = *(const bf16x8*)(wi + 16 * s); } }
                __syncthreads();
                f32x16 aa[2], ai[2];
#pragma unroll
                for (int mb = 0; mb < 2; ++mb)
#pragma unroll
                    for (int q = 0; q < 16; ++q) { aa[mb][q] = 0.f; ai[mb][q] = 0.f; }
#pragma unroll
                for (int s = 0; s < 16; ++s) {
#pragma unroll
                    for (int mb = 0; mb < 2; ++mb) { const bf16x8 af = *(const LAS bf16x8*)(XC + (32 * mb + r) * 264 + 16 * s + 8 * hh);
                        aa[mb] = __builtin_amdgcn_mfma_f32_32x32x16_bf16(af, ba[s], aa[mb], 0, 0, 0); } }
                __builtin_amdgcn_sched_barrier(0);
#pragma unroll
                for (int s = 0; s < 16; ++s) {
#pragma unroll
                    for (int mb = 0; mb < 2; ++mb) { const bf16x8 af = *(const LAS bf16x8*)(XC + (32 * mb + r) * 264 + 16 * s + 8 * hh);
                        ai[mb] = __builtin_amdgcn_mfma_f32_32x32x16_bf16(af, bi[s], ai[mb], 0, 0, 0); } }
                const int ch = h * 256 + 32 * w + r;
                const float ba_ = p.in[I_BA][ch], bi_ = p.in[I_BI][ch]; const float L = p.in[I_AP][ch];
                const float sp = fmaxf(-L, 0.f) + log1pf(__expf(-fabsf(L)));
                const unsigned off0 = (unsigned)((tok0 + 4 * hh) * 1024 + ch);
#pragma unroll
                for (int mb = 0; mb < 2; ++mb)
#pragma unroll
                    for (int q4 = 0; q4 < 4; ++q4) {
                        unsigned o = off0 + (unsigned)((32 * mb + 8 * q4) * 1024); asm volatile("" : "+v"(o));
#pragma unroll
                        for (int i = 0; i < 4; ++i) { const int q = 4 * q4 + i; const int t = 32 * mb + 8 * q4 + i + 4 * hh;
                            const float ga = sigmoidf_(aa[mb][q] + ba_), gi = sigmoidf_(ai[mb][q] + bi_);
                            const float la = -8.0f * ga * sp; const float a = __expf(la);
                            const float xcv = bf2f(XC[t * 264 + 32 * w + r]);
                            const float u = xcv * gi * sqrtf(fmaxf(1.0f - a * a, 0.f));
                            AUA[(size_t)o + i * 1024] = a; AUU[(size_t)o + i * 1024] = u; } }
            }
#endif
            __syncthreads();
        }
    }
}

__device__ __forceinline__ void p2b(Frame& F, const Params& p) {
    const float* AN = (const float*)(F.ws + WS_AN); const float* DN = (const float*)(F.ws + WS_DN); bf16_t* SP = (bf16_t*)(F.ws + WS_SP);
    for (int st = (int)blockIdx.x * 512 + F.tid; st < 131072; st += F.G * 512) {
        const int bh = st >> 14, rem = st & 16383, half = rem & 1, ln = (rem >> 1) & 63, g = (rem >> 7) & 3, w = (rem >> 9) & 7, mb = (rem >> 12) & 3;
        const int kk0 = 32 * mb + 2 * half + 8 * g + 4 * (ln >> 5);
        const int offA = (((mb * 8 + w) * 4 + g) * 64 + ln) * 4 + 2 * half;
        const int offS = (((mb * 8 + w) * 2 + (g >> 1)) * 64 + ln) * 8 + (g & 1) * 4 + 2 * half;
        float S0 = 0.f, S1 = 0.f;
#pragma unroll 16
        for (int n = 0; n < 128; ++n) { const size_t uh = (size_t)bh * 128 + n;
            *(unsigned*)(SP + uh * 32768 + offS) = pk2(S0, S1);
            const f32x2 a = *(const f32x2*)(AN + uh * 32768 + offA); const f32x2 d = *(const f32x2*)(DN + uh * 128 + kk0);
            S0 = d.x * S0 + a.x; S1 = d.y * S1 + a.y; }
    }
    const float* AUA = (const float*)(F.ws + WS_AUA); const float* AUU = (const float*)(F.ws + WS_AUU);
    float* SUMA = (float*)(F.ws + WS_SUMA); float* SUMH = (float*)(F.ws + WS_SUMH);
    for (int c = blockIdx.x; c < NCHUNK; c += F.G) { const int ch = 2 * F.tid;
        f32x2 A = (f32x2){1.f, 1.f}, Hh = (f32x2){0.f, 0.f};
#pragma unroll 16
        for (int t = 0; t < 64; ++t) { const f32x2 a = *(const f32x2*)(AUA + (size_t)(c * 64 + t) * 1024 + ch), u = *(const f32x2*)(AUU + (size_t)(c * 64 + t) * 1024 + ch);
            Hh = a * Hh + u; A = A * a; }
        *(f32x2*)(SUMA + c * 1024 + ch) = A; *(f32x2*)(SUMH + c * 1024 + ch) = Hh; }
}

__device__ __forceinline__ void p2c(Frame& F, const Params& p) {
    const bf16_t* Z = (const bf16_t*)(F.ws + WS_Z); const float* LG = (const float*)(F.ws + WS_LG); const bf16_t* SP = (const bf16_t*)(F.ws + WS_SP);
    bf16_t* MIX = (bf16_t*)(F.ws + WS_MIX);
    LAS float* BC = (LAS float*)(F.lds); LAS float* SEG = (LAS float*)(F.lds + 32768);
    LAS bf16_t* QE = (LAS bf16_t*)(F.lds + 34816); LAS bf16_t* KE = (LAS bf16_t*)(F.lds + 52224); LAS bf16_t* VT = (LAS bf16_t*)(F.lds + 69632);
    LAS float* SSQ = (LAS float*)(F.lds + 106496); LAS float* OS = (LAS float*)(F.lds);
    const int tid = F.tid, lane = F.lane, w = F.wave, r = lane & 31, hh = lane >> 5;
    const float* gng = p.in[I_GNG];
    for (int unit = blockIdx.x; unit < NCHUNK; unit += F.G) {
        const int b = unit >> 7, n = unit & 127, tok0 = b * SEQL + 64 * n;
        { const float* AUA = (const float*)(F.ws + WS_AUA); const float* AUU = (const float*)(F.ws + WS_AUU);
          const float* SUMA = (const float*)(F.ws + WS_SUMA); const float* SUMH = (const float*)(F.ws + WS_SUMH);
          const int ch = 2 * tid; f32x2 hc = (f32x2){0.f, 0.f};
          int c2 = unit & ~127;
          for (; c2 + 16 <= unit; c2 += 16) { f32x2 a[16], hv[16];
#pragma unroll
              for (int q = 0; q < 16; ++q) { a[q] = *(const f32x2*)(SUMA + (c2 + q) * 1024 + ch); hv[q] = *(const f32x2*)(SUMH + (c2 + q) * 1024 + ch); }
#pragma unroll
              for (int q = 0; q < 16; ++q) hc = a[q] * hc + hv[q]; }
          { f32x2 a[16], hv[16];
#pragma unroll
              for (int q = 0; q < 16; ++q) { const bool ok = (c2 + q) < unit; a[q] = ok ? *(const f32x2*)(SUMA + (c2 + q) * 1024 + ch) : (f32x2){1.f, 1.f}; hv[q] = ok ? *(const f32x2*)(SUMH + (c2 + q) * 1024 + ch) : (f32x2){0.f, 0.f}; }
#pragma unroll
              for (int q = 0; q < 16; ++q) hc = a[q] * hc + hv[q]; }
#pragma unroll 16
          for (int t = 0; t < 64; ++t) { const size_t tok = (size_t)tok0 + t;
              const f32x2 a = *(const f32x2*)(AUA + tok * 1024 + ch), u = *(const f32x2*)(AUU + tok * 1024 + ch);
              hc = a * hc + u;
              const unsigned lgw = *(const unsigned*)(Z + tok * ZC + ZLG + ch);
              *(unsigned*)(MIX + tok * DM + 1024 + ch) = pk2(hc.x * gelu_tanh_f(bflo(lgw)), hc.y * gelu_tanh_f(bfhi(lgw))); } }
        for (int h = 0; h < 4; ++h) {
            const int uh = (b * 4 + h) * 128 + n;
            bf16x8 sf[4][2];
            { const bf16_t* spu = SP + (size_t)uh * 32768;
#pragma unroll
              for (int mb = 0; mb < 4; ++mb)
#pragma unroll
                  for (int s2 = 0; s2 < 2; ++s2) sf[mb][s2] = *(const bf16x8*)(spu + (((mb * 8 + w) * 2 + s2) * 64 + lane) * 8); }
            gla_cumsum(LG, tok0, h, BC, SEG, tid);
#pragma unroll
            for (int it = 0; it < 2; ++it) { const int item = tid + 512 * it, kk8 = item & 15, t = item >> 4;
                const u32x4 qv = *(const u32x4*)(Z + (size_t)(tok0 + t) * ZC + ZQ + h * 128 + kk8 * 8);
                const u32x4 kv = *(const u32x4*)(Z + (size_t)(tok0 + t) * ZC + ZK + h * 128 + kk8 * 8);
                const f32x4 b0 = *(const LAS f32x4*)(BC + t * 128 + kk8 * 8), b1 = *(const LAS f32x4*)(BC + t * 128 + kk8 * 8 + 4);
                float qe[8], ke[8];
#pragma unroll
                for (int i = 0; i < 8; ++i) { const float bb = (i < 4) ? b0[i & 3] : b1[i & 3]; const unsigned qw = qv[i >> 1], kw = kv[i >> 1];
                    const float qf = (i & 1) ? bfhi(qw) : bflo(qw), kf = (i & 1) ? bfhi(kw) : bflo(kw);
                    qe[i] = qf * 0.08838834764831845f * __expf(bb); ke[i] = kf * __expf(-bb); }
                u32x4 oq, ok; oq.x = pk2(qe[0], qe[1]); oq.y = pk2(qe[2], qe[3]); oq.z = pk2(qe[4], qe[5]); oq.w = pk2(qe[6], qe[7]);
                ok.x = pk2(ke[0], ke[1]); ok.y = pk2(ke[2], ke[3]); ok.z = pk2(ke[4], ke[5]); ok.w = pk2(ke[6], ke[7]);
                *(LAS u32x4*)(QE + t * 136 + kk8 * 8) = oq; *(LAS u32x4*)(KE + t * 136 + kk8 * 8) = ok; }
#pragma unroll
            for (int it = 0; it < 4; ++it) { const int item = tid + 512 * it, t = item & 63, vc8 = item >> 6;
                const u32x4 vv = *(const u32x4*)(Z + (size_t)(tok0 + t) * ZC + ZV + h * 256 + vc8 * 8);
#pragma unroll
                for (int i = 0; i < 8; ++i) { const unsigned wv = vv[i >> 1]; VT[(vc8 * 8 + i) * 72 + t] = (bf16_t)((i & 1) ? (wv >> 16) : (wv & 0xffffu)); } }
            __syncthreads();
            f32x16 oacc[2];
            {
                f32x16 P00, P01, P11;
#pragma unroll
                for (int q = 0; q < 16; ++q) { P00[q] = 0.f; P01[q] = 0.f; P11[q] = 0.f; oacc[0][q] = 0.f; oacc[1][q] = 0.f; }
#pragma unroll
                for (int s = 0; s < 8; ++s) {
                    const bf16x8 a0 = *(const LAS bf16x8*)(KE + r * 136 + 16 * s + 8 * hh), a1 = *(const LAS bf16x8*)(KE + (32 + r) * 136 + 16 * s + 8 * hh);
                    const bf16x8 b0 = *(const LAS bf16x8*)(QE + r * 136 + 16 * s + 8 * hh), b1 = *(const LAS bf16x8*)(QE + (32 + r) * 136 + 16 * s + 8 * hh);
                    P00 = __builtin_amdgcn_mfma_f32_32x32x16_bf16(a0, b0, P00, 0, 0, 0);
                    P01 = __builtin_amdgcn_mfma_f32_32x32x16_bf16(a0, b1, P01, 0, 0, 0);
                    P11 = __builtin_amdgcn_mfma_f32_32x32x16_bf16(a1, b1, P11, 0, 0, 0); }
#pragma unroll
                for (int q = 0; q < 16; ++q) { const int jl = (q & 3) + 8 * (q >> 2) + 4 * hh; if (jl > r) { P00[q] = 0.f; P11[q] = 0.f; } }
                bf16x8 F00[2], F01[2], F11[2];
#pragma unroll
                for (int s2 = 0; s2 < 2; ++s2) {
                    u32x4 t0, t1, t2;
#pragma unroll
                    for (int q = 0; q < 4; ++q) { t0[q] = pk2(P00[8 * s2 + 2 * q], P00[8 * s2 + 2 * q + 1]); t1[q] = pk2(P01[8 * s2 + 2 * q], P01[8 * s2 + 2 * q + 1]); t2[q] = pk2(P11[8 * s2 + 2 * q], P11[8 * s2 + 2 * q + 1]); }
                    F00[s2] = as_bf16x8(t0); F01[s2] = as_bf16x8(t1); F11[s2] = as_bf16x8(t2); }
#pragma unroll
                for (int mb = 0; mb < 4; ++mb)
#pragma unroll
                    for (int s2 = 0; s2 < 2; ++s2) { const bf16x8 af = sf[mb][s2];
                        const int kkb = 32 * mb + 16 * s2 + 4 * hh;
#pragma unroll
                        for (int ib = 0; ib < 2; ++ib) { const bf16x4 lo = *(const LAS bf16x4*)(QE + (32 * ib + r) * 136 + kkb), hi = *(const LAS bf16x4*)(QE + (32 * ib + r) * 136 + kkb + 8);
                            oacc[ib] = __builtin_amdgcn_mfma_f32_32x32x16_bf16(af, cat4(lo, hi), oacc[ib], 0, 0, 0); } }
#pragma unroll
                for (int s2 = 0; s2 < 2; ++s2) {
                    const int tb0 = 16 * s2 + 4 * hh, tb1 = 32 + 16 * s2 + 4 * hh;
                    const bf16x8 v0 = cat4(*(const LAS bf16x4*)(VT + (32 * w + r) * 72 + tb0), *(const LAS bf16x4*)(VT + (32 * w + r) * 72 + tb0 + 8));
                    const bf16x8 v1 = cat4(*(const LAS bf16x4*)(VT + (32 * w + r) * 72 + tb1), *(const LAS bf16x4*)(VT + (32 * w + r) * 72 + tb1 + 8));
                    oacc[0] = __builtin_amdgcn_mfma_f32_32x32x16_bf16(v0, F00[s2], oacc[0], 0, 0, 0);
                    oacc[1] = __builtin_amdgcn_mfma_f32_32x32x16_bf16(v0, F01[s2], oacc[1], 0, 0, 0);
                    oacc[1] = __builtin_amdgcn_mfma_f32_32x32x16_bf16(v1, F11[s2], oacc[1], 0, 0, 0); }
            }
#pragma unroll
            for (int ib = 0; ib < 2; ++ib) { float sq = 0.f;
#pragma unroll
                for (int q = 0; q < 16; ++q) sq += oacc[ib][q] * oacc[ib][q];
                sq += __shfl_xor(sq, 32);
                if (hh == 0) SSQ[w * 64 + 32 * ib + r] = sq; }
            __syncthreads();
#pragma unroll
            for (int ib = 0; ib < 2; ++ib) { float tot = 0.f;
#pragma unroll
                for (int w2 = 0; w2 < 8; ++w2) tot += SSQ[w2 * 64 + 32 * ib + r];
                const float rs = 1.0f / sqrtf(tot * (1.0f / 256.0f) + 1e-6f);
#pragma unroll
                for (int g = 0; g < 4; ++g) *(LAS f32x4*)(OS + (32 * ib + r) * 260 + 32 * w + 8 * g + 4 * hh) =
                    (f32x4){oacc[ib][4 * g] * rs, oacc[ib][4 * g + 1] * rs, oacc[ib][4 * g + 2] * rs, oacc[ib][4 * g + 3] * rs}; }
            __syncthreads();
#pragma unroll
            for (int it = 0; it < 4; ++it) { const int item = tid + 512 * it, vc8 = item & 31, t = item >> 5; const int c = h * 256 + vc8 * 8;
                const f32x4 o0 = *(const LAS f32x4*)(OS + t * 260 + vc8 * 8), o1 = *(const LAS f32x4*)(OS + t * 260 + vc8 * 8 + 4);
                const u32x4 rv = *(const u32x4*)(Z + (size_t)(tok0 + t) * ZC + ZR + c);
                const f32x4 g0 = *(const f32x4*)(gng + c), g1 = *(const f32x4*)(gng + c + 4);
                float o[8];
#pragma unroll
                for (int i = 0; i < 8; ++i) { const unsigned rw = rv[i >> 1]; const float rf = (i & 1) ? bfhi(rw) : bflo(rw);
                    const float sil = rf * sigmoidf_(rf); o[i] = sil * ((i < 4) ? o0[i & 3] * g0[i & 3] : o1[i & 3] * g1[i & 3]); }
                u32x4 ov; ov.x = pk2(o[0], o[1]); ov.y = pk2(o[2], o[3]); ov.z = pk2(o[4], o[5]); ov.w = pk2(o[6], o[7]);
                *(u32x4*)(MIX + (size_t)(tok0 + t) * DM + c) = ov; }
            __syncthreads();
        }
    }
}

__device__ __forceinline__ void build_moe_tables(Frame& F) {
    unsigned* cnt = (unsigned*)(F.ws + WS_CTL) + CW_CNT;
    if (F.tid < 32) F.MISC[MI_LCNT + F.tid] = xb_ld(cnt + 64 * F.tid);
    __syncthreads();
    if (F.tid == 0) { int tiles = 0;
        for (int e = 0; e < NEXP; ++e) { const int c = (int)F.MISC[MI_LCNT + e]; const int mt = (c + 255) >> 8; F.MISC[MI_PBASE + e] = (unsigned)(tiles * 256);
            for (int q = 0; q < mt; ++q) F.MISC[MI_T2E + tiles + q] = (unsigned)e; tiles += mt; }
        F.MISC[MI_NMT] = (unsigned)tiles; }
    __syncthreads();
    if (F.tid < 32) F.MISC[MI_LCNT + F.tid] = 0u;
    __syncthreads();
}

__device__ __forceinline__ void p4a(Frame& F, const Params& p) {
    const float* XMID = (const float*)(F.ws + WS_XMID); const float* WrT = (const float*)(F.ws + WS_WRT); const float* br = p.in[I_BR];
    float* RSTD = (float*)(F.ws + WS_RSTD); unsigned* TOKE = (unsigned*)(F.ws + WS_TOKE); float* GATES = (float*)(F.ws + WS_GATES);
    unsigned* cnt = (unsigned*)(F.ws + WS_CTL) + CW_CNT;
    LAS float* RED = (LAS float*)(F.lds); LAS float* SSQ2 = (LAS float*)(F.lds + 32768); LAS float* LGT = (LAS float*)(F.lds + 33792); LAS float* RS = (LAS float*)(F.lds + 38016);
    const int tid = F.tid, lane = F.lane, w = F.wave, m = lane & 31, kh = lane >> 5;
    if (tid < 32) F.MISC[MI_LCNT + tid] = 0u;
    __syncthreads();
    for (int ut = blockIdx.x; ut < T / 32; ut += F.G) {
        const int m0 = 32 * ut; const int kw = 256 * w + 128 * kh;
        f32x16 acc;
#pragma unroll
        for (int q = 0; q < 16; ++q) acc[q] = 0.f;
        float ss = 0.f;
        const float* ap = XMID + (size_t)(m0 + m) * DM + kw; const float* bp = WrT + (size_t)m * DM + kw;
#pragma unroll 2
        for (int c = 0; c < 8; ++c) {
            f32x4 a[4], b[4];
#pragma unroll
            for (int q = 0; q < 4; ++q) { a[q] = *(const f32x4*)(ap + 16 * c + 4 * q); b[q] = *(const f32x4*)(bp + 16 * c + 4 * q); }
#pragma unroll
            for (int q = 0; q < 4; ++q)
#pragma unroll
                for (int i = 0; i < 4; ++i) { acc = __builtin_amdgcn_mfma_f32_32x32x2f32(a[q][i], b[q][i], acc, 0, 0, 0); ss += a[q][i] * a[q][i]; }
        }
        ss += __shfl_xor(ss, 32);
#pragma unroll
        for (int q = 0; q < 16; ++q) RED[(w * 16 + q) * 64 + lane] = acc[q];
        if (kh == 0) SSQ2[w * 32 + m] = ss;
        __syncthreads();
#pragma unroll
        for (int it = 0; it < 2; ++it) { const int o = tid + 512 * it, reg = o >> 6, ln = o & 63, nn = ln & 31, h2 = ln >> 5; const int mm = (reg & 3) + 8 * (reg >> 2) + 4 * h2;
            float v = 0.f, s2 = 0.f;
#pragma unroll
            for (int w2 = 0; w2 < 8; ++w2) { v += RED[(w2 * 16 + reg) * 64 + ln]; s2 += SSQ2[w2 * 32 + mm]; }
            const float rs = 1.0f / sqrtf(s2 * (1.0f / DM) + 1e-6f);
            LGT[mm * 33 + nn] = v * rs + br[nn]; if (nn == 0) RS[mm] = rs; }
        __syncthreads();
        int ex[4]; unsigned ls[4]; float gt[4];
        if (tid < 32) {
            float l[32];
#pragma unroll
            for (int i = 0; i < 32; ++i) l[i] = LGT[tid * 33 + i];
            float val[4];
#pragma unroll
            for (int k = 0; k < 4; ++k) { float best = -3.0e38f; int bi = 0;
#pragma unroll
                for (int i = 0; i < 32; ++i) if (l[i] > best) { best = l[i]; bi = i; }
                ex[k] = bi; val[k] = best;
#pragma unroll
                for (int i = 0; i < 32; ++i) if (i == bi) l[i] = -3.0e38f; }
            float s = 0.f;
#pragma unroll
            for (int k = 0; k < 4; ++k) { gt[k] = __expf(val[k] - val[0]); s += gt[k]; }
            const float inv = 1.0f / s;
#pragma unroll
            for (int k = 0; k < 4; ++k) { gt[k] *= inv; ls[k] = __hip_atomic_fetch_add((LAS unsigned*)(F.MISC + MI_LCNT + ex[k]), 1u, __ATOMIC_RELAXED, __HIP_MEMORY_SCOPE_WORKGROUP); }
        }
        __syncthreads();
        if (tid < 32) { const unsigned c = F.MISC[MI_LCNT + tid]; F.MISC[MI_LBASE + tid] = c ? xb_add(cnt + 64 * tid, c) : 0u; F.MISC[MI_LCNT + tid] = 0u; }
        __syncthreads();
        if (tid < 32) { const int tok = m0 + tid;
#pragma unroll
            for (int k = 0; k < 4; ++k) { const unsigned slot = F.MISC[MI_LBASE + ex[k]] + ls[k]; TOKE[tok * 4 + k] = (unsigned)ex[k] | (slot << 8); GATES[tok * 4 + k] = gt[k]; }
            RSTD[tok] = RS[tid]; }
        __syncthreads();
    }
}

__device__ __forceinline__ void p4b(Frame& F, const Params& p) {
    build_moe_tables(F);
    const float* XMID = (const float*)(F.ws + WS_XMID); const float* RSTD = (const float*)(F.ws + WS_RSTD); const unsigned* TOKE = (const unsigned*)(F.ws + WS_TOKE);
    const float* gf = p.in[I_NFG]; bf16_t* ABUF = (bf16_t*)(F.ws + WS_ABUF);
    const int l = F.lane;
    f32x4 xn[8]; float rsn = 0.f; unsigned ten[4] = {0u, 0u, 0u, 0u};
    if (F.gw < T) { rsn = RSTD[F.gw];
#pragma unroll
        for (int k = 0; k < 4; ++k) ten[k] = TOKE[F.gw * 4 + k];
#pragma unroll
        for (int j = 0; j < 8; ++j) xn[j] = *(const f32x4*)(XMID + (size_t)F.gw * DM + 4 * l + 256 * j); }
    f32x4 gv[8];
#pragma unroll
    for (int j = 0; j < 8; ++j) gv[j] = *(const f32x4*)(gf + 4 * l + 256 * j);
    for (int tok = F.gw; tok < T; tok += F.NGW) {
        const float rs = rsn; unsigned te[4]; u32x2 o[8];
#pragma unroll
        for (int k = 0; k < 4; ++k) te[k] = ten[k];
#pragma unroll
        for (int j = 0; j < 8; ++j) { const f32x4 xv = xn[j];
            o[j].x = pk2(xv[0] * rs * gv[j][0], xv[1] * rs * gv[j][1]); o[j].y = pk2(xv[2] * rs * gv[j][2], xv[3] * rs * gv[j][3]); }
        const int t2 = tok + F.NGW;
        if (t2 < T) { rsn = RSTD[t2];
#pragma unroll
            for (int k = 0; k < 4; ++k) ten[k] = TOKE[t2 * 4 + k];
#pragma unroll
            for (int j = 0; j < 8; ++j) xn[j] = *(const f32x4*)(XMID + (size_t)t2 * DM + 4 * l + 256 * j); }
#pragma unroll
        for (int k = 0; k < 4; ++k) { const size_t row = (size_t)F.MISC[MI_PBASE + (te[k] & 255u)] + (te[k] >> 8);
#pragma unroll
            for (int j = 0; j < 8; ++j) *(u32x2*)(ABUF + row * DM + 4 * l + 256 * j) = o[j]; }
    }
}

__device__ __forceinline__ void p7(Frame& F, const Params& p) {
    build_moe_tables(F);
    const float* XMID = (const float*)(F.ws + WS_XMID); const unsigned* TOKE = (const unsigned*)(F.ws + WS_TOKE); const float* GATES = (const float*)(F.ws + WS_GATES);
    const bf16_t* Y = (const bf16_t*)(F.ws + WS_Y); const float* gfin = p.in[I_NFINAL];
    const int l = F.lane;
    f32x4 xn[8]; unsigned ten[4] = {0u, 0u, 0u, 0u}; float gkn[4] = {0.f, 0.f, 0.f, 0.f};
    if (F.gw < T) {
#pragma unroll
        for (int k = 0; k < 4; ++k) { ten[k] = TOKE[F.gw * 4 + k]; gkn[k] = GATES[F.gw * 4 + k]; }
#pragma unroll
        for (int j = 0; j < 4; ++j) { xn[2 * j] = *(const f32x4*)(XMID + (size_t)F.gw * DM + 8 * l + 512 * j); xn[2 * j + 1] = *(const f32x4*)(XMID + (size_t)F.gw * DM + 8 * l + 512 * j + 4); } }
    for (int tok = F.gw; tok < T; tok += F.NGW) {
        f32x4 xv[8]; u32x4 yv[4][4]; float gk[4];
#pragma unroll
        for (int k = 0; k < 4; ++k) { const unsigned te = ten[k]; gk[k] = gkn[k]; const size_t row = (size_t)F.MISC[MI_PBASE + (te & 255u)] + (te >> 8);
#pragma unroll
            for (int j = 0; j < 4; ++j) yv[k][j] = *(const u32x4*)(Y + row * DM + 8 * l + 512 * j); }
#pragma unroll
        for (int j = 0; j < 8; ++j) xv[j] = xn[j];
        const int t2 = tok + F.NGW;
        if (t2 < T) {
#pragma unroll
            for (int k = 0; k < 4; ++k) { ten[k] = TOKE[t2 * 4 + k]; gkn[k] = GATES[t2 * 4 + k]; }
#pragma unroll
            for (int j = 0; j < 4; ++j) { xn[2 * j] = *(const f32x4*)(XMID + (size_t)t2 * DM + 8 * l + 512 * j); xn[2 * j + 1] = *(const f32x4*)(XMID + (size_t)t2 * DM + 8 * l + 512 * j + 4); } }
#pragma unroll
        for (int k = 0; k < 4; ++k)
#pragma unroll
            for (int j = 0; j < 4; ++j) { const u32x4 y4 = yv[k][j];
                xv[2 * j][0] += gk[k] * bflo(y4.x); xv[2 * j][1] += gk[k] * bfhi(y4.x); xv[2 * j][2] += gk[k] * bflo(y4.y); xv[2 * j][3] += gk[k] * bfhi(y4.y);
                xv[2 * j + 1][0] += gk[k] * bflo(y4.z); xv[2 * j + 1][1] += gk[k] * bfhi(y4.z); xv[2 * j + 1][2] += gk[k] * bflo(y4.w); xv[2 * j + 1][3] += gk[k] * bfhi(y4.w); }
        float ss = 0.f;
#pragma unroll
        for (int j = 0; j < 8; ++j) ss += (xv[j][0] * xv[j][0] + xv[j][1] * xv[j][1]) + (xv[j][2] * xv[j][2] + xv[j][3] * xv[j][3]);
        const float rs = 1.0f / sqrtf(wave_sum(ss) * (1.0f / DM) + 1e-6f);
#pragma unroll
        for (int j = 0; j < 4; ++j) { const f32x4 g0 = *(const f32x4*)(gfin + 8 * l + 512 * j), g1 = *(const f32x4*)(gfin + 8 * l + 512 * j + 4);
            *(f32x4*)(p.out + (size_t)tok * DM + 8 * l + 512 * j) = xv[2 * j] * rs * g0; *(f32x4*)(p.out + (size_t)tok * DM + 8 * l + 512 * j + 4) = xv[2 * j + 1] * rs * g1; }
    }
}


#ifdef PROBE_STREAM
__device__ __forceinline__ void probe_stream(Frame& F, const Params& p) {
    const f32x4* src = (const f32x4*)p.in[I_WGU]; const size_t n4 = (size_t)32 * 2048 * 4096 / 4;
    const f32x4* src2 = (const f32x4*)p.in[I_WDN]; const size_t m4 = (size_t)32 * 2048 * 2048 / 4;
    f32x4 acc = (f32x4){0.f, 0.f, 0.f, 0.f};
    for (size_t base = (size_t)F.gw * 1024; base < n4; base += (size_t)F.NGW * 1024) {
        f32x4 v[16];
#pragma unroll
        for (int i = 0; i < 16; ++i) v[i] = src[base + i * 64 + F.lane];
#pragma unroll
        for (int i = 0; i < 16; ++i) acc += v[i]; }
    for (size_t base = (size_t)F.gw * 1024; base < m4; base += (size_t)F.NGW * 1024) {
        f32x4 v[16];
#pragma unroll
        for (int i = 0; i < 16; ++i) v[i] = src2[base + i * 64 + F.lane];
#pragma unroll
        for (int i = 0; i < 16; ++i) acc += v[i]; }
    if (acc[0] + acc[1] + acc[2] + acc[3] == 12345.678f) p.out[0] = 1.0f;
}
#endif
constexpr int NPHASE = 11;
__global__ void __launch_bounds__(512, 2) mk_fwd(Params p) {
    extern __shared__ __attribute__((aligned(16))) unsigned char lds_raw[];
    Frame F;
    F.lds = (LAS unsigned char*)lds_raw; F.MISC = (volatile LAS unsigned*)(F.lds + MISC_OFF);
    F.tid = threadIdx.x; F.lane = F.tid & 63; F.wave = __builtin_amdgcn_readfirstlane(F.tid >> 6);
    F.G = gridDim.x; F.gw = (int)blockIdx.x * 8 + F.wave; F.NGW = F.G * 8; F.ws = p.ws;
    for (int u = F.tid; u < (LDS_BYTES - MISC_OFF) / 4; u += 512) F.MISC[u] = 0u;
    __syncthreads();
    const int lo = p.ph_lo, hi = p.ph_hi;
    XcdBarrier bar; bar.bar = (unsigned*)(F.ws + WS_CTL) + CW_BAR; bar.x = 0; bar.st = F.MISC;
    if (hi - lo > 1) bar = xcd_barrier_post((unsigned*)(F.ws + WS_CTL) + CW_BAR, F.MISC);
#ifndef PHASE_MASK
#define PHASE_MASK 0x7ff
#endif
#define IN(k) (((PHASE_MASK >> (k)) & 1) && lo <= (k) && (k) < hi)
#define SEAM(k) do { if (IN(k) && IN((k) + 1)) xcd_barrier(bar); } while (0)
#ifndef REPEAT_MASK
#define REPEAT_MASK 0
#endif
#define REP(k) for (int rep_ = 0; rep_ < (((REPEAT_MASK >> (k)) & 1) ? 2 : 1); ++rep_)
    LAS unsigned char* ring = F.lds;
#ifdef PROBE_STREAM
    if (IN(0)) { probe_stream(F, p); }
#endif
    if (IN(0)) { REP(11) { p0a(F, p); } REP(12) { p0b(F, p); } SEAM(0); }
    if (IN(1)) REP(1) {
        pg8::Gemm g{(const bf16_t*)(F.ws + WS_H), (const bf16_t*)(F.ws + WS_WINT), DM, DM, DM, 0}; pg8::StaticOrder S; S.init(T, ZC, F.G, (int)blockIdx.x);
        pg8::EpiBf16 E{(bf16_t*)(F.ws + WS_Z), ZC, nullptr, 0};
        pg8::gemm_phase<pg8::EpiBf16, pg8::StaticOrder, true>(ring, g, S, E); SEAM(1); }
    if (IN(2)) REP(2) { p2a(F, p); SEAM(2); }
    if (IN(3)) REP(3) { p2b(F, p); SEAM(3); }
    if (IN(4)) REP(4) { p2c(F, p); SEAM(4); }
    if (IN(5)) REP(5) {
        pg8::Gemm g{(const bf16_t*)(F.ws + WS_MIX), (const bf16_t*)(F.ws + WS_WOUTT), DM, DM, DM, 0}; pg8::StaticOrder S; S.init(T, DM, F.G, (int)blockIdx.x);
        pg8::EpiF32Res E{(float*)(F.ws + WS_XMID), p.in[I_X], DM};
        pg8::gemm_phase<pg8::EpiF32Res, pg8::StaticOrder, true>(ring, g, S, E); SEAM(5); }
    if (IN(6)) { p4a(F, p); SEAM(6); }
    if (IN(7)) REP(7) { p4b(F, p); SEAM(7); }
    if (IN(8)) REP(8) {
        build_moe_tables(F);
        pg8::Gemm g{(const bf16_t*)(F.ws + WS_ABUF), (const bf16_t*)(F.ws + WS_WGUT), DM, DM, DM, (size_t)4096 * DM};
        pg8::MoeOrder S{(int)F.MISC[MI_NMT], 16, F.G, (int)blockIdx.x, (const LAS int*)(F.lds + MISC_OFF + 4 * MI_T2E)};
        pg8::EpiSwiGLU E{(bf16_t*)(F.ws + WS_ACT), DM, p.in[I_BGU]};
        pg8::gemm_phase<pg8::EpiSwiGLU, pg8::MoeOrder, true>(ring, g, S, E); SEAM(8); }
    if (IN(9)) REP(9) {
        build_moe_tables(F);
        pg8::Gemm g{(const bf16_t*)(F.ws + WS_ACT), (const bf16_t*)(F.ws + WS_WDT), DM, DM, DM, (size_t)DM * DM};
        pg8::MoeOrder S{(int)F.MISC[MI_NMT], 8, F.G, (int)blockIdx.x, (const LAS int*)(F.lds + MISC_OFF + 4 * MI_T2E)};
        pg8::EpiBf16 E{(bf16_t*)(F.ws + WS_Y), DM, p.in[I_BDN], DM};
        pg8::gemm_phase<pg8::EpiBf16, pg8::MoeOrder, true>(ring, g, S, E); SEAM(9); }
    if (IN(10)) REP(10) { p7(F, p); if (((REPEAT_MASK >> 10) & 1)) xcd_barrier(bar); }
#undef IN
#undef SEAM
}
#ifndef STAGE
#define STAGE 4
#endif
#ifndef PER_PHASE_LAUNCH
#define PER_PHASE_LAUNCH 0
#endif

#if STAGE < 4
__global__ void adapt_z_kernel(const bf16_t* Z, float* z) {
    const long idx = (long)blockIdx.x * blockDim.x + threadIdx.x; const long t = idx / ZC; const int c = (int)(idx % ZC);
    z[t * INC + (c < 3072 ? c : c + 16)] = bf2f(Z[idx]);
}
__global__ void adapt_bf16_kernel(const bf16_t* src, float* dst) { const long idx = (long)blockIdx.x * blockDim.x + threadIdx.x; dst[idx] = bf2f(src[idx]); }
#endif

static void launch_mk(Params& a, int lo, int hi, int grid, hipStream_t stream) {
#if PER_PHASE_LAUNCH
    for (int k = lo; k < hi; ++k) { a.ph_lo = k; a.ph_hi = k + 1; hipLaunchKernelGGL(mk_fwd, dim3(grid), dim3(512), LDS_BYTES, stream, a); }
#else
    a.ph_lo = lo; a.ph_hi = hi; hipLaunchKernelGGL(mk_fwd, dim3(grid), dim3(512), LDS_BYTES, stream, a);
#endif
}

extern "C" void kernel_launch(void* const* d_in, const int* in_sizes, int n_in, void* d_out, int out_size, void* d_ws, size_t ws_size, hipStream_t stream) {
    static int grid = 0;
    if (grid == 0) {
        int dev = 0, cus = 0;
        if (hipGetDevice(&dev) != hipSuccess || hipDeviceGetAttribute(&cus, hipDeviceAttributeMultiprocessorCount, dev) != hipSuccess) { grid = -1; return; }
        if (hipFuncSetAttribute((const void*)mk_fwd, hipFuncAttributeMaxDynamicSharedMemorySize, LDS_BYTES) != hipSuccess) { grid = -1; return; }
        int per_cu = 0;
        (void)hipOccupancyMaxActiveBlocksPerMultiprocessor(&per_cu, (const void*)mk_fwd, 512, LDS_BYTES);
        (void)hipGetLastError();
        grid = cus;
        if (per_cu < 1) fprintf(stderr, "kernel_launch: occupancy query reports %d\n", per_cu);
    }
    if (grid < 0) return;
    (void)hipMemsetAsync((char*)d_ws + WS_CTL, 0, CTL_ZERO_BYTES, stream);
    Params a{};
    for (int i = 0; i < 22; ++i) a.in[i] = (const float*)d_in[i];
    a.out = (float*)d_out; a.ws = (unsigned char*)d_ws;
#if STAGE >= 4
    launch_mk(a, 0, NPHASE, grid, stream);
#else
    const float* x = a.in[I_X];
    char* ws = (char*)d_ws + WS_ABUF; size_t off = 0;
    auto alloc = [&](size_t bytes) { void* p = ws + off; off += (bytes + 255) & ~(size_t)255; return p; };
    int* counts = (int*)alloc(256);
    float* z = (float*)alloc((size_t)T * INC * 4);
    float* ogla = (float*)alloc((size_t)T * 1024 * 4);
    float* xc = (float*)alloc((size_t)T * 1024 * 4);
    float* za = (float*)alloc((size_t)T * 1024 * 4);
    float* zi = (float*)alloc((size_t)T * 1024 * 4);
    float* mix = (float*)alloc((size_t)T * DM * 4);
    float* xmid = (float*)alloc((size_t)T * DM * 4);
    float* hf = (float*)alloc((size_t)T * DM * 4);
    float* logits = (float*)alloc((size_t)T * 32 * 4);
    float* gates = (float*)alloc((size_t)T * 4 * 4);
    int* list = (int*)alloc((size_t)NEXP * T * 4);
    float* act = (float*)alloc((size_t)T * 4 * DM * 4);
    float* y = (float*)alloc((size_t)T * 4 * DM * 4);
    (void)hipMemsetAsync(counts, 0, 256, stream);
#if STAGE == 1
    launch_mk(a, 0, 2, grid, stream);
    adapt_z_kernel<<<(unsigned)((size_t)T * ZC / 256), 256, 0, stream>>>((const bf16_t*)((char*)d_ws + WS_Z), z);
    gla_naive_kernel<<<64, 256, 0, stream>>>(z, (const float*)((char*)d_ws + WS_LG), ogla);
    gla_out_kernel<<<T, 256, 0, stream>>>(ogla, z, a.in[I_GNG], mix);
    lru_conv_kernel<<<T * 1024 / 256, 256, 0, stream>>>(z, a.in[I_CW], a.in[I_CB], xc);
    for (int h = 0; h < 4; ++h) {
        GemmArgs g{}; g.A = xc + h * 256; g.lda = 1024; g.ldb = 256; g.ldc = 1024; g.M = T; g.N = 256; g.K = 256; g.a_div = 1;
        g.B = a.in[I_WA] + (size_t)h * 65536; g.C = za + h * 256;
        sgemm_kernel<0><<<dim3(2, T / 128, 1), 256, 0, stream>>>(g);
        g.B = a.in[I_WI] + (size_t)h * 65536; g.C = zi + h * 256;
        sgemm_kernel<0><<<dim3(2, T / 128, 1), 256, 0, stream>>>(g);
    }
    lru_gate_kernel<<<T * 1024 / 256, 256, 0, stream>>>(xc, za, zi, a.in[I_BA], a.in[I_BI], a.in[I_AP]);
    lru_scan_kernel<<<2048 / 64, 64, 0, stream>>>(za, zi, z, mix);
#endif
#if STAGE == 2
    launch_mk(a, 0, 5, grid, stream);
    adapt_bf16_kernel<<<(unsigned)((size_t)T * DM / 256), 256, 0, stream>>>((const bf16_t*)((char*)d_ws + WS_MIX), mix);
#endif
#if STAGE <= 2
    { GemmArgs g{}; g.A = mix; g.lda = DM; g.B = a.in[I_WOUT]; g.ldb = DM; g.C = xmid; g.ldc = DM; g.M = T; g.N = DM; g.K = DM; g.a_div = 1; g.resid = x; g.ldr = DM;
      sgemm_kernel<1><<<dim3(DM / 128, T / 128, 1), 256, 0, stream>>>(g); }
#else
    launch_mk(a, 0, 6, grid, stream);
    xmid = (float*)((char*)d_ws + WS_XMID);
#endif
    rmsnorm_kernel<<<T, 256, 0, stream>>>(xmid, a.in[I_NFG], hf);
    { GemmArgs g{}; g.A = hf; g.lda = DM; g.B = a.in[I_WR]; g.ldb = 32; g.C = logits; g.ldc = 32; g.M = T; g.N = 32; g.K = DM; g.a_div = 1; g.bias = a.in[I_BR];
      sgemm_kernel<0><<<dim3(1, T / 128, 1), 256, 0, stream>>>(g); }
    route_kernel<<<T / 256, 256, 0, stream>>>(logits, counts, list, gates);
    { GemmArgs g{}; g.A = hf; g.lda = DM; g.B = a.in[I_WGU]; g.ldb = 4096; g.C = act; g.ldc = DM; g.M = 0; g.N = 4096; g.K = DM; g.a_div = 4; g.bias = a.in[I_BGU];
      g.rowlist = list; g.count = counts; g.strideB_e = (long)DM * 4096; g.strideBias_e = 4096; g.list_stride = T;
      sgemm_kernel<2><<<dim3(2048 / 64, T / 128, NEXP), 256, 0, stream>>>(g); }
    { GemmArgs g{}; g.A = act; g.lda = DM; g.B = a.in[I_WDN]; g.ldb = DM; g.C = y; g.ldc = DM; g.M = 0; g.N = DM; g.K = DM; g.a_div = 1; g.bias = a.in[I_BDN];
      g.rowlist = list; g.count = counts; g.strideB_e = (long)DM * DM; g.strideBias_e = DM; g.list_stride = T;
      sgemm_kernel<0><<<dim3(DM / 128, T / 128, NEXP), 256, 0, stream>>>(g); }
    final_kernel<<<T, 256, 0, stream>>>(xmid, y, gates, a.in[I_NFINAL], (float*)d_out);
#endif
}
```

```cpp
#define STAGE 4
#define PER_PHASE_LAUNCH 0
#define REPEAT_MASK 0
#include <hip/hip_runtime.h>
#include <stdint.h>
#include <stdio.h>

#define GAS __attribute__((address_space(1)))
#define LAS __attribute__((address_space(3)))
typedef unsigned short bf16_t;
typedef short bf16x8 __attribute__((ext_vector_type(8)));
typedef short bf16x4 __attribute__((ext_vector_type(4)));
typedef float f32x4 __attribute__((ext_vector_type(4)));
typedef float f32x2 __attribute__((ext_vector_type(2)));
typedef float f32x16 __attribute__((ext_vector_type(16)));
typedef unsigned u32x4 __attribute__((ext_vector_type(4)));
typedef unsigned u32x2 __attribute__((ext_vector_type(2)));
typedef int i32x8 __attribute__((ext_vector_type(8)));
typedef int i32x4 __attribute__((ext_vector_type(4)));
typedef int i32x32 __attribute__((ext_vector_type(32)));

constexpr int T = 16384, SEQL = 8192, DM = 2048, INC = 5136, ZC = 5120, NEXP = 32;
constexpr int ZQ = 0, ZK = 512, ZV = 1024, ZR = 2048, ZLX = 3072, ZLG = 4096;
constexpr int MPAD_MAX = 65536 + NEXP * 256;
constexpr int NCHUNK = 256;

constexpr size_t MiB = 1u << 20;
constexpr size_t WS_CTL = 0, CTL_ZERO_BYTES = 1 * MiB;
constexpr size_t WS_WINT = 1 * MiB;
constexpr size_t WS_WOUTT = WS_WINT + 20 * MiB;
constexpr size_t WS_WGUT = WS_WOUTT + 8 * MiB;
constexpr size_t WS_WDT = WS_WGUT + 512 * MiB;
constexpr size_t WS_WAT = WS_WDT + 256 * MiB;
constexpr size_t WS_WIT = WS_WAT + 512 * 1024;
constexpr size_t WS_WRT = WS_WIT + 512 * 1024;
constexpr size_t WS_H = WS_WRT + 1 * MiB;
constexpr size_t WS_LG = WS_H + 64 * MiB;
constexpr size_t WS_Z = WS_LG + 32 * MiB;
constexpr size_t WS_AN = WS_Z + 160 * MiB;
constexpr size_t WS_DN = WS_AN + 128 * MiB;
constexpr size_t WS_SP = WS_DN + 1 * MiB;
constexpr size_t WS_AUA = WS_SP + 64 * MiB;
constexpr size_t WS_AUU = WS_AUA + 64 * MiB;
constexpr size_t WS_SUMA = WS_AUU + 64 * MiB;
constexpr size_t WS_SUMH = WS_SUMA + 1 * MiB;
constexpr size_t WS_MIX = WS_SUMH + 1 * MiB;
constexpr size_t WS_XMID = WS_MIX + 64 * MiB;
constexpr size_t WS_RSTD = WS_XMID + 128 * MiB;
constexpr size_t WS_TOKE = WS_RSTD + 1 * MiB;
constexpr size_t WS_GATES = WS_TOKE + 1 * MiB;
constexpr size_t WS_ABUF = WS_GATES + 1 * MiB;
constexpr size_t WS_ACT = WS_ABUF + 288 * MiB;
constexpr size_t WS_Y = WS_ACT + 288 * MiB;
constexpr size_t WS_END = WS_Y + 288 * MiB;
constexpr int CW_BAR = 4096;
constexpr int CW_CNT = 16384;

constexpr int RING_BYTES = 131072;
constexpr int SCR_BYTES = 135168;
constexpr int MISC_OFF = SCR_BYTES;
constexpr int LDS_BYTES = 147456;
constexpr int MI_PBASE = 16, MI_NMT = 48, MI_LCNT = 64, MI_LBASE = 96, MI_T2E = 128;

#define LDS_WAIT() asm volatile("s_waitcnt lgkmcnt(0)" ::: "memory")
#define VM_WAIT() asm volatile("s_waitcnt vmcnt(0)" ::: "memory")

__device__ __forceinline__ unsigned f2bf(float f) { unsigned u = __builtin_bit_cast(unsigned, f); return (u + 0x7fffu + ((u >> 16) & 1u)) >> 16; }
__device__ __forceinline__ unsigned pk2(float lo, float hi) { return f2bf(lo) | (f2bf(hi) << 16); }
__device__ __forceinline__ float bf2f(unsigned short b) { return __builtin_bit_cast(float, (unsigned)b << 16); }
__device__ __forceinline__ float bflo(unsigned w) { return __builtin_bit_cast(float, w << 16); }
__device__ __forceinline__ float bfhi(unsigned w) { return __builtin_bit_cast(float, w & 0xffff0000u); }
__device__ __forceinline__ float clamp448(float x) { return __builtin_amdgcn_fmed3f(x, -448.0f, 448.0f); }
__device__ __forceinline__ unsigned pk4_fp8(float a, float b, float c, float d) {
    int p = 0; p = __builtin_amdgcn_cvt_pk_fp8_f32(clamp448(a), clamp448(b), p, false); p = __builtin_amdgcn_cvt_pk_fp8_f32(clamp448(c), clamp448(d), p, true); return (unsigned)p; }
__device__ __forceinline__ float wave_sum(float v) {
#pragma unroll
    for (int o = 1; o < 64; o <<= 1) v += __shfl_xor(v, o);
    return v;
}
__device__ __forceinline__ int fresh_lane() { int l; asm volatile("v_mbcnt_lo_u32_b32 %0, -1, 0\n\tv_mbcnt_hi_u32_b32 %0, -1, %0" : "=v"(l)); return l; }
__device__ __forceinline__ float sigmoidf_(float x) { return 1.0f / (1.0f + __expf(-x)); }

#define XB_TMO      128
#define XB_XCNT(j)  (256  + 64 * (j))
#define XB_XSUB(j)  (1280 + 64 * (j))
#define XB_XGEN(j)  (2304 + 64 * (j))
#define XB_TOP      3328
#define XB_TOPGEN   3392
#define XCD_BAR_WORDS 3456
#define XB_SPIN_CAP (1u << 18)

__device__ __forceinline__ unsigned xb_ld(unsigned* p)              { return __hip_atomic_load(p, __ATOMIC_RELAXED, __HIP_MEMORY_SCOPE_AGENT); }
__device__ __forceinline__ unsigned xb_add(unsigned* p, unsigned v) { return __hip_atomic_fetch_add(p, v, __ATOMIC_RELAXED, __HIP_MEMORY_SCOPE_AGENT); }
__device__ __forceinline__ unsigned xb_xcc_id() { return (unsigned)__builtin_amdgcn_s_getreg((3 << 11) | 20) & 0xFu; }
#define XB_SPIN(cond, bar) do { unsigned _sp = 0; while (cond) { __builtin_amdgcn_s_sleep(1); \
    if ((++_sp & 255u) == 0u) { if (xb_ld(&(bar)[XB_TMO])) break; if (_sp > XB_SPIN_CAP) { atomicAdd(&(bar)[XB_TMO], 1u); break; } } } } while (0)

struct XcdBarrier { unsigned* bar; unsigned x; volatile LAS unsigned* st; };

__device__ __forceinline__ XcdBarrier xcd_barrier_post(unsigned* bar, volatile LAS unsigned* st, bool t0) {
    XcdBarrier b; b.bar = bar; b.x = xb_xcc_id(); b.st = st;
    if (t0) (void)xb_add(&bar[XB_XCNT(b.x)], 1u);
    return b;
}
__device__ __forceinline__ void xcd_barrier_complete(unsigned* bar, unsigned x, unsigned& nloc, unsigned& nx) {
    const unsigned G = gridDim.x * gridDim.y * gridDim.z;
    unsigned sum, cnt, mine, sp = 0u;
    for (;;) {
        sum = 0u; cnt = 0u; mine = 0u;
#pragma unroll
        for (unsigned j = 0; j < 16; ++j) { const unsigned c = xb_ld(&bar[XB_XCNT(j)]); sum += c; cnt += (c > 0u) ? 1u : 0u; mine = (j == x) ? c : mine; }
        if (sum == G) break;
        __builtin_amdgcn_s_sleep(1);
        if ((++sp & 255u) == 0u) { if (xb_ld(&bar[XB_TMO])) break; if (sp > XB_SPIN_CAP) { atomicAdd(&bar[XB_TMO], 1u); break; } }
    }
    nloc = mine > 0u ? mine : 1u; nx = cnt > 0u ? cnt : 1u;
}
__device__ __forceinline__ void xcd_barrier(const XcdBarrier& b, bool t0) {
    asm volatile("s_waitcnt vmcnt(0)" ::: "memory");
    __syncthreads();
    if (t0) {
        unsigned* bar = b.bar;
        __builtin_amdgcn_s_waitcnt(0);
        unsigned nloc = b.st[0], nx = b.st[1];
        if (nloc == 0u) { xcd_barrier_complete(bar, b.x, nloc, nx); b.st[0] = nloc; b.st[1] = nx; }
        const unsigned old = xb_add(&bar[XB_XSUB(b.x)], 1u);
        const unsigned gen = old / nloc;
        if (old + 1u == (gen + 1u) * nloc) {
            __builtin_amdgcn_fence(__ATOMIC_RELEASE, "agent");
            asm volatile("s_waitcnt vmcnt(0)" ::: "memory");
            const unsigned og = xb_add(&bar[XB_TOP], 1u);
            const unsigned tg = og / nx;
            if (og + 1u == (tg + 1u) * nx) xb_add(&bar[XB_TOPGEN], 1u);
            else XB_SPIN(xb_ld(&bar[XB_TOPGEN]) == tg, bar);
            __builtin_amdgcn_fence(__ATOMIC_ACQUIRE, "agent");
            xb_add(&bar[XB_XGEN(b.x)], 1u);
            asm volatile("s_waitcnt vmcnt(0)" ::: "memory");
        } else {
            XB_SPIN(xb_ld(&bar[XB_XGEN(b.x)]) == gen, bar);
            __builtin_amdgcn_fence(__ATOMIC_ACQUIRE, "agent");
            asm volatile("s_waitcnt vmcnt(0)" ::: "memory");
        }
    }
    __syncthreads();
}

namespace pg8 {
constexpr int BM = 256, BK = 64, HALF = 128, HTB = HALF * BK * 2, STAGE_BYTES = 8 * HTB, NXCD = 8, WGM = 8;
__host__ __device__ __forceinline__ int lds_byte(int r, int c) { const int st = (r >> 4) * 2 + (c >> 5), rr = r & 15, cc = c & 31, ob = rr * 64 + cc * 2; return st * 1024 + (ob ^ (((ob >> 9) & 1) << 5)); }
__host__ __device__ __forceinline__ void stage_rc(int b, int& R, int& C) { const int st = b / 1024, sb = b % 1024, swz = sb ^ (((sb >> 9) & 1) << 5); R = (st >> 1) * 16 + swz / 64; C = (st & 1) * 32 + (swz % 64) / 2; }
__host__ __device__ __forceinline__ int perm32(int rho) { const int n = rho >> 4, i = rho & 15; return 8 * (i >> 2) + 4 * n + (i & 3); }

struct Unit { int pm, pn, e; };
struct Gemm { const void* A; const void* Bt; };
template <int LDA_, int LDB_, int KB_, size_t SB_> struct GShape { static constexpr int LDA = LDA_, LDB = LDB_, KB = KB_; static constexpr size_t SB = SB_; };

__device__ __forceinline__ bool order_map(int L, int nM, int nN, int& pm, int& pn) {
    const int nwg = nM * nN; if (L >= nwg) return false;
    int wgid = L; { const int q = nwg / NXCD, r = nwg % NXCD, xcd = wgid % NXCD, off = wgid / NXCD; wgid = (xcd < r ? xcd * (q + 1) : r * (q + 1) + (xcd - r) * q) + off; }
    const int nig = WGM * nN, gid = wgid / nig, fm = gid * WGM, gsz = (nM - fm) < WGM ? (nM - fm) : WGM;
    pm = fm + ((wgid % nig) % gsz); pn = (wgid % nig) / gsz; return true;
}
struct StaticOrder {
    int nM, nN, G, c;
    __device__ void init(int M, int N, int G_, int c_) { nM = M / BM; nN = N / BM; G = G_; c = c_; }
    __device__ __forceinline__ bool next(int i, Unit& u) const { u.e = 0; return order_map(i * G + c, nM, nN, u.pm, u.pn); }
};
struct MoeOrder {
    int nM, nN, G, c; const LAS int* t2e;
    __device__ __forceinline__ bool next(int i, Unit& u) const { if (!order_map(i * G + c, nM, nN, u.pm, u.pn)) return false; u.e = __builtin_amdgcn_readfirstlane(t2e[u.pm]); return true; }
};

__device__ __forceinline__ unsigned cvt_pk_bf16(float lo, float hi) { unsigned r; asm volatile("v_cvt_pk_bf16_f32 %0, %1, %2" : "=v"(r) : "v"(lo), "v"(hi)); return r; }

struct EpiBf16 {
    static constexpr bool PERM = true;
    bf16_t* O; int ldc; const float* bias; int bias_stride;
    __device__ __forceinline__ void operator()(const f32x4 (&acc)[2][2][4][2], const Unit& u, int wr, int wc, int fr, int fq) const {
        const int row0 = u.pm * BM + wr * 64 + fr; const int col0 = u.pn * BM + wc * 32 + 8 * fq;
        f32x4 bv[2][2];
#pragma unroll
        for (int bj = 0; bj < 2; ++bj)
#pragma unroll
            for (int n = 0; n < 2; ++n) bv[bj][n] = bias ? *(const f32x4*)(bias + (size_t)u.e * bias_stride + col0 + bj * HALF + 4 * n) : (f32x4){0.f, 0.f, 0.f, 0.f};
#pragma unroll
        for (int ai = 0; ai < 2; ++ai)
#pragma unroll
            for (int m = 0; m < 4; ++m) { bf16_t* rowp = O + (size_t)(row0 + ai * HALF + m * 16) * ldc + col0;
#pragma unroll
                for (int bj = 0; bj < 2; ++bj) { const f32x4 v0 = acc[ai][bj][m][0] + bv[bj][0], v1 = acc[ai][bj][m][1] + bv[bj][1];
                    u32x4 w; w.x = cvt_pk_bf16(v0[0], v0[1]); w.y = cvt_pk_bf16(v0[2], v0[3]); w.z = cvt_pk_bf16(v1[0], v1[1]); w.w = cvt_pk_bf16(v1[2], v1[3]);
                    *(u32x4*)(rowp + bj * HALF) = w; } }
    }
};
struct EpiF32Res {
    static constexpr bool PERM = false;
    float* C; const float* resid; int ldc;
    __device__ __forceinline__ void operator()(const f32x4 (&acc)[2][2][4][2], const Unit& u, int wr, int wc, int fr, int fq) const {
        const int row0 = u.pm * BM + wr * 64 + fr, col0 = u.pn * BM + wc * 32 + 4 * fq;
#pragma unroll
        for (int ai = 0; ai < 2; ++ai)
#pragma unroll
            for (int m = 0; m < 4; ++m) { const size_t off = (size_t)(row0 + ai * HALF + m * 16) * ldc + col0;
#pragma unroll
                for (int bj = 0; bj < 2; ++bj)
#pragma unroll
                    for (int n = 0; n < 2; ++n) { const f32x4 r = *(const f32x4*)(resid + off + bj * HALF + n * 16); *(f32x4*)(C + off + bj * HALF + n * 16) = acc[ai][bj][m][n] + r; } }
    }
};
struct EpiSwiGLU {
    static constexpr bool PERM = true;
    bf16_t* O; int ldc; const float* bias;
    __device__ __forceinline__ void operator()(const f32x4 (&acc)[2][2][4][2], const Unit& u, int wr, int wc, int fr, int fq) const {
        const int row0 = u.pm * BM + wr * 64 + fr; const int j0 = u.pn * HALF + wc * 32 + 8 * fq;
        const float* be = bias + (size_t)u.e * 4096;
        f32x4 bg[2], bu[2];
#pragma unroll
        for (int n = 0; n < 2; ++n) { bg[n] = *(const f32x4*)(be + j0 + 4 * n); bu[n] = *(const f32x4*)(be + 2048 + j0 + 4 * n); }
#pragma unroll
        for (int ai = 0; ai < 2; ++ai)
#pragma unroll
            for (int m = 0; m < 4; ++m) { bf16_t* rowp = O + (size_t)(row0 + ai * HALF + m * 16) * ldc + j0;
                float o[8];
#pragma unroll
                for (int n = 0; n < 2; ++n) { const f32x4 g = acc[ai][0][m][n] + bg[n], up = acc[ai][1][m][n] + bu[n];
#pragma unroll
                    for (int q = 0; q < 4; ++q) { const float gt = fminf(g[q], 7.0f), ut = fminf(fmaxf(up[q], -7.0f), 7.0f);
                        const float glu = gt * __builtin_amdgcn_rcpf(1.0f + __expf(-1.702f * gt)); o[4 * n + q] = (ut + 1.0f) * glu; } }
                u32x4 w; w.x = cvt_pk_bf16(o[0], o[1]); w.y = cvt_pk_bf16(o[2], o[3]); w.z = cvt_pk_bf16(o[4], o[5]); w.w = cvt_pk_bf16(o[6], o[7]);
                *(u32x4*)rowp = w; }
    }
};

struct EpiSwiGLU8 {
    static constexpr bool PERM = true;
    unsigned char* O; int ldc; const float* bias;
    __device__ __forceinline__ void operator()(const f32x4 (&acc)[2][2][4][2], const Unit& u, int wr, int wc, int fr, int fq) const {
        const int row0 = u.pm * BM + wr * 64 + fr; const int j0 = u.pn * HALF + wc * 32 + 8 * fq;
        const float* be = bias + (size_t)u.e * 4096;
        f32x4 bg[2], bu[2];
#pragma unroll
        for (int n = 0; n < 2; ++n) { bg[n] = *(const f32x4*)(be + j0 + 4 * n); bu[n] = *(const f32x4*)(be + 2048 + j0 + 4 * n); }
#pragma unroll
        for (int ai = 0; ai < 2; ++ai)
#pragma unroll
            for (int m = 0; m < 4; ++m) { unsigned char* rowp = O + (size_t)(row0 + ai * HALF + m * 16) * ldc + j0;
                float o[8];
#pragma unroll
                for (int n = 0; n < 2; ++n) { const f32x4 g = acc[ai][0][m][n] * (1.0f / 8192.0f) + bg[n], up = acc[ai][1][m][n] * (1.0f / 8192.0f) + bu[n];
#pragma unroll
                    for (int q = 0; q < 4; ++q) { const float gt = fminf(g[q], 7.0f), ut = fminf(fmaxf(up[q], -7.0f), 7.0f);
                        const float glu = gt * __builtin_amdgcn_rcpf(1.0f + __expf(-1.702f * gt)); o[4 * n + q] = 4.0f * (ut + 1.0f) * glu; } }
                u32x2 w; w.x = pk4_fp8(o[0], o[1], o[2], o[3]); w.y = pk4_fp8(o[4], o[5], o[6], o[7]);
                *(u32x2*)rowp = w; }
    }
};
struct EpiBf16S {
    static constexpr bool PERM = true;
    bf16_t* O; int ldc; const float* bias; int bias_stride; float scale;
    __device__ __forceinline__ void operator()(const f32x4 (&acc)[2][2][4][2], const Unit& u, int wr, int wc, int fr, int fq) const {
        const int row0 = u.pm * BM + wr * 64 + fr; const int col0 = u.pn * BM + wc * 32 + 8 * fq;
        f32x4 bv[2][2];
#pragma unroll
        for (int bj = 0; bj < 2; ++bj)
#pragma unroll
            for (int n = 0; n < 2; ++n) bv[bj][n] = *(const f32x4*)(bias + (size_t)u.e * bias_stride + col0 + bj * HALF + 4 * n);
#pragma unroll
        for (int ai = 0; ai < 2; ++ai)
#pragma unroll
            for (int m = 0; m < 4; ++m) { bf16_t* rowp = O + (size_t)(row0 + ai * HALF + m * 16) * ldc + col0;
#pragma unroll
                for (int bj = 0; bj < 2; ++bj) { const f32x4 v0 = acc[ai][bj][m][0] * scale + bv[bj][0], v1 = acc[ai][bj][m][1] * scale + bv[bj][1];
                    u32x4 w; w.x = cvt_pk_bf16(v0[0], v0[1]); w.y = cvt_pk_bf16(v0[2], v0[3]); w.z = cvt_pk_bf16(v1[0], v1[1]); w.w = cvt_pk_bf16(v1[2], v1[3]);
                    *(u32x4*)(rowp + bj * HALF) = w; } }
    }
};

__device__ __forceinline__ i32x8 pg8_get8(const i32x32& v, int idx) { i32x8 r;
#pragma unroll
    for (int j = 0; j < 8; ++j) r[j] = v[8 * idx + j];
    return r; }
__device__ __forceinline__ i32x4 pg8_get4(const i32x32& v, int idx) { i32x4 r;
#pragma unroll
    for (int j = 0; j < 4; ++j) r[j] = v[4 * idx + j];
    return r; }
template <class Epi, class Sched, class GS, bool ALIGN_EPI = true, bool F8 = false>
__device__ __forceinline__ void gemm_phase(LAS unsigned char* lds, const Gemm g, const Sched& S, const Epi& E, int wave) {
    const int wid = wave, lane = fresh_lane(), tid = wid * 64 + lane, wr = wid >> 2, wc = wid & 3, fr = lane & 15, fq = lane >> 4;
    constexpr int nt = GS::KB / 128;
    unsigned voffA, voffB;
    { int R, C; stage_rc(tid * 16, R, C); const int Rb = Epi::PERM ? ((R & ~31) + perm32(R & 31)) : R;
      voffA = (unsigned)(R * GS::LDA + C * 2); voffB = (unsigned)(Rb * GS::LDB + C * 2); }
    constexpr size_t pstepA = (size_t)64 * GS::LDA, pstepB = (size_t)64 * GS::LDB;
    constexpr size_t kstep = (size_t)(BK * 2);
    constexpr size_t hstepA = (size_t)HALF * GS::LDA, hstepB = (size_t)HALF * GS::LDB;
    constexpr size_t tstepA = 2 * hstepA, tstepB = 2 * hstepB;
    const unsigned ldsw = (unsigned)wid * 1024u;
    const int aoff = lds_byte(wr * 64 + fr, F8 ? fq * 16 : fq * 8), boff = lds_byte(wc * 32 + fr, F8 ? fq * 16 : fq * 8);
    const int kofs = F8 ? 16 : 1024;
#define PG8_SA(b, h) (((b) * 2 + (h)) * HTB)
#define PG8_SB(b, h) ((4 + (b) * 2 + (h)) * HTB)
#define PG8_STAGE(bufoff, gbase, voff) do { _Pragma("unroll") for (int _i = 0; _i < 2; ++_i) \
        __builtin_amdgcn_global_load_lds((const unsigned*)((const char*)(gbase) + _i * pstep##voff + (voff##_v)), (LAS unsigned*)(lds + (bufoff) + ldsw + _i * 8192), 16, 0, 0); } while (0)
#define pstepvoffA pstepA
#define pstepvoffB pstepB
#define voffA_v voffA
#define voffB_v voffB
#define PG8_LD16(p) (*(const LAS i32x4*)(p))
#define PG8_SET8(V, idx, lo, hi) do { _Pragma("unroll") for (int _j = 0; _j < 4; ++_j) { V[8 * (idx) + _j] = (lo)[_j]; V[8 * (idx) + 4 + _j] = (hi)[_j]; } } while (0)
#define PG8_GET8(V, idx) pg8_get8(V, idx)
#define PG8_GETLO(V, idx) __builtin_bit_cast(bf16x8, pg8_get4(V, 2 * (idx)))
#define PG8_GETHI(V, idx) __builtin_bit_cast(bf16x8, pg8_get4(V, 2 * (idx) + 1))
#define PG8_LDA(dst, b, h) do { _Pragma("unroll") for (int m = 0; m < 4; ++m) { const i32x4 _lo = PG8_LD16(lds + PG8_SA(b, h) + aoff + m * 2048), _hi = PG8_LD16(lds + PG8_SA(b, h) + aoff + m * 2048 + kofs); \
        PG8_SET8(AV, m, _lo, _hi); } } while (0)
#define PG8_LDB(dst, b, h) do { _Pragma("unroll") for (int n = 0; n < 2; ++n) { const i32x4 _lo = PG8_LD16(lds + PG8_SB(b, h) + boff + n * 2048), _hi = PG8_LD16(lds + PG8_SB(b, h) + boff + n * 2048 + kofs); \
        PG8_SET8(BV, (dst) + n, _lo, _hi); } } while (0)
#define PG8_MMA(ai, bj, At, Bt) do { __builtin_amdgcn_s_setprio(1); \
        if constexpr (F8) { _Pragma("unroll") for (int m = 0; m < 4; ++m) _Pragma("unroll") for (int n = 0; n < 2; ++n) \
            acc[ai][bj][m][n] = __builtin_amdgcn_mfma_scale_f32_16x16x128_f8f6f4(PG8_GET8(BV, (Bt) + n), PG8_GET8(AV, m), acc[ai][bj][m][n], 0, 0, 0, 0, 0, 0); } \
        else { _Pragma("unroll") for (int m = 0; m < 4; ++m) _Pragma("unroll") for (int n = 0; n < 2; ++n) { \
            acc[ai][bj][m][n] = __builtin_amdgcn_mfma_f32_16x16x32_bf16(PG8_GETLO(BV, (Bt) + n), PG8_GETLO(AV, m), acc[ai][bj][m][n], 0, 0, 0); \
            acc[ai][bj][m][n] = __builtin_amdgcn_mfma_f32_16x16x32_bf16(PG8_GETHI(BV, (Bt) + n), PG8_GETHI(AV, m), acc[ai][bj][m][n], 0, 0, 0); } } \
        __builtin_amdgcn_s_setprio(0); } while (0)
#define PG8_WAIT_V(n) asm volatile("s_waitcnt vmcnt(" #n ")" ::: "memory")
#define PG8_WAIT_L(n) asm volatile("s_waitcnt lgkmcnt(" #n ")" ::: "memory")
#define PG8_BAR __builtin_amdgcn_s_barrier()
#define PG8_SCHED __builtin_amdgcn_sched_barrier(0)
    Unit cur, nxt; int ui = 0;
    if (!S.next(0, cur)) return;
    i32x32 AV, BV;
    constexpr int At = 0, B0 = 0, B1 = 2;
    const char* cA = (const char*)g.A + (size_t)cur.pm * tstepA; const char* cB = (const char*)g.Bt + (size_t)cur.e * GS::SB + (size_t)cur.pn * tstepB;
    PG8_STAGE(PG8_SB(0, 0), cB, voffB); PG8_SCHED; PG8_STAGE(PG8_SB(0, 1), cB + hstepB, voffB); PG8_SCHED; PG8_STAGE(PG8_SA(0, 0), cA, voffA); PG8_SCHED; PG8_STAGE(PG8_SA(0, 1), cA + hstepA, voffA); PG8_SCHED;
    if (wr == 1) PG8_BAR;
    PG8_WAIT_V(2); PG8_BAR;
    PG8_STAGE(PG8_SB(1, 0), cB + kstep, voffB); PG8_SCHED; PG8_STAGE(PG8_SA(1, 0), cA + kstep, voffA); PG8_SCHED; PG8_STAGE(PG8_SB(1, 1), cB + hstepB + kstep, voffB); PG8_SCHED;
    PG8_WAIT_V(6); PG8_BAR; PG8_SCHED;
    f32x4 acc[2][2][4][2];
#pragma unroll
    for (int a = 0; a < 2; ++a)
#pragma unroll
        for (int b = 0; b < 2; ++b)
#pragma unroll
            for (int m = 0; m < 4; ++m)
#pragma unroll
                for (int n = 0; n < 2; ++n) acc[a][b][m][n] = (f32x4){0.f, 0.f, 0.f, 0.f};
    for (;;) {
        const bool has_next = S.next(ui + 1, nxt);
        const char* nA = has_next ? (const char*)g.A + (size_t)nxt.pm * tstepA : cA;
        const char* nB = has_next ? (const char*)g.Bt + (size_t)nxt.e * GS::SB + (size_t)nxt.pn * tstepB : cB;
        for (int t = 0; t < nt; t += 2) {
            const bool last = (t == nt - 2);
            const char* a1 = cA + (size_t)(t + 1) * kstep;
            const char* a2 = last ? nA : cA + (size_t)(t + 2) * kstep; const char* b2 = last ? nB : cB + (size_t)(t + 2) * kstep;
            const char* a3 = a2 + kstep; const char* b3 = b2 + kstep;
            PG8_LDB(B0, 0, 0); PG8_LDB(B1, 0, 1); PG8_SCHED; PG8_LDA(At, 0, 0); PG8_STAGE(PG8_SA(1, 1), a1 + hstepA, voffA);
            PG8_WAIT_V(8); PG8_WAIT_L(0); PG8_BAR; PG8_MMA(0, 0, At, B0); PG8_MMA(0, 1, At, B1); PG8_BAR; PG8_SCHED;
            PG8_LDA(At, 0, 1); PG8_STAGE(PG8_SB(0, 0), b2, voffB); PG8_STAGE(PG8_SB(0, 1), b2 + hstepB, voffB); PG8_STAGE(PG8_SA(0, 0), a2, voffA);
            PG8_WAIT_V(8); PG8_WAIT_L(0); PG8_BAR; PG8_MMA(1, 0, At, B0); PG8_MMA(1, 1, At, B1); PG8_BAR; PG8_SCHED;
            PG8_LDB(B0, 1, 0); PG8_LDB(B1, 1, 1); PG8_SCHED; PG8_LDA(At, 1, 0); PG8_STAGE(PG8_SA(0, 1), a2 + hstepA, voffA);
            PG8_WAIT_V(8); PG8_WAIT_L(0); PG8_BAR; PG8_MMA(0, 0, At, B0); PG8_MMA(0, 1, At, B1); PG8_BAR; PG8_SCHED;
            PG8_LDA(At, 1, 1); PG8_STAGE(PG8_SB(1, 0), b3, voffB); PG8_STAGE(PG8_SB(1, 1), b3 + hstepB, voffB); PG8_STAGE(PG8_SA(1, 0), a3, voffA);
            PG8_WAIT_V(8); PG8_WAIT_L(0); PG8_BAR; PG8_MMA(1, 0, At, B0); PG8_MMA(1, 1, At, B1); PG8_BAR; PG8_SCHED;
        }
        if constexpr (ALIGN_EPI) { if (wr == 0) PG8_BAR; }
        { const int l2 = fresh_lane();
          E(acc, cur, wr, wc, l2 & 15, l2 >> 4); }
        if (!has_next) break;
#pragma unroll
        for (int a = 0; a < 2; ++a)
#pragma unroll
            for (int b = 0; b < 2; ++b)
#pragma unroll
                for (int m = 0; m < 4; ++m)
#pragma unroll
                    for (int n = 0; n < 2; ++n) acc[a][b][m][n] = (f32x4){0.f, 0.f, 0.f, 0.f};
        cur = nxt; cA = nA; cB = nB; ++ui;
        if constexpr (ALIGN_EPI) { if (wr == 1) PG8_BAR; }
    }
    PG8_WAIT_V(0);
    if constexpr (!ALIGN_EPI) { if (wr == 0) PG8_BAR; }
    PG8_BAR;
#undef PG8_SA
#undef PG8_SB
#undef PG8_STAGE
#undef pstepvoffA
#undef pstepvoffB
#undef voffA_v
#undef voffB_v
#undef PG8_LDA
#undef PG8_LD16
#undef PG8_SET8
#undef PG8_GET8
#undef PG8_GETLO
#undef PG8_GETHI
#undef PG8_LDB
#undef PG8_MMA
#undef PG8_WAIT_V
#undef PG8_WAIT_L
#undef PG8_BAR
#undef PG8_SCHED
}
}
struct Params {
    const float* in[22];
    float* out; unsigned char* ws;
    int ph_lo, ph_hi;
};
enum { I_X = 0, I_NMG, I_WIN, I_GWG, I_GBG, I_GNG, I_CW, I_CB, I_WA, I_BA, I_WI, I_BI, I_AP, I_WOUT, I_NFG, I_WR, I_BR, I_WGU, I_BGU, I_WDN, I_BDN, I_NFINAL };

struct Frame {
    LAS unsigned char* lds; volatile LAS unsigned* MISC;
    int tid, lane, wave, G, gw, NGW;
    unsigned char* ws;
};

__device__ __forceinline__ float gelu_tanh_f(float x) {
    const float u = 0.7978845608028654f * (x + 0.044715f * x * x * x);
    const float e = __expf(2.0f * u);
    const float th = 1.0f - 2.0f * __builtin_amdgcn_rcpf(e + 1.0f);
    return 0.5f * x * (1.0f + th);
}
__device__ __forceinline__ float log_sigmoid_f(float s) { return fminf(s, 0.f) - log1pf(__expf(-fabsf(s))); }

__device__ __forceinline__ void p0_item(const float* W, int ldw, int col0, bf16_t* WT, int ldt, size_t drow0, int k0, LAS float* scr, int lane) {
    (void)scr;
    const float* src = W + (size_t)k0 * ldw + col0 + lane;
    float v[64];
#pragma unroll
    for (int i = 0; i < 64; ++i) v[i] = src[(size_t)i * ldw];
    bf16_t* dst = WT + (drow0 + lane) * (size_t)ldt + k0;
#pragma unroll
    for (int c = 0; c < 8; ++c) { u32x4 o; o.x = pk2(v[8 * c], v[8 * c + 1]); o.y = pk2(v[8 * c + 2], v[8 * c + 3]); o.z = pk2(v[8 * c + 4], v[8 * c + 5]); o.w = pk2(v[8 * c + 6], v[8 * c + 7]);
        *(u32x4*)(dst + 8 * c) = o; }
}

__device__ __forceinline__ void p0_item8(const float* W, int ldw, int col0, unsigned char* WT, int ldt, size_t drow0, int k0, int lane) {
    const float* src = W + (size_t)k0 * ldw + col0 + lane;
    float v[64];
#pragma unroll
    for (int i = 0; i < 64; ++i) v[i] = src[(size_t)i * ldw];
    unsigned char* dst = WT + (drow0 + lane) * (size_t)ldt + k0;
#pragma unroll
    for (int c = 0; c < 4; ++c) { u32x4 o;
#pragma unroll
        for (int q = 0; q < 4; ++q) o[q] = pk4_fp8(v[16 * c + 4 * q] * 512.0f, v[16 * c + 4 * q + 1] * 512.0f, v[16 * c + 4 * q + 2] * 512.0f, v[16 * c + 4 * q + 3] * 512.0f);
        *(u32x4*)(dst + 16 * c) = o; }
}

__device__ __forceinline__ void p0a(Frame& F, const Params& p) {
    LAS float* scr = (LAS float*)(F.lds + F.wave * 16640);
    const float* w_in = p.in[I_WIN]; const float* w_out = p.in[I_WOUT]; const float* w_gu = p.in[I_WGU]; const float* w_dn = p.in[I_WDN];
    bf16_t* WinT = (bf16_t*)(F.ws + WS_WINT); bf16_t* WoutT = (bf16_t*)(F.ws + WS_WOUTT); unsigned char* WguT = F.ws + WS_WGUT; unsigned char* WdT = F.ws + WS_WDT;
    bf16_t* WaT = (bf16_t*)(F.ws + WS_WAT); bf16_t* WiT = (bf16_t*)(F.ws + WS_WIT);
    constexpr int N_INA = 32 * 48, N_INB = 32 * 32, N_OUT = 32 * 32, N_LRU = 128, N_GU = 32 * 2048, N_DN = 32 * 1024;
    constexpr int NITEMS = N_INA + N_INB + N_OUT + N_LRU + N_GU + N_DN;
    for (int it = F.gw; it < NITEMS; it += F.NGW) {
        int r = it;
        if (r < N_INA) { const int kb = r / 48, nb = r % 48; p0_item(w_in, INC, 64 * nb, WinT, DM, (size_t)64 * nb, 64 * kb, scr, F.lane); continue; } r -= N_INA;
        if (r < N_INB) { const int kb = r / 32, nb = r % 32; p0_item(w_in, INC, 3088 + 64 * nb, WinT, DM, (size_t)3072 + 64 * nb, 64 * kb, scr, F.lane); continue; } r -= N_INB;
        if (r < N_OUT) { const int kb = r / 32, nb = r % 32; p0_item(w_out, DM, 64 * nb, WoutT, DM, (size_t)64 * nb, 64 * kb, scr, F.lane); continue; } r -= N_OUT;
        if (r < N_LRU) { const int which = r >> 6, h = (r >> 4) & 3, kb = (r >> 2) & 3, nb = r & 3;
            p0_item((which ? p.in[I_WI] : p.in[I_WA]) + (size_t)h * 65536, 256, 64 * nb, (which ? WiT : WaT) + (size_t)h * 65536, 256, (size_t)64 * nb, 64 * kb, scr, F.lane); continue; } r -= N_LRU;
        if (r < N_GU) { const int e = r >> 11, q = r & 2047, kb = q >> 6, nb = q & 63; const int n0 = 64 * nb;
            const int drow0 = (n0 < 2048) ? (256 * (n0 >> 7) + (n0 & 127)) : (256 * ((n0 - 2048) >> 7) + 128 + ((n0 - 2048) & 127));
            p0_item8(w_gu + (size_t)e * DM * 4096, 4096, n0, WguT + (size_t)e * 4096 * DM, DM, (size_t)drow0, 64 * kb, F.lane); continue; } r -= N_GU;
        { const int e = r >> 10, q = r & 1023, kb = q >> 5, nb = q & 31;
            p0_item8(w_dn + (size_t)e * DM * DM, DM, 64 * nb, WdT + (size_t)e * DM * DM, DM, (size_t)64 * nb, 64 * kb, F.lane); }
    }
    { float* WrT = (float*)(F.ws + WS_WRT); const float* wr = p.in[I_WR]; const float* gf = p.in[I_NFG];
      for (int idx = (int)blockIdx.x * 512 + F.tid; idx < 32 * DM; idx += F.G * 512) { const int n = idx >> 11, k = idx & 2047; WrT[idx] = wr[k * 32 + n] * gf[k]; } }
}
__device__ __forceinline__ void p0b(Frame& F, const Params& p) {
    const float* w_in = p.in[I_WIN];
    __syncthreads();
    { LAS f32x4* Wl = (LAS f32x4*)F.lds;
      for (int idx = F.tid; idx < 8192; idx += 512) { const int l = idx & 63, i = (idx >> 6) & 3, j = (idx >> 8) & 7, c4 = idx >> 11; const int k = 4 * l + 256 * j + i;
          Wl[idx] = *(const f32x4*)(w_in + (size_t)k * INC + 3072 + 4 * c4); }
      __syncthreads();
      const float* x = p.in[I_X]; const float* g1 = p.in[I_NMG]; const float* wg = p.in[I_GWG]; const float* bgp = p.in[I_GBG];
      bf16_t* H = (bf16_t*)(F.ws + WS_H); float* LG = (float*)(F.ws + WS_LG);
      const int l = F.lane;
      f32x4 xn[8];
#pragma unroll
      for (int j = 0; j < 8; ++j) xn[j] = (F.gw < T) ? *(const f32x4*)(x + (size_t)F.gw * DM + 4 * l + 256 * j) : (f32x4){0.f, 0.f, 0.f, 0.f};
      for (int m = F.gw; m < T; m += F.NGW) {
          f32x4 xv[8]; float ss = 0.f;
#pragma unroll
          for (int j = 0; j < 8; ++j) { xv[j] = xn[j]; ss += (xv[j][0] * xv[j][0] + xv[j][1] * xv[j][1]) + (xv[j][2] * xv[j][2] + xv[j][3] * xv[j][3]); }
          if (m + F.NGW < T) {
#pragma unroll
              for (int j = 0; j < 8; ++j) xn[j] = *(const f32x4*)(x + (size_t)(m + F.NGW) * DM + 4 * l + 256 * j); }
          const float rs = 1.0f / sqrtf(wave_sum(ss) * (1.0f / DM) + 1e-6f);
          float acc[16];
#pragma unroll
          for (int c = 0; c < 16; ++c) acc[c] = 0.f;
#pragma unroll
          for (int j = 0; j < 8; ++j) { __builtin_amdgcn_sched_barrier(0); const f32x4 gv = *(const f32x4*)(g1 + 4 * l + 256 * j); xv[j] = xv[j] * rs * gv;
              u32x2 o; o.x = pk2(xv[j][0], xv[j][1]); o.y = pk2(xv[j][2], xv[j][3]); *(u32x2*)(H + (size_t)m * DM + 4 * l + 256 * j) = o;
#pragma unroll
              for (int i = 0; i < 4; ++i)
#pragma unroll
                  for (int c4 = 0; c4 < 4; ++c4) { const f32x4 wv = Wl[((c4 * 8 + j) * 4 + i) * 64 + l];
                      acc[4 * c4 + 0] += xv[j][i] * wv[0]; acc[4 * c4 + 1] += xv[j][i] * wv[1]; acc[4 * c4 + 2] += xv[j][i] * wv[2]; acc[4 * c4 + 3] += xv[j][i] * wv[3]; } }
#pragma unroll
          for (int c = 0; c < 16; ++c) acc[c] = wave_sum(acc[c]);
          f32x4 s0 = *(const f32x4*)(bgp + 8 * l), s1 = *(const f32x4*)(bgp + 8 * l + 4);
#pragma unroll
          for (int jj = 0; jj < 16; ++jj) { const f32x4 w0 = *(const f32x4*)(wg + jj * 512 + 8 * l), w1 = *(const f32x4*)(wg + jj * 512 + 8 * l + 4); s0 += acc[jj] * w0; s1 += acc[jj] * w1; }
          f32x4 o0, o1;
#pragma unroll
          for (int q = 0; q < 4; ++q) { o0[q] = log_sigmoid_f(s0[q]) * 0.0625f; o1[q] = log_sigmoid_f(s1[q]) * 0.0625f; }
          *(f32x4*)(LG + (size_t)m * 512 + 8 * l) = o0; *(f32x4*)(LG + (size_t)m * 512 + 8 * l + 4) = o1;
      }
    }
    __syncthreads();
}

__device__ __forceinline__ void gla_cumsum(const float* LG, int tok0, int h, LAS float* BC, LAS float* SEG, int tid) {
    const int seg = tid >> 7, kk = tid & 127;
    float v[16];
#pragma unroll
    for (int i = 0; i < 16; ++i) v[i] = LG[(size_t)(tok0 + 16 * seg + i) * 512 + h * 128 + kk];
#pragma unroll
    for (int i = 1; i < 16; ++i) v[i] += v[i - 1];
    SEG[seg * 128 + kk] = v[15];
    __syncthreads();
    float off = 0.f;
#pragma unroll
    for (int s = 0; s < 3; ++s) off += (s < seg) ? SEG[s * 128 + kk] : 0.f;
#pragma unroll
    for (int i = 0; i < 16; ++i) BC[(16 * seg + i) * 128 + kk] = v[i] + off;
    __syncthreads();
}
__device__ __forceinline__ bf16x8 as_bf16x8(u32x4 v) { return __builtin_bit_cast(bf16x8, v); }
__device__ __forceinline__ bf16x8 cat4(bf16x4 lo, bf16x4 hi) { return __builtin_shufflevector(lo, hi, 0, 1, 2, 3, 4, 5, 6, 7); }

__device__ __forceinline__ void p2a(Frame& F, const Params& p) {
    const bf16_t* Z = (const bf16_t*)(F.ws + WS_Z); const float* LG = (const float*)(F.ws + WS_LG);
    float* AN = (float*)(F.ws + WS_AN); float* DN = (float*)(F.ws + WS_DN); float* AUA = (float*)(F.ws + WS_AUA); float* AUU = (float*)(F.ws + WS_AUU);
    const bf16_t* WaT = (const bf16_t*)(F.ws + WS_WAT); const bf16_t* WiT = (const bf16_t*)(F.ws + WS_WIT);
    LAS float* BC = (LAS float*)(F.lds); LAS float* SEG = (LAS float*)(F.lds + 32768);
    LAS bf16_t* KDT = (LAS bf16_t*)(F.lds + 34816); LAS bf16_t* VT = (LAS bf16_t*)(F.lds + 53248); LAS bf16_t* XC = (LAS bf16_t*)(F.lds + 90112);
    const int w = F.wave;
    for (int unit = blockIdx.x; unit < NCHUNK; unit += F.G) {
        const int b = unit >> 7, n = unit & 127, tok0 = b * SEQL + 64 * n;
        for (int h = 0; h < 4; ++h) {
            int lane = fresh_lane(), tid = F.wave * 64 + lane;
            int r = lane & 31, hh = lane >> 5;
            gla_cumsum(LG, tok0, h, BC, SEG, tid);
            const int uh = (b * 4 + h) * 128 + n;
            if (tid < 128) DN[(size_t)uh * 128 + tid] = __expf(BC[63 * 128 + tid]);
#pragma unroll
            for (int it = 0; it < 2; ++it) { const int item = tid + 512 * it, t = item & 63, kk8 = item >> 6;
                const u32x4 kv = *(const u32x4*)(Z + (size_t)(tok0 + t) * ZC + ZK + h * 128 + kk8 * 8);
#pragma unroll
                for (int i = 0; i < 8; ++i) { const int kk = kk8 * 8 + i; const unsigned wv = kv[i >> 1]; const float kf = (i & 1) ? bfhi(wv) : bflo(wv);
                    const float d = __expf(BC[63 * 128 + kk] - BC[t * 128 + kk]); KDT[kk * 72 + t] = (bf16_t)f2bf(kf * d); } }
#pragma unroll
            for (int it = 0; it < 4; ++it) { const int item = tid + 512 * it, t = item & 63, vc8 = item >> 6;
                const u32x4 vv = *(const u32x4*)(Z + (size_t)(tok0 + t) * ZC + ZV + h * 256 + vc8 * 8);
#pragma unroll
                for (int i = 0; i < 8; ++i) { const unsigned wv = vv[i >> 1]; VT[(vc8 * 8 + i) * 72 + t] = (bf16_t)((i & 1) ? (wv >> 16) : (wv & 0xffffu)); } }
            __syncthreads();
            {
                f32x16 acc[4];
#pragma unroll
                for (int mb = 0; mb < 4; ++mb)
#pragma unroll
                    for (int q = 0; q < 16; ++q) acc[mb][q] = 0.f;
#pragma unroll
                for (int s = 0; s < 4; ++s) { const bf16x8 bfr = *(const LAS bf16x8*)(VT + (32 * w + r) * 72 + 16 * s + 8 * hh);
#pragma unroll
                    for (int mb = 0; mb < 4; ++mb) { const bf16x8 afr = *(const LAS bf16x8*)(KDT + (32 * mb + r) * 72 + 16 * s + 8 * hh);
                        acc[mb] = __builtin_amdgcn_mfma_f32_32x32x16_bf16(afr, bfr, acc[mb], 0, 0, 0); } }
                float* base = AN + (size_t)uh * 32768;
#pragma unroll
                for (int mb = 0; mb < 4; ++mb)
#pragma unroll
                    for (int g = 0; g < 4; ++g) *(f32x4*)(base + (((mb * 8 + w) * 4 + g) * 64 + lane) * 4) = (f32x4){acc[mb][4 * g], acc[mb][4 * g + 1], acc[mb][4 * g + 2], acc[mb][4 * g + 3]};
            }
#ifndef P2A_NO_LRU
            {
                lane = fresh_lane(); tid = F.wave * 64 + lane; r = lane & 31; hh = lane >> 5;
                const float* cw = p.in[I_CW]; const float* cb = p.in[I_CB];
                {
                    const int c8 = tid & 31, tq = tid >> 5, chc = h * 256 + c8 * 8;
                    u32x4 lv[7];
#pragma unroll
                    for (int i = 0; i < 7; ++i) { const int s = 64 * n + 4 * tq - 3 + i;
                        lv[i] = (s >= 0) ? *(const u32x4*)(Z + (size_t)(tok0 + 4 * tq - 3 + i) * ZC + ZLX + chc) : (u32x4){0u, 0u, 0u, 0u}; }
                    f32x4 wv[4][2], bv[2];
#pragma unroll
                    for (int i = 0; i < 4; ++i) { wv[i][0] = *(const f32x4*)(cw + i * 1024 + chc); wv[i][1] = *(const f32x4*)(cw + i * 1024 + chc + 4); }
                    bv[0] = *(const f32x4*)(cb + chc); bv[1] = *(const f32x4*)(cb + chc + 4);
#pragma unroll
                    for (int it = 0; it < 4; ++it) { float xc[8];
#pragma unroll
                        for (int q = 0; q < 4; ++q) { xc[q] = bv[0][q]; xc[4 + q] = bv[1][q]; }
#pragma unroll
                        for (int i = 0; i < 4; ++i) { const u32x4 l4 = lv[it + i];
                            xc[0] += bflo(l4[0]) * wv[i][0][0]; xc[1] += bfhi(l4[0]) * wv[i][0][1]; xc[2] += bflo(l4[1]) * wv[i][0][2]; xc[3] += bfhi(l4[1]) * wv[i][0][3];
                            xc[4] += bflo(l4[2]) * wv[i][1][0]; xc[5] += bfhi(l4[2]) * wv[i][1][1]; xc[6] += bflo(l4[3]) * wv[i][1][2]; xc[7] += bfhi(l4[3]) * wv[i][1][3]; }
                        u32x4 o; o.x = pk2(xc[0], xc[1]); o.y = pk2(xc[2], xc[3]); o.z = pk2(xc[4], xc[5]); o.w = pk2(xc[6], xc[7]);
                        *(LAS u32x4*)(XC + (4 * tq + it) * 264 + c8 * 8) = o; }
                }
                __builtin_amdgcn_sched_barrier(0);
                bf16x8 ba[16], bi[16];
                { const bf16_t* wa = WaT + (size_t)h * 65536 + (size_t)(32 * w + r) * 256 + 8 * hh;
                  const bf16_t* wi = WiT + (size_t)h * 65536 + (size_t)(32 * w + r) * 256 + 8 * hh;
#pragma unroll
                  for (int s = 0; s < 16; ++s) { ba[s] = *(const bf16x8*)(wa + 16 * s); bi[s] = *(const bf16x8*)(wi + 16 * s); } }
                __syncthreads();
                f32x16 aa[2], ai[2];
#pragma unroll
                for (int mb = 0; mb < 2; ++mb)
#pragma unroll
                    for (int q = 0; q < 16; ++q) { aa[mb][q] = 0.f; ai[mb][q] = 0.f; }
#pragma unroll
                for (int s = 0; s < 16; ++s) {
#pragma unroll
                    for (int mb = 0; mb < 2; ++mb) { const bf16x8 af = *(const LAS bf16x8*)(XC + (32 * mb + r) * 264 + 16 * s + 8 * hh);
                        aa[mb] = __builtin_amdgcn_mfma_f32_32x32x16_bf16(af, ba[s], aa[mb], 0, 0, 0); } }
                __builtin_amdgcn_sched_barrier(0);
#pragma unroll
                for (int s = 0; s < 16; ++s) {
#pragma unroll
                    for (int mb = 0; mb < 2; ++mb) { const bf16x8 af = *(const LAS bf16x8*)(XC + (32 * mb + r) * 264 + 16 * s + 8 * hh);
                        ai[mb] = __builtin_amdgcn_mfma_f32_32x32x16_bf16(af, bi[s], ai[mb], 0, 0, 0); } }
                const int ch = h * 256 + 32 * w + r;
                const float ba_ = p.in[I_BA][ch], bi_ = p.in[I_BI][ch]; const float L = p.in[I_AP][ch];
                const float sp = fmaxf(-L, 0.f) + log1pf(__expf(-fabsf(L)));
                const unsigned off0 = (unsigned)((tok0 + 4 * hh) * 1024 + ch);
#pragma unroll
                for (int mb = 0; mb < 2; ++mb)
#pragma unroll
                    for (int q4 = 0; q4 < 4; ++q4) {
                        unsigned o = off0 + (unsigned)((32 * mb + 8 * q4) * 1024); asm volatile("" : "+v"(o));
#pragma unroll
                        for (int i = 0; i < 4; ++i) { const int q = 4 * q4 + i; const int t = 32 * mb + 8 * q4 + i + 4 * hh;
                            const float ga = sigmoidf_(aa[mb][q] + ba_), gi = sigmoidf_(ai[mb][q] + bi_);
                            const float la = -8.0f * ga * sp; const float a = __expf(la);
                            const float xcv = bf2f(XC[t * 264 + 32 * w + r]);
                            const float u = xcv * gi * sqrtf(fmaxf(1.0f - a * a, 0.f));
                            AUA[(size_t)o + i * 1024] = a; AUU[(size_t)o + i * 1024] = u; } }
            }
#endif
            __syncthreads();
        }
    }
}

__device__ __forceinline__ void p2b(Frame& F, const Params& p) {
    const float* AN = (const float*)(F.ws + WS_AN); const float* DN = (const float*)(F.ws + WS_DN); bf16_t* SP = (bf16_t*)(F.ws + WS_SP);
    for (int st = (int)blockIdx.x * 512 + F.tid; st < 131072; st += F.G * 512) {
        const int bh = st >> 14, rem = st & 16383, half = rem & 1, ln = (rem >> 1) & 63, g = (rem >> 7) & 3, w = (rem >> 9) & 7, mb = (rem >> 12) & 3;
        const int kk0 = 32 * mb + 2 * half + 8 * g + 4 * (ln >> 5);
        const int offA = (((mb * 8 + w) * 4 + g) * 64 + ln) * 4 + 2 * half;
        const int offS = (((mb * 8 + w) * 2 + (g >> 1)) * 64 + ln) * 8 + (g & 1) * 4 + 2 * half;
        float S0 = 0.f, S1 = 0.f;
#pragma unroll 16
        for (int n = 0; n < 128; ++n) { const size_t uh = (size_t)bh * 128 + n;
            *(unsigned*)(SP + uh * 32768 + offS) = pk2(S0, S1);
            const f32x2 a = *(const f32x2*)(AN + uh * 32768 + offA); const f32x2 d = *(const f32x2*)(DN + uh * 128 + kk0);
            S0 = d.x * S0 + a.x; S1 = d.y * S1 + a.y; }
    }
    const float* AUA = (const float*)(F.ws + WS_AUA); const float* AUU = (const float*)(F.ws + WS_AUU);
    float* SUMA = (float*)(F.ws + WS_SUMA); float* SUMH = (float*)(F.ws + WS_SUMH);
    for (int c = blockIdx.x; c < NCHUNK; c += F.G) { const int ch = 2 * F.tid;
        f32x2 A = (f32x2){1.f, 1.f}, Hh = (f32x2){0.f, 0.f};
#pragma unroll 16
        for (int t = 0; t < 64; ++t) { const f32x2 a = *(const f32x2*)(AUA + (size_t)(c * 64 + t) * 1024 + ch), u = *(const f32x2*)(AUU + (size_t)(c * 64 + t) * 1024 + ch);
            Hh = a * Hh + u; A = A * a; }
        *(f32x2*)(SUMA + c * 1024 + ch) = A; *(f32x2*)(SUMH + c * 1024 + ch) = Hh; }
}

__device__ __forceinline__ void p2c(Frame& F, const Params& p) {
    const bf16_t* Z = (const bf16_t*)(F.ws + WS_Z); const float* LG = (const float*)(F.ws + WS_LG); const bf16_t* SP = (const bf16_t*)(F.ws + WS_SP);
    bf16_t* MIX = (bf16_t*)(F.ws + WS_MIX);
    LAS float* BC = (LAS float*)(F.lds); LAS float* SEG = (LAS float*)(F.lds + 32768);
    LAS bf16_t* QE = (LAS bf16_t*)(F.lds + 34816); LAS bf16_t* KE = (LAS bf16_t*)(F.lds + 52224); LAS bf16_t* VT = (LAS bf16_t*)(F.lds + 69632);
    LAS float* SSQ = (LAS float*)(F.lds + 106496); LAS float* OS = (LAS float*)(F.lds);
    const int tid = F.tid, lane = F.lane, w = F.wave, r = lane & 31, hh = lane >> 5;
    const float* gng = p.in[I_GNG];
    for (int unit = blockIdx.x; unit < NCHUNK; unit += F.G) {
        const int b = unit >> 7, n = unit & 127, tok0 = b * SEQL + 64 * n;
        { const float* AUA = (const float*)(F.ws + WS_AUA); const float* AUU = (const float*)(F.ws + WS_AUU);
          const float* SUMA = (const float*)(F.ws + WS_SUMA); const float* SUMH = (const float*)(F.ws + WS_SUMH);
          const int ch = 2 * tid; f32x2 hc = (f32x2){0.f, 0.f};
          int c2 = unit & ~127;
          for (; c2 + 16 <= unit; c2 += 16) { f32x2 a[16], hv[16];
#pragma unroll
              for (int q = 0; q < 16; ++q) { a[q] = *(const f32x2*)(SUMA + (c2 + q) * 1024 + ch); hv[q] = *(const f32x2*)(SUMH + (c2 + q) * 1024 + ch); }
#pragma unroll
              for (int q = 0; q < 16; ++q) hc = a[q] * hc + hv[q]; }
          { f32x2 a[16], hv[16];
#pragma unroll
              for (int q = 0; q < 16; ++q) { const bool ok = (c2 + q) < unit; a[q] = ok ? *(const f32x2*)(SUMA + (c2 + q) * 1024 + ch) : (f32x2){1.f, 1.f}; hv[q] = ok ? *(const f32x2*)(SUMH + (c2 + q) * 1024 + ch) : (f32x2){0.f, 0.f}; }
#pragma unroll
              for (int q = 0; q < 16; ++q) hc = a[q] * hc + hv[q]; }
#pragma unroll 16
          for (int t = 0; t < 64; ++t) { const size_t tok = (size_t)tok0 + t;
              const f32x2 a = *(const f32x2*)(AUA + tok * 1024 + ch), u = *(const f32x2*)(AUU + tok * 1024 + ch);
              hc = a * hc + u;
              const unsigned lgw = *(const unsigned*)(Z + tok * ZC + ZLG + ch);
              *(unsigned*)(MIX + tok * DM + 1024 + ch) = pk2(hc.x * gelu_tanh_f(bflo(lgw)), hc.y * gelu_tanh_f(bfhi(lgw))); } }
        for (int h = 0; h < 4; ++h) {
            const int uh = (b * 4 + h) * 128 + n;
            bf16x8 sf[4][2];
            { const bf16_t* spu = SP + (size_t)uh * 32768;
#pragma unroll
              for (int mb = 0; mb < 4; ++mb)
#pragma unroll
                  for (int s2 = 0; s2 < 2; ++s2) sf[mb][s2] = *(const bf16x8*)(spu + (((mb * 8 + w) * 2 + s2) * 64 + lane) * 8); }
            gla_cumsum(LG, tok0, h, BC, SEG, tid);
#pragma unroll
            for (int it = 0; it < 2; ++it) { const int item = tid + 512 * it, kk8 = item & 15, t = item >> 4;
                const u32x4 qv = *(const u32x4*)(Z + (size_t)(tok0 + t) * ZC + ZQ + h * 128 + kk8 * 8);
                const u32x4 kv = *(const u32x4*)(Z + (size_t)(tok0 + t) * ZC + ZK + h * 128 + kk8 * 8);
                const f32x4 b0 = *(const LAS f32x4*)(BC + t * 128 + kk8 * 8), b1 = *(const LAS f32x4*)(BC + t * 128 + kk8 * 8 + 4);
                float qe[8], ke[8];
#pragma unroll
                for (int i = 0; i < 8; ++i) { const float bb = (i < 4) ? b0[i & 3] : b1[i & 3]; const unsigned qw = qv[i >> 1], kw = kv[i >> 1];
                    const float qf = (i & 1) ? bfhi(qw) : bflo(qw), kf = (i & 1) ? bfhi(kw) : bflo(kw);
                    qe[i] = qf * 0.08838834764831845f * __expf(bb); ke[i] = kf * __expf(-bb); }
                u32x4 oq, ok; oq.x = pk2(qe[0], qe[1]); oq.y = pk2(qe[2], qe[3]); oq.z = pk2(qe[4], qe[5]); oq.w = pk2(qe[6], qe[7]);
                ok.x = pk2(ke[0], ke[1]); ok.y = pk2(ke[2], ke[3]); ok.z = pk2(ke[4], ke[5]); ok.w = pk2(ke[6], ke[7]);
                *(LAS u32x4*)(QE + t * 136 + kk8 * 8) = oq; *(LAS u32x4*)(KE + t * 136 + kk8 * 8) = ok; }
#pragma unroll
            for (int it = 0; it < 4; ++it) { const int item = tid + 512 * it, t = item & 63, vc8 = item >> 6;
                const u32x4 vv = *(const u32x4*)(Z + (size_t)(tok0 + t) * ZC + ZV + h * 256 + vc8 * 8);
#pragma unroll
                for (int i = 0; i < 8; ++i) { const unsigned wv = vv[i >> 1]; VT[(vc8 * 8 + i) * 72 + t] = (bf16_t)((i & 1) ? (wv >> 16) : (wv & 0xffffu)); } }
            __syncthreads();
            f32x16 oacc[2];
            {
                f32x16 P00, P01, P11;
#pragma unroll
                for (int q = 0; q < 16; ++q) { P00[q] = 0.f; P01[q] = 0.f; P11[q] = 0.f; oacc[0][q] = 0.f; oacc[1][q] = 0.f; }
#pragma unroll
                for (int s = 0; s < 8; ++s) {
                    const bf16x8 a0 = *(const LAS bf16x8*)(KE + r * 136 + 16 * s + 8 * hh), a1 = *(const LAS bf16x8*)(KE + (32 + r) * 136 + 16 * s + 8 * hh);
                    const bf16x8 b0 = *(const LAS bf16x8*)(QE + r * 136 + 16 * s + 8 * hh), b1 = *(const LAS bf16x8*)(QE + (32 + r) * 136 + 16 * s + 8 * hh);
                    P00 = __builtin_amdgcn_mfma_f32_32x32x16_bf16(a0, b0, P00, 0, 0, 0);
                    P01 = __builtin_amdgcn_mfma_f32_32x32x16_bf16(a0, b1, P01, 0, 0, 0);
                    P11 = __builtin_amdgcn_mfma_f32_32x32x16_bf16(a1, b1, P11, 0, 0, 0); }
#pragma unroll
                for (int q = 0; q < 16; ++q) { const int jl = (q & 3) + 8 * (q >> 2) + 4 * hh; if (jl > r) { P00[q] = 0.f; P11[q] = 0.f; } }
                bf16x8 F00[2], F01[2], F11[2];
#pragma unroll
                for (int s2 = 0; s2 < 2; ++s2) {
                    u32x4 t0, t1, t2;
#pragma unroll
                    for (int q = 0; q < 4; ++q) { t0[q] = pk2(P00[8 * s2 + 2 * q], P00[8 * s2 + 2 * q + 1]); t1[q] = pk2(P01[8 * s2 + 2 * q], P01[8 * s2 + 2 * q + 1]); t2[q] = pk2(P11[8 * s2 + 2 * q], P11[8 * s2 + 2 * q + 1]); }
                    F00[s2] = as_bf16x8(t0); F01[s2] = as_bf16x8(t1); F11[s2] = as_bf16x8(t2); }
#pragma unroll
                for (int mb = 0; mb < 4; ++mb)
#pragma unroll
                    for (int s2 = 0; s2 < 2; ++s2) { const bf16x8 af = sf[mb][s2];
                        const int kkb = 32 * mb + 16 * s2 + 4 * hh;
#pragma unroll
                        for (int ib = 0; ib < 2; ++ib) { const bf16x4 lo = *(const LAS bf16x4*)(QE + (32 * ib + r) * 136 + kkb), hi = *(const LAS bf16x4*)(QE + (32 * ib + r) * 136 + kkb + 8);
                            oacc[ib] = __builtin_amdgcn_mfma_f32_32x32x16_bf16(af, cat4(lo, hi), oacc[ib], 0, 0, 0); } }
#pragma unroll
                for (int s2 = 0; s2 < 2; ++s2) {
                    const int tb0 = 16 * s2 + 4 * hh, tb1 = 32 + 16 * s2 + 4 * hh;
                    const bf16x8 v0 = cat4(*(const LAS bf16x4*)(VT + (32 * w + r) * 72 + tb0), *(const LAS bf16x4*)(VT + (32 * w + r) * 72 + tb0 + 8));
                    const bf16x8 v1 = cat4(*(const LAS bf16x4*)(VT + (32 * w + r) * 72 + tb1), *(const LAS bf16x4*)(VT + (32 * w + r) * 72 + tb1 + 8));
                    oacc[0] = __builtin_amdgcn_mfma_f32_32x32x16_bf16(v0, F00[s2], oacc[0], 0, 0, 0);
                    oacc[1] = __builtin_amdgcn_mfma_f32_32x32x16_bf16(v0, F01[s2], oacc[1], 0, 0, 0);
                    oacc[1] = __builtin_amdgcn_mfma_f32_32x32x16_bf16(v1, F11[s2], oacc[1], 0, 0, 0); }
            }
#pragma unroll
            for (int ib = 0; ib < 2; ++ib) { float sq = 0.f;
#pragma unroll
                for (int q = 0; q < 16; ++q) sq += oacc[ib][q] * oacc[ib][q];
                sq += __shfl_xor(sq, 32);
                if (hh == 0) SSQ[w * 64 + 32 * ib + r] = sq; }
            __syncthreads();
#pragma unroll
            for (int ib = 0; ib < 2; ++ib) { float tot = 0.f;
#pragma unroll
                for (int w2 = 0; w2 < 8; ++w2) tot += SSQ[w2 * 64 + 32 * ib + r];
                const float rs = 1.0f / sqrtf(tot * (1.0f / 256.0f) + 1e-6f);
#pragma unroll
                for (int g = 0; g < 4; ++g) *(LAS f32x4*)(OS + (32 * ib + r) * 260 + 32 * w + 8 * g + 4 * hh) =
                    (f32x4){oacc[ib][4 * g] * rs, oacc[ib][4 * g + 1] * rs, oacc[ib][4 * g + 2] * rs, oacc[ib][4 * g + 3] * rs}; }
            __syncthreads();
#pragma unroll
            for (int it = 0; it < 4; ++it) { const int item = tid + 512 * it, vc8 = item & 31, t = item >> 5; const int c = h * 256 + vc8 * 8;
                const f32x4 o0 = *(const LAS f32x4*)(OS + t * 260 + vc8 * 8), o1 = *(const LAS f32x4*)(OS + t * 260 + vc8 * 8 + 4);
                const u32x4 rv = *(const u32x4*)(Z + (size_t)(tok0 + t) * ZC + ZR + c);
                const f32x4 g0 = *(const f32x4*)(gng + c), g1 = *(const f32x4*)(gng + c + 4);
                float o[8];
#pragma unroll
                for (int i = 0; i < 8; ++i) { const unsigned rw = rv[i >> 1]; const float rf = (i & 1) ? bfhi(rw) : bflo(rw);
                    const float sil = rf * sigmoidf_(rf); o[i] = sil * ((i < 4) ? o0[i & 3] * g0[i & 3] : o1[i & 3] * g1[i & 3]); }
                u32x4 ov; ov.x = pk2(o[0], o[1]); ov.y = pk2(o[2], o[3]); ov.z = pk2(o[4], o[5]); ov.w = pk2(o[6], o[7]);
                *(u32x4*)(MIX + (size_t)(tok0 + t) * DM + c) = ov; }
            __syncthreads();
        }
    }
}

__device__ __forceinline__ void build_moe_tables(Frame& F) {
    unsigned* cnt = (unsigned*)(F.ws + WS_CTL) + CW_CNT;
    if (F.tid < 32) F.MISC[MI_LCNT + F.tid] = xb_ld(cnt + 64 * F.tid);
    __syncthreads();
    if (F.tid == 0) { int tiles = 0;
        for (int e = 0; e < NEXP; ++e) { const int c = (int)F.MISC[MI_LCNT + e]; const int mt = (c + 255) >> 8; F.MISC[MI_PBASE + e] = (unsigned)(tiles * 256);
            for (int q = 0; q < mt; ++q) F.MISC[MI_T2E + tiles + q] = (unsigned)e; tiles += mt; }
        F.MISC[MI_NMT] = (unsigned)tiles; }
    __syncthreads();
    if (F.tid < 32) F.MISC[MI_LCNT + F.tid] = 0u;
    __syncthreads();
}

__device__ __forceinline__ void p4a(Frame& F, const Params& p) {
    const float* XMID = (const float*)(F.ws + WS_XMID); const float* WrT = (const float*)(F.ws + WS_WRT); const float* br = p.in[I_BR];
    float* RSTD = (float*)(F.ws + WS_RSTD); unsigned* TOKE = (unsigned*)(F.ws + WS_TOKE); float* GATES = (float*)(F.ws + WS_GATES);
    unsigned* cnt = (unsigned*)(F.ws + WS_CTL) + CW_CNT;
    LAS float* RED = (LAS float*)(F.lds); LAS float* SSQ2 = (LAS float*)(F.lds + 32768); LAS float* LGT = (LAS float*)(F.lds + 33792); LAS float* RS = (LAS float*)(F.lds + 38016);
    const int tid = F.tid, lane = F.lane, w = F.wave, m = lane & 31, kh = lane >> 5;
    if (tid < 32) F.MISC[MI_LCNT + tid] = 0u;
    __syncthreads();
    for (int ut = blockIdx.x; ut < T / 32; ut += F.G) {
        const int m0 = 32 * ut; const int kw = 256 * w + 128 * kh;
        f32x16 acc;
#pragma unroll
        for (int q = 0; q < 16; ++q) acc[q] = 0.f;
        float ss = 0.f;
        const float* ap = XMID + (size_t)(m0 + m) * DM + kw; const float* bp = WrT + (size_t)m * DM + kw;
#pragma unroll 2
        for (int c = 0; c < 8; ++c) {
            f32x4 a[4], b[4];
#pragma unroll
            for (int q = 0; q < 4; ++q) { a[q] = *(const f32x4*)(ap + 16 * c + 4 * q); b[q] = *(const f32x4*)(bp + 16 * c + 4 * q); }
#pragma unroll
            for (int q = 0; q < 4; ++q)
#pragma unroll
                for (int i = 0; i < 4; ++i) { acc = __builtin_amdgcn_mfma_f32_32x32x2f32(a[q][i], b[q][i], acc, 0, 0, 0); ss += a[q][i] * a[q][i]; }
        }
        ss += __shfl_xor(ss, 32);
#pragma unroll
        for (int q = 0; q < 16; ++q) RED[(w * 16 + q) * 64 + lane] = acc[q];
        if (kh == 0) SSQ2[w * 32 + m] = ss;
        __syncthreads();
#pragma unroll
        for (int it = 0; it < 2; ++it) { const int o = tid + 512 * it, reg = o >> 6, ln = o & 63, nn = ln & 31, h2 = ln >> 5; const int mm = (reg & 3) + 8 * (reg >> 2) + 4 * h2;
            float v = 0.f, s2 = 0.f;
#pragma unroll
            for (int w2 = 0; w2 < 8; ++w2) { v += RED[(w2 * 16 + reg) * 64 + ln]; s2 += SSQ2[w2 * 32 + mm]; }
            const float rs = 1.0f / sqrtf(s2 * (1.0f / DM) + 1e-6f);
            LGT[mm * 33 + nn] = v * rs + br[nn]; if (nn == 0) RS[mm] = rs; }
        __syncthreads();
        int ex[4]; unsigned ls[4]; float gt[4];
        if (tid < 32) {
            float l[32];
#pragma unroll
            for (int i = 0; i < 32; ++i) l[i] = LGT[tid * 33 + i];
            float val[4];
#pragma unroll
            for (int k = 0; k < 4; ++k) { float best = -3.0e38f; int bi = 0;
#pragma unroll
                for (int i = 0; i < 32; ++i) if (l[i] > best) { best = l[i]; bi = i; }
                ex[k] = bi; val[k] = best;
#pragma unroll
                for (int i = 0; i < 32; ++i) if (i == bi) l[i] = -3.0e38f; }
            float s = 0.f;
#pragma unroll
            for (int k = 0; k < 4; ++k) { gt[k] = __expf(val[k] - val[0]); s += gt[k]; }
            const float inv = 1.0f / s;
#pragma unroll
            for (int k = 0; k < 4; ++k) { gt[k] *= inv; ls[k] = __hip_atomic_fetch_add((LAS unsigned*)(F.MISC + MI_LCNT + ex[k]), 1u, __ATOMIC_RELAXED, __HIP_MEMORY_SCOPE_WORKGROUP); }
        }
        __syncthreads();
        if (tid < 32) { const unsigned c = F.MISC[MI_LCNT + tid]; F.MISC[MI_LBASE + tid] = c ? xb_add(cnt + 64 * tid, c) : 0u; F.MISC[MI_LCNT + tid] = 0u; }
        __syncthreads();
        if (tid < 32) { const int tok = m0 + tid;
#pragma unroll
            for (int k = 0; k < 4; ++k) { const unsigned slot = F.MISC[MI_LBASE + ex[k]] + ls[k]; TOKE[tok * 4 + k] = (unsigned)ex[k] | (slot << 8); GATES[tok * 4 + k] = gt[k]; }
            RSTD[tok] = RS[tid]; }
        __syncthreads();
    }
}

__device__ __forceinline__ void p4b(Frame& F, const Params& p) {
    build_moe_tables(F);
    const float* XMID = (const float*)(F.ws + WS_XMID); const float* RSTD = (const float*)(F.ws + WS_RSTD); const unsigned* TOKE = (const unsigned*)(F.ws + WS_TOKE);
    const float* gf = p.in[I_NFG]; unsigned char* ABUF = F.ws + WS_ABUF;
    const int l = F.lane;
    f32x4 xn[8]; float rsn = 0.f; unsigned ten[4] = {0u, 0u, 0u, 0u};
    if (F.gw < T) { rsn = RSTD[F.gw];
#pragma unroll
        for (int k = 0; k < 4; ++k) ten[k] = TOKE[F.gw * 4 + k];
#pragma unroll
        for (int j = 0; j < 4; ++j) { xn[2 * j] = *(const f32x4*)(XMID + (size_t)F.gw * DM + 8 * l + 512 * j); xn[2 * j + 1] = *(const f32x4*)(XMID + (size_t)F.gw * DM + 8 * l + 512 * j + 4); } }
    f32x4 gv[8];
#pragma unroll
    for (int j = 0; j < 4; ++j) { gv[2 * j] = *(const f32x4*)(gf + 8 * l + 512 * j) * 16.0f; gv[2 * j + 1] = *(const f32x4*)(gf + 8 * l + 512 * j + 4) * 16.0f; }
    for (int tok = F.gw; tok < T; tok += F.NGW) {
        const float rs = rsn; unsigned te[4]; u32x2 o[4];
#pragma unroll
        for (int k = 0; k < 4; ++k) te[k] = ten[k];
#pragma unroll
        for (int j = 0; j < 4; ++j) { const f32x4 a = xn[2 * j] * rs * gv[2 * j], b = xn[2 * j + 1] * rs * gv[2 * j + 1];
            o[j].x = pk4_fp8(a[0], a[1], a[2], a[3]); o[j].y = pk4_fp8(b[0], b[1], b[2], b[3]); }
        const int t2 = tok + F.NGW;
        if (t2 < T) { rsn = RSTD[t2];
#pragma unroll
            for (int k = 0; k < 4; ++k) ten[k] = TOKE[t2 * 4 + k];
#pragma unroll
            for (int j = 0; j < 4; ++j) { xn[2 * j] = *(const f32x4*)(XMID + (size_t)t2 * DM + 8 * l + 512 * j); xn[2 * j + 1] = *(const f32x4*)(XMID + (size_t)t2 * DM + 8 * l + 512 * j + 4); } }
#pragma unroll
        for (int k = 0; k < 4; ++k) { const size_t row = (size_t)F.MISC[MI_PBASE + (te[k] & 255u)] + (te[k] >> 8);
#pragma unroll
            for (int j = 0; j < 4; ++j) *(u32x2*)(ABUF + row * DM + 8 * l + 512 * j) = o[j]; }
    }
}

__device__ __forceinline__ void p7(Frame& F, const Params& p) {
    build_moe_tables(F);
    const float* XMID = (const float*)(F.ws + WS_XMID); const unsigned* TOKE = (const unsigned*)(F.ws + WS_TOKE); const float* GATES = (const float*)(F.ws + WS_GATES);
    const bf16_t* Y = (const bf16_t*)(F.ws + WS_Y); const float* gfin = p.in[I_NFINAL];
    const int l = F.lane;
    f32x4 xn[8]; unsigned ten[4] = {0u, 0u, 0u, 0u}; float gkn[4] = {0.f, 0.f, 0.f, 0.f};
    if (F.gw < T) {
#pragma unroll
        for (int k = 0; k < 4; ++k) { ten[k] = TOKE[F.gw * 4 + k]; gkn[k] = GATES[F.gw * 4 + k]; }
#pragma unroll
        for (int j = 0; j < 4; ++j) { xn[2 * j] = *(const f32x4*)(XMID + (size_t)F.gw * DM + 8 * l + 512 * j); xn[2 * j + 1] = *(const f32x4*)(XMID + (size_t)F.gw * DM + 8 * l + 512 * j + 4); } }
    for (int tok = F.gw; tok < T; tok += F.NGW) {
        f32x4 xv[8]; u32x4 yv[4][4]; float gk[4];
#pragma unroll
        for (int k = 0; k < 4; ++k) { const unsigned te = ten[k]; gk[k] = gkn[k]; const size_t row = (size_t)F.MISC[MI_PBASE + (te & 255u)] + (te >> 8);
#pragma unroll
            for (int j = 0; j < 4; ++j) yv[k][j] = *(const u32x4*)(Y + row * DM + 8 * l + 512 * j); }
#pragma unroll
        for (int j = 0; j < 8; ++j) xv[j] = xn[j];
        const int t2 = tok + F.NGW;
        if (t2 < T) {
#pragma unroll
            for (int k = 0; k < 4; ++k) { ten[k] = TOKE[t2 * 4 + k]; gkn[k] = GATES[t2 * 4 + k]; }
#pragma unroll
            for (int j = 0; j < 4; ++j) { xn[2 * j] = *(const f32x4*)(XMID + (size_t)t2 * DM + 8 * l + 512 * j); xn[2 * j + 1] = *(const f32x4*)(XMID + (size_t)t2 * DM + 8 * l + 512 * j + 4); } }
#pragma unroll
        for (int k = 0; k < 4; ++k)
#pragma unroll
            for (int j = 0; j < 4; ++j) { const u32x4 y4 = yv[k][j];
                xv[2 * j][0] += gk[k] * bflo(y4.x); xv[2 * j][1] += gk[k] * bfhi(y4.x); xv[2 * j][2] += gk[k] * bflo(y4.y); xv[2 * j][3] += gk[k] * bfhi(y4.y);
                xv[2 * j + 1][0] += gk[k] * bflo(y4.z); xv[2 * j + 1][1] += gk[k] * bfhi(y4.z); xv[2 * j + 1][2] += gk[k] * bflo(y4.w); xv[2 * j + 1][3] += gk[k] * bfhi(y4.w); }
        float ss = 0.f;
#pragma unroll
        for (int j = 0; j < 8; ++j) ss += (xv[j][0] * xv[j][0] + xv[j][1] * xv[j][1]) + (xv[j][2] * xv[j][2] + xv[j][3] * xv[j][3]);
        const float rs = 1.0f / sqrtf(wave_sum(ss) * (1.0f / DM) + 1e-6f);
#pragma unroll
        for (int j = 0; j < 4; ++j) { const f32x4 g0 = *(const f32x4*)(gfin + 8 * l + 512 * j), g1 = *(const f32x4*)(gfin + 8 * l + 512 * j + 4);
            *(f32x4*)(p.out + (size_t)tok * DM + 8 * l + 512 * j) = xv[2 * j] * rs * g0; *(f32x4*)(p.out + (size_t)tok * DM + 8 * l + 512 * j + 4) = xv[2 * j + 1] * rs * g1; }
    }
}


#ifdef PROBE_STREAM
__device__ __forceinline__ void probe_stream(Frame& F, const Params& p) {
    const f32x4* src = (const f32x4*)p.in[I_WGU]; const size_t n4 = (size_t)32 * 2048 * 4096 / 4;
    const f32x4* src2 = (const f32x4*)p.in[I_WDN]; const size_t m4 = (size_t)32 * 2048 * 2048 / 4;
    f32x4 acc = (f32x4){0.f, 0.f, 0.f, 0.f};
    for (size_t base = (size_t)F.gw * 1024; base < n4; base += (size_t)F.NGW * 1024) {
        f32x4 v[16];
#pragma unroll
        for (int i = 0; i < 16; ++i) v[i] = src[base + i * 64 + F.lane];
#pragma unroll
        for (int i = 0; i < 16; ++i) acc += v[i]; }
    for (size_t base = (size_t)F.gw * 1024; base < m4; base += (size_t)F.NGW * 1024) {
        f32x4 v[16];
#pragma unroll
        for (int i = 0; i < 16; ++i) v[i] = src2[base + i * 64 + F.lane];
#pragma unroll
        for (int i = 0; i < 16; ++i) acc += v[i]; }
    if (acc[0] + acc[1] + acc[2] + acc[3] == 12345.678f) p.out[0] = 1.0f;
}
#endif
constexpr int NPHASE = 11;
__global__ void __launch_bounds__(512, 2) mk_fwd(Params p) {
    extern __shared__ __attribute__((aligned(16))) unsigned char lds_raw[];
    Frame F;
    F.lds = (LAS unsigned char*)lds_raw; F.MISC = (volatile LAS unsigned*)(F.lds + MISC_OFF);
    F.wave = __builtin_amdgcn_readfirstlane((int)threadIdx.x >> 6);
#define FRESH() do { F.lane = fresh_lane(); F.tid = F.wave * 64 + F.lane; } while (0)
    FRESH();
    F.G = gridDim.x; F.gw = (int)blockIdx.x * 8 + F.wave; F.NGW = F.G * 8; F.ws = p.ws;
    for (int u = F.tid; u < (LDS_BYTES - MISC_OFF) / 4; u += 512) F.MISC[u] = 0u;
    __syncthreads();
    const int lo = p.ph_lo, hi = p.ph_hi;
    XcdBarrier bar; bar.bar = (unsigned*)(F.ws + WS_CTL) + CW_BAR; bar.x = 0; bar.st = F.MISC;
    if (hi - lo > 1) bar = xcd_barrier_post((unsigned*)(F.ws + WS_CTL) + CW_BAR, F.MISC, F.tid == 0);
#ifndef PHASE_MASK
#define PHASE_MASK 0x7ff
#endif
#define IN(k) (((PHASE_MASK >> (k)) & 1) && lo <= (k) && (k) < hi)
#define SEAM(k) do { if (IN(k) && IN((k) + 1)) xcd_barrier(bar, F.wave == 0 && fresh_lane() == 0); } while (0)
#ifndef REPEAT_MASK
#define REPEAT_MASK 0
#endif
#define REP(k) for (int rep_ = 0; rep_ < (((REPEAT_MASK >> (k)) & 1) ? 2 : 1); ++rep_)
    LAS unsigned char* ring = F.lds;
#ifdef PROBE_STREAM
    if (IN(0)) { probe_stream(F, p); }
#endif
    if (IN(0)) { REP(11) { FRESH(); p0a(F, p); } REP(12) { FRESH(); p0b(F, p); } SEAM(0); }
    if (IN(1)) REP(1) {
        pg8::Gemm g{F.ws + WS_H, F.ws + WS_WINT}; using GS = pg8::GShape<DM * 2, DM * 2, DM * 2, 0>; pg8::StaticOrder S; S.init(T, ZC, F.G, (int)blockIdx.x);
        pg8::EpiBf16 E{(bf16_t*)(F.ws + WS_Z), ZC, nullptr, 0};
        pg8::gemm_phase<pg8::EpiBf16, pg8::StaticOrder, GS, true>(ring, g, S, E, F.wave); SEAM(1); }
    if (IN(2)) REP(2) { FRESH(); p2a(F, p); SEAM(2); }
    if (IN(3)) REP(3) { FRESH(); p2b(F, p); SEAM(3); }
    if (IN(4)) REP(4) { FRESH(); p2c(F, p); SEAM(4); }
    if (IN(5)) REP(5) {
        pg8::Gemm g{F.ws + WS_MIX, F.ws + WS_WOUTT}; using GS = pg8::GShape<DM * 2, DM * 2, DM * 2, 0>; pg8::StaticOrder S; S.init(T, DM, F.G, (int)blockIdx.x);
        pg8::EpiF32Res E{(float*)(F.ws + WS_XMID), p.in[I_X], DM};
        pg8::gemm_phase<pg8::EpiF32Res, pg8::StaticOrder, GS, true>(ring, g, S, E, F.wave); SEAM(5); }
    if (IN(6)) { FRESH(); p4a(F, p); SEAM(6); }
    if (IN(7)) REP(7) { FRESH(); p4b(F, p); SEAM(7); }
    if (IN(8)) {
        FRESH(); build_moe_tables(F);
        pg8::Gemm g{F.ws + WS_ABUF, F.ws + WS_WGUT}; using GS = pg8::GShape<DM, DM, DM, (size_t)4096 * DM>;
        pg8::MoeOrder S{__builtin_amdgcn_readfirstlane((int)F.MISC[MI_NMT]), 16, F.G, (int)blockIdx.x, (const LAS int*)(F.lds + MISC_OFF + 4 * MI_T2E)};
        pg8::EpiSwiGLU8 E{F.ws + WS_ACT, DM, p.in[I_BGU]};
        pg8::gemm_phase<pg8::EpiSwiGLU8, pg8::MoeOrder, GS, true, true>(ring, g, S, E, F.wave); SEAM(8); }
#if (REPEAT_MASK & 0x100)
    if (IN(8)) {
        FRESH(); build_moe_tables(F);
        pg8::Gemm g{F.ws + WS_ABUF, F.ws + WS_WGUT}; using GS = pg8::GShape<DM, DM, DM, (size_t)4096 * DM>;
        pg8::MoeOrder S{__builtin_amdgcn_readfirstlane((int)F.MISC[MI_NMT]), 16, F.G, (int)blockIdx.x, (const LAS int*)(F.lds + MISC_OFF + 4 * MI_T2E)};
        pg8::EpiSwiGLU8 E{F.ws + WS_ACT, DM, p.in[I_BGU]};
        pg8::gemm_phase<pg8::EpiSwiGLU8, pg8::MoeOrder, GS, true, true>(ring, g, S, E, F.wave); SEAM(8); }
#endif
    if (IN(9)) {
        FRESH(); build_moe_tables(F);
        pg8::Gemm g{F.ws + WS_ACT, F.ws + WS_WDT}; using GS = pg8::GShape<DM, DM, DM, (size_t)DM * DM>;
        pg8::MoeOrder S{__builtin_amdgcn_readfirstlane((int)F.MISC[MI_NMT]), 8, F.G, (int)blockIdx.x, (const LAS int*)(F.lds + MISC_OFF + 4 * MI_T2E)};
        pg8::EpiBf16S E{(bf16_t*)(F.ws + WS_Y), DM, p.in[I_BDN], DM, 1.0f / 2048.0f};
        pg8::gemm_phase<pg8::EpiBf16S, pg8::MoeOrder, GS, true, true>(ring, g, S, E, F.wave); SEAM(9); }
#if (REPEAT_MASK & 0x200)
    if (IN(9)) {
        FRESH(); build_moe_tables(F);
        pg8::Gemm g{F.ws + WS_ACT, F.ws + WS_WDT}; using GS = pg8::GShape<DM, DM, DM, (size_t)DM * DM>;
        pg8::MoeOrder S{__builtin_amdgcn_readfirstlane((int)F.MISC[MI_NMT]), 8, F.G, (int)blockIdx.x, (const LAS int*)(F.lds + MISC_OFF + 4 * MI_T2E)};
        pg8::EpiBf16S E{(bf16_t*)(F.ws + WS_Y), DM, p.in[I_BDN], DM, 1.0f / 2048.0f};
        pg8::gemm_phase<pg8::EpiBf16S, pg8::MoeOrder, GS, true, true>(ring, g, S, E, F.wave); SEAM(9); }
#endif
    if (IN(10)) REP(10) { FRESH(); p7(F, p); if (((REPEAT_MASK >> 10) & 1)) xcd_barrier(bar, F.wave == 0 && fresh_lane() == 0); }
#undef IN
#undef SEAM
}
#ifndef STAGE
#define STAGE 4
#endif
#ifndef PER_PHASE_LAUNCH
#define PER_PHASE_LAUNCH 0
#endif

#if STAGE < 4
__global__ void adapt_z_kernel(const bf16_t* Z, float* z) {
    const long idx = (long)blockIdx.x * blockDim.x + threadIdx.x; const long t = idx / ZC; const int c = (int)(idx % ZC);
    z[t * INC + (c < 3072 ? c : c + 16)] = bf2f(Z[idx]);
}
__global__ void adapt_bf16_kernel(const bf16_t* src, float* dst) { const long idx = (long)blockIdx.x * blockDim.x + threadIdx.x; dst[idx] = bf2f(src[idx]); }
#endif

static void launch_mk(Params& a, int lo, int hi, int grid, hipStream_t stream) {
#if PER_PHASE_LAUNCH
    for (int k = lo; k < hi; ++k) { a.ph_lo = k; a.ph_hi = k + 1; hipLaunchKernelGGL(mk_fwd, dim3(grid), dim3(512), LDS_BYTES, stream, a); }
#else
    a.ph_lo = lo; a.ph_hi = hi; hipLaunchKernelGGL(mk_fwd, dim3(grid), dim3(512), LDS_BYTES, stream, a);
#endif
}

extern "C" void kernel_launch(void* const* d_in, const int* in_sizes, int n_in, void* d_out, int out_size, void* d_ws, size_t ws_size, hipStream_t stream) {
    static int grid = 0;
    if (grid == 0) {
        int dev = 0, cus = 0;
        if (hipGetDevice(&dev) != hipSuccess || hipDeviceGetAttribute(&cus, hipDeviceAttributeMultiprocessorCount, dev) != hipSuccess) { grid = -1; return; }
        if (hipFuncSetAttribute((const void*)mk_fwd, hipFuncAttributeMaxDynamicSharedMemorySize, LDS_BYTES) != hipSuccess) { grid = -1; return; }
        int per_cu = 0;
        (void)hipOccupancyMaxActiveBlocksPerMultiprocessor(&per_cu, (const void*)mk_fwd, 512, LDS_BYTES);
        (void)hipGetLastError();
        grid = cus;
        if (per_cu < 1) fprintf(stderr, "kernel_launch: occupancy query reports %d\n", per_cu);
    }
    if (grid < 0) return;
    (void)hipMemsetAsync((char*)d_ws + WS_CTL, 0, CTL_ZERO_BYTES, stream);
    Params a{};
    for (int i = 0; i < 22; ++i) a.in[i] = (const float*)d_in[i];
    a.out = (float*)d_out; a.ws = (unsigned char*)d_ws;
#if STAGE >= 4
    launch_mk(a, 0, NPHASE, grid, stream);
#else
    const float* x = a.in[I_X];
    char* ws = (char*)d_ws + WS_ABUF; size_t off = 0;
    auto alloc = [&](size_t bytes) { void* p = ws + off; off += (bytes + 255) & ~(size_t)255; return p; };
    int* counts = (int*)alloc(256);
    float* z = (float*)alloc((size_t)T * INC * 4);
    float* ogla = (float*)alloc((size_t)T * 1024 * 4);
    float* xc = (float*)alloc((size_t)T * 1024 * 4);
    float* za = (float*)alloc((size_t)T * 1024 * 4);
    float* zi = (float*)alloc((size_t)T * 1024 * 4);
    float* mix = (float*)alloc((size_t)T * DM * 4);
    float* xmid = (float*)alloc((size_t)T * DM * 4);
    float* hf = (float*)alloc((size_t)T * DM * 4);
    float* logits = (float*)alloc((size_t)T * 32 * 4);
    float* gates = (float*)alloc((size_t)T * 4 * 4);
    int* list = (int*)alloc((size_t)NEXP * T * 4);
    float* act = (float*)alloc((size_t)T * 4 * DM * 4);
    float* y = (float*)alloc((size_t)T * 4 * DM * 4);
    (void)hipMemsetAsync(counts, 0, 256, stream);
#if STAGE == 1
    launch_mk(a, 0, 2, grid, stream);
    adapt_z_kernel<<<(unsigned)((size_t)T * ZC / 256), 256, 0, stream>>>((const bf16_t*)((char*)d_ws + WS_Z), z);
    gla_naive_kernel<<<64, 256, 0, stream>>>(z, (const float*)((char*)d_ws + WS_LG), ogla);
    gla_out_kernel<<<T, 256, 0, stream>>>(ogla, z, a.in[I_GNG], mix);
    lru_conv_kernel<<<T * 1024 / 256, 256, 0, stream>>>(z, a.in[I_CW], a.in[I_CB], xc);
    for (int h = 0; h < 4; ++h) {
        GemmArgs g{}; g.A = xc + h * 256; g.lda = 1024; g.ldb = 256; g.ldc = 1024; g.M = T; g.N = 256; g.K = 256; g.a_div = 1;
        g.B = a.in[I_WA] + (size_t)h * 65536; g.C = za + h * 256;
        sgemm_kernel<0><<<dim3(2, T / 128, 1), 256, 0, stream>>>(g);
        g.B = a.in[I_WI] + (size_t)h * 65536; g.C = zi + h * 256;
        sgemm_kernel<0><<<dim3(2, T / 128, 1), 256, 0, stream>>>(g);
    }
    lru_gate_kernel<<<T * 1024 / 256, 256, 0, stream>>>(xc, za, zi, a.in[I_BA], a.in[I_BI], a.in[I_AP]);
    lru_scan_kernel<<<2048 / 64, 64, 0, stream>>>(za, zi, z, mix);
#endif
#if STAGE == 2
    launch_mk(a, 0, 5, grid, stream);
    adapt_bf16_kernel<<<(unsigned)((size_t)T * DM / 256), 256, 0, stream>>>((const bf16_t*)((char*)d_ws + WS_MIX), mix);
#endif
#if STAGE <= 2
    { GemmArgs g{}; g.A = mix; g.lda = DM; g.B = a.in[I_WOUT]; g.ldb = DM; g.C = xmid; g.ldc = DM; g.M = T; g.N = DM; g.K = DM; g.a_div = 1; g.resid = x; g.ldr = DM;
      sgemm_kernel<1><<<dim3(DM / 128, T / 128, 1), 256, 0, stream>>>(g); }
#else
    launch_mk(a, 0, 6, grid, stream);
    xmid = (float*)((char*)d_ws + WS_XMID);
#endif
    rmsnorm_kernel<<<T, 256, 0, stream>>>(xmid, a.in[I_NFG], hf);
    { GemmArgs g{}; g.A = hf; g.lda = DM; g.B = a.in[I_WR]; g.ldb = 32; g.C = logits; g.ldc = 32; g.M = T; g.N = 32; g.K = DM; g.a_div = 1; g.bias = a.in[I_BR];
      sgemm_kernel<0><<<dim3(1, T / 128, 1), 256, 0, stream>>>(g); }
    route_kernel<<<T / 256, 256, 0, stream>>>(logits, counts, list, gates);
    { GemmArgs g{}; g.A = hf; g.lda = DM; g.B = a.in[I_WGU]; g.ldb = 4096; g.C = act; g.ldc = DM; g.M = 0; g.N = 4096; g.K = DM; g.a_div = 4; g.bias = a.in[I_BGU];
      g.rowlist = list; g.count = counts; g.strideB_e = (long)DM * 4096; g.strideBias_e = 4096; g.list_stride = T;
      sgemm_kernel<2><<<dim3(2048 / 64, T / 128, NEXP), 256, 0, stream>>>(g); }
    { GemmArgs g{}; g.A = act; g.lda = DM; g.B = a.in[I_WDN]; g.ldb = DM; g.C = y; g.ldc = DM; g.M = 0; g.N = DM; g.K = DM; g.a_div = 1; g.bias = a.in[I_BDN];
      g.rowlist = list; g.count = counts; g.strideB_e = (long)DM * DM; g.strideBias_e = DM; g.list_stride = T;
      sgemm_kernel<0><<<dim3(DM / 128, T / 128, NEXP), 256, 0, stream>>>(g); }
    final_kernel<<<T, 256, 0, stream>>>(xmid, y, gates, a.in[I_NFINAL], (float*)d_out);
#endif
}
```

```cpp
#define STAGE 4
#define PER_PHASE_LAUNCH 0
#define REPEAT_MASK 0
#include <hip/hip_runtime.h>
#include <stdint.h>
#include <stdio.h>

#define GAS __attribute__((address_space(1)))
#define LAS __attribute__((address_space(3)))
typedef unsigned short bf16_t;
typedef short bf16x8 __attribute__((ext_vector_type(8)));
typedef short bf16x4 __attribute__((ext_vector_type(4)));
typedef float f32x4 __attribute__((ext_vector_type(4)));
typedef float f32x2 __attribute__((ext_vector_type(2)));
typedef float f32x16 __attribute__((ext_vector_type(16)));
typedef unsigned u32x4 __attribute__((ext_vector_type(4)));
typedef unsigned u32x2 __attribute__((ext_vector_type(2)));
typedef int i32x8 __attribute__((ext_vector_type(8)));
typedef int i32x4 __attribute__((ext_vector_type(4)));
typedef int i32x32 __attribute__((ext_vector_type(32)));

constexpr int T = 16384, SEQL = 8192, DM = 2048, INC = 5136, ZC = 5120, NEXP = 32;
constexpr int ZQ = 0, ZK = 512, ZV = 1024, ZR = 2048, ZLX = 3072, ZLG = 4096;
constexpr int MPAD_MAX = 65536 + NEXP * 256;
constexpr int NCHUNK = 256;

constexpr size_t MiB = 1u << 20;
constexpr size_t WS_CTL = 0, CTL_ZERO_BYTES = 1 * MiB;
constexpr size_t WS_WINT = 1 * MiB;
constexpr size_t WS_WOUTT = WS_WINT + 20 * MiB;
constexpr size_t WS_WGUT = WS_WOUTT + 8 * MiB;
constexpr size_t WS_WDT = WS_WGUT + 512 * MiB;
constexpr size_t WS_WAT = WS_WDT + 256 * MiB;
constexpr size_t WS_WIT = WS_WAT + 512 * 1024;
constexpr size_t WS_WRT = WS_WIT + 512 * 1024;
constexpr size_t WS_H = WS_WRT + 1 * MiB;
constexpr size_t WS_LG = WS_H + 64 * MiB;
constexpr size_t WS_Z = WS_LG + 32 * MiB;
constexpr size_t WS_AN = WS_Z + 160 * MiB;
constexpr size_t WS_DN = WS_AN + 128 * MiB;
constexpr size_t WS_SP = WS_DN + 1 * MiB;
constexpr size_t WS_AUA = WS_SP + 64 * MiB;
constexpr size_t WS_AUU = WS_AUA + 64 * MiB;
constexpr size_t WS_SUMA = WS_AUU + 64 * MiB;
constexpr size_t WS_SUMH = WS_SUMA + 1 * MiB;
constexpr size_t WS_MIX = WS_SUMH + 1 * MiB;
constexpr size_t WS_XMID = WS_MIX + 64 * MiB;
constexpr size_t WS_RSTD = WS_XMID + 128 * MiB;
constexpr size_t WS_TOKE = WS_RSTD + 1 * MiB;
constexpr size_t WS_GATES = WS_TOKE + 1 * MiB;
constexpr size_t WS_ABUF = WS_GATES + 1 * MiB;
constexpr size_t WS_ACT = WS_ABUF + 288 * MiB;
constexpr size_t WS_Y = WS_ACT + 288 * MiB;
constexpr size_t WS_END = WS_Y + 288 * MiB;
constexpr int CW_BAR = 4096;
constexpr int CW_CNT = 16384;

constexpr int RING_BYTES = 131072;
constexpr int SCR_BYTES = 135168;
constexpr int MISC_OFF = SCR_BYTES;
constexpr int LDS_BYTES = 147456;
constexpr int MI_PBASE = 16, MI_NMT = 48, MI_LCNT = 64, MI_LBASE = 96, MI_T2E = 128;

#define LDS_WAIT() asm volatile("s_waitcnt lgkmcnt(0)" ::: "memory")
#define VM_WAIT() asm volatile("s_waitcnt vmcnt(0)" ::: "memory")

__device__ __forceinline__ unsigned f2bf(float f) { unsigned u = __builtin_bit_cast(unsigned, f); return (u + 0x7fffu + ((u >> 16) & 1u)) >> 16; }
__device__ __forceinline__ unsigned pk2(float lo, float hi) { return f2bf(lo) | (f2bf(hi) << 16); }
__device__ __forceinline__ float bf2f(unsigned short b) { return __builtin_bit_cast(float, (unsigned)b << 16); }
__device__ __forceinline__ float bflo(unsigned w) { return __builtin_bit_cast(float, w << 16); }
__device__ __forceinline__ float bfhi(unsigned w) { return __builtin_bit_cast(float, w & 0xffff0000u); }
__device__ __forceinline__ float clamp448(float x) { return __builtin_amdgcn_fmed3f(x, -448.0f, 448.0f); }
__device__ __forceinline__ unsigned pk4_fp8(float a, float b, float c, float d) {
    int p = 0; p = __builtin_amdgcn_cvt_pk_fp8_f32(clamp448(a), clamp448(b), p, false); p = __builtin_amdgcn_cvt_pk_fp8_f32(clamp448(c), clamp448(d), p, true); return (unsigned)p; }
__device__ __forceinline__ float wave_sum(float v) {
#pragma unroll
    for (int o = 1; o < 64; o <<= 1) v += __shfl_xor(v, o);
    return v;
}
__device__ __forceinline__ int fresh_lane() { int l; asm volatile("v_mbcnt_lo_u32_b32 %0, -1, 0\n\tv_mbcnt_hi_u32_b32 %0, -1, %0" : "=v"(l)); return l; }
__device__ __forceinline__ float sigmoidf_(float x) { return 1.0f / (1.0f + __expf(-x)); }

#define XB_TMO      128
#define XB_XCNT(j)  (256  + 64 * (j))
#define XB_XSUB(j)  (1280 + 64 * (j))
#define XB_XGEN(j)  (2304 + 64 * (j))
#define XB_TOP      3328
#define XB_TOPGEN   3392
#define XCD_BAR_WORDS 3456
#define XB_SPIN_CAP (1u << 18)

__device__ __forceinline__ unsigned xb_ld(unsigned* p)              { return __hip_atomic_load(p, __ATOMIC_RELAXED, __HIP_MEMORY_SCOPE_AGENT); }
__device__ __forceinline__ unsigned xb_add(unsigned* p, unsigned v) { return __hip_atomic_fetch_add(p, v, __ATOMIC_RELAXED, __HIP_MEMORY_SCOPE_AGENT); }
__device__ __forceinline__ unsigned xb_xcc_id() { return (unsigned)__builtin_amdgcn_s_getreg((3 << 11) | 20) & 0xFu; }
#define XB_SPIN(cond, bar) do { unsigned _sp = 0; while (cond) { __builtin_amdgcn_s_sleep(1); \
    if ((++_sp & 255u) == 0u) { if (xb_ld(&(bar)[XB_TMO])) break; if (_sp > XB_SPIN_CAP) { atomicAdd(&(bar)[XB_TMO], 1u); break; } } } } while (0)

struct XcdBarrier { unsigned* bar; unsigned x; volatile LAS unsigned* st; };

__device__ __forceinline__ XcdBarrier xcd_barrier_post(unsigned* bar, volatile LAS unsigned* st, bool t0) {
    XcdBarrier b; b.bar = bar; b.x = xb_xcc_id(); b.st = st;
    if (t0) (void)xb_add(&bar[XB_XCNT(b.x)], 1u);
    return b;
}
__device__ __forceinline__ void xcd_barrier_complete(unsigned* bar, unsigned x, unsigned& nloc, unsigned& nx) {
    const unsigned G = gridDim.x * gridDim.y * gridDim.z;
    unsigned sum, cnt, mine, sp = 0u;
    for (;;) {
        sum = 0u; cnt = 0u; mine = 0u;
#pragma unroll
        for (unsigned j = 0; j < 16; ++j) { const unsigned c = xb_ld(&bar[XB_XCNT(j)]); sum += c; cnt += (c > 0u) ? 1u : 0u; mine = (j == x) ? c : mine; }
        if (sum == G) break;
        __builtin_amdgcn_s_sleep(1);
        if ((++sp & 255u) == 0u) { if (xb_ld(&bar[XB_TMO])) break; if (sp > XB_SPIN_CAP) { atomicAdd(&bar[XB_TMO], 1u); break; } }
    }
    nloc = mine > 0u ? mine : 1u; nx = cnt > 0u ? cnt : 1u;
}
__device__ __forceinline__ void xcd_barrier(const XcdBarrier& b, bool t0) {
    asm volatile("s_waitcnt vmcnt(0)" ::: "memory");
    __syncthreads();
    if (t0) {
        unsigned* bar = b.bar;
        __builtin_amdgcn_s_waitcnt(0);
        unsigned nloc = b.st[0], nx = b.st[1];
        if (nloc == 0u) { xcd_barrier_complete(bar, b.x, nloc, nx); b.st[0] = nloc; b.st[1] = nx; }
        const unsigned old = xb_add(&bar[XB_XSUB(b.x)], 1u);
        const unsigned gen = old / nloc;
        if (old + 1u == (gen + 1u) * nloc) {
            __builtin_amdgcn_fence(__ATOMIC_RELEASE, "agent");
            asm volatile("s_waitcnt vmcnt(0)" ::: "memory");
            const unsigned og = xb_add(&bar[XB_TOP], 1u);
            const unsigned tg = og / nx;
            if (og + 1u == (tg + 1u) * nx) xb_add(&bar[XB_TOPGEN], 1u);
            else XB_SPIN(xb_ld(&bar[XB_TOPGEN]) == tg, bar);
            __builtin_amdgcn_fence(__ATOMIC_ACQUIRE, "agent");
            xb_add(&bar[XB_XGEN(b.x)], 1u);
            asm volatile("s_waitcnt vmcnt(0)" ::: "memory");
        } else {
            XB_SPIN(xb_ld(&bar[XB_XGEN(b.x)]) == gen, bar);
            __builtin_amdgcn_fence(__ATOMIC_ACQUIRE, "agent");
            asm volatile("s_waitcnt vmcnt(0)" ::: "memory");
        }
    }
    __syncthreads();
}

namespace pg8 {
constexpr int BM = 256, BK = 64, HALF = 128, HTB = HALF * BK * 2, STAGE_BYTES = 8 * HTB, NXCD = 8, WGM = 8;
__host__ __device__ __forceinline__ int lds_byte(int r, int c) { const int st = (r >> 4) * 2 + (c >> 5), rr = r & 15, cc = c & 31, ob = rr * 64 + cc * 2; return st * 1024 + (ob ^ (((ob >> 9) & 1) << 5)); }
__host__ __device__ __forceinline__ void stage_rc(int b, int& R, int& C) { const int st = b / 1024, sb = b % 1024, swz = sb ^ (((sb >> 9) & 1) << 5); R = (st >> 1) * 16 + swz / 64; C = (st & 1) * 32 + (swz % 64) / 2; }
__host__ __device__ __forceinline__ int perm32(int rho) { const int n = rho >> 4, i = rho & 15; return 8 * (i >> 2) + 4 * n + (i & 3); }

struct Unit { int pm, pn, e; };
struct Gemm { const void* A; const void* Bt; };
template <int LDA_, int LDB_, int KB_, size_t SB_> struct GShape { static constexpr int LDA = LDA_, LDB = LDB_, KB = KB_; static constexpr size_t SB = SB_; };

__device__ __forceinline__ bool order_map(int L, int nM, int nN, int& pm, int& pn) {
    const int nwg = nM * nN; if (L >= nwg) return false;
    int wgid = L; { const int q = nwg / NXCD, r = nwg % NXCD, xcd = wgid % NXCD, off = wgid / NXCD; wgid = (xcd < r ? xcd * (q + 1) : r * (q + 1) + (xcd - r) * q) + off; }
    const int nig = WGM * nN, gid = wgid / nig, fm = gid * WGM, gsz = (nM - fm) < WGM ? (nM - fm) : WGM;
    pm = fm + ((wgid % nig) % gsz); pn = (wgid % nig) / gsz; return true;
}
struct StaticOrder {
    int nM, nN, G, c;
    __device__ void init(int M, int N, int G_, int c_) { nM = M / BM; nN = N / BM; G = G_; c = c_; }
    __device__ __forceinline__ bool next(int i, Unit& u) const { u.e = 0; return order_map(i * G + c, nM, nN, u.pm, u.pn); }
};
struct MoeOrder {
    int nM, nN, G, c; const LAS int* t2e;
    __device__ __forceinline__ bool next(int i, Unit& u) const { if (!order_map(i * G + c, nM, nN, u.pm, u.pn)) return false; u.e = __builtin_amdgcn_readfirstlane(t2e[u.pm]); return true; }
};

__device__ __forceinline__ unsigned cvt_pk_bf16(float lo, float hi) { unsigned r; asm volatile("v_cvt_pk_bf16_f32 %0, %1, %2" : "=v"(r) : "v"(lo), "v"(hi)); return r; }

struct EpiBf16 {
    static constexpr bool PERM = true;
    bf16_t* O; int ldc; const float* bias; int bias_stride;
    __device__ __forceinline__ void operator()(const f32x4 (&acc)[2][2][4][2], const Unit& u, int wr, int wc, int fr, int fq) const {
        const int row0 = u.pm * BM + wr * 64 + fr; const int col0 = u.pn * BM + wc * 32 + 8 * fq;
        f32x4 bv[2][2];
#pragma unroll
        for (int bj = 0; bj < 2; ++bj)
#pragma unroll
            for (int n = 0; n < 2; ++n) bv[bj][n] = bias ? *(const f32x4*)(bias + (size_t)u.e * bias_stride + col0 + bj * HALF + 4 * n) : (f32x4){0.f, 0.f, 0.f, 0.f};
#pragma unroll
        for (int ai = 0; ai < 2; ++ai)
#pragma unroll
            for (int m = 0; m < 4; ++m) { bf16_t* rowp = O + (size_t)(row0 + ai * HALF + m * 16) * ldc + col0;
#pragma unroll
                for (int bj = 0; bj < 2; ++bj) { const f32x4 v0 = acc[ai][bj][m][0] + bv[bj][0], v1 = acc[ai][bj][m][1] + bv[bj][1];
                    u32x4 w; w.x = cvt_pk_bf16(v0[0], v0[1]); w.y = cvt_pk_bf16(v0[2], v0[3]); w.z = cvt_pk_bf16(v1[0], v1[1]); w.w = cvt_pk_bf16(v1[2], v1[3]);
                    *(u32x4*)(rowp + bj * HALF) = w; } }
    }
};
struct EpiF32Res {
    static constexpr bool PERM = false;
    float* C; const float* resid; int ldc;
    __device__ __forceinline__ void operator()(const f32x4 (&acc)[2][2][4][2], const Unit& u, int wr, int wc, int fr, int fq) const {
        const int row0 = u.pm * BM + wr * 64 + fr, col0 = u.pn * BM + wc * 32 + 4 * fq;
#pragma unroll
        for (int ai = 0; ai < 2; ++ai)
#pragma unroll
            for (int m = 0; m < 4; ++m) { const size_t off = (size_t)(row0 + ai * HALF + m * 16) * ldc + col0;
#pragma unroll
                for (int bj = 0; bj < 2; ++bj)
#pragma unroll
                    for (int n = 0; n < 2; ++n) { const f32x4 r = *(const f32x4*)(resid + off + bj * HALF + n * 16); *(f32x4*)(C + off + bj * HALF + n * 16) = acc[ai][bj][m][n] + r; } }
    }
};
struct EpiSwiGLU {
    static constexpr bool PERM = true;
    bf16_t* O; int ldc; const float* bias;
    __device__ __forceinline__ void operator()(const f32x4 (&acc)[2][2][4][2], const Unit& u, int wr, int wc, int fr, int fq) const {
        const int row0 = u.pm * BM + wr * 64 + fr; const int j0 = u.pn * HALF + wc * 32 + 8 * fq;
        const float* be = bias + (size_t)u.e * 4096;
        f32x4 bg[2], bu[2];
#pragma unroll
        for (int n = 0; n < 2; ++n) { bg[n] = *(const f32x4*)(be + j0 + 4 * n); bu[n] = *(const f32x4*)(be + 2048 + j0 + 4 * n); }
#pragma unroll
        for (int ai = 0; ai < 2; ++ai)
#pragma unroll
            for (int m = 0; m < 4; ++m) { bf16_t* rowp = O + (size_t)(row0 + ai * HALF + m * 16) * ldc + j0;
                float o[8];
#pragma unroll
                for (int n = 0; n < 2; ++n) { const f32x4 g = acc[ai][0][m][n] + bg[n], up = acc[ai][1][m][n] + bu[n];
#pragma unroll
                    for (int q = 0; q < 4; ++q) { const float gt = fminf(g[q], 7.0f), ut = fminf(fmaxf(up[q], -7.0f), 7.0f);
                        const float glu = gt * __builtin_amdgcn_rcpf(1.0f + __expf(-1.702f * gt)); o[4 * n + q] = (ut + 1.0f) * glu; } }
                u32x4 w; w.x = cvt_pk_bf16(o[0], o[1]); w.y = cvt_pk_bf16(o[2], o[3]); w.z = cvt_pk_bf16(o[4], o[5]); w.w = cvt_pk_bf16(o[6], o[7]);
                *(u32x4*)rowp = w; }
    }
};

struct EpiSwiGLU8 {
    static constexpr bool PERM = true;
    unsigned char* O; int ldc; const float* bias;
    __device__ __forceinline__ void operator()(const f32x4 (&acc)[2][2][4][2], const Unit& u, int wr, int wc, int fr, int fq) const {
        const int row0 = u.pm * BM + wr * 64 + fr; const int j0 = u.pn * HALF + wc * 32 + 8 * fq;
        const float* be = bias + (size_t)u.e * 4096;
        f32x4 bg[2], bu[2];
#pragma unroll
        for (int n = 0; n < 2; ++n) { bg[n] = *(const f32x4*)(be + j0 + 4 * n); bu[n] = *(const f32x4*)(be + 2048 + j0 + 4 * n); }
#pragma unroll
        for (int ai = 0; ai < 2; ++ai)
#pragma unroll
            for (int m = 0; m < 4; ++m) { unsigned char* rowp = O + (size_t)(row0 + ai * HALF + m * 16) * ldc + j0;
                float o[8];
#pragma unroll
                for (int n = 0; n < 2; ++n) { const f32x4 g = acc[ai][0][m][n] * (1.0f / 8192.0f) + bg[n], up = acc[ai][1][m][n] * (1.0f / 8192.0f) + bu[n];
#pragma unroll
                    for (int q = 0; q < 4; ++q) { const float gt = fminf(g[q], 7.0f), ut = fminf(fmaxf(up[q], -7.0f), 7.0f);
                        const float glu = gt * __builtin_amdgcn_rcpf(1.0f + __expf(-1.702f * gt)); o[4 * n + q] = 4.0f * (ut + 1.0f) * glu; } }
                u32x2 w; w.x = pk4_fp8(o[0], o[1], o[2], o[3]); w.y = pk4_fp8(o[4], o[5], o[6], o[7]);
                *(u32x2*)rowp = w; }
    }
};
struct EpiBf16S {
    static constexpr bool PERM = true;
    bf16_t* O; int ldc; const float* bias; int bias_stride; float scale;
    __device__ __forceinline__ void operator()(const f32x4 (&acc)[2][2][4][2], const Unit& u, int wr, int wc, int fr, int fq) const {
        const int row0 = u.pm * BM + wr * 64 + fr; const int col0 = u.pn * BM + wc * 32 + 8 * fq;
        f32x4 bv[2][2];
#pragma unroll
        for (int bj = 0; bj < 2; ++bj)
#pragma unroll
            for (int n = 0; n < 2; ++n) bv[bj][n] = *(const f32x4*)(bias + (size_t)u.e * bias_stride + col0 + bj * HALF + 4 * n);
#pragma unroll
        for (int ai = 0; ai < 2; ++ai)
#pragma unroll
            for (int m = 0; m < 4; ++m) { bf16_t* rowp = O + (size_t)(row0 + ai * HALF + m * 16) * ldc + col0;
#pragma unroll
                for (int bj = 0; bj < 2; ++bj) { const f32x4 v0 = acc[ai][bj][m][0] * scale + bv[bj][0], v1 = acc[ai][bj][m][1] * scale + bv[bj][1];
                    u32x4 w; w.x = cvt_pk_bf16(v0[0], v0[1]); w.y = cvt_pk_bf16(v0[2], v0[3]); w.z = cvt_pk_bf16(v1[0], v1[1]); w.w = cvt_pk_bf16(v1[2], v1[3]);
                    *(u32x4*)(rowp + bj * HALF) = w; } }
    }
};

__device__ __forceinline__ i32x8 pg8_get8(const i32x32& v, int idx) { i32x8 r;
#pragma unroll
    for (int j = 0; j < 8; ++j) r[j] = v[8 * idx + j];
    return r; }
__device__ __forceinline__ i32x4 pg8_get4(const i32x32& v, int idx) { i32x4 r;
#pragma unroll
    for (int j = 0; j < 4; ++j) r[j] = v[4 * idx + j];
    return r; }
template <class Epi, class Sched, class GS, bool ALIGN_EPI = true, bool F8 = false>
__device__ __forceinline__ void gemm_phase(LAS unsigned char* lds, const Gemm g, const Sched& S, const Epi& E, int wave) {
    const int wid = wave, lane = fresh_lane(), tid = wid * 64 + lane, wr = wid >> 2, wc = wid & 3, fr = lane & 15, fq = lane >> 4;
    constexpr int nt = GS::KB / 128;
    unsigned voffA, voffB;
    { int R, C; stage_rc(tid * 16, R, C); const int Rb = Epi::PERM ? ((R & ~31) + perm32(R & 31)) : R;
      voffA = (unsigned)(R * GS::LDA + C * 2); voffB = (unsigned)(Rb * GS::LDB + C * 2); }
    constexpr size_t pstepA = (size_t)64 * GS::LDA, pstepB = (size_t)64 * GS::LDB;
    constexpr size_t kstep = (size_t)(BK * 2);
    constexpr size_t hstepA = (size_t)HALF * GS::LDA, hstepB = (size_t)HALF * GS::LDB;
    constexpr size_t tstepA = 2 * hstepA, tstepB = 2 * hstepB;
    const unsigned ldsw = (unsigned)wid * 1024u;
    const int aoff = lds_byte(wr * 64 + fr, F8 ? fq * 16 : fq * 8), boff = lds_byte(wc * 32 + fr, F8 ? fq * 16 : fq * 8);
    const int kofs = F8 ? 16 : 1024;
#define PG8_SA(b, h) (((b) * 2 + (h)) * HTB)
#define PG8_SB(b, h) ((4 + (b) * 2 + (h)) * HTB)
#define PG8_STAGE(bufoff, gbase, voff) do { _Pragma("unroll") for (int _i = 0; _i < 2; ++_i) \
        __builtin_amdgcn_global_load_lds((const unsigned*)((const char*)(gbase) + _i * pstep##voff + (voff##_v)), (LAS unsigned*)(lds + (bufoff) + ldsw + _i * 8192), 16, 0, 0); } while (0)
#define pstepvoffA pstepA
#define pstepvoffB pstepB
#define voffA_v voffA
#define voffB_v voffB
#define PG8_LD16(p) (*(const LAS i32x4*)(p))
#define PG8_SET8(V, idx, lo, hi) do { _Pragma("unroll") for (int _j = 0; _j < 4; ++_j) { V[8 * (idx) + _j] = (lo)[_j]; V[8 * (idx) + 4 + _j] = (hi)[_j]; } } while (0)
#define PG8_GET8(V, idx) pg8_get8(V, idx)
#define PG8_GETLO(V, idx) __builtin_bit_cast(bf16x8, pg8_get4(V, 2 * (idx)))
#define PG8_GETHI(V, idx) __builtin_bit_cast(bf16x8, pg8_get4(V, 2 * (idx) + 1))
#define PG8_LDA(dst, b, h) do { _Pragma("unroll") for (int m = 0; m < 4; ++m) { const i32x4 _lo = PG8_LD16(lds + PG8_SA(b, h) + aoff + m * 2048), _hi = PG8_LD16(lds + PG8_SA(b, h) + aoff + m * 2048 + kofs); \
        PG8_SET8(AV, m, _lo, _hi); } } while (0)
#define PG8_LDB(dst, b, h) do { _Pragma("unroll") for (int n = 0; n < 2; ++n) { const i32x4 _lo = PG8_LD16(lds + PG8_SB(b, h) + boff + n * 2048), _hi = PG8_LD16(lds + PG8_SB(b, h) + boff + n * 2048 + kofs); \
        PG8_SET8(BV, (dst) + n, _lo, _hi); } } while (0)
#define PG8_MMA(ai, bj, At, Bt) do { __builtin_amdgcn_s_setprio(1); \
        if constexpr (F8) { _Pragma("unroll") for (int m = 0; m < 4; ++m) _Pragma("unroll") for (int n = 0; n < 2; ++n) \
            acc[ai][bj][m][n] = __builtin_amdgcn_mfma_scale_f32_16x16x128_f8f6f4(PG8_GET8(BV, (Bt) + n), PG8_GET8(AV, m), acc[ai][bj][m][n], 0, 0, 0, 0, 0, 0); } \
        else { _Pragma("unroll") for (int m = 0; m < 4; ++m) _Pragma("unroll") for (int n = 0; n < 2; ++n) { \
            acc[ai][bj][m][n] = __builtin_amdgcn_mfma_f32_16x16x32_bf16(PG8_GETLO(BV, (Bt) + n), PG8_GETLO(AV, m), acc[ai][bj][m][n], 0, 0, 0); \
            acc[ai][bj][m][n] = __builtin_amdgcn_mfma_f32_16x16x32_bf16(PG8_GETHI(BV, (Bt) + n), PG8_GETHI(AV, m), acc[ai][bj][m][n], 0, 0, 0); } } \
        __builtin_amdgcn_s_setprio(0); } while (0)
#define PG8_WAIT_V(n) asm volatile("s_waitcnt vmcnt(" #n ")" ::: "memory")
#define PG8_WAIT_L(n) asm volatile("s_waitcnt lgkmcnt(" #n ")" ::: "memory")
#define PG8_BAR __builtin_amdgcn_s_barrier()
#define PG8_SCHED __builtin_amdgcn_sched_barrier(0)
    Unit cur, nxt; int ui = 0;
    if (!S.next(0, cur)) return;
    i32x32 AV, BV;
    constexpr int At = 0, B0 = 0, B1 = 2;
    const char* cA = (const char*)g.A + (size_t)cur.pm * tstepA; const char* cB = (const char*)g.Bt + (size_t)cur.e * GS::SB + (size_t)cur.pn * tstepB;
    PG8_STAGE(PG8_SB(0, 0), cB, voffB); PG8_SCHED; PG8_STAGE(PG8_SB(0, 1), cB + hstepB, voffB); PG8_SCHED; PG8_STAGE(PG8_SA(0, 0), cA, voffA); PG8_SCHED; PG8_STAGE(PG8_SA(0, 1), cA + hstepA, voffA); PG8_SCHED;
    if (wr == 1) PG8_BAR;
    PG8_WAIT_V(2); PG8_BAR;
    PG8_STAGE(PG8_SB(1, 0), cB + kstep, voffB); PG8_SCHED; PG8_STAGE(PG8_SA(1, 0), cA + kstep, voffA); PG8_SCHED; PG8_STAGE(PG8_SB(1, 1), cB + hstepB + kstep, voffB); PG8_SCHED;
    PG8_WAIT_V(6); PG8_BAR; PG8_SCHED;
    f32x4 acc[2][2][4][2];
#pragma unroll
    for (int a = 0; a < 2; ++a)
#pragma unroll
        for (int b = 0; b < 2; ++b)
#pragma unroll
            for (int m = 0; m < 4; ++m)
#pragma unroll
                for (int n = 0; n < 2; ++n) acc[a][b][m][n] = (f32x4){0.f, 0.f, 0.f, 0.f};
    for (;;) {
        const bool has_next = S.next(ui + 1, nxt);
        const char* nA = has_next ? (const char*)g.A + (size_t)nxt.pm * tstepA : cA;
        const char* nB = has_next ? (const char*)g.Bt + (size_t)nxt.e * GS::SB + (size_t)nxt.pn * tstepB : cB;
        for (int t = 0; t < nt; t += 2) {
            const bool last = (t == nt - 2);
            const char* a1 = cA + (size_t)(t + 1) * kstep;
            const char* a2 = last ? nA : cA + (size_t)(t + 2) * kstep; const char* b2 = last ? nB : cB + (size_t)(t + 2) * kstep;
            const char* a3 = a2 + kstep; const char* b3 = b2 + kstep;
            PG8_LDB(B0, 0, 0); PG8_LDB(B1, 0, 1); PG8_SCHED; PG8_LDA(At, 0, 0); PG8_STAGE(PG8_SA(1, 1), a1 + hstepA, voffA);
            PG8_WAIT_V(8); PG8_WAIT_L(0); PG8_BAR; PG8_MMA(0, 0, At, B0); PG8_MMA(0, 1, At, B1); PG8_BAR; PG8_SCHED;
            PG8_LDA(At, 0, 1); PG8_STAGE(PG8_SB(0, 0), b2, voffB); PG8_STAGE(PG8_SB(0, 1), b2 + hstepB, voffB); PG8_STAGE(PG8_SA(0, 0), a2, voffA);
            PG8_WAIT_V(8); PG8_WAIT_L(0); PG8_BAR; PG8_MMA(1, 0, At, B0); PG8_MMA(1, 1, At, B1); PG8_BAR; PG8_SCHED;
            PG8_LDB(B0, 1, 0); PG8_LDB(B1, 1, 1); PG8_SCHED; PG8_LDA(At, 1, 0); PG8_STAGE(PG8_SA(0, 1), a2 + hstepA, voffA);
            PG8_WAIT_V(8); PG8_WAIT_L(0); PG8_BAR; PG8_MMA(0, 0, At, B0); PG8_MMA(0, 1, At, B1); PG8_BAR; PG8_SCHED;
            PG8_LDA(At, 1, 1); PG8_STAGE(PG8_SB(1, 0), b3, voffB); PG8_STAGE(PG8_SB(1, 1), b3 + hstepB, voffB); PG8_STAGE(PG8_SA(1, 0), a3, voffA);
            PG8_WAIT_V(8); PG8_WAIT_L(0); PG8_BAR; PG8_MMA(1, 0, At, B0); PG8_MMA(1, 1, At, B1); PG8_BAR; PG8_SCHED;
        }
        if constexpr (ALIGN_EPI) { if (wr == 0) PG8_BAR; }
        { const int l2 = fresh_lane();
          E(acc, cur, wr, wc, l2 & 15, l2 >> 4); }
        if (!has_next) break;
#pragma unroll
        for (int a = 0; a < 2; ++a)
#pragma unroll
            for (int b = 0; b < 2; ++b)
#pragma unroll
                for (int m = 0; m < 4; ++m)
#pragma unroll
                    for (int n = 0; n < 2; ++n) acc[a][b][m][n] = (f32x4){0.f, 0.f, 0.f, 0.f};
        cur = nxt; cA = nA; cB = nB; ++ui;
        if constexpr (ALIGN_EPI) { if (wr == 1) PG8_BAR; }
    }
    PG8_WAIT_V(0);
    if constexpr (!ALIGN_EPI) { if (wr == 0) PG8_BAR; }
    PG8_BAR;
#undef PG8_SA
#undef PG8_SB
#undef PG8_STAGE
#undef pstepvoffA
#undef pstepvoffB
#undef voffA_v
#undef voffB_v
#undef PG8_LDA
#undef PG8_LD16
#undef PG8_SET8
#undef PG8_GET8
#undef PG8_GETLO
#undef PG8_GETHI
#undef PG8_LDB
#undef PG8_MMA
#undef PG8_WAIT_V
#undef PG8_WAIT_L
#undef PG8_BAR
#undef PG8_SCHED
}
}
struct Params {
    const float* in[22];
    float* out; unsigned char* ws;
    int ph_lo, ph_hi;
};
enum { I_X = 0, I_NMG, I_WIN, I_GWG, I_GBG, I_GNG, I_CW, I_CB, I_WA, I_BA, I_WI, I_BI, I_AP, I_WOUT, I_NFG, I_WR, I_BR, I_WGU, I_BGU, I_WDN, I_BDN, I_NFINAL };

struct Frame {
    LAS unsigned char* lds; volatile LAS unsigned* MISC;
    int tid, lane, wave, G, gw, NGW;
    unsigned char* ws;
};

__device__ __forceinline__ float gelu_tanh_f(float x) {
    const float u = 0.7978845608028654f * (x + 0.044715f * x * x * x);
    const float e = __expf(2.0f * u);
    const float th = 1.0f - 2.0f * __builtin_amdgcn_rcpf(e + 1.0f);
    return 0.5f * x * (1.0f + th);
}
__device__ __forceinline__ float log_sigmoid_f(float s) { return fminf(s, 0.f) - log1pf(__expf(-fabsf(s))); }

__device__ __forceinline__ void p0_item(const float* W, int ldw, int col0, bf16_t* WT, int ldt, size_t drow0, int k0, LAS float* scr, int lane) {
    (void)scr;
    const float* src = W + (size_t)k0 * ldw + col0 + lane;
    float v[64];
#pragma unroll
    for (int i = 0; i < 64; ++i) v[i] = src[(size_t)i * ldw];
    bf16_t* dst = WT + (drow0 + lane) * (size_t)ldt + k0;
#pragma unroll
    for (int c = 0; c < 8; ++c) { u32x4 o; o.x = pk2(v[8 * c], v[8 * c + 1]); o.y = pk2(v[8 * c + 2], v[8 * c + 3]); o.z = pk2(v[8 * c + 4], v[8 * c + 5]); o.w = pk2(v[8 * c + 6], v[8 * c + 7]);
        *(u32x4*)(dst + 8 * c) = o; }
}

__device__ __forceinline__ void p0_item8(const float* W, int ldw, int col0, unsigned char* WT, int ldt, size_t drow0, int k0, int lane) {
    const float* src = W + (size_t)k0 * ldw + col0 + lane;
    float v[64];
#pragma unroll
    for (int i = 0; i < 64; ++i) v[i] = src[(size_t)i * ldw];
    unsigned char* dst = WT + (drow0 + lane) * (size_t)ldt + k0;
#pragma unroll
    for (int c = 0; c < 4; ++c) { u32x4 o;
#pragma unroll
        for (int q = 0; q < 4; ++q) o[q] = pk4_fp8(v[16 * c + 4 * q] * 512.0f, v[16 * c + 4 * q + 1] * 512.0f, v[16 * c + 4 * q + 2] * 512.0f, v[16 * c + 4 * q + 3] * 512.0f);
        *(u32x4*)(dst + 16 * c) = o; }
}

struct CoopTile { const float* W; int ldw; int col0; unsigned char* WT; int ldt_b; int mode; int k0; int gu; int drow0; };
__device__ __forceinline__ void coop_load(const CoopTile& t, int w, int l, f32x4 (&v)[16]) {
    if (t.mode == 0) {
#pragma unroll
        for (int i = 0; i < 8; ++i) { const float* r = t.W + (size_t)(t.k0 + 8 * w + i) * t.ldw + t.col0 + 4 * l; v[2 * i] = *(const f32x4*)r; v[2 * i + 1] = *(const f32x4*)(r + 256); }
    } else {
#pragma unroll
        for (int i = 0; i < 16; ++i) v[i] = *(const f32x4*)(t.W + (size_t)(t.k0 + 16 * w + i) * t.ldw + t.col0 + 4 * l);
    }
}
__device__ __forceinline__ void coop_to_lds(const CoopTile& t, int w, int l, const f32x4 (&v)[16], LAS unsigned char* buf) {
    const int sw = (w ^ (l & 7)) * 16;
    if (t.mode == 0) {
#pragma unroll
        for (int jp = 0; jp < 2; ++jp)
#pragma unroll
            for (int j = 0; j < 4; ++j) { u32x4 o; o.x = pk2(v[0 + jp][j], v[2 + jp][j]); o.y = pk2(v[4 + jp][j], v[6 + jp][j]); o.z = pk2(v[8 + jp][j], v[10 + jp][j]); o.w = pk2(v[12 + jp][j], v[14 + jp][j]);
                *(LAS u32x4*)(buf + (256 * jp + 4 * l + j) * 128 + sw) = o; }
    } else {
#pragma unroll
        for (int j = 0; j < 4; ++j) { u32x4 o;
#pragma unroll
            for (int q = 0; q < 4; ++q) o[q] = pk4_fp8(v[4 * q][j] * 512.0f, v[4 * q + 1][j] * 512.0f, v[4 * q + 2][j] * 512.0f, v[4 * q + 3][j] * 512.0f);
            *(LAS u32x4*)(buf + (4 * l + j) * 128 + sw) = o; }
    }
}
__device__ __forceinline__ void coop_store(const CoopTile& t, int w, int l, const LAS unsigned char* buf) {
    const int nrows = t.mode == 0 ? 512 : 256; const int cp = l & 7;
    for (int n = 8 * w + (l >> 3); n < nrows; n += 64) {
        const u32x4 o = *(const LAS u32x4*)(buf + n * 128 + cp * 16); const int c = cp ^ ((n >> 2) & 7);
        int drow;
        if (t.gu) { const int g = t.col0 + n; drow = (g < 2048) ? (256 * (g >> 7) + (g & 127)) : (256 * ((g - 2048) >> 7) + 128 + ((g - 2048) & 127)); } else drow = t.drow0 + n;
        *(u32x4*)(t.WT + (size_t)drow * t.ldt_b + (t.mode == 0 ? 2 * t.k0 : t.k0) + 16 * c) = o; }
}
__device__ __forceinline__ bool coop_tile(const Params& p, unsigned char* ws, int it, CoopTile& t) {
    constexpr int N_GU = 32 * 256, N_DN = 32 * 128, N_INA = 32 * 6, N_INB = 32 * 4, N_OUT = 32 * 4;
    int r = it;
    if (r < N_GU) { const int e = r >> 8, q = r & 255, kb = q >> 4, nb = q & 15; t = CoopTile{p.in[I_WGU] + (size_t)e * DM * 4096, 4096, 256 * nb, ws + WS_WGUT + (size_t)e * 4096 * DM, DM, 1, 128 * kb, 1, 0}; return true; } r -= N_GU;
    if (r < N_DN) { const int e = r >> 7, q = r & 127, kb = q >> 3, nb = q & 7; t = CoopTile{p.in[I_WDN] + (size_t)e * DM * DM, DM, 256 * nb, ws + WS_WDT + (size_t)e * DM * DM, DM, 1, 128 * kb, 0, 256 * nb}; return true; } r -= N_DN;
    if (r < N_INA) { const int kb = r / 6, nb = r % 6; t = CoopTile{p.in[I_WIN], INC, 512 * nb, ws + WS_WINT, DM * 2, 0, 64 * kb, 0, 512 * nb}; return true; } r -= N_INA;
    if (r < N_INB) { const int kb = r >> 2, nb = r & 3; t = CoopTile{p.in[I_WIN], INC, 3088 + 512 * nb, ws + WS_WINT, DM * 2, 0, 64 * kb, 0, 3072 + 512 * nb}; return true; } r -= N_INB;
    if (r < N_OUT) { const int kb = r >> 2, nb = r & 3; t = CoopTile{p.in[I_WOUT], DM, 512 * nb, ws + WS_WOUTT, DM * 2, 0, 64 * kb, 0, 512 * nb}; return true; }
    return false;
}
__device__ __forceinline__ void p0a(Frame& F, const Params& p) {
    const int w = F.wave, l = F.lane;
    CoopTile cur, nxt; f32x4 v[16];
    int it = blockIdx.x; bool have = coop_tile(p, F.ws, it, cur);
    if (have) coop_load(cur, w, l, v);
    int par = 0;
    while (have) {
        LAS unsigned char* buf = F.lds + par * 65536;
        coop_to_lds(cur, w, l, v, buf);
        it += F.G; const bool hn = coop_tile(p, F.ws, it, nxt);
        if (hn) coop_load(nxt, w, l, v);
        __syncthreads();
        coop_store(cur, w, l, buf);
        cur = nxt; have = hn; par ^= 1;
    }
    __syncthreads();
    { bf16_t* WaT = (bf16_t*)(F.ws + WS_WAT); bf16_t* WiT = (bf16_t*)(F.ws + WS_WIT);
      for (int r = F.gw; r < 128; r += F.NGW) { const int which = r >> 6, h = (r >> 4) & 3, kb = (r >> 2) & 3, nb = r & 3;
          p0_item((which ? p.in[I_WI] : p.in[I_WA]) + (size_t)h * 65536, 256, 64 * nb, (which ? WiT : WaT) + (size_t)h * 65536, 256, (size_t)64 * nb, 64 * kb, nullptr, F.lane); } }
    { float* WrT = (float*)(F.ws + WS_WRT); const float* wr = p.in[I_WR]; const float* gf = p.in[I_NFG];
      for (int idx = (int)blockIdx.x * 512 + F.tid; idx < 32 * DM; idx += F.G * 512) { const int n = idx >> 11, k = idx & 2047; WrT[idx] = wr[k * 32 + n] * gf[k]; } }
}
__device__ __forceinline__ void p0b(Frame& F, const Params& p) {
    const float* w_in = p.in[I_WIN];
    __syncthreads();
    { LAS f32x4* Wl = (LAS f32x4*)F.lds;
      for (int idx = F.tid; idx < 8192; idx += 512) { const int l = idx & 63, i = (idx >> 6) & 3, j = (idx >> 8) & 7, c4 = idx >> 11; const int k = 4 * l + 256 * j + i;
          Wl[idx] = *(const f32x4*)(w_in + (size_t)k * INC + 3072 + 4 * c4); }
      __syncthreads();
      const float* x = p.in[I_X]; const float* g1 = p.in[I_NMG]; const float* wg = p.in[I_GWG]; const float* bgp = p.in[I_GBG];
      bf16_t* H = (bf16_t*)(F.ws + WS_H); float* LG = (float*)(F.ws + WS_LG);
      const int l = F.lane;
      f32x4 xn[2][8];
#pragma unroll
      for (int r = 0; r < 2; ++r)
#pragma unroll
          for (int j = 0; j < 8; ++j) xn[r][j] = (2 * F.gw < T) ? *(const f32x4*)(x + (size_t)(2 * F.gw + r) * DM + 4 * l + 256 * j) : (f32x4){0.f, 0.f, 0.f, 0.f};
      for (int q = F.gw; 2 * q < T; q += F.NGW) {
          const int m = 2 * q;
          f32x4 xv[2][8]; float ss[2] = {0.f, 0.f};
#pragma unroll
          for (int r = 0; r < 2; ++r)
#pragma unroll
              for (int j = 0; j < 8; ++j) { xv[r][j] = xn[r][j]; ss[r] += (xv[r][j][0] * xv[r][j][0] + xv[r][j][1] * xv[r][j][1]) + (xv[r][j][2] * xv[r][j][2] + xv[r][j][3] * xv[r][j][3]); }
          if (2 * (q + F.NGW) < T) {
#pragma unroll
              for (int r = 0; r < 2; ++r)
#pragma unroll
                  for (int j = 0; j < 8; ++j) xn[r][j] = *(const f32x4*)(x + (size_t)(2 * (q + F.NGW) + r) * DM + 4 * l + 256 * j); }
          float rs[2];
#pragma unroll
          for (int r = 0; r < 2; ++r) rs[r] = 1.0f / sqrtf(wave_sum(ss[r]) * (1.0f / DM) + 1e-6f);
          float acc[2][16];
#pragma unroll
          for (int r = 0; r < 2; ++r)
#pragma unroll
              for (int c = 0; c < 16; ++c) acc[r][c] = 0.f;
#pragma unroll
          for (int j = 0; j < 8; ++j) { __builtin_amdgcn_sched_barrier(0); const f32x4 gv = *(const f32x4*)(g1 + 4 * l + 256 * j);
#pragma unroll
              for (int r = 0; r < 2; ++r) { xv[r][j] = xv[r][j] * rs[r] * gv;
                  u32x2 o; o.x = pk2(xv[r][j][0], xv[r][j][1]); o.y = pk2(xv[r][j][2], xv[r][j][3]); *(u32x2*)(H + (size_t)(m + r) * DM + 4 * l + 256 * j) = o; }
#pragma unroll
              for (int i = 0; i < 4; ++i)
#pragma unroll
                  for (int c4 = 0; c4 < 4; ++c4) { const f32x4 wv = Wl[((c4 * 8 + j) * 4 + i) * 64 + l];
#pragma unroll
                      for (int r = 0; r < 2; ++r) { acc[r][4 * c4 + 0] += xv[r][j][i] * wv[0]; acc[r][4 * c4 + 1] += xv[r][j][i] * wv[1]; acc[r][4 * c4 + 2] += xv[r][j][i] * wv[2]; acc[r][4 * c4 + 3] += xv[r][j][i] * wv[3]; } } }
#pragma unroll
          for (int r = 0; r < 2; ++r)
#pragma unroll
              for (int c = 0; c < 16; ++c) acc[r][c] = wave_sum(acc[r][c]);
          f32x4 s0[2], s1[2];
#pragma unroll
          for (int r = 0; r < 2; ++r) { s0[r] = *(const f32x4*)(bgp + 8 * l); s1[r] = *(const f32x4*)(bgp + 8 * l + 4); }
#pragma unroll
          for (int jj = 0; jj < 16; ++jj) { const f32x4 w0 = *(const f32x4*)(wg + jj * 512 + 8 * l), w1 = *(const f32x4*)(wg + jj * 512 + 8 * l + 4);
#pragma unroll
              for (int r = 0; r < 2; ++r) { s0[r] += acc[r][jj] * w0; s1[r] += acc[r][jj] * w1; } }
#pragma unroll
          for (int r = 0; r < 2; ++r) { f32x4 o0, o1;
#pragma unroll
              for (int qq = 0; qq < 4; ++qq) { o0[qq] = log_sigmoid_f(s0[r][qq]) * 0.0625f; o1[qq] = log_sigmoid_f(s1[r][qq]) * 0.0625f; }
              *(f32x4*)(LG + (size_t)(m + r) * 512 + 8 * l) = o0; *(f32x4*)(LG + (size_t)(m + r) * 512 + 8 * l + 4) = o1; }
      }
    }
    __syncthreads();
}

__device__ __forceinline__ void gla_cumsum(const float* LG, int tok0, int h, LAS float* BC, LAS float* SEG, int tid) {
    const int seg = tid >> 7, kk = tid & 127;
    float v[16];
#pragma unroll
    for (int i = 0; i < 16; ++i) v[i] = LG[(size_t)(tok0 + 16 * seg + i) * 512 + h * 128 + kk];
#pragma unroll
    for (int i = 1; i < 16; ++i) v[i] += v[i - 1];
    SEG[seg * 128 + kk] = v[15];
    __syncthreads();
    float off = 0.f;
#pragma unroll
    for (int s = 0; s < 3; ++s) off += (s < seg) ? SEG[s * 128 + kk] : 0.f;
#pragma unroll
    for (int i = 0; i < 16; ++i) BC[(16 * seg + i) * 128 + kk] = v[i] + off;
    __syncthreads();
}
__device__ __forceinline__ bf16x8 as_bf16x8(u32x4 v) { return __builtin_bit_cast(bf16x8, v); }
__device__ __forceinline__ bf16x8 cat4(bf16x4 lo, bf16x4 hi) { return __builtin_shufflevector(lo, hi, 0, 1, 2, 3, 4, 5, 6, 7); }

__device__ __forceinline__ void p2a(Frame& F, const Params& p) {
    const bf16_t* Z = (const bf16_t*)(F.ws + WS_Z); const float* LG = (const float*)(F.ws + WS_LG);
    float* AN = (float*)(F.ws + WS_AN); float* DN = (float*)(F.ws + WS_DN); float* AUA = (float*)(F.ws + WS_AUA); float* AUU = (float*)(F.ws + WS_AUU);
    const bf16_t* WaT = (const bf16_t*)(F.ws + WS_WAT); const bf16_t* WiT = (const bf16_t*)(F.ws + WS_WIT);
    LAS float* BC = (LAS float*)(F.lds); LAS float* SEG = (LAS float*)(F.lds + 32768);
    LAS bf16_t* KDT = (LAS bf16_t*)(F.lds + 34816); LAS bf16_t* VT = (LAS bf16_t*)(F.lds + 53248); LAS bf16_t* XC = (LAS bf16_t*)(F.lds + 90112);
    const int w = F.wave;
    for (int unit = blockIdx.x; unit < NCHUNK; unit += F.G) {
        const int b = unit >> 7, n = unit & 127, tok0 = b * SEQL + 64 * n;
        for (int h = 0; h < 4; ++h) {
            int lane = fresh_lane(), tid = F.wave * 64 + lane;
            int r = lane & 31, hh = lane >> 5;
            gla_cumsum(LG, tok0, h, BC, SEG, tid);
            const int uh = (b * 4 + h) * 128 + n;
            if (tid < 128) DN[(size_t)uh * 128 + tid] = __expf(BC[63 * 128 + tid]);
#pragma unroll
            for (int it = 0; it < 2; ++it) { const int item = tid + 512 * it, t = item & 63, kk8 = item >> 6;
                const u32x4 kv = *(const u32x4*)(Z + (size_t)(tok0 + t) * ZC + ZK + h * 128 + kk8 * 8);
#pragma unroll
                for (int i = 0; i < 8; ++i) { const int kk = kk8 * 8 + i; const unsigned wv = kv[i >> 1]; const float kf = (i & 1) ? bfhi(wv) : bflo(wv);
                    const float d = __expf(BC[63 * 128 + kk] - BC[t * 128 + kk]); KDT[kk * 72 + t] = (bf16_t)f2bf(kf * d); } }
#pragma unroll
            for (int it = 0; it < 4; ++it) { const int item = tid + 512 * it, t = item & 63, vc8 = item >> 6;
                const u32x4 vv = *(const u32x4*)(Z + (size_t)(tok0 + t) * ZC + ZV + h * 256 + vc8 * 8);
#pragma unroll
                for (int i = 0; i < 8; ++i) { const unsigned wv = vv[i >> 1]; VT[(vc8 * 8 + i) * 72 + t] = (bf16_t)((i & 1) ? (wv >> 16) : (wv & 0xffffu)); } }
            __syncthreads();
            {
                f32x16 acc[4];
#pragma unroll
                for (int mb = 0; mb < 4; ++mb)
#pragma unroll
                    for (int q = 0; q < 16; ++q) acc[mb][q] = 0.f;
#pragma unroll
                for (int s = 0; s < 4; ++s) { const bf16x8 bfr = *(const LAS bf16x8*)(VT + (32 * w + r) * 72 + 16 * s + 8 * hh);
#pragma unroll
                    for (int mb = 0; mb < 4; ++mb) { const bf16x8 afr = *(const LAS bf16x8*)(KDT + (32 * mb + r) * 72 + 16 * s + 8 * hh);
                        acc[mb] = __builtin_amdgcn_mfma_f32_32x32x16_bf16(afr, bfr, acc[mb], 0, 0, 0); } }
                float* base = AN + (size_t)uh * 32768;
#pragma unroll
                for (int mb = 0; mb < 4; ++mb)
#pragma unroll
                    for (int g = 0; g < 4; ++g) *(f32x4*)(base + (((mb * 8 + w) * 4 + g) * 64 + lane) * 4) = (f32x4){acc[mb][4 * g], acc[mb][4 * g + 1], acc[mb][4 * g + 2], acc[mb][4 * g + 3]};
            }
#ifndef P2A_NO_LRU
            {
                lane = fresh_lane(); tid = F.wave * 64 + lane; r = lane & 31; hh = lane >> 5;
                const float* cw = p.in[I_CW]; const float* cb = p.in[I_CB];
                {
                    const int c8 = tid & 31, tq = tid >> 5, chc = h * 256 + c8 * 8;
                    u32x4 lv[7];
#pragma unroll
                    for (int i = 0; i < 7; ++i) { const int s = 64 * n + 4 * tq - 3 + i;
                        lv[i] = (s >= 0) ? *(const u32x4*)(Z + (size_t)(tok0 + 4 * tq - 3 + i) * ZC + ZLX + chc) : (u32x4){0u, 0u, 0u, 0u}; }
                    f32x4 wv[4][2], bv[2];
#pragma unroll
                    for (int i = 0; i < 4; ++i) { wv[i][0] = *(const f32x4*)(cw + i * 1024 + chc); wv[i][1] = *(const f32x4*)(cw + i * 1024 + chc + 4); }
                    bv[0] = *(const f32x4*)(cb + chc); bv[1] = *(const f32x4*)(cb + chc + 4);
#pragma unroll
                    for (int it = 0; it < 4; ++it) { float xc[8];
#pragma unroll
                        for (int q = 0; q < 4; ++q) { xc[q] = bv[0][q]; xc[4 + q] = bv[1][q]; }
#pragma unroll
                        for (int i = 0; i < 4; ++i) { const u32x4 l4 = lv[it + i];
                            xc[0] += bflo(l4[0]) * wv[i][0][0]; xc[1] += bfhi(l4[0]) * wv[i][0][1]; xc[2] += bflo(l4[1]) * wv[i][0][2]; xc[3] += bfhi(l4[1]) * wv[i][0][3];
                            xc[4] += bflo(l4[2]) * wv[i][1][0]; xc[5] += bfhi(l4[2]) * wv[i][1][1]; xc[6] += bflo(l4[3]) * wv[i][1][2]; xc[7] += bfhi(l4[3]) * wv[i][1][3]; }
                        u32x4 o; o.x = pk2(xc[0], xc[1]); o.y = pk2(xc[2], xc[3]); o.z = pk2(xc[4], xc[5]); o.w = pk2(xc[6], xc[7]);
                        *(LAS u32x4*)(XC + (4 * tq + it) * 264 + c8 * 8) = o; }
                }
                __builtin_amdgcn_sched_barrier(0);
                bf16x8 ba[16], bi[16];
                { const bf16_t* wa = WaT + (size_t)h * 65536 + (size_t)(32 * w + r) * 256 + 8 * hh;
                  const bf16_t* wi = WiT + (size_t)h * 65536 + (size_t)(32 * w + r) * 256 + 8 * hh;
#pragma unroll
                  for (int s = 0; s < 16; ++s) { ba[s] = *(const bf16x8*)(wa + 16 * s); bi[s] = *(const bf16x8*)(wi + 16 * s); } }
                __syncthreads();
                f32x16 aa[2], ai[2];
#pragma unroll
                for (int mb = 0; mb < 2; ++mb)
#pragma unroll
                    for (int q = 0; q < 16; ++q) { aa[mb][q] = 0.f; ai[mb][q] = 0.f; }
#pragma unroll
                for (int s = 0; s < 16; ++s) {
#pragma unroll
                    for (int mb = 0; mb < 2; ++mb) { const bf16x8 af = *(const LAS bf16x8*)(XC + (32 * mb + r) * 264 + 16 * s + 8 * hh);
                        aa[mb] = __builtin_amdgcn_mfma_f32_32x32x16_bf16(af, ba[s], aa[mb], 0, 0, 0); } }
                __builtin_amdgcn_sched_barrier(0);
#pragma unroll
                for (int s = 0; s < 16; ++s) {
#pragma unroll
                    for (int mb = 0; mb < 2; ++mb) { const bf16x8 af = *(const LAS bf16x8*)(XC + (32 * mb + r) * 264 + 16 * s + 8 * hh);
                        ai[mb] = __builtin_amdgcn_mfma_f32_32x32x16_bf16(af, bi[s], ai[mb], 0, 0, 0); } }
                const int ch = h * 256 + 32 * w + r;
                const float ba_ = p.in[I_BA][ch], bi_ = p.in[I_BI][ch]; const float L = p.in[I_AP][ch];
                const float sp = fmaxf(-L, 0.f) + log1pf(__expf(-fabsf(L)));
                const unsigned off0 = (unsigned)((tok0 + 4 * hh) * 1024 + ch);
#pragma unroll
                for (int mb = 0; mb < 2; ++mb)
#pragma unroll
                    for (int q4 = 0; q4 < 4; ++q4) {
                        unsigned o = off0 + (unsigned)((32 * mb + 8 * q4) * 1024); asm volatile("" : "+v"(o));
#pragma unroll
                        for (int i = 0; i < 4; ++i) { const int q = 4 * q4 + i; const int t = 32 * mb + 8 * q4 + i + 4 * hh;
                            const float ga = sigmoidf_(aa[mb][q] + ba_), gi = sigmoidf_(ai[mb][q] + bi_);
                            const float la = -8.0f * ga * sp; const float a = __expf(la);
                            const float xcv = bf2f(XC[t * 264 + 32 * w + r]);
                            const float u = xcv * gi * sqrtf(fmaxf(1.0f - a * a, 0.f));
                            AUA[(size_t)o + i * 1024] = a; AUU[(size_t)o + i * 1024] = u; } }
            }
#endif
            __syncthreads();
        }
    }
}

__device__ __forceinline__ void p2b(Frame& F, const Params& p) {
    const float* AN = (const float*)(F.ws + WS_AN); const float* DN = (const float*)(F.ws + WS_DN); bf16_t* SP = (bf16_t*)(F.ws + WS_SP);
    const float* AUA = (const float*)(F.ws + WS_AUA); const float* AUU = (const float*)(F.ws + WS_AUU);
    float* SUMA = (float*)(F.ws + WS_SUMA); float* SUMH = (float*)(F.ws + WS_SUMH);
    if (F.tid < 128) {
        for (int st = (int)blockIdx.x * 128 + F.tid; st < 32768; st += F.G * 128) {
            const int bh = st >> 12, rem = st & 4095, ln = rem & 63, s2 = (rem >> 6) & 1, w = (rem >> 7) & 7, mb = (rem >> 10) & 3;
            const int kk0 = 32 * mb + 16 * s2 + 4 * (ln >> 5);
            const int offA = (((mb * 8 + w) * 4 + 2 * s2) * 64 + ln) * 4;
            const int offS = (((mb * 8 + w) * 2 + s2) * 64 + ln) * 8;
            f32x4 S0 = (f32x4){0.f, 0.f, 0.f, 0.f}, S1 = S0;
            for (int n0 = 0; n0 < 128; n0 += 8) {
                f32x4 a0[8], a1[8], d0[8], d1[8];
#pragma unroll
                for (int i = 0; i < 8; ++i) { const size_t uh = (size_t)bh * 128 + n0 + i;
                    a0[i] = *(const f32x4*)(AN + uh * 32768 + offA); a1[i] = *(const f32x4*)(AN + uh * 32768 + offA + 256);
                    d0[i] = *(const f32x4*)(DN + uh * 128 + kk0); d1[i] = *(const f32x4*)(DN + uh * 128 + kk0 + 8); }
#pragma unroll
                for (int i = 0; i < 8; ++i) { const size_t uh = (size_t)bh * 128 + n0 + i;
                    u32x4 o; o.x = pk2(S0[0], S0[1]); o.y = pk2(S0[2], S0[3]); o.z = pk2(S1[0], S1[1]); o.w = pk2(S1[2], S1[3]);
                    *(u32x4*)(SP + uh * 32768 + offS) = o;
                    S0 = d0[i] * S0 + a0[i]; S1 = d1[i] * S1 + a1[i]; } }
        }
    } else if (F.tid < 384) {
        for (int c = blockIdx.x; c < NCHUNK; c += F.G) { const int ch = 4 * (F.tid - 128);
            f32x4 A = (f32x4){1.f, 1.f, 1.f, 1.f}, Hh = (f32x4){0.f, 0.f, 0.f, 0.f};
#pragma unroll 16
            for (int t = 0; t < 64; ++t) { const f32x4 a = *(const f32x4*)(AUA + (size_t)(c * 64 + t) * 1024 + ch), u = *(const f32x4*)(AUU + (size_t)(c * 64 + t) * 1024 + ch);
                Hh = a * Hh + u; A = A * a; }
            *(f32x4*)(SUMA + c * 1024 + ch) = A; *(f32x4*)(SUMH + c * 1024 + ch) = Hh; }
    }
}

__device__ __forceinline__ void p2c(Frame& F, const Params& p) {
    const bf16_t* Z = (const bf16_t*)(F.ws + WS_Z); const float* LG = (const float*)(F.ws + WS_LG); const bf16_t* SP = (const bf16_t*)(F.ws + WS_SP);
    bf16_t* MIX = (bf16_t*)(F.ws + WS_MIX);
    LAS float* BC = (LAS float*)(F.lds); LAS float* SEG = (LAS float*)(F.lds + 32768);
    LAS bf16_t* QE = (LAS bf16_t*)(F.lds + 34816); LAS bf16_t* KE = (LAS bf16_t*)(F.lds + 52224); LAS bf16_t* VT = (LAS bf16_t*)(F.lds + 69632);
    LAS float* SSQ = (LAS float*)(F.lds + 106496); LAS float* OS = (LAS float*)(F.lds);
    const int tid = F.tid, lane = F.lane, w = F.wave, r = lane & 31, hh = lane >> 5;
    const float* gng = p.in[I_GNG];
    for (int unit = blockIdx.x; unit < NCHUNK; unit += F.G) {
        const int b = unit >> 7, n = unit & 127, tok0 = b * SEQL + 64 * n;
        { const float* AUA = (const float*)(F.ws + WS_AUA); const float* AUU = (const float*)(F.ws + WS_AUU);
          const float* SUMA = (const float*)(F.ws + WS_SUMA); const float* SUMH = (const float*)(F.ws + WS_SUMH);
          const int ch = 2 * tid; f32x2 hc = (f32x2){0.f, 0.f};
          int c2 = unit & ~127;
          for (; c2 + 16 <= unit; c2 += 16) { f32x2 a[16], hv[16];
#pragma unroll
              for (int q = 0; q < 16; ++q) { a[q] = *(const f32x2*)(SUMA + (c2 + q) * 1024 + ch); hv[q] = *(const f32x2*)(SUMH + (c2 + q) * 1024 + ch); }
#pragma unroll
              for (int q = 0; q < 16; ++q) hc = a[q] * hc + hv[q]; }
          { f32x2 a[16], hv[16];
#pragma unroll
              for (int q = 0; q < 16; ++q) { const bool ok = (c2 + q) < unit; a[q] = ok ? *(const f32x2*)(SUMA + (c2 + q) * 1024 + ch) : (f32x2){1.f, 1.f}; hv[q] = ok ? *(const f32x2*)(SUMH + (c2 + q) * 1024 + ch) : (f32x2){0.f, 0.f}; }
#pragma unroll
              for (int q = 0; q < 16; ++q) hc = a[q] * hc + hv[q]; }
          for (int t0 = 0; t0 < 64; t0 += 16) {
              f32x2 a[16], u[16]; unsigned lgw[16];
#pragma unroll
              for (int i = 0; i < 16; ++i) { const size_t tok = (size_t)tok0 + t0 + i;
                  a[i] = *(const f32x2*)(AUA + tok * 1024 + ch); u[i] = *(const f32x2*)(AUU + tok * 1024 + ch); lgw[i] = *(const unsigned*)(Z + tok * ZC + ZLG + ch); }
#pragma unroll
              for (int i = 0; i < 16; ++i) { const size_t tok = (size_t)tok0 + t0 + i;
                  hc = a[i] * hc + u[i];
                  *(unsigned*)(MIX + tok * DM + 1024 + ch) = pk2(hc.x * gelu_tanh_f(bflo(lgw[i])), hc.y * gelu_tanh_f(bfhi(lgw[i]))); } } }
        for (int h = 0; h < 4; ++h) {
            const int uh = (b * 4 + h) * 128 + n;
            bf16x8 sf[4][2];
            { const bf16_t* spu = SP + (size_t)uh * 32768;
#pragma unroll
              for (int mb = 0; mb < 4; ++mb)
#pragma unroll
                  for (int s2 = 0; s2 < 2; ++s2) sf[mb][s2] = *(const bf16x8*)(spu + (((mb * 8 + w) * 2 + s2) * 64 + lane) * 8); }
            gla_cumsum(LG, tok0, h, BC, SEG, tid);
#pragma unroll
            for (int it = 0; it < 2; ++it) { const int item = tid + 512 * it, kk8 = item & 15, t = item >> 4;
                const u32x4 qv = *(const u32x4*)(Z + (size_t)(tok0 + t) * ZC + ZQ + h * 128 + kk8 * 8);
                const u32x4 kv = *(const u32x4*)(Z + (size_t)(tok0 + t) * ZC + ZK + h * 128 + kk8 * 8);
                const f32x4 b0 = *(const LAS f32x4*)(BC + t * 128 + kk8 * 8), b1 = *(const LAS f32x4*)(BC + t * 128 + kk8 * 8 + 4);
                float qe[8], ke[8];
#pragma unroll
                for (int i = 0; i < 8; ++i) { const float bb = (i < 4) ? b0[i & 3] : b1[i & 3]; const unsigned qw = qv[i >> 1], kw = kv[i >> 1];
                    const float qf = (i & 1) ? bfhi(qw) : bflo(qw), kf = (i & 1) ? bfhi(kw) : bflo(kw);
                    qe[i] = qf * 0.08838834764831845f * __expf(bb); ke[i] = kf * __expf(-bb); }
                u32x4 oq, ok; oq.x = pk2(qe[0], qe[1]); oq.y = pk2(qe[2], qe[3]); oq.z = pk2(qe[4], qe[5]); oq.w = pk2(qe[6], qe[7]);
                ok.x = pk2(ke[0], ke[1]); ok.y = pk2(ke[2], ke[3]); ok.z = pk2(ke[4], ke[5]); ok.w = pk2(ke[6], ke[7]);
                *(LAS u32x4*)(QE + t * 136 + kk8 * 8) = oq; *(LAS u32x4*)(KE + t * 136 + kk8 * 8) = ok; }
#pragma unroll
            for (int it = 0; it < 4; ++it) { const int item = tid + 512 * it, t = item & 63, vc8 = item >> 6;
                const u32x4 vv = *(const u32x4*)(Z + (size_t)(tok0 + t) * ZC + ZV + h * 256 + vc8 * 8);
#pragma unroll
                for (int i = 0; i < 8; ++i) { const unsigned wv = vv[i >> 1]; VT[(vc8 * 8 + i) * 72 + t] = (bf16_t)((i & 1) ? (wv >> 16) : (wv & 0xffffu)); } }
            __syncthreads();
            f32x16 oacc[2];
            {
                f32x16 P00, P01, P11;
#pragma unroll
                for (int q = 0; q < 16; ++q) { P00[q] = 0.f; P01[q] = 0.f; P11[q] = 0.f; oacc[0][q] = 0.f; oacc[1][q] = 0.f; }
#pragma unroll
                for (int s = 0; s < 8; ++s) {
                    const bf16x8 a0 = *(const LAS bf16x8*)(KE + r * 136 + 16 * s + 8 * hh), a1 = *(const LAS bf16x8*)(KE + (32 + r) * 136 + 16 * s + 8 * hh);
                    const bf16x8 b0 = *(const LAS bf16x8*)(QE + r * 136 + 16 * s + 8 * hh), b1 = *(const LAS bf16x8*)(QE + (32 + r) * 136 + 16 * s + 8 * hh);
                    P00 = __builtin_amdgcn_mfma_f32_32x32x16_bf16(a0, b0, P00, 0, 0, 0);
                    P01 = __builtin_amdgcn_mfma_f32_32x32x16_bf16(a0, b1, P01, 0, 0, 0);
                    P11 = __builtin_amdgcn_mfma_f32_32x32x16_bf16(a1, b1, P11, 0, 0, 0); }
#pragma unroll
                for (int q = 0; q < 16; ++q) { const int jl = (q & 3) + 8 * (q >> 2) + 4 * hh; if (jl > r) { P00[q] = 0.f; P11[q] = 0.f; } }
                bf16x8 F00[2], F01[2], F11[2];
#pragma unroll
                for (int s2 = 0; s2 < 2; ++s2) {
                    u32x4 t0, t1, t2;
#pragma unroll
                    for (int q = 0; q < 4; ++q) { t0[q] = pk2(P00[8 * s2 + 2 * q], P00[8 * s2 + 2 * q + 1]); t1[q] = pk2(P01[8 * s2 + 2 * q], P01[8 * s2 + 2 * q + 1]); t2[q] = pk2(P11[8 * s2 + 2 * q], P11[8 * s2 + 2 * q + 1]); }
                    F00[s2] = as_bf16x8(t0); F01[s2] = as_bf16x8(t1); F11[s2] = as_bf16x8(t2); }
#pragma unroll
                for (int mb = 0; mb < 4; ++mb)
#pragma unroll
                    for (int s2 = 0; s2 < 2; ++s2) { const bf16x8 af = sf[mb][s2];
                        const int kkb = 32 * mb + 16 * s2 + 4 * hh;
#pragma unroll
                        for (int ib = 0; ib < 2; ++ib) { const bf16x4 lo = *(const LAS bf16x4*)(QE + (32 * ib + r) * 136 + kkb), hi = *(const LAS bf16x4*)(QE + (32 * ib + r) * 136 + kkb + 8);
                            oacc[ib] = __builtin_amdgcn_mfma_f32_32x32x16_bf16(af, cat4(lo, hi), oacc[ib], 0, 0, 0); } }
#pragma unroll
                for (int s2 = 0; s2 < 2; ++s2) {
                    const int tb0 = 16 * s2 + 4 * hh, tb1 = 32 + 16 * s2 + 4 * hh;
                    const bf16x8 v0 = cat4(*(const LAS bf16x4*)(VT + (32 * w + r) * 72 + tb0), *(const LAS bf16x4*)(VT + (32 * w + r) * 72 + tb0 + 8));
                    const bf16x8 v1 = cat4(*(const LAS bf16x4*)(VT + (32 * w + r) * 72 + tb1), *(const LAS bf16x4*)(VT + (32 * w + r) * 72 + tb1 + 8));
                    oacc[0] = __builtin_amdgcn_mfma_f32_32x32x16_bf16(v0, F00[s2], oacc[0], 0, 0, 0);
                    oacc[1] = __builtin_amdgcn_mfma_f32_32x32x16_bf16(v0, F01[s2], oacc[1], 0, 0, 0);
                    oacc[1] = __builtin_amdgcn_mfma_f32_32x32x16_bf16(v1, F11[s2], oacc[1], 0, 0, 0); }
            }
#pragma unroll
            for (int ib = 0; ib < 2; ++ib) { float sq = 0.f;
#pragma unroll
                for (int q = 0; q < 16; ++q) sq += oacc[ib][q] * oacc[ib][q];
                sq += __shfl_xor(sq, 32);
                if (hh == 0) SSQ[w * 64 + 32 * ib + r] = sq; }
            __syncthreads();
#pragma unroll
            for (int ib = 0; ib < 2; ++ib) { float tot = 0.f;
#pragma unroll
                for (int w2 = 0; w2 < 8; ++w2) tot += SSQ[w2 * 64 + 32 * ib + r];
                const float rs = 1.0f / sqrtf(tot * (1.0f / 256.0f) + 1e-6f);
#pragma unroll
                for (int g = 0; g < 4; ++g) *(LAS f32x4*)(OS + (32 * ib + r) * 260 + 32 * w + 8 * g + 4 * hh) =
                    (f32x4){oacc[ib][4 * g] * rs, oacc[ib][4 * g + 1] * rs, oacc[ib][4 * g + 2] * rs, oacc[ib][4 * g + 3] * rs}; }
            __syncthreads();
#pragma unroll
            for (int it = 0; it < 4; ++it) { const int item = tid + 512 * it, vc8 = item & 31, t = item >> 5; const int c = h * 256 + vc8 * 8;
                const f32x4 o0 = *(const LAS f32x4*)(OS + t * 260 + vc8 * 8), o1 = *(const LAS f32x4*)(OS + t * 260 + vc8 * 8 + 4);
                const u32x4 rv = *(const u32x4*)(Z + (size_t)(tok0 + t) * ZC + ZR + c);
                const f32x4 g0 = *(const f32x4*)(gng + c), g1 = *(const f32x4*)(gng + c + 4);
                float o[8];
#pragma unroll
                for (int i = 0; i < 8; ++i) { const unsigned rw = rv[i >> 1]; const float rf = (i & 1) ? bfhi(rw) : bflo(rw);
                    const float sil = rf * sigmoidf_(rf); o[i] = sil * ((i < 4) ? o0[i & 3] * g0[i & 3] : o1[i & 3] * g1[i & 3]); }
                u32x4 ov; ov.x = pk2(o[0], o[1]); ov.y = pk2(o[2], o[3]); ov.z = pk2(o[4], o[5]); ov.w = pk2(o[6], o[7]);
                *(u32x4*)(MIX + (size_t)(tok0 + t) * DM + c) = ov; }
            __syncthreads();
        }
    }
}

__device__ __forceinline__ void build_moe_tables(Frame& F) {
    unsigned* cnt = (unsigned*)(F.ws + WS_CTL) + CW_CNT;
    if (F.tid < 32) F.MISC[MI_LCNT + F.tid] = xb_ld(cnt + 64 * F.tid);
    __syncthreads();
    if (F.tid == 0) { int tiles = 0;
        for (int e = 0; e < NEXP; ++e) { const int c = (int)F.MISC[MI_LCNT + e]; const int mt = (c + 255) >> 8; F.MISC[MI_PBASE + e] = (unsigned)(tiles * 256);
            for (int q = 0; q < mt; ++q) F.MISC[MI_T2E + tiles + q] = (unsigned)e; tiles += mt; }
        F.MISC[MI_NMT] = (unsigned)tiles; }
    __syncthreads();
    if (F.tid < 32) F.MISC[MI_LCNT + F.tid] = 0u;
    __syncthreads();
}

__device__ __forceinline__ void p4a(Frame& F, const Params& p) {
    const float* XMID = (const float*)(F.ws + WS_XMID); const float* WrT = (const float*)(F.ws + WS_WRT); const float* br = p.in[I_BR];
    float* RSTD = (float*)(F.ws + WS_RSTD); unsigned* TOKE = (unsigned*)(F.ws + WS_TOKE); float* GATES = (float*)(F.ws + WS_GATES);
    unsigned* cnt = (unsigned*)(F.ws + WS_CTL) + CW_CNT;
    LAS float* RED = (LAS float*)(F.lds); LAS float* SSQ2 = (LAS float*)(F.lds + 32768); LAS float* LGT = (LAS float*)(F.lds + 33792); LAS float* RS = (LAS float*)(F.lds + 38016);
    const int tid = F.tid, lane = F.lane, w = F.wave, m = lane & 31, kh = lane >> 5;
    if (tid < 32) F.MISC[MI_LCNT + tid] = 0u;
    __syncthreads();
    for (int ut = blockIdx.x; ut < T / 32; ut += F.G) {
        const int m0 = 32 * ut; const int kw = 256 * w + 128 * kh;
        f32x16 acc;
#pragma unroll
        for (int q = 0; q < 16; ++q) acc[q] = 0.f;
        float ss = 0.f;
        const float* ap = XMID + (size_t)(m0 + m) * DM + kw; const float* bp = WrT + (size_t)m * DM + kw;
#pragma unroll 2
        for (int c = 0; c < 8; ++c) {
            f32x4 a[4], b[4];
#pragma unroll
            for (int q = 0; q < 4; ++q) { a[q] = *(const f32x4*)(ap + 16 * c + 4 * q); b[q] = *(const f32x4*)(bp + 16 * c + 4 * q); }
#pragma unroll
            for (int q = 0; q < 4; ++q)
#pragma unroll
                for (int i = 0; i < 4; ++i) { acc = __builtin_amdgcn_mfma_f32_32x32x2f32(a[q][i], b[q][i], acc, 0, 0, 0); ss += a[q][i] * a[q][i]; }
        }
        ss += __shfl_xor(ss, 32);
#pragma unroll
        for (int q = 0; q < 16; ++q) RED[(w * 16 + q) * 64 + lane] = acc[q];
        if (kh == 0) SSQ2[w * 32 + m] = ss;
        __syncthreads();
#pragma unroll
        for (int it = 0; it < 2; ++it) { const int o = tid + 512 * it, reg = o >> 6, ln = o & 63, nn = ln & 31, h2 = ln >> 5; const int mm = (reg & 3) + 8 * (reg >> 2) + 4 * h2;
            float v = 0.f, s2 = 0.f;
#pragma unroll
            for (int w2 = 0; w2 < 8; ++w2) { v += RED[(w2 * 16 + reg) * 64 + ln]; s2 += SSQ2[w2 * 32 + mm]; }
            const float rs = 1.0f / sqrtf(s2 * (1.0f / DM) + 1e-6f);
            LGT[mm * 33 + nn] = v * rs + br[nn]; if (nn == 0) RS[mm] = rs; }
        __syncthreads();
        int ex[4]; unsigned ls[4]; float gt[4];
        if (tid < 32) {
            float l[32];
#pragma unroll
            for (int i = 0; i < 32; ++i) l[i] = LGT[tid * 33 + i];
            float val[4];
#pragma unroll
            for (int k = 0; k < 4; ++k) { float best = -3.0e38f; int bi = 0;
#pragma unroll
                for (int i = 0; i < 32; ++i) if (l[i] > best) { best = l[i]; bi = i; }
                ex[k] = bi; val[k] = best;
#pragma unroll
                for (int i = 0; i < 32; ++i) if (i == bi) l[i] = -3.0e38f; }
            float s = 0.f;
#pragma unroll
            for (int k = 0; k < 4; ++k) { gt[k] = __expf(val[k] - val[0]); s += gt[k]; }
            const float inv = 1.0f / s;
#pragma unroll
            for (int k = 0; k < 4; ++k) { gt[k] *= inv; ls[k] = __hip_atomic_fetch_add((LAS unsigned*)(F.MISC + MI_LCNT + ex[k]), 1u, __ATOMIC_RELAXED, __HIP_MEMORY_SCOPE_WORKGROUP); }
        }
        __syncthreads();
        if (tid < 32) { const unsigned c = F.MISC[MI_LCNT + tid]; F.MISC[MI_LBASE + tid] = c ? xb_add(cnt + 64 * tid, c) : 0u; F.MISC[MI_LCNT + tid] = 0u; }
        __syncthreads();
        if (tid < 32) { const int tok = m0 + tid;
#pragma unroll
            for (int k = 0; k < 4; ++k) { const unsigned slot = F.MISC[MI_LBASE + ex[k]] + ls[k]; TOKE[tok * 4 + k] = (unsigned)ex[k] | (slot << 8); GATES[tok * 4 + k] = gt[k]; }
            RSTD[tok] = RS[tid]; }
        __syncthreads();
    }
}

__device__ __forceinline__ void p4b(Frame& F, const Params& p) {
    build_moe_tables(F);
    const float* XMID = (const float*)(F.ws + WS_XMID); const float* RSTD = (const float*)(F.ws + WS_RSTD); const unsigned* TOKE = (const unsigned*)(F.ws + WS_TOKE);
    const float* gf = p.in[I_NFG]; unsigned char* ABUF = F.ws + WS_ABUF;
    const int l = F.lane;
    f32x4 xn[8]; float rsn = 0.f; unsigned ten[4] = {0u, 0u, 0u, 0u};
    if (F.gw < T) { rsn = RSTD[F.gw];
#pragma unroll
        for (int k = 0; k < 4; ++k) ten[k] = TOKE[F.gw * 4 + k];
#pragma unroll
        for (int j = 0; j < 4; ++j) { xn[2 * j] = *(const f32x4*)(XMID + (size_t)F.gw * DM + 8 * l + 512 * j); xn[2 * j + 1] = *(const f32x4*)(XMID + (size_t)F.gw * DM + 8 * l + 512 * j + 4); } }
    f32x4 gv[8];
#pragma unroll
    for (int j = 0; j < 4; ++j) { gv[2 * j] = *(const f32x4*)(gf + 8 * l + 512 * j) * 16.0f; gv[2 * j + 1] = *(const f32x4*)(gf + 8 * l + 512 * j + 4) * 16.0f; }
    for (int tok = F.gw; tok < T; tok += F.NGW) {
        const float rs = rsn; unsigned te[4]; u32x2 o[4];
#pragma unroll
        for (int k = 0; k < 4; ++k) te[k] = ten[k];
#pragma unroll
        for (int j = 0; j < 4; ++j) { const f32x4 a = xn[2 * j] * rs * gv[2 * j], b = xn[2 * j + 1] * rs * gv[2 * j + 1];
            o[j].x = pk4_fp8(a[0], a[1], a[2], a[3]); o[j].y = pk4_fp8(b[0], b[1], b[2], b[3]); }
        const int t2 = tok + F.NGW;
        if (t2 < T) { rsn = RSTD[t2];
#pragma unroll
            for (int k = 0; k < 4; ++k) ten[k] = TOKE[t2 * 4 + k];
#pragma unroll
            for (int j = 0; j < 4; ++j) { xn[2 * j] = *(const f32x4*)(XMID + (size_t)t2 * DM + 8 * l + 512 * j); xn[2 * j + 1] = *(const f32x4*)(XMID + (size_t)t2 * DM + 8 * l + 512 * j + 4); } }
#pragma unroll
        for (int k = 0; k < 4; ++k) { const size_t row = (size_t)F.MISC[MI_PBASE + (te[k] & 255u)] + (te[k] >> 8);
#pragma unroll
            for (int j = 0; j < 4; ++j) *(u32x2*)(ABUF + row * DM + 8 * l + 512 * j) = o[j]; }
    }
}

__device__ __forceinline__ void p7(Frame& F, const Params& p) {
    build_moe_tables(F);
    const float* XMID = (const float*)(F.ws + WS_XMID); const unsigned* TOKE = (const unsigned*)(F.ws + WS_TOKE); const float* GATES = (const float*)(F.ws + WS_GATES);
    const bf16_t* Y = (const bf16_t*)(F.ws + WS_Y); const float* gfin = p.in[I_NFINAL];
    const int l = F.lane;
    f32x4 xn[8]; u32x4 yn[4][4]; float gkn[4] = {0.f, 0.f, 0.f, 0.f};
#define P7_FETCH(tk) do { \
        _Pragma("unroll") for (int k = 0; k < 4; ++k) { const unsigned te = TOKE[(tk) * 4 + k]; gkn[k] = GATES[(tk) * 4 + k]; const size_t row = (size_t)F.MISC[MI_PBASE + (te & 255u)] + (te >> 8); \
            _Pragma("unroll") for (int j = 0; j < 4; ++j) yn[k][j] = *(const u32x4*)(Y + row * DM + 8 * l + 512 * j); } \
        _Pragma("unroll") for (int j = 0; j < 4; ++j) { xn[2 * j] = *(const f32x4*)(XMID + (size_t)(tk) * DM + 8 * l + 512 * j); xn[2 * j + 1] = *(const f32x4*)(XMID + (size_t)(tk) * DM + 8 * l + 512 * j + 4); } } while (0)
    if (F.gw < T) P7_FETCH(F.gw);
    f32x4 g0[4], g1[4];
#pragma unroll
    for (int j = 0; j < 4; ++j) { g0[j] = *(const f32x4*)(gfin + 8 * l + 512 * j); g1[j] = *(const f32x4*)(gfin + 8 * l + 512 * j + 4); }
    for (int tok = F.gw; tok < T; tok += F.NGW) {
        f32x4 xv[8];
#pragma unroll
        for (int j = 0; j < 8; ++j) xv[j] = xn[j];
#pragma unroll
        for (int k = 0; k < 4; ++k)
#pragma unroll
            for (int j = 0; j < 4; ++j) { const u32x4 y4 = yn[k][j]; const float gk = gkn[k];
                xv[2 * j][0] += gk * bflo(y4.x); xv[2 * j][1] += gk * bfhi(y4.x); xv[2 * j][2] += gk * bflo(y4.y); xv[2 * j][3] += gk * bfhi(y4.y);
                xv[2 * j + 1][0] += gk * bflo(y4.z); xv[2 * j + 1][1] += gk * bfhi(y4.z); xv[2 * j + 1][2] += gk * bflo(y4.w); xv[2 * j + 1][3] += gk * bfhi(y4.w); }
        const int t2 = tok + F.NGW;
        if (t2 < T) P7_FETCH(t2);
        float ss = 0.f;
#pragma unroll
        for (int j = 0; j < 8; ++j) ss += (xv[j][0] * xv[j][0] + xv[j][1] * xv[j][1]) + (xv[j][2] * xv[j][2] + xv[j][3] * xv[j][3]);
        const float rs = 1.0f / sqrtf(wave_sum(ss) * (1.0f / DM) + 1e-6f);
#pragma unroll
        for (int j = 0; j < 4; ++j) { *(f32x4*)(p.out + (size_t)tok * DM + 8 * l + 512 * j) = xv[2 * j] * rs * g0[j]; *(f32x4*)(p.out + (size_t)tok * DM + 8 * l + 512 * j + 4) = xv[2 * j + 1] * rs * g1[j]; }
    }
#undef P7_FETCH
}

#ifdef PROBE_STREAM
__device__ __forceinline__ void probe_stream(Frame& F, const Params& p) {
    const f32x4* src = (const f32x4*)p.in[I_WGU]; const size_t n4 = (size_t)32 * 2048 * 4096 / 4;
    const f32x4* src2 = (const f32x4*)p.in[I_WDN]; const size_t m4 = (size_t)32 * 2048 * 2048 / 4;
    f32x4 acc = (f32x4){0.f, 0.f, 0.f, 0.f};
    for (size_t base = (size_t)F.gw * 1024; base < n4; base += (size_t)F.NGW * 1024) {
        f32x4 v[16];
#pragma unroll
        for (int i = 0; i < 16; ++i) v[i] = src[base + i * 64 + F.lane];
#pragma unroll
        for (int i = 0; i < 16; ++i) acc += v[i]; }
    for (size_t base = (size_t)F.gw * 1024; base < m4; base += (size_t)F.NGW * 1024) {
        f32x4 v[16];
#pragma unroll
        for (int i = 0; i < 16; ++i) v[i] = src2[base + i * 64 + F.lane];
#pragma unroll
        for (int i = 0; i < 16; ++i) acc += v[i]; }
    if (acc[0] + acc[1] + acc[2] + acc[3] == 12345.678f) p.out[0] = 1.0f;
}
#endif
constexpr int NPHASE = 11;
__global__ void __launch_bounds__(512, 2) mk_fwd(Params p) {
    extern __shared__ __attribute__((aligned(16))) unsigned char lds_raw[];
    Frame F;
    F.lds = (LAS unsigned char*)lds_raw; F.MISC = (volatile LAS unsigned*)(F.lds + MISC_OFF);
    F.wave = __builtin_amdgcn_readfirstlane((int)threadIdx.x >> 6);
#define FRESH() do { F.lane = fresh_lane(); F.tid = F.wave * 64 + F.lane; } while (0)
    FRESH();
    F.G = gridDim.x; F.gw = (int)blockIdx.x * 8 + F.wave; F.NGW = F.G * 8; F.ws = p.ws;
    for (int u = F.tid; u < (LDS_BYTES - MISC_OFF) / 4; u += 512) F.MISC[u] = 0u;
    __syncthreads();
    const int lo = p.ph_lo, hi = p.ph_hi;
    XcdBarrier bar; bar.bar = (unsigned*)(F.ws + WS_CTL) + CW_BAR; bar.x = 0; bar.st = F.MISC;
    if (hi - lo > 1) bar = xcd_barrier_post((unsigned*)(F.ws + WS_CTL) + CW_BAR, F.MISC, F.tid == 0);
#ifndef PHASE_MASK
#define PHASE_MASK 0x7ff
#endif
#define IN(k) (((PHASE_MASK >> (k)) & 1) && lo <= (k) && (k) < hi)
#define SEAM(k) do { if (IN(k) && IN((k) + 1)) xcd_barrier(bar, F.wave == 0 && fresh_lane() == 0); } while (0)
#ifndef REPEAT_MASK
#define REPEAT_MASK 0
#endif
#define REP(k) for (int rep_ = 0; rep_ < (((REPEAT_MASK >> (k)) & 1) ? 2 : 1); ++rep_)
    LAS unsigned char* ring = F.lds;
#ifdef PROBE_STREAM
    if (IN(0)) { probe_stream(F, p); }
#endif
    if (IN(0)) { REP(11) { FRESH(); p0a(F, p); } REP(12) { FRESH(); p0b(F, p); } SEAM(0); }
    if (IN(1)) REP(1) {
        pg8::Gemm g{F.ws + WS_H, F.ws + WS_WINT}; using GS = pg8::GShape<DM * 2, DM * 2, DM * 2, 0>; pg8::StaticOrder S; S.init(T, ZC, F.G, (int)blockIdx.x);
        pg8::EpiBf16 E{(bf16_t*)(F.ws + WS_Z), ZC, nullptr, 0};
        pg8::gemm_phase<pg8::EpiBf16, pg8::StaticOrder, GS, true>(ring, g, S, E, F.wave); SEAM(1); }
    if (IN(2)) REP(2) { FRESH(); p2a(F, p); SEAM(2); }
    if (IN(3)) REP(3) { FRESH(); p2b(F, p); SEAM(3); }
    if (IN(4)) REP(4) { FRESH(); p2c(F, p); SEAM(4); }
    if (IN(5)) REP(5) {
        pg8::Gemm g{F.ws + WS_MIX, F.ws + WS_WOUTT}; using GS = pg8::GShape<DM * 2, DM * 2, DM * 2, 0>; pg8::StaticOrder S; S.init(T, DM, F.G, (int)blockIdx.x);
        pg8::EpiF32Res E{(float*)(F.ws + WS_XMID), p.in[I_X], DM};
        pg8::gemm_phase<pg8::EpiF32Res, pg8::StaticOrder, GS, true>(ring, g, S, E, F.wave); SEAM(5); }
    if (IN(6)) { FRESH(); p4a(F, p); SEAM(6); }
    if (IN(7)) REP(7) { FRESH(); p4b(F, p); SEAM(7); }
    if (IN(8)) {
        FRESH(); build_moe_tables(F);
        pg8::Gemm g{F.ws + WS_ABUF, F.ws + WS_WGUT}; using GS = pg8::GShape<DM, DM, DM, (size_t)4096 * DM>;
        pg8::MoeOrder S{__builtin_amdgcn_readfirstlane((int)F.MISC[MI_NMT]), 16, F.G, (int)blockIdx.x, (const LAS int*)(F.lds + MISC_OFF + 4 * MI_T2E)};
        pg8::EpiSwiGLU8 E{F.ws + WS_ACT, DM, p.in[I_BGU]};
        pg8::gemm_phase<pg8::EpiSwiGLU8, pg8::MoeOrder, GS, true, true>(ring, g, S, E, F.wave); SEAM(8); }
#if (REPEAT_MASK & 0x100)
    if (IN(8)) {
        FRESH(); build_moe_tables(F);
        pg8::Gemm g{F.ws + WS_ABUF, F.ws + WS_WGUT}; using GS = pg8::GShape<DM, DM, DM, (size_t)4096 * DM>;
        pg8::MoeOrder S{__builtin_amdgcn_readfirstlane((int)F.MISC[MI_NMT]), 16, F.G, (int)blockIdx.x, (const LAS int*)(F.lds + MISC_OFF + 4 * MI_T2E)};
        pg8::EpiSwiGLU8 E{F.ws + WS_ACT, DM, p.in[I_BGU]};
        pg8::gemm_phase<pg8::EpiSwiGLU8, pg8::MoeOrder, GS, true, true>(ring, g, S, E, F.wave); SEAM(8); }
#endif
    if (IN(9)) {
        FRESH(); build_moe_tables(F);
        pg8::Gemm g{F.ws + WS_ACT, F.ws + WS_WDT}; using GS = pg8::GShape<DM, DM, DM, (size_t)DM * DM>;
        pg8::MoeOrder S{__builtin_amdgcn_readfirstlane((int)F.MISC[MI_NMT]), 8, F.G, (int)blockIdx.x, (const LAS int*)(F.lds + MISC_OFF + 4 * MI_T2E)};
        pg8::EpiBf16S E{(bf16_t*)(F.ws + WS_Y), DM, p.in[I_BDN], DM, 1.0f / 2048.0f};
        pg8::gemm_phase<pg8::EpiBf16S, pg8::MoeOrder, GS, true, true>(ring, g, S, E, F.wave); SEAM(9); }
#if (REPEAT_MASK & 0x200)
    if (IN(9)) {
        FRESH(); build_moe_tables(F);
        pg8::Gemm g{F.ws + WS_ACT, F.ws + WS_WDT}; using GS = pg8::GShape<DM, DM, DM, (size_t)DM * DM>;
        pg8::MoeOrder S{__builtin_amdgcn_readfirstlane((int)F.MISC[MI_NMT]), 8, F.G, (int)blockIdx.x, (const LAS int*)(F.lds + MISC_OFF + 4 * MI_T2E)};
        pg8::EpiBf16S E{(bf16_t*)(F.ws + WS_Y), DM, p.in[I_BDN], DM, 1.0f / 2048.0f};
        pg8::gemm_phase<pg8::EpiBf16S, pg8::MoeOrder, GS, true, true>(ring, g, S, E, F.wave); SEAM(9); }
#endif
    if (IN(10)) REP(10) { FRESH(); p7(F, p); if (((REPEAT_MASK >> 10) & 1)) xcd_barrier(bar, F.wave == 0 && fresh_lane() == 0); }
#undef IN
#undef SEAM
}
#ifndef STAGE
#define STAGE 4
#endif
#ifndef PER_PHASE_LAUNCH
#define PER_PHASE_LAUNCH 0
#endif

#if STAGE < 4
__global__ void adapt_z_kernel(const bf16_t* Z, float* z) {
    const long idx = (long)blockIdx.x * blockDim.x + threadIdx.x; const long t = idx / ZC; const int c = (int)(idx % ZC);
    z[t * INC + (c < 3072 ? c : c + 16)] = bf2f(Z[idx]);
}
__global__ void adapt_bf16_kernel(const bf16_t* src, float* dst) { const long idx = (long)blockIdx.x * blockDim.x + threadIdx.x; dst[idx] = bf2f(src[idx]); }
#endif

static void launch_mk(Params& a, int lo, int hi, int grid, hipStream_t stream) {
#if PER_PHASE_LAUNCH
    for (int k = lo; k < hi; ++k) { a.ph_lo = k; a.ph_hi = k + 1; hipLaunchKernelGGL(mk_fwd, dim3(grid), dim3(512), LDS_BYTES, stream, a); }
#else
    a.ph_lo = lo; a.ph_hi = hi; hipLaunchKernelGGL(mk_fwd, dim3(grid), dim3(512), LDS_BYTES, stream, a);
#endif
}

extern "C" void kernel_launch(void* const* d_in, const int* in_sizes, int n_in, void* d_out, int out_size, void* d_ws, size_t ws_size, hipStream_t stream) {
    static int grid = 0;
    if (grid == 0) {
        int dev = 0, cus = 0;
        if (hipGetDevice(&dev) != hipSuccess || hipDeviceGetAttribute(&cus, hipDeviceAttributeMultiprocessorCount, dev) != hipSuccess) { grid = -1; return; }
        if (hipFuncSetAttribute((const void*)mk_fwd, hipFuncAttributeMaxDynamicSharedMemorySize, LDS_BYTES) != hipSuccess) { grid = -1; return; }
        int per_cu = 0;
        (void)hipOccupancyMaxActiveBlocksPerMultiprocessor(&per_cu, (const void*)mk_fwd, 512, LDS_BYTES);
        (void)hipGetLastError();
        grid = cus;
        if (per_cu < 1) fprintf(stderr, "kernel_launch: occupancy query reports %d\n", per_cu);
    }
    if (grid < 0) return;
    (void)hipMemsetAsync((char*)d_ws + WS_CTL, 0, CTL_ZERO_BYTES, stream);
    Params a{};
    for (int i = 0; i < 22; ++i) a.in[i] = (const float*)d_in[i];
    a.out = (float*)d_out; a.ws = (unsigned char*)d_ws;
#if STAGE >= 4
    launch_mk(a, 0, NPHASE, grid, stream);
#else
    const float* x = a.in[I_X];
    char* ws = (char*)d_ws + WS_ABUF; size_t off = 0;
    auto alloc = [&](size_t bytes) { void* p = ws + off; off += (bytes + 255) & ~(size_t)255; return p; };
    int* counts = (int*)alloc(256);
    float* z = (float*)alloc((size_t)T * INC * 4);
    float* ogla = (float*)alloc((size_t)T * 1024 * 4);
    float* xc = (float*)alloc((size_t)T * 1024 * 4);
    float* za = (float*)alloc((size_t)T * 1024 * 4);
    float* zi = (float*)alloc((size_t)T * 1024 * 4);
    float* mix = (float*)alloc((size_t)T * DM * 4);
    float* xmid = (float*)alloc((size_t)T * DM * 4);
    float* hf = (float*)alloc((size_t)T * DM * 4);
    float* logits = (float*)alloc((size_t)T * 32 * 4);
    float* gates = (float*)alloc((size_t)T * 4 * 4);
    int* list = (int*)alloc((size_t)NEXP * T * 4);
    float* act = (float*)alloc((size_t)T * 4 * DM * 4);
    float* y = (float*)alloc((size_t)T * 4 * DM * 4);
    (void)hipMemsetAsync(counts, 0, 256, stream);
#if STAGE == 1
    launch_mk(a, 0, 2, grid, stream);
    adapt_z_kernel<<<(unsigned)((size_t)T * ZC / 256), 256, 0, stream>>>((const bf16_t*)((char*)d_ws + WS_Z), z);
    gla_naive_kernel<<<64, 256, 0, stream>>>(z, (const float*)((char*)d_ws + WS_LG), ogla);
    gla_out_kernel<<<T, 256, 0, stream>>>(ogla, z, a.in[I_GNG], mix);
    lru_conv_kernel<<<T * 1024 / 256, 256, 0, stream>>>(z, a.in[I_CW], a.in[I_CB], xc);
    for (int h = 0; h < 4; ++h) {
        GemmArgs g{}; g.A = xc + h * 256; g.lda = 1024; g.ldb = 256; g.ldc = 1024; g.M = T; g.N = 256; g.K = 256; g.a_div = 1;
        g.B = a.in[I_WA] + (size_t)h * 65536; g.C = za + h * 256;
        sgemm_kernel<0><<<dim3(2, T / 128, 1), 256, 0, stream>>>(g);
        g.B = a.in[I_WI] + (size_t)h * 65536; g.C = zi + h * 256;
        sgemm_kernel<0><<<dim3(2, T / 128, 1), 256, 0, stream>>>(g);
    }
    lru_gate_kernel<<<T * 1024 / 256, 256, 0, stream>>>(xc, za, zi, a.in[I_BA], a.in[I_BI], a.in[I_AP]);
    lru_scan_kernel<<<2048 / 64, 64, 0, stream>>>(za, zi, z, mix);
#endif
#if STAGE == 2
    launch_mk(a, 0, 5, grid, stream);
    adapt_bf16_kernel<<<(unsigned)((size_t)T * DM / 256), 256, 0, stream>>>((const bf16_t*)((char*)d_ws + WS_MIX), mix);
#endif
#if STAGE <= 2
    { GemmArgs g{}; g.A = mix; g.lda = DM; g.B = a.in[I_WOUT]; g.ldb = DM; g.C = xmid; g.ldc = DM; g.M = T; g.N = DM; g.K = DM; g.a_div = 1; g.resid = x; g.ldr = DM;
      sgemm_kernel<1><<<dim3(DM / 128, T / 128, 1), 256, 0, stream>>>(g); }
#else
    launch_mk(a, 0, 6, grid, stream);
    xmid = (float*)((char*)d_ws + WS_XMID);
#endif
    rmsnorm_kernel<<<T, 256, 0, stream>>>(xmid, a.in[I_NFG], hf);
    { GemmArgs g{}; g.A = hf; g.lda = DM; g.B = a.in[I_WR]; g.ldb = 32; g.C = logits; g.ldc = 32; g.M = T; g.N = 32; g.K = DM; g.a_div = 1; g.bias = a.in[I_BR];
      sgemm_kernel<0><<<dim3(1, T / 128, 1), 256, 0, stream>>>(g); }
    route_kernel<<<T / 256, 256, 0, stream>>>(logits, counts, list, gates);
    { GemmArgs g{}; g.A = hf; g.lda = DM; g.B = a.in[I_WGU]; g.ldb = 4096; g.C = act; g.ldc = DM; g.M = 0; g.N = 4096; g.K = DM; g.a_div = 4; g.bias = a.in[I_BGU];
      g.rowlist = list; g.count = counts; g.strideB_e = (long)DM * 4096; g.strideBias_e = 4096; g.list_stride = T;
      sgemm_kernel<2><<<dim3(2048 / 64, T / 128, NEXP), 256, 0, stream>>>(g); }
    { GemmArgs g{}; g.A = act; g.lda = DM; g.B = a.in[I_WDN]; g.ldb = DM; g.C = y; g.ldc = DM; g.M = 0; g.N = DM; g.K = DM; g.a_div = 1; g.bias = a.in[I_BDN];
      g.rowlist = list; g.count = counts; g.strideB_e = (long)DM * DM; g.strideBias_e = DM; g.list_stride = T;
      sgemm_kernel<0><<<dim3(DM / 128, T / 128, NEXP), 256, 0, stream>>>(g); }
    final_kernel<<<T, 256, 0, stream>>>(xmid, y, gates, a.in[I_NFINAL], (float*)d_out);
#endif
}
```

```cpp
#define STAGE 4
#define PER_PHASE_LAUNCH 0
#define REPEAT_MASK 0
#include <hip/hip_runtime.h>
#include <stdint.h>
#include <stdio.h>

#define GAS __attribute__((address_space(1)))
#define LAS __attribute__((address_space(3)))
typedef unsigned short bf16_t;
typedef short bf16x8 __attribute__((ext_vector_type(8)));
typedef short bf16x4 __attribute__((ext_vector_type(4)));
typedef float f32x4 __attribute__((ext_vector_type(4)));
typedef float f32x2 __attribute__((ext_vector_type(2)));
typedef float f32x16 __attribute__((ext_vector_type(16)));
typedef unsigned u32x4 __attribute__((ext_vector_type(4)));
typedef unsigned u32x2 __attribute__((ext_vector_type(2)));
typedef int i32x8 __attribute__((ext_vector_type(8)));
typedef int i32x4 __attribute__((ext_vector_type(4)));
typedef int i32x32 __attribute__((ext_vector_type(32)));

constexpr int T = 16384, SEQL = 8192, DM = 2048, INC = 5136, ZC = 5120, NEXP = 32;
constexpr int ZQ = 0, ZK = 512, ZV = 1024, ZR = 2048, ZLX = 3072, ZLG = 4096;
constexpr int MPAD_MAX = 65536 + NEXP * 256;
constexpr int NCHUNK = 256;

constexpr size_t MiB = 1u << 20;
constexpr size_t WS_CTL = 0, CTL_ZERO_BYTES = 1 * MiB;
constexpr size_t WS_WINT = 1 * MiB;
constexpr size_t WS_WOUTT = WS_WINT + 20 * MiB;
constexpr size_t WS_WGUT = WS_WOUTT + 8 * MiB;
constexpr size_t WS_WDT = WS_WGUT + 512 * MiB;
constexpr size_t WS_WAT = WS_WDT + 256 * MiB;
constexpr size_t WS_WIT = WS_WAT + 512 * 1024;
constexpr size_t WS_WRT = WS_WIT + 512 * 1024;
constexpr size_t WS_H = WS_WRT + 1 * MiB;
constexpr size_t WS_LG = WS_H + 64 * MiB;
constexpr size_t WS_Z = WS_LG + 32 * MiB;
constexpr size_t WS_AN = WS_Z + 160 * MiB;
constexpr size_t WS_DN = WS_AN + 128 * MiB;
constexpr size_t WS_SP = WS_DN + 1 * MiB;
constexpr size_t WS_AUA = WS_SP + 64 * MiB;
constexpr size_t WS_AUU = WS_AUA + 64 * MiB;
constexpr size_t WS_SUMA = WS_AUU + 64 * MiB;
constexpr size_t WS_SUMH = WS_SUMA + 1 * MiB;
constexpr size_t WS_MIX = WS_SUMH + 1 * MiB;
constexpr size_t WS_XMID = WS_MIX + 64 * MiB;
constexpr size_t WS_RSTD = WS_XMID + 128 * MiB;
constexpr size_t WS_TOKE = WS_RSTD + 1 * MiB;
constexpr size_t WS_GATES = WS_TOKE + 1 * MiB;
constexpr size_t WS_ABUF = WS_GATES + 1 * MiB;
constexpr size_t WS_ACT = WS_ABUF + 288 * MiB;
constexpr size_t WS_Y = WS_ACT + 288 * MiB;
constexpr size_t WS_END = WS_Y + 288 * MiB;
constexpr int CW_BAR = 4096;
constexpr int CW_CNT = 16384;

constexpr int RING_BYTES = 131072;
constexpr int SCR_BYTES = 135168;
constexpr int MISC_OFF = SCR_BYTES;
constexpr int LDS_BYTES = 147456;
constexpr int MI_PBASE = 16, MI_NMT = 48, MI_LCNT = 64, MI_LBASE = 96, MI_T2E = 128;

#define LDS_WAIT() asm volatile("s_waitcnt lgkmcnt(0)" ::: "memory")
#define VM_WAIT() asm volatile("s_waitcnt vmcnt(0)" ::: "memory")

__device__ __forceinline__ unsigned f2bf(float f) { unsigned u = __builtin_bit_cast(unsigned, f); return (u + 0x7fffu + ((u >> 16) & 1u)) >> 16; }
__device__ __forceinline__ unsigned pk2(float lo, float hi) { return f2bf(lo) | (f2bf(hi) << 16); }
__device__ __forceinline__ float bf2f(unsigned short b) { return __builtin_bit_cast(float, (unsigned)b << 16); }
__device__ __forceinline__ float bflo(unsigned w) { return __builtin_bit_cast(float, w << 16); }
__device__ __forceinline__ float bfhi(unsigned w) { return __builtin_bit_cast(float, w & 0xffff0000u); }
__device__ __forceinline__ float clamp448(float x) { return __builtin_amdgcn_fmed3f(x, -448.0f, 448.0f); }
__device__ __forceinline__ unsigned pk4_fp8(float a, float b, float c, float d) {
    int p = 0; p = __builtin_amdgcn_cvt_pk_fp8_f32(clamp448(a), clamp448(b), p, false); p = __builtin_amdgcn_cvt_pk_fp8_f32(clamp448(c), clamp448(d), p, true); return (unsigned)p; }
__device__ __forceinline__ float fp8f(unsigned w, int b) { return b == 0 ? __builtin_amdgcn_cvt_f32_fp8((int)w, 0) : b == 1 ? __builtin_amdgcn_cvt_f32_fp8((int)w, 1) : b == 2 ? __builtin_amdgcn_cvt_f32_fp8((int)w, 2) : __builtin_amdgcn_cvt_f32_fp8((int)w, 3); }
__device__ __forceinline__ float wave_sum(float v) {
#pragma unroll
    for (int o = 1; o < 64; o <<= 1) v += __shfl_xor(v, o);
    return v;
}
__device__ __forceinline__ int fresh_lane() { int l; asm volatile("v_mbcnt_lo_u32_b32 %0, -1, 0\n\tv_mbcnt_hi_u32_b32 %0, -1, %0" : "=v"(l)); return l; }
__device__ __forceinline__ float sigmoidf_(float x) { return 1.0f / (1.0f + __expf(-x)); }

#define XB_TMO      128
#define XB_XCNT(j)  (256  + 64 * (j))
#define XB_XSUB(j)  (1280 + 64 * (j))
#define XB_XGEN(j)  (2304 + 64 * (j))
#define XB_TOP      3328
#define XB_TOPGEN   3392
#define XCD_BAR_WORDS 3456
#define XB_SPIN_CAP (1u << 18)

__device__ __forceinline__ unsigned xb_ld(unsigned* p)              { return __hip_atomic_load(p, __ATOMIC_RELAXED, __HIP_MEMORY_SCOPE_AGENT); }
__device__ __forceinline__ unsigned xb_add(unsigned* p, unsigned v) { return __hip_atomic_fetch_add(p, v, __ATOMIC_RELAXED, __HIP_MEMORY_SCOPE_AGENT); }
__device__ __forceinline__ unsigned xb_xcc_id() { return (unsigned)__builtin_amdgcn_s_getreg((3 << 11) | 20) & 0xFu; }
#define XB_SPIN(cond, bar) do { unsigned _sp = 0; while (cond) { __builtin_amdgcn_s_sleep(1); \
    if ((++_sp & 255u) == 0u) { if (xb_ld(&(bar)[XB_TMO])) break; if (_sp > XB_SPIN_CAP) { atomicAdd(&(bar)[XB_TMO], 1u); break; } } } } while (0)

struct XcdBarrier { unsigned* bar; unsigned x; volatile LAS unsigned* st; };

__device__ __forceinline__ XcdBarrier xcd_barrier_post(unsigned* bar, volatile LAS unsigned* st, bool t0) {
    XcdBarrier b; b.bar = bar; b.x = xb_xcc_id(); b.st = st;
    if (t0) (void)xb_add(&bar[XB_XCNT(b.x)], 1u);
    return b;
}
__device__ __forceinline__ void xcd_barrier_complete(unsigned* bar, unsigned x, unsigned& nloc, unsigned& nx) {
    const unsigned G = gridDim.x * gridDim.y * gridDim.z;
    unsigned sum, cnt, mine, sp = 0u;
    for (;;) {
        sum = 0u; cnt = 0u; mine = 0u;
#pragma unroll
        for (unsigned j = 0; j < 16; ++j) { const unsigned c = xb_ld(&bar[XB_XCNT(j)]); sum += c; cnt += (c > 0u) ? 1u : 0u; mine = (j == x) ? c : mine; }
        if (sum == G) break;
        __builtin_amdgcn_s_sleep(1);
        if ((++sp & 255u) == 0u) { if (xb_ld(&bar[XB_TMO])) break; if (sp > XB_SPIN_CAP) { atomicAdd(&bar[XB_TMO], 1u); break; } }
    }
    nloc = mine > 0u ? mine : 1u; nx = cnt > 0u ? cnt : 1u;
}
__device__ __forceinline__ void xcd_barrier(const XcdBarrier& b, bool t0) {
    asm volatile("s_waitcnt vmcnt(0)" ::: "memory");
    __syncthreads();
    if (t0) {
        unsigned* bar = b.bar;
        __builtin_amdgcn_s_waitcnt(0);
        unsigned nloc = b.st[0], nx = b.st[1];
        if (nloc == 0u) { xcd_barrier_complete(bar, b.x, nloc, nx); b.st[0] = nloc; b.st[1] = nx; }
        const unsigned old = xb_add(&bar[XB_XSUB(b.x)], 1u);
        const unsigned gen = old / nloc;
        if (old + 1u == (gen + 1u) * nloc) {
            __builtin_amdgcn_fence(__ATOMIC_RELEASE, "agent");
            asm volatile("s_waitcnt vmcnt(0)" ::: "memory");
            const unsigned og = xb_add(&bar[XB_TOP], 1u);
            const unsigned tg = og / nx;
            if (og + 1u == (tg + 1u) * nx) xb_add(&bar[XB_TOPGEN], 1u);
            else XB_SPIN(xb_ld(&bar[XB_TOPGEN]) == tg, bar);
            __builtin_amdgcn_fence(__ATOMIC_ACQUIRE, "agent");
            xb_add(&bar[XB_XGEN(b.x)], 1u);
            asm volatile("s_waitcnt vmcnt(0)" ::: "memory");
        } else {
            XB_SPIN(xb_ld(&bar[XB_XGEN(b.x)]) == gen, bar);
            __builtin_amdgcn_fence(__ATOMIC_ACQUIRE, "agent");
            asm volatile("s_waitcnt vmcnt(0)" ::: "memory");
        }
    }
    __syncthreads();
}

namespace pg8 {
constexpr int BM = 256, BK = 64, HALF = 128, HTB = HALF * BK * 2, STAGE_BYTES = 8 * HTB, NXCD = 8, WGM = 8;
__host__ __device__ __forceinline__ int lds_byte(int r, int c) { const int st = (r >> 4) * 2 + (c >> 5), rr = r & 15, cc = c & 31, ob = rr * 64 + cc * 2; return st * 1024 + (ob ^ (((ob >> 9) & 1) << 5)); }
__host__ __device__ __forceinline__ void stage_rc(int b, int& R, int& C) { const int st = b / 1024, sb = b % 1024, swz = sb ^ (((sb >> 9) & 1) << 5); R = (st >> 1) * 16 + swz / 64; C = (st & 1) * 32 + (swz % 64) / 2; }
__host__ __device__ __forceinline__ int perm32(int rho) { const int n = rho >> 4, i = rho & 15; return 8 * (i >> 2) + 4 * n + (i & 3); }

struct Unit { int pm, pn, e; };
struct Gemm { const void* A; const void* Bt; };
template <int LDA_, int LDB_, int KB_, size_t SB_> struct GShape { static constexpr int LDA = LDA_, LDB = LDB_, KB = KB_; static constexpr size_t SB = SB_; };

__device__ __forceinline__ bool order_map(int L, int nM, int nN, int& pm, int& pn) {
    const int nwg = nM * nN; if (L >= nwg) return false;
    int wgid = L; { const int q = nwg / NXCD, r = nwg % NXCD, xcd = wgid % NXCD, off = wgid / NXCD; wgid = (xcd < r ? xcd * (q + 1) : r * (q + 1) + (xcd - r) * q) + off; }
    const int nig = WGM * nN, gid = wgid / nig, fm = gid * WGM, gsz = (nM - fm) < WGM ? (nM - fm) : WGM;
    pm = fm + ((wgid % nig) % gsz); pn = (wgid % nig) / gsz; return true;
}
struct StaticOrder {
    int nM, nN, G, c;
    __device__ void init(int M, int N, int G_, int c_) { nM = M / BM; nN = N / BM; G = G_; c = c_; }
    __device__ __forceinline__ bool next(int i, Unit& u) const { u.e = 0; return order_map(i * G + c, nM, nN, u.pm, u.pn); }
};
struct MoeOrder {
    int nM, nN, G, c; const LAS int* t2e;
    __device__ __forceinline__ bool next(int i, Unit& u) const { if (!order_map(i * G + c, nM, nN, u.pm, u.pn)) return false; u.e = __builtin_amdgcn_readfirstlane(t2e[u.pm]); return true; }
};

__device__ __forceinline__ unsigned cvt_pk_bf16(float lo, float hi) { unsigned r; asm volatile("v_cvt_pk_bf16_f32 %0, %1, %2" : "=v"(r) : "v"(lo), "v"(hi)); return r; }

struct EpiBf16 {
    static constexpr bool PERM = true;
    bf16_t* O; int ldc; const float* bias; int bias_stride;
    __device__ __forceinline__ void operator()(const f32x4 (&acc)[2][2][4][2], const Unit& u, int wr, int wc, int fr, int fq) const {
        const int row0 = u.pm * BM + wr * 64 + fr; const int col0 = u.pn * BM + wc * 32 + 8 * fq;
        f32x4 bv[2][2];
#pragma unroll
        for (int bj = 0; bj < 2; ++bj)
#pragma unroll
            for (int n = 0; n < 2; ++n) bv[bj][n] = bias ? *(const f32x4*)(bias + (size_t)u.e * bias_stride + col0 + bj * HALF + 4 * n) : (f32x4){0.f, 0.f, 0.f, 0.f};
#pragma unroll
        for (int ai = 0; ai < 2; ++ai)
#pragma unroll
            for (int m = 0; m < 4; ++m) { bf16_t* rowp = O + (size_t)(row0 + ai * HALF + m * 16) * ldc + col0;
#pragma unroll
                for (int bj = 0; bj < 2; ++bj) { const f32x4 v0 = acc[ai][bj][m][0] + bv[bj][0], v1 = acc[ai][bj][m][1] + bv[bj][1];
                    u32x4 w; w.x = cvt_pk_bf16(v0[0], v0[1]); w.y = cvt_pk_bf16(v0[2], v0[3]); w.z = cvt_pk_bf16(v1[0], v1[1]); w.w = cvt_pk_bf16(v1[2], v1[3]);
                    *(u32x4*)(rowp + bj * HALF) = w; } }
    }
};
struct EpiF32Res {
    static constexpr bool PERM = false;
    float* C; const float* resid; int ldc;
    __device__ __forceinline__ void operator()(const f32x4 (&acc)[2][2][4][2], const Unit& u, int wr, int wc, int fr, int fq) const {
        const int row0 = u.pm * BM + wr * 64 + fr, col0 = u.pn * BM + wc * 32 + 4 * fq;
#pragma unroll
        for (int ai = 0; ai < 2; ++ai)
#pragma unroll
            for (int m = 0; m < 4; ++m) { const size_t off = (size_t)(row0 + ai * HALF + m * 16) * ldc + col0;
#pragma unroll
                for (int bj = 0; bj < 2; ++bj)
#pragma unroll
                    for (int n = 0; n < 2; ++n) { const f32x4 r = *(const f32x4*)(resid + off + bj * HALF + n * 16); *(f32x4*)(C + off + bj * HALF + n * 16) = acc[ai][bj][m][n] + r; } }
    }
};
struct EpiSwiGLU {
    static constexpr bool PERM = true;
    bf16_t* O; int ldc; const float* bias;
    __device__ __forceinline__ void operator()(const f32x4 (&acc)[2][2][4][2], const Unit& u, int wr, int wc, int fr, int fq) const {
        const int row0 = u.pm * BM + wr * 64 + fr; const int j0 = u.pn * HALF + wc * 32 + 8 * fq;
        const float* be = bias + (size_t)u.e * 4096;
        f32x4 bg[2], bu[2];
#pragma unroll
        for (int n = 0; n < 2; ++n) { bg[n] = *(const f32x4*)(be + j0 + 4 * n); bu[n] = *(const f32x4*)(be + 2048 + j0 + 4 * n); }
#pragma unroll
        for (int ai = 0; ai < 2; ++ai)
#pragma unroll
            for (int m = 0; m < 4; ++m) { bf16_t* rowp = O + (size_t)(row0 + ai * HALF + m * 16) * ldc + j0;
                float o[8];
#pragma unroll
                for (int n = 0; n < 2; ++n) { const f32x4 g = acc[ai][0][m][n] + bg[n], up = acc[ai][1][m][n] + bu[n];
#pragma unroll
                    for (int q = 0; q < 4; ++q) { const float gt = fminf(g[q], 7.0f), ut = fminf(fmaxf(up[q], -7.0f), 7.0f);
                        const float glu = gt * __builtin_amdgcn_rcpf(1.0f + __expf(-1.702f * gt)); o[4 * n + q] = (ut + 1.0f) * glu; } }
                u32x4 w; w.x = cvt_pk_bf16(o[0], o[1]); w.y = cvt_pk_bf16(o[2], o[3]); w.z = cvt_pk_bf16(o[4], o[5]); w.w = cvt_pk_bf16(o[6], o[7]);
                *(u32x4*)rowp = w; }
    }
};

struct EpiBf16Res {
    static constexpr bool PERM = true;
    bf16_t* O; const float* resid; int ldc;
    __device__ __forceinline__ void operator()(const f32x4 (&acc)[2][2][4][2], const Unit& u, int wr, int wc, int fr, int fq) const {
        const int row0 = u.pm * BM + wr * 64 + fr; const int col0 = u.pn * BM + wc * 32 + 8 * fq;
#pragma unroll
        for (int ai = 0; ai < 2; ++ai)
#pragma unroll
            for (int m = 0; m < 4; ++m) { const size_t off = (size_t)(row0 + ai * HALF + m * 16) * ldc + col0;
#pragma unroll
                for (int bj = 0; bj < 2; ++bj) { const f32x4 r0 = *(const f32x4*)(resid + off + bj * HALF), r1 = *(const f32x4*)(resid + off + bj * HALF + 4);
                    const f32x4 v0 = acc[ai][bj][m][0] + r0, v1 = acc[ai][bj][m][1] + r1;
                    u32x4 w; w.x = cvt_pk_bf16(v0[0], v0[1]); w.y = cvt_pk_bf16(v0[2], v0[3]); w.z = cvt_pk_bf16(v1[0], v1[1]); w.w = cvt_pk_bf16(v1[2], v1[3]);
                    *(u32x4*)(O + off + bj * HALF) = w; } }
    }
};
struct EpiFp8S {
    static constexpr bool PERM = true;
    unsigned char* O; int ldc; const float* bias; int bias_stride; float scale, oscale;
    __device__ __forceinline__ void operator()(const f32x4 (&acc)[2][2][4][2], const Unit& u, int wr, int wc, int fr, int fq) const {
        const int row0 = u.pm * BM + wr * 64 + fr; const int col0 = u.pn * BM + wc * 32 + 8 * fq;
        f32x4 bv[2][2];
#pragma unroll
        for (int bj = 0; bj < 2; ++bj)
#pragma unroll
            for (int n = 0; n < 2; ++n) bv[bj][n] = *(const f32x4*)(bias + (size_t)u.e * bias_stride + col0 + bj * HALF + 4 * n) * oscale;
        const float sc = scale * oscale;
#pragma unroll
        for (int ai = 0; ai < 2; ++ai)
#pragma unroll
            for (int m = 0; m < 4; ++m) { unsigned char* rowp = O + (size_t)(row0 + ai * HALF + m * 16) * ldc + col0;
#pragma unroll
                for (int bj = 0; bj < 2; ++bj) { const f32x4 v0 = acc[ai][bj][m][0] * sc + bv[bj][0], v1 = acc[ai][bj][m][1] * sc + bv[bj][1];
                    u32x2 w; w.x = pk4_fp8(v0[0], v0[1], v0[2], v0[3]); w.y = pk4_fp8(v1[0], v1[1], v1[2], v1[3]);
                    *(u32x2*)(rowp + bj * HALF) = w; } }
    }
};
struct EpiSwiGLU8 {
    static constexpr bool PERM = true;
    unsigned char* O; int ldc; const float* bias;
    __device__ __forceinline__ void operator()(const f32x4 (&acc)[2][2][4][2], const Unit& u, int wr, int wc, int fr, int fq) const {
        const int row0 = u.pm * BM + wr * 64 + fr; const int j0 = u.pn * HALF + wc * 32 + 8 * fq;
        const float* be = bias + (size_t)u.e * 4096;
        f32x4 bg[2], bu[2];
#pragma unroll
        for (int n = 0; n < 2; ++n) { bg[n] = *(const f32x4*)(be + j0 + 4 * n); bu[n] = *(const f32x4*)(be + 2048 + j0 + 4 * n); }
#pragma unroll
        for (int ai = 0; ai < 2; ++ai)
#pragma unroll
            for (int m = 0; m < 4; ++m) { unsigned char* rowp = O + (size_t)(row0 + ai * HALF + m * 16) * ldc + j0;
                float o[8];
#pragma unroll
                for (int n = 0; n < 2; ++n) { const f32x4 g = acc[ai][0][m][n] * (1.0f / 8192.0f) + bg[n], up = acc[ai][1][m][n] * (1.0f / 8192.0f) + bu[n];
#pragma unroll
                    for (int q = 0; q < 4; ++q) { const float gt = fminf(g[q], 7.0f), ut = fminf(fmaxf(up[q], -7.0f), 7.0f);
                        const float glu = gt * __builtin_amdgcn_rcpf(1.0f + __expf(-1.702f * gt)); o[4 * n + q] = 4.0f * (ut + 1.0f) * glu; } }
                u32x2 w; w.x = pk4_fp8(o[0], o[1], o[2], o[3]); w.y = pk4_fp8(o[4], o[5], o[6], o[7]);
                *(u32x2*)rowp = w; }
    }
};
struct EpiBf16S {
    static constexpr bool PERM = true;
    bf16_t* O; int ldc; const float* bias; int bias_stride; float scale;
    __device__ __forceinline__ void operator()(const f32x4 (&acc)[2][2][4][2], const Unit& u, int wr, int wc, int fr, int fq) const {
        const int row0 = u.pm * BM + wr * 64 + fr; const int col0 = u.pn * BM + wc * 32 + 8 * fq;
        f32x4 bv[2][2];
#pragma unroll
        for (int bj = 0; bj < 2; ++bj)
#pragma unroll
            for (int n = 0; n < 2; ++n) bv[bj][n] = *(const f32x4*)(bias + (size_t)u.e * bias_stride + col0 + bj * HALF + 4 * n);
#pragma unroll
        for (int ai = 0; ai < 2; ++ai)
#pragma unroll
            for (int m = 0; m < 4; ++m) { bf16_t* rowp = O + (size_t)(row0 + ai * HALF + m * 16) * ldc + col0;
#pragma unroll
                for (int bj = 0; bj < 2; ++bj) { const f32x4 v0 = acc[ai][bj][m][0] * scale + bv[bj][0], v1 = acc[ai][bj][m][1] * scale + bv[bj][1];
                    u32x4 w; w.x = cvt_pk_bf16(v0[0], v0[1]); w.y = cvt_pk_bf16(v0[2], v0[3]); w.z = cvt_pk_bf16(v1[0], v1[1]); w.w = cvt_pk_bf16(v1[2], v1[3]);
                    *(u32x4*)(rowp + bj * HALF) = w; } }
    }
};

__device__ __forceinline__ i32x8 pg8_get8(const i32x32& v, int idx) { i32x8 r;
#pragma unroll
    for (int j = 0; j < 8; ++j) r[j] = v[8 * idx + j];
    return r; }
__device__ __forceinline__ i32x4 pg8_get4(const i32x32& v, int idx) { i32x4 r;
#pragma unroll
    for (int j = 0; j < 4; ++j) r[j] = v[4 * idx + j];
    return r; }
template <class Epi, class Sched, class GS, bool ALIGN_EPI = true, bool F8 = false>
__device__ __forceinline__ void gemm_phase(LAS unsigned char* lds, const Gemm g, const Sched& S, const Epi& E, int wave) {
    const int wid = wave, lane = fresh_lane(), tid = wid * 64 + lane, wr = wid >> 2, wc = wid & 3, fr = lane & 15, fq = lane >> 4;
    constexpr int nt = GS::KB / 128;
    unsigned voffA, voffB;
    { int R, C; stage_rc(tid * 16, R, C); const int Rb = Epi::PERM ? ((R & ~31) + perm32(R & 31)) : R;
      voffA = (unsigned)(R * GS::LDA + C * 2); voffB = (unsigned)(Rb * GS::LDB + C * 2); }
    constexpr size_t pstepA = (size_t)64 * GS::LDA, pstepB = (size_t)64 * GS::LDB;
    constexpr size_t kstep = (size_t)(BK * 2);
    constexpr size_t hstepA = (size_t)HALF * GS::LDA, hstepB = (size_t)HALF * GS::LDB;
    constexpr size_t tstepA = 2 * hstepA, tstepB = 2 * hstepB;
    const unsigned ldsw = (unsigned)wid * 1024u;
    const unsigned ldsb = (unsigned)(size_t)lds + ldsw;
    const int aoff = lds_byte(wr * 64 + fr, F8 ? fq * 16 : fq * 8), boff = lds_byte(wc * 32 + fr, F8 ? fq * 16 : fq * 8);
    const int kofs = F8 ? 16 : 1024;
#define PG8_SA(b, h) (((b) * 2 + (h)) * HTB)
#define PG8_SB(b, h) ((4 + (b) * 2 + (h)) * HTB)
#define PG8_STAGE(bufoff, gbase, voff) do { _Pragma("unroll") for (int _i = 0; _i < 2; ++_i) { unsigned _keep; \
        asm volatile("s_mov_b32 %0, m0\n\ts_mov_b32 m0, %3\n\ts_nop 0\n\tglobal_load_lds_dwordx4 %1, %2\n\ts_mov_b32 m0, %0" \
            : "=&s"(_keep) : "v"(voff##_v), "s"((const char*)(gbase) + _i * pstep##voff), "s"(ldsb + (unsigned)((bufoff) + _i * 8192)) : "memory"); } } while (0)
#define pstepvoffA pstepA
#define pstepvoffB pstepB
#define voffA_v voffA
#define voffB_v voffB
#define PG8_LD16(p) (*(const LAS i32x4*)(p))
#define PG8_SET8(V, idx, lo, hi) do { _Pragma("unroll") for (int _j = 0; _j < 4; ++_j) { V[8 * (idx) + _j] = (lo)[_j]; V[8 * (idx) + 4 + _j] = (hi)[_j]; } } while (0)
#define PG8_GET8(V, idx) pg8_get8(V, idx)
#define PG8_GETLO(V, idx) __builtin_bit_cast(bf16x8, pg8_get4(V, 2 * (idx)))
#define PG8_GETHI(V, idx) __builtin_bit_cast(bf16x8, pg8_get4(V, 2 * (idx) + 1))
#define PG8_LDA(dst, b, h) do { _Pragma("unroll") for (int m = 0; m < 4; ++m) { const i32x4 _lo = PG8_LD16(lds + PG8_SA(b, h) + aoff + m * 2048), _hi = PG8_LD16(lds + PG8_SA(b, h) + aoff + m * 2048 + kofs); \
        PG8_SET8(AV, m, _lo, _hi); } } while (0)
#define PG8_LDB(dst, b, h) do { _Pragma("unroll") for (int n = 0; n < 2; ++n) { const i32x4 _lo = PG8_LD16(lds + PG8_SB(b, h) + boff + n * 2048), _hi = PG8_LD16(lds + PG8_SB(b, h) + boff + n * 2048 + kofs); \
        PG8_SET8(BV, (dst) + n, _lo, _hi); } } while (0)
#define PG8_MMA(ai, bj, At, Bt) do { __builtin_amdgcn_s_setprio(1); \
        if constexpr (F8) { _Pragma("unroll") for (int m = 0; m < 4; ++m) _Pragma("unroll") for (int n = 0; n < 2; ++n) \
            acc[ai][bj][m][n] = __builtin_amdgcn_mfma_scale_f32_16x16x128_f8f6f4(PG8_GET8(BV, (Bt) + n), PG8_GET8(AV, m), acc[ai][bj][m][n], 0, 0, 0, 0, 0, 0); } \
        else { _Pragma("unroll") for (int m = 0; m < 4; ++m) _Pragma("unroll") for (int n = 0; n < 2; ++n) { \
            acc[ai][bj][m][n] = __builtin_amdgcn_mfma_f32_16x16x32_bf16(PG8_GETLO(BV, (Bt) + n), PG8_GETLO(AV, m), acc[ai][bj][m][n], 0, 0, 0); \
            acc[ai][bj][m][n] = __builtin_amdgcn_mfma_f32_16x16x32_bf16(PG8_GETHI(BV, (Bt) + n), PG8_GETHI(AV, m), acc[ai][bj][m][n], 0, 0, 0); } } \
        __builtin_amdgcn_s_setprio(0); } while (0)
#define PG8_WAIT_V(n) asm volatile("s_waitcnt vmcnt(" #n ")" ::: "memory")
#define PG8_WAIT_L(n) asm volatile("s_waitcnt lgkmcnt(" #n ")" ::: "memory")
#define PG8_BAR __builtin_amdgcn_s_barrier()
#define PG8_SCHED __builtin_amdgcn_sched_barrier(0)
    Unit cur, nxt; int ui = 0;
    if (!S.next(0, cur)) return;
    i32x32 AV, BV;
    constexpr int At = 0, B0 = 0, B1 = 2;
    const char* cA = (const char*)g.A + (size_t)cur.pm * tstepA; const char* cB = (const char*)g.Bt + (size_t)cur.e * GS::SB + (size_t)cur.pn * tstepB;
    PG8_STAGE(PG8_SB(0, 0), cB, voffB); PG8_SCHED; PG8_STAGE(PG8_SB(0, 1), cB + hstepB, voffB); PG8_SCHED; PG8_STAGE(PG8_SA(0, 0), cA, voffA); PG8_SCHED; PG8_STAGE(PG8_SA(0, 1), cA + hstepA, voffA); PG8_SCHED;
    if (wr == 1) PG8_BAR;
    PG8_WAIT_V(2); PG8_BAR;
    PG8_STAGE(PG8_SB(1, 0), cB + kstep, voffB); PG8_SCHED; PG8_STAGE(PG8_SA(1, 0), cA + kstep, voffA); PG8_SCHED; PG8_STAGE(PG8_SB(1, 1), cB + hstepB + kstep, voffB); PG8_SCHED;
    PG8_WAIT_V(6); PG8_BAR; PG8_SCHED;
    f32x4 acc[2][2][4][2];
#pragma unroll
    for (int a = 0; a < 2; ++a)
#pragma unroll
        for (int b = 0; b < 2; ++b)
#pragma unroll
            for (int m = 0; m < 4; ++m)
#pragma unroll
                for (int n = 0; n < 2; ++n) acc[a][b][m][n] = (f32x4){0.f, 0.f, 0.f, 0.f};
    for (;;) {
        const bool has_next = S.next(ui + 1, nxt);
        const char* nA = has_next ? (const char*)g.A + (size_t)nxt.pm * tstepA : cA;
        const char* nB = has_next ? (const char*)g.Bt + (size_t)nxt.e * GS::SB + (size_t)nxt.pn * tstepB : cB;
        for (int t = 0; t < nt; t += 2) {
            const bool last = (t == nt - 2);
            const char* a1 = cA + (size_t)(t + 1) * kstep;
            const char* a2 = last ? nA : cA + (size_t)(t + 2) * kstep; const char* b2 = last ? nB : cB + (size_t)(t + 2) * kstep;
            const char* a3 = a2 + kstep; const char* b3 = b2 + kstep;
            PG8_LDB(B0, 0, 0); PG8_LDB(B1, 0, 1); PG8_SCHED; PG8_LDA(At, 0, 0); PG8_STAGE(PG8_SA(1, 1), a1 + hstepA, voffA);
            PG8_WAIT_V(8); PG8_WAIT_L(0); PG8_BAR; PG8_MMA(0, 0, At, B0); PG8_MMA(0, 1, At, B1); PG8_BAR; PG8_SCHED;
            PG8_LDA(At, 0, 1); PG8_STAGE(PG8_SB(0, 0), b2, voffB); PG8_STAGE(PG8_SB(0, 1), b2 + hstepB, voffB); PG8_STAGE(PG8_SA(0, 0), a2, voffA);
            PG8_WAIT_V(8); PG8_WAIT_L(0); PG8_BAR; PG8_MMA(1, 0, At, B0); PG8_MMA(1, 1, At, B1); PG8_BAR; PG8_SCHED;
            PG8_LDB(B0, 1, 0); PG8_LDB(B1, 1, 1); PG8_SCHED; PG8_LDA(At, 1, 0); PG8_STAGE(PG8_SA(0, 1), a2 + hstepA, voffA);
            PG8_WAIT_V(8); PG8_WAIT_L(0); PG8_BAR; PG8_MMA(0, 0, At, B0); PG8_MMA(0, 1, At, B1); PG8_BAR; PG8_SCHED;
            PG8_LDA(At, 1, 1); PG8_STAGE(PG8_SB(1, 0), b3, voffB); PG8_STAGE(PG8_SB(1, 1), b3 + hstepB, voffB); PG8_STAGE(PG8_SA(1, 0), a3, voffA);
            PG8_WAIT_V(8); PG8_WAIT_L(0); PG8_BAR; PG8_MMA(1, 0, At, B0); PG8_MMA(1, 1, At, B1); PG8_BAR; PG8_SCHED;
        }
        if constexpr (ALIGN_EPI) { if (wr == 0) PG8_BAR; }
        { const int l2 = fresh_lane();
          E(acc, cur, wr, wc, l2 & 15, l2 >> 4); }
        if (!has_next) break;
#pragma unroll
        for (int a = 0; a < 2; ++a)
#pragma unroll
            for (int b = 0; b < 2; ++b)
#pragma unroll
                for (int m = 0; m < 4; ++m)
#pragma unroll
                    for (int n = 0; n < 2; ++n) acc[a][b][m][n] = (f32x4){0.f, 0.f, 0.f, 0.f};
        cur = nxt; cA = nA; cB = nB; ++ui;
        if constexpr (ALIGN_EPI) { if (wr == 1) PG8_BAR; }
    }
    PG8_WAIT_V(0);
    if constexpr (!ALIGN_EPI) { if (wr == 0) PG8_BAR; }
    PG8_BAR;
#undef PG8_SA
#undef PG8_SB
#undef PG8_STAGE
#undef pstepvoffA
#undef pstepvoffB
#undef voffA_v
#undef voffB_v
#undef PG8_LDA
#undef PG8_LD16
#undef PG8_SET8
#undef PG8_GET8
#undef PG8_GETLO
#undef PG8_GETHI
#undef PG8_LDB
#undef PG8_MMA
#undef PG8_WAIT_V
#undef PG8_WAIT_L
#undef PG8_BAR
#undef PG8_SCHED
}
}
struct Params {
    const float* in[22];
    float* out; unsigned char* ws;
    int ph_lo, ph_hi;
};
enum { I_X = 0, I_NMG, I_WIN, I_GWG, I_GBG, I_GNG, I_CW, I_CB, I_WA, I_BA, I_WI, I_BI, I_AP, I_WOUT, I_NFG, I_WR, I_BR, I_WGU, I_BGU, I_WDN, I_BDN, I_NFINAL };

struct Frame {
    LAS unsigned char* lds; volatile LAS unsigned* MISC;
    int tid, lane, wave, G, gw, NGW;
    unsigned char* ws;
};

__device__ __forceinline__ float gelu_tanh_f(float x) {
    const float u = 0.7978845608028654f * (x + 0.044715f * x * x * x);
    const float e = __expf(2.0f * u);
    const float th = 1.0f - 2.0f * __builtin_amdgcn_rcpf(e + 1.0f);
    return 0.5f * x * (1.0f + th);
}
__device__ __forceinline__ float log_sigmoid_f(float s) { return fminf(s, 0.f) - log1pf(__expf(-fabsf(s))); }

__device__ __forceinline__ void p0_item(const float* W, int ldw, int col0, bf16_t* WT, int ldt, size_t drow0, int k0, LAS float* scr, int lane) {
    (void)scr;
    const float* src = W + (size_t)k0 * ldw + col0 + lane;
    float v[64];
#pragma unroll
    for (int i = 0; i < 64; ++i) v[i] = src[(size_t)i * ldw];
    bf16_t* dst = WT + (drow0 + lane) * (size_t)ldt + k0;
#pragma unroll
    for (int c = 0; c < 8; ++c) { u32x4 o; o.x = pk2(v[8 * c], v[8 * c + 1]); o.y = pk2(v[8 * c + 2], v[8 * c + 3]); o.z = pk2(v[8 * c + 4], v[8 * c + 5]); o.w = pk2(v[8 * c + 6], v[8 * c + 7]);
        *(u32x4*)(dst + 8 * c) = o; }
}

__device__ __forceinline__ void p0_item8(const float* W, int ldw, int col0, unsigned char* WT, int ldt, size_t drow0, int k0, int lane) {
    const float* src = W + (size_t)k0 * ldw + col0 + lane;
    float v[64];
#pragma unroll
    for (int i = 0; i < 64; ++i) v[i] = src[(size_t)i * ldw];
    unsigned char* dst = WT + (drow0 + lane) * (size_t)ldt + k0;
#pragma unroll
    for (int c = 0; c < 4; ++c) { u32x4 o;
#pragma unroll
        for (int q = 0; q < 4; ++q) o[q] = pk4_fp8(v[16 * c + 4 * q] * 512.0f, v[16 * c + 4 * q + 1] * 512.0f, v[16 * c + 4 * q + 2] * 512.0f, v[16 * c + 4 * q + 3] * 512.0f);
        *(u32x4*)(dst + 16 * c) = o; }
}

struct CoopTile { const float* W; int ldw; int col0; unsigned char* WT; int ldt_b; int mode; int k0; int gu; int drow0; };
__device__ __forceinline__ void coop_load(const CoopTile& t, int w, int l, f32x4 (&v)[16]) {
    if (t.mode == 0) {
#pragma unroll
        for (int i = 0; i < 8; ++i) { const float* r = t.W + (size_t)(t.k0 + 8 * w + i) * t.ldw + t.col0 + 4 * l; v[2 * i] = *(const f32x4*)r; v[2 * i + 1] = *(const f32x4*)(r + 256); }
    } else {
#pragma unroll
        for (int i = 0; i < 16; ++i) v[i] = *(const f32x4*)(t.W + (size_t)(t.k0 + 16 * w + i) * t.ldw + t.col0 + 4 * l);
    }
}
__device__ __forceinline__ void coop_to_lds(const CoopTile& t, int w, int l, const f32x4 (&v)[16], LAS unsigned char* buf) {
    const int sw = (w ^ (l & 7)) * 16;
    if (t.mode == 0) {
#pragma unroll
        for (int jp = 0; jp < 2; ++jp)
#pragma unroll
            for (int j = 0; j < 4; ++j) { u32x4 o; o.x = pk2(v[0 + jp][j], v[2 + jp][j]); o.y = pk2(v[4 + jp][j], v[6 + jp][j]); o.z = pk2(v[8 + jp][j], v[10 + jp][j]); o.w = pk2(v[12 + jp][j], v[14 + jp][j]);
                *(LAS u32x4*)(buf + (256 * jp + 4 * l + j) * 128 + sw) = o; }
    } else {
#pragma unroll
        for (int j = 0; j < 4; ++j) { u32x4 o;
#pragma unroll
            for (int q = 0; q < 4; ++q) o[q] = pk4_fp8(v[4 * q][j] * 512.0f, v[4 * q + 1][j] * 512.0f, v[4 * q + 2][j] * 512.0f, v[4 * q + 3][j] * 512.0f);
            *(LAS u32x4*)(buf + (4 * l + j) * 128 + sw) = o; }
    }
}
__device__ __forceinline__ void coop_store(const CoopTile& t, int w, int l, const LAS unsigned char* buf) {
    const int nrows = t.mode == 0 ? 512 : 256; const int cp = l & 7;
    for (int n = 8 * w + (l >> 3); n < nrows; n += 64) {
        const u32x4 o = *(const LAS u32x4*)(buf + n * 128 + cp * 16); const int c = cp ^ ((n >> 2) & 7);
        int drow;
        if (t.gu) { const int g = t.col0 + n; drow = (g < 2048) ? (256 * (g >> 7) + (g & 127)) : (256 * ((g - 2048) >> 7) + 128 + ((g - 2048) & 127)); } else drow = t.drow0 + n;
        *(u32x4*)(t.WT + (size_t)drow * t.ldt_b + (t.mode == 0 ? 2 * t.k0 : t.k0) + 16 * c) = o; }
}
__device__ __forceinline__ bool coop_tile(const Params& p, unsigned char* ws, int it, CoopTile& t) {
    constexpr int N_GU = 32 * 256, N_DN = 32 * 128, N_INA = 32 * 6, N_INB = 32 * 4, N_OUT = 32 * 4;
    int r = it;
    if (r < N_GU) { const int e = r >> 8, q = r & 255, kb = q >> 4, nb = q & 15; t = CoopTile{p.in[I_WGU] + (size_t)e * DM * 4096, 4096, 256 * nb, ws + WS_WGUT + (size_t)e * 4096 * DM, DM, 1, 128 * kb, 1, 0}; return true; } r -= N_GU;
    if (r < N_DN) { const int e = r >> 7, q = r & 127, kb = q >> 3, nb = q & 7; t = CoopTile{p.in[I_WDN] + (size_t)e * DM * DM, DM, 256 * nb, ws + WS_WDT + (size_t)e * DM * DM, DM, 1, 128 * kb, 0, 256 * nb}; return true; } r -= N_DN;
    if (r < N_INA) { const int kb = r / 6, nb = r % 6; t = CoopTile{p.in[I_WIN], INC, 512 * nb, ws + WS_WINT, DM * 2, 0, 64 * kb, 0, 512 * nb}; return true; } r -= N_INA;
    if (r < N_INB) { const int kb = r >> 2, nb = r & 3; t = CoopTile{p.in[I_WIN], INC, 3088 + 512 * nb, ws + WS_WINT, DM * 2, 0, 64 * kb, 0, 3072 + 512 * nb}; return true; } r -= N_INB;
    if (r < N_OUT) { const int kb = r >> 2, nb = r & 3; t = CoopTile{p.in[I_WOUT], DM, 512 * nb, ws + WS_WOUTT, DM * 2, 0, 64 * kb, 0, 512 * nb}; return true; }
    return false;
}
__device__ __forceinline__ void p0a(Frame& F, const Params& p) {
    const int w = F.wave, l = F.lane;
    CoopTile cur, nxt; f32x4 v[16];
    int it = blockIdx.x; bool have = coop_tile(p, F.ws, it, cur);
    if (have) coop_load(cur, w, l, v);
    int par = 0;
    while (have) {
        LAS unsigned char* buf = F.lds + par * 65536;
        coop_to_lds(cur, w, l, v, buf);
        it += F.G; const bool hn = coop_tile(p, F.ws, it, nxt);
        if (hn) coop_load(nxt, w, l, v);
        __syncthreads();
        coop_store(cur, w, l, buf);
        cur = nxt; have = hn; par ^= 1;
    }
    __syncthreads();
    { bf16_t* WaT = (bf16_t*)(F.ws + WS_WAT); bf16_t* WiT = (bf16_t*)(F.ws + WS_WIT);
      for (int r = F.gw; r < 128; r += F.NGW) { const int which = r >> 6, h = (r >> 4) & 3, kb = (r >> 2) & 3, nb = r & 3;
          p0_item((which ? p.in[I_WI] : p.in[I_WA]) + (size_t)h * 65536, 256, 64 * nb, (which ? WiT : WaT) + (size_t)h * 65536, 256, (size_t)64 * nb, 64 * kb, nullptr, F.lane); } }
    { float* WrT = (float*)(F.ws + WS_WRT); const float* wr = p.in[I_WR]; const float* gf = p.in[I_NFG];
      for (int idx = (int)blockIdx.x * 512 + F.tid; idx < 32 * DM; idx += F.G * 512) { const int n = idx >> 11, k = idx & 2047; WrT[idx] = wr[k * 32 + n] * gf[k]; } }
}
__device__ __forceinline__ void p0b(Frame& F, const Params& p) {
    const float* w_in = p.in[I_WIN];
    __syncthreads();
    { LAS f32x4* Wl = (LAS f32x4*)F.lds;
      for (int idx = F.tid; idx < 8192; idx += 512) { const int l = idx & 63, i = (idx >> 6) & 3, j = (idx >> 8) & 7, c4 = idx >> 11; const int k = 4 * l + 256 * j + i;
          Wl[idx] = *(const f32x4*)(w_in + (size_t)k * INC + 3072 + 4 * c4); }
      __syncthreads();
      const float* x = p.in[I_X]; const float* g1 = p.in[I_NMG]; const float* wg = p.in[I_GWG]; const float* bgp = p.in[I_GBG];
      bf16_t* H = (bf16_t*)(F.ws + WS_H); float* LG = (float*)(F.ws + WS_LG);
      const int l = F.lane;
      f32x4 xn[2][8];
#pragma unroll
      for (int r = 0; r < 2; ++r)
#pragma unroll
          for (int j = 0; j < 8; ++j) xn[r][j] = (2 * F.gw < T) ? *(const f32x4*)(x + (size_t)(2 * F.gw + r) * DM + 4 * l + 256 * j) : (f32x4){0.f, 0.f, 0.f, 0.f};
      for (int q = F.gw; 2 * q < T; q += F.NGW) {
          const int m = 2 * q;
          f32x4 xv[2][8]; float ss[2] = {0.f, 0.f};
#pragma unroll
          for (int r = 0; r < 2; ++r)
#pragma unroll
              for (int j = 0; j < 8; ++j) { xv[r][j] = xn[r][j]; ss[r] += (xv[r][j][0] * xv[r][j][0] + xv[r][j][1] * xv[r][j][1]) + (xv[r][j][2] * xv[r][j][2] + xv[r][j][3] * xv[r][j][3]); }
          if (2 * (q + F.NGW) < T) {
#pragma unroll
              for (int r = 0; r < 2; ++r)
#pragma unroll
                  for (int j = 0; j < 8; ++j) xn[r][j] = *(const f32x4*)(x + (size_t)(2 * (q + F.NGW) + r) * DM + 4 * l + 256 * j); }
          float rs[2];
#pragma unroll
          for (int r = 0; r < 2; ++r) rs[r] = 1.0f / sqrtf(wave_sum(ss[r]) * (1.0f / DM) + 1e-6f);
          float acc[2][16];
#pragma unroll
          for (int r = 0; r < 2; ++r)
#pragma unroll
              for (int c = 0; c < 16; ++c) acc[r][c] = 0.f;
#pragma unroll
          for (int j = 0; j < 8; ++j) { __builtin_amdgcn_sched_barrier(0); const f32x4 gv = *(const f32x4*)(g1 + 4 * l + 256 * j);
#pragma unroll
              for (int r = 0; r < 2; ++r) { xv[r][j] = xv[r][j] * rs[r] * gv;
                  u32x2 o; o.x = pk2(xv[r][j][0], xv[r][j][1]); o.y = pk2(xv[r][j][2], xv[r][j][3]); *(u32x2*)(H + (size_t)(m + r) * DM + 4 * l + 256 * j) = o; }
#pragma unroll
              for (int i = 0; i < 4; ++i)
#pragma unroll
                  for (int c4 = 0; c4 < 4; ++c4) { const f32x4 wv = Wl[((c4 * 8 + j) * 4 + i) * 64 + l];
#pragma unroll
                      for (int r = 0; r < 2; ++r) { acc[r][4 * c4 + 0] += xv[r][j][i] * wv[0]; acc[r][4 * c4 + 1] += xv[r][j][i] * wv[1]; acc[r][4 * c4 + 2] += xv[r][j][i] * wv[2]; acc[r][4 * c4 + 3] += xv[r][j][i] * wv[3]; } } }
#pragma unroll
          for (int r = 0; r < 2; ++r)
#pragma unroll
              for (int c = 0; c < 16; ++c) acc[r][c] = wave_sum(acc[r][c]);
          f32x4 s0[2], s1[2];
#pragma unroll
          for (int r = 0; r < 2; ++r) { s0[r] = *(const f32x4*)(bgp + 8 * l); s1[r] = *(const f32x4*)(bgp + 8 * l + 4); }
#pragma unroll
          for (int jj = 0; jj < 16; ++jj) { const f32x4 w0 = *(const f32x4*)(wg + jj * 512 + 8 * l), w1 = *(const f32x4*)(wg + jj * 512 + 8 * l + 4);
#pragma unroll
              for (int r = 0; r < 2; ++r) { s0[r] += acc[r][jj] * w0; s1[r] += acc[r][jj] * w1; } }
#pragma unroll
          for (int r = 0; r < 2; ++r) { f32x4 o0, o1;
#pragma unroll
              for (int qq = 0; qq < 4; ++qq) { o0[qq] = log_sigmoid_f(s0[r][qq]) * 0.0625f; o1[qq] = log_sigmoid_f(s1[r][qq]) * 0.0625f; }
              *(f32x4*)(LG + (size_t)(m + r) * 512 + 8 * l) = o0; *(f32x4*)(LG + (size_t)(m + r) * 512 + 8 * l + 4) = o1; }
      }
    }
    __syncthreads();
}

__device__ __forceinline__ void gla_cumsum(const float* LG, int tok0, int h, LAS float* BC, LAS float* SEG, int tid) {
    const int seg = tid >> 7, kk = tid & 127;
    float v[16];
#pragma unroll
    for (int i = 0; i < 16; ++i) v[i] = LG[(size_t)(tok0 + 16 * seg + i) * 512 + h * 128 + kk];
#pragma unroll
    for (int i = 1; i < 16; ++i) v[i] += v[i - 1];
    SEG[seg * 128 + kk] = v[15];
    __syncthreads();
    float off = 0.f;
#pragma unroll
    for (int s = 0; s < 3; ++s) off += (s < seg) ? SEG[s * 128 + kk] : 0.f;
#pragma unroll
    for (int i = 0; i < 16; ++i) BC[(16 * seg + i) * 128 + kk] = v[i] + off;
    __syncthreads();
}
__device__ __forceinline__ bf16x8 as_bf16x8(u32x4 v) { return __builtin_bit_cast(bf16x8, v); }
__device__ __forceinline__ bf16x8 cat4(bf16x4 lo, bf16x4 hi) { return __builtin_shufflevector(lo, hi, 0, 1, 2, 3, 4, 5, 6, 7); }

__device__ __forceinline__ void p2a(Frame& F, const Params& p) {
    const bf16_t* Z = (const bf16_t*)(F.ws + WS_Z); const float* LG = (const float*)(F.ws + WS_LG);
    float* AN = (float*)(F.ws + WS_AN); float* DN = (float*)(F.ws + WS_DN); float* AUA = (float*)(F.ws + WS_AUA); float* AUU = (float*)(F.ws + WS_AUU);
    const bf16_t* WaT = (const bf16_t*)(F.ws + WS_WAT); const bf16_t* WiT = (const bf16_t*)(F.ws + WS_WIT);
    LAS float* BC = (LAS float*)(F.lds); LAS float* SEG = (LAS float*)(F.lds + 32768);
    LAS bf16_t* KDT = (LAS bf16_t*)(F.lds + 34816); LAS bf16_t* VT = (LAS bf16_t*)(F.lds + 53248); LAS bf16_t* XC = (LAS bf16_t*)(F.lds + 90112);
    const int w = F.wave;
    for (int unit = blockIdx.x; unit < NCHUNK; unit += F.G) {
        const int b = unit >> 7, n = unit & 127, tok0 = b * SEQL + 64 * n;
        for (int h = 0; h < 4; ++h) {
            int lane = fresh_lane(), tid = F.wave * 64 + lane;
            int r = lane & 31, hh = lane >> 5;
            gla_cumsum(LG, tok0, h, BC, SEG, tid);
            const int uh = (b * 4 + h) * 128 + n;
            if (tid < 128) DN[(size_t)uh * 128 + tid] = __expf(BC[63 * 128 + tid]);
#pragma unroll
            for (int it = 0; it < 2; ++it) { const int item = tid + 512 * it, t = item & 63, kk8 = item >> 6;
                const u32x4 kv = *(const u32x4*)(Z + (size_t)(tok0 + t) * ZC + ZK + h * 128 + kk8 * 8);
#pragma unroll
                for (int i = 0; i < 8; ++i) { const int kk = kk8 * 8 + i; const unsigned wv = kv[i >> 1]; const float kf = (i & 1) ? bfhi(wv) : bflo(wv);
                    const float d = __expf(BC[63 * 128 + kk] - BC[t * 128 + kk]); KDT[kk * 72 + t] = (bf16_t)f2bf(kf * d); } }
#pragma unroll
            for (int it = 0; it < 4; ++it) { const int item = tid + 512 * it, t = item & 63, vc8 = item >> 6;
                const u32x4 vv = *(const u32x4*)(Z + (size_t)(tok0 + t) * ZC + ZV + h * 256 + vc8 * 8);
#pragma unroll
                for (int i = 0; i < 8; ++i) { const unsigned wv = vv[i >> 1]; VT[(vc8 * 8 + i) * 72 + t] = (bf16_t)((i & 1) ? (wv >> 16) : (wv & 0xffffu)); } }
            __syncthreads();
            {
                f32x16 acc[4];
#pragma unroll
                for (int mb = 0; mb < 4; ++mb)
#pragma unroll
                    for (int q = 0; q < 16; ++q) acc[mb][q] = 0.f;
#pragma unroll
                for (int s = 0; s < 4; ++s) { const bf16x8 bfr = *(const LAS bf16x8*)(VT + (32 * w + r) * 72 + 16 * s + 8 * hh);
#pragma unroll
                    for (int mb = 0; mb < 4; ++mb) { const bf16x8 afr = *(const LAS bf16x8*)(KDT + (32 * mb + r) * 72 + 16 * s + 8 * hh);
                        acc[mb] = __builtin_amdgcn_mfma_f32_32x32x16_bf16(afr, bfr, acc[mb], 0, 0, 0); } }
                float* base = AN + (size_t)uh * 32768;
#pragma unroll
                for (int mb = 0; mb < 4; ++mb)
#pragma unroll
                    for (int g = 0; g < 4; ++g) *(f32x4*)(base + (((mb * 8 + w) * 4 + g) * 64 + lane) * 4) = (f32x4){acc[mb][4 * g], acc[mb][4 * g + 1], acc[mb][4 * g + 2], acc[mb][4 * g + 3]};
            }
#ifndef P2A_NO_LRU
            {
                lane = fresh_lane(); tid = F.wave * 64 + lane; r = lane & 31; hh = lane >> 5;
                const float* cw = p.in[I_CW]; const float* cb = p.in[I_CB];
                {
                    const int c8 = tid & 31, tq = tid >> 5, chc = h * 256 + c8 * 8;
                    u32x4 lv[7];
#pragma unroll
                    for (int i = 0; i < 7; ++i) { const int s = 64 * n + 4 * tq - 3 + i;
                        lv[i] = (s >= 0) ? *(const u32x4*)(Z + (size_t)(tok0 + 4 * tq - 3 + i) * ZC + ZLX + chc) : (u32x4){0u, 0u, 0u, 0u}; }
                    f32x4 wv[4][2], bv[2];
#pragma unroll
                    for (int i = 0; i < 4; ++i) { wv[i][0] = *(const f32x4*)(cw + i * 1024 + chc); wv[i][1] = *(const f32x4*)(cw + i * 1024 + chc + 4); }
                    bv[0] = *(const f32x4*)(cb + chc); bv[1] = *(const f32x4*)(cb + chc + 4);
#pragma unroll
                    for (int it = 0; it < 4; ++it) { float xc[8];
#pragma unroll
                        for (int q = 0; q < 4; ++q) { xc[q] = bv[0][q]; xc[4 + q] = bv[1][q]; }
#pragma unroll
                        for (int i = 0; i < 4; ++i) { const u32x4 l4 = lv[it + i];
                            xc[0] += bflo(l4[0]) * wv[i][0][0]; xc[1] += bfhi(l4[0]) * wv[i][0][1]; xc[2] += bflo(l4[1]) * wv[i][0][2]; xc[3] += bfhi(l4[1]) * wv[i][0][3];
                            xc[4] += bflo(l4[2]) * wv[i][1][0]; xc[5] += bfhi(l4[2]) * wv[i][1][1]; xc[6] += bflo(l4[3]) * wv[i][1][2]; xc[7] += bfhi(l4[3]) * wv[i][1][3]; }
                        u32x4 o; o.x = pk2(xc[0], xc[1]); o.y = pk2(xc[2], xc[3]); o.z = pk2(xc[4], xc[5]); o.w = pk2(xc[6], xc[7]);
                        *(LAS u32x4*)(XC + (4 * tq + it) * 264 + c8 * 8) = o; }
                }
                __builtin_amdgcn_sched_barrier(0);
                bf16x8 ba[16], bi[16];
                { const bf16_t* wa = WaT + (size_t)h * 65536 + (size_t)(32 * w + r) * 256 + 8 * hh;
                  const bf16_t* wi = WiT + (size_t)h * 65536 + (size_t)(32 * w + r) * 256 + 8 * hh;
#pragma unroll
                  for (int s = 0; s < 16; ++s) { ba[s] = *(const bf16x8*)(wa + 16 * s); bi[s] = *(const bf16x8*)(wi + 16 * s); } }
                __syncthreads();
                f32x16 aa[2], ai[2];
#pragma unroll
                for (int mb = 0; mb < 2; ++mb)
#pragma unroll
                    for (int q = 0; q < 16; ++q) { aa[mb][q] = 0.f; ai[mb][q] = 0.f; }
#pragma unroll
                for (int s = 0; s < 16; ++s) {
#pragma unroll
                    for (int mb = 0; mb < 2; ++mb) { const bf16x8 af = *(const LAS bf16x8*)(XC + (32 * mb + r) * 264 + 16 * s + 8 * hh);
                        aa[mb] = __builtin_amdgcn_mfma_f32_32x32x16_bf16(af, ba[s], aa[mb], 0, 0, 0); } }
                __builtin_amdgcn_sched_barrier(0);
#pragma unroll
                for (int s = 0; s < 16; ++s) {
#pragma unroll
                    for (int mb = 0; mb < 2; ++mb) { const bf16x8 af = *(const LAS bf16x8*)(XC + (32 * mb + r) * 264 + 16 * s + 8 * hh);
                        ai[mb] = __builtin_amdgcn_mfma_f32_32x32x16_bf16(af, bi[s], ai[mb], 0, 0, 0); } }
                const int ch = h * 256 + 32 * w + r;
                const float ba_ = p.in[I_BA][ch], bi_ = p.in[I_BI][ch]; const float L = p.in[I_AP][ch];
                const float sp = fmaxf(-L, 0.f) + log1pf(__expf(-fabsf(L)));
                const unsigned off0 = (unsigned)((tok0 + 4 * hh) * 1024 + ch);
#pragma unroll
                for (int mb = 0; mb < 2; ++mb)
#pragma unroll
                    for (int q4 = 0; q4 < 4; ++q4) {
                        unsigned o = off0 + (unsigned)((32 * mb + 8 * q4) * 1024); asm volatile("" : "+v"(o));
#pragma unroll
                        for (int i = 0; i < 4; ++i) { const int q = 4 * q4 + i; const int t = 32 * mb + 8 * q4 + i + 4 * hh;
                            const float ga = sigmoidf_(aa[mb][q] + ba_), gi = sigmoidf_(ai[mb][q] + bi_);
                            const float la = -8.0f * ga * sp; const float a = __expf(la);
                            const float xcv = bf2f(XC[t * 264 + 32 * w + r]);
                            const float u = xcv * gi * sqrtf(fmaxf(1.0f - a * a, 0.f));
                            AUA[(size_t)o + i * 1024] = a; AUU[(size_t)o + i * 1024] = u; } }
            }
#endif
            __syncthreads();
        }
    }
}

__device__ __forceinline__ void p2b(Frame& F, const Params& p) {
    const float* AN = (const float*)(F.ws + WS_AN); const float* DN = (const float*)(F.ws + WS_DN); bf16_t* SP = (bf16_t*)(F.ws + WS_SP);
    const float* AUA = (const float*)(F.ws + WS_AUA); const float* AUU = (const float*)(F.ws + WS_AUU);
    float* SUMA = (float*)(F.ws + WS_SUMA); float* SUMH = (float*)(F.ws + WS_SUMH);
    if (F.tid < 128) {
        for (int st = (int)blockIdx.x * 128 + F.tid; st < 32768; st += F.G * 128) {
            const int bh = st >> 12, rem = st & 4095, ln = rem & 63, s2 = (rem >> 6) & 1, w = (rem >> 7) & 7, mb = (rem >> 10) & 3;
            const int kk0 = 32 * mb + 16 * s2 + 4 * (ln >> 5);
            const int offA = (((mb * 8 + w) * 4 + 2 * s2) * 64 + ln) * 4;
            const int offS = (((mb * 8 + w) * 2 + s2) * 64 + ln) * 8;
            f32x4 S0 = (f32x4){0.f, 0.f, 0.f, 0.f}, S1 = S0;
            for (int n0 = 0; n0 < 128; n0 += 8) {
                f32x4 a0[8], a1[8], d0[8], d1[8];
#pragma unroll
                for (int i = 0; i < 8; ++i) { const size_t uh = (size_t)bh * 128 + n0 + i;
                    a0[i] = *(const f32x4*)(AN + uh * 32768 + offA); a1[i] = *(const f32x4*)(AN + uh * 32768 + offA + 256);
                    d0[i] = *(const f32x4*)(DN + uh * 128 + kk0); d1[i] = *(const f32x4*)(DN + uh * 128 + kk0 + 8); }
#pragma unroll
                for (int i = 0; i < 8; ++i) { const size_t uh = (size_t)bh * 128 + n0 + i;
                    u32x4 o; o.x = pk2(S0[0], S0[1]); o.y = pk2(S0[2], S0[3]); o.z = pk2(S1[0], S1[1]); o.w = pk2(S1[2], S1[3]);
                    *(u32x4*)(SP + uh * 32768 + offS) = o;
                    S0 = d0[i] * S0 + a0[i]; S1 = d1[i] * S1 + a1[i]; } }
        }
    } else if (F.tid < 384) {
        for (int c = blockIdx.x; c < NCHUNK; c += F.G) { const int ch = 4 * (F.tid - 128);
            f32x4 A = (f32x4){1.f, 1.f, 1.f, 1.f}, Hh = (f32x4){0.f, 0.f, 0.f, 0.f};
#pragma unroll 16
            for (int t = 0; t < 64; ++t) { const f32x4 a = *(const f32x4*)(AUA + (size_t)(c * 64 + t) * 1024 + ch), u = *(const f32x4*)(AUU + (size_t)(c * 64 + t) * 1024 + ch);
                Hh = a * Hh + u; A = A * a; }
            *(f32x4*)(SUMA + c * 1024 + ch) = A; *(f32x4*)(SUMH + c * 1024 + ch) = Hh; }
    }
}

__device__ __forceinline__ void p2c(Frame& F, const Params& p) {
    const bf16_t* Z = (const bf16_t*)(F.ws + WS_Z); const float* LG = (const float*)(F.ws + WS_LG); const bf16_t* SP = (const bf16_t*)(F.ws + WS_SP);
    bf16_t* MIX = (bf16_t*)(F.ws + WS_MIX);
    LAS float* BC = (LAS float*)(F.lds); LAS float* SEG = (LAS float*)(F.lds + 32768);
    LAS bf16_t* QE = (LAS bf16_t*)(F.lds + 34816); LAS bf16_t* KE = (LAS bf16_t*)(F.lds + 52224); LAS bf16_t* VT = (LAS bf16_t*)(F.lds + 69632);
    LAS float* SSQ = (LAS float*)(F.lds + 106496); LAS float* OS = (LAS float*)(F.lds);
    const int tid = F.tid, lane = F.lane, w = F.wave, r = lane & 31, hh = lane >> 5;
    const float* gng = p.in[I_GNG];
    for (int unit = blockIdx.x; unit < NCHUNK; unit += F.G) {
        const int b = unit >> 7, n = unit & 127, tok0 = b * SEQL + 64 * n;
        { const float* AUA = (const float*)(F.ws + WS_AUA); const float* AUU = (const float*)(F.ws + WS_AUU);
          const float* SUMA = (const float*)(F.ws + WS_SUMA); const float* SUMH = (const float*)(F.ws + WS_SUMH);
          const int ch = 2 * tid; f32x2 hc = (f32x2){0.f, 0.f};
          int c2 = unit & ~127;
          for (; c2 + 16 <= unit; c2 += 16) { f32x2 a[16], hv[16];
#pragma unroll
              for (int q = 0; q < 16; ++q) { a[q] = *(const f32x2*)(SUMA + (c2 + q) * 1024 + ch); hv[q] = *(const f32x2*)(SUMH + (c2 + q) * 1024 + ch); }
#pragma unroll
              for (int q = 0; q < 16; ++q) hc = a[q] * hc + hv[q]; }
          { f32x2 a[16], hv[16];
#pragma unroll
              for (int q = 0; q < 16; ++q) { const bool ok = (c2 + q) < unit; a[q] = ok ? *(const f32x2*)(SUMA + (c2 + q) * 1024 + ch) : (f32x2){1.f, 1.f}; hv[q] = ok ? *(const f32x2*)(SUMH + (c2 + q) * 1024 + ch) : (f32x2){0.f, 0.f}; }
#pragma unroll
              for (int q = 0; q < 16; ++q) hc = a[q] * hc + hv[q]; }
          for (int t0 = 0; t0 < 64; t0 += 16) {
              f32x2 a[16], u[16]; unsigned lgw[16];
#pragma unroll
              for (int i = 0; i < 16; ++i) { const size_t tok = (size_t)tok0 + t0 + i;
                  a[i] = *(const f32x2*)(AUA + tok * 1024 + ch); u[i] = *(const f32x2*)(AUU + tok * 1024 + ch); lgw[i] = *(const unsigned*)(Z + tok * ZC + ZLG + ch); }
#pragma unroll
              for (int i = 0; i < 16; ++i) { const size_t tok = (size_t)tok0 + t0 + i;
                  hc = a[i] * hc + u[i];
                  *(unsigned*)(MIX + tok * DM + 1024 + ch) = pk2(hc.x * gelu_tanh_f(bflo(lgw[i])), hc.y * gelu_tanh_f(bfhi(lgw[i]))); } } }
        for (int h = 0; h < 4; ++h) {
            const int uh = (b * 4 + h) * 128 + n;
            bf16x8 sf[4][2];
            { const bf16_t* spu = SP + (size_t)uh * 32768;
#pragma unroll
              for (int mb = 0; mb < 4; ++mb)
#pragma unroll
                  for (int s2 = 0; s2 < 2; ++s2) sf[mb][s2] = *(const bf16x8*)(spu + (((mb * 8 + w) * 2 + s2) * 64 + lane) * 8); }
            gla_cumsum(LG, tok0, h, BC, SEG, tid);
#pragma unroll
            for (int it = 0; it < 2; ++it) { const int item = tid + 512 * it, kk8 = item & 15, t = item >> 4;
                const u32x4 qv = *(const u32x4*)(Z + (size_t)(tok0 + t) * ZC + ZQ + h * 128 + kk8 * 8);
                const u32x4 kv = *(const u32x4*)(Z + (size_t)(tok0 + t) * ZC + ZK + h * 128 + kk8 * 8);
                const f32x4 b0 = *(const LAS f32x4*)(BC + t * 128 + kk8 * 8), b1 = *(const LAS f32x4*)(BC + t * 128 + kk8 * 8 + 4);
                float qe[8], ke[8];
#pragma unroll
                for (int i = 0; i < 8; ++i) { const float bb = (i < 4) ? b0[i & 3] : b1[i & 3]; const unsigned qw = qv[i >> 1], kw = kv[i >> 1];
                    const float qf = (i & 1) ? bfhi(qw) : bflo(qw), kf = (i & 1) ? bfhi(kw) : bflo(kw);
                    qe[i] = qf * 0.08838834764831845f * __expf(bb); ke[i] = kf * __expf(-bb); }
                u32x4 oq, ok; oq.x = pk2(qe[0], qe[1]); oq.y = pk2(qe[2], qe[3]); oq.z = pk2(qe[4], qe[5]); oq.w = pk2(qe[6], qe[7]);
                ok.x = pk2(ke[0], ke[1]); ok.y = pk2(ke[2], ke[3]); ok.z = pk2(ke[4], ke[5]); ok.w = pk2(ke[6], ke[7]);
                *(LAS u32x4*)(QE + t * 136 + kk8 * 8) = oq; *(LAS u32x4*)(KE + t * 136 + kk8 * 8) = ok; }
#pragma unroll
            for (int it = 0; it < 4; ++it) { const int item = tid + 512 * it, t = item & 63, vc8 = item >> 6;
                const u32x4 vv = *(const u32x4*)(Z + (size_t)(tok0 + t) * ZC + ZV + h * 256 + vc8 * 8);
#pragma unroll
                for (int i = 0; i < 8; ++i) { const unsigned wv = vv[i >> 1]; VT[(vc8 * 8 + i) * 72 + t] = (bf16_t)((i & 1) ? (wv >> 16) : (wv & 0xffffu)); } }
            __syncthreads();
            f32x16 oacc[2];
            {
                f32x16 P00, P01, P11;
#pragma unroll
                for (int q = 0; q < 16; ++q) { P00[q] = 0.f; P01[q] = 0.f; P11[q] = 0.f; oacc[0][q] = 0.f; oacc[1][q] = 0.f; }
#pragma unroll
                for (int s = 0; s < 8; ++s) {
                    const bf16x8 a0 = *(const LAS bf16x8*)(KE + r * 136 + 16 * s + 8 * hh), a1 = *(const LAS bf16x8*)(KE + (32 + r) * 136 + 16 * s + 8 * hh);
                    const bf16x8 b0 = *(const LAS bf16x8*)(QE + r * 136 + 16 * s + 8 * hh), b1 = *(const LAS bf16x8*)(QE + (32 + r) * 136 + 16 * s + 8 * hh);
                    P00 = __builtin_amdgcn_mfma_f32_32x32x16_bf16(a0, b0, P00, 0, 0, 0);
                    P01 = __builtin_amdgcn_mfma_f32_32x32x16_bf16(a0, b1, P01, 0, 0, 0);
                    P11 = __builtin_amdgcn_mfma_f32_32x32x16_bf16(a1, b1, P11, 0, 0, 0); }
#pragma unroll
                for (int q = 0; q < 16; ++q) { const int jl = (q & 3) + 8 * (q >> 2) + 4 * hh; if (jl > r) { P00[q] = 0.f; P11[q] = 0.f; } }
                bf16x8 F00[2], F01[2], F11[2];
#pragma unroll
                for (int s2 = 0; s2 < 2; ++s2) {
                    u32x4 t0, t1, t2;
#pragma unroll
                    for (int q = 0; q < 4; ++q) { t0[q] = pk2(P00[8 * s2 + 2 * q], P00[8 * s2 + 2 * q + 1]); t1[q] = pk2(P01[8 * s2 + 2 * q], P01[8 * s2 + 2 * q + 1]); t2[q] = pk2(P11[8 * s2 + 2 * q], P11[8 * s2 + 2 * q + 1]); }
                    F00[s2] = as_bf16x8(t0); F01[s2] = as_bf16x8(t1); F11[s2] = as_bf16x8(t2); }
#pragma unroll
                for (int mb = 0; mb < 4; ++mb)
#pragma unroll
                    for (int s2 = 0; s2 < 2; ++s2) { const bf16x8 af = sf[mb][s2];
                        const int kkb = 32 * mb + 16 * s2 + 4 * hh;
#pragma unroll
                        for (int ib = 0; ib < 2; ++ib) { const bf16x4 lo = *(const LAS bf16x4*)(QE + (32 * ib + r) * 136 + kkb), hi = *(const LAS bf16x4*)(QE + (32 * ib + r) * 136 + kkb + 8);
                            oacc[ib] = __builtin_amdgcn_mfma_f32_32x32x16_bf16(af, cat4(lo, hi), oacc[ib], 0, 0, 0); } }
#pragma unroll
                for (int s2 = 0; s2 < 2; ++s2) {
                    const int tb0 = 16 * s2 + 4 * hh, tb1 = 32 + 16 * s2 + 4 * hh;
                    const bf16x8 v0 = cat4(*(const LAS bf16x4*)(VT + (32 * w + r) * 72 + tb0), *(const LAS bf16x4*)(VT + (32 * w + r) * 72 + tb0 + 8));
                    const bf16x8 v1 = cat4(*(const LAS bf16x4*)(VT + (32 * w + r) * 72 + tb1), *(const LAS bf16x4*)(VT + (32 * w + r) * 72 + tb1 + 8));
                    oacc[0] = __builtin_amdgcn_mfma_f32_32x32x16_bf16(v0, F00[s2], oacc[0], 0, 0, 0);
                    oacc[1] = __builtin_amdgcn_mfma_f32_32x32x16_bf16(v0, F01[s2], oacc[1], 0, 0, 0);
                    oacc[1] = __builtin_amdgcn_mfma_f32_32x32x16_bf16(v1, F11[s2], oacc[1], 0, 0, 0); }
            }
#pragma unroll
            for (int ib = 0; ib < 2; ++ib) { float sq = 0.f;
#pragma unroll
                for (int q = 0; q < 16; ++q) sq += oacc[ib][q] * oacc[ib][q];
                sq += __shfl_xor(sq, 32);
                if (hh == 0) SSQ[w * 64 + 32 * ib + r] = sq; }
            __syncthreads();
#pragma unroll
            for (int ib = 0; ib < 2; ++ib) { float tot = 0.f;
#pragma unroll
                for (int w2 = 0; w2 < 8; ++w2) tot += SSQ[w2 * 64 + 32 * ib + r];
                const float rs = 1.0f / sqrtf(tot * (1.0f / 256.0f) + 1e-6f);
#pragma unroll
                for (int g = 0; g < 4; ++g) *(LAS f32x4*)(OS + (32 * ib + r) * 260 + 32 * w + 8 * g + 4 * hh) =
                    (f32x4){oacc[ib][4 * g] * rs, oacc[ib][4 * g + 1] * rs, oacc[ib][4 * g + 2] * rs, oacc[ib][4 * g + 3] * rs}; }
            __syncthreads();
#pragma unroll
            for (int it = 0; it < 4; ++it) { const int item = tid + 512 * it, vc8 = item & 31, t = item >> 5; const int c = h * 256 + vc8 * 8;
                const f32x4 o0 = *(const LAS f32x4*)(OS + t * 260 + vc8 * 8), o1 = *(const LAS f32x4*)(OS + t * 260 + vc8 * 8 + 4);
                const u32x4 rv = *(const u32x4*)(Z + (size_t)(tok0 + t) * ZC + ZR + c);
                const f32x4 g0 = *(const f32x4*)(gng + c), g1 = *(const f32x4*)(gng + c + 4);
                float o[8];
#pragma unroll
                for (int i = 0; i < 8; ++i) { const unsigned rw = rv[i >> 1]; const float rf = (i & 1) ? bfhi(rw) : bflo(rw);
                    const float sil = rf * sigmoidf_(rf); o[i] = sil * ((i < 4) ? o0[i & 3] * g0[i & 3] : o1[i & 3] * g1[i & 3]); }
                u32x4 ov; ov.x = pk2(o[0], o[1]); ov.y = pk2(o[2], o[3]); ov.z = pk2(o[4], o[5]); ov.w = pk2(o[6], o[7]);
                *(u32x4*)(MIX + (size_t)(tok0 + t) * DM + c) = ov; }
            __syncthreads();
        }
    }
}

__device__ __forceinline__ void build_moe_tables(Frame& F) {
    unsigned* cnt = (unsigned*)(F.ws + WS_CTL) + CW_CNT;
    if (F.tid < 32) F.MISC[MI_LCNT + F.tid] = xb_ld(cnt + 64 * F.tid);
    __syncthreads();
    if (F.tid == 0) { int tiles = 0;
        for (int e = 0; e < NEXP; ++e) { const int c = (int)F.MISC[MI_LCNT + e]; const int mt = (c + 255) >> 8; F.MISC[MI_PBASE + e] = (unsigned)(tiles * 256);
            for (int q = 0; q < mt; ++q) F.MISC[MI_T2E + tiles + q] = (unsigned)e; tiles += mt; }
        F.MISC[MI_NMT] = (unsigned)tiles; }
    __syncthreads();
    if (F.tid < 32) F.MISC[MI_LCNT + F.tid] = 0u;
    __syncthreads();
}

__device__ __forceinline__ void p4a(Frame& F, const Params& p) {
    const bf16_t* XMID = (const bf16_t*)(F.ws + WS_XMID); const float* WrT = (const float*)(F.ws + WS_WRT); const float* br = p.in[I_BR];
    float* RSTD = (float*)(F.ws + WS_RSTD); unsigned* TOKE = (unsigned*)(F.ws + WS_TOKE); float* GATES = (float*)(F.ws + WS_GATES);
    unsigned* cnt = (unsigned*)(F.ws + WS_CTL) + CW_CNT;
    LAS float* RED = (LAS float*)(F.lds); LAS float* SSQ2 = (LAS float*)(F.lds + 32768); LAS float* LGT = (LAS float*)(F.lds + 33792); LAS float* RS = (LAS float*)(F.lds + 38016);
    const int tid = F.tid, lane = F.lane, w = F.wave, m = lane & 31, kh = lane >> 5;
    if (tid < 32) F.MISC[MI_LCNT + tid] = 0u;
    __syncthreads();
    for (int ut = blockIdx.x; ut < T / 32; ut += F.G) {
        const int m0 = 32 * ut; const int kw = 256 * w + 128 * kh;
        f32x16 acc;
#pragma unroll
        for (int q = 0; q < 16; ++q) acc[q] = 0.f;
        float ss = 0.f;
        const bf16_t* ap = XMID + (size_t)(m0 + m) * DM + kw; const float* bp = WrT + (size_t)m * DM + kw;
#pragma unroll 2
        for (int c = 0; c < 8; ++c) {
            f32x4 a[4], b[4];
            { const u32x4 r0 = *(const u32x4*)(ap + 16 * c), r1 = *(const u32x4*)(ap + 16 * c + 8);
              a[0] = (f32x4){bflo(r0.x), bfhi(r0.x), bflo(r0.y), bfhi(r0.y)}; a[1] = (f32x4){bflo(r0.z), bfhi(r0.z), bflo(r0.w), bfhi(r0.w)};
              a[2] = (f32x4){bflo(r1.x), bfhi(r1.x), bflo(r1.y), bfhi(r1.y)}; a[3] = (f32x4){bflo(r1.z), bfhi(r1.z), bflo(r1.w), bfhi(r1.w)}; }
#pragma unroll
            for (int q = 0; q < 4; ++q) b[q] = *(const f32x4*)(bp + 16 * c + 4 * q);
#pragma unroll
            for (int q = 0; q < 4; ++q)
#pragma unroll
                for (int i = 0; i < 4; ++i) { acc = __builtin_amdgcn_mfma_f32_32x32x2f32(a[q][i], b[q][i], acc, 0, 0, 0); ss += a[q][i] * a[q][i]; }
        }
        ss += __shfl_xor(ss, 32);
#pragma unroll
        for (int q = 0; q < 16; ++q) RED[(w * 16 + q) * 64 + lane] = acc[q];
        if (kh == 0) SSQ2[w * 32 + m] = ss;
        __syncthreads();
#pragma unroll
        for (int it = 0; it < 2; ++it) { const int o = tid + 512 * it, reg = o >> 6, ln = o & 63, nn = ln & 31, h2 = ln >> 5; const int mm = (reg & 3) + 8 * (reg >> 2) + 4 * h2;
            float v = 0.f, s2 = 0.f;
#pragma unroll
            for (int w2 = 0; w2 < 8; ++w2) { v += RED[(w2 * 16 + reg) * 64 + ln]; s2 += SSQ2[w2 * 32 + mm]; }
            const float rs = 1.0f / sqrtf(s2 * (1.0f / DM) + 1e-6f);
            LGT[mm * 33 + nn] = v * rs + br[nn]; if (nn == 0) RS[mm] = rs; }
        __syncthreads();
        int ex[4]; unsigned ls[4]; float gt[4];
        if (tid < 32) {
            float l[32];
#pragma unroll
            for (int i = 0; i < 32; ++i) l[i] = LGT[tid * 33 + i];
            float val[4];
#pragma unroll
            for (int k = 0; k < 4; ++k) { float best = -3.0e38f; int bi = 0;
#pragma unroll
                for (int i = 0; i < 32; ++i) if (l[i] > best) { best = l[i]; bi = i; }
                ex[k] = bi; val[k] = best;
#pragma unroll
                for (int i = 0; i < 32; ++i) if (i == bi) l[i] = -3.0e38f; }
            float s = 0.f;
#pragma unroll
            for (int k = 0; k < 4; ++k) { gt[k] = __expf(val[k] - val[0]); s += gt[k]; }
            const float inv = 1.0f / s;
#pragma unroll
            for (int k = 0; k < 4; ++k) { gt[k] *= inv; ls[k] = __hip_atomic_fetch_add((LAS unsigned*)(F.MISC + MI_LCNT + ex[k]), 1u, __ATOMIC_RELAXED, __HIP_MEMORY_SCOPE_WORKGROUP); }
        }
        __syncthreads();
        if (tid < 32) { const unsigned c = F.MISC[MI_LCNT + tid]; F.MISC[MI_LBASE + tid] = c ? xb_add(cnt + 64 * tid, c) : 0u; F.MISC[MI_LCNT + tid] = 0u; }
        __syncthreads();
        if (tid < 32) { const int tok = m0 + tid;
#pragma unroll
            for (int k = 0; k < 4; ++k) { const unsigned slot = F.MISC[MI_LBASE + ex[k]] + ls[k]; TOKE[tok * 4 + k] = (unsigned)ex[k] | (slot << 8); GATES[tok * 4 + k] = gt[k]; }
            RSTD[tok] = RS[tid]; }
        __syncthreads();
    }
}

__device__ __forceinline__ void p4b(Frame& F, const Params& p) {
    build_moe_tables(F);
    const bf16_t* XMID = (const bf16_t*)(F.ws + WS_XMID); const float* RSTD = (const float*)(F.ws + WS_RSTD); const unsigned* TOKE = (const unsigned*)(F.ws + WS_TOKE);
    const float* gf = p.in[I_NFG]; unsigned char* ABUF = F.ws + WS_ABUF;
    const int l = F.lane;
    u32x4 xn[4]; float rsn = 0.f; unsigned ten[4] = {0u, 0u, 0u, 0u};
    if (F.gw < T) { rsn = RSTD[F.gw];
#pragma unroll
        for (int k = 0; k < 4; ++k) ten[k] = TOKE[F.gw * 4 + k];
#pragma unroll
        for (int j = 0; j < 4; ++j) xn[j] = *(const u32x4*)(XMID + (size_t)F.gw * DM + 8 * l + 512 * j); }
    f32x4 gv[8];
#pragma unroll
    for (int j = 0; j < 4; ++j) { gv[2 * j] = *(const f32x4*)(gf + 8 * l + 512 * j) * 16.0f; gv[2 * j + 1] = *(const f32x4*)(gf + 8 * l + 512 * j + 4) * 16.0f; }
    for (int tok = F.gw; tok < T; tok += F.NGW) {
        const float rs = rsn; unsigned te[4]; u32x2 o[4];
#pragma unroll
        for (int k = 0; k < 4; ++k) te[k] = ten[k];
#pragma unroll
        for (int j = 0; j < 4; ++j) { const u32x4 xr = xn[j]; const f32x4 a = (f32x4){bflo(xr.x), bfhi(xr.x), bflo(xr.y), bfhi(xr.y)} * rs * gv[2 * j], b = (f32x4){bflo(xr.z), bfhi(xr.z), bflo(xr.w), bfhi(xr.w)} * rs * gv[2 * j + 1];
            o[j].x = pk4_fp8(a[0], a[1], a[2], a[3]); o[j].y = pk4_fp8(b[0], b[1], b[2], b[3]); }
        const int t2 = tok + F.NGW;
        if (t2 < T) { rsn = RSTD[t2];
#pragma unroll
            for (int k = 0; k < 4; ++k) ten[k] = TOKE[t2 * 4 + k];
#pragma unroll
            for (int j = 0; j < 4; ++j) xn[j] = *(const u32x4*)(XMID + (size_t)t2 * DM + 8 * l + 512 * j); }
#pragma unroll
        for (int k = 0; k < 4; ++k) { const size_t row = (size_t)F.MISC[MI_PBASE + (te[k] & 255u)] + (te[k] >> 8);
#pragma unroll
            for (int j = 0; j < 4; ++j) *(u32x2*)(ABUF + row * DM + 8 * l + 512 * j) = o[j]; }
    }
}

__device__ __forceinline__ void p7(Frame& F, const Params& p) {
    build_moe_tables(F);
    const bf16_t* XMID = (const bf16_t*)(F.ws + WS_XMID); const unsigned* TOKE = (const unsigned*)(F.ws + WS_TOKE); const float* GATES = (const float*)(F.ws + WS_GATES);
    const unsigned char* Y = F.ws + WS_Y; const float* gfin = p.in[I_NFINAL];
    const int l = F.lane;
    u32x4 xn[4]; u32x2 yn[4][4]; float gkn[4] = {0.f, 0.f, 0.f, 0.f};
#define P7_FETCH(tk) do { \
        _Pragma("unroll") for (int k = 0; k < 4; ++k) { const unsigned te = TOKE[(tk) * 4 + k]; gkn[k] = GATES[(tk) * 4 + k]; const size_t row = (size_t)F.MISC[MI_PBASE + (te & 255u)] + (te >> 8); \
            _Pragma("unroll") for (int j = 0; j < 4; ++j) yn[k][j] = *(const u32x2*)(Y + row * DM + 8 * l + 512 * j); } \
        _Pragma("unroll") for (int j = 0; j < 4; ++j) xn[j] = *(const u32x4*)(XMID + (size_t)(tk) * DM + 8 * l + 512 * j); } while (0)
    if (F.gw < T) P7_FETCH(F.gw);
    f32x4 g0[4], g1[4];
#pragma unroll
    for (int j = 0; j < 4; ++j) { g0[j] = *(const f32x4*)(gfin + 8 * l + 512 * j); g1[j] = *(const f32x4*)(gfin + 8 * l + 512 * j + 4); }
    for (int tok = F.gw; tok < T; tok += F.NGW) {
        f32x4 xv[8];
#pragma unroll
        for (int j = 0; j < 4; ++j) { const u32x4 xr = xn[j]; xv[2 * j] = (f32x4){bflo(xr.x), bfhi(xr.x), bflo(xr.y), bfhi(xr.y)}; xv[2 * j + 1] = (f32x4){bflo(xr.z), bfhi(xr.z), bflo(xr.w), bfhi(xr.w)}; }
#pragma unroll
        for (int k = 0; k < 4; ++k)
#pragma unroll
            for (int j = 0; j < 4; ++j) { const u32x2 y2 = yn[k][j]; const float gk = gkn[k] * (1.0f / 32.0f);
                xv[2 * j][0] += gk * fp8f(y2.x, 0); xv[2 * j][1] += gk * fp8f(y2.x, 1); xv[2 * j][2] += gk * fp8f(y2.x, 2); xv[2 * j][3] += gk * fp8f(y2.x, 3);
                xv[2 * j + 1][0] += gk * fp8f(y2.y, 0); xv[2 * j + 1][1] += gk * fp8f(y2.y, 1); xv[2 * j + 1][2] += gk * fp8f(y2.y, 2); xv[2 * j + 1][3] += gk * fp8f(y2.y, 3); }
        const int t2 = tok + F.NGW;
        if (t2 < T) P7_FETCH(t2);
        float ss = 0.f;
#pragma unroll
        for (int j = 0; j < 8; ++j) ss += (xv[j][0] * xv[j][0] + xv[j][1] * xv[j][1]) + (xv[j][2] * xv[j][2] + xv[j][3] * xv[j][3]);
        const float rs = 1.0f / sqrtf(wave_sum(ss) * (1.0f / DM) + 1e-6f);
#pragma unroll
        for (int j = 0; j < 4; ++j) { *(f32x4*)(p.out + (size_t)tok * DM + 8 * l + 512 * j) = xv[2 * j] * rs * g0[j]; *(f32x4*)(p.out + (size_t)tok * DM + 8 * l + 512 * j + 4) = xv[2 * j + 1] * rs * g1[j]; }
    }
#undef P7_FETCH
}

#ifdef PROBE_STREAM
__device__ __forceinline__ void probe_stream(Frame& F, const Params& p) {
    const f32x4* src = (const f32x4*)p.in[I_WGU]; const size_t n4 = (size_t)32 * 2048 * 4096 / 4;
    const f32x4* src2 = (const f32x4*)p.in[I_WDN]; const size_t m4 = (size_t)32 * 2048 * 2048 / 4;
    f32x4 acc = (f32x4){0.f, 0.f, 0.f, 0.f};
    for (size_t base = (size_t)F.gw * 1024; base < n4; base += (size_t)F.NGW * 1024) {
        f32x4 v[16];
#pragma unroll
        for (int i = 0; i < 16; ++i) v[i] = src[base + i * 64 + F.lane];
#pragma unroll
        for (int i = 0; i < 16; ++i) acc += v[i]; }
    for (size_t base = (size_t)F.gw * 1024; base < m4; base += (size_t)F.NGW * 1024) {
        f32x4 v[16];
#pragma unroll
        for (int i = 0; i < 16; ++i) v[i] = src2[base + i * 64 + F.lane];
#pragma unroll
        for (int i = 0; i < 16; ++i) acc += v[i]; }
    if (acc[0] + acc[1] + acc[2] + acc[3] == 12345.678f) p.out[0] = 1.0f;
}
#endif
constexpr int NPHASE = 11;
__global__ void __launch_bounds__(512, 2) mk_fwd(Params p) {
    extern __shared__ __attribute__((aligned(16))) unsigned char lds_raw[];
    Frame F;
    F.lds = (LAS unsigned char*)lds_raw; F.MISC = (volatile LAS unsigned*)(F.lds + MISC_OFF);
    F.wave = __builtin_amdgcn_readfirstlane((int)threadIdx.x >> 6);
#define FRESH() do { F.lane = fresh_lane(); F.tid = F.wave * 64 + F.lane; } while (0)
    FRESH();
    F.G = gridDim.x; F.gw = (int)blockIdx.x * 8 + F.wave; F.NGW = F.G * 8; F.ws = p.ws;
    for (int u = F.tid; u < (LDS_BYTES - MISC_OFF) / 4; u += 512) F.MISC[u] = 0u;
    __syncthreads();
    const int lo = p.ph_lo, hi = p.ph_hi;
    XcdBarrier bar; bar.bar = (unsigned*)(F.ws + WS_CTL) + CW_BAR; bar.x = 0; bar.st = F.MISC;
    if (hi - lo > 1) bar = xcd_barrier_post((unsigned*)(F.ws + WS_CTL) + CW_BAR, F.MISC, F.tid == 0);
#ifndef PHASE_MASK
#define PHASE_MASK 0x7ff
#endif
#define IN(k) (((PHASE_MASK >> (k)) & 1) && lo <= (k) && (k) < hi)
#define SEAM(k) do { if (IN(k) && IN((k) + 1)) xcd_barrier(bar, F.wave == 0 && fresh_lane() == 0); } while (0)
#ifndef REPEAT_MASK
#define REPEAT_MASK 0
#endif
#define REP(k) for (int rep_ = 0; rep_ < (((REPEAT_MASK >> (k)) & 1) ? 2 : 1); ++rep_)
    LAS unsigned char* ring = F.lds;
#ifdef PROBE_STREAM
    if (IN(0)) { probe_stream(F, p); }
#endif
    if (IN(0)) { REP(11) { FRESH(); p0a(F, p); } REP(12) { FRESH(); p0b(F, p); } SEAM(0); }
    if (IN(1)) REP(1) {
        pg8::Gemm g{F.ws + WS_H, F.ws + WS_WINT}; using GS = pg8::GShape<DM * 2, DM * 2, DM * 2, 0>; pg8::StaticOrder S; S.init(T, ZC, F.G, (int)blockIdx.x);
        pg8::EpiBf16 E{(bf16_t*)(F.ws + WS_Z), ZC, nullptr, 0};
        pg8::gemm_phase<pg8::EpiBf16, pg8::StaticOrder, GS, true>(ring, g, S, E, F.wave); SEAM(1); }
    if (IN(2)) REP(2) { FRESH(); p2a(F, p); SEAM(2); }
    if (IN(3)) REP(3) { FRESH(); p2b(F, p); SEAM(3); }
    if (IN(4)) REP(4) { FRESH(); p2c(F, p); SEAM(4); }
    if (IN(5)) REP(5) {
        pg8::Gemm g{F.ws + WS_MIX, F.ws + WS_WOUTT}; using GS = pg8::GShape<DM * 2, DM * 2, DM * 2, 0>; pg8::StaticOrder S; S.init(T, DM, F.G, (int)blockIdx.x);
        pg8::EpiBf16Res E{(bf16_t*)(F.ws + WS_XMID), p.in[I_X], DM};
        pg8::gemm_phase<pg8::EpiBf16Res, pg8::StaticOrder, GS, true>(ring, g, S, E, F.wave); SEAM(5); }
    if (IN(6)) { FRESH(); p4a(F, p); SEAM(6); }
    if (IN(7)) REP(7) { FRESH(); p4b(F, p); SEAM(7); }
    if (IN(8)) {
        FRESH(); build_moe_tables(F);
        pg8::Gemm g{F.ws + WS_ABUF, F.ws + WS_WGUT}; using GS = pg8::GShape<DM, DM, DM, (size_t)4096 * DM>;
        pg8::MoeOrder S{__builtin_amdgcn_readfirstlane((int)F.MISC[MI_NMT]), 16, F.G, (int)blockIdx.x, (const LAS int*)(F.lds + MISC_OFF + 4 * MI_T2E)};
        pg8::EpiSwiGLU8 E{F.ws + WS_ACT, DM, p.in[I_BGU]};
        pg8::gemm_phase<pg8::EpiSwiGLU8, pg8::MoeOrder, GS, true, true>(ring, g, S, E, F.wave); SEAM(8); }
#if (REPEAT_MASK & 0x100)
    if (IN(8)) {
        FRESH(); build_moe_tables(F);
        pg8::Gemm g{F.ws + WS_ABUF, F.ws + WS_WGUT}; using GS = pg8::GShape<DM, DM, DM, (size_t)4096 * DM>;
        pg8::MoeOrder S{__builtin_amdgcn_readfirstlane((int)F.MISC[MI_NMT]), 16, F.G, (int)blockIdx.x, (const LAS int*)(F.lds + MISC_OFF + 4 * MI_T2E)};
        pg8::EpiSwiGLU8 E{F.ws + WS_ACT, DM, p.in[I_BGU]};
        pg8::gemm_phase<pg8::EpiSwiGLU8, pg8::MoeOrder, GS, true, true>(ring, g, S, E, F.wave); SEAM(8); }
#endif
    if (IN(9)) {
        FRESH(); build_moe_tables(F);
        pg8::Gemm g{F.ws + WS_ACT, F.ws + WS_WDT}; using GS = pg8::GShape<DM, DM, DM, (size_t)DM * DM>;
        pg8::MoeOrder S{__builtin_amdgcn_readfirstlane((int)F.MISC[MI_NMT]), 8, F.G, (int)blockIdx.x, (const LAS int*)(F.lds + MISC_OFF + 4 * MI_T2E)};
        pg8::EpiFp8S E{F.ws + WS_Y, DM, p.in[I_BDN], DM, 1.0f / 2048.0f, 32.0f};
        pg8::gemm_phase<pg8::EpiFp8S, pg8::MoeOrder, GS, true, true>(ring, g, S, E, F.wave); SEAM(9); }
#if (REPEAT_MASK & 0x200)
    if (IN(9)) {
        FRESH(); build_moe_tables(F);
        pg8::Gemm g{F.ws + WS_ACT, F.ws + WS_WDT}; using GS = pg8::GShape<DM, DM, DM, (size_t)DM * DM>;
        pg8::MoeOrder S{__builtin_amdgcn_readfirstlane((int)F.MISC[MI_NMT]), 8, F.G, (int)blockIdx.x, (const LAS int*)(F.lds + MISC_OFF + 4 * MI_T2E)};
        pg8::EpiFp8S E{F.ws + WS_Y, DM, p.in[I_BDN], DM, 1.0f / 2048.0f, 32.0f};
        pg8::gemm_phase<pg8::EpiFp8S, pg8::MoeOrder, GS, true, true>(ring, g, S, E, F.wave); SEAM(9); }
#endif
    if (IN(10)) REP(10) { FRESH(); p7(F, p); if (((REPEAT_MASK >> 10) & 1)) xcd_barrier(bar, F.wave == 0 && fresh_lane() == 0); }
#undef IN
#undef SEAM
}
#ifndef STAGE
#define STAGE 4
#endif
#ifndef PER_PHASE_LAUNCH
#define PER_PHASE_LAUNCH 0
#endif

#if STAGE < 4
__global__ void adapt_z_kernel(const bf16_t* Z, float* z) {
    const long idx = (long)blockIdx.x * blockDim.x + threadIdx.x; const long t = idx / ZC; const int c = (int)(idx % ZC);
    z[t * INC + (c < 3072 ? c : c + 16)] = bf2f(Z[idx]);
}
__global__ void adapt_bf16_kernel(const bf16_t* src, float* dst) { const long idx = (long)blockIdx.x * blockDim.x + threadIdx.x; dst[idx] = bf2f(src[idx]); }
#endif

static void launch_mk(Params& a, int lo, int hi, int grid, hipStream_t stream) {
#if PER_PHASE_LAUNCH
    for (int k = lo; k < hi; ++k) { a.ph_lo = k; a.ph_hi = k + 1; hipLaunchKernelGGL(mk_fwd, dim3(grid), dim3(512), LDS_BYTES, stream, a); }
#else
    a.ph_lo = lo; a.ph_hi = hi; hipLaunchKernelGGL(mk_fwd, dim3(grid), dim3(512), LDS_BYTES, stream, a);
#endif
}

extern "C" void kernel_launch(void* const* d_in, const int* in_sizes, int n_in, void* d_out, int out_size, void* d_ws, size_t ws_size, hipStream_t stream) {
    static int grid = 0;
    if (grid == 0) {
        int dev = 0, cus = 0;
        if (hipGetDevice(&dev) != hipSuccess || hipDeviceGetAttribute(&cus, hipDeviceAttributeMultiprocessorCount, dev) != hipSuccess) { grid = -1; return; }
        if (hipFuncSetAttribute((const void*)mk_fwd, hipFuncAttributeMaxDynamicSharedMemorySize, LDS_BYTES) != hipSuccess) { grid = -1; return; }
        int per_cu = 0;
        (void)hipOccupancyMaxActiveBlocksPerMultiprocessor(&per_cu, (const void*)mk_fwd, 512, LDS_BYTES);
        (void)hipGetLastError();
        grid = cus;
        if (per_cu < 1) fprintf(stderr, "kernel_launch: occupancy query reports %d\n", per_cu);
    }
    if (grid < 0) return;
    (void)hipMemsetAsync((char*)d_ws + WS_CTL, 0, CTL_ZERO_BYTES, stream);
    Params a{};
    for (int i = 0; i < 22; ++i) a.in[i] = (const float*)d_in[i];
    a.out = (float*)d_out; a.ws = (unsigned char*)d_ws;
#if STAGE >= 4
    launch_mk(a, 0, NPHASE, grid, stream);
#else
    const float* x = a.in[I_X];
    char* ws = (char*)d_ws + WS_ABUF; size_t off = 0;
    auto alloc = [&](size_t bytes) { void* p = ws + off; off += (bytes + 255) & ~(size_t)255; return p; };
    int* counts = (int*)alloc(256);
    float* z = (float*)alloc((size_t)T * INC * 4);
    float* ogla = (float*)alloc((size_t)T * 1024 * 4);
    float* xc = (float*)alloc((size_t)T * 1024 * 4);
    float* za = (float*)alloc((size_t)T * 1024 * 4);
    float* zi = (float*)alloc((size_t)T * 1024 * 4);
    float* mix = (float*)alloc((size_t)T * DM * 4);
    float* xmid = (float*)alloc((size_t)T * DM * 4);
    float* hf = (float*)alloc((size_t)T * DM * 4);
    float* logits = (float*)alloc((size_t)T * 32 * 4);
    float* gates = (float*)alloc((size_t)T * 4 * 4);
    int* list = (int*)alloc((size_t)NEXP * T * 4);
    float* act = (float*)alloc((size_t)T * 4 * DM * 4);
    float* y = (float*)alloc((size_t)T * 4 * DM * 4);
    (void)hipMemsetAsync(counts, 0, 256, stream);
#if STAGE == 1
    launch_mk(a, 0, 2, grid, stream);
    adapt_z_kernel<<<(unsigned)((size_t)T * ZC / 256), 256, 0, stream>>>((const bf16_t*)((char*)d_ws + WS_Z), z);
    gla_naive_kernel<<<64, 256, 0, stream>>>(z, (const float*)((char*)d_ws + WS_LG), ogla);
    gla_out_kernel<<<T, 256, 0, stream>>>(ogla, z, a.in[I_GNG], mix);
    lru_conv_kernel<<<T * 1024 / 256, 256, 0, stream>>>(z, a.in[I_CW], a.in[I_CB], xc);
    for (int h = 0; h < 4; ++h) {
        GemmArgs g{}; g.A = xc + h * 256; g.lda = 1024; g.ldb = 256; g.ldc = 1024; g.M = T; g.N = 256; g.K = 256; g.a_div = 1;
        g.B = a.in[I_WA] + (size_t)h * 65536; g.C = za + h * 256;
        sgemm_kernel<0><<<dim3(2, T / 128, 1), 256, 0, stream>>>(g);
        g.B = a.in[I_WI] + (size_t)h * 65536; g.C = zi + h * 256;
        sgemm_kernel<0><<<dim3(2, T / 128, 1), 256, 0, stream>>>(g);
    }
    lru_gate_kernel<<<T * 1024 / 256, 256, 0, stream>>>(xc, za, zi, a.in[I_BA], a.in[I_BI], a.in[I_AP]);
    lru_scan_kernel<<<2048 / 64, 64, 0, stream>>>(za, zi, z, mix);
#endif
#if STAGE == 2
    launch_mk(a, 0, 5, grid, stream);
    adapt_bf16_kernel<<<(unsigned)((size_t)T * DM / 256), 256, 0, stream>>>((const bf16_t*)((char*)d_ws + WS_MIX), mix);
#endif
#if STAGE <= 2
    { GemmArgs g{}; g.A = mix; g.lda = DM; g.B = a.in[I_WOUT]; g.ldb = DM; g.C = xmid; g.ldc = DM; g.M = T; g.N = DM; g.K = DM; g.a_div = 1; g.resid = x; g.ldr = DM;
      sgemm_kernel<1><<<dim3(DM / 128, T / 128, 1), 256, 0, stream>>>(g); }
#else
    launch_mk(a, 0, 6, grid, stream);
    xmid = (float*)((char*)d_ws + WS_XMID);
#endif
    rmsnorm_kernel<<<T, 256, 0, stream>>>(xmid, a.in[I_NFG], hf);
    { GemmArgs g{}; g.A = hf; g.lda = DM; g.B = a.in[I_WR]; g.ldb = 32; g.C = logits; g.ldc = 32; g.M = T; g.N = 32; g.K = DM; g.a_div = 1; g.bias = a.in[I_BR];
      sgemm_kernel<0><<<dim3(1, T / 128, 1), 256, 0, stream>>>(g); }
    route_kernel<<<T / 256, 256, 0, stream>>>(logits, counts, list, gates);
    { GemmArgs g{}; g.A = hf; g.lda = DM; g.B = a.in[I_WGU]; g.ldb = 4096; g.C = act; g.ldc = DM; g.M = 0; g.N = 4096; g.K = DM; g.a_div = 4; g.bias = a.in[I_BGU];
      g.rowlist = list; g.count = counts; g.strideB_e = (long)DM * 4096; g.strideBias_e = 4096; g.list_stride = T;
      sgemm_kernel<2><<<dim3(2048 / 64, T / 128, NEXP), 256, 0, stream>>>(g); }
    { GemmArgs g{}; g.A = act; g.lda = DM; g.B = a.in[I_WDN]; g.ldb = DM; g.C = y; g.ldc = DM; g.M = 0; g.N = DM; g.K = DM; g.a_div = 1; g.bias = a.in[I_BDN];
      g.rowlist = list; g.count = counts; g.strideB_e = (long)DM * DM; g.strideBias_e = DM; g.list_stride = T;
      sgemm_kernel<0><<<dim3(DM / 128, T / 128, NEXP), 256, 0, stream>>>(g); }
    final_kernel<<<T, 256, 0, stream>>>(xmid, y, gates, a.in[I_NFINAL], (float*)d_out);
#endif
}
```

```cpp
#define STAGE 4
#define PER_PHASE_LAUNCH 0
#define REPEAT_MASK 0
#include <hip/hip_runtime.h>
#include <stdint.h>
#include <stdio.h>

#define GAS __attribute__((address_space(1)))
#define LAS __attribute__((address_space(3)))
typedef unsigned short bf16_t;
typedef short bf16x8 __attribute__((ext_vector_type(8)));
typedef short bf16x4 __attribute__((ext_vector_type(4)));
typedef float f32x4 __attribute__((ext_vector_type(4)));
typedef float f32x2 __attribute__((ext_vector_type(2)));
typedef float f32x16 __attribute__((ext_vector_type(16)));
typedef unsigned u32x4 __attribute__((ext_vector_type(4)));
typedef unsigned u32x2 __attribute__((ext_vector_type(2)));
typedef int i32x8 __attribute__((ext_vector_type(8)));
typedef int i32x4 __attribute__((ext_vector_type(4)));
typedef int i32x32 __attribute__((ext_vector_type(32)));

constexpr int T = 16384, SEQL = 8192, DM = 2048, INC = 5136, ZC = 5120, NEXP = 32;
constexpr int ZQ = 0, ZK = 512, ZV = 1024, ZR = 2048, ZLX = 3072, ZLG = 4096;
constexpr int MPAD_MAX = 65536 + NEXP * 256;
constexpr int NCHUNK = 256;

constexpr size_t MiB = 1u << 20;
constexpr size_t WS_CTL = 0, CTL_ZERO_BYTES = 128 * 1024;
constexpr size_t WS_WINT = 1 * MiB;
constexpr size_t WS_WOUTT = WS_WINT + 20 * MiB;
constexpr size_t WS_WGUT = WS_WOUTT + 8 * MiB;
constexpr size_t WS_WDT = WS_WGUT + 512 * MiB;
constexpr size_t WS_WAT = WS_WDT + 256 * MiB;
constexpr size_t WS_WIT = WS_WAT + 512 * 1024;
constexpr size_t WS_WRT = WS_WIT + 512 * 1024;
constexpr size_t WS_H = WS_WRT + 1 * MiB;
constexpr size_t WS_LG = WS_H + 64 * MiB;
constexpr size_t WS_Z = WS_LG + 32 * MiB;
constexpr size_t WS_AN = WS_Z + 160 * MiB;
constexpr size_t WS_DN = WS_AN + 128 * MiB;
constexpr size_t WS_SP = WS_DN + 1 * MiB;
constexpr size_t WS_AUA = WS_SP + 64 * MiB;
constexpr size_t WS_AUU = WS_AUA + 64 * MiB;
constexpr size_t WS_SUMA = WS_AUU + 64 * MiB;
constexpr size_t WS_SUMH = WS_SUMA + 1 * MiB;
constexpr size_t WS_MIX = WS_SUMH + 1 * MiB;
constexpr size_t WS_XMID = WS_MIX + 64 * MiB;
constexpr size_t WS_RSTD = WS_XMID + 128 * MiB;
constexpr size_t WS_TOKE = WS_RSTD + 1 * MiB;
constexpr size_t WS_GATES = WS_TOKE + 1 * MiB;
constexpr size_t WS_ABUF = WS_GATES + 1 * MiB;
constexpr size_t WS_ACT = WS_ABUF + 288 * MiB;
constexpr size_t WS_Y = WS_ACT + 288 * MiB;
constexpr size_t WS_END = WS_Y + 288 * MiB;
constexpr int CW_BAR = 4096;
constexpr int CW_CNT = 16384;

constexpr int RING_BYTES = 131072;
constexpr int SCR_BYTES = 135168;
constexpr int MISC_OFF = SCR_BYTES;
constexpr int LDS_BYTES = 147456;
constexpr int MI_PBASE = 16, MI_NMT = 48, MI_LCNT = 64, MI_LBASE = 96, MI_T2E = 128;

#define LDS_WAIT() asm volatile("s_waitcnt lgkmcnt(0)" ::: "memory")
#define VM_WAIT() asm volatile("s_waitcnt vmcnt(0)" ::: "memory")

__device__ __forceinline__ unsigned f2bf(float f) { unsigned u = __builtin_bit_cast(unsigned, f); return (u + 0x7fffu + ((u >> 16) & 1u)) >> 16; }
__device__ __forceinline__ unsigned pk2(float lo, float hi) { return f2bf(lo) | (f2bf(hi) << 16); }
__device__ __forceinline__ float bf2f(unsigned short b) { return __builtin_bit_cast(float, (unsigned)b << 16); }
__device__ __forceinline__ float bflo(unsigned w) { return __builtin_bit_cast(float, w << 16); }
__device__ __forceinline__ float bfhi(unsigned w) { return __builtin_bit_cast(float, w & 0xffff0000u); }
__device__ __forceinline__ float clamp448(float x) { return __builtin_amdgcn_fmed3f(x, -448.0f, 448.0f); }
__device__ __forceinline__ unsigned pk4_fp8(float a, float b, float c, float d) {
    int p = 0; p = __builtin_amdgcn_cvt_pk_fp8_f32(clamp448(a), clamp448(b), p, false); p = __builtin_amdgcn_cvt_pk_fp8_f32(clamp448(c), clamp448(d), p, true); return (unsigned)p; }
__device__ __forceinline__ float fp8f(unsigned w, int b) { return b == 0 ? __builtin_amdgcn_cvt_f32_fp8((int)w, 0) : b == 1 ? __builtin_amdgcn_cvt_f32_fp8((int)w, 1) : b == 2 ? __builtin_amdgcn_cvt_f32_fp8((int)w, 2) : __builtin_amdgcn_cvt_f32_fp8((int)w, 3); }
__device__ __forceinline__ float wave_sum(float v) {
#pragma unroll
    for (int o = 1; o < 64; o <<= 1) v += __shfl_xor(v, o);
    return v;
}
__device__ __forceinline__ int fresh_lane() { int l; asm volatile("v_mbcnt_lo_u32_b32 %0, -1, 0\n\tv_mbcnt_hi_u32_b32 %0, -1, %0" : "=v"(l)); return l; }
__device__ __forceinline__ float sigmoidf_(float x) { return 1.0f / (1.0f + __expf(-x)); }

#define XB_TMO      128
#define XB_XCNT(j)  (256  + 64 * (j))
#define XB_XSUB(j)  (1280 + 64 * (j))
#define XB_XGEN(j)  (2304 + 64 * (j))
#define XB_TOP      3328
#define XB_TOPGEN   3392
#define XCD_BAR_WORDS 3456
#define XB_SPIN_CAP (1u << 18)

__device__ __forceinline__ unsigned xb_ld(unsigned* p)              { return __hip_atomic_load(p, __ATOMIC_RELAXED, __HIP_MEMORY_SCOPE_AGENT); }
__device__ __forceinline__ unsigned xb_add(unsigned* p, unsigned v) { return __hip_atomic_fetch_add(p, v, __ATOMIC_RELAXED, __HIP_MEMORY_SCOPE_AGENT); }
__device__ __forceinline__ unsigned xb_xcc_id() { return (unsigned)__builtin_amdgcn_s_getreg((3 << 11) | 20) & 0xFu; }
#define XB_SPIN(cond, bar) do { unsigned _sp = 0; while (cond) { __builtin_amdgcn_s_sleep(1); \
    if ((++_sp & 255u) == 0u) { if (xb_ld(&(bar)[XB_TMO])) break; if (_sp > XB_SPIN_CAP) { atomicAdd(&(bar)[XB_TMO], 1u); break; } } } } while (0)

struct XcdBarrier { unsigned* bar; unsigned x; volatile LAS unsigned* st; };

__device__ __forceinline__ XcdBarrier xcd_barrier_post(unsigned* bar, volatile LAS unsigned* st, bool t0) {
    XcdBarrier b; b.bar = bar; b.x = xb_xcc_id(); b.st = st;
    if (t0) (void)xb_add(&bar[XB_XCNT(b.x)], 1u);
    return b;
}
__device__ __forceinline__ void xcd_barrier_complete(unsigned* bar, unsigned x, unsigned& nloc, unsigned& nx) {
    const unsigned G = gridDim.x * gridDim.y * gridDim.z;
    unsigned sum, cnt, mine, sp = 0u;
    for (;;) {
        sum = 0u; cnt = 0u; mine = 0u;
#pragma unroll
        for (unsigned j = 0; j < 16; ++j) { const unsigned c = xb_ld(&bar[XB_XCNT(j)]); sum += c; cnt += (c > 0u) ? 1u : 0u; mine = (j == x) ? c : mine; }
        if (sum == G) break;
        __builtin_amdgcn_s_sleep(1);
        if ((++sp & 255u) == 0u) { if (xb_ld(&bar[XB_TMO])) break; if (sp > XB_SPIN_CAP) { atomicAdd(&bar[XB_TMO], 1u); break; } }
    }
    nloc = mine > 0u ? mine : 1u; nx = cnt > 0u ? cnt : 1u;
}
__device__ __forceinline__ void xcd_barrier(const XcdBarrier& b, bool t0) {
    asm volatile("s_waitcnt vmcnt(0)" ::: "memory");
    __syncthreads();
    if (t0) {
        unsigned* bar = b.bar;
        __builtin_amdgcn_s_waitcnt(0);
        unsigned nloc = b.st[0], nx = b.st[1];
        if (nloc == 0u) { xcd_barrier_complete(bar, b.x, nloc, nx); b.st[0] = nloc; b.st[1] = nx; }
        const unsigned old = xb_add(&bar[XB_XSUB(b.x)], 1u);
        const unsigned gen = old / nloc;
        if (old + 1u == (gen + 1u) * nloc) {
            __builtin_amdgcn_fence(__ATOMIC_RELEASE, "agent");
            asm volatile("s_waitcnt vmcnt(0)" ::: "memory");
            const unsigned og = xb_add(&bar[XB_TOP], 1u);
            const unsigned tg = og / nx;
            if (og + 1u == (tg + 1u) * nx) xb_add(&bar[XB_TOPGEN], 1u);
            else XB_SPIN(xb_ld(&bar[XB_TOPGEN]) == tg, bar);
            __builtin_amdgcn_fence(__ATOMIC_ACQUIRE, "agent");
            xb_add(&bar[XB_XGEN(b.x)], 1u);
            asm volatile("s_waitcnt vmcnt(0)" ::: "memory");
        } else {
            XB_SPIN(xb_ld(&bar[XB_XGEN(b.x)]) == gen, bar);
            __builtin_amdgcn_fence(__ATOMIC_ACQUIRE, "agent");
            asm volatile("s_waitcnt vmcnt(0)" ::: "memory");
        }
    }
    __syncthreads();
}

namespace pg8 {
constexpr int BM = 256, BK = 64, HALF = 128, HTB = HALF * BK * 2, STAGE_BYTES = 8 * HTB, NXCD = 8, WGM = 8;
__host__ __device__ __forceinline__ int lds_byte(int r, int c) { const int st = (r >> 4) * 2 + (c >> 5), rr = r & 15, cc = c & 31, ob = rr * 64 + cc * 2; return st * 1024 + (ob ^ (((ob >> 9) & 1) << 5)); }
__host__ __device__ __forceinline__ void stage_rc(int b, int& R, int& C) { const int st = b / 1024, sb = b % 1024, swz = sb ^ (((sb >> 9) & 1) << 5); R = (st >> 1) * 16 + swz / 64; C = (st & 1) * 32 + (swz % 64) / 2; }
__host__ __device__ __forceinline__ int perm32(int rho) { const int n = rho >> 4, i = rho & 15; return 8 * (i >> 2) + 4 * n + (i & 3); }

struct Unit { int pm, pn, e; };
struct Gemm { const void* A; const void* Bt; };
template <int LDA_, int LDB_, int KB_, size_t SB_> struct GShape { static constexpr int LDA = LDA_, LDB = LDB_, KB = KB_; static constexpr size_t SB = SB_; };

__device__ __forceinline__ bool order_map(int L, int nM, int nN, int& pm, int& pn) {
    const int nwg = nM * nN; if (L >= nwg) return false;
    int wgid = L; { const int q = nwg / NXCD, r = nwg % NXCD, xcd = wgid % NXCD, off = wgid / NXCD; wgid = (xcd < r ? xcd * (q + 1) : r * (q + 1) + (xcd - r) * q) + off; }
    const int nig = WGM * nN, gid = wgid / nig, fm = gid * WGM, gsz = (nM - fm) < WGM ? (nM - fm) : WGM;
    pm = fm + ((wgid % nig) % gsz); pn = (wgid % nig) / gsz; return true;
}
struct StaticOrder {
    int nM, nN, G, c;
    __device__ void init(int M, int N, int G_, int c_) { nM = M / BM; nN = N / BM; G = G_; c = c_; }
    __device__ __forceinline__ bool next(int i, Unit& u) const { u.e = 0; return order_map(i * G + c, nM, nN, u.pm, u.pn); }
};
struct MoeOrder {
    int nM, nN, G, c; const LAS int* t2e;
    __device__ __forceinline__ bool next(int i, Unit& u) const { if (!order_map(i * G + c, nM, nN, u.pm, u.pn)) return false; u.e = __builtin_amdgcn_readfirstlane(t2e[u.pm]); return true; }
};

__device__ __forceinline__ unsigned cvt_pk_bf16(float lo, float hi) { unsigned r; asm volatile("v_cvt_pk_bf16_f32 %0, %1, %2" : "=v"(r) : "v"(lo), "v"(hi)); return r; }

struct EpiBf16 {
    static constexpr bool PERM = true;
    bf16_t* O; int ldc; const float* bias; int bias_stride;
    __device__ __forceinline__ void operator()(const f32x4 (&acc)[2][2][4][2], const Unit& u, int wr, int wc, int fr, int fq) const {
        const int row0 = u.pm * BM + wr * 64 + fr; const int col0 = u.pn * BM + wc * 32 + 8 * fq;
        f32x4 bv[2][2];
#pragma unroll
        for (int bj = 0; bj < 2; ++bj)
#pragma unroll
            for (int n = 0; n < 2; ++n) bv[bj][n] = bias ? *(const f32x4*)(bias + (size_t)u.e * bias_stride + col0 + bj * HALF + 4 * n) : (f32x4){0.f, 0.f, 0.f, 0.f};
#pragma unroll
        for (int ai = 0; ai < 2; ++ai)
#pragma unroll
            for (int m = 0; m < 4; ++m) { bf16_t* rowp = O + (size_t)(row0 + ai * HALF + m * 16) * ldc + col0;
#pragma unroll
                for (int bj = 0; bj < 2; ++bj) { const f32x4 v0 = acc[ai][bj][m][0] + bv[bj][0], v1 = acc[ai][bj][m][1] + bv[bj][1];
                    u32x4 w; w.x = cvt_pk_bf16(v0[0], v0[1]); w.y = cvt_pk_bf16(v0[2], v0[3]); w.z = cvt_pk_bf16(v1[0], v1[1]); w.w = cvt_pk_bf16(v1[2], v1[3]);
                    *(u32x4*)(rowp + bj * HALF) = w; } }
    }
};
struct EpiF32Res {
    static constexpr bool PERM = false;
    float* C; const float* resid; int ldc;
    __device__ __forceinline__ void operator()(const f32x4 (&acc)[2][2][4][2], const Unit& u, int wr, int wc, int fr, int fq) const {
        const int row0 = u.pm * BM + wr * 64 + fr, col0 = u.pn * BM + wc * 32 + 4 * fq;
#pragma unroll
        for (int ai = 0; ai < 2; ++ai)
#pragma unroll
            for (int m = 0; m < 4; ++m) { const size_t off = (size_t)(row0 + ai * HALF + m * 16) * ldc + col0;
#pragma unroll
                for (int bj = 0; bj < 2; ++bj)
#pragma unroll
                    for (int n = 0; n < 2; ++n) { const f32x4 r = *(const f32x4*)(resid + off + bj * HALF + n * 16); *(f32x4*)(C + off + bj * HALF + n * 16) = acc[ai][bj][m][n] + r; } }
    }
};
struct EpiSwiGLU {
    static constexpr bool PERM = true;
    bf16_t* O; int ldc; const float* bias;
    __device__ __forceinline__ void operator()(const f32x4 (&acc)[2][2][4][2], const Unit& u, int wr, int wc, int fr, int fq) const {
        const int row0 = u.pm * BM + wr * 64 + fr; const int j0 = u.pn * HALF + wc * 32 + 8 * fq;
        const float* be = bias + (size_t)u.e * 4096;
        f32x4 bg[2], bu[2];
#pragma unroll
        for (int n = 0; n < 2; ++n) { bg[n] = *(const f32x4*)(be + j0 + 4 * n); bu[n] = *(const f32x4*)(be + 2048 + j0 + 4 * n); }
#pragma unroll
        for (int ai = 0; ai < 2; ++ai)
#pragma unroll
            for (int m = 0; m < 4; ++m) { bf16_t* rowp = O + (size_t)(row0 + ai * HALF + m * 16) * ldc + j0;
                float o[8];
#pragma unroll
                for (int n = 0; n < 2; ++n) { const f32x4 g = acc[ai][0][m][n] + bg[n], up = acc[ai][1][m][n] + bu[n];
#pragma unroll
                    for (int q = 0; q < 4; ++q) { const float gt = fminf(g[q], 7.0f), ut = fminf(fmaxf(up[q], -7.0f), 7.0f);
                        const float glu = gt * __builtin_amdgcn_rcpf(1.0f + __expf(-1.702f * gt)); o[4 * n + q] = (ut + 1.0f) * glu; } }
                u32x4 w; w.x = cvt_pk_bf16(o[0], o[1]); w.y = cvt_pk_bf16(o[2], o[3]); w.z = cvt_pk_bf16(o[4], o[5]); w.w = cvt_pk_bf16(o[6], o[7]);
                *(u32x4*)rowp = w; }
    }
};

struct EpiBf16Res {
    static constexpr bool PERM = true;
    bf16_t* O; const float* resid; int ldc;
    __device__ __forceinline__ void operator()(const f32x4 (&acc)[2][2][4][2], const Unit& u, int wr, int wc, int fr, int fq) const {
        const int row0 = u.pm * BM + wr * 64 + fr; const int col0 = u.pn * BM + wc * 32 + 8 * fq;
#pragma unroll
        for (int ai = 0; ai < 2; ++ai)
#pragma unroll
            for (int m = 0; m < 4; ++m) { const size_t off = (size_t)(row0 + ai * HALF + m * 16) * ldc + col0;
#pragma unroll
                for (int bj = 0; bj < 2; ++bj) { const f32x4 r0 = *(const f32x4*)(resid + off + bj * HALF), r1 = *(const f32x4*)(resid + off + bj * HALF + 4);
                    const f32x4 v0 = acc[ai][bj][m][0] + r0, v1 = acc[ai][bj][m][1] + r1;
                    u32x4 w; w.x = cvt_pk_bf16(v0[0], v0[1]); w.y = cvt_pk_bf16(v0[2], v0[3]); w.z = cvt_pk_bf16(v1[0], v1[1]); w.w = cvt_pk_bf16(v1[2], v1[3]);
                    *(u32x4*)(O + off + bj * HALF) = w; } }
    }
};
struct EpiFp8S {
    static constexpr bool PERM = true;
    unsigned char* O; int ldc; const float* bias; int bias_stride; float scale, oscale;
    __device__ __forceinline__ void operator()(const f32x4 (&acc)[2][2][4][2], const Unit& u, int wr, int wc, int fr, int fq) const {
        const int row0 = u.pm * BM + wr * 64 + fr; const int col0 = u.pn * BM + wc * 32 + 8 * fq;
        f32x4 bv[2][2];
#pragma unroll
        for (int bj = 0; bj < 2; ++bj)
#pragma unroll
            for (int n = 0; n < 2; ++n) bv[bj][n] = *(const f32x4*)(bias + (size_t)u.e * bias_stride + col0 + bj * HALF + 4 * n) * oscale;
        const float sc = scale * oscale;
#pragma unroll
        for (int ai = 0; ai < 2; ++ai)
#pragma unroll
            for (int m = 0; m < 4; ++m) { unsigned char* rowp = O + (size_t)(row0 + ai * HALF + m * 16) * ldc + col0;
#pragma unroll
                for (int bj = 0; bj < 2; ++bj) { const f32x4 v0 = acc[ai][bj][m][0] * sc + bv[bj][0], v1 = acc[ai][bj][m][1] * sc + bv[bj][1];
                    u32x2 w; w.x = pk4_fp8(v0[0], v0[1], v0[2], v0[3]); w.y = pk4_fp8(v1[0], v1[1], v1[2], v1[3]);
                    *(u32x2*)(rowp + bj * HALF) = w; } }
    }
};
struct EpiSwiGLU8 {
    static constexpr bool PERM = true;
    unsigned char* O; int ldc; const float* bias;
    __device__ __forceinline__ void operator()(const f32x4 (&acc)[2][2][4][2], const Unit& u, int wr, int wc, int fr, int fq) const {
        const int row0 = u.pm * BM + wr * 64 + fr; const int j0 = u.pn * HALF + wc * 32 + 8 * fq;
        const float* be = bias + (size_t)u.e * 4096;
        f32x4 bg[2], bu[2];
#pragma unroll
        for (int n = 0; n < 2; ++n) { bg[n] = *(const f32x4*)(be + j0 + 4 * n); bu[n] = *(const f32x4*)(be + 2048 + j0 + 4 * n); }
#pragma unroll
        for (int ai = 0; ai < 2; ++ai)
#pragma unroll
            for (int m = 0; m < 4; ++m) { unsigned char* rowp = O + (size_t)(row0 + ai * HALF + m * 16) * ldc + j0;
                float o[8];
#pragma unroll
                for (int n = 0; n < 2; ++n) { const f32x4 g = acc[ai][0][m][n] * (1.0f / 8192.0f) + bg[n], up = acc[ai][1][m][n] * (1.0f / 8192.0f) + bu[n];
#pragma unroll
                    for (int q = 0; q < 4; ++q) { const float gt = fminf(g[q], 7.0f), ut = fminf(fmaxf(up[q], -7.0f), 7.0f);
                        const float glu = gt * __builtin_amdgcn_rcpf(1.0f + __expf(-1.702f * gt)); o[4 * n + q] = 4.0f * (ut + 1.0f) * glu; } }
                u32x2 w; w.x = pk4_fp8(o[0], o[1], o[2], o[3]); w.y = pk4_fp8(o[4], o[5], o[6], o[7]);
                *(u32x2*)rowp = w; }
    }
};
struct EpiBf16S {
    static constexpr bool PERM = true;
    bf16_t* O; int ldc; const float* bias; int bias_stride; float scale;
    __device__ __forceinline__ void operator()(const f32x4 (&acc)[2][2][4][2], const Unit& u, int wr, int wc, int fr, int fq) const {
        const int row0 = u.pm * BM + wr * 64 + fr; const int col0 = u.pn * BM + wc * 32 + 8 * fq;
        f32x4 bv[2][2];
#pragma unroll
        for (int bj = 0; bj < 2; ++bj)
#pragma unroll
            for (int n = 0; n < 2; ++n) bv[bj][n] = *(const f32x4*)(bias + (size_t)u.e * bias_stride + col0 + bj * HALF + 4 * n);
#pragma unroll
        for (int ai = 0; ai < 2; ++ai)
#pragma unroll
            for (int m = 0; m < 4; ++m) { bf16_t* rowp = O + (size_t)(row0 + ai * HALF + m * 16) * ldc + col0;
#pragma unroll
                for (int bj = 0; bj < 2; ++bj) { const f32x4 v0 = acc[ai][bj][m][0] * scale + bv[bj][0], v1 = acc[ai][bj][m][1] * scale + bv[bj][1];
                    u32x4 w; w.x = cvt_pk_bf16(v0[0], v0[1]); w.y = cvt_pk_bf16(v0[2], v0[3]); w.z = cvt_pk_bf16(v1[0], v1[1]); w.w = cvt_pk_bf16(v1[2], v1[3]);
                    *(u32x4*)(rowp + bj * HALF) = w; } }
    }
};

__device__ __forceinline__ i32x8 pg8_get8(const i32x32& v, int idx) { i32x8 r;
#pragma unroll
    for (int j = 0; j < 8; ++j) r[j] = v[8 * idx + j];
    return r; }
__device__ __forceinline__ i32x4 pg8_get4(const i32x32& v, int idx) { i32x4 r;
#pragma unroll
    for (int j = 0; j < 4; ++j) r[j] = v[4 * idx + j];
    return r; }
template <class Epi, class Sched, class GS, bool ALIGN_EPI = true, bool F8 = false>
__device__ __forceinline__ void gemm_phase(LAS unsigned char* lds, const Gemm g, const Sched& S, const Epi& E, int wave) {
    const int wid = wave, lane = fresh_lane(), tid = wid * 64 + lane, wr = wid >> 2, wc = wid & 3, fr = lane & 15, fq = lane >> 4;
    constexpr int nt = GS::KB / 128;
    unsigned voffA, voffB;
    { int R, C; stage_rc(tid * 16, R, C); const int Rb = Epi::PERM ? ((R & ~31) + perm32(R & 31)) : R;
      voffA = (unsigned)(R * GS::LDA + C * 2); voffB = (unsigned)(Rb * GS::LDB + C * 2); }
    constexpr size_t pstepA = (size_t)64 * GS::LDA, pstepB = (size_t)64 * GS::LDB;
    constexpr size_t kstep = (size_t)(BK * 2);
    constexpr size_t hstepA = (size_t)HALF * GS::LDA, hstepB = (size_t)HALF * GS::LDB;
    constexpr size_t tstepA = 2 * hstepA, tstepB = 2 * hstepB;
    const unsigned ldsw = (unsigned)wid * 1024u;
    const unsigned ldsb = (unsigned)(size_t)lds + ldsw;
    const int aoff = lds_byte(wr * 64 + fr, F8 ? fq * 16 : fq * 8), boff = lds_byte(wc * 32 + fr, F8 ? fq * 16 : fq * 8);
    const int kofs = F8 ? 16 : 1024;
#define PG8_SA(b, h) (((b) * 2 + (h)) * HTB)
#define PG8_SB(b, h) ((4 + (b) * 2 + (h)) * HTB)
#define PG8_STAGE(bufoff, gbase, voff) do { _Pragma("unroll") for (int _i = 0; _i < 2; ++_i) { unsigned _keep; \
        asm volatile("s_mov_b32 %0, m0\n\ts_mov_b32 m0, %3\n\ts_nop 0\n\tglobal_load_lds_dwordx4 %1, %2\n\ts_mov_b32 m0, %0" \
            : "=&s"(_keep) : "v"(voff##_v), "s"((const char*)(gbase) + _i * pstep##voff), "s"(ldsb + (unsigned)((bufoff) + _i * 8192)) : "memory"); } } while (0)
#define pstepvoffA pstepA
#define pstepvoffB pstepB
#define voffA_v voffA
#define voffB_v voffB
#define PG8_LD16(p) (*(const LAS i32x4*)(p))
#define PG8_SET8(V, idx, lo, hi) do { _Pragma("unroll") for (int _j = 0; _j < 4; ++_j) { V[8 * (idx) + _j] = (lo)[_j]; V[8 * (idx) + 4 + _j] = (hi)[_j]; } } while (0)
#define PG8_GET8(V, idx) pg8_get8(V, idx)
#define PG8_GETLO(V, idx) __builtin_bit_cast(bf16x8, pg8_get4(V, 2 * (idx)))
#define PG8_GETHI(V, idx) __builtin_bit_cast(bf16x8, pg8_get4(V, 2 * (idx) + 1))
#define PG8_LDA(dst, b, h) do { _Pragma("unroll") for (int m = 0; m < 4; ++m) { const i32x4 _lo = PG8_LD16(lds + PG8_SA(b, h) + aoff + m * 2048), _hi = PG8_LD16(lds + PG8_SA(b, h) + aoff + m * 2048 + kofs); \
        PG8_SET8(AV, m, _lo, _hi); } } while (0)
#define PG8_LDB(dst, b, h) do { _Pragma("unroll") for (int n = 0; n < 2; ++n) { const i32x4 _lo = PG8_LD16(lds + PG8_SB(b, h) + boff + n * 2048), _hi = PG8_LD16(lds + PG8_SB(b, h) + boff + n * 2048 + kofs); \
        PG8_SET8(BV, (dst) + n, _lo, _hi); } } while (0)
#define PG8_MMA(ai, bj, At, Bt) do { __builtin_amdgcn_s_setprio(1); \
        if constexpr (F8) { _Pragma("unroll") for (int m = 0; m < 4; ++m) _Pragma("unroll") for (int n = 0; n < 2; ++n) \
            acc[ai][bj][m][n] = __builtin_amdgcn_mfma_scale_f32_16x16x128_f8f6f4(PG8_GET8(BV, (Bt) + n), PG8_GET8(AV, m), acc[ai][bj][m][n], 0, 0, 0, 0, 0, 0); } \
        else { _Pragma("unroll") for (int m = 0; m < 4; ++m) _Pragma("unroll") for (int n = 0; n < 2; ++n) { \
            acc[ai][bj][m][n] = __builtin_amdgcn_mfma_f32_16x16x32_bf16(PG8_GETLO(BV, (Bt) + n), PG8_GETLO(AV, m), acc[ai][bj][m][n], 0, 0, 0); \
            acc[ai][bj][m][n] = __builtin_amdgcn_mfma_f32_16x16x32_bf16(PG8_GETHI(BV, (Bt) + n), PG8_GETHI(AV, m), acc[ai][bj][m][n], 0, 0, 0); } } \
        __builtin_amdgcn_s_setprio(0); } while (0)
#define PG8_WAIT_V(n) asm volatile("s_waitcnt vmcnt(" #n ")" ::: "memory")
#define PG8_WAIT_L(n) asm volatile("s_waitcnt lgkmcnt(" #n ")" ::: "memory")
#define PG8_BAR __builtin_amdgcn_s_barrier()
#define PG8_SCHED __builtin_amdgcn_sched_barrier(0)
    Unit cur, nxt; int ui = 0;
    if (!S.next(0, cur)) return;
    i32x32 AV, BV;
    constexpr int At = 0, B0 = 0, B1 = 2;
    const char* cA = (const char*)g.A + (size_t)cur.pm * tstepA; const char* cB = (const char*)g.Bt + (size_t)cur.e * GS::SB + (size_t)cur.pn * tstepB;
    PG8_STAGE(PG8_SB(0, 0), cB, voffB); PG8_SCHED; PG8_STAGE(PG8_SB(0, 1), cB + hstepB, voffB); PG8_SCHED; PG8_STAGE(PG8_SA(0, 0), cA, voffA); PG8_SCHED; PG8_STAGE(PG8_SA(0, 1), cA + hstepA, voffA); PG8_SCHED;
    if (wr == 1) PG8_BAR;
    PG8_WAIT_V(2); PG8_BAR;
    PG8_STAGE(PG8_SB(1, 0), cB + kstep, voffB); PG8_SCHED; PG8_STAGE(PG8_SA(1, 0), cA + kstep, voffA); PG8_SCHED; PG8_STAGE(PG8_SB(1, 1), cB + hstepB + kstep, voffB); PG8_SCHED;
    PG8_WAIT_V(6); PG8_BAR; PG8_SCHED;
    f32x4 acc[2][2][4][2];
#pragma unroll
    for (int a = 0; a < 2; ++a)
#pragma unroll
        for (int b = 0; b < 2; ++b)
#pragma unroll
            for (int m = 0; m < 4; ++m)
#pragma unroll
                for (int n = 0; n < 2; ++n) acc[a][b][m][n] = (f32x4){0.f, 0.f, 0.f, 0.f};
    for (;;) {
        const bool has_next = S.next(ui + 1, nxt);
        const char* nA = has_next ? (const char*)g.A + (size_t)nxt.pm * tstepA : cA;
        const char* nB = has_next ? (const char*)g.Bt + (size_t)nxt.e * GS::SB + (size_t)nxt.pn * tstepB : cB;
        for (int t = 0; t < nt; t += 2) {
            const bool last = (t == nt - 2);
            const char* a1 = cA + (size_t)(t + 1) * kstep;
            const char* a2 = last ? nA : cA + (size_t)(t + 2) * kstep; const char* b2 = last ? nB : cB + (size_t)(t + 2) * kstep;
            const char* a3 = a2 + kstep; const char* b3 = b2 + kstep;
            PG8_LDB(B0, 0, 0); PG8_LDB(B1, 0, 1); PG8_SCHED; PG8_LDA(At, 0, 0); PG8_STAGE(PG8_SA(1, 1), a1 + hstepA, voffA);
            PG8_WAIT_V(8); PG8_WAIT_L(0); PG8_BAR; PG8_MMA(0, 0, At, B0); PG8_MMA(0, 1, At, B1); PG8_BAR; PG8_SCHED;
            PG8_LDA(At, 0, 1); PG8_STAGE(PG8_SB(0, 0), b2, voffB); PG8_STAGE(PG8_SB(0, 1), b2 + hstepB, voffB); PG8_STAGE(PG8_SA(0, 0), a2, voffA);
            PG8_WAIT_V(8); PG8_WAIT_L(0); PG8_BAR; PG8_MMA(1, 0, At, B0); PG8_MMA(1, 1, At, B1); PG8_BAR; PG8_SCHED;
            PG8_LDB(B0, 1, 0); PG8_LDB(B1, 1, 1); PG8_SCHED; PG8_LDA(At, 1, 0); PG8_STAGE(PG8_SA(0, 1), a2 + hstepA, voffA);
            PG8_WAIT_V(8); PG8_WAIT_L(0); PG8_BAR; PG8_MMA(0, 0, At, B0); PG8_MMA(0, 1, At, B1); PG8_BAR; PG8_SCHED;
            PG8_LDA(At, 1, 1); PG8_STAGE(PG8_SB(1, 0), b3, voffB); PG8_STAGE(PG8_SB(1, 1), b3 + hstepB, voffB); PG8_STAGE(PG8_SA(1, 0), a3, voffA);
            PG8_WAIT_V(8); PG8_WAIT_L(0); PG8_BAR; PG8_MMA(1, 0, At, B0); PG8_MMA(1, 1, At, B1); PG8_BAR; PG8_SCHED;
        }
        if constexpr (ALIGN_EPI) { if (wr == 0) PG8_BAR; }
        { const int l2 = fresh_lane();
          E(acc, cur, wr, wc, l2 & 15, l2 >> 4); }
        if (!has_next) break;
#pragma unroll
        for (int a = 0; a < 2; ++a)
#pragma unroll
            for (int b = 0; b < 2; ++b)
#pragma unroll
                for (int m = 0; m < 4; ++m)
#pragma unroll
                    for (int n = 0; n < 2; ++n) acc[a][b][m][n] = (f32x4){0.f, 0.f, 0.f, 0.f};
        cur = nxt; cA = nA; cB = nB; ++ui;
        if constexpr (ALIGN_EPI) { if (wr == 1) PG8_BAR; }
    }
    PG8_WAIT_V(0);
    if constexpr (!ALIGN_EPI) { if (wr == 0) PG8_BAR; }
    PG8_BAR;
#undef PG8_SA
#undef PG8_SB
#undef PG8_STAGE
#undef pstepvoffA
#undef pstepvoffB
#undef voffA_v
#undef voffB_v
#undef PG8_LDA
#undef PG8_LD16
#undef PG8_SET8
#undef PG8_GET8
#undef PG8_GETLO
#undef PG8_GETHI
#undef PG8_LDB
#undef PG8_MMA
#undef PG8_WAIT_V
#undef PG8_WAIT_L
#undef PG8_BAR
#undef PG8_SCHED
}
}
struct Params {
    const float* in[22];
    float* out; unsigned char* ws;
    int ph_lo, ph_hi;
};
enum { I_X = 0, I_NMG, I_WIN, I_GWG, I_GBG, I_GNG, I_CW, I_CB, I_WA, I_BA, I_WI, I_BI, I_AP, I_WOUT, I_NFG, I_WR, I_BR, I_WGU, I_BGU, I_WDN, I_BDN, I_NFINAL };

struct Frame {
    LAS unsigned char* lds; volatile LAS unsigned* MISC;
    int tid, lane, wave, G, gw, NGW;
    unsigned char* ws;
};

__device__ __forceinline__ float gelu_tanh_f(float x) {
    const float u = 0.7978845608028654f * (x + 0.044715f * x * x * x);
    const float e = __expf(2.0f * u);
    const float th = 1.0f - 2.0f * __builtin_amdgcn_rcpf(e + 1.0f);
    return 0.5f * x * (1.0f + th);
}
__device__ __forceinline__ float log_sigmoid_f(float s) { return fminf(s, 0.f) - log1pf(__expf(-fabsf(s))); }

__device__ __forceinline__ void p0_item(const float* W, int ldw, int col0, bf16_t* WT, int ldt, size_t drow0, int k0, LAS float* scr, int lane) {
    (void)scr;
    const float* src = W + (size_t)k0 * ldw + col0 + lane;
    float v[64];
#pragma unroll
    for (int i = 0; i < 64; ++i) v[i] = src[(size_t)i * ldw];
    bf16_t* dst = WT + (drow0 + lane) * (size_t)ldt + k0;
#pragma unroll
    for (int c = 0; c < 8; ++c) { u32x4 o; o.x = pk2(v[8 * c], v[8 * c + 1]); o.y = pk2(v[8 * c + 2], v[8 * c + 3]); o.z = pk2(v[8 * c + 4], v[8 * c + 5]); o.w = pk2(v[8 * c + 6], v[8 * c + 7]);
        *(u32x4*)(dst + 8 * c) = o; }
}

__device__ __forceinline__ void p0_item8(const float* W, int ldw, int col0, unsigned char* WT, int ldt, size_t drow0, int k0, int lane) {
    const float* src = W + (size_t)k0 * ldw + col0 + lane;
    float v[64];
#pragma unroll
    for (int i = 0; i < 64; ++i) v[i] = src[(size_t)i * ldw];
    unsigned char* dst = WT + (drow0 + lane) * (size_t)ldt + k0;
#pragma unroll
    for (int c = 0; c < 4; ++c) { u32x4 o;
#pragma unroll
        for (int q = 0; q < 4; ++q) o[q] = pk4_fp8(v[16 * c + 4 * q] * 512.0f, v[16 * c + 4 * q + 1] * 512.0f, v[16 * c + 4 * q + 2] * 512.0f, v[16 * c + 4 * q + 3] * 512.0f);
        *(u32x4*)(dst + 16 * c) = o; }
}

struct CoopTile { const float* W; int ldw; int col0; unsigned char* WT; int ldt_b; int mode; int k0; int gu; int drow0; };
__device__ __forceinline__ void coop_load(const CoopTile& t, int w, int l, f32x4 (&v)[16]) {
    if (t.mode == 0) {
#pragma unroll
        for (int i = 0; i < 8; ++i) { const float* r = t.W + (size_t)(t.k0 + 8 * w + i) * t.ldw + t.col0 + 4 * l; v[2 * i] = *(const f32x4*)r; v[2 * i + 1] = *(const f32x4*)(r + 256); }
    } else {
#pragma unroll
        for (int i = 0; i < 16; ++i) v[i] = *(const f32x4*)(t.W + (size_t)(t.k0 + 16 * w + i) * t.ldw + t.col0 + 4 * l);
    }
}
__device__ __forceinline__ void coop_to_lds(const CoopTile& t, int w, int l, const f32x4 (&v)[16], LAS unsigned char* buf) {
    const int sw = (w ^ (l & 7)) * 16;
    if (t.mode == 0) {
#pragma unroll
        for (int jp = 0; jp < 2; ++jp)
#pragma unroll
            for (int j = 0; j < 4; ++j) { u32x4 o; o.x = pk2(v[0 + jp][j], v[2 + jp][j]); o.y = pk2(v[4 + jp][j], v[6 + jp][j]); o.z = pk2(v[8 + jp][j], v[10 + jp][j]); o.w = pk2(v[12 + jp][j], v[14 + jp][j]);
                *(LAS u32x4*)(buf + (256 * jp + 4 * l + j) * 128 + sw) = o; }
    } else {
#pragma unroll
        for (int j = 0; j < 4; ++j) { u32x4 o;
#pragma unroll
            for (int q = 0; q < 4; ++q) o[q] = pk4_fp8(v[4 * q][j] * 512.0f, v[4 * q + 1][j] * 512.0f, v[4 * q + 2][j] * 512.0f, v[4 * q + 3][j] * 512.0f);
            *(LAS u32x4*)(buf + (4 * l + j) * 128 + sw) = o; }
    }
}
__device__ __forceinline__ void coop_store(const CoopTile& t, int w, int l, const LAS unsigned char* buf) {
    const int nrows = t.mode == 0 ? 512 : 256; const int cp = l & 7;
    for (int n = 8 * w + (l >> 3); n < nrows; n += 64) {
        const u32x4 o = *(const LAS u32x4*)(buf + n * 128 + cp * 16); const int c = cp ^ ((n >> 2) & 7);
        int drow;
        if (t.gu) { const int g = t.col0 + n; drow = (g < 2048) ? (256 * (g >> 7) + (g & 127)) : (256 * ((g - 2048) >> 7) + 128 + ((g - 2048) & 127)); } else drow = t.drow0 + n;
        *(u32x4*)(t.WT + (size_t)drow * t.ldt_b + (t.mode == 0 ? 2 * t.k0 : t.k0) + 16 * c) = o; }
}
__device__ __forceinline__ bool coop_tile(const Params& p, unsigned char* ws, int it, CoopTile& t) {
    constexpr int N_GU = 32 * 256, N_DN = 32 * 128, N_INA = 32 * 6, N_INB = 32 * 4, N_OUT = 32 * 4;
    int r = it;
    if (r < N_GU) { const int e = r >> 8, q = r & 255, kb = q >> 4, nb = q & 15; t = CoopTile{p.in[I_WGU] + (size_t)e * DM * 4096, 4096, 256 * nb, ws + WS_WGUT + (size_t)e * 4096 * DM, DM, 1, 128 * kb, 1, 0}; return true; } r -= N_GU;
    if (r < N_DN) { const int e = r >> 7, q = r & 127, kb = q >> 3, nb = q & 7; t = CoopTile{p.in[I_WDN] + (size_t)e * DM * DM, DM, 256 * nb, ws + WS_WDT + (size_t)e * DM * DM, DM, 1, 128 * kb, 0, 256 * nb}; return true; } r -= N_DN;
    if (r < N_INA) { const int kb = r / 6, nb = r % 6; t = CoopTile{p.in[I_WIN], INC, 512 * nb, ws + WS_WINT, DM * 2, 0, 64 * kb, 0, 512 * nb}; return true; } r -= N_INA;
    if (r < N_INB) { const int kb = r >> 2, nb = r & 3; t = CoopTile{p.in[I_WIN], INC, 3088 + 512 * nb, ws + WS_WINT, DM * 2, 0, 64 * kb, 0, 3072 + 512 * nb}; return true; } r -= N_INB;
    if (r < N_OUT) { const int kb = r >> 2, nb = r & 3; t = CoopTile{p.in[I_WOUT], DM, 512 * nb, ws + WS_WOUTT, DM * 2, 0, 64 * kb, 0, 512 * nb}; return true; }
    return false;
}
__device__ __forceinline__ void p0a(Frame& F, const Params& p) {
    const int w = F.wave, l = F.lane;
    CoopTile cur, nxt; f32x4 v[16];
    int it = blockIdx.x; bool have = coop_tile(p, F.ws, it, cur);
    if (have) coop_load(cur, w, l, v);
    int par = 0;
    while (have) {
        LAS unsigned char* buf = F.lds + par * 65536;
        coop_to_lds(cur, w, l, v, buf);
        it += F.G; const bool hn = coop_tile(p, F.ws, it, nxt);
        if (hn) coop_load(nxt, w, l, v);
        __syncthreads();
        coop_store(cur, w, l, buf);
        cur = nxt; have = hn; par ^= 1;
    }
    __syncthreads();
    { bf16_t* WaT = (bf16_t*)(F.ws + WS_WAT); bf16_t* WiT = (bf16_t*)(F.ws + WS_WIT);
      for (int r = F.gw; r < 128; r += F.NGW) { const int which = r >> 6, h = (r >> 4) & 3, kb = (r >> 2) & 3, nb = r & 3;
          p0_item((which ? p.in[I_WI] : p.in[I_WA]) + (size_t)h * 65536, 256, 64 * nb, (which ? WiT : WaT) + (size_t)h * 65536, 256, (size_t)64 * nb, 64 * kb, nullptr, F.lane); } }
    { float* WrT = (float*)(F.ws + WS_WRT); const float* wr = p.in[I_WR]; const float* gf = p.in[I_NFG];
      for (int idx = (int)blockIdx.x * 512 + F.tid; idx < 32 * DM; idx += F.G * 512) { const int n = idx >> 11, k = idx & 2047; WrT[idx] = wr[k * 32 + n] * gf[k]; } }
}
__device__ __forceinline__ void p0b(Frame& F, const Params& p) {
    const float* w_in = p.in[I_WIN];
    __syncthreads();
    { LAS f32x4* Wl = (LAS f32x4*)F.lds;
      for (int idx = F.tid; idx < 8192; idx += 512) { const int l = idx & 63, i = (idx >> 6) & 3, j = (idx >> 8) & 7, c4 = idx >> 11; const int k = 4 * l + 256 * j + i;
          Wl[idx] = *(const f32x4*)(w_in + (size_t)k * INC + 3072 + 4 * c4); }
      __syncthreads();
      const float* x = p.in[I_X]; const float* g1 = p.in[I_NMG]; const float* wg = p.in[I_GWG]; const float* bgp = p.in[I_GBG];
      bf16_t* H = (bf16_t*)(F.ws + WS_H); float* LG = (float*)(F.ws + WS_LG);
      const int l = F.lane;
      f32x4 xn[2][8];
#pragma unroll
      for (int r = 0; r < 2; ++r)
#pragma unroll
          for (int j = 0; j < 8; ++j) xn[r][j] = (2 * F.gw < T) ? *(const f32x4*)(x + (size_t)(2 * F.gw + r) * DM + 4 * l + 256 * j) : (f32x4){0.f, 0.f, 0.f, 0.f};
      for (int q = F.gw; 2 * q < T; q += F.NGW) {
          const int m = 2 * q;
          f32x4 xv[2][8]; float ss[2] = {0.f, 0.f};
#pragma unroll
          for (int r = 0; r < 2; ++r)
#pragma unroll
              for (int j = 0; j < 8; ++j) { xv[r][j] = xn[r][j]; ss[r] += (xv[r][j][0] * xv[r][j][0] + xv[r][j][1] * xv[r][j][1]) + (xv[r][j][2] * xv[r][j][2] + xv[r][j][3] * xv[r][j][3]); }
          if (2 * (q + F.NGW) < T) {
#pragma unroll
              for (int r = 0; r < 2; ++r)
#pragma unroll
                  for (int j = 0; j < 8; ++j) xn[r][j] = *(const f32x4*)(x + (size_t)(2 * (q + F.NGW) + r) * DM + 4 * l + 256 * j); }
          float rs[2];
#pragma unroll
          for (int r = 0; r < 2; ++r) rs[r] = 1.0f / sqrtf(wave_sum(ss[r]) * (1.0f / DM) + 1e-6f);
          float acc[2][16];
#pragma unroll
          for (int r = 0; r < 2; ++r)
#pragma unroll
              for (int c = 0; c < 16; ++c) acc[r][c] = 0.f;
#pragma unroll
          for (int j = 0; j < 8; ++j) { __builtin_amdgcn_sched_barrier(0); const f32x4 gv = *(const f32x4*)(g1 + 4 * l + 256 * j);
#pragma unroll
              for (int r = 0; r < 2; ++r) { xv[r][j] = xv[r][j] * rs[r] * gv;
                  u32x2 o; o.x = pk2(xv[r][j][0], xv[r][j][1]); o.y = pk2(xv[r][j][2], xv[r][j][3]); *(u32x2*)(H + (size_t)(m + r) * DM + 4 * l + 256 * j) = o; }
#pragma unroll
              for (int i = 0; i < 4; ++i)
#pragma unroll
                  for (int c4 = 0; c4 < 4; ++c4) { const f32x4 wv = Wl[((c4 * 8 + j) * 4 + i) * 64 + l];
#pragma unroll
                      for (int r = 0; r < 2; ++r) { acc[r][4 * c4 + 0] += xv[r][j][i] * wv[0]; acc[r][4 * c4 + 1] += xv[r][j][i] * wv[1]; acc[r][4 * c4 + 2] += xv[r][j][i] * wv[2]; acc[r][4 * c4 + 3] += xv[r][j][i] * wv[3]; } } }
#pragma unroll
          for (int r = 0; r < 2; ++r)
#pragma unroll
              for (int c = 0; c < 16; ++c) acc[r][c] = wave_sum(acc[r][c]);
          f32x4 s0[2], s1[2];
#pragma unroll
          for (int r = 0; r < 2; ++r) { s0[r] = *(const f32x4*)(bgp + 8 * l); s1[r] = *(const f32x4*)(bgp + 8 * l + 4); }
#pragma unroll
          for (int jj = 0; jj < 16; ++jj) { const f32x4 w0 = *(const f32x4*)(wg + jj * 512 + 8 * l), w1 = *(const f32x4*)(wg + jj * 512 + 8 * l + 4);
#pragma unroll
              for (int r = 0; r < 2; ++r) { s0[r] += acc[r][jj] * w0; s1[r] += acc[r][jj] * w1; } }
#pragma unroll
          for (int r = 0; r < 2; ++r) { f32x4 o0, o1;
#pragma unroll
              for (int qq = 0; qq < 4; ++qq) { o0[qq] = log_sigmoid_f(s0[r][qq]) * 0.0625f; o1[qq] = log_sigmoid_f(s1[r][qq]) * 0.0625f; }
              *(f32x4*)(LG + (size_t)(m + r) * 512 + 8 * l) = o0; *(f32x4*)(LG + (size_t)(m + r) * 512 + 8 * l + 4) = o1; }
      }
    }
    __syncthreads();
}

__device__ __forceinline__ void gla_cumsum(const float* LG, int tok0, int h, LAS float* BC, LAS float* SEG, int tid) {
    const int seg = tid >> 7, kk = tid & 127;
    float v[16];
#pragma unroll
    for (int i = 0; i < 16; ++i) v[i] = LG[(size_t)(tok0 + 16 * seg + i) * 512 + h * 128 + kk];
#pragma unroll
    for (int i = 1; i < 16; ++i) v[i] += v[i - 1];
    SEG[seg * 128 + kk] = v[15];
    __syncthreads();
    float off = 0.f;
#pragma unroll
    for (int s = 0; s < 3; ++s) off += (s < seg) ? SEG[s * 128 + kk] : 0.f;
#pragma unroll
    for (int i = 0; i < 16; ++i) BC[(16 * seg + i) * 128 + kk] = v[i] + off;
    __syncthreads();
}
__device__ __forceinline__ bf16x8 as_bf16x8(u32x4 v) { return __builtin_bit_cast(bf16x8, v); }
__device__ __forceinline__ bf16x8 cat4(bf16x4 lo, bf16x4 hi) { return __builtin_shufflevector(lo, hi, 0, 1, 2, 3, 4, 5, 6, 7); }

__device__ __forceinline__ void p2a(Frame& F, const Params& p) {
    const bf16_t* Z = (const bf16_t*)(F.ws + WS_Z); const float* LG = (const float*)(F.ws + WS_LG);
    bf16_t* AN = (bf16_t*)(F.ws + WS_AN); float* DN = (float*)(F.ws + WS_DN);
    const bf16_t* WaT = (const bf16_t*)(F.ws + WS_WAT); const bf16_t* WiT = (const bf16_t*)(F.ws + WS_WIT);
    LAS float* BC = (LAS float*)(F.lds); LAS float* SEG = (LAS float*)(F.lds + 32768);
    LAS bf16_t* KDT = (LAS bf16_t*)(F.lds + 34816); LAS bf16_t* VT = (LAS bf16_t*)(F.lds + 53248); LAS bf16_t* XC = (LAS bf16_t*)(F.lds + 90112);
    const int w = F.wave;
    for (int unit = blockIdx.x; unit < NCHUNK; unit += F.G) {
        const int b = unit >> 7, n = unit & 127, tok0 = b * SEQL + 64 * n;
        for (int h = 0; h < 4; ++h) {
            int lane = fresh_lane(), tid = F.wave * 64 + lane;
            int r = lane & 31, hh = lane >> 5;
            u32x4 kvr[2], vvr[4];
#pragma unroll
            for (int it = 0; it < 2; ++it) { const int item = tid + 512 * it, t = item & 63, kk8 = item >> 6; kvr[it] = *(const u32x4*)(Z + (size_t)(tok0 + t) * ZC + ZK + h * 128 + kk8 * 8); }
#pragma unroll
            for (int it = 0; it < 4; ++it) { const int item = tid + 512 * it, t = item & 63, vc8 = item >> 6; vvr[it] = *(const u32x4*)(Z + (size_t)(tok0 + t) * ZC + ZV + h * 256 + vc8 * 8); }
            gla_cumsum(LG, tok0, h, BC, SEG, tid);
            const int uh = (b * 4 + h) * 128 + n;
            if (tid < 128) DN[(size_t)uh * 128 + tid] = __expf(BC[63 * 128 + tid]);
#pragma unroll
            for (int it = 0; it < 2; ++it) { const int item = tid + 512 * it, t = item & 63, kk8 = item >> 6;
                const u32x4 kv = kvr[it];
#pragma unroll
                for (int i = 0; i < 8; ++i) { const int kk = kk8 * 8 + i; const unsigned wv = kv[i >> 1]; const float kf = (i & 1) ? bfhi(wv) : bflo(wv);
                    const float d = __expf(BC[63 * 128 + kk] - BC[t * 128 + kk]); KDT[kk * 72 + t] = (bf16_t)f2bf(kf * d); } }
#pragma unroll
            for (int it = 0; it < 4; ++it) { const int item = tid + 512 * it, t = item & 63, vc8 = item >> 6;
                const u32x4 vv = vvr[it];
#pragma unroll
                for (int i = 0; i < 8; ++i) { const unsigned wv = vv[i >> 1]; VT[(vc8 * 8 + i) * 72 + t] = (bf16_t)((i & 1) ? (wv >> 16) : (wv & 0xffffu)); } }
#ifndef P2A_NO_LRU
            u32x4 lv[7]; f32x4 cwv[4][2], cbv[2];
            { const float* cw = p.in[I_CW]; const float* cb = p.in[I_CB]; const int c8 = tid & 31, tq = tid >> 5, chc = h * 256 + c8 * 8;
#pragma unroll
              for (int i = 0; i < 7; ++i) { const int sq = 64 * n + 4 * tq - 3 + i;
                  lv[i] = (sq >= 0) ? *(const u32x4*)(Z + (size_t)(tok0 + 4 * tq - 3 + i) * ZC + ZLX + chc) : (u32x4){0u, 0u, 0u, 0u}; }
#pragma unroll
              for (int i = 0; i < 4; ++i) { cwv[i][0] = *(const f32x4*)(cw + i * 1024 + chc); cwv[i][1] = *(const f32x4*)(cw + i * 1024 + chc + 4); }
              cbv[0] = *(const f32x4*)(cb + chc); cbv[1] = *(const f32x4*)(cb + chc + 4); }
#endif
            __syncthreads();
            {
                f32x16 acc[4];
#pragma unroll
                for (int mb = 0; mb < 4; ++mb)
#pragma unroll
                    for (int q = 0; q < 16; ++q) acc[mb][q] = 0.f;
#pragma unroll
                for (int s = 0; s < 4; ++s) { const bf16x8 bfr = *(const LAS bf16x8*)(VT + (32 * w + r) * 72 + 16 * s + 8 * hh);
#pragma unroll
                    for (int mb = 0; mb < 4; ++mb) { const bf16x8 afr = *(const LAS bf16x8*)(KDT + (32 * mb + r) * 72 + 16 * s + 8 * hh);
                        acc[mb] = __builtin_amdgcn_mfma_f32_32x32x16_bf16(afr, bfr, acc[mb], 0, 0, 0); } }
                bf16_t* base = AN + (size_t)uh * 32768;
#pragma unroll
                for (int mb = 0; mb < 4; ++mb)
#pragma unroll
                    for (int s2 = 0; s2 < 2; ++s2) { u32x4 o;
#pragma unroll
                        for (int q = 0; q < 4; ++q) o[q] = pk2(acc[mb][8 * s2 + 2 * q], acc[mb][8 * s2 + 2 * q + 1]);
                        *(u32x4*)(base + (((mb * 8 + w) * 2 + s2) * 64 + lane) * 8) = o; }
            }
#ifndef P2A_NO_LRU
            {
                {
                    const int c8 = tid & 31, tq = tid >> 5;
#pragma unroll
                    for (int it = 0; it < 4; ++it) { float xc[8];
#pragma unroll
                        for (int q = 0; q < 4; ++q) { xc[q] = cbv[0][q]; xc[4 + q] = cbv[1][q]; }
#pragma unroll
                        for (int i = 0; i < 4; ++i) { const u32x4 l4 = lv[it + i];
                            xc[0] += bflo(l4[0]) * cwv[i][0][0]; xc[1] += bfhi(l4[0]) * cwv[i][0][1]; xc[2] += bflo(l4[1]) * cwv[i][0][2]; xc[3] += bfhi(l4[1]) * cwv[i][0][3];
                            xc[4] += bflo(l4[2]) * cwv[i][1][0]; xc[5] += bfhi(l4[2]) * cwv[i][1][1]; xc[6] += bflo(l4[3]) * cwv[i][1][2]; xc[7] += bfhi(l4[3]) * cwv[i][1][3]; }
                        u32x4 o; o.x = pk2(xc[0], xc[1]); o.y = pk2(xc[2], xc[3]); o.z = pk2(xc[4], xc[5]); o.w = pk2(xc[6], xc[7]);
                        *(LAS u32x4*)(XC + (4 * tq + it) * 264 + c8 * 8) = o; }
                }
                __builtin_amdgcn_sched_barrier(0);
                bf16x8 ba[16], bi[16];
                { const bf16_t* wa = WaT + (size_t)h * 65536 + (size_t)(32 * w + r) * 256 + 8 * hh;
                  const bf16_t* wi = WiT + (size_t)h * 65536 + (size_t)(32 * w + r) * 256 + 8 * hh;
#pragma unroll
                  for (int s = 0; s < 16; ++s) { ba[s] = *(const bf16x8*)(wa + 16 * s); bi[s] = *(const bf16x8*)(wi + 16 * s); } }
                __syncthreads();
                f32x16 aa[2], ai[2];
#pragma unroll
                for (int mb = 0; mb < 2; ++mb)
#pragma unroll
                    for (int q = 0; q < 16; ++q) { aa[mb][q] = 0.f; ai[mb][q] = 0.f; }
#pragma unroll
                for (int s = 0; s < 16; ++s) {
#pragma unroll
                    for (int mb = 0; mb < 2; ++mb) { const bf16x8 af = *(const LAS bf16x8*)(XC + (32 * mb + r) * 264 + 16 * s + 8 * hh);
                        aa[mb] = __builtin_amdgcn_mfma_f32_32x32x16_bf16(af, ba[s], aa[mb], 0, 0, 0); } }
                __builtin_amdgcn_sched_barrier(0);
#pragma unroll
                for (int s = 0; s < 16; ++s) {
#pragma unroll
                    for (int mb = 0; mb < 2; ++mb) { const bf16x8 af = *(const LAS bf16x8*)(XC + (32 * mb + r) * 264 + 16 * s + 8 * hh);
                        ai[mb] = __builtin_amdgcn_mfma_f32_32x32x16_bf16(af, bi[s], ai[mb], 0, 0, 0); } }
                const int ch = h * 256 + 32 * w + r;
                const float ba_ = p.in[I_BA][ch], bi_ = p.in[I_BI][ch]; const float L = p.in[I_AP][ch];
                const float sp = fmaxf(-L, 0.f) + log1pf(__expf(-fabsf(L)));
#pragma unroll
                for (int mb = 0; mb < 2; ++mb)
#pragma unroll
                    for (int q = 0; q < 16; ++q) { const int t = 32 * mb + (q & 3) + 8 * (q >> 2) + 4 * hh;
                        if ((q & 3) == 0) __builtin_amdgcn_sched_barrier(0);
                        const float ga = sigmoidf_(aa[mb][q] + ba_), gi = sigmoidf_(ai[mb][q] + bi_);
                        const float la = -8.0f * ga * sp; const float a = __expf(la);
                        const float xcv = bf2f(XC[t * 264 + 32 * w + r]);
                        aa[mb][q] = a; ai[mb][q] = xcv * gi * sqrtf(fmaxf(1.0f - a * a, 0.f)); }
#pragma unroll
                for (int mb = 0; mb < 2; ++mb)
#pragma unroll
                    for (int g = 0; g < 4; ++g)
#pragma unroll
                        for (int i = 1; i < 4; ++i) { const int q = 4 * g + i; ai[mb][q] = aa[mb][q] * ai[mb][q - 1] + ai[mb][q]; aa[mb][q] = aa[mb][q] * aa[mb][q - 1]; }
                LAS bf16_t* HL = (LAS bf16_t*)(F.lds); LAS bf16_t* AC = (LAS bf16_t*)(F.lds + 34816);
                float carryH = 0.f, carryP = 1.f;
#pragma unroll
                for (int mb = 0; mb < 2; ++mb)
#pragma unroll
                    for (int g = 0; g < 4; ++g) { const float myP = aa[mb][4 * g + 3], myH = ai[mb][4 * g + 3];
                        const float pP = __shfl_xor(myP, 32), pH = __shfl_xor(myH, 32);
                        const float fP = hh ? pP : myP, fH = hh ? pH : myH, sP = hh ? myP : pP, sH = hh ? myH : pH;
                        const float c1H = fP * carryH + fH, c1P = carryP * fP;
                        const float Cin = hh ? c1H : carryH, Pin = hh ? c1P : carryP;
                        carryH = sP * c1H + sH; carryP = c1P * sP;
#pragma unroll
                        for (int i = 0; i < 4; ++i) { const int q = 4 * g + i, t = 32 * mb + 8 * g + 4 * hh + i;
                            HL[t * 264 + 32 * w + r] = (bf16_t)f2bf(ai[mb][q] + aa[mb][q] * Cin); AC[t * 264 + 32 * w + r] = (bf16_t)f2bf(aa[mb][q] * Pin); } }
                if (hh == 0) { float* SUMA = (float*)(F.ws + WS_SUMA); float* SUMH = (float*)(F.ws + WS_SUMH); SUMA[unit * 1024 + ch] = carryP; SUMH[unit * 1024 + ch] = carryH; }
                __syncthreads();
                { bf16_t* HLOC = (bf16_t*)(F.ws + WS_AUA); bf16_t* ACUM = (bf16_t*)(F.ws + WS_AUU);
#pragma unroll
                  for (int it = 0; it < 4; ++it) { const int item = tid + 512 * it, c8 = item & 31, t = item >> 5; const size_t o = (size_t)(tok0 + t) * 1024 + h * 256 + c8 * 8;
                      *(u32x4*)(HLOC + o) = *(const LAS u32x4*)(HL + t * 264 + c8 * 8); *(u32x4*)(ACUM + o) = *(const LAS u32x4*)(AC + t * 264 + c8 * 8); } }
            }
#endif
            __syncthreads();
        }
    }
}

__device__ __forceinline__ void p2b(Frame& F, const Params& p) {
    const bf16_t* AN = (const bf16_t*)(F.ws + WS_AN); const float* DN = (const float*)(F.ws + WS_DN); bf16_t* SP = (bf16_t*)(F.ws + WS_SP);
    if (F.tid < 128) {
        for (int st = (int)blockIdx.x * 128 + F.tid; st < 32768; st += F.G * 128) {
            const int bh = st >> 12, rem = st & 4095, ln = rem & 63, s2 = (rem >> 6) & 1, w = (rem >> 7) & 7, mb = (rem >> 10) & 3;
            const int kk0 = 32 * mb + 16 * s2 + 4 * (ln >> 5);
            const int offS = (((mb * 8 + w) * 2 + s2) * 64 + ln) * 8;
            f32x4 S0 = (f32x4){0.f, 0.f, 0.f, 0.f}, S1 = S0;
            for (int n0 = 0; n0 < 128; n0 += 8) {
                u32x4 av[8]; f32x4 d0[8], d1[8];
#pragma unroll
                for (int i = 0; i < 8; ++i) { const size_t uh = (size_t)bh * 128 + n0 + i;
                    av[i] = *(const u32x4*)(AN + uh * 32768 + offS);
                    d0[i] = *(const f32x4*)(DN + uh * 128 + kk0); d1[i] = *(const f32x4*)(DN + uh * 128 + kk0 + 8); }
#pragma unroll
                for (int i = 0; i < 8; ++i) { const size_t uh = (size_t)bh * 128 + n0 + i;
                    u32x4 o; o.x = pk2(S0[0], S0[1]); o.y = pk2(S0[2], S0[3]); o.z = pk2(S1[0], S1[1]); o.w = pk2(S1[2], S1[3]);
                    *(u32x4*)(SP + uh * 32768 + offS) = o;
                    const f32x4 a0 = (f32x4){bflo(av[i].x), bfhi(av[i].x), bflo(av[i].y), bfhi(av[i].y)}, a1 = (f32x4){bflo(av[i].z), bfhi(av[i].z), bflo(av[i].w), bfhi(av[i].w)};
                    S0 = d0[i] * S0 + a0; S1 = d1[i] * S1 + a1; } }
        }
    }
}

__device__ __forceinline__ void p2c(Frame& F, const Params& p) {
    const bf16_t* Z = (const bf16_t*)(F.ws + WS_Z); const float* LG = (const float*)(F.ws + WS_LG); const bf16_t* SP = (const bf16_t*)(F.ws + WS_SP);
    bf16_t* MIX = (bf16_t*)(F.ws + WS_MIX);
    LAS float* BC = (LAS float*)(F.lds); LAS float* SEG = (LAS float*)(F.lds + 32768);
    LAS bf16_t* QE = (LAS bf16_t*)(F.lds + 34816); LAS bf16_t* KE = (LAS bf16_t*)(F.lds + 52224); LAS bf16_t* VT = (LAS bf16_t*)(F.lds + 69632);
    LAS float* SSQ = (LAS float*)(F.lds + 106496); LAS float* OS = (LAS float*)(F.lds);
    const int tid = F.tid, lane = F.lane, w = F.wave, r = lane & 31, hh = lane >> 5;
    const float* gng = p.in[I_GNG];
    for (int unit = blockIdx.x; unit < NCHUNK; unit += F.G) {
        const int b = unit >> 7, n = unit & 127, tok0 = b * SEQL + 64 * n;
        { const float* SUMA = (const float*)(F.ws + WS_SUMA); const float* SUMH = (const float*)(F.ws + WS_SUMH);
          const int ch = 2 * tid; f32x2 hc = (f32x2){0.f, 0.f};
          int c2 = unit & ~127;
          for (; c2 + 16 <= unit; c2 += 16) { f32x2 a[16], hv[16];
#pragma unroll
              for (int q = 0; q < 16; ++q) { a[q] = *(const f32x2*)(SUMA + (c2 + q) * 1024 + ch); hv[q] = *(const f32x2*)(SUMH + (c2 + q) * 1024 + ch); }
#pragma unroll
              for (int q = 0; q < 16; ++q) hc = a[q] * hc + hv[q]; }
          { f32x2 a[16], hv[16];
#pragma unroll
              for (int q = 0; q < 16; ++q) { const bool ok = (c2 + q) < unit; a[q] = ok ? *(const f32x2*)(SUMA + (c2 + q) * 1024 + ch) : (f32x2){1.f, 1.f}; hv[q] = ok ? *(const f32x2*)(SUMH + (c2 + q) * 1024 + ch) : (f32x2){0.f, 0.f}; }
#pragma unroll
              for (int q = 0; q < 16; ++q) hc = a[q] * hc + hv[q]; }
          const bf16_t* HLOC = (const bf16_t*)(F.ws + WS_AUA); const bf16_t* ACUM = (const bf16_t*)(F.ws + WS_AUU);
          for (int t0 = 0; t0 < 64; t0 += 16) {
              unsigned hv[16], av[16], lgw[16];
#pragma unroll
              for (int i = 0; i < 16; ++i) { const size_t tok = (size_t)tok0 + t0 + i;
                  hv[i] = *(const unsigned*)(HLOC + tok * 1024 + ch); av[i] = *(const unsigned*)(ACUM + tok * 1024 + ch); lgw[i] = *(const unsigned*)(Z + tok * ZC + ZLG + ch); }
#pragma unroll
              for (int i = 0; i < 16; ++i) { const size_t tok = (size_t)tok0 + t0 + i;
                  const float h0 = bflo(hv[i]) + bflo(av[i]) * hc.x, h1 = bfhi(hv[i]) + bfhi(av[i]) * hc.y;
                  *(unsigned*)(MIX + tok * DM + 1024 + ch) = pk2(h0 * gelu_tanh_f(bflo(lgw[i])), h1 * gelu_tanh_f(bfhi(lgw[i]))); } } }
        for (int h = 0; h < 4; ++h) {
            const int uh = (b * 4 + h) * 128 + n;
            bf16x8 sf[4][2];
            { const bf16_t* spu = SP + (size_t)uh * 32768;
#pragma unroll
              for (int mb = 0; mb < 4; ++mb)
#pragma unroll
                  for (int s2 = 0; s2 < 2; ++s2) sf[mb][s2] = *(const bf16x8*)(spu + (((mb * 8 + w) * 2 + s2) * 64 + lane) * 8); }
            gla_cumsum(LG, tok0, h, BC, SEG, tid);
#pragma unroll
            for (int it = 0; it < 2; ++it) { const int item = tid + 512 * it, kk8 = item & 15, t = item >> 4;
                const u32x4 qv = *(const u32x4*)(Z + (size_t)(tok0 + t) * ZC + ZQ + h * 128 + kk8 * 8);
                const u32x4 kv = *(const u32x4*)(Z + (size_t)(tok0 + t) * ZC + ZK + h * 128 + kk8 * 8);
                const f32x4 b0 = *(const LAS f32x4*)(BC + t * 128 + kk8 * 8), b1 = *(const LAS f32x4*)(BC + t * 128 + kk8 * 8 + 4);
                float qe[8], ke[8];
#pragma unroll
                for (int i = 0; i < 8; ++i) { const float bb = (i < 4) ? b0[i & 3] : b1[i & 3]; const unsigned qw = qv[i >> 1], kw = kv[i >> 1];
                    const float qf = (i & 1) ? bfhi(qw) : bflo(qw), kf = (i & 1) ? bfhi(kw) : bflo(kw);
                    qe[i] = qf * 0.08838834764831845f * __expf(bb); ke[i] = kf * __expf(-bb); }
                u32x4 oq, ok; oq.x = pk2(qe[0], qe[1]); oq.y = pk2(qe[2], qe[3]); oq.z = pk2(qe[4], qe[5]); oq.w = pk2(qe[6], qe[7]);
                ok.x = pk2(ke[0], ke[1]); ok.y = pk2(ke[2], ke[3]); ok.z = pk2(ke[4], ke[5]); ok.w = pk2(ke[6], ke[7]);
                *(LAS u32x4*)(QE + t * 136 + kk8 * 8) = oq; *(LAS u32x4*)(KE + t * 136 + kk8 * 8) = ok; }
#pragma unroll
            for (int it = 0; it < 4; ++it) { const int item = tid + 512 * it, t = item & 63, vc8 = item >> 6;
                const u32x4 vv = *(const u32x4*)(Z + (size_t)(tok0 + t) * ZC + ZV + h * 256 + vc8 * 8);
#pragma unroll
                for (int i = 0; i < 8; ++i) { const unsigned wv = vv[i >> 1]; VT[(vc8 * 8 + i) * 72 + t] = (bf16_t)((i & 1) ? (wv >> 16) : (wv & 0xffffu)); } }
            __syncthreads();
            f32x16 oacc[2];
            {
                f32x16 P00, P01, P11;
#pragma unroll
                for (int q = 0; q < 16; ++q) { P00[q] = 0.f; P01[q] = 0.f; P11[q] = 0.f; oacc[0][q] = 0.f; oacc[1][q] = 0.f; }
#pragma unroll
                for (int s = 0; s < 8; ++s) {
                    const bf16x8 a0 = *(const LAS bf16x8*)(KE + r * 136 + 16 * s + 8 * hh), a1 = *(const LAS bf16x8*)(KE + (32 + r) * 136 + 16 * s + 8 * hh);
                    const bf16x8 b0 = *(const LAS bf16x8*)(QE + r * 136 + 16 * s + 8 * hh), b1 = *(const LAS bf16x8*)(QE + (32 + r) * 136 + 16 * s + 8 * hh);
                    P00 = __builtin_amdgcn_mfma_f32_32x32x16_bf16(a0, b0, P00, 0, 0, 0);
                    P01 = __builtin_amdgcn_mfma_f32_32x32x16_bf16(a0, b1, P01, 0, 0, 0);
                    P11 = __builtin_amdgcn_mfma_f32_32x32x16_bf16(a1, b1, P11, 0, 0, 0); }
#pragma unroll
                for (int q = 0; q < 16; ++q) { const int jl = (q & 3) + 8 * (q >> 2) + 4 * hh; if (jl > r) { P00[q] = 0.f; P11[q] = 0.f; } }
                bf16x8 F00[2], F01[2], F11[2];
#pragma unroll
                for (int s2 = 0; s2 < 2; ++s2) {
                    u32x4 t0, t1, t2;
#pragma unroll
                    for (int q = 0; q < 4; ++q) { t0[q] = pk2(P00[8 * s2 + 2 * q], P00[8 * s2 + 2 * q + 1]); t1[q] = pk2(P01[8 * s2 + 2 * q], P01[8 * s2 + 2 * q + 1]); t2[q] = pk2(P11[8 * s2 + 2 * q], P11[8 * s2 + 2 * q + 1]); }
                    F00[s2] = as_bf16x8(t0); F01[s2] = as_bf16x8(t1); F11[s2] = as_bf16x8(t2); }
#pragma unroll
                for (int mb = 0; mb < 4; ++mb)
#pragma unroll
                    for (int s2 = 0; s2 < 2; ++s2) { const bf16x8 af = sf[mb][s2];
                        const int kkb = 32 * mb + 16 * s2 + 4 * hh;
#pragma unroll
                        for (int ib = 0; ib < 2; ++ib) { const bf16x4 lo = *(const LAS bf16x4*)(QE + (32 * ib + r) * 136 + kkb), hi = *(const LAS bf16x4*)(QE + (32 * ib + r) * 136 + kkb + 8);
                            oacc[ib] = __builtin_amdgcn_mfma_f32_32x32x16_bf16(af, cat4(lo, hi), oacc[ib], 0, 0, 0); } }
#pragma unroll
                for (int s2 = 0; s2 < 2; ++s2) {
                    const int tb0 = 16 * s2 + 4 * hh, tb1 = 32 + 16 * s2 + 4 * hh;
                    const bf16x8 v0 = cat4(*(const LAS bf16x4*)(VT + (32 * w + r) * 72 + tb0), *(const LAS bf16x4*)(VT + (32 * w + r) * 72 + tb0 + 8));
                    const bf16x8 v1 = cat4(*(const LAS bf16x4*)(VT + (32 * w + r) * 72 + tb1), *(const LAS bf16x4*)(VT + (32 * w + r) * 72 + tb1 + 8));
                    oacc[0] = __builtin_amdgcn_mfma_f32_32x32x16_bf16(v0, F00[s2], oacc[0], 0, 0, 0);
                    oacc[1] = __builtin_amdgcn_mfma_f32_32x32x16_bf16(v0, F01[s2], oacc[1], 0, 0, 0);
                    oacc[1] = __builtin_amdgcn_mfma_f32_32x32x16_bf16(v1, F11[s2], oacc[1], 0, 0, 0); }
            }
#pragma unroll
            for (int ib = 0; ib < 2; ++ib) { float sq = 0.f;
#pragma unroll
                for (int q = 0; q < 16; ++q) sq += oacc[ib][q] * oacc[ib][q];
                sq += __shfl_xor(sq, 32);
                if (hh == 0) SSQ[w * 64 + 32 * ib + r] = sq; }
            __syncthreads();
#pragma unroll
            for (int ib = 0; ib < 2; ++ib) { float tot = 0.f;
#pragma unroll
                for (int w2 = 0; w2 < 8; ++w2) tot += SSQ[w2 * 64 + 32 * ib + r];
                const float rs = 1.0f / sqrtf(tot * (1.0f / 256.0f) + 1e-6f);
#pragma unroll
                for (int g = 0; g < 4; ++g) *(LAS f32x4*)(OS + (32 * ib + r) * 260 + 32 * w + 8 * g + 4 * hh) =
                    (f32x4){oacc[ib][4 * g] * rs, oacc[ib][4 * g + 1] * rs, oacc[ib][4 * g + 2] * rs, oacc[ib][4 * g + 3] * rs}; }
            __syncthreads();
#pragma unroll
            for (int it = 0; it < 4; ++it) { const int item = tid + 512 * it, vc8 = item & 31, t = item >> 5; const int c = h * 256 + vc8 * 8;
                const f32x4 o0 = *(const LAS f32x4*)(OS + t * 260 + vc8 * 8), o1 = *(const LAS f32x4*)(OS + t * 260 + vc8 * 8 + 4);
                const u32x4 rv = *(const u32x4*)(Z + (size_t)(tok0 + t) * ZC + ZR + c);
                const f32x4 g0 = *(const f32x4*)(gng + c), g1 = *(const f32x4*)(gng + c + 4);
                float o[8];
#pragma unroll
                for (int i = 0; i < 8; ++i) { const unsigned rw = rv[i >> 1]; const float rf = (i & 1) ? bfhi(rw) : bflo(rw);
                    const float sil = rf * sigmoidf_(rf); o[i] = sil * ((i < 4) ? o0[i & 3] * g0[i & 3] : o1[i & 3] * g1[i & 3]); }
                u32x4 ov; ov.x = pk2(o[0], o[1]); ov.y = pk2(o[2], o[3]); ov.z = pk2(o[4], o[5]); ov.w = pk2(o[6], o[7]);
                *(u32x4*)(MIX + (size_t)(tok0 + t) * DM + c) = ov; }
            __syncthreads();
        }
    }
}

__device__ __forceinline__ void build_moe_tables(Frame& F) {
    unsigned* cnt = (unsigned*)(F.ws + WS_CTL) + CW_CNT;
    if (F.tid < 32) F.MISC[MI_LCNT + F.tid] = xb_ld(cnt + 64 * F.tid);
    __syncthreads();
    if (F.tid == 0) { int tiles = 0;
        for (int e = 0; e < NEXP; ++e) { const int c = (int)F.MISC[MI_LCNT + e]; const int mt = (c + 255) >> 8; F.MISC[MI_PBASE + e] = (unsigned)(tiles * 256);
            for (int q = 0; q < mt; ++q) F.MISC[MI_T2E + tiles + q] = (unsigned)e; tiles += mt; }
        F.MISC[MI_NMT] = (unsigned)tiles; }
    __syncthreads();
    if (F.tid < 32) F.MISC[MI_LCNT + F.tid] = 0u;
    __syncthreads();
}

__device__ __forceinline__ void p4a(Frame& F, const Params& p) {
    const bf16_t* XMID = (const bf16_t*)(F.ws + WS_XMID); const float* WrT = (const float*)(F.ws + WS_WRT); const float* br = p.in[I_BR];
    float* RSTD = (float*)(F.ws + WS_RSTD); unsigned* TOKE = (unsigned*)(F.ws + WS_TOKE); float* GATES = (float*)(F.ws + WS_GATES);
    unsigned* cnt = (unsigned*)(F.ws + WS_CTL) + CW_CNT;
    LAS float* RED = (LAS float*)(F.lds); LAS float* SSQ2 = (LAS float*)(F.lds + 32768); LAS float* LGT = (LAS float*)(F.lds + 33792); LAS float* RS = (LAS float*)(F.lds + 38016);
    const int tid = F.tid, lane = F.lane, w = F.wave, m = lane & 31, kh = lane >> 5;
    if (tid < 32) F.MISC[MI_LCNT + tid] = 0u;
    __syncthreads();
    for (int ut = blockIdx.x; ut < T / 32; ut += F.G) {
        const int m0 = 32 * ut; const int kw = 256 * w + 128 * kh;
        f32x16 acc;
#pragma unroll
        for (int q = 0; q < 16; ++q) acc[q] = 0.f;
        float ss = 0.f;
        const bf16_t* ap = XMID + (size_t)(m0 + m) * DM + kw; const float* bp = WrT + (size_t)m * DM + kw;
#pragma unroll 2
        for (int c = 0; c < 8; ++c) {
            f32x4 a[4], b[4];
            { const u32x4 r0 = *(const u32x4*)(ap + 16 * c), r1 = *(const u32x4*)(ap + 16 * c + 8);
              a[0] = (f32x4){bflo(r0.x), bfhi(r0.x), bflo(r0.y), bfhi(r0.y)}; a[1] = (f32x4){bflo(r0.z), bfhi(r0.z), bflo(r0.w), bfhi(r0.w)};
              a[2] = (f32x4){bflo(r1.x), bfhi(r1.x), bflo(r1.y), bfhi(r1.y)}; a[3] = (f32x4){bflo(r1.z), bfhi(r1.z), bflo(r1.w), bfhi(r1.w)}; }
#pragma unroll
            for (int q = 0; q < 4; ++q) b[q] = *(const f32x4*)(bp + 16 * c + 4 * q);
#pragma unroll
            for (int q = 0; q < 4; ++q)
#pragma unroll
                for (int i = 0; i < 4; ++i) { acc = __builtin_amdgcn_mfma_f32_32x32x2f32(a[q][i], b[q][i], acc, 0, 0, 0); ss += a[q][i] * a[q][i]; }
        }
        ss += __shfl_xor(ss, 32);
#pragma unroll
        for (int q = 0; q < 16; ++q) RED[(w * 16 + q) * 64 + lane] = acc[q];
        if (kh == 0) SSQ2[w * 32 + m] = ss;
        __syncthreads();
#pragma unroll
        for (int it = 0; it < 2; ++it) { const int o = tid + 512 * it, reg = o >> 6, ln = o & 63, nn = ln & 31, h2 = ln >> 5; const int mm = (reg & 3) + 8 * (reg >> 2) + 4 * h2;
            float v = 0.f, s2 = 0.f;
#pragma unroll
            for (int w2 = 0; w2 < 8; ++w2) { v += RED[(w2 * 16 + reg) * 64 + ln]; s2 += SSQ2[w2 * 32 + mm]; }
            const float rs = 1.0f / sqrtf(s2 * (1.0f / DM) + 1e-6f);
            LGT[mm * 33 + nn] = v * rs + br[nn]; if (nn == 0) RS[mm] = rs; }
        __syncthreads();
        int ex[4]; unsigned ls[4]; float gt[4];
        if (tid < 32) {
            float l[32];
#pragma unroll
            for (int i = 0; i < 32; ++i) l[i] = LGT[tid * 33 + i];
            float val[4];
#pragma unroll
            for (int k = 0; k < 4; ++k) { float best = -3.0e38f; int bi = 0;
#pragma unroll
                for (int i = 0; i < 32; ++i) if (l[i] > best) { best = l[i]; bi = i; }
                ex[k] = bi; val[k] = best;
#pragma unroll
                for (int i = 0; i < 32; ++i) if (i == bi) l[i] = -3.0e38f; }
            float s = 0.f;
#pragma unroll
            for (int k = 0; k < 4; ++k) { gt[k] = __expf(val[k] - val[0]); s += gt[k]; }
            const float inv = 1.0f / s;
#pragma unroll
            for (int k = 0; k < 4; ++k) { gt[k] *= inv; ls[k] = __hip_atomic_fetch_add((LAS unsigned*)(F.MISC + MI_LCNT + ex[k]), 1u, __ATOMIC_RELAXED, __HIP_MEMORY_SCOPE_WORKGROUP); }
        }
        __syncthreads();
        if (tid < 32) { const unsigned c = F.MISC[MI_LCNT + tid]; F.MISC[MI_LBASE + tid] = c ? xb_add(cnt + 64 * tid, c) : 0u; F.MISC[MI_LCNT + tid] = 0u; }
        __syncthreads();
        if (tid < 32) { const int tok = m0 + tid;
#pragma unroll
            for (int k = 0; k < 4; ++k) { const unsigned slot = F.MISC[MI_LBASE + ex[k]] + ls[k]; TOKE[tok * 4 + k] = (unsigned)ex[k] | (slot << 8); GATES[tok * 4 + k] = gt[k]; }
            RSTD[tok] = RS[tid]; }
        __syncthreads();
    }
}

__device__ __forceinline__ void p4b(Frame& F, const Params& p) {
    build_moe_tables(F);
    const bf16_t* XMID = (const bf16_t*)(F.ws + WS_XMID); const float* RSTD = (const float*)(F.ws + WS_RSTD); const unsigned* TOKE = (const unsigned*)(F.ws + WS_TOKE);
    const float* gf = p.in[I_NFG]; unsigned char* ABUF = F.ws + WS_ABUF;
    const int l = F.lane;
    u32x4 xn[4]; float rsn = 0.f; unsigned ten[4] = {0u, 0u, 0u, 0u};
    if (F.gw < T) { rsn = RSTD[F.gw];
#pragma unroll
        for (int k = 0; k < 4; ++k) ten[k] = TOKE[F.gw * 4 + k];
#pragma unroll
        for (int j = 0; j < 4; ++j) xn[j] = *(const u32x4*)(XMID + (size_t)F.gw * DM + 8 * l + 512 * j); }
    f32x4 gv[8];
#pragma unroll
    for (int j = 0; j < 4; ++j) { gv[2 * j] = *(const f32x4*)(gf + 8 * l + 512 * j) * 16.0f; gv[2 * j + 1] = *(const f32x4*)(gf + 8 * l + 512 * j + 4) * 16.0f; }
    for (int tok = F.gw; tok < T; tok += F.NGW) {
        const float rs = rsn; unsigned te[4]; u32x2 o[4];
#pragma unroll
        for (int k = 0; k < 4; ++k) te[k] = ten[k];
#pragma unroll
        for (int j = 0; j < 4; ++j) { const u32x4 xr = xn[j]; const f32x4 a = (f32x4){bflo(xr.x), bfhi(xr.x), bflo(xr.y), bfhi(xr.y)} * rs * gv[2 * j], b = (f32x4){bflo(xr.z), bfhi(xr.z), bflo(xr.w), bfhi(xr.w)} * rs * gv[2 * j + 1];
            o[j].x = pk4_fp8(a[0], a[1], a[2], a[3]); o[j].y = pk4_fp8(b[0], b[1], b[2], b[3]); }
        const int t2 = tok + F.NGW;
        if (t2 < T) { rsn = RSTD[t2];
#pragma unroll
            for (int k = 0; k < 4; ++k) ten[k] = TOKE[t2 * 4 + k];
#pragma unroll
            for (int j = 0; j < 4; ++j) xn[j] = *(const u32x4*)(XMID + (size_t)t2 * DM + 8 * l + 512 * j); }
#pragma unroll
        for (int k = 0; k < 4; ++k) { const size_t row = (size_t)F.MISC[MI_PBASE + (te[k] & 255u)] + (te[k] >> 8);
#pragma unroll
            for (int j = 0; j < 4; ++j) *(u32x2*)(ABUF + row * DM + 8 * l + 512 * j) = o[j]; }
    }
}

__device__ __forceinline__ void p7(Frame& F, const Params& p) {
    build_moe_tables(F);
    const bf16_t* XMID = (const bf16_t*)(F.ws + WS_XMID); const unsigned* TOKE = (const unsigned*)(F.ws + WS_TOKE); const float* GATES = (const float*)(F.ws + WS_GATES);
    const unsigned char* Y = F.ws + WS_Y; const float* gfin = p.in[I_NFINAL];
    const int l = F.lane;
    u32x4 xn[4]; u32x2 yn[4][4]; float gkn[4] = {0.f, 0.f, 0.f, 0.f};
#define P7_FETCH(tk) do { \
        _Pragma("unroll") for (int k = 0; k < 4; ++k) { const unsigned te = TOKE[(tk) * 4 + k]; gkn[k] = GATES[(tk) * 4 + k]; const size_t row = (size_t)F.MISC[MI_PBASE + (te & 255u)] + (te >> 8); \
            _Pragma("unroll") for (int j = 0; j < 4; ++j) yn[k][j] = *(const u32x2*)(Y + row * DM + 8 * l + 512 * j); } \
        _Pragma("unroll") for (int j = 0; j < 4; ++j) xn[j] = *(const u32x4*)(XMID + (size_t)(tk) * DM + 8 * l + 512 * j); } while (0)
    if (F.gw < T) P7_FETCH(F.gw);
    f32x4 g0[4], g1[4];
#pragma unroll
    for (int j = 0; j < 4; ++j) { g0[j] = *(const f32x4*)(gfin + 8 * l + 512 * j); g1[j] = *(const f32x4*)(gfin + 8 * l + 512 * j + 4); }
    for (int tok = F.gw; tok < T; tok += F.NGW) {
        f32x4 xv[8];
#pragma unroll
        for (int j = 0; j < 4; ++j) { const u32x4 xr = xn[j]; xv[2 * j] = (f32x4){bflo(xr.x), bfhi(xr.x), bflo(xr.y), bfhi(xr.y)}; xv[2 * j + 1] = (f32x4){bflo(xr.z), bfhi(xr.z), bflo(xr.w), bfhi(xr.w)}; }
#pragma unroll
        for (int k = 0; k < 4; ++k)
#pragma unroll
            for (int j = 0; j < 4; ++j) { const u32x2 y2 = yn[k][j]; const float gk = gkn[k] * (1.0f / 32.0f);
                xv[2 * j][0] += gk * fp8f(y2.x, 0); xv[2 * j][1] += gk * fp8f(y2.x, 1); xv[2 * j][2] += gk * fp8f(y2.x, 2); xv[2 * j][3] += gk * fp8f(y2.x, 3);
                xv[2 * j + 1][0] += gk * fp8f(y2.y, 0); xv[2 * j + 1][1] += gk * fp8f(y2.y, 1); xv[2 * j + 1][2] += gk * fp8f(y2.y, 2); xv[2 * j + 1][3] += gk * fp8f(y2.y, 3); }
        const int t2 = tok + F.NGW;
        if (t2 < T) P7_FETCH(t2);
        float ss = 0.f;
#pragma unroll
        for (int j = 0; j < 8; ++j) ss += (xv[j][0] * xv[j][0] + xv[j][1] * xv[j][1]) + (xv[j][2] * xv[j][2] + xv[j][3] * xv[j][3]);
        const float rs = 1.0f / sqrtf(wave_sum(ss) * (1.0f / DM) + 1e-6f);
#pragma unroll
        for (int j = 0; j < 4; ++j) { *(f32x4*)(p.out + (size_t)tok * DM + 8 * l + 512 * j) = xv[2 * j] * rs * g0[j]; *(f32x4*)(p.out + (size_t)tok * DM + 8 * l + 512 * j + 4) = xv[2 * j + 1] * rs * g1[j]; }
    }
#undef P7_FETCH
}

#ifdef PROBE_STREAM
__device__ __forceinline__ void probe_stream(Frame& F, const Params& p) {
    const f32x4* src = (const f32x4*)p.in[I_WGU]; const size_t n4 = (size_t)32 * 2048 * 4096 / 4;
    const f32x4* src2 = (const f32x4*)p.in[I_WDN]; const size_t m4 = (size_t)32 * 2048 * 2048 / 4;
    f32x4 acc = (f32x4){0.f, 0.f, 0.f, 0.f};
    for (size_t base = (size_t)F.gw * 1024; base < n4; base += (size_t)F.NGW * 1024) {
        f32x4 v[16];
#pragma unroll
        for (int i = 0; i < 16; ++i) v[i] = src[base + i * 64 + F.lane];
#pragma unroll
        for (int i = 0; i < 16; ++i) acc += v[i]; }
    for (size_t base = (size_t)F.gw * 1024; base < m4; base += (size_t)F.NGW * 1024) {
        f32x4 v[16];
#pragma unroll
        for (int i = 0; i < 16; ++i) v[i] = src2[base + i * 64 + F.lane];
#pragma unroll
        for (int i = 0; i < 16; ++i) acc += v[i]; }
    if (acc[0] + acc[1] + acc[2] + acc[3] == 12345.678f) p.out[0] = 1.0f;
}
#endif
constexpr int NPHASE = 11;
__global__ void __launch_bounds__(512, 2) mk_fwd(Params p) {
    extern __shared__ __attribute__((aligned(16))) unsigned char lds_raw[];
    Frame F;
    F.lds = (LAS unsigned char*)lds_raw; F.MISC = (volatile LAS unsigned*)(F.lds + MISC_OFF);
    F.wave = __builtin_amdgcn_readfirstlane((int)threadIdx.x >> 6);
#define FRESH() do { F.lane = fresh_lane(); F.tid = F.wave * 64 + F.lane; } while (0)
    FRESH();
    F.G = gridDim.x; F.gw = (int)blockIdx.x * 8 + F.wave; F.NGW = F.G * 8; F.ws = p.ws;
    for (int u = F.tid; u < (LDS_BYTES - MISC_OFF) / 4; u += 512) F.MISC[u] = 0u;
    __syncthreads();
    const int lo = p.ph_lo, hi = p.ph_hi;
    XcdBarrier bar; bar.bar = (unsigned*)(F.ws + WS_CTL) + CW_BAR; bar.x = 0; bar.st = F.MISC;
    if (hi - lo > 1) bar = xcd_barrier_post((unsigned*)(F.ws + WS_CTL) + CW_BAR, F.MISC, F.tid == 0);
#ifndef PHASE_MASK
#define PHASE_MASK 0x7ff
#endif
#define IN(k) (((PHASE_MASK >> (k)) & 1) && lo <= (k) && (k) < hi)
#define SEAM(k) do { if (IN(k) && IN((k) + 1)) xcd_barrier(bar, F.wave == 0 && fresh_lane() == 0); } while (0)
#ifndef REPEAT_MASK
#define REPEAT_MASK 0
#endif
#define REP(k) for (int rep_ = 0; rep_ < (((REPEAT_MASK >> (k)) & 1) ? 2 : 1); ++rep_)
    LAS unsigned char* ring = F.lds;
#ifdef PROBE_STREAM
    if (IN(0)) { probe_stream(F, p); }
#endif
    if (IN(0)) { REP(11) { FRESH(); p0a(F, p); } REP(12) { FRESH(); p0b(F, p); } SEAM(0); }
    if (IN(1)) REP(1) {
        pg8::Gemm g{F.ws + WS_H, F.ws + WS_WINT}; using GS = pg8::GShape<DM * 2, DM * 2, DM * 2, 0>; pg8::StaticOrder S; S.init(T, ZC, F.G, (int)blockIdx.x);
        pg8::EpiBf16 E{(bf16_t*)(F.ws + WS_Z), ZC, nullptr, 0};
        pg8::gemm_phase<pg8::EpiBf16, pg8::StaticOrder, GS, true>(ring, g, S, E, F.wave); SEAM(1); }
    if (IN(2)) REP(2) { FRESH(); p2a(F, p); SEAM(2); }
    if (IN(3)) REP(3) { FRESH(); p2b(F, p); SEAM(3); }
    if (IN(4)) REP(4) { FRESH(); p2c(F, p); SEAM(4); }
    if (IN(5)) REP(5) {
        pg8::Gemm g{F.ws + WS_MIX, F.ws + WS_WOUTT}; using GS = pg8::GShape<DM * 2, DM * 2, DM * 2, 0>; pg8::StaticOrder S; S.init(T, DM, F.G, (int)blockIdx.x);
        pg8::EpiBf16Res E{(bf16_t*)(F.ws + WS_XMID), p.in[I_X], DM};
        pg8::gemm_phase<pg8::EpiBf16Res, pg8::StaticOrder, GS, true>(ring, g, S, E, F.wave); SEAM(5); }
    if (IN(6)) { FRESH(); p4a(F, p); SEAM(6); }
    if (IN(7)) REP(7) { FRESH(); p4b(F, p); SEAM(7); }
    if (IN(8)) {
        FRESH(); build_moe_tables(F);
        pg8::Gemm g{F.ws + WS_ABUF, F.ws + WS_WGUT}; using GS = pg8::GShape<DM, DM, DM, (size_t)4096 * DM>;
        pg8::MoeOrder S{__builtin_amdgcn_readfirstlane((int)F.MISC[MI_NMT]), 16, F.G, (int)blockIdx.x, (const LAS int*)(F.lds + MISC_OFF + 4 * MI_T2E)};
        pg8::EpiSwiGLU8 E{F.ws + WS_ACT, DM, p.in[I_BGU]};
        pg8::gemm_phase<pg8::EpiSwiGLU8, pg8::MoeOrder, GS, true, true>(ring, g, S, E, F.wave); SEAM(8); }
#if (REPEAT_MASK & 0x100)
    if (IN(8)) {
        FRESH(); build_moe_tables(F);
        pg8::Gemm g{F.ws + WS_ABUF, F.ws + WS_WGUT}; using GS = pg8::GShape<DM, DM, DM, (size_t)4096 * DM>;
        pg8::MoeOrder S{__builtin_amdgcn_readfirstlane((int)F.MISC[MI_NMT]), 16, F.G, (int)blockIdx.x, (const LAS int*)(F.lds + MISC_OFF + 4 * MI_T2E)};
        pg8::EpiSwiGLU8 E{F.ws + WS_ACT, DM, p.in[I_BGU]};
        pg8::gemm_phase<pg8::EpiSwiGLU8, pg8::MoeOrder, GS, true, true>(ring, g, S, E, F.wave); SEAM(8); }
#endif
    if (IN(9)) {
        FRESH(); build_moe_tables(F);
        pg8::Gemm g{F.ws + WS_ACT, F.ws + WS_WDT}; using GS = pg8::GShape<DM, DM, DM, (size_t)DM * DM>;
        pg8::MoeOrder S{__builtin_amdgcn_readfirstlane((int)F.MISC[MI_NMT]), 8, F.G, (int)blockIdx.x, (const LAS int*)(F.lds + MISC_OFF + 4 * MI_T2E)};
        pg8::EpiFp8S E{F.ws + WS_Y, DM, p.in[I_BDN], DM, 1.0f / 2048.0f, 32.0f};
        pg8::gemm_phase<pg8::EpiFp8S, pg8::MoeOrder, GS, true, true>(ring, g, S, E, F.wave); SEAM(9); }
#if (REPEAT_MASK & 0x200)
    if (IN(9)) {
        FRESH(); build_moe_tables(F);
        pg8::Gemm g{F.ws + WS_ACT, F.ws + WS_WDT}; using GS = pg8::GShape<DM, DM, DM, (size_t)DM * DM>;
        pg8::MoeOrder S{__builtin_amdgcn_readfirstlane((int)F.MISC[MI_NMT]), 8, F.G, (int)blockIdx.x, (const LAS int*)(F.lds + MISC_OFF + 4 * MI_T2E)};
        pg8::EpiFp8S E{F.ws + WS_Y, DM, p.in[I_BDN], DM, 1.0f / 2048.0f, 32.0f};
        pg8::gemm_phase<pg8::EpiFp8S, pg8::MoeOrder, GS, true, true>(ring, g, S, E, F.wave); SEAM(9); }
#endif
    if (IN(10)) REP(10) { FRESH(); p7(F, p); if (((REPEAT_MASK >> 10) & 1)) xcd_barrier(bar, F.wave == 0 && fresh_lane() == 0); }
#undef IN
#undef SEAM
}
#ifndef STAGE
#define STAGE 4
#endif
#ifndef PER_PHASE_LAUNCH
#define PER_PHASE_LAUNCH 0
#endif

#if STAGE < 4
__global__ void adapt_z_kernel(const bf16_t* Z, float* z) {
    const long idx = (long)blockIdx.x * blockDim.x + threadIdx.x; const long t = idx / ZC; const int c = (int)(idx % ZC);
    z[t * INC + (c < 3072 ? c : c + 16)] = bf2f(Z[idx]);
}
__global__ void adapt_bf16_kernel(const bf16_t* src, float* dst) { const long idx = (long)blockIdx.x * blockDim.x + threadIdx.x; dst[idx] = bf2f(src[idx]); }
#endif

static void launch_mk(Params& a, int lo, int hi, int grid, hipStream_t stream) {
#if PER_PHASE_LAUNCH
    for (int k = lo; k < hi; ++k) { a.ph_lo = k; a.ph_hi = k + 1; hipLaunchKernelGGL(mk_fwd, dim3(grid), dim3(512), LDS_BYTES, stream, a); }
#else
    a.ph_lo = lo; a.ph_hi = hi; hipLaunchKernelGGL(mk_fwd, dim3(grid), dim3(512), LDS_BYTES, stream, a);
#endif
}

extern "C" void kernel_launch(void* const* d_in, const int* in_sizes, int n_in, void* d_out, int out_size, void* d_ws, size_t ws_size, hipStream_t stream) {
    static int grid = 0;
    if (grid == 0) {
        int dev = 0, cus = 0;
        if (hipGetDevice(&dev) != hipSuccess || hipDeviceGetAttribute(&cus, hipDeviceAttributeMultiprocessorCount, dev) != hipSuccess) { grid = -1; return; }
        if (hipFuncSetAttribute((const void*)mk_fwd, hipFuncAttributeMaxDynamicSharedMemorySize, LDS_BYTES) != hipSuccess) { grid = -1; return; }
        int per_cu = 0;
        (void)hipOccupancyMaxActiveBlocksPerMultiprocessor(&per_cu, (const void*)mk_fwd, 512, LDS_BYTES);
        (void)hipGetLastError();
        grid = cus;
        if (per_cu < 1) fprintf(stderr, "kernel_launch: occupancy query reports %d\n", per_cu);
    }
    if (grid < 0) return;
    (void)hipMemsetAsync((char*)d_ws + WS_CTL, 0, CTL_ZERO_BYTES, stream);
    Params a{};
    for (int i = 0; i < 22; ++i) a.in[i] = (const float*)d_in[i];
    a.out = (float*)d_out; a.ws = (unsigned char*)d_ws;
#if STAGE >= 4
    launch_mk(a, 0, NPHASE, grid, stream);
#else
    const float* x = a.in[I_X];
    char* ws = (char*)d_ws + WS_ABUF; size_t off = 0;
    auto alloc = [&](size_t bytes) { void* p = ws + off; off += (bytes + 255) & ~(size_t)255; return p; };
    int* counts = (int*)alloc(256);
    float* z = (float*)alloc((size_t)T * INC * 4);
    float* ogla = (float*)alloc((size_t)T * 1024 * 4);
    float* xc = (float*)alloc((size_t)T * 1024 * 4);
    float* za = (float*)alloc((size_t)T * 1024 * 4);
    float* zi = (float*)alloc((size_t)T * 1024 * 4);
    float* mix = (float*)alloc((size_t)T * DM * 4);
    float* xmid = (float*)alloc((size_t)T * DM * 4);
    float* hf = (float*)alloc((size_t)T * DM * 4);
    float* logits = (float*)alloc((size_t)T * 32 * 4);
    float* gates = (float*)alloc((size_t)T * 4 * 4);
    int* list = (int*)alloc((size_t)NEXP * T * 4);
    float* act = (float*)alloc((size_t)T * 4 * DM * 4);
    float* y = (float*)alloc((size_t)T * 4 * DM * 4);
    (void)hipMemsetAsync(counts, 0, 256, stream);
#if STAGE == 1
    launch_mk(a, 0, 2, grid, stream);
    adapt_z_kernel<<<(unsigned)((size_t)T * ZC / 256), 256, 0, stream>>>((const bf16_t*)((char*)d_ws + WS_Z), z);
    gla_naive_kernel<<<64, 256, 0, stream>>>(z, (const float*)((char*)d_ws + WS_LG), ogla);
    gla_out_kernel<<<T, 256, 0, stream>>>(ogla, z, a.in[I_GNG], mix);
    lru_conv_kernel<<<T * 1024 / 256, 256, 0, stream>>>(z, a.in[I_CW], a.in[I_CB], xc);
    for (int h = 0; h < 4; ++h) {
        GemmArgs g{}; g.A = xc + h * 256; g.lda = 1024; g.ldb = 256; g.ldc = 1024; g.M = T; g.N = 256; g.K = 256; g.a_div = 1;
        g.B = a.in[I_WA] + (size_t)h * 65536; g.C = za + h * 256;
        sgemm_kernel<0><<<dim3(2, T / 128, 1), 256, 0, stream>>>(g);
        g.B = a.in[I_WI] + (size_t)h * 65536; g.C = zi + h * 256;
        sgemm_kernel<0><<<dim3(2, T / 128, 1), 256, 0, stream>>>(g);
    }
    lru_gate_kernel<<<T * 1024 / 256, 256, 0, stream>>>(xc, za, zi, a.in[I_BA], a.in[I_BI], a.in[I_AP]);
    lru_scan_kernel<<<2048 / 64, 64, 0, stream>>>(za, zi, z, mix);
#endif
#if STAGE == 2
    launch_mk(a, 0, 5, grid, stream);
    adapt_bf16_kernel<<<(unsigned)((size_t)T * DM / 256), 256, 0, stream>>>((const bf16_t*)((char*)d_ws + WS_MIX), mix);
#endif
#if STAGE <= 2
    { GemmArgs g{}; g.A = mix; g.lda = DM; g.B = a.in[I_WOUT]; g.ldb = DM; g.C = xmid; g.ldc = DM; g.M = T; g.N = DM; g.K = DM; g.a_div = 1; g.resid = x; g.ldr = DM;
      sgemm_kernel<1><<<dim3(DM / 128, T / 128, 1), 256, 0, stream>>>(g); }
#else
    launch_mk(a, 0, 6, grid, stream);
    xmid = (float*)((char*)d_ws + WS_XMID);
#endif
    rmsnorm_kernel<<<T, 256, 0, stream>>>(xmid, a.in[I_NFG], hf);
    { GemmArgs g{}; g.A = hf; g.lda = DM; g.B = a.in[I_WR]; g.ldb = 32; g.C = logits; g.ldc = 32; g.M = T; g.N = 32; g.K = DM; g.a_div = 1; g.bias = a.in[I_BR];
      sgemm_kernel<0><<<dim3(1, T / 128, 1), 256, 0, stream>>>(g); }
    route_kernel<<<T / 256, 256, 0, stream>>>(logits, counts, list, gates);
    { GemmArgs g{}; g.A = hf; g.lda = DM; g.B = a.in[I_WGU]; g.ldb = 4096; g.C = act; g.ldc = DM; g.M = 0; g.N = 4096; g.K = DM; g.a_div = 4; g.bias = a.in[I_BGU];
      g.rowlist = list; g.count = counts; g.strideB_e = (long)DM * 4096; g.strideBias_e = 4096; g.list_stride = T;
      sgemm_kernel<2><<<dim3(2048 / 64, T / 128, NEXP), 256, 0, stream>>>(g); }
    { GemmArgs g{}; g.A = act; g.lda = DM; g.B = a.in[I_WDN]; g.ldb = DM; g.C = y; g.ldc = DM; g.M = 0; g.N = DM; g.K = DM; g.a_div = 1; g.bias = a.in[I_BDN];
      g.rowlist = list; g.count = counts; g.strideB_e = (long)DM * DM; g.strideBias_e = DM; g.list_stride = T;
      sgemm_kernel<0><<<dim3(DM / 128, T / 128, NEXP), 256, 0, stream>>>(g); }
    final_kernel<<<T, 256, 0, stream>>>(xmid, y, gates, a.in[I_NFINAL], (float*)d_out);
#endif
}
```

```cpp
#define STAGE 4
#define PER_PHASE_LAUNCH 0
#define REPEAT_MASK 0
#include <hip/hip_runtime.h>
#include <stdint.h>
#include <stdio.h>

#define GAS __attribute__((address_space(1)))
#define LAS __attribute__((address_space(3)))
typedef unsigned short bf16_t;
typedef short bf16x8 __attribute__((ext_vector_type(8)));
typedef short bf16x4 __attribute__((ext_vector_type(4)));
typedef float f32x4 __attribute__((ext_vector_type(4)));
typedef float f32x2 __attribute__((ext_vector_type(2)));
typedef float f32x16 __attribute__((ext_vector_type(16)));
typedef unsigned u32x4 __attribute__((ext_vector_type(4)));
typedef unsigned u32x2 __attribute__((ext_vector_type(2)));
typedef int i32x8 __attribute__((ext_vector_type(8)));
typedef int i32x4 __attribute__((ext_vector_type(4)));
typedef int i32x32 __attribute__((ext_vector_type(32)));

constexpr int T = 16384, SEQL = 8192, DM = 2048, INC = 5136, ZC = 5120, NEXP = 32;
constexpr int ZQ = 0, ZK = 512, ZV = 1024, ZR = 2048, ZLX = 3072, ZLG = 4096;
constexpr int MPAD_MAX = 65536 + NEXP * 256;
constexpr int NCHUNK = 256;

constexpr size_t MiB = 1u << 20;
constexpr size_t WS_CTL = 0, CTL_ZERO_BYTES = 128 * 1024;
constexpr size_t WS_WINT = 1 * MiB;
constexpr size_t WS_WOUTT = WS_WINT + 20 * MiB;
constexpr size_t WS_WGUT = WS_WOUTT + 8 * MiB;
constexpr size_t WS_WDT = WS_WGUT + 512 * MiB;
constexpr size_t WS_WAT = WS_WDT + 256 * MiB;
constexpr size_t WS_WIT = WS_WAT + 512 * 1024;
constexpr size_t WS_WRT = WS_WIT + 512 * 1024;
constexpr size_t WS_WGLT = WS_WRT + 512 * 1024;
constexpr size_t WS_H = WS_WRT + 1 * MiB;
constexpr size_t WS_LG = WS_H + 64 * MiB;
constexpr size_t WS_Z = WS_LG + 32 * MiB;
constexpr size_t WS_AN = WS_Z + 160 * MiB;
constexpr size_t WS_DN = WS_AN + 128 * MiB;
constexpr size_t WS_SP = WS_DN + 1 * MiB;
constexpr size_t WS_AUA = WS_SP + 64 * MiB;
constexpr size_t WS_AUU = WS_AUA + 64 * MiB;
constexpr size_t WS_SUMA = WS_AUU + 64 * MiB;
constexpr size_t WS_SUMH = WS_SUMA + 1 * MiB;
constexpr size_t WS_MIX = WS_SUMH + 1 * MiB;
constexpr size_t WS_XMID = WS_MIX + 64 * MiB;
constexpr size_t WS_RSTD = WS_XMID + 128 * MiB;
constexpr size_t WS_TOKE = WS_RSTD + 1 * MiB;
constexpr size_t WS_GATES = WS_TOKE + 1 * MiB;
constexpr size_t WS_ABUF = WS_GATES + 1 * MiB;
constexpr size_t WS_HF8 = WS_ABUF, WS_LIST = WS_ABUF + 64 * MiB;
constexpr size_t WS_ACT = WS_ABUF + 288 * MiB;
constexpr size_t WS_Y = WS_ACT + 288 * MiB;
constexpr size_t WS_END = WS_Y + 288 * MiB;
constexpr int CW_BAR = 4096;
constexpr int CW_CNT = 16384;

constexpr int RING_BYTES = 131072;
constexpr int SCR_BYTES = 135168;
constexpr int MISC_OFF = SCR_BYTES;
constexpr int LDS_BYTES = 147456;
constexpr int MI_PBASE = 16, MI_NMT = 48, MI_LCNT = 64, MI_LBASE = 96, MI_T2E = 128, MI_CNT = 480;

#define LDS_WAIT() asm volatile("s_waitcnt lgkmcnt(0)" ::: "memory")
#define VM_WAIT() asm volatile("s_waitcnt vmcnt(0)" ::: "memory")

typedef __bf16 bf16v2_t __attribute__((ext_vector_type(2)));
__device__ __forceinline__ unsigned pk2(float lo, float hi) { const f32x2 v = {lo, hi}; return __builtin_bit_cast(unsigned, __builtin_convertvector(v, bf16v2_t)); }
#ifdef SIM_FP8
__device__ __forceinline__ float q8_(float x, float sc) { int p = 0; p = __builtin_amdgcn_cvt_pk_fp8_f32(__builtin_amdgcn_fmed3f(x * sc, -448.0f, 448.0f), 0.0f, p, false); return __builtin_amdgcn_cvt_f32_fp8(p, 0) * (1.0f / sc); }
#define PK2A(a, b) pk2(q8_(a, 16.0f), q8_(b, 16.0f))
#define PK2W(a, b) pk2(q8_(a, 512.0f), q8_(b, 512.0f))
#else
#define PK2A(a, b) pk2(a, b)
#define PK2W(a, b) pk2(a, b)
#endif
__device__ __forceinline__ unsigned f2bf(float f) { return pk2(f, 0.0f) & 0xffffu; }
__device__ __forceinline__ float bf2f(unsigned short b) { return __builtin_bit_cast(float, (unsigned)b << 16); }
__device__ __forceinline__ float bflo(unsigned w) { return __builtin_bit_cast(float, w << 16); }
__device__ __forceinline__ float bfhi(unsigned w) { return __builtin_bit_cast(float, w & 0xffff0000u); }
__device__ __forceinline__ float clamp448(float x) { return __builtin_amdgcn_fmed3f(x, -448.0f, 448.0f); }
__device__ __forceinline__ unsigned pk4_fp8(float a, float b, float c, float d) {
    int p = 0; p = __builtin_amdgcn_cvt_pk_fp8_f32(clamp448(a), clamp448(b), p, false); p = __builtin_amdgcn_cvt_pk_fp8_f32(clamp448(c), clamp448(d), p, true); return (unsigned)p; }
__device__ __forceinline__ unsigned pk4_fp8_nc(float a, float b, float c, float d) {
    int p = 0; p = __builtin_amdgcn_cvt_pk_fp8_f32(a, b, p, false); p = __builtin_amdgcn_cvt_pk_fp8_f32(c, d, p, true); return (unsigned)p; }
__device__ __forceinline__ float fp8f(unsigned w, int b) { return b == 0 ? __builtin_amdgcn_cvt_f32_fp8((int)w, 0) : b == 1 ? __builtin_amdgcn_cvt_f32_fp8((int)w, 1) : b == 2 ? __builtin_amdgcn_cvt_f32_fp8((int)w, 2) : __builtin_amdgcn_cvt_f32_fp8((int)w, 3); }
__device__ __forceinline__ float wave_sum(float v) {
#pragma unroll
    for (int o = 1; o < 64; o <<= 1) v += __shfl_xor(v, o);
    return v;
}
__device__ __forceinline__ int fresh_lane() { int l; asm volatile("v_mbcnt_lo_u32_b32 %0, -1, 0\n\tv_mbcnt_hi_u32_b32 %0, -1, %0" : "=v"(l)); return l; }
__device__ __forceinline__ float sigmoidf_(float x) { return __builtin_amdgcn_rcpf(1.0f + __expf(-x)); }
__device__ __forceinline__ float rsqrtf_(float x) { return __builtin_amdgcn_rsqf(x); }

#define XB_TMO      128
#define XB_XCNT(j)  (256  + 64 * (j))
#define XB_XSUB(j)  (1280 + 64 * (j))
#define XB_XGEN(j)  (2304 + 64 * (j))
#define XB_TOP      3328
#define XB_TOPGEN   3392
#define XCD_BAR_WORDS 3456
#define XB_SPIN_CAP (1u << 18)

__device__ __forceinline__ unsigned xb_ld(unsigned* p)              { return __hip_atomic_load(p, __ATOMIC_RELAXED, __HIP_MEMORY_SCOPE_AGENT); }
__device__ __forceinline__ unsigned xb_add(unsigned* p, unsigned v) { return __hip_atomic_fetch_add(p, v, __ATOMIC_RELAXED, __HIP_MEMORY_SCOPE_AGENT); }
__device__ __forceinline__ unsigned xb_xcc_id() { return (unsigned)__builtin_amdgcn_s_getreg((3 << 11) | 20) & 0xFu; }
#define XB_SPIN(cond, bar) do { unsigned _sp = 0; while (cond) { __builtin_amdgcn_s_sleep(1); \
    if ((++_sp & 255u) == 0u) { if (xb_ld(&(bar)[XB_TMO])) break; if (_sp > XB_SPIN_CAP) { atomicAdd(&(bar)[XB_TMO], 1u); break; } } } } while (0)

struct XcdBarrier { unsigned* bar; unsigned x; volatile LAS unsigned* st; };

__device__ __forceinline__ XcdBarrier xcd_barrier_post(unsigned* bar, volatile LAS unsigned* st, bool t0) {
    XcdBarrier b; b.bar = bar; b.x = xb_xcc_id(); b.st = st;
    if (t0) (void)xb_add(&bar[XB_XCNT(b.x)], 1u);
    return b;
}
__device__ __forceinline__ void xcd_barrier_complete(unsigned* bar, unsigned x, unsigned& nloc, unsigned& nx) {
    const unsigned G = gridDim.x * gridDim.y * gridDim.z;
    unsigned sum, cnt, mine, sp = 0u;
    for (;;) {
        sum = 0u; cnt = 0u; mine = 0u;
#pragma unroll
        for (unsigned j = 0; j < 16; ++j) { const unsigned c = xb_ld(&bar[XB_XCNT(j)]); sum += c; cnt += (c > 0u) ? 1u : 0u; mine = (j == x) ? c : mine; }
        if (sum == G) break;
        __builtin_amdgcn_s_sleep(1);
        if ((++sp & 255u) == 0u) { if (xb_ld(&bar[XB_TMO])) break; if (sp > XB_SPIN_CAP) { atomicAdd(&bar[XB_TMO], 1u); break; } }
    }
    nloc = mine > 0u ? mine : 1u; nx = cnt > 0u ? cnt : 1u;
}
__device__ __forceinline__ void xcd_barrier(const XcdBarrier& b, bool t0) {
    asm volatile("s_waitcnt vmcnt(0)" ::: "memory");
    __syncthreads();
    if (t0) {
        unsigned* bar = b.bar;
        __builtin_amdgcn_s_waitcnt(0);
        unsigned nloc = b.st[0], nx = b.st[1];
        if (nloc == 0u) { xcd_barrier_complete(bar, b.x, nloc, nx); b.st[0] = nloc; b.st[1] = nx; }
        const unsigned old = xb_add(&bar[XB_XSUB(b.x)], 1u);
        const unsigned gen = old / nloc;
        if (old + 1u == (gen + 1u) * nloc) {
            __builtin_amdgcn_fence(__ATOMIC_RELEASE, "agent");
            asm volatile("s_waitcnt vmcnt(0)" ::: "memory");
            const unsigned og = xb_add(&bar[XB_TOP], 1u);
            const unsigned tg = og / nx;
            if (og + 1u == (tg + 1u) * nx) xb_add(&bar[XB_TOPGEN], 1u);
            else XB_SPIN(xb_ld(&bar[XB_TOPGEN]) == tg, bar);
            __builtin_amdgcn_fence(__ATOMIC_ACQUIRE, "agent");
            xb_add(&bar[XB_XGEN(b.x)], 1u);
            asm volatile("s_waitcnt vmcnt(0)" ::: "memory");
        } else {
            XB_SPIN(xb_ld(&bar[XB_XGEN(b.x)]) == gen, bar);
            __builtin_amdgcn_fence(__ATOMIC_ACQUIRE, "agent");
            asm volatile("s_waitcnt vmcnt(0)" ::: "memory");
        }
    }
    __syncthreads();
}

namespace pg8 {
#ifndef PG8_WGM
#define PG8_WGM 4
#endif
constexpr int BM = 256, BK = 64, HALF = 128, HTB = HALF * BK * 2, STAGE_BYTES = 8 * HTB, NXCD = 8, WGM = PG8_WGM;
__host__ __device__ __forceinline__ int lds_byte(int r, int c) { const int st = (r >> 4) * 2 + (c >> 5), rr = r & 15, cc = c & 31, ob = rr * 64 + cc * 2; return st * 1024 + (ob ^ (((ob >> 9) & 1) << 5)); }
__host__ __device__ __forceinline__ void stage_rc(int b, int& R, int& C) { const int st = b / 1024, sb = b % 1024, swz = sb ^ (((sb >> 9) & 1) << 5); R = (st >> 1) * 16 + swz / 64; C = (st & 1) * 32 + (swz % 64) / 2; }
__host__ __device__ __forceinline__ int perm32(int rho) { const int n = rho >> 4, i = rho & 15; return 8 * (i >> 2) + 4 * n + (i & 3); }

struct Unit { int pm, pn, e; };
struct Gemm { const void* A; const void* Bt; };
template <int LDA_, int LDB_, int KB_, size_t SB_> struct GShape { static constexpr int LDA = LDA_, LDB = LDB_, KB = KB_; static constexpr size_t SB = SB_; };

__device__ __forceinline__ bool order_map(int L, int nM, int nN, int& pm, int& pn) {
    const int nwg = nM * nN; if (L >= nwg) return false;
    int wgid = L; { const int q = nwg / NXCD, r = nwg % NXCD, xcd = wgid % NXCD, off = wgid / NXCD; wgid = (xcd < r ? xcd * (q + 1) : r * (q + 1) + (xcd - r) * q) + off; }
    const int nig = WGM * nN, gid = wgid / nig, fm = gid * WGM, gsz = (nM - fm) < WGM ? (nM - fm) : WGM;
    pm = fm + ((wgid % nig) % gsz); pn = (wgid % nig) / gsz; return true;
}
struct StaticOrder {
    int nM, nN, G, c;
    __device__ void init(int M, int N, int G_, int c_) { nM = M / BM; nN = N / BM; G = G_; c = c_; }
    __device__ __forceinline__ bool next(int i, Unit& u) const { u.e = 0; return order_map(i * G + c, nM, nN, u.pm, u.pn); }
};
struct MoeOrder {
    int nM, nN, G, c; const LAS int* t2e;
    __device__ __forceinline__ bool next(int i, Unit& u) const { if (!order_map(i * G + c, nM, nN, u.pm, u.pn)) return false; u.e = __builtin_amdgcn_readfirstlane(t2e[u.pm]); return true; }
};

__device__ __forceinline__ unsigned cvt_pk_bf16(float lo, float hi) { return pk2(lo, hi); }

struct EpiBf16 {
    static constexpr bool PERM = true; static constexpr int NSTORES = 16;
    bf16_t* O; int ldc; const float* bias; int bias_stride;
    __device__ __forceinline__ void operator()(const f32x4 (&acc)[2][2][4][2], const Unit& u, int wr, int wc, int fr, int fq) const {
        const int row0 = u.pm * BM + wr * 64 + fr; const int col0 = u.pn * BM + wc * 32 + 8 * fq;
        f32x4 bv[2][2];
#pragma unroll
        for (int bj = 0; bj < 2; ++bj)
#pragma unroll
            for (int n = 0; n < 2; ++n) bv[bj][n] = bias ? *(const f32x4*)(bias + (size_t)u.e * bias_stride + col0 + bj * HALF + 4 * n) : (f32x4){0.f, 0.f, 0.f, 0.f};
#pragma unroll
        for (int ai = 0; ai < 2; ++ai)
#pragma unroll
            for (int m = 0; m < 4; ++m) { bf16_t* rowp = O + (size_t)(row0 + ai * HALF + m * 16) * ldc + col0;
#pragma unroll
                for (int bj = 0; bj < 2; ++bj) { const f32x4 v0 = acc[ai][bj][m][0] + bv[bj][0], v1 = acc[ai][bj][m][1] + bv[bj][1];
                    u32x4 w; w.x = cvt_pk_bf16(v0[0], v0[1]); w.y = cvt_pk_bf16(v0[2], v0[3]); w.z = cvt_pk_bf16(v1[0], v1[1]); w.w = cvt_pk_bf16(v1[2], v1[3]);
                    *(u32x4*)(rowp + bj * HALF) = w; } }
    }
};
struct EpiF32Res {
    static constexpr bool PERM = false;
    float* C; const float* resid; int ldc;
    __device__ __forceinline__ void operator()(const f32x4 (&acc)[2][2][4][2], const Unit& u, int wr, int wc, int fr, int fq) const {
        const int row0 = u.pm * BM + wr * 64 + fr, col0 = u.pn * BM + wc * 32 + 4 * fq;
#pragma unroll
        for (int ai = 0; ai < 2; ++ai)
#pragma unroll
            for (int m = 0; m < 4; ++m) { const size_t off = (size_t)(row0 + ai * HALF + m * 16) * ldc + col0;
#pragma unroll
                for (int bj = 0; bj < 2; ++bj)
#pragma unroll
                    for (int n = 0; n < 2; ++n) { const f32x4 r = *(const f32x4*)(resid + off + bj * HALF + n * 16); *(f32x4*)(C + off + bj * HALF + n * 16) = acc[ai][bj][m][n] + r; } }
    }
};
struct EpiSwiGLU {
    static constexpr bool PERM = true;
    bf16_t* O; int ldc; const float* bias;
    __device__ __forceinline__ void operator()(const f32x4 (&acc)[2][2][4][2], const Unit& u, int wr, int wc, int fr, int fq) const {
        const int row0 = u.pm * BM + wr * 64 + fr; const int j0 = u.pn * HALF + wc * 32 + 8 * fq;
        const float* be = bias + (size_t)u.e * 4096;
        f32x4 bg[2], bu[2];
#pragma unroll
        for (int n = 0; n < 2; ++n) { bg[n] = *(const f32x4*)(be + j0 + 4 * n); bu[n] = *(const f32x4*)(be + 2048 + j0 + 4 * n); }
#pragma unroll
        for (int ai = 0; ai < 2; ++ai)
#pragma unroll
            for (int m = 0; m < 4; ++m) { bf16_t* rowp = O + (size_t)(row0 + ai * HALF + m * 16) * ldc + j0;
                float o[8];
#pragma unroll
                for (int n = 0; n < 2; ++n) { const f32x4 g = acc[ai][0][m][n] + bg[n], up = acc[ai][1][m][n] + bu[n];
#pragma unroll
                    for (int q = 0; q < 4; ++q) { const float gt = fminf(g[q], 7.0f), ut = fminf(fmaxf(up[q], -7.0f), 7.0f);
                        const float glu = gt * __builtin_amdgcn_rcpf(1.0f + __expf(-1.702f * gt)); o[4 * n + q] = (ut + 1.0f) * glu; } }
                u32x4 w; w.x = cvt_pk_bf16(o[0], o[1]); w.y = cvt_pk_bf16(o[2], o[3]); w.z = cvt_pk_bf16(o[4], o[5]); w.w = cvt_pk_bf16(o[6], o[7]);
                *(u32x4*)rowp = w; }
    }
};

struct EpiBf16Res {
    static constexpr bool PERM = true; static constexpr int NSTORES = 16;
    bf16_t* O; const float* resid; int ldc;
    __device__ __forceinline__ void operator()(const f32x4 (&acc)[2][2][4][2], const Unit& u, int wr, int wc, int fr, int fq) const {
        const int row0 = u.pm * BM + wr * 64 + fr; const int col0 = u.pn * BM + wc * 32 + 8 * fq;
#pragma unroll
        for (int ai = 0; ai < 2; ++ai)
#pragma unroll
            for (int m = 0; m < 4; ++m) { const size_t off = (size_t)(row0 + ai * HALF + m * 16) * ldc + col0;
#pragma unroll
                for (int bj = 0; bj < 2; ++bj) { const f32x4 r0 = *(const f32x4*)(resid + off + bj * HALF), r1 = *(const f32x4*)(resid + off + bj * HALF + 4);
                    const f32x4 v0 = acc[ai][bj][m][0] + r0, v1 = acc[ai][bj][m][1] + r1;
                    u32x4 w; w.x = cvt_pk_bf16(v0[0], v0[1]); w.y = cvt_pk_bf16(v0[2], v0[3]); w.z = cvt_pk_bf16(v1[0], v1[1]); w.w = cvt_pk_bf16(v1[2], v1[3]);
                    *(u32x4*)(O + off + bj * HALF) = w; } }
    }
};
template <int MODE = 0> struct EpiFp8S_ {
    static constexpr int NSTORES = 16;
    static constexpr bool PERM = true, BIAS_LDS = true;
    unsigned char* O; int ldc; const float* bias; int bias_stride; float scale, oscale;
    __device__ __forceinline__ const char* bias_base(const Unit& u) const { return (const char*)(bias + (size_t)u.e * bias_stride + u.pn * BM); }
    __device__ static __forceinline__ unsigned bias_voff(int i) { return (unsigned)i * 4u; }
    __device__ __forceinline__ void operator()(const f32x4 (&acc)[2][2][4][2], const Unit& u, int wr, int wc, int fr, int fq, const LAS float* bl) const {
        const int row0 = u.pm * BM + wr * 64 + fr; const int col0 = u.pn * BM + wc * 32 + 8 * fq;
        f32x4 bv[2][2];
#pragma unroll
        for (int bj = 0; bj < 2; ++bj)
#pragma unroll
            for (int n = 0; n < 2; ++n) { if constexpr (MODE == 2) bv[bj][n] = (f32x4){oscale, oscale, oscale, oscale}; else bv[bj][n] = *(const LAS f32x4*)(bl + wc * 32 + 8 * fq + bj * HALF + 4 * n) * oscale; }
        const float sc = scale * oscale;
#pragma unroll
        for (int ai = 0; ai < 2; ++ai)
#pragma unroll
            for (int m = 0; m < 4; ++m) { unsigned char* rowp = O + (size_t)(row0 + ai * HALF + m * 16) * ldc + col0;
#pragma unroll
                for (int bj = 0; bj < 2; ++bj) { const f32x4 v0 = acc[ai][bj][m][0] * sc + bv[bj][0], v1 = acc[ai][bj][m][1] * sc + bv[bj][1];
                    u32x2 w; w.x = pk4_fp8(v0[0], v0[1], v0[2], v0[3]); w.y = pk4_fp8(v1[0], v1[1], v1[2], v1[3]);
                    if constexpr (MODE == 1) { if (u.pm < 0) *(u32x2*)(rowp + bj * HALF) = w; else asm volatile("" :: "v"(w)); } else *(u32x2*)(rowp + bj * HALF) = w; } }
    }
};
using EpiFp8S = EpiFp8S_<0>;
struct EpiSwiGLU8 {
    static constexpr bool PERM = true, BIAS_LDS = true; static constexpr int NSTORES = 8;
    unsigned char* O; int ldc; const float* bias;
    struct Bias { f32x4 bg[2], bu[2]; };
    __device__ __forceinline__ const char* bias_base(const Unit& u) const { return (const char*)(bias + (size_t)u.e * 4096 + u.pn * HALF); }
    __device__ static __forceinline__ unsigned bias_voff(int i) { return (unsigned)(i < 128 ? i : 2048 - 128 + i) * 4u; }
    __device__ __forceinline__ void load_bias(const Unit& u, int wc, int fq, Bias& b, const LAS float* bl) const {
        const int j0 = wc * 32 + 8 * fq;
#pragma unroll
        for (int n = 0; n < 2; ++n) { b.bg[n] = *(const LAS f32x4*)(bl + j0 + 4 * n); b.bu[n] = *(const LAS f32x4*)(bl + 128 + j0 + 4 * n); } }
    __device__ __forceinline__ void operator()(const f32x4 (&acc)[2][2][4][2], const Unit& u, int wr, int wc, int fr, int fq, const LAS float* bl) const { Bias b; load_bias(u, wc, fq, b, bl); apply(acc, u, wr, wc, fr, fq, b); }
    __device__ __forceinline__ void apply(const f32x4 (&acc)[2][2][4][2], const Unit& u, int wr, int wc, int fr, int fq, const Bias& b) const {
        const int row0 = u.pm * BM + wr * 64 + fr; const int j0 = u.pn * HALF + wc * 32 + 8 * fq;
        const f32x4 (&bg)[2] = b.bg; const f32x4 (&bu)[2] = b.bu;
#pragma unroll
        for (int ai = 0; ai < 2; ++ai)
#pragma unroll
            for (int m = 0; m < 4; ++m) { unsigned char* rowp = O + (size_t)(row0 + ai * HALF + m * 16) * ldc + j0;
                float o[8];
#pragma unroll
                for (int n = 0; n < 2; ++n) { const f32x4 g = acc[ai][0][m][n] * (1.0f / 8192.0f) + bg[n], up = acc[ai][1][m][n] * (1.0f / 8192.0f) + bu[n];
#pragma unroll
                    for (int q = 0; q < 4; ++q) { const float gt = fminf(g[q], 7.0f), ut = __builtin_amdgcn_fmed3f(up[q], -7.0f, 7.0f);
                        const float glu = gt * __builtin_amdgcn_rcpf(1.0f + __builtin_amdgcn_exp2f(-2.4554669595930156f * gt)); o[4 * n + q] = __builtin_fmaf(ut, 4.0f, 4.0f) * glu; } }
                u32x2 w; w.x = pk4_fp8_nc(o[0], o[1], o[2], o[3]); w.y = pk4_fp8_nc(o[4], o[5], o[6], o[7]);
                *(u32x2*)rowp = w; }
    }
};
template <int ALL> struct EpiNull_ { static constexpr bool PERM = true;
    __device__ __forceinline__ void operator()(const f32x4 (&acc)[2][2][4][2], const Unit& u, int wr, int wc, int fr, int fq) const {
        if constexpr (ALL == 0) asm volatile("" :: "v"(acc[0][0][0][0]), "v"(acc[1][1][3][1]));
        else {
#pragma unroll
        for (int a = 0; a < 2; ++a)
#pragma unroll
            for (int b = 0; b < 2; ++b) asm volatile("" :: "v"(acc[a][b][0][0]), "v"(acc[a][b][0][1]), "v"(acc[a][b][1][0]), "v"(acc[a][b][1][1]), "v"(acc[a][b][2][0]), "v"(acc[a][b][2][1]), "v"(acc[a][b][3][0]), "v"(acc[a][b][3][1])); } } };
using EpiNull = EpiNull_<1>;
struct EpiBf16S {
    static constexpr bool PERM = true;
    bf16_t* O; int ldc; const float* bias; int bias_stride; float scale;
    __device__ __forceinline__ void operator()(const f32x4 (&acc)[2][2][4][2], const Unit& u, int wr, int wc, int fr, int fq) const {
        const int row0 = u.pm * BM + wr * 64 + fr; const int col0 = u.pn * BM + wc * 32 + 8 * fq;
        f32x4 bv[2][2];
#pragma unroll
        for (int bj = 0; bj < 2; ++bj)
#pragma unroll
            for (int n = 0; n < 2; ++n) bv[bj][n] = *(const f32x4*)(bias + (size_t)u.e * bias_stride + col0 + bj * HALF + 4 * n);
#pragma unroll
        for (int ai = 0; ai < 2; ++ai)
#pragma unroll
            for (int m = 0; m < 4; ++m) { bf16_t* rowp = O + (size_t)(row0 + ai * HALF + m * 16) * ldc + col0;
#pragma unroll
                for (int bj = 0; bj < 2; ++bj) { const f32x4 v0 = acc[ai][bj][m][0] * scale + bv[bj][0], v1 = acc[ai][bj][m][1] * scale + bv[bj][1];
                    u32x4 w; w.x = cvt_pk_bf16(v0[0], v0[1]); w.y = cvt_pk_bf16(v0[2], v0[3]); w.z = cvt_pk_bf16(v1[0], v1[1]); w.w = cvt_pk_bf16(v1[2], v1[3]);
                    *(u32x4*)(rowp + bj * HALF) = w; } }
    }
};

__device__ __forceinline__ i32x8 pg8_get8(const i32x32& v, int idx) { i32x8 r;
#pragma unroll
    for (int j = 0; j < 8; ++j) r[j] = v[8 * idx + j];
    return r; }
__device__ __forceinline__ i32x4 pg8_get4(const i32x32& v, int idx) { i32x4 r;
#pragma unroll
    for (int j = 0; j < 4; ++j) r[j] = v[4 * idx + j];
    return r; }
struct NoHost { static constexpr bool ON = false; static constexpr int N = 0; };
template <int N_> struct EpiHost {
    static constexpr bool ON = true; static constexpr int N = N_;
    const float* W; unsigned char* WT; int cid, cend, cstride; int ldw, cbs, gu, e0; int pend[N_];
    __device__ __forceinline__ void issue(unsigned (&x)[16 * N_], int lane) {
        const unsigned vo = (unsigned)lane * 4u; const size_t rowb = (size_t)ldw * 4;
#pragma unroll
        for (int j = 0; j < N_; ++j) { const int id = cid < cend ? cid : cend - 1; pend[j] = id; cid += cstride;
            const int cb = id & ((1 << cbs) - 1), kb = (id >> cbs) & 127, e = e0 + (id >> (cbs + 7));
            const char* rb = (const char*)(W + (size_t)e * DM * ldw + (size_t)(16 * kb) * ldw + 64 * cb);
#pragma unroll
            for (int i = 0; i < 16; ++i) asm volatile("s_nop 4\n\tglobal_load_dword %0, %1, %2" : "=v"(x[16 * j + i]) : "v"(vo), "s"(rb + (size_t)i * rowb) : "memory"); }
    }
    __device__ __forceinline__ void finish(const unsigned (&x)[16 * N_], int lane) const {
#pragma unroll
        for (int j = 0; j < N_; ++j) { const int id = pend[j]; const int cb = id & ((1 << cbs) - 1), kb = (id >> cbs) & 127, e = e0 + (id >> (cbs + 7)); const int n0 = 64 * cb;
            const int drow0 = !gu ? n0 : (n0 < 2048) ? (256 * (n0 >> 7) + (n0 & 127)) : (256 * ((n0 - 2048) >> 7) + 128 + ((n0 - 2048) & 127));
            u32x4 o;
#pragma unroll
            for (int q = 0; q < 4; ++q) o[q] = pk4_fp8(__builtin_bit_cast(float, x[16 * j + 4 * q]) * 512.0f, __builtin_bit_cast(float, x[16 * j + 4 * q + 1]) * 512.0f, __builtin_bit_cast(float, x[16 * j + 4 * q + 2]) * 512.0f, __builtin_bit_cast(float, x[16 * j + 4 * q + 3]) * 512.0f);
            *(u32x4*)(WT + (size_t)e * ldw * DM + (size_t)(drow0 + lane) * DM + 16 * kb) = o; }
    }
};
struct NoGather { static constexpr bool ON = false; };
struct Gather { static constexpr bool ON = true; const unsigned short* list; const LAS unsigned* pbase; const LAS unsigned* cnt; };
__device__ __forceinline__ unsigned gather_clamp(unsigned P, int r0, int cn) { const unsigned lo = (r0 < cn) ? (P & 0xffffu) : 0u, hi = (r0 + 64 < cn) ? (P >> 16) : 0u; return lo | (hi << 16); }
struct NoConv { static constexpr bool ON = false; };
struct ConvGU {
    static constexpr bool ON = true;
    const float* W; unsigned char* WT; int cid, cend, cstride, pend; const char* rbase;
    __device__ __forceinline__ void issue(unsigned (&x)[16], int lane) {
        const int id = cid < cend ? cid : cend - 1; pend = id; cid += cstride;
        const int e = id >> 13, kb = (id >> 6) & 127, cb = id & 63;
        const char* rb = (const char*)(W + (size_t)e * DM * 4096 + (size_t)(16 * kb) * 4096 + 64 * cb);
        const unsigned vo = (unsigned)lane * 4u; rbase = rb;
#pragma unroll
        for (int i = 0; i < 8; ++i) asm volatile("s_nop 4\n\tglobal_load_dword %0, %1, %2" : "=v"(x[i]) : "v"(vo), "s"(rb + (size_t)i * 16384) : "memory");
    }
    __device__ __forceinline__ void issue_b(unsigned (&x)[16], int lane) {
        const unsigned vo = (unsigned)lane * 4u;
#pragma unroll
        for (int i = 8; i < 16; ++i) asm volatile("s_nop 4\n\tglobal_load_dword %0, %1, %2" : "=v"(x[i]) : "v"(vo), "s"(rbase + (size_t)i * 16384) : "memory");
    }
    __device__ __forceinline__ void finish(const unsigned (&x)[16], int lane) const {
        const int id = pend; const int e = id >> 13, kb = (id >> 6) & 127, cb = id & 63; const int n0 = 64 * cb;
        const int drow0 = (n0 < 2048) ? (256 * (n0 >> 7) + (n0 & 127)) : (256 * ((n0 - 2048) >> 7) + 128 + ((n0 - 2048) & 127));
        u32x4 o;
#pragma unroll
        for (int q = 0; q < 4; ++q) o[q] = pk4_fp8(__builtin_bit_cast(float, x[4 * q]) * 512.0f, __builtin_bit_cast(float, x[4 * q + 1]) * 512.0f, __builtin_bit_cast(float, x[4 * q + 2]) * 512.0f, __builtin_bit_cast(float, x[4 * q + 3]) * 512.0f);
        *(u32x4*)(WT + (size_t)e * 4096 * DM + (size_t)(drow0 + lane) * DM + 16 * kb) = o;
    }
};
#define PG8_X16A(x, b) "+v"(x[b+0]), "+v"(x[b+1]), "+v"(x[b+2]), "+v"(x[b+3]), "+v"(x[b+4]), "+v"(x[b+5]), "+v"(x[b+6]), "+v"(x[b+7]), "+v"(x[b+8]), "+v"(x[b+9]), "+v"(x[b+10]), "+v"(x[b+11]), "+v"(x[b+12]), "+v"(x[b+13]), "+v"(x[b+14]), "+v"(x[b+15])
#define PG8_X16(x) "+v"(x[0]), "+v"(x[1]), "+v"(x[2]), "+v"(x[3]), "+v"(x[4]), "+v"(x[5]), "+v"(x[6]), "+v"(x[7]), "+v"(x[8]), "+v"(x[9]), "+v"(x[10]), "+v"(x[11]), "+v"(x[12]), "+v"(x[13]), "+v"(x[14]), "+v"(x[15])

template <class E, class = void> struct epi_nstores { static constexpr int value = 0; };
template <class E> struct epi_nstores<E, decltype((void)E::NSTORES)> { static constexpr int value = E::NSTORES; };
template <class E, class = void> struct has_bias_lds { static constexpr bool value = false; };
template <class E> struct has_bias_lds<E, decltype((void)E::BIAS_LDS)> { static constexpr bool value = E::BIAS_LDS; };
constexpr int BIAS_LDS_OFF = MISC_OFF + 4096;
#ifndef CV_XMASK
#define CV_XMASK 0
#endif
template <class Epi, class Sched, class GS, bool ALIGN_EPI = true, bool F8 = false, int STAGGER_TICKS = 0, class CV = NoConv, class EH = NoHost, bool KROT = false, class GI = NoGather, bool FLP = false>
__device__ __forceinline__ void gemm_phase(LAS unsigned char* lds, const Gemm g, const Sched& S, const Epi& E, int wave, CV cv = CV(), EH eh = EH(), GI gi = GI()) {
    const int wid = wave, lane = fresh_lane(), tid = wid * 64 + lane, wr = wid >> 2, wc = wid & 3, fr = lane & 15, fq = lane >> 4;
    constexpr int nt = GS::KB / 128;
    unsigned voffA, voffB;
    { int R, C; stage_rc(tid * 16, R, C); const int Rb = Epi::PERM ? ((R & ~31) + perm32(R & 31)) : R;
      voffA = (unsigned)(R * GS::LDA + C * 2); voffB = (unsigned)(Rb * GS::LDB + C * 2);
      if constexpr (FLP) { const int b = tid * 16; voffA = (unsigned)((b >> 7) * GS::LDA + (b & 127)); voffB = (unsigned)((b >> 7) * GS::LDB + (b & 127)); } }
    constexpr size_t pstepA = (size_t)64 * GS::LDA, pstepB = (size_t)64 * GS::LDB;
    constexpr size_t kstep = (size_t)(BK * 2);
    constexpr size_t hstepA = (size_t)HALF * GS::LDA, hstepB = (size_t)HALF * GS::LDB;
    constexpr size_t tstepA = 2 * hstepA, tstepB = 2 * hstepB;
    const unsigned ldsw = (unsigned)wid * 1024u;
    const unsigned ldsb = (unsigned)(size_t)lds + ldsw;
    const int aoff = lds_byte(wr * 64 + fr, F8 ? fq * 16 : fq * 8), boff = lds_byte(wc * 32 + fr, F8 ? fq * 16 : fq * 8);
    const int kofs = F8 ? 16 : 1024;
#define PG8_SA(b, h) (((b) * 2 + (h)) * HTB)
#define PG8_SB(b, h) ((4 + (b) * 2 + (h)) * HTB)
#define PG8_STAGE(bufoff, gbase, voff) do { _Pragma("unroll") for (int _i = 0; _i < 2; ++_i) { unsigned _keep; \
        asm volatile("s_mov_b32 %0, m0\n\ts_mov_b32 m0, %3\n\ts_nop 3\n\tglobal_load_lds_dwordx4 %1, %2\n\ts_mov_b32 m0, %0" \
            : "=&s"(_keep) : "v"(voff##_v), "s"((const char*)(gbase) + _i * pstep##voff), "s"(ldsb + (unsigned)((bufoff) + _i * 8192)) : "memory"); } } while (0)
#define PG8_STAGE_GA(bufoff, kp, vlo, vhi) do { unsigned _keep; \
        asm volatile("s_mov_b32 %0, m0\n\ts_mov_b32 m0, %3\n\ts_nop 3\n\tglobal_load_lds_dwordx4 %1, %2\n\ts_mov_b32 m0, %0" : "=&s"(_keep) : "v"(vlo), "s"((const char*)(kp)), "s"(ldsb + (unsigned)(bufoff)) : "memory"); \
        asm volatile("s_mov_b32 %0, m0\n\ts_mov_b32 m0, %3\n\ts_nop 3\n\tglobal_load_lds_dwordx4 %1, %2\n\ts_mov_b32 m0, %0" : "=&s"(_keep) : "v"(vhi), "s"((const char*)(kp)), "s"(ldsb + (unsigned)((bufoff) + 8192)) : "memory"); } while (0)
#define PG8_STA(bufoff, kp, h, nx) do { if constexpr (GI::ON) { const unsigned _p = (nx) ? nvP[h] : voP[h]; const unsigned _lo = ((_p & 0xffffu) << 11) + gcb, _hi = ((_p >> 16) << 11) + gcb; PG8_STAGE_GA(bufoff, kp, _lo, _hi); } \
        else PG8_STAGE(bufoff, (kp) + (h) * hstepA, voffA); } while (0)
#define pstepvoffA pstepA
#define pstepvoffB pstepB
#define voffA_v voffA
#define voffB_v voffB
#define PG8_LD16(p) (*(const LAS i32x4*)(p))
#define PG8_SET8(V, idx, lo, hi) do { _Pragma("unroll") for (int _j = 0; _j < 4; ++_j) { V[8 * (idx) + _j] = (lo)[_j]; V[8 * (idx) + 4 + _j] = (hi)[_j]; } } while (0)
#define PG8_GET8(V, idx) pg8_get8(V, idx)
#define PG8_GETLO(V, idx) __builtin_bit_cast(bf16x8, pg8_get4(V, 2 * (idx)))
#define PG8_GETHI(V, idx) __builtin_bit_cast(bf16x8, pg8_get4(V, 2 * (idx) + 1))
#define PG8_LDA(dst, b, h) do { _Pragma("unroll") for (int m = 0; m < 4; ++m) { const i32x4 _lo = PG8_LD16(lds + PG8_SA(b, h) + aoff + m * 2048), _hi = PG8_LD16(lds + PG8_SA(b, h) + aoff + m * 2048 + kofs); \
        PG8_SET8(AV, m, _lo, _hi); } } while (0)
#define PG8_LDB(dst, b, h) do { _Pragma("unroll") for (int n = 0; n < 2; ++n) { const i32x4 _lo = PG8_LD16(lds + PG8_SB(b, h) + boff + n * 2048), _hi = PG8_LD16(lds + PG8_SB(b, h) + boff + n * 2048 + kofs); \
        PG8_SET8(BV, (dst) + n, _lo, _hi); } } while (0)
#define PG8_MMA(ai, bj, At, Bt) do { __builtin_amdgcn_s_setprio(1); \
        if constexpr (F8) { _Pragma("unroll") for (int m = 0; m < 4; ++m) _Pragma("unroll") for (int n = 0; n < 2; ++n) \
            acc[ai][bj][m][n] = __builtin_amdgcn_mfma_scale_f32_16x16x128_f8f6f4(PG8_GET8(BV, (Bt) + n), PG8_GET8(AV, m), acc[ai][bj][m][n], 0, 0, 0, 0, 0, 0); } \
        else { _Pragma("unroll") for (int m = 0; m < 4; ++m) _Pragma("unroll") for (int n = 0; n < 2; ++n) { \
            acc[ai][bj][m][n] = __builtin_amdgcn_mfma_f32_16x16x32_bf16(PG8_GETLO(BV, (Bt) + n), PG8_GETLO(AV, m), acc[ai][bj][m][n], 0, 0, 0); \
            acc[ai][bj][m][n] = __builtin_amdgcn_mfma_f32_16x16x32_bf16(PG8_GETHI(BV, (Bt) + n), PG8_GETHI(AV, m), acc[ai][bj][m][n], 0, 0, 0); } } \
        __builtin_amdgcn_s_setprio(0); } while (0)
#define PG8_WAIT_V(n) asm volatile("s_waitcnt vmcnt(" #n ")" ::: "memory")
#define PG8_WAIT_L(n) asm volatile("s_waitcnt lgkmcnt(" #n ")" ::: "memory")
#define PG8_BAR __builtin_amdgcn_s_barrier()
#define PG8_SCHED __builtin_amdgcn_sched_barrier(0)
    Unit cur, nxt; int ui = 0;
    if (!S.next(0, cur)) return;
    constexpr bool BL = has_bias_lds<Epi>::value;
    constexpr int NST = EH::ON ? EH::N : epi_nstores<Epi>::value;
#define PG8_WAIT_VN(n) asm volatile("s_waitcnt vmcnt(%0)" :: "n"(n) : "memory")
    static_assert(!(BL && CV::ON), "the counted waits below know one or the other");
    unsigned bx = 0;
    unsigned cx[16];
    if constexpr (CV::ON) { cv.issue(cx, lane); cv.issue_b(cx, lane); asm volatile("s_waitcnt vmcnt(0)" ::: "memory"); asm volatile("" : PG8_X16(cx) :: "memory"); }
    if constexpr (STAGGER_TICKS > 0) {
        if (blockIdx.x & 1) { const unsigned long long t0 = __builtin_amdgcn_s_memrealtime(); while (__builtin_amdgcn_s_memrealtime() - t0 < (unsigned long long)STAGGER_TICKS) __builtin_amdgcn_s_sleep(8); } }
    i32x32 AV, BV;
    constexpr int At = 0, B0 = 0, B1 = 2;
    static_assert(!GI::ON || GS::LDA == 2048, "gather: 2 KiB token rows");
    int tfetch = 0; if constexpr (GI::ON) asm volatile("s_mov_b32 %0, 0" : "=s"(tfetch));
    unsigned voP[2] = {0u, 0u}, nvP[2] = {0u, 0u}, gcb = 0u;
    if constexpr (GI::ON) { int R, C; stage_rc(tid * 16, R, C); gcb = (unsigned)(C * 2);
        const int lb = cur.pm * BM - __builtin_amdgcn_readfirstlane((int)gi.pbase[cur.e]), cn = __builtin_amdgcn_readfirstlane((int)gi.cnt[cur.e]);
        const u32x2 pr = *(const u32x2*)(gi.list + (size_t)cur.e * 16384 + lb + 4 * R);
        voP[0] = gather_clamp(pr.x, lb + R, cn); voP[1] = gather_clamp(pr.y, lb + R + 128, cn); }
    const char* cA = GI::ON ? (const char*)g.A : (const char*)g.A + (size_t)cur.pm * tstepA; const char* cB = (const char*)g.Bt + (size_t)cur.e * GS::SB + (size_t)cur.pn * tstepB;
#define PG8_KO(u) (KROT ? ((((u).pn & 7) * 2 + ((u).pm & 3) * 4) * (nt / 16)) & (nt - 1) : 0)
    int ko = PG8_KO(cur);
    { const char* pA = cA + (size_t)ko * kstep; const char* pB = cB + (size_t)ko * kstep;
    PG8_STAGE(PG8_SB(0, 0), pB, voffB); PG8_SCHED; PG8_STAGE(PG8_SB(0, 1), pB + hstepB, voffB); PG8_SCHED; PG8_STA(PG8_SA(0, 0), pA, 0, false); PG8_SCHED; PG8_STA(PG8_SA(0, 1), pA, 1, false); PG8_SCHED;
    if (wr == 1) PG8_BAR;
    PG8_WAIT_V(2); PG8_BAR;
    PG8_STAGE(PG8_SB(1, 0), pB + kstep, voffB); PG8_SCHED; PG8_STA(PG8_SA(1, 0), pA + kstep, 0, false); PG8_SCHED; PG8_STAGE(PG8_SB(1, 1), pB + hstepB + kstep, voffB); PG8_SCHED; }
    PG8_WAIT_V(6); PG8_BAR; PG8_SCHED;
    f32x4 acc[2][2][4][2];
#pragma unroll
    for (int a = 0; a < 2; ++a)
#pragma unroll
        for (int b = 0; b < 2; ++b)
#pragma unroll
            for (int m = 0; m < 4; ++m)
#pragma unroll
                for (int n = 0; n < 2; ++n) acc[a][b][m][n] = (f32x4){0.f, 0.f, 0.f, 0.f};
    for (;;) {
        const bool has_next = S.next(ui + 1, nxt);
        const char* nA = (has_next && !GI::ON) ? (const char*)g.A + (size_t)nxt.pm * tstepA : cA;
        const char* nB = has_next ? (const char*)g.Bt + (size_t)nxt.e * GS::SB + (size_t)nxt.pn * tstepB : cB;
        const int nko = has_next ? PG8_KO(nxt) : ko;
        for (int t = 0; t < nt; t += 2) {
            const bool last = (t == nt - 2);
            const int kt = KROT ? ((ko + t) & (nt - 1)) : t, kt2 = KROT ? ((ko + t + 2) & (nt - 1)) : t + 2;
            const char* a1 = cA + (size_t)(kt + 1) * kstep;
            const char* a2 = last ? nA + (size_t)nko * kstep : cA + (size_t)kt2 * kstep; const char* b2 = last ? nB + (size_t)nko * kstep : cB + (size_t)kt2 * kstep;
            const char* a3 = a2 + kstep; const char* b3 = b2 + kstep;
            PG8_LDB(B0, 0, 0); PG8_LDB(B1, 0, 1); PG8_SCHED; PG8_LDA(At, 0, 0); PG8_STA(PG8_SA(1, 1), a1, 1, false);
            PG8_WAIT_V(8);
            if constexpr (CV::ON) asm volatile("" : PG8_X16(cx));
            PG8_WAIT_L(0); PG8_BAR;
            const bool xon = CV::ON && ((t & CV_XMASK) == 0);
            if constexpr (CV::ON) { if (xon) { cv.finish(cx, lane); cv.issue(cx, lane); } }
            if constexpr (GI::ON) { if (t == tfetch && has_next) {
                int R, C; stage_rc((wid * 64 + fresh_lane()) * 16, R, C); const unsigned lvo = (unsigned)R * 8u;
                const char* lp = (const char*)(gi.list + (size_t)nxt.e * 16384 + (nxt.pm * BM - __builtin_amdgcn_readfirstlane((int)gi.pbase[nxt.e])));
                u32x2 pr; asm volatile("s_nop 4\n\tglobal_load_dwordx2 %0, %1, %2" : "=&v"(pr) : "v"(lvo), "s"(lp) : "memory"); nvP[0] = pr.x; nvP[1] = pr.y; } }
            if constexpr (BL) { if (last) { const unsigned bvo = Epi::bias_voff((wid * 64 + fresh_lane()) & 255);
                asm volatile("s_nop 4\n\tglobal_load_dword %0, %1, %2" : "=v"(bx) : "v"(bvo), "s"(E.bias_base(cur)) : "memory"); } }
            PG8_MMA(0, 0, At, B0); PG8_MMA(0, 1, At, B1); PG8_BAR; PG8_SCHED;
            PG8_LDA(At, 0, 1); PG8_STAGE(PG8_SB(0, 0), b2, voffB); PG8_STAGE(PG8_SB(0, 1), b2 + hstepB, voffB); PG8_STA(PG8_SA(0, 0), a2, 0, last);
            if (xon) PG8_WAIT_V(17); else if (BL && last) PG8_WAIT_V(9); else if (GI::ON && t == tfetch && has_next) PG8_WAIT_V(9); else PG8_WAIT_V(8);
            PG8_WAIT_L(0); PG8_BAR;
            if constexpr (CV::ON) { if (xon) cv.issue_b(cx, lane); }
            PG8_MMA(1, 0, At, B0); PG8_MMA(1, 1, At, B1); PG8_BAR; PG8_SCHED;
            PG8_LDB(B0, 1, 0); PG8_LDB(B1, 1, 1); PG8_SCHED; PG8_LDA(At, 1, 0); PG8_STA(PG8_SA(0, 1), a2, 1, last);
            if (xon) PG8_WAIT_V(25); else PG8_WAIT_V(8);
            if constexpr (GI::ON) { if (t == tfetch && has_next) { asm volatile("" : "+v"(nvP[0]), "+v"(nvP[1]));
                int R, C; stage_rc((wid * 64 + fresh_lane()) * 16, R, C); const int lb = nxt.pm * BM - __builtin_amdgcn_readfirstlane((int)gi.pbase[nxt.e]), cn = __builtin_amdgcn_readfirstlane((int)gi.cnt[nxt.e]);
                nvP[0] = gather_clamp(nvP[0], lb + R, cn); nvP[1] = gather_clamp(nvP[1], lb + R + 128, cn); } }
            if constexpr (BL) { if (last) { asm volatile("" : "+v"(bx));
                *(LAS unsigned*)(lds + BIAS_LDS_OFF + 4 * ((wid * 64 + fresh_lane()) & 255)) = bx; } }
            PG8_WAIT_L(0); PG8_BAR; PG8_MMA(0, 0, At, B0); PG8_MMA(0, 1, At, B1); PG8_BAR; PG8_SCHED;
            PG8_LDA(At, 1, 1); PG8_STAGE(PG8_SB(1, 0), b3, voffB); PG8_STAGE(PG8_SB(1, 1), b3 + hstepB, voffB); PG8_STA(PG8_SA(1, 0), a3, 0, last);
            if constexpr (CV::ON) { if (xon) PG8_WAIT_V(16); else PG8_WAIT_V(8); } else PG8_WAIT_V(8);
            PG8_WAIT_L(0); PG8_BAR; PG8_MMA(1, 0, At, B0); PG8_MMA(1, 1, At, B1); PG8_BAR; PG8_SCHED;
        }
        if constexpr (ALIGN_EPI) { if (wr == 0) PG8_BAR; }
        { const int l2 = fresh_lane();
          const LAS float* bl = (const LAS float*)(lds + BIAS_LDS_OFF);
          if constexpr (EH::ON) {
              unsigned ex[16 * EH::N]; eh.issue(ex, l2);
              typename Epi::Bias eb; E.load_bias(cur, wc, l2 >> 4, eb, bl);
              E.apply(acc, cur, wr, wc, l2 & 15, l2 >> 4, eb);
              asm volatile("s_waitcnt vmcnt(0)" ::: "memory");
              if constexpr (EH::N == 3) asm volatile("" : PG8_X16A(ex, 0), PG8_X16A(ex, 16), PG8_X16A(ex, 32) :: "memory");
              else asm volatile("" : PG8_X16A(ex, 0), PG8_X16A(ex, 16), PG8_X16A(ex, 32), PG8_X16A(ex, 48) :: "memory");
              eh.finish(ex, l2);
          } else if constexpr (BL) E(acc, cur, wr, wc, l2 & 15, l2 >> 4, bl);
          else E(acc, cur, wr, wc, l2 & 15, l2 >> 4); }
        if (!has_next) break;
#pragma unroll
        for (int a = 0; a < 2; ++a)
#pragma unroll
            for (int b = 0; b < 2; ++b)
#pragma unroll
                for (int m = 0; m < 4; ++m)
#pragma unroll
                    for (int n = 0; n < 2; ++n) acc[a][b][m][n] = (f32x4){0.f, 0.f, 0.f, 0.f};
        cur = nxt; cA = nA; cB = nB; ko = nko; ++ui;
        if constexpr (GI::ON) {
#pragma unroll
            for (int i = 0; i < 2; ++i) voP[i] = nvP[i]; }
        if constexpr (ALIGN_EPI) { if (wr == 1) PG8_BAR; }
    }
    if constexpr (CV::ON) { asm volatile("s_waitcnt vmcnt(0)" ::: "memory"); asm volatile("" : PG8_X16(cx) :: "memory"); cv.finish(cx, lane); }
    else PG8_WAIT_V(0);
    if constexpr (!ALIGN_EPI) { if (wr == 0) PG8_BAR; }
    PG8_BAR;
#undef PG8_SA
#undef PG8_KO
#undef PG8_SB
#undef PG8_STAGE
#undef PG8_STAGE_GA
#undef PG8_STA
#undef pstepvoffA
#undef pstepvoffB
#undef voffA_v
#undef voffB_v
#undef PG8_LDA
#undef PG8_LD16
#undef PG8_SET8
#undef PG8_GET8
#undef PG8_GETLO
#undef PG8_GETHI
#undef PG8_LDB
#undef PG8_MMA
#undef PG8_WAIT_V
#undef PG8_WAIT_VN
#undef PG8_WAIT_L
#undef PG8_BAR
#undef PG8_SCHED
}
}
struct Params {
    const float* in[22];
    float* out; unsigned char* ws;
    int ph_lo, ph_hi;
};
enum { I_X = 0, I_NMG, I_WIN, I_GWG, I_GBG, I_GNG, I_CW, I_CB, I_WA, I_BA, I_WI, I_BI, I_AP, I_WOUT, I_NFG, I_WR, I_BR, I_WGU, I_BGU, I_WDN, I_BDN, I_NFINAL };

struct Frame {
    LAS unsigned char* lds; volatile LAS unsigned* MISC;
    int tid, lane, wave, G, gw, NGW;
    unsigned char* ws;
};

__device__ __forceinline__ float gelu_tanh_f(float x) {
    const float u = 0.7978845608028654f * (x + 0.044715f * x * x * x);
    const float e = __expf(2.0f * u);
    const float th = 1.0f - 2.0f * __builtin_amdgcn_rcpf(e + 1.0f);
    return 0.5f * x * (1.0f + th);
}
__device__ __forceinline__ float log_sigmoid_f(float s) { return fminf(s, 0.f) - __logf(1.0f + __expf(-fabsf(s))); }

__device__ __forceinline__ void p0_item(const float* W, int ldw, int col0, bf16_t* WT, int ldt, size_t drow0, int k0, LAS float* scr, int lane) {
    (void)scr;
    const float* src = W + (size_t)k0 * ldw + col0 + lane;
    float v[64];
#pragma unroll
    for (int i = 0; i < 64; ++i) v[i] = src[(size_t)i * ldw];
    bf16_t* dst = WT + (drow0 + lane) * (size_t)ldt + k0;
#pragma unroll
    for (int c = 0; c < 8; ++c) { u32x4 o; o.x = pk2(v[8 * c], v[8 * c + 1]); o.y = pk2(v[8 * c + 2], v[8 * c + 3]); o.z = pk2(v[8 * c + 4], v[8 * c + 5]); o.w = pk2(v[8 * c + 6], v[8 * c + 7]);
        *(u32x4*)(dst + 8 * c) = o; }
}

__device__ __forceinline__ void p0_item8(const float* W, int ldw, int col0, unsigned char* WT, int ldt, size_t drow0, int k0, int lane) {
    const float* src = W + (size_t)k0 * ldw + col0 + lane;
    float v[64];
#pragma unroll
    for (int i = 0; i < 64; ++i) v[i] = src[(size_t)i * ldw];
    unsigned char* dst = WT + (drow0 + lane) * (size_t)ldt + k0;
#pragma unroll
    for (int c = 0; c < 4; ++c) { u32x4 o;
#pragma unroll
        for (int q = 0; q < 4; ++q) o[q] = pk4_fp8(v[16 * c + 4 * q] * 512.0f, v[16 * c + 4 * q + 1] * 512.0f, v[16 * c + 4 * q + 2] * 512.0f, v[16 * c + 4 * q + 3] * 512.0f);
        *(u32x4*)(dst + 16 * c) = o; }
}

constexpr int CONV_EXPERTS_P0 = 28, HOST_DN_EXPERTS_P0 = 24;
struct CoopTile { const float* W; int ldw; int col0; unsigned char* WT; int ldt_b; int mode; int k0; int gu; int drow0; };
__device__ __forceinline__ void coop_load(const CoopTile& t, int w, int l, f32x4 (&v)[16]) {
    if (t.mode == 0) {
#pragma unroll
        for (int i = 0; i < 8; ++i) { const float* r = t.W + (size_t)(t.k0 + 8 * w + i) * t.ldw + t.col0 + 4 * l; v[2 * i] = *(const f32x4*)r; v[2 * i + 1] = *(const f32x4*)(r + 256); }
    } else {
#pragma unroll
        for (int i = 0; i < 16; ++i) v[i] = *(const f32x4*)(t.W + (size_t)(t.k0 + 16 * w + i) * t.ldw + t.col0 + 4 * l);
    }
}
__device__ __forceinline__ void coop_to_lds(const CoopTile& t, int w, int l, const f32x4 (&v)[16], LAS unsigned char* buf) {
    const int sw = (w ^ (l & 7)) * 16;
    if (t.mode == 0) {
#pragma unroll
        for (int jp = 0; jp < 2; ++jp)
#pragma unroll
            for (int j = 0; j < 4; ++j) { u32x4 o; if (t.ldw == INC) { o.x = PK2W(v[0 + jp][j], v[2 + jp][j]); o.y = PK2W(v[4 + jp][j], v[6 + jp][j]); o.z = PK2W(v[8 + jp][j], v[10 + jp][j]); o.w = PK2W(v[12 + jp][j], v[14 + jp][j]); } else { o.x = pk2(v[0 + jp][j], v[2 + jp][j]); o.y = pk2(v[4 + jp][j], v[6 + jp][j]); o.z = pk2(v[8 + jp][j], v[10 + jp][j]); o.w = pk2(v[12 + jp][j], v[14 + jp][j]); }
                *(LAS u32x4*)(buf + (256 * jp + 4 * l + j) * 128 + sw) = o; }
    } else {
#pragma unroll
        for (int j = 0; j < 4; ++j) { u32x4 o;
#pragma unroll
            for (int q = 0; q < 4; ++q) o[q] = pk4_fp8(v[4 * q][j] * 512.0f, v[4 * q + 1][j] * 512.0f, v[4 * q + 2][j] * 512.0f, v[4 * q + 3][j] * 512.0f);
            *(LAS u32x4*)(buf + (4 * l + j) * 128 + sw) = o; }
    }
}
__device__ __forceinline__ void coop_store(const CoopTile& t, int w, int l, const LAS unsigned char* buf) {
    const int nrows = t.mode == 0 ? 512 : 256; const int cp = l & 7;
    for (int n = 8 * w + (l >> 3); n < nrows; n += 64) {
        const u32x4 o = *(const LAS u32x4*)(buf + n * 128 + cp * 16); const int c = cp ^ ((n >> 2) & 7);
        int drow;
        if (t.gu) { const int g = t.col0 + n; drow = (g < 2048) ? (256 * (g >> 7) + (g & 127)) : (256 * ((g - 2048) >> 7) + 128 + ((g - 2048) & 127)); } else drow = t.drow0 + n;
        *(u32x4*)(t.WT + (size_t)drow * t.ldt_b + (t.mode == 0 ? 2 * t.k0 : t.k0) + 16 * c) = o; }
}
__device__ __forceinline__ bool coop_tile(const Params& p, unsigned char* ws, int it, CoopTile& t) {
    constexpr int N_GU = (32 - CONV_EXPERTS_P0) * 256, N_DN = (32 - HOST_DN_EXPERTS_P0) * 128, N_INA = 32 * 6, N_INB = 32 * 4, N_OUT = 32 * 4;
    int r = it;
    if (r < N_GU) { const int e = CONV_EXPERTS_P0 + (r >> 8), q = r & 255, kb = q >> 4, nb = q & 15; t = CoopTile{p.in[I_WGU] + (size_t)e * DM * 4096, 4096, 256 * nb, ws + WS_WGUT + (size_t)e * 4096 * DM, DM, 1, 128 * kb, 1, 0}; return true; } r -= N_GU;
    if (r < N_DN) { const int e = HOST_DN_EXPERTS_P0 + (r >> 7), q = r & 127, kb = q >> 3, nb = q & 7; t = CoopTile{p.in[I_WDN] + (size_t)e * DM * DM, DM, 256 * nb, ws + WS_WDT + (size_t)e * DM * DM, DM, 1, 128 * kb, 0, 256 * nb}; return true; } r -= N_DN;
    if (r < N_INA) { const int kb = r / 6, nb = r % 6; t = CoopTile{p.in[I_WIN], INC, 512 * nb, ws + WS_WINT, DM * 2, 0, 64 * kb, 0, 512 * nb}; return true; } r -= N_INA;
    if (r < N_INB) { const int kb = r >> 2, nb = r & 3; t = CoopTile{p.in[I_WIN], INC, 3088 + 512 * nb, ws + WS_WINT, DM * 2, 0, 64 * kb, 0, 3072 + 512 * nb}; return true; } r -= N_INB;
    if (r < N_OUT) { const int kb = r >> 2, nb = r & 3; t = CoopTile{p.in[I_WOUT], DM, 512 * nb, ws + WS_WOUTT, DM * 2, 0, 64 * kb, 0, 512 * nb}; return true; }
    return false;
}
__device__ __forceinline__ void p0a(Frame& F, const Params& p) {
    const int w = F.wave, l = F.lane;
    CoopTile cur, nxt; f32x4 v[16];
    int it = blockIdx.x; bool have = coop_tile(p, F.ws, it, cur);
    if (have) coop_load(cur, w, l, v);
    int par = 0;
    while (have) {
        LAS unsigned char* buf = F.lds + par * 65536;
        coop_to_lds(cur, w, l, v, buf);
        it += F.G; const bool hn = coop_tile(p, F.ws, it, nxt);
        if (hn) coop_load(nxt, w, l, v);
        __syncthreads();
        coop_store(cur, w, l, buf);
        cur = nxt; have = hn; par ^= 1;
    }
    __syncthreads();
    { bf16_t* WaT = (bf16_t*)(F.ws + WS_WAT); bf16_t* WiT = (bf16_t*)(F.ws + WS_WIT);
      for (int r = F.gw; r < 128; r += F.NGW) { const int which = r >> 6, h = (r >> 4) & 3, kb = (r >> 2) & 3, nb = r & 3;
          p0_item((which ? p.in[I_WI] : p.in[I_WA]) + (size_t)h * 65536, 256, 64 * nb, (which ? WiT : WaT) + (size_t)h * 65536, 256, (size_t)64 * nb, 64 * kb, nullptr, F.lane); } }
    { bf16_t* WglT = (bf16_t*)(F.ws + WS_WGLT); const float* w_in = p.in[I_WIN];
      for (int idx = (int)blockIdx.x * 512 + F.tid; idx < 16 * DM; idx += F.G * 512) { const int cc = idx >> 11, k = idx & 2047; WglT[idx] = (bf16_t)f2bf(w_in[(size_t)k * INC + 3072 + cc]); } }
    { float* WrT = (float*)(F.ws + WS_WRT); const float* wr = p.in[I_WR]; const float* gf = p.in[I_NFG];
      for (int idx = (int)blockIdx.x * 512 + F.tid; idx < 32 * DM; idx += F.G * 512) { const int n = idx >> 11, k = idx & 2047; WrT[idx] = wr[k * 32 + n] * gf[k]; } }
}
__device__ __forceinline__ void p0b(Frame& F, const Params& p) {
    const float* x = p.in[I_X]; const float* g1 = p.in[I_NMG]; bf16_t* H = (bf16_t*)(F.ws + WS_H);
    const int l = F.lane;
    f32x4 gv[8], xn[8];
#pragma unroll
    for (int j = 0; j < 4; ++j) { gv[2 * j] = *(const f32x4*)(g1 + 8 * l + 512 * j); gv[2 * j + 1] = *(const f32x4*)(g1 + 8 * l + 512 * j + 4); }
#pragma unroll
    for (int j = 0; j < 4; ++j) { xn[2 * j] = (F.gw < T) ? *(const f32x4*)(x + (size_t)F.gw * DM + 8 * l + 512 * j) : (f32x4){0.f, 0.f, 0.f, 0.f}; xn[2 * j + 1] = (F.gw < T) ? *(const f32x4*)(x + (size_t)F.gw * DM + 8 * l + 512 * j + 4) : (f32x4){0.f, 0.f, 0.f, 0.f}; }
    for (int m = F.gw; m < T; m += F.NGW) {
        f32x4 xv[8]; float ss = 0.f;
#pragma unroll
        for (int j = 0; j < 8; ++j) { xv[j] = xn[j]; ss += (xv[j][0] * xv[j][0] + xv[j][1] * xv[j][1]) + (xv[j][2] * xv[j][2] + xv[j][3] * xv[j][3]); }
        if (m + F.NGW < T) {
#pragma unroll
            for (int j = 0; j < 4; ++j) { xn[2 * j] = *(const f32x4*)(x + (size_t)(m + F.NGW) * DM + 8 * l + 512 * j); xn[2 * j + 1] = *(const f32x4*)(x + (size_t)(m + F.NGW) * DM + 8 * l + 512 * j + 4); } }
        const float rs = rsqrtf_(wave_sum(ss) * (1.0f / DM) + 1e-6f);
#pragma unroll
        for (int j = 0; j < 4; ++j) { const f32x4 a = xv[2 * j] * rs * gv[2 * j], b = xv[2 * j + 1] * rs * gv[2 * j + 1];
            u32x4 o; o.x = pk2(a[0], a[1]); o.y = pk2(a[2], a[3]); o.z = pk2(b[0], b[1]); o.w = pk2(b[2], b[3]);
            *(u32x4*)(H + (size_t)m * DM + 8 * l + 512 * j) = o;
#ifdef SIM_FP8
            o.x = PK2A(a[0], a[1]); o.y = PK2A(a[2], a[3]); o.z = PK2A(b[0], b[1]); o.w = PK2A(b[2], b[3]); *(u32x4*)((bf16_t*)(F.ws + WS_MIX) + (size_t)m * DM + 8 * l + 512 * j) = o;
#endif
            }
    }
}

__device__ __forceinline__ void gla_cumsum(const LAS float* GL, const float* wg, const float* bgp, int h, LAS float* BC, LAS float* SEG, int tid) {
    const int seg = tid >> 7, kk = tid & 127;
    float wcol[16];
#pragma unroll
    for (int c = 0; c < 16; ++c) wcol[c] = wg[c * 512 + h * 128 + kk];
    const float bcol = bgp[h * 128 + kk];
    float v[16];
#pragma unroll
    for (int i = 0; i < 16; ++i) { const LAS f32x4* g4 = (const LAS f32x4*)(GL + (16 * seg + i) * 16); float sacc = bcol;
#pragma unroll
        for (int c4 = 0; c4 < 4; ++c4) { const f32x4 gq = g4[c4]; sacc += gq[0] * wcol[4 * c4] + gq[1] * wcol[4 * c4 + 1] + gq[2] * wcol[4 * c4 + 2] + gq[3] * wcol[4 * c4 + 3]; }
        v[i] = log_sigmoid_f(sacc) * 0.0625f; }
#pragma unroll
    for (int i = 1; i < 16; ++i) v[i] += v[i - 1];
    SEG[seg * 128 + kk] = v[15];
    __syncthreads();
    float off = 0.f;
#pragma unroll
    for (int s = 0; s < 3; ++s) off += (s < seg) ? SEG[s * 128 + kk] : 0.f;
#pragma unroll
    for (int i = 0; i < 16; ++i) BC[(16 * seg + i) * 128 + kk] = v[i] + off;
    __syncthreads();
}
__device__ __forceinline__ bf16x8 as_bf16x8(u32x4 v) { return __builtin_bit_cast(bf16x8, v); }
__device__ __forceinline__ bf16x8 cat4(bf16x4 lo, bf16x4 hi) { return __builtin_shufflevector(lo, hi, 0, 1, 2, 3, 4, 5, 6, 7); }

__device__ __forceinline__ void p2a(Frame& F, const Params& p) {
    const bf16_t* Z = (const bf16_t*)(F.ws + WS_Z);
    bf16_t* AN = (bf16_t*)(F.ws + WS_AN); float* DN = (float*)(F.ws + WS_DN);
    const bf16_t* WaT = (const bf16_t*)(F.ws + WS_WAT); const bf16_t* WiT = (const bf16_t*)(F.ws + WS_WIT);
    LAS float* BC = (LAS float*)(F.lds); LAS float* SEG = (LAS float*)(F.lds + 32768);
    LAS bf16_t* KDT = (LAS bf16_t*)(F.lds + 34816); LAS bf16_t* VT = (LAS bf16_t*)(F.lds + 53248); LAS bf16_t* XC = (LAS bf16_t*)(F.lds + 90112);
    const int w = F.wave;
    LAS float* GLR = (LAS float*)(F.lds + 90112);
    LAS float* GL = (LAS float*)(F.lds + 124928);
    const float* wg = p.in[I_GWG]; const float* bgp = p.in[I_GBG];
    for (int unit = blockIdx.x; unit < NCHUNK; unit += F.G) {
        const int b = unit >> 7, n = unit & 127, tok0 = b * SEQL + 64 * n;
        {
            const int lane = fresh_lane(), r16 = lane & 15, q4 = lane >> 4;
            const bf16_t* Hb = (const bf16_t*)(F.ws + WS_H) + (size_t)(tok0 + r16) * DM + 256 * w + 8 * q4;
            const bf16_t* Wb = (const bf16_t*)(F.ws + WS_WGLT) + (size_t)r16 * DM + 256 * w + 8 * q4;
            f32x4 gacc[4];
#pragma unroll
            for (int mb = 0; mb < 4; ++mb) gacc[mb] = (f32x4){0.f, 0.f, 0.f, 0.f};
#pragma unroll
            for (int sb = 0; sb < 2; ++sb) { bf16x8 af[4][4], bfr[4];
#pragma unroll
                for (int s4 = 0; s4 < 4; ++s4) { bfr[s4] = *(const bf16x8*)(Wb + 32 * (4 * sb + s4));
#pragma unroll
                    for (int mb = 0; mb < 4; ++mb) af[s4][mb] = *(const bf16x8*)(Hb + (size_t)(16 * mb) * DM + 32 * (4 * sb + s4)); }
#pragma unroll
                for (int s4 = 0; s4 < 4; ++s4)
#pragma unroll
                    for (int mb = 0; mb < 4; ++mb) gacc[mb] = __builtin_amdgcn_mfma_f32_16x16x32_bf16(af[s4][mb], bfr[s4], gacc[mb], 0, 0, 0); }
#pragma unroll
            for (int mb = 0; mb < 4; ++mb)
#pragma unroll
                for (int q = 0; q < 4; ++q) GLR[(w * 64 + 16 * mb + 4 * q4 + q) * 16 + r16] = gacc[mb][q];
            __syncthreads();
            const int tid2 = w * 64 + lane;
#pragma unroll
            for (int it = 0; it < 2; ++it) { const int o = tid2 + 512 * it; float sacc = 0.f;
#pragma unroll
                for (int w2 = 0; w2 < 8; ++w2) sacc += GLR[w2 * 1024 + o];
                GL[o] = sacc; ((float*)(F.ws + WS_LG))[(size_t)tok0 * 16 + o] = sacc; }
            __syncthreads();
        }
        for (int h = 0; h < 4; ++h) {
            int lane = fresh_lane(), tid = F.wave * 64 + lane;
            int r = lane & 31, hh = lane >> 5;
            u32x4 kvr[2], vvr[4];
#pragma unroll
            for (int it = 0; it < 2; ++it) { const int item = tid + 512 * it, t = item & 63, kk8 = item >> 6; kvr[it] = *(const u32x4*)(Z + (size_t)(tok0 + t) * ZC + ZK + h * 128 + kk8 * 8); }
#pragma unroll
            for (int it = 0; it < 4; ++it) { const int item = tid + 512 * it, t = item & 63, vc8 = item >> 6; vvr[it] = *(const u32x4*)(Z + (size_t)(tok0 + t) * ZC + ZV + h * 256 + vc8 * 8); }
            gla_cumsum(GL, wg, bgp, h, BC, SEG, tid);
            const int uh = (b * 4 + h) * 128 + n;
            if (tid < 128) DN[(size_t)uh * 128 + tid] = __expf(BC[63 * 128 + tid]);
#pragma unroll
            for (int it = 0; it < 2; ++it) { const int item = tid + 512 * it, t = item & 63, kk8 = item >> 6;
                const u32x4 kv = kvr[it];
#pragma unroll
                for (int i = 0; i < 8; ++i) { const int kk = kk8 * 8 + i; const unsigned wv = kv[i >> 1]; const float kf = (i & 1) ? bfhi(wv) : bflo(wv);
                    const float d = __expf(BC[63 * 128 + kk] - BC[t * 128 + kk]); KDT[kk * 72 + t] = (bf16_t)f2bf(kf * d); } }
#pragma unroll
            for (int it = 0; it < 4; ++it) { const int item = tid + 512 * it, t = item & 63, vc8 = item >> 6;
                const u32x4 vv = vvr[it];
#pragma unroll
                for (int i = 0; i < 8; ++i) { const unsigned wv = vv[i >> 1]; VT[(vc8 * 8 + i) * 72 + t] = (bf16_t)((i & 1) ? (wv >> 16) : (wv & 0xffffu)); } }
#ifndef P2A_NO_LRU
            u32x4 lv[7]; f32x4 cwv[4][2], cbv[2];
            { const float* cw = p.in[I_CW]; const float* cb = p.in[I_CB]; const int c8 = tid & 31, tq = tid >> 5, chc = h * 256 + c8 * 8;
#pragma unroll
              for (int i = 0; i < 7; ++i) { const int sq = 64 * n + 4 * tq - 3 + i;
                  lv[i] = (sq >= 0) ? *(const u32x4*)(Z + (size_t)(tok0 + 4 * tq - 3 + i) * ZC + ZLX + chc) : (u32x4){0u, 0u, 0u, 0u}; }
#pragma unroll
              for (int i = 0; i < 4; ++i) { cwv[i][0] = *(const f32x4*)(cw + i * 1024 + chc); cwv[i][1] = *(const f32x4*)(cw + i * 1024 + chc + 4); }
              cbv[0] = *(const f32x4*)(cb + chc); cbv[1] = *(const f32x4*)(cb + chc + 4); }
#endif
            __syncthreads();
            {
                f32x16 acc[4];
#pragma unroll
                for (int mb = 0; mb < 4; ++mb)
#pragma unroll
                    for (int q = 0; q < 16; ++q) acc[mb][q] = 0.f;
#pragma unroll
                for (int s = 0; s < 4; ++s) { const bf16x8 bfr = *(const LAS bf16x8*)(VT + (32 * w + r) * 72 + 16 * s + 8 * hh);
#pragma unroll
                    for (int mb = 0; mb < 4; ++mb) { const bf16x8 afr = *(const LAS bf16x8*)(KDT + (32 * mb + r) * 72 + 16 * s + 8 * hh);
                        acc[mb] = __builtin_amdgcn_mfma_f32_32x32x16_bf16(afr, bfr, acc[mb], 0, 0, 0); } }
                bf16_t* base = AN + (size_t)uh * 32768;
#pragma unroll
                for (int mb = 0; mb < 4; ++mb)
#pragma unroll
                    for (int s2 = 0; s2 < 2; ++s2) { u32x4 o;
#pragma unroll
                        for (int q = 0; q < 4; ++q) o[q] = pk2(acc[mb][8 * s2 + 2 * q], acc[mb][8 * s2 + 2 * q + 1]);
                        *(u32x4*)(base + (((mb * 8 + w) * 2 + s2) * 64 + lane) * 8) = o; }
            }
#ifndef P2A_NO_LRU
            {
                {
                    const int c8 = tid & 31, tq = tid >> 5;
#pragma unroll
                    for (int it = 0; it < 4; ++it) { float xc[8];
#pragma unroll
                        for (int q = 0; q < 4; ++q) { xc[q] = cbv[0][q]; xc[4 + q] = cbv[1][q]; }
#pragma unroll
                        for (int i = 0; i < 4; ++i) { const u32x4 l4 = lv[it + i];
                            xc[0] += bflo(l4[0]) * cwv[i][0][0]; xc[1] += bfhi(l4[0]) * cwv[i][0][1]; xc[2] += bflo(l4[1]) * cwv[i][0][2]; xc[3] += bfhi(l4[1]) * cwv[i][0][3];
                            xc[4] += bflo(l4[2]) * cwv[i][1][0]; xc[5] += bfhi(l4[2]) * cwv[i][1][1]; xc[6] += bflo(l4[3]) * cwv[i][1][2]; xc[7] += bfhi(l4[3]) * cwv[i][1][3]; }
                        u32x4 o; o.x = pk2(xc[0], xc[1]); o.y = pk2(xc[2], xc[3]); o.z = pk2(xc[4], xc[5]); o.w = pk2(xc[6], xc[7]);
                        *(LAS u32x4*)(XC + (4 * tq + it) * 264 + c8 * 8) = o; }
                }
                __builtin_amdgcn_sched_barrier(0);
                bf16x8 ba[16], bi[16];
                { const bf16_t* wa = WaT + (size_t)h * 65536 + (size_t)(32 * w + r) * 256 + 8 * hh;
                  const bf16_t* wi = WiT + (size_t)h * 65536 + (size_t)(32 * w + r) * 256 + 8 * hh;
#pragma unroll
                  for (int s = 0; s < 16; ++s) { ba[s] = *(const bf16x8*)(wa + 16 * s); bi[s] = *(const bf16x8*)(wi + 16 * s); } }
                __syncthreads();
                f32x16 aa[2], ai[2];
#pragma unroll
                for (int mb = 0; mb < 2; ++mb)
#pragma unroll
                    for (int q = 0; q < 16; ++q) { aa[mb][q] = 0.f; ai[mb][q] = 0.f; }
#pragma unroll
                for (int s = 0; s < 16; ++s) {
#pragma unroll
                    for (int mb = 0; mb < 2; ++mb) { const bf16x8 af = *(const LAS bf16x8*)(XC + (32 * mb + r) * 264 + 16 * s + 8 * hh);
                        aa[mb] = __builtin_amdgcn_mfma_f32_32x32x16_bf16(af, ba[s], aa[mb], 0, 0, 0); } }
                __builtin_amdgcn_sched_barrier(0);
#pragma unroll
                for (int s = 0; s < 16; ++s) {
#pragma unroll
                    for (int mb = 0; mb < 2; ++mb) { const bf16x8 af = *(const LAS bf16x8*)(XC + (32 * mb + r) * 264 + 16 * s + 8 * hh);
                        ai[mb] = __builtin_amdgcn_mfma_f32_32x32x16_bf16(af, bi[s], ai[mb], 0, 0, 0); } }
                const int ch = h * 256 + 32 * w + r;
                const float ba_ = p.in[I_BA][ch], bi_ = p.in[I_BI][ch]; const float L = p.in[I_AP][ch];
                const float sp = fmaxf(-L, 0.f) + log1pf(__expf(-fabsf(L)));
#pragma unroll
                for (int mb = 0; mb < 2; ++mb)
#pragma unroll
                    for (int q = 0; q < 16; ++q) { const int t = 32 * mb + (q & 3) + 8 * (q >> 2) + 4 * hh;
                        if ((q & 3) == 0) __builtin_amdgcn_sched_barrier(0);
                        const float ga = sigmoidf_(aa[mb][q] + ba_), gi = sigmoidf_(ai[mb][q] + bi_);
                        const float la = -8.0f * ga * sp; const float a = __expf(la);
                        const float xcv = bf2f(XC[t * 264 + 32 * w + r]);
                        aa[mb][q] = a; ai[mb][q] = xcv * gi * __builtin_amdgcn_sqrtf(fmaxf(1.0f - a * a, 0.f)); }
#pragma unroll
                for (int mb = 0; mb < 2; ++mb)
#pragma unroll
                    for (int g = 0; g < 4; ++g)
#pragma unroll
                        for (int i = 1; i < 4; ++i) { const int q = 4 * g + i; ai[mb][q] = aa[mb][q] * ai[mb][q - 1] + ai[mb][q]; aa[mb][q] = aa[mb][q] * aa[mb][q - 1]; }
                LAS bf16_t* HL = (LAS bf16_t*)(F.lds); LAS bf16_t* AC = (LAS bf16_t*)(F.lds + 34816);
                float carryH = 0.f, carryP = 1.f;
#pragma unroll
                for (int mb = 0; mb < 2; ++mb)
#pragma unroll
                    for (int g = 0; g < 4; ++g) { const float myP = aa[mb][4 * g + 3], myH = ai[mb][4 * g + 3];
                        const float pP = __shfl_xor(myP, 32), pH = __shfl_xor(myH, 32);
                        const float fP = hh ? pP : myP, fH = hh ? pH : myH, sP = hh ? myP : pP, sH = hh ? myH : pH;
                        const float c1H = fP * carryH + fH, c1P = carryP * fP;
                        const float Cin = hh ? c1H : carryH, Pin = hh ? c1P : carryP;
                        carryH = sP * c1H + sH; carryP = c1P * sP;
#pragma unroll
                        for (int i = 0; i < 4; ++i) { const int q = 4 * g + i, t = 32 * mb + 8 * g + 4 * hh + i;
                            HL[t * 264 + 32 * w + r] = (bf16_t)f2bf(ai[mb][q] + aa[mb][q] * Cin); AC[t * 264 + 32 * w + r] = (bf16_t)f2bf(aa[mb][q] * Pin); } }
                if (hh == 0) { float* SUMA = (float*)(F.ws + WS_SUMA); float* SUMH = (float*)(F.ws + WS_SUMH); SUMA[unit * 1024 + ch] = carryP; SUMH[unit * 1024 + ch] = carryH; }
                __syncthreads();
                { bf16_t* HLOC = (bf16_t*)(F.ws + WS_AUA); bf16_t* ACUM = (bf16_t*)(F.ws + WS_AUU);
#pragma unroll
                  for (int it = 0; it < 4; ++it) { const int item = tid + 512 * it, c8 = item & 31, t = item >> 5; const size_t o = (size_t)(tok0 + t) * 1024 + h * 256 + c8 * 8;
                      *(u32x4*)(HLOC + o) = *(const LAS u32x4*)(HL + t * 264 + c8 * 8); *(u32x4*)(ACUM + o) = *(const LAS u32x4*)(AC + t * 264 + c8 * 8); } }
            }
#endif
            __syncthreads();
        }
    }
}

__device__ __forceinline__ void p2b(Frame& F, const Params& p) {
    const bf16_t* AN = (const bf16_t*)(F.ws + WS_AN); const float* DN = (const float*)(F.ws + WS_DN); bf16_t* SP = (bf16_t*)(F.ws + WS_SP);
    if (F.tid < 128) {
        for (int st = (int)blockIdx.x * 128 + F.tid; st < 32768; st += F.G * 128) {
            const int bh = st >> 12, rem = st & 4095, ln = rem & 63, s2 = (rem >> 6) & 1, w = (rem >> 7) & 7, mb = (rem >> 10) & 3;
            const int kk0 = 32 * mb + 16 * s2 + 4 * (ln >> 5);
            const int offS = (((mb * 8 + w) * 2 + s2) * 64 + ln) * 8;
            f32x4 S0 = (f32x4){0.f, 0.f, 0.f, 0.f}, S1 = S0;
            for (int n0 = 0; n0 < 128; n0 += 8) {
                u32x4 av[8]; f32x4 d0[8], d1[8];
#pragma unroll
                for (int i = 0; i < 8; ++i) { const size_t uh = (size_t)bh * 128 + n0 + i;
                    av[i] = *(const u32x4*)(AN + uh * 32768 + offS);
                    d0[i] = *(const f32x4*)(DN + uh * 128 + kk0); d1[i] = *(const f32x4*)(DN + uh * 128 + kk0 + 8); }
#pragma unroll
                for (int i = 0; i < 8; ++i) { const size_t uh = (size_t)bh * 128 + n0 + i;
                    u32x4 o; o.x = pk2(S0[0], S0[1]); o.y = pk2(S0[2], S0[3]); o.z = pk2(S1[0], S1[1]); o.w = pk2(S1[2], S1[3]);
                    *(u32x4*)(SP + uh * 32768 + offS) = o;
                    const f32x4 a0 = (f32x4){bflo(av[i].x), bfhi(av[i].x), bflo(av[i].y), bfhi(av[i].y)}, a1 = (f32x4){bflo(av[i].z), bfhi(av[i].z), bflo(av[i].w), bfhi(av[i].w)};
                    S0 = d0[i] * S0 + a0; S1 = d1[i] * S1 + a1; } }
        }
    }
}

__device__ __forceinline__ void p2c(Frame& F, const Params& p) {
    const bf16_t* Z = (const bf16_t*)(F.ws + WS_Z); const float* GLOW = (const float*)(F.ws + WS_LG); const bf16_t* SP = (const bf16_t*)(F.ws + WS_SP);
    LAS float* GL = (LAS float*)(F.lds + 124928); const float* wg = p.in[I_GWG]; const float* bgp = p.in[I_GBG];
    bf16_t* MIX = (bf16_t*)(F.ws + WS_MIX);
    LAS float* BC = (LAS float*)(F.lds); LAS float* SEG = (LAS float*)(F.lds + 32768);
    LAS bf16_t* QE = (LAS bf16_t*)(F.lds + 34816); LAS bf16_t* KE = (LAS bf16_t*)(F.lds + 52224); LAS bf16_t* VT = (LAS bf16_t*)(F.lds + 69632);
    LAS float* SSQ = (LAS float*)(F.lds + 106496); LAS float* OS = (LAS float*)(F.lds);
    const int w = F.wave;
    const float* gng = p.in[I_GNG];
    for (int unit = blockIdx.x; unit < NCHUNK; unit += F.G) {
        const int b = unit >> 7, n = unit & 127, tok0 = b * SEQL + 64 * n;
        const int lane = fresh_lane(), tid = w * 64 + lane, r = lane & 31, hh = lane >> 5;
        { const float* SUMA = (const float*)(F.ws + WS_SUMA); const float* SUMH = (const float*)(F.ws + WS_SUMH);
          const int ch = 2 * tid; f32x2 hc = (f32x2){0.f, 0.f};
          int c2 = unit & ~127;
          for (; c2 + 16 <= unit; c2 += 16) { f32x2 a[16], hv[16];
#pragma unroll
              for (int q = 0; q < 16; ++q) { a[q] = *(const f32x2*)(SUMA + (c2 + q) * 1024 + ch); hv[q] = *(const f32x2*)(SUMH + (c2 + q) * 1024 + ch); }
#pragma unroll
              for (int q = 0; q < 16; ++q) hc = a[q] * hc + hv[q]; }
          { f32x2 a[16], hv[16];
#pragma unroll
              for (int q = 0; q < 16; ++q) { const bool ok = (c2 + q) < unit; a[q] = ok ? *(const f32x2*)(SUMA + (c2 + q) * 1024 + ch) : (f32x2){1.f, 1.f}; hv[q] = ok ? *(const f32x2*)(SUMH + (c2 + q) * 1024 + ch) : (f32x2){0.f, 0.f}; }
#pragma unroll
              for (int q = 0; q < 16; ++q) hc = a[q] * hc + hv[q]; }
          const bf16_t* HLOC = (const bf16_t*)(F.ws + WS_AUA); const bf16_t* ACUM = (const bf16_t*)(F.ws + WS_AUU);
          for (int t0 = 0; t0 < 64; t0 += 16) {
              unsigned hv[16], av[16], lgw[16];
#pragma unroll
              for (int i = 0; i < 16; ++i) { const size_t tok = (size_t)tok0 + t0 + i;
                  hv[i] = *(const unsigned*)(HLOC + tok * 1024 + ch); av[i] = *(const unsigned*)(ACUM + tok * 1024 + ch); lgw[i] = *(const unsigned*)(Z + tok * ZC + ZLG + ch); }
#pragma unroll
              for (int i = 0; i < 16; ++i) { const size_t tok = (size_t)tok0 + t0 + i;
                  const float h0 = bflo(hv[i]) + bflo(av[i]) * hc.x, h1 = bfhi(hv[i]) + bfhi(av[i]) * hc.y;
                  *(unsigned*)(MIX + tok * DM + 1024 + ch) = pk2(h0 * gelu_tanh_f(bflo(lgw[i])), h1 * gelu_tanh_f(bfhi(lgw[i]))); } } }
        { const f32x2 gq = *(const f32x2*)(GLOW + (size_t)tok0 * 16 + 2 * tid); *(LAS f32x2*)(GL + 2 * tid) = gq; }
        __syncthreads();
        for (int h = 0; h < 4; ++h) {
            const int uh = (b * 4 + h) * 128 + n;
            gla_cumsum(GL, wg, bgp, h, BC, SEG, tid);
            bf16x8 sf[4][2];
            { const bf16_t* spu = SP + (size_t)uh * 32768;
#pragma unroll
              for (int mb = 0; mb < 4; ++mb)
#pragma unroll
                  for (int s2 = 0; s2 < 2; ++s2) sf[mb][s2] = *(const bf16x8*)(spu + (((mb * 8 + w) * 2 + s2) * 64 + lane) * 8); }
#pragma unroll
            for (int it = 0; it < 2; ++it) { const int item = tid + 512 * it, kk8 = item & 15, t = item >> 4;
                const u32x4 qv = *(const u32x4*)(Z + (size_t)(tok0 + t) * ZC + ZQ + h * 128 + kk8 * 8);
                const u32x4 kv = *(const u32x4*)(Z + (size_t)(tok0 + t) * ZC + ZK + h * 128 + kk8 * 8);
                const f32x4 b0 = *(const LAS f32x4*)(BC + t * 128 + kk8 * 8), b1 = *(const LAS f32x4*)(BC + t * 128 + kk8 * 8 + 4);
                float qe[8], ke[8];
#pragma unroll
                for (int i = 0; i < 8; ++i) { const float bb = (i < 4) ? b0[i & 3] : b1[i & 3]; const unsigned qw = qv[i >> 1], kw = kv[i >> 1];
                    const float qf = (i & 1) ? bfhi(qw) : bflo(qw), kf = (i & 1) ? bfhi(kw) : bflo(kw);
                    qe[i] = qf * 0.08838834764831845f * __expf(bb); ke[i] = kf * __expf(-bb); }
                u32x4 oq, ok; oq.x = pk2(qe[0], qe[1]); oq.y = pk2(qe[2], qe[3]); oq.z = pk2(qe[4], qe[5]); oq.w = pk2(qe[6], qe[7]);
                ok.x = pk2(ke[0], ke[1]); ok.y = pk2(ke[2], ke[3]); ok.z = pk2(ke[4], ke[5]); ok.w = pk2(ke[6], ke[7]);
                *(LAS u32x4*)(QE + t * 136 + kk8 * 8) = oq; *(LAS u32x4*)(KE + t * 136 + kk8 * 8) = ok; }
#pragma unroll
            for (int it = 0; it < 4; ++it) { const int item = tid + 512 * it, t = item & 63, vc8 = item >> 6;
                const u32x4 vv = *(const u32x4*)(Z + (size_t)(tok0 + t) * ZC + ZV + h * 256 + vc8 * 8);
#pragma unroll
                for (int i = 0; i < 8; ++i) { const unsigned wv = vv[i >> 1]; VT[(vc8 * 8 + i) * 72 + t] = (bf16_t)((i & 1) ? (wv >> 16) : (wv & 0xffffu)); } }
            __syncthreads();
            f32x16 oacc[2];
            {
                f32x16 P00, P01, P11;
#pragma unroll
                for (int q = 0; q < 16; ++q) { P00[q] = 0.f; P01[q] = 0.f; P11[q] = 0.f; oacc[0][q] = 0.f; oacc[1][q] = 0.f; }
#pragma unroll
                for (int s = 0; s < 8; ++s) {
                    const bf16x8 a0 = *(const LAS bf16x8*)(KE + r * 136 + 16 * s + 8 * hh), a1 = *(const LAS bf16x8*)(KE + (32 + r) * 136 + 16 * s + 8 * hh);
                    const bf16x8 b0 = *(const LAS bf16x8*)(QE + r * 136 + 16 * s + 8 * hh), b1 = *(const LAS bf16x8*)(QE + (32 + r) * 136 + 16 * s + 8 * hh);
                    P00 = __builtin_amdgcn_mfma_f32_32x32x16_bf16(a0, b0, P00, 0, 0, 0);
                    P01 = __builtin_amdgcn_mfma_f32_32x32x16_bf16(a0, b1, P01, 0, 0, 0);
                    P11 = __builtin_amdgcn_mfma_f32_32x32x16_bf16(a1, b1, P11, 0, 0, 0); }
#pragma unroll
                for (int q = 0; q < 16; ++q) { const int jl = (q & 3) + 8 * (q >> 2) + 4 * hh; if (jl > r) { P00[q] = 0.f; P11[q] = 0.f; } }
                bf16x8 F00[2], F01[2], F11[2];
#pragma unroll
                for (int s2 = 0; s2 < 2; ++s2) {
                    u32x4 t0, t1, t2;
#pragma unroll
                    for (int q = 0; q < 4; ++q) { t0[q] = pk2(P00[8 * s2 + 2 * q], P00[8 * s2 + 2 * q + 1]); t1[q] = pk2(P01[8 * s2 + 2 * q], P01[8 * s2 + 2 * q + 1]); t2[q] = pk2(P11[8 * s2 + 2 * q], P11[8 * s2 + 2 * q + 1]); }
                    F00[s2] = as_bf16x8(t0); F01[s2] = as_bf16x8(t1); F11[s2] = as_bf16x8(t2); }
#pragma unroll
                for (int mb = 0; mb < 4; ++mb)
#pragma unroll
                    for (int s2 = 0; s2 < 2; ++s2) { const bf16x8 af = sf[mb][s2];
                        const int kkb = 32 * mb + 16 * s2 + 4 * hh;
#pragma unroll
                        for (int ib = 0; ib < 2; ++ib) { const bf16x4 lo = *(const LAS bf16x4*)(QE + (32 * ib + r) * 136 + kkb), hi = *(const LAS bf16x4*)(QE + (32 * ib + r) * 136 + kkb + 8);
                            oacc[ib] = __builtin_amdgcn_mfma_f32_32x32x16_bf16(af, cat4(lo, hi), oacc[ib], 0, 0, 0); } }
#pragma unroll
                for (int s2 = 0; s2 < 2; ++s2) {
                    const int tb0 = 16 * s2 + 4 * hh, tb1 = 32 + 16 * s2 + 4 * hh;
                    const bf16x8 v0 = cat4(*(const LAS bf16x4*)(VT + (32 * w + r) * 72 + tb0), *(const LAS bf16x4*)(VT + (32 * w + r) * 72 + tb0 + 8));
                    const bf16x8 v1 = cat4(*(const LAS bf16x4*)(VT + (32 * w + r) * 72 + tb1), *(const LAS bf16x4*)(VT + (32 * w + r) * 72 + tb1 + 8));
                    oacc[0] = __builtin_amdgcn_mfma_f32_32x32x16_bf16(v0, F00[s2], oacc[0], 0, 0, 0);
                    oacc[1] = __builtin_amdgcn_mfma_f32_32x32x16_bf16(v0, F01[s2], oacc[1], 0, 0, 0);
                    oacc[1] = __builtin_amdgcn_mfma_f32_32x32x16_bf16(v1, F11[s2], oacc[1], 0, 0, 0); }
            }
#pragma unroll
            for (int ib = 0; ib < 2; ++ib) { float sq = 0.f;
#pragma unroll
                for (int q = 0; q < 16; ++q) sq += oacc[ib][q] * oacc[ib][q];
                sq += __shfl_xor(sq, 32);
                if (hh == 0) SSQ[w * 64 + 32 * ib + r] = sq; }
            __syncthreads();
#pragma unroll
            for (int ib = 0; ib < 2; ++ib) { float tot = 0.f;
#pragma unroll
                for (int w2 = 0; w2 < 8; ++w2) tot += SSQ[w2 * 64 + 32 * ib + r];
                const float rs = rsqrtf_(tot * (1.0f / 256.0f) + 1e-6f);
#pragma unroll
                for (int g = 0; g < 4; ++g) *(LAS f32x4*)(OS + (32 * ib + r) * 260 + 32 * w + 8 * g + 4 * hh) =
                    (f32x4){oacc[ib][4 * g] * rs, oacc[ib][4 * g + 1] * rs, oacc[ib][4 * g + 2] * rs, oacc[ib][4 * g + 3] * rs}; }
            __syncthreads();
#pragma unroll
            for (int it = 0; it < 4; ++it) { const int item = tid + 512 * it, vc8 = item & 31, t = item >> 5; const int c = h * 256 + vc8 * 8;
                const f32x4 o0 = *(const LAS f32x4*)(OS + t * 260 + vc8 * 8), o1 = *(const LAS f32x4*)(OS + t * 260 + vc8 * 8 + 4);
                const u32x4 rv = *(const u32x4*)(Z + (size_t)(tok0 + t) * ZC + ZR + c);
                const f32x4 g0 = *(const f32x4*)(gng + c), g1 = *(const f32x4*)(gng + c + 4);
                float o[8];
#pragma unroll
                for (int i = 0; i < 8; ++i) { const unsigned rw = rv[i >> 1]; const float rf = (i & 1) ? bfhi(rw) : bflo(rw);
                    const float sil = rf * sigmoidf_(rf); o[i] = sil * ((i < 4) ? o0[i & 3] * g0[i & 3] : o1[i & 3] * g1[i & 3]); }
                u32x4 ov; ov.x = pk2(o[0], o[1]); ov.y = pk2(o[2], o[3]); ov.z = pk2(o[4], o[5]); ov.w = pk2(o[6], o[7]);
                *(u32x4*)(MIX + (size_t)(tok0 + t) * DM + c) = ov; }
            __syncthreads();
        }
    }
}

__device__ __forceinline__ void build_moe_tables(Frame& F) {
    unsigned* cnt = (unsigned*)(F.ws + WS_CTL) + CW_CNT;
    if (F.tid < 32) F.MISC[MI_LCNT + F.tid] = xb_ld(cnt + 64 * F.tid);
    __syncthreads();
    if (F.tid == 0) { int tiles = 0;
        for (int e = 0; e < NEXP; ++e) { const int c = (int)F.MISC[MI_LCNT + e]; const int mt = (c + 255) >> 8; F.MISC[MI_PBASE + e] = (unsigned)(tiles * 256); F.MISC[MI_CNT + e] = (unsigned)c;
            for (int q = 0; q < mt; ++q) F.MISC[MI_T2E + tiles + q] = (unsigned)e; tiles += mt; }
        F.MISC[MI_NMT] = (unsigned)tiles; }
    __syncthreads();
    if (F.tid < 32) F.MISC[MI_LCNT + F.tid] = 0u;
    __syncthreads();
}

__device__ __forceinline__ void p4a(Frame& F, const Params& p) {
    const bf16_t* XMID = (const bf16_t*)(F.ws + WS_XMID); const float* WrT = (const float*)(F.ws + WS_WRT); const float* br = p.in[I_BR];
    float* RSTD = (float*)(F.ws + WS_RSTD); unsigned* TOKE = (unsigned*)(F.ws + WS_TOKE); float* GATES = (float*)(F.ws + WS_GATES);
    unsigned* cnt = (unsigned*)(F.ws + WS_CTL) + CW_CNT;
    unsigned char* HF8 = F.ws + WS_HF8; unsigned short* LIST = (unsigned short*)(F.ws + WS_LIST); const float* gf = p.in[I_NFG];
    LAS float* RED = (LAS float*)(F.lds); LAS float* SSQ2 = (LAS float*)(F.lds + 32768); LAS float* LGT = (LAS float*)(F.lds + 33792); LAS float* RS = (LAS float*)(F.lds + 38016);
    const int tid = F.tid, lane = F.lane, w = F.wave, m = lane & 31, kh = lane >> 5;
    if (tid < 32) F.MISC[MI_LCNT + tid] = 0u;
    __syncthreads();
    f32x4 bw[32];
    { const float* bp = WrT + (size_t)m * DM + 256 * w + 128 * kh;
#pragma unroll
      for (int c = 0; c < 32; ++c) bw[c] = *(const f32x4*)(bp + 4 * c); }
    LAS float* RSA = (LAS float*)(F.lds + 38400);
    int ui = 0;
    for (int ut = blockIdx.x; ut < T / 32; ut += F.G, ++ui) {
        const int m0 = 32 * ut; const int kw = 256 * w + 128 * kh;
        f32x16 acc;
#pragma unroll
        for (int q = 0; q < 16; ++q) acc[q] = 0.f;
        float ss = 0.f;
        const bf16_t* ap = XMID + (size_t)(m0 + m) * DM + kw;
        u32x4 ar[16];
#pragma unroll
        for (int c = 0; c < 16; ++c) ar[c] = *(const u32x4*)(ap + 8 * c);
#pragma unroll
        for (int c = 0; c < 16; ++c) { const u32x4 r0 = ar[c];
            const f32x4 a0 = (f32x4){bflo(r0.x), bfhi(r0.x), bflo(r0.y), bfhi(r0.y)}, a1 = (f32x4){bflo(r0.z), bfhi(r0.z), bflo(r0.w), bfhi(r0.w)};
#pragma unroll
            for (int i = 0; i < 4; ++i) { acc = __builtin_amdgcn_mfma_f32_32x32x2f32(a0[i], bw[2 * c][i], acc, 0, 0, 0); ss += a0[i] * a0[i]; }
#pragma unroll
            for (int i = 0; i < 4; ++i) { acc = __builtin_amdgcn_mfma_f32_32x32x2f32(a1[i], bw[2 * c + 1][i], acc, 0, 0, 0); ss += a1[i] * a1[i]; } }
        ss += __shfl_xor(ss, 32);
#pragma unroll
        for (int q = 0; q < 16; ++q) RED[(w * 16 + q) * 64 + lane] = acc[q];
        if (kh == 0) SSQ2[w * 32 + m] = ss;
        __syncthreads();
#pragma unroll
        for (int it = 0; it < 2; ++it) { const int o = tid + 512 * it, reg = o >> 6, ln = o & 63, nn = ln & 31, h2 = ln >> 5; const int mm = (reg & 3) + 8 * (reg >> 2) + 4 * h2;
            float v = 0.f, s2 = 0.f;
#pragma unroll
            for (int w2 = 0; w2 < 8; ++w2) { v += RED[(w2 * 16 + reg) * 64 + ln]; s2 += SSQ2[w2 * 32 + mm]; }
            const float rs = rsqrtf_(s2 * (1.0f / DM) + 1e-6f);
            LGT[mm * 33 + nn] = v * rs + br[nn]; if (nn == 0) { RS[mm] = rs; RSA[32 * ui + mm] = rs; } }
        __syncthreads();
        int ex[4]; unsigned ls[4]; float gt[4];
        if (tid < 32) {
            float l[32];
#pragma unroll
            for (int i = 0; i < 32; ++i) l[i] = LGT[tid * 33 + i];
            float val[4];
#pragma unroll
            for (int k = 0; k < 4; ++k) { float best = -3.0e38f; int bi = 0;
#pragma unroll
                for (int i = 0; i < 32; ++i) if (l[i] > best) { best = l[i]; bi = i; }
                ex[k] = bi; val[k] = best;
#pragma unroll
                for (int i = 0; i < 32; ++i) if (i == bi) l[i] = -3.0e38f; }
            float s = 0.f;
#pragma unroll
            for (int k = 0; k < 4; ++k) { gt[k] = __expf(val[k] - val[0]); s += gt[k]; }
            const float inv = __builtin_amdgcn_rcpf(s);
#pragma unroll
            for (int k = 0; k < 4; ++k) { gt[k] *= inv; ls[k] = __hip_atomic_fetch_add((LAS unsigned*)(F.MISC + MI_LCNT + ex[k]), 1u, __ATOMIC_RELAXED, __HIP_MEMORY_SCOPE_WORKGROUP); }
        }
        __syncthreads();
        if (tid < 32) { const unsigned c = F.MISC[MI_LCNT + tid]; F.MISC[MI_LBASE + tid] = c ? xb_add(cnt + 64 * tid, c) : 0u; F.MISC[MI_LCNT + tid] = 0u; }
        __syncthreads();
        if (tid < 32) { const int tok = m0 + tid;
#pragma unroll
            for (int k = 0; k < 4; ++k) { const unsigned slot = F.MISC[MI_LBASE + ex[k]] + ls[k]; TOKE[tok * 4 + k] = (unsigned)ex[k] | (slot << 8); GATES[tok * 4 + k] = gt[k]; LIST[(size_t)ex[k] * 16384 + (slot & ~255u) + ((slot & 63u) << 2) + ((slot >> 6) & 3u)] = (unsigned short)tok; }
            RSTD[tok] = RS[tid]; }
        __syncthreads();
    }
    { const int ntok = 32 * ui; const int l = lane;
      f32x4 gv[8];
#pragma unroll
      for (int j = 0; j < 4; ++j) { gv[2 * j] = *(const f32x4*)(gf + 8 * l + 512 * j) * 16.0f; gv[2 * j + 1] = *(const f32x4*)(gf + 8 * l + 512 * j + 4) * 16.0f; }
      u32x4 xn[4];
      int jt = w;
      if (jt < ntok) { const size_t tk = (size_t)32 * (blockIdx.x + (jt >> 5) * F.G) + (jt & 31);
#pragma unroll
          for (int j = 0; j < 4; ++j) xn[j] = *(const u32x4*)(XMID + tk * DM + 8 * l + 512 * j); }
      for (; jt < ntok; jt += 8) {
          const size_t tk = (size_t)32 * (blockIdx.x + (jt >> 5) * F.G) + (jt & 31); const float rs = RSA[jt]; u32x2 o[4];
#pragma unroll
          for (int j = 0; j < 4; ++j) { const u32x4 xr = xn[j]; const f32x4 a = (f32x4){bflo(xr.x), bfhi(xr.x), bflo(xr.y), bfhi(xr.y)} * rs * gv[2 * j], b = (f32x4){bflo(xr.z), bfhi(xr.z), bflo(xr.w), bfhi(xr.w)} * rs * gv[2 * j + 1];
              o[j].x = pk4_fp8(a[0], a[1], a[2], a[3]); o[j].y = pk4_fp8(b[0], b[1], b[2], b[3]); }
          const int j2 = jt + 8;
          if (j2 < ntok) { const size_t t2 = (size_t)32 * (blockIdx.x + (j2 >> 5) * F.G) + (j2 & 31);
#pragma unroll
              for (int j = 0; j < 4; ++j) xn[j] = *(const u32x4*)(XMID + t2 * DM + 8 * l + 512 * j); }
#pragma unroll
          for (int j = 0; j < 4; ++j) *(u32x2*)(HF8 + tk * DM + 8 * l + 512 * j) = o[j]; } }
}

__device__ __forceinline__ void p4b(Frame& F, const Params& p) {
    build_moe_tables(F);
    const bf16_t* XMID = (const bf16_t*)(F.ws + WS_XMID); const float* RSTD = (const float*)(F.ws + WS_RSTD); const unsigned* TOKE = (const unsigned*)(F.ws + WS_TOKE);
    const float* gf = p.in[I_NFG]; unsigned char* ABUF = F.ws + WS_ABUF;
    const int l = F.lane;
    u32x4 xn[4]; float rsn = 0.f; unsigned ten[4] = {0u, 0u, 0u, 0u};
    if (F.gw < T) { rsn = RSTD[F.gw];
#pragma unroll
        for (int k = 0; k < 4; ++k) ten[k] = TOKE[F.gw * 4 + k];
#pragma unroll
        for (int j = 0; j < 4; ++j) xn[j] = *(const u32x4*)(XMID + (size_t)F.gw * DM + 8 * l + 512 * j); }
    f32x4 gv[8];
#pragma unroll
    for (int j = 0; j < 4; ++j) { gv[2 * j] = *(const f32x4*)(gf + 8 * l + 512 * j) * 16.0f; gv[2 * j + 1] = *(const f32x4*)(gf + 8 * l + 512 * j + 4) * 16.0f; }
    for (int tok = F.gw; tok < T; tok += F.NGW) {
        const float rs = rsn; unsigned te[4]; u32x2 o[4];
#pragma unroll
        for (int k = 0; k < 4; ++k) te[k] = ten[k];
#pragma unroll
        for (int j = 0; j < 4; ++j) { const u32x4 xr = xn[j]; const f32x4 a = (f32x4){bflo(xr.x), bfhi(xr.x), bflo(xr.y), bfhi(xr.y)} * rs * gv[2 * j], b = (f32x4){bflo(xr.z), bfhi(xr.z), bflo(xr.w), bfhi(xr.w)} * rs * gv[2 * j + 1];
            o[j].x = pk4_fp8(a[0], a[1], a[2], a[3]); o[j].y = pk4_fp8(b[0], b[1], b[2], b[3]); }
        const int t2 = tok + F.NGW;
        if (t2 < T) { rsn = RSTD[t2];
#pragma unroll
            for (int k = 0; k < 4; ++k) ten[k] = TOKE[t2 * 4 + k];
#pragma unroll
            for (int j = 0; j < 4; ++j) xn[j] = *(const u32x4*)(XMID + (size_t)t2 * DM + 8 * l + 512 * j); }
#pragma unroll
        for (int k = 0; k < 4; ++k) { const size_t row = (size_t)F.MISC[MI_PBASE + (te[k] & 255u)] + (te[k] >> 8);
#pragma unroll
            for (int j = 0; j < 4; ++j) *(u32x2*)(ABUF + row * DM + 8 * l + 512 * j) = o[j]; }
    }
}

__device__ __forceinline__ void p7(Frame& F, const Params& p) {
    build_moe_tables(F);
    const bf16_t* XMID = (const bf16_t*)(F.ws + WS_XMID); const unsigned* TOKE = (const unsigned*)(F.ws + WS_TOKE); const float* GATES = (const float*)(F.ws + WS_GATES);
    const unsigned char* Y = F.ws + WS_Y; const float* gfin = p.in[I_NFINAL];
    const int l = F.lane;
    u32x4 xn[4]; u32x2 yn[4][4]; float gkn[4] = {0.f, 0.f, 0.f, 0.f};
#define P7_FETCH(tk) do { \
        _Pragma("unroll") for (int k = 0; k < 4; ++k) { const unsigned te = TOKE[(tk) * 4 + k]; gkn[k] = GATES[(tk) * 4 + k]; const size_t row = (size_t)F.MISC[MI_PBASE + (te & 255u)] + (te >> 8); \
            _Pragma("unroll") for (int j = 0; j < 4; ++j) yn[k][j] = *(const u32x2*)(Y + row * DM + 8 * l + 512 * j); } \
        _Pragma("unroll") for (int j = 0; j < 4; ++j) xn[j] = *(const u32x4*)(XMID + (size_t)(tk) * DM + 8 * l + 512 * j); } while (0)
    if (F.gw < T) P7_FETCH(F.gw);
    f32x4 g0[4], g1[4];
#pragma unroll
    for (int j = 0; j < 4; ++j) { g0[j] = *(const f32x4*)(gfin + 8 * l + 512 * j); g1[j] = *(const f32x4*)(gfin + 8 * l + 512 * j + 4); }
    for (int tok = F.gw; tok < T; tok += F.NGW) {
        f32x4 xv[8];
#pragma unroll
        for (int j = 0; j < 4; ++j) { const u32x4 xr = xn[j]; xv[2 * j] = (f32x4){bflo(xr.x), bfhi(xr.x), bflo(xr.y), bfhi(xr.y)}; xv[2 * j + 1] = (f32x4){bflo(xr.z), bfhi(xr.z), bflo(xr.w), bfhi(xr.w)}; }
#pragma unroll
        for (int k = 0; k < 4; ++k)
#pragma unroll
            for (int j = 0; j < 4; ++j) { const u32x2 y2 = yn[k][j]; const float gk = gkn[k] * (1.0f / 32.0f);
                xv[2 * j][0] += gk * fp8f(y2.x, 0); xv[2 * j][1] += gk * fp8f(y2.x, 1); xv[2 * j][2] += gk * fp8f(y2.x, 2); xv[2 * j][3] += gk * fp8f(y2.x, 3);
                xv[2 * j + 1][0] += gk * fp8f(y2.y, 0); xv[2 * j + 1][1] += gk * fp8f(y2.y, 1); xv[2 * j + 1][2] += gk * fp8f(y2.y, 2); xv[2 * j + 1][3] += gk * fp8f(y2.y, 3); }
        const int t2 = tok + F.NGW;
        if (t2 < T) P7_FETCH(t2);
        float ss = 0.f;
#pragma unroll
        for (int j = 0; j < 8; ++j) ss += (xv[j][0] * xv[j][0] + xv[j][1] * xv[j][1]) + (xv[j][2] * xv[j][2] + xv[j][3] * xv[j][3]);
        const float rs = rsqrtf_(wave_sum(ss) * (1.0f / DM) + 1e-6f);
#pragma unroll
        for (int j = 0; j < 4; ++j) { *(f32x4*)(p.out + (size_t)tok * DM + 8 * l + 512 * j) = xv[2 * j] * rs * g0[j]; *(f32x4*)(p.out + (size_t)tok * DM + 8 * l + 512 * j + 4) = xv[2 * j + 1] * rs * g1[j]; }
    }
#undef P7_FETCH
}

#ifdef PROBE_STREAM
__device__ __forceinline__ void probe_stream(Frame& F, const Params& p) {
    const f32x4* src = (const f32x4*)p.in[I_WGU]; const size_t n4 = (size_t)32 * 2048 * 4096 / 4;
    const f32x4* src2 = (const f32x4*)p.in[I_WDN]; const size_t m4 = (size_t)32 * 2048 * 2048 / 4;
    f32x4 acc = (f32x4){0.f, 0.f, 0.f, 0.f};
    for (size_t base = (size_t)F.gw * 1024; base < n4; base += (size_t)F.NGW * 1024) {
        f32x4 v[16];
#pragma unroll
        for (int i = 0; i < 16; ++i) v[i] = src[base + i * 64 + F.lane];
#pragma unroll
        for (int i = 0; i < 16; ++i) acc += v[i]; }
    for (size_t base = (size_t)F.gw * 1024; base < m4; base += (size_t)F.NGW * 1024) {
        f32x4 v[16];
#pragma unroll
        for (int i = 0; i < 16; ++i) v[i] = src2[base + i * 64 + F.lane];
#pragma unroll
        for (int i = 0; i < 16; ++i) acc += v[i]; }
    if (acc[0] + acc[1] + acc[2] + acc[3] == 12345.678f) p.out[0] = 1.0f;
}
#endif
#ifdef PROBE_ORDER
__device__ __forceinline__ void probe_order(Frame& F, const Params& p) {
    volatile LAS unsigned* flag = F.MISC + 2000;
    if (F.wave < 4) {
        const unsigned* hot = (const unsigned*)p.in[I_X] + (size_t)blockIdx.x * 16384;
        unsigned idx = F.tid & 255, sm = 0;
        for (int it = 0; it < 600; ++it) {
            const unsigned b = idx * 4 + (it & 3) * 1024;
            const unsigned v0 = hot[b & 16383], v1 = hot[(b + 4096) & 16383], v2 = hot[(b + 8192) & 16383], v3 = hot[(b + 12288) & 16383];
            sm += v0 + v1 + v2 + v3; idx = (idx + (sm & 3)) & 255;
        }
        if (sm == 0x12345678u) p.out[0] = 1.0f;
        *flag = 1u;
    } else {
#if PROBE_ORDER == 2
        const f32x4* src = (const f32x4*)p.in[I_WGU];
        f32x4 acc = (f32x4){0.f, 0.f, 0.f, 0.f}; unsigned it = 0;
        const unsigned sw = blockIdx.x * 4 + (F.wave - 4);
        while (*flag == 0u) {
            const size_t base = (((size_t)it * 1024 + sw) * 1024) & (((size_t)1 << 26) - 1);
            f32x4 v[16];
#pragma unroll
            for (int i = 0; i < 16; ++i) v[i] = src[base + i * 64 + F.lane];
#pragma unroll
            for (int i = 0; i < 16; ++i) acc += v[i];
            ++it;
        }
        if (acc[0] + acc[1] + acc[2] + acc[3] == 12345.678f) p.out[1] = 1.0f;
#endif
    }
    __syncthreads();
}
#endif
constexpr int NPHASE = 11;
constexpr int HOST_DN_EXPERTS = 24;
constexpr int CONV_EXPERTS = 28, CONV_END = CONV_EXPERTS * 8192, CONV_P1 = 2048 * 81;
#ifndef KROT5
#define KROT5 false
#endif
#ifndef KROT6
#define KROT6 false
#endif
#ifndef STAG5
#define STAG5 0
#endif
#ifndef STAG6
#define STAG6 0
#endif
__global__ void __launch_bounds__(512, 2) mk_fwd(Params p) {
    extern __shared__ __attribute__((aligned(16))) unsigned char lds_raw[];
    Frame F;
    F.lds = (LAS unsigned char*)lds_raw; F.MISC = (volatile LAS unsigned*)(F.lds + MISC_OFF);
    F.wave = __builtin_amdgcn_readfirstlane((int)threadIdx.x >> 6);
#define FRESH() do { F.lane = fresh_lane(); F.tid = F.wave * 64 + F.lane; } while (0)
    FRESH();
    F.G = gridDim.x; F.gw = (int)blockIdx.x * 8 + F.wave; F.NGW = F.G * 8; F.ws = p.ws;
    for (int u = F.tid; u < (LDS_BYTES - MISC_OFF) / 4; u += 512) F.MISC[u] = 0u;
    __syncthreads();
    const int lo = p.ph_lo, hi = p.ph_hi;
    XcdBarrier bar; bar.bar = (unsigned*)(F.ws + WS_CTL) + CW_BAR; bar.x = 0; bar.st = F.MISC;
    if (hi - lo > 1) bar = xcd_barrier_post((unsigned*)(F.ws + WS_CTL) + CW_BAR, F.MISC, F.tid == 0);
#ifndef PHASE_MASK
#define PHASE_MASK 0x7ff
#endif
#define IN(k) (((PHASE_MASK >> (k)) & 1) && lo <= (k) && (k) < hi)
#define SEAM(k) do { if (IN(k) && IN((k) + 1)) xcd_barrier(bar, F.wave == 0 && fresh_lane() == 0); } while (0)
#ifndef REPEAT_MASK
#define REPEAT_MASK 0
#endif
#define REP(k) for (int rep_ = 0; rep_ < (((REPEAT_MASK >> (k)) & 1) ? 2 : 1); ++rep_)
    LAS unsigned char* ring = F.lds;
#ifdef PROBE_STREAM
    if (IN(0)) { probe_stream(F, p); }
#endif
#ifdef PROBE_ORDER
    if (IN(0)) { probe_order(F, p); }
#endif
    if (IN(0)) { REP(11) { FRESH(); p0a(F, p); } REP(12) { FRESH(); p0b(F, p); } SEAM(0); }
    if (IN(1)) REP(1) {

#ifdef SIM_FP8
        pg8::Gemm g{F.ws + WS_MIX, F.ws + WS_WINT};
#else
        pg8::Gemm g{F.ws + WS_H, F.ws + WS_WINT};
#endif
 using GS = pg8::GShape<DM * 2, DM * 2, DM * 2, 0>; pg8::StaticOrder S; S.init(T, ZC, F.G, (int)blockIdx.x);
        pg8::EpiBf16 E{(bf16_t*)(F.ws + WS_Z), ZC, nullptr, 0};
        pg8::ConvGU cv{p.in[I_WGU], F.ws + WS_WGUT, F.gw, CONV_END, F.NGW, 0};
        pg8::gemm_phase<pg8::EpiBf16, pg8::StaticOrder, GS, true, false, 0, pg8::ConvGU>(ring, g, S, E, F.wave, cv); SEAM(1); }
    if (IN(2)) REP(2) { FRESH(); p2a(F, p); SEAM(2); }
    if (IN(3)) REP(3) { FRESH(); p2b(F, p); SEAM(3); }
    if (IN(4)) REP(4) { FRESH(); p2c(F, p); SEAM(4); }
    if (IN(5)) REP(5) {
        pg8::Gemm g{F.ws + WS_MIX, F.ws + WS_WOUTT}; using GS = pg8::GShape<DM * 2, DM * 2, DM * 2, 0>; pg8::StaticOrder S; S.init(T, DM, F.G, (int)blockIdx.x);
        pg8::EpiBf16Res E{(bf16_t*)(F.ws + WS_XMID), p.in[I_X], DM};
        pg8::ConvGU cv{p.in[I_WGU], F.ws + WS_WGUT, CONV_P1 + F.gw, CONV_END, F.NGW, 0};
        pg8::gemm_phase<pg8::EpiBf16Res, pg8::StaticOrder, GS, true, false, 0, pg8::ConvGU>(ring, g, S, E, F.wave, cv); SEAM(5); }
    if (IN(6)) { FRESH(); p4a(F, p); SEAM(6); }
    if (IN(8)) {
        FRESH(); build_moe_tables(F);
        pg8::Gemm g{F.ws + WS_HF8, F.ws + WS_WGUT}; using GS = pg8::GShape<DM, DM, DM, (size_t)4096 * DM>;
        pg8::MoeOrder S{__builtin_amdgcn_readfirstlane((int)F.MISC[MI_NMT]), 16, F.G, (int)blockIdx.x, (const LAS int*)(F.lds + MISC_OFF + 4 * MI_T2E)};
        pg8::EpiSwiGLU8 E{F.ws + WS_ACT, DM, p.in[I_BGU]};
        pg8::Gather gi{(const unsigned short*)(F.ws + WS_LIST), (const LAS unsigned*)(F.lds + MISC_OFF + 4 * MI_PBASE), (const LAS unsigned*)(F.lds + MISC_OFF + 4 * MI_CNT)};
        pg8::EpiHost<3> eh{p.in[I_WDN], F.ws + WS_WDT, F.gw, HOST_DN_EXPERTS * 4096, F.NGW, DM, 5, 0, 0, {0, 0, 0}};
        pg8::gemm_phase<pg8::EpiSwiGLU8, pg8::MoeOrder, GS, true, true, STAG5, pg8::NoConv, pg8::EpiHost<3>, KROT5, pg8::Gather>(ring, g, S, E, F.wave, pg8::NoConv(), eh, gi); SEAM(8); }
#if (REPEAT_MASK & 0x100)
    if (IN(8)) {
        FRESH(); build_moe_tables(F);
        pg8::Gemm g{F.ws + WS_ABUF, F.ws + WS_WGUT}; using GS = pg8::GShape<DM, DM, DM, (size_t)4096 * DM>;
        pg8::MoeOrder S{__builtin_amdgcn_readfirstlane((int)F.MISC[MI_NMT]), 16, F.G, (int)blockIdx.x, (const LAS int*)(F.lds + MISC_OFF + 4 * MI_T2E)};
        pg8::EpiSwiGLU8 E{F.ws + WS_Y, DM, p.in[I_BGU]};
#if P5DUP == 2
        pg8::Gemm g2{F.ws + WS_HF8, F.ws + WS_WGUT};
        pg8::Gather gi{(const unsigned short*)(F.ws + WS_LIST), (const LAS unsigned*)(F.lds + MISC_OFF + 4 * MI_PBASE), (const LAS unsigned*)(F.lds + MISC_OFF + 4 * MI_CNT)};
        pg8::gemm_phase<pg8::EpiSwiGLU8, pg8::MoeOrder, GS, true, true, STAG5, pg8::NoConv, pg8::NoHost, false, pg8::Gather>(ring, g2, S, E, F.wave, pg8::NoConv(), pg8::NoHost(), gi); SEAM(8); }
#else
        pg8::gemm_phase<pg8::EpiSwiGLU8, pg8::MoeOrder, GS, true, true, STAG5>(ring, g, S, E, F.wave); SEAM(8); }
#endif
#endif
    if (IN(9)) {
        FRESH(); build_moe_tables(F);
        pg8::Gemm g{F.ws + WS_ACT, F.ws + WS_WDT}; using GS = pg8::GShape<DM, DM, DM, (size_t)DM * DM>;
        pg8::MoeOrder S{__builtin_amdgcn_readfirstlane((int)F.MISC[MI_NMT]), 8, F.G, (int)blockIdx.x, (const LAS int*)(F.lds + MISC_OFF + 4 * MI_T2E)};
        pg8::EpiFp8S E{F.ws + WS_Y, DM, p.in[I_BDN], DM, 1.0f / 2048.0f, 32.0f};
        pg8::gemm_phase<pg8::EpiFp8S, pg8::MoeOrder, GS, true, true, STAG6, pg8::NoConv, pg8::NoHost, KROT6>(ring, g, S, E, F.wave); SEAM(9); }
#if (REPEAT_MASK & 0x200)
    if (IN(9)) {
        FRESH(); build_moe_tables(F);
#ifdef P6_PITCH
        pg8::Gemm g{F.ws + WS_ACT, F.ws + WS_WDT}; using GS = pg8::GShape<P6_PITCH, P6_PITCH, DM, (size_t)DM * DM>;
#else
        pg8::Gemm g{F.ws + WS_ACT, F.ws + WS_WDT}; using GS = pg8::GShape<DM, DM, DM, (size_t)DM * DM>;
#endif
        pg8::MoeOrder S{__builtin_amdgcn_readfirstlane((int)F.MISC[MI_NMT]), 8, F.G, (int)blockIdx.x, (const LAS int*)(F.lds + MISC_OFF + 4 * MI_T2E)};
#ifdef P6_NOSTORE
        pg8::EpiNull_<P6_NOSTORE - 1> E{};

#ifndef P6_FLP
#define P6_FLP false
#endif
        pg8::gemm_phase<pg8::EpiNull_<P6_NOSTORE - 1>, pg8::MoeOrder, GS, true, true, STAG6, pg8::NoConv, pg8::NoHost, false, pg8::NoGather, P6_FLP>(ring, g, S, E, F.wave); SEAM(9); }
#elif defined(P6_MODE)
        pg8::EpiFp8S_<P6_MODE> E{F.ws + WS_Y, DM, p.in[I_BDN], DM, 1.0f / 2048.0f, 32.0f};
        pg8::gemm_phase<pg8::EpiFp8S_<P6_MODE>, pg8::MoeOrder, GS, true, true, STAG6>(ring, g, S, E, F.wave); SEAM(9); }
#else
        pg8::EpiFp8S E{F.ws + WS_Y, DM, p.in[I_BDN], DM, 1.0f / 2048.0f, 32.0f};
        pg8::gemm_phase<pg8::EpiFp8S, pg8::MoeOrder, GS, true, true, STAG6>(ring, g, S, E, F.wave); SEAM(9); }
#endif
#endif
    if (IN(10)) REP(10) { FRESH(); p7(F, p); if (((REPEAT_MASK >> 10) & 1)) xcd_barrier(bar, F.wave == 0 && fresh_lane() == 0); }
#undef IN
#undef SEAM
}
#ifndef STAGE
#define STAGE 4
#endif
#ifndef PER_PHASE_LAUNCH
#define PER_PHASE_LAUNCH 0
#endif

#if STAGE < 4
__global__ void adapt_z_kernel(const bf16_t* Z, float* z) {
    const long idx = (long)blockIdx.x * blockDim.x + threadIdx.x; const long t = idx / ZC; const int c = (int)(idx % ZC);
    z[t * INC + (c < 3072 ? c : c + 16)] = bf2f(Z[idx]);
}
__global__ void adapt_bf16_kernel(const bf16_t* src, float* dst) { const long idx = (long)blockIdx.x * blockDim.x + threadIdx.x; dst[idx] = bf2f(src[idx]); }
#endif

static void launch_mk(Params& a, int lo, int hi, int grid, hipStream_t stream) {
#if PER_PHASE_LAUNCH
    for (int k = lo; k < hi; ++k) { a.ph_lo = k; a.ph_hi = k + 1; hipLaunchKernelGGL(mk_fwd, dim3(grid), dim3(512), LDS_BYTES, stream, a); }
#else
    a.ph_lo = lo; a.ph_hi = hi; hipLaunchKernelGGL(mk_fwd, dim3(grid), dim3(512), LDS_BYTES, stream, a);
#endif
}

extern "C" void kernel_launch(void* const* d_in, const int* in_sizes, int n_in, void* d_out, int out_size, void* d_ws, size_t ws_size, hipStream_t stream) {
    static int grid = 0;
    if (grid == 0) {
        int dev = 0, cus = 0;
        if (hipGetDevice(&dev) != hipSuccess || hipDeviceGetAttribute(&cus, hipDeviceAttributeMultiprocessorCount, dev) != hipSuccess) { grid = -1; return; }
        if (hipFuncSetAttribute((const void*)mk_fwd, hipFuncAttributeMaxDynamicSharedMemorySize, LDS_BYTES) != hipSuccess) { grid = -1; return; }
        int per_cu = 0;
        (void)hipOccupancyMaxActiveBlocksPerMultiprocessor(&per_cu, (const void*)mk_fwd, 512, LDS_BYTES);
        (void)hipGetLastError();
        grid = cus < 256 ? cus : 256;
        if (per_cu < 1) fprintf(stderr, "kernel_launch: occupancy query reports %d\n", per_cu);
    }
    if (grid < 0) return;
    (void)hipMemsetAsync((char*)d_ws + WS_CTL, 0, CTL_ZERO_BYTES, stream);
    Params a{};
    for (int i = 0; i < 22; ++i) a.in[i] = (const float*)d_in[i];
    a.out = (float*)d_out; a.ws = (unsigned char*)d_ws;
#if STAGE >= 4
    launch_mk(a, 0, NPHASE, grid, stream);
#else
    const float* x = a.in[I_X];
    char* ws = (char*)d_ws + WS_ABUF; size_t off = 0;
    auto alloc = [&](size_t bytes) { void* p = ws + off; off += (bytes + 255) & ~(size_t)255; return p; };
    int* counts = (int*)alloc(256);
    float* z = (float*)alloc((size_t)T * INC * 4);
    float* ogla = (float*)alloc((size_t)T * 1024 * 4);
    float* xc = (float*)alloc((size_t)T * 1024 * 4);
    float* za = (float*)alloc((size_t)T * 1024 * 4);
    float* zi = (float*)alloc((size_t)T * 1024 * 4);
    float* mix = (float*)alloc((size_t)T * DM * 4);
    float* xmid = (float*)alloc((size_t)T * DM * 4);
    float* hf = (float*)alloc((size_t)T * DM * 4);
    float* logits = (float*)alloc((size_t)T * 32 * 4);
    float* gates = (float*)alloc((size_t)T * 4 * 4);
    int* list = (int*)alloc((size_t)NEXP * T * 4);
    float* act = (float*)alloc((size_t)T * 4 * DM * 4);
    float* y = (float*)alloc((size_t)T * 4 * DM * 4);
    (void)hipMemsetAsync(counts, 0, 256, stream);
#if STAGE == 1
    launch_mk(a, 0, 2, grid, stream);
    adapt_z_kernel<<<(unsigned)((size_t)T * ZC / 256), 256, 0, stream>>>((const bf16_t*)((char*)d_ws + WS_Z), z);
    gla_naive_kernel<<<64, 256, 0, stream>>>(z, (const float*)((char*)d_ws + WS_LG), ogla);
    gla_out_kernel<<<T, 256, 0, stream>>>(ogla, z, a.in[I_GNG], mix);
    lru_conv_kernel<<<T * 1024 / 256, 256, 0, stream>>>(z, a.in[I_CW], a.in[I_CB], xc);
    for (int h = 0; h < 4; ++h) {
        GemmArgs g{}; g.A = xc + h * 256; g.lda = 1024; g.ldb = 256; g.ldc = 1024; g.M = T; g.N = 256; g.K = 256; g.a_div = 1;
        g.B = a.in[I_WA] + (size_t)h * 65536; g.C = za + h * 256;
        sgemm_kernel<0><<<dim3(2, T / 128, 1), 256, 0, stream>>>(g);
        g.B = a.in[I_WI] + (size_t)h * 65536; g.C = zi + h * 256;
        sgemm_kernel<0><<<dim3(2, T / 128, 1), 256, 0, stream>>>(g);
    }
    lru_gate_kernel<<<T * 1024 / 256, 256, 0, stream>>>(xc, za, zi, a.in[I_BA], a.in[I_BI], a.in[I_AP]);
    lru_scan_kernel<<<2048 / 64, 64, 0, stream>>>(za, zi, z, mix);
#endif
#if STAGE == 2
    launch_mk(a, 0, 5, grid, stream);
    adapt_bf16_kernel<<<(unsigned)((size_t)T * DM / 256), 256, 0, stream>>>((const bf16_t*)((char*)d_ws + WS_MIX), mix);
#endif
#if STAGE <= 2
    { GemmArgs g{}; g.A = mix; g.lda = DM; g.B = a.in[I_WOUT]; g.ldb = DM; g.C = xmid; g.ldc = DM; g.M = T; g.N = DM; g.K = DM; g.a_div = 1; g.resid = x; g.ldr = DM;
      sgemm_kernel<1><<<dim3(DM / 128, T / 128, 1), 256, 0, stream>>>(g); }
#else
    launch_mk(a, 0, 6, grid, stream);
    xmid = (float*)((char*)d_ws + WS_XMID);
#endif
    rmsnorm_kernel<<<T, 256, 0, stream>>>(xmid, a.in[I_NFG], hf);
    { GemmArgs g{}; g.A = hf; g.lda = DM; g.B = a.in[I_WR]; g.ldb = 32; g.C = logits; g.ldc = 32; g.M = T; g.N = 32; g.K = DM; g.a_div = 1; g.bias = a.in[I_BR];
      sgemm_kernel<0><<<dim3(1, T / 128, 1), 256, 0, stream>>>(g); }
    route_kernel<<<T / 256, 256, 0, stream>>>(logits, counts, list, gates);
    { GemmArgs g{}; g.A = hf; g.lda = DM; g.B = a.in[I_WGU]; g.ldb = 4096; g.C = act; g.ldc = DM; g.M = 0; g.N = 4096; g.K = DM; g.a_div = 4; g.bias = a.in[I_BGU];
      g.rowlist = list; g.count = counts; g.strideB_e = (long)DM * 4096; g.strideBias_e = 4096; g.list_stride = T;
      sgemm_kernel<2><<<dim3(2048 / 64, T / 128, NEXP), 256, 0, stream>>>(g); }
    { GemmArgs g{}; g.A = act; g.lda = DM; g.B = a.in[I_WDN]; g.ldb = DM; g.C = y; g.ldc = DM; g.M = 0; g.N = DM; g.K = DM; g.a_div = 1; g.bias = a.in[I_BDN];
      g.rowlist = list; g.count = counts; g.strideB_e = (long)DM * DM; g.strideBias_e = DM; g.list_stride = T;
      sgemm_kernel<0><<<dim3(DM / 128, T / 128, NEXP), 256, 0, stream>>>(g); }
    final_kernel<<<T, 256, 0, stream>>>(xmid, y, gates, a.in[I_NFINAL], (float*)d_out);
#endif
}
```

```cpp
#define STAGE 4
#define PER_PHASE_LAUNCH 0
#define REPEAT_MASK 0
#define USE_BIAS_LDS 0
#include <hip/hip_runtime.h>
#include <stdint.h>
#include <stdio.h>

#define GAS __attribute__((address_space(1)))
#define LAS __attribute__((address_space(3)))
typedef unsigned short bf16_t;
typedef short bf16x8 __attribute__((ext_vector_type(8)));
typedef short bf16x4 __attribute__((ext_vector_type(4)));
typedef float f32x4 __attribute__((ext_vector_type(4)));
typedef float f32x2 __attribute__((ext_vector_type(2)));
typedef float f32x16 __attribute__((ext_vector_type(16)));
typedef unsigned u32x4 __attribute__((ext_vector_type(4)));
typedef unsigned u32x2 __attribute__((ext_vector_type(2)));
typedef int i32x8 __attribute__((ext_vector_type(8)));
typedef int i32x4 __attribute__((ext_vector_type(4)));
typedef int i32x32 __attribute__((ext_vector_type(32)));

constexpr int T = 16384, SEQL = 8192, DM = 2048, INC = 5136, ZC = 5120, NEXP = 32;
constexpr int ZQ = 0, ZK = 512, ZV = 1024, ZR = 2048, ZLX = 3072, ZLG = 4096;
constexpr int MPAD_MAX = 65536 + NEXP * 256;
constexpr int NCHUNK = 256;

constexpr size_t MiB = 1u << 20;
constexpr size_t WS_CTL = 0, CTL_ZERO_BYTES = 128 * 1024;
constexpr size_t WS_WINT = 1 * MiB;
constexpr size_t WS_WOUTT = WS_WINT + 20 * MiB;
constexpr size_t WS_WGUT = WS_WOUTT + 8 * MiB;
constexpr size_t WS_WDT = WS_WGUT + 512 * MiB;
constexpr size_t WS_WAT = WS_WDT + 256 * MiB;
constexpr size_t WS_WIT = WS_WAT + 512 * 1024;
constexpr size_t WS_WRT = WS_WIT + 512 * 1024;
constexpr size_t WS_WGLT = WS_WRT + 512 * 1024;
constexpr size_t WS_H = WS_WRT + 1 * MiB;
constexpr size_t WS_LG = WS_H + 64 * MiB;
constexpr size_t WS_Z = WS_LG + 32 * MiB;
constexpr size_t WS_AN = WS_Z + 160 * MiB;
constexpr size_t WS_DN = WS_AN + 128 * MiB;
constexpr size_t WS_SP = WS_DN + 1 * MiB;
constexpr size_t WS_AUA = WS_SP + 64 * MiB;
constexpr size_t WS_AUU = WS_AUA + 64 * MiB;
constexpr size_t WS_SUMA = WS_AUU + 64 * MiB;
constexpr size_t WS_SUMH = WS_SUMA + 1 * MiB;
constexpr size_t WS_MIX = WS_SUMH + 1 * MiB;
constexpr size_t WS_XMID = WS_MIX + 64 * MiB;
constexpr size_t WS_RSTD = WS_XMID + 128 * MiB;
constexpr size_t WS_TOKE = WS_RSTD + 1 * MiB;
constexpr size_t WS_GATES = WS_TOKE + 1 * MiB;
constexpr size_t WS_ABUF = WS_GATES + 1 * MiB;
constexpr size_t WS_HF8 = WS_ABUF, WS_LIST = WS_ABUF + 64 * MiB;
constexpr size_t WS_ACT = WS_ABUF + 288 * MiB;
constexpr size_t WS_Y = WS_ACT + 288 * MiB;
constexpr size_t WS_END = WS_Y + 288 * MiB;
constexpr int CW_BAR = 4096;
constexpr int CW_CNT = 16384;

constexpr int RING_BYTES = 131072;
constexpr int SCR_BYTES = 135168;
constexpr int MISC_OFF = SCR_BYTES;
constexpr int LDS_BYTES = 147456;
constexpr int MI_PBASE = 16, MI_NMT = 48, MI_LCNT = 64, MI_LBASE = 96, MI_T2E = 128, MI_CNT = 480;

#define LDS_WAIT() asm volatile("s_waitcnt lgkmcnt(0)" ::: "memory")
#define VM_WAIT() asm volatile("s_waitcnt vmcnt(0)" ::: "memory")

typedef __bf16 bf16v2_t __attribute__((ext_vector_type(2)));
__device__ __forceinline__ unsigned pk2(float lo, float hi) { const f32x2 v = {lo, hi}; return __builtin_bit_cast(unsigned, __builtin_convertvector(v, bf16v2_t)); }
#ifdef SIM_FP8
__device__ __forceinline__ float q8_(float x, float sc) { int p = 0; p = __builtin_amdgcn_cvt_pk_fp8_f32(__builtin_amdgcn_fmed3f(x * sc, -448.0f, 448.0f), 0.0f, p, false); return __builtin_amdgcn_cvt_f32_fp8(p, 0) * (1.0f / sc); }
#define PK2A(a, b) pk2(q8_(a, 16.0f), q8_(b, 16.0f))
#define PK2W(a, b) pk2(q8_(a, 512.0f), q8_(b, 512.0f))
#else
#define PK2A(a, b) pk2(a, b)
#define PK2W(a, b) pk2(a, b)
#endif
__device__ __forceinline__ unsigned f2bf(float f) { return pk2(f, 0.0f) & 0xffffu; }
__device__ __forceinline__ float bf2f(unsigned short b) { return __builtin_bit_cast(float, (unsigned)b << 16); }
__device__ __forceinline__ float bflo(unsigned w) { return __builtin_bit_cast(float, w << 16); }
__device__ __forceinline__ float bfhi(unsigned w) { return __builtin_bit_cast(float, w & 0xffff0000u); }
__device__ __forceinline__ float clamp448(float x) { return __builtin_amdgcn_fmed3f(x, -448.0f, 448.0f); }
__device__ __forceinline__ unsigned pk4_fp8(float a, float b, float c, float d) {
    int p = 0; p = __builtin_amdgcn_cvt_pk_fp8_f32(clamp448(a), clamp448(b), p, false); p = __builtin_amdgcn_cvt_pk_fp8_f32(clamp448(c), clamp448(d), p, true); return (unsigned)p; }
__device__ __forceinline__ unsigned pk4_fp8_nc(float a, float b, float c, float d) {
    int p = 0; p = __builtin_amdgcn_cvt_pk_fp8_f32(a, b, p, false); p = __builtin_amdgcn_cvt_pk_fp8_f32(c, d, p, true); return (unsigned)p; }
__device__ __forceinline__ float fp8f(unsigned w, int b) { return b == 0 ? __builtin_amdgcn_cvt_f32_fp8((int)w, 0) : b == 1 ? __builtin_amdgcn_cvt_f32_fp8((int)w, 1) : b == 2 ? __builtin_amdgcn_cvt_f32_fp8((int)w, 2) : __builtin_amdgcn_cvt_f32_fp8((int)w, 3); }
__device__ __forceinline__ float wave_sum(float v) {
#pragma unroll
    for (int o = 1; o < 64; o <<= 1) v += __shfl_xor(v, o);
    return v;
}
__device__ __forceinline__ int fresh_lane() { int l; asm volatile("v_mbcnt_lo_u32_b32 %0, -1, 0\n\tv_mbcnt_hi_u32_b32 %0, -1, %0" : "=v"(l)); return l; }
__device__ __forceinline__ float sigmoidf_(float x) { return __builtin_amdgcn_rcpf(1.0f + __expf(-x)); }
__device__ __forceinline__ float rsqrtf_(float x) { return __builtin_amdgcn_rsqf(x); }

#define XB_TMO      128
#define XB_XCNT(j)  (256  + 64 * (j))
#define XB_XSUB(j)  (1280 + 64 * (j))
#define XB_XGEN(j)  (2304 + 64 * (j))
#define XB_TOP      3328
#define XB_TOPGEN   3392
#define XCD_BAR_WORDS 3456
#define XB_SPIN_CAP (1u << 18)

__device__ __forceinline__ unsigned xb_ld(unsigned* p)              { return __hip_atomic_load(p, __ATOMIC_RELAXED, __HIP_MEMORY_SCOPE_AGENT); }
__device__ __forceinline__ unsigned xb_add(unsigned* p, unsigned v) { return __hip_atomic_fetch_add(p, v, __ATOMIC_RELAXED, __HIP_MEMORY_SCOPE_AGENT); }
__device__ __forceinline__ unsigned xb_xcc_id() { return (unsigned)__builtin_amdgcn_s_getreg((3 << 11) | 20) & 0xFu; }
#define XB_SPIN(cond, bar) do { unsigned _sp = 0; while (cond) { __builtin_amdgcn_s_sleep(1); \
    if ((++_sp & 255u) == 0u) { if (xb_ld(&(bar)[XB_TMO])) break; if (_sp > XB_SPIN_CAP) { atomicAdd(&(bar)[XB_TMO], 1u); break; } } } } while (0)

struct XcdBarrier { unsigned* bar; unsigned x; volatile LAS unsigned* st; };

__device__ __forceinline__ XcdBarrier xcd_barrier_post(unsigned* bar, volatile LAS unsigned* st, bool t0) {
    XcdBarrier b; b.bar = bar; b.x = xb_xcc_id(); b.st = st;
    if (t0) (void)xb_add(&bar[XB_XCNT(b.x)], 1u);
    return b;
}
__device__ __forceinline__ void xcd_barrier_complete(unsigned* bar, unsigned x, unsigned& nloc, unsigned& nx) {
    const unsigned G = gridDim.x * gridDim.y * gridDim.z;
    unsigned sum, cnt, mine, sp = 0u;
    for (;;) {
        sum = 0u; cnt = 0u; mine = 0u;
#pragma unroll
        for (unsigned j = 0; j < 16; ++j) { const unsigned c = xb_ld(&bar[XB_XCNT(j)]); sum += c; cnt += (c > 0u) ? 1u : 0u; mine = (j == x) ? c : mine; }
        if (sum == G) break;
        __builtin_amdgcn_s_sleep(1);
        if ((++sp & 255u) == 0u) { if (xb_ld(&bar[XB_TMO])) break; if (sp > XB_SPIN_CAP) { atomicAdd(&bar[XB_TMO], 1u); break; } }
    }
    nloc = mine > 0u ? mine : 1u; nx = cnt > 0u ? cnt : 1u;
}
__device__ __forceinline__ void xcd_barrier(const XcdBarrier& b, bool t0) {
    asm volatile("s_waitcnt vmcnt(0)" ::: "memory");
    __syncthreads();
    if (t0) {
        unsigned* bar = b.bar;
        __builtin_amdgcn_s_waitcnt(0);
        unsigned nloc = b.st[0], nx = b.st[1];
        if (nloc == 0u) { xcd_barrier_complete(bar, b.x, nloc, nx); b.st[0] = nloc; b.st[1] = nx; }
        const unsigned old = xb_add(&bar[XB_XSUB(b.x)], 1u);
        const unsigned gen = old / nloc;
        if (old + 1u == (gen + 1u) * nloc) {
            __builtin_amdgcn_fence(__ATOMIC_RELEASE, "agent");
            asm volatile("s_waitcnt vmcnt(0)" ::: "memory");
            const unsigned og = xb_add(&bar[XB_TOP], 1u);
            const unsigned tg = og / nx;
            if (og + 1u == (tg + 1u) * nx) xb_add(&bar[XB_TOPGEN], 1u);
            else XB_SPIN(xb_ld(&bar[XB_TOPGEN]) == tg, bar);
            __builtin_amdgcn_fence(__ATOMIC_ACQUIRE, "agent");
            xb_add(&bar[XB_XGEN(b.x)], 1u);
            asm volatile("s_waitcnt vmcnt(0)" ::: "memory");
        } else {
            XB_SPIN(xb_ld(&bar[XB_XGEN(b.x)]) == gen, bar);
            __builtin_amdgcn_fence(__ATOMIC_ACQUIRE, "agent");
            asm volatile("s_waitcnt vmcnt(0)" ::: "memory");
        }
    }
    __syncthreads();
}

namespace pg8 {
#ifndef PG8_WGM
#define PG8_WGM 4
#endif
constexpr int BM = 256, BK = 64, HALF = 128, HTB = HALF * BK * 2, STAGE_BYTES = 8 * HTB, NXCD = 8, WGM = PG8_WGM;
__host__ __device__ __forceinline__ int lds_byte(int r, int c) { const int st = (r >> 4) * 2 + (c >> 5), rr = r & 15, cc = c & 31, ob = rr * 64 + cc * 2; return st * 1024 + (ob ^ (((ob >> 9) & 1) << 5)); }
__host__ __device__ __forceinline__ void stage_rc(int b, int& R, int& C) { const int st = b / 1024, sb = b % 1024, swz = sb ^ (((sb >> 9) & 1) << 5); R = (st >> 1) * 16 + swz / 64; C = (st & 1) * 32 + (swz % 64) / 2; }
__host__ __device__ __forceinline__ int perm32(int rho) { const int n = rho >> 4, i = rho & 15; return 8 * (i >> 2) + 4 * n + (i & 3); }

struct Unit { int pm, pn, e; };
struct Gemm { const void* A; const void* Bt; };
template <int LDA_, int LDB_, int KB_, size_t SB_> struct GShape { static constexpr int LDA = LDA_, LDB = LDB_, KB = KB_; static constexpr size_t SB = SB_; };

__device__ __forceinline__ bool order_map(int L, int nM, int nN, int& pm, int& pn) {
    const int nwg = nM * nN; if (L >= nwg) return false;
    int wgid = L; { const int q = nwg / NXCD, r = nwg % NXCD, xcd = wgid % NXCD, off = wgid / NXCD; wgid = (xcd < r ? xcd * (q + 1) : r * (q + 1) + (xcd - r) * q) + off; }
    const int nig = WGM * nN, gid = wgid / nig, fm = gid * WGM, gsz = (nM - fm) < WGM ? (nM - fm) : WGM;
    pm = fm + ((wgid % nig) % gsz); pn = (wgid % nig) / gsz; return true;
}
struct StaticOrder {
    int nM, nN, G, c;
    __device__ void init(int M, int N, int G_, int c_) { nM = M / BM; nN = N / BM; G = G_; c = c_; }
    __device__ __forceinline__ bool next(int i, Unit& u) const { u.e = 0; return order_map(i * G + c, nM, nN, u.pm, u.pn); }
};
struct MoeOrder {
    int nM, nN, G, c; const LAS int* t2e;
    __device__ __forceinline__ bool next(int i, Unit& u) const { if (!order_map(i * G + c, nM, nN, u.pm, u.pn)) return false; u.e = __builtin_amdgcn_readfirstlane(t2e[u.pm]); return true; }
};

__device__ __forceinline__ unsigned cvt_pk_bf16(float lo, float hi) { return pk2(lo, hi); }

struct EpiBf16 {
    static constexpr bool PERM = true; static constexpr int NSTORES = 16;
    bf16_t* O; int ldc; const float* bias; int bias_stride;
    __device__ __forceinline__ void operator()(const f32x4 (&acc)[2][2][4][2], const Unit& u, int wr, int wc, int fr, int fq) const {
        const int row0 = u.pm * BM + wr * 64 + fr; const int col0 = u.pn * BM + wc * 32 + 8 * fq;
        f32x4 bv[2][2];
#pragma unroll
        for (int bj = 0; bj < 2; ++bj)
#pragma unroll
            for (int n = 0; n < 2; ++n) bv[bj][n] = bias ? *(const f32x4*)(bias + (size_t)u.e * bias_stride + col0 + bj * HALF + 4 * n) : (f32x4){0.f, 0.f, 0.f, 0.f};
#pragma unroll
        for (int ai = 0; ai < 2; ++ai)
#pragma unroll
            for (int m = 0; m < 4; ++m) { bf16_t* rowp = O + (size_t)(row0 + ai * HALF + m * 16) * ldc + col0;
#pragma unroll
                for (int bj = 0; bj < 2; ++bj) { const f32x4 v0 = acc[ai][bj][m][0] + bv[bj][0], v1 = acc[ai][bj][m][1] + bv[bj][1];
                    u32x4 w; w.x = cvt_pk_bf16(v0[0], v0[1]); w.y = cvt_pk_bf16(v0[2], v0[3]); w.z = cvt_pk_bf16(v1[0], v1[1]); w.w = cvt_pk_bf16(v1[2], v1[3]);
                    *(u32x4*)(rowp + bj * HALF) = w; } }
    }
};
struct EpiF32Res {
    static constexpr bool PERM = false;
    float* C; const float* resid; int ldc;
    __device__ __forceinline__ void operator()(const f32x4 (&acc)[2][2][4][2], const Unit& u, int wr, int wc, int fr, int fq) const {
        const int row0 = u.pm * BM + wr * 64 + fr, col0 = u.pn * BM + wc * 32 + 4 * fq;
#pragma unroll
        for (int ai = 0; ai < 2; ++ai)
#pragma unroll
            for (int m = 0; m < 4; ++m) { const size_t off = (size_t)(row0 + ai * HALF + m * 16) * ldc + col0;
#pragma unroll
                for (int bj = 0; bj < 2; ++bj)
#pragma unroll
                    for (int n = 0; n < 2; ++n) { const f32x4 r = *(const f32x4*)(resid + off + bj * HALF + n * 16); *(f32x4*)(C + off + bj * HALF + n * 16) = acc[ai][bj][m][n] + r; } }
    }
};
struct EpiSwiGLU {
    static constexpr bool PERM = true;
    bf16_t* O; int ldc; const float* bias;
    __device__ __forceinline__ void operator()(const f32x4 (&acc)[2][2][4][2], const Unit& u, int wr, int wc, int fr, int fq) const {
        const int row0 = u.pm * BM + wr * 64 + fr; const int j0 = u.pn * HALF + wc * 32 + 8 * fq;
        const float* be = bias + (size_t)u.e * 4096;
        f32x4 bg[2], bu[2];
#pragma unroll
        for (int n = 0; n < 2; ++n) { bg[n] = *(const f32x4*)(be + j0 + 4 * n); bu[n] = *(const f32x4*)(be + 2048 + j0 + 4 * n); }
#pragma unroll
        for (int ai = 0; ai < 2; ++ai)
#pragma unroll
            for (int m = 0; m < 4; ++m) { bf16_t* rowp = O + (size_t)(row0 + ai * HALF + m * 16) * ldc + j0;
                float o[8];
#pragma unroll
                for (int n = 0; n < 2; ++n) { const f32x4 g = acc[ai][0][m][n] + bg[n], up = acc[ai][1][m][n] + bu[n];
#pragma unroll
                    for (int q = 0; q < 4; ++q) { const float gt = fminf(g[q], 7.0f), ut = fminf(fmaxf(up[q], -7.0f), 7.0f);
                        const float glu = gt * __builtin_amdgcn_rcpf(1.0f + __expf(-1.702f * gt)); o[4 * n + q] = (ut + 1.0f) * glu; } }
                u32x4 w; w.x = cvt_pk_bf16(o[0], o[1]); w.y = cvt_pk_bf16(o[2], o[3]); w.z = cvt_pk_bf16(o[4], o[5]); w.w = cvt_pk_bf16(o[6], o[7]);
                *(u32x4*)rowp = w; }
    }
};

struct EpiBf16Res {
    static constexpr bool PERM = true; static constexpr int NSTORES = 16;
    bf16_t* O; const float* resid; int ldc;
    __device__ __forceinline__ void operator()(const f32x4 (&acc)[2][2][4][2], const Unit& u, int wr, int wc, int fr, int fq) const {
        const int row0 = u.pm * BM + wr * 64 + fr; const int col0 = u.pn * BM + wc * 32 + 8 * fq;
#pragma unroll
        for (int ai = 0; ai < 2; ++ai)
#pragma unroll
            for (int m = 0; m < 4; ++m) { const size_t off = (size_t)(row0 + ai * HALF + m * 16) * ldc + col0;
#pragma unroll
                for (int bj = 0; bj < 2; ++bj) { const f32x4 r0 = *(const f32x4*)(resid + off + bj * HALF), r1 = *(const f32x4*)(resid + off + bj * HALF + 4);
                    const f32x4 v0 = acc[ai][bj][m][0] + r0, v1 = acc[ai][bj][m][1] + r1;
                    u32x4 w; w.x = cvt_pk_bf16(v0[0], v0[1]); w.y = cvt_pk_bf16(v0[2], v0[3]); w.z = cvt_pk_bf16(v1[0], v1[1]); w.w = cvt_pk_bf16(v1[2], v1[3]);
                    *(u32x4*)(O + off + bj * HALF) = w; } }
    }
};
#ifndef USE_BIAS_LDS
#define USE_BIAS_LDS 1
#endif
template <int MODE = 0> struct EpiFp8S_ {
    static constexpr int NSTORES = 16;
    static constexpr bool PERM = true, BIAS_LDS = (USE_BIAS_LDS != 0);
    unsigned char* O; int ldc; const float* bias; int bias_stride; float scale, oscale;
    __device__ __forceinline__ const char* bias_base(const Unit& u) const { return (const char*)(bias + (size_t)u.e * bias_stride + u.pn * BM); }
    __device__ static __forceinline__ unsigned bias_voff(int i) { return (unsigned)i * 4u; }
    __device__ __forceinline__ void operator()(const f32x4 (&acc)[2][2][4][2], const Unit& u, int wr, int wc, int fr, int fq, const LAS float* bl) const {
        const int row0 = u.pm * BM + wr * 64 + fr; const int col0 = u.pn * BM + wc * 32 + 8 * fq;
        f32x4 bv[2][2];
#pragma unroll
        for (int bj = 0; bj < 2; ++bj)
#pragma unroll
            for (int n = 0; n < 2; ++n) { if constexpr (MODE == 2) bv[bj][n] = (f32x4){oscale, oscale, oscale, oscale}; else if constexpr (BIAS_LDS) bv[bj][n] = *(const LAS f32x4*)(bl + wc * 32 + 8 * fq + bj * HALF + 4 * n) * oscale; else bv[bj][n] = *(const f32x4*)(bias + (size_t)u.e * bias_stride + col0 + bj * HALF + 4 * n) * oscale; }
        const float sc = scale * oscale;
#pragma unroll
        for (int ai = 0; ai < 2; ++ai)
#pragma unroll
            for (int m = 0; m < 4; ++m) { unsigned char* rowp = O + (size_t)(row0 + ai * HALF + m * 16) * ldc + col0;
#pragma unroll
                for (int bj = 0; bj < 2; ++bj) { const f32x4 v0 = acc[ai][bj][m][0] * sc + bv[bj][0], v1 = acc[ai][bj][m][1] * sc + bv[bj][1];
                    u32x2 w; w.x = pk4_fp8(v0[0], v0[1], v0[2], v0[3]); w.y = pk4_fp8(v1[0], v1[1], v1[2], v1[3]);
                    if constexpr (MODE == 1) { if (u.pm < 0) *(u32x2*)(rowp + bj * HALF) = w; else asm volatile("" :: "v"(w)); } else *(u32x2*)(rowp + bj * HALF) = w; } }
    }
};
using EpiFp8S = EpiFp8S_<0>;
struct EpiSwiGLU8 {
    static constexpr bool PERM = true, BIAS_LDS = (USE_BIAS_LDS != 0); static constexpr int NSTORES = 8;
    unsigned char* O; int ldc; const float* bias;
    struct Bias { f32x4 bg[2], bu[2];
        __device__ __forceinline__ void pin() { asm volatile("" : "+v"(bg[0]), "+v"(bg[1]), "+v"(bu[0]), "+v"(bu[1])); } };
    __device__ __forceinline__ const char* bias_base(const Unit& u) const { return (const char*)(bias + (size_t)u.e * 4096 + u.pn * HALF); }
    __device__ static __forceinline__ unsigned bias_voff(int i) { return (unsigned)(i < 128 ? i : 2048 - 128 + i) * 4u; }
    __device__ __forceinline__ void load_bias(const Unit& u, int wc, int fq, Bias& b, const LAS float* bl) const {
        const int j0 = wc * 32 + 8 * fq;
        if constexpr (BIAS_LDS) {
#pragma unroll
            for (int n = 0; n < 2; ++n) { b.bg[n] = *(const LAS f32x4*)(bl + j0 + 4 * n); b.bu[n] = *(const LAS f32x4*)(bl + 128 + j0 + 4 * n); }
        } else { const float* be = bias + (size_t)u.e * 4096 + u.pn * HALF + j0;
#pragma unroll
            for (int n = 0; n < 2; ++n) { b.bg[n] = *(const f32x4*)(be + 4 * n); b.bu[n] = *(const f32x4*)(be + 2048 + 4 * n); } } }
    __device__ __forceinline__ void operator()(const f32x4 (&acc)[2][2][4][2], const Unit& u, int wr, int wc, int fr, int fq, const LAS float* bl) const { Bias b; load_bias(u, wc, fq, b, bl); apply(acc, u, wr, wc, fr, fq, b); }
    __device__ __forceinline__ void apply(const f32x4 (&acc)[2][2][4][2], const Unit& u, int wr, int wc, int fr, int fq, const Bias& b) const {
        const int row0 = u.pm * BM + wr * 64 + fr; const int j0 = u.pn * HALF + wc * 32 + 8 * fq;
        const f32x4 (&bg)[2] = b.bg; const f32x4 (&bu)[2] = b.bu;
#pragma unroll
        for (int ai = 0; ai < 2; ++ai)
#pragma unroll
            for (int m = 0; m < 4; ++m) { unsigned char* rowp = O + (size_t)(row0 + ai * HALF + m * 16) * ldc + j0;
                float o[8];
#pragma unroll
                for (int n = 0; n < 2; ++n) { const f32x4 g = acc[ai][0][m][n] * (1.0f / 8192.0f) + bg[n], up = acc[ai][1][m][n] * (1.0f / 8192.0f) + bu[n];
#pragma unroll
                    for (int q = 0; q < 4; ++q) { const float gt = fminf(g[q], 7.0f), ut = __builtin_amdgcn_fmed3f(up[q], -7.0f, 7.0f);
                        const float glu = gt * __builtin_amdgcn_rcpf(1.0f + __builtin_amdgcn_exp2f(-2.4554669595930156f * gt)); o[4 * n + q] = __builtin_fmaf(ut, 4.0f, 4.0f) * glu; } }
                u32x2 w; w.x = pk4_fp8_nc(o[0], o[1], o[2], o[3]); w.y = pk4_fp8_nc(o[4], o[5], o[6], o[7]);
                *(u32x2*)rowp = w; }
    }
};
template <int ALL> struct EpiNull_ { static constexpr bool PERM = true;
    __device__ __forceinline__ void operator()(const f32x4 (&acc)[2][2][4][2], const Unit& u, int wr, int wc, int fr, int fq) const {
        if constexpr (ALL == 0) asm volatile("" :: "v"(acc[0][0][0][0]), "v"(acc[1][1][3][1]));
        else {
#pragma unroll
        for (int a = 0; a < 2; ++a)
#pragma unroll
            for (int b = 0; b < 2; ++b) asm volatile("" :: "v"(acc[a][b][0][0]), "v"(acc[a][b][0][1]), "v"(acc[a][b][1][0]), "v"(acc[a][b][1][1]), "v"(acc[a][b][2][0]), "v"(acc[a][b][2][1]), "v"(acc[a][b][3][0]), "v"(acc[a][b][3][1])); } } };
using EpiNull = EpiNull_<1>;
struct EpiBf16S {
    static constexpr bool PERM = true;
    bf16_t* O; int ldc; const float* bias; int bias_stride; float scale;
    __device__ __forceinline__ void operator()(const f32x4 (&acc)[2][2][4][2], const Unit& u, int wr, int wc, int fr, int fq) const {
        const int row0 = u.pm * BM + wr * 64 + fr; const int col0 = u.pn * BM + wc * 32 + 8 * fq;
        f32x4 bv[2][2];
#pragma unroll
        for (int bj = 0; bj < 2; ++bj)
#pragma unroll
            for (int n = 0; n < 2; ++n) bv[bj][n] = *(const f32x4*)(bias + (size_t)u.e * bias_stride + col0 + bj * HALF + 4 * n);
#pragma unroll
        for (int ai = 0; ai < 2; ++ai)
#pragma unroll
            for (int m = 0; m < 4; ++m) { bf16_t* rowp = O + (size_t)(row0 + ai * HALF + m * 16) * ldc + col0;
#pragma unroll
                for (int bj = 0; bj < 2; ++bj) { const f32x4 v0 = acc[ai][bj][m][0] * scale + bv[bj][0], v1 = acc[ai][bj][m][1] * scale + bv[bj][1];
                    u32x4 w; w.x = cvt_pk_bf16(v0[0], v0[1]); w.y = cvt_pk_bf16(v0[2], v0[3]); w.z = cvt_pk_bf16(v1[0], v1[1]); w.w = cvt_pk_bf16(v1[2], v1[3]);
                    *(u32x4*)(rowp + bj * HALF) = w; } }
    }
};

__device__ __forceinline__ i32x8 pg8_get8(const i32x32& v, int idx) { i32x8 r;
#pragma unroll
    for (int j = 0; j < 8; ++j) r[j] = v[8 * idx + j];
    return r; }
__device__ __forceinline__ i32x4 pg8_get4(const i32x32& v, int idx) { i32x4 r;
#pragma unroll
    for (int j = 0; j < 4; ++j) r[j] = v[4 * idx + j];
    return r; }
struct NoHost { static constexpr bool ON = false; static constexpr int N = 0; };
template <int N_> struct EpiHost {
    static constexpr bool ON = true; static constexpr int N = N_;
    const float* W; unsigned char* WT; int cid, cend, cstride; int ldw, cbs, gu, e0; int pend[N_];
    __device__ __forceinline__ void issue(unsigned (&x)[16 * N_], int lane) {
        const unsigned vo = (unsigned)lane * 4u; const size_t rowb = (size_t)ldw * 4;
#pragma unroll
        for (int j = 0; j < N_; ++j) { const int id = cid < cend ? cid : cend - 1; pend[j] = id; cid += cstride;
            const int cb = id & ((1 << cbs) - 1), kb = (id >> cbs) & 127, e = e0 + (id >> (cbs + 7));
            const char* rb = (const char*)(W + (size_t)e * DM * ldw + (size_t)(16 * kb) * ldw + 64 * cb);
#pragma unroll
            for (int i = 0; i < 16; ++i) asm volatile("s_nop 4\n\tglobal_load_dword %0, %1, %2" : "=v"(x[16 * j + i]) : "v"(vo), "s"(rb + (size_t)i * rowb) : "memory"); }
    }
    __device__ __forceinline__ void finish(const unsigned (&x)[16 * N_], int lane) const {
#pragma unroll
        for (int j = 0; j < N_; ++j) { const int id = pend[j]; const int cb = id & ((1 << cbs) - 1), kb = (id >> cbs) & 127, e = e0 + (id >> (cbs + 7)); const int n0 = 64 * cb;
            const int drow0 = !gu ? n0 : (n0 < 2048) ? (256 * (n0 >> 7) + (n0 & 127)) : (256 * ((n0 - 2048) >> 7) + 128 + ((n0 - 2048) & 127));
            u32x4 o;
#pragma unroll
            for (int q = 0; q < 4; ++q) o[q] = pk4_fp8(__builtin_bit_cast(float, x[16 * j + 4 * q]) * 512.0f, __builtin_bit_cast(float, x[16 * j + 4 * q + 1]) * 512.0f, __builtin_bit_cast(float, x[16 * j + 4 * q + 2]) * 512.0f, __builtin_bit_cast(float, x[16 * j + 4 * q + 3]) * 512.0f);
            *(u32x4*)(WT + (size_t)e * ldw * DM + (size_t)(drow0 + lane) * DM + 16 * kb) = o; }
    }
};
struct NoGather { static constexpr bool ON = false; };
struct Gather { static constexpr bool ON = true; const unsigned short* list; const LAS unsigned* pbase; const LAS unsigned* cnt; };
__device__ __forceinline__ unsigned gather_clamp(unsigned P, int r0, int cn) { const unsigned lo = (r0 < cn) ? (P & 0xffffu) : 0u, hi = (r0 + 64 < cn) ? (P >> 16) : 0u; return lo | (hi << 16); }
struct NoConv { static constexpr bool ON = false; };
struct ConvGU {
    static constexpr bool ON = true;
    const float* W; unsigned char* WT; int cid, cend, cstride, pend; const char* rbase;
    __device__ __forceinline__ void issue(unsigned (&x)[16], int lane) {
        const int id = cid < cend ? cid : cend - 1; pend = id; cid += cstride;
        const int e = id >> 13, kb = (id >> 6) & 127, cb = id & 63;
        const char* rb = (const char*)(W + (size_t)e * DM * 4096 + (size_t)(16 * kb) * 4096 + 64 * cb);
        const unsigned vo = (unsigned)lane * 4u; rbase = rb;
#pragma unroll
        for (int i = 0; i < 8; ++i) asm volatile("s_nop 4\n\tglobal_load_dword %0, %1, %2" : "=v"(x[i]) : "v"(vo), "s"(rb + (size_t)i * 16384) : "memory");
    }
    __device__ __forceinline__ void issue_b(unsigned (&x)[16], int lane) {
        const unsigned vo = (unsigned)lane * 4u;
#pragma unroll
        for (int i = 8; i < 16; ++i) asm volatile("s_nop 4\n\tglobal_load_dword %0, %1, %2" : "=v"(x[i]) : "v"(vo), "s"(rbase + (size_t)i * 16384) : "memory");
    }
    __device__ __forceinline__ void finish(const unsigned (&x)[16], int lane) const {
        const int id = pend; const int e = id >> 13, kb = (id >> 6) & 127, cb = id & 63; const int n0 = 64 * cb;
        const int drow0 = (n0 < 2048) ? (256 * (n0 >> 7) + (n0 & 127)) : (256 * ((n0 - 2048) >> 7) + 128 + ((n0 - 2048) & 127));
        u32x4 o;
#pragma unroll
        for (int q = 0; q < 4; ++q) o[q] = pk4_fp8(__builtin_bit_cast(float, x[4 * q]) * 512.0f, __builtin_bit_cast(float, x[4 * q + 1]) * 512.0f, __builtin_bit_cast(float, x[4 * q + 2]) * 512.0f, __builtin_bit_cast(float, x[4 * q + 3]) * 512.0f);
        *(u32x4*)(WT + (size_t)e * 4096 * DM + (size_t)(drow0 + lane) * DM + 16 * kb) = o;
    }
};
#define PG8_X16A(x, b) "+v"(x[b+0]), "+v"(x[b+1]), "+v"(x[b+2]), "+v"(x[b+3]), "+v"(x[b+4]), "+v"(x[b+5]), "+v"(x[b+6]), "+v"(x[b+7]), "+v"(x[b+8]), "+v"(x[b+9]), "+v"(x[b+10]), "+v"(x[b+11]), "+v"(x[b+12]), "+v"(x[b+13]), "+v"(x[b+14]), "+v"(x[b+15])
#define PG8_X16(x) "+v"(x[0]), "+v"(x[1]), "+v"(x[2]), "+v"(x[3]), "+v"(x[4]), "+v"(x[5]), "+v"(x[6]), "+v"(x[7]), "+v"(x[8]), "+v"(x[9]), "+v"(x[10]), "+v"(x[11]), "+v"(x[12]), "+v"(x[13]), "+v"(x[14]), "+v"(x[15])

template <class E, class = void> struct epi_nstores { static constexpr int value = 0; };
template <class E> struct epi_nstores<E, decltype((void)E::NSTORES)> { static constexpr int value = E::NSTORES; };
template <class E, class = void> struct epi_takes_bl { static constexpr bool value = false; };
template <class E> struct epi_takes_bl<E, decltype((void)E::BIAS_LDS)> { static constexpr bool value = true; };
template <class E, class = void> struct has_bias_lds { static constexpr bool value = false; };
template <class E> struct has_bias_lds<E, decltype((void)E::BIAS_LDS)> { static constexpr bool value = E::BIAS_LDS; };
constexpr int BIAS_LDS_OFF = MISC_OFF + 4096;
#ifndef CV_XMASK
#define CV_XMASK 0
#endif
template <class Epi, class Sched, class GS, bool ALIGN_EPI = true, bool F8 = false, int STAGGER_TICKS = 0, class CV = NoConv, class EH = NoHost, bool KROT = false, class GI = NoGather, bool FLP = false>
__device__ __forceinline__ void gemm_phase(LAS unsigned char* lds, const Gemm g, const Sched& S, const Epi& E, int wave, CV cv = CV(), EH eh = EH(), GI gi = GI()) {
    const int wid = wave, lane = fresh_lane(), tid = wid * 64 + lane, wr = wid >> 2, wc = wid & 3, fr = lane & 15, fq = lane >> 4;
    constexpr int nt = GS::KB / 128;
    unsigned voffA, voffB;
    { int R, C; stage_rc(tid * 16, R, C); const int Rb = Epi::PERM ? ((R & ~31) + perm32(R & 31)) : R;
      voffA = (unsigned)(R * GS::LDA + C * 2); voffB = (unsigned)(Rb * GS::LDB + C * 2);
      if constexpr (FLP) { const int b = tid * 16; voffA = (unsigned)((b >> 7) * GS::LDA + (b & 127)); voffB = (unsigned)((b >> 7) * GS::LDB + (b & 127)); } }
    constexpr size_t pstepA = (size_t)64 * GS::LDA, pstepB = (size_t)64 * GS::LDB;
    constexpr size_t kstep = (size_t)(BK * 2);
    constexpr size_t hstepA = (size_t)HALF * GS::LDA, hstepB = (size_t)HALF * GS::LDB;
    constexpr size_t tstepA = 2 * hstepA, tstepB = 2 * hstepB;
    const unsigned ldsw = (unsigned)wid * 1024u;
    const unsigned ldsb = (unsigned)(size_t)lds + ldsw;
    const int aoff = lds_byte(wr * 64 + fr, F8 ? fq * 16 : fq * 8), boff = lds_byte(wc * 32 + fr, F8 ? fq * 16 : fq * 8);
    const int kofs = F8 ? 16 : 1024;
#define PG8_SA(b, h) (((b) * 2 + (h)) * HTB)
#define PG8_SB(b, h) ((4 + (b) * 2 + (h)) * HTB)
#define PG8_STAGE(bufoff, gbase, voff) do { _Pragma("unroll") for (int _i = 0; _i < 2; ++_i) { unsigned _keep; \
        asm volatile("s_mov_b32 %0, m0\n\ts_mov_b32 m0, %3\n\ts_nop 3\n\tglobal_load_lds_dwordx4 %1, %2\n\ts_mov_b32 m0, %0" \
            : "=&s"(_keep) : "v"(voff##_v), "s"((const char*)(gbase) + _i * pstep##voff), "s"(ldsb + (unsigned)((bufoff) + _i * 8192)) : "memory"); } } while (0)
#define PG8_STAGE_GA(bufoff, kp, vlo, vhi) do { unsigned _keep; \
        asm volatile("s_mov_b32 %0, m0\n\ts_mov_b32 m0, %3\n\ts_nop 3\n\tglobal_load_lds_dwordx4 %1, %2\n\ts_mov_b32 m0, %0" : "=&s"(_keep) : "v"(vlo), "s"((const char*)(kp)), "s"(ldsb + (unsigned)(bufoff)) : "memory"); \
        asm volatile("s_mov_b32 %0, m0\n\ts_mov_b32 m0, %3\n\ts_nop 3\n\tglobal_load_lds_dwordx4 %1, %2\n\ts_mov_b32 m0, %0" : "=&s"(_keep) : "v"(vhi), "s"((const char*)(kp)), "s"(ldsb + (unsigned)((bufoff) + 8192)) : "memory"); } while (0)
#define PG8_STA(bufoff, kp, h, nx) do { if constexpr (GI::ON) { const unsigned _p = (nx) ? nvP[h] : voP[h]; const unsigned _lo = ((_p & 0xffffu) << 11) + gcb, _hi = ((_p >> 16) << 11) + gcb; PG8_STAGE_GA(bufoff, kp, _lo, _hi); } \
        else PG8_STAGE(bufoff, (kp) + (h) * hstepA, voffA); } while (0)
#define pstepvoffA pstepA
#define pstepvoffB pstepB
#define voffA_v voffA
#define voffB_v voffB
#define PG8_LD16(p) (*(const LAS i32x4*)(p))
#define PG8_SET8(V, idx, lo, hi) do { _Pragma("unroll") for (int _j = 0; _j < 4; ++_j) { V[8 * (idx) + _j] = (lo)[_j]; V[8 * (idx) + 4 + _j] = (hi)[_j]; } } while (0)
#define PG8_GET8(V, idx) pg8_get8(V, idx)
#define PG8_GETLO(V, idx) __builtin_bit_cast(bf16x8, pg8_get4(V, 2 * (idx)))
#define PG8_GETHI(V, idx) __builtin_bit_cast(bf16x8, pg8_get4(V, 2 * (idx) + 1))
#define PG8_LDA(dst, b, h) do { _Pragma("unroll") for (int m = 0; m < 4; ++m) { const i32x4 _lo = PG8_LD16(lds + PG8_SA(b, h) + aoff + m * 2048), _hi = PG8_LD16(lds + PG8_SA(b, h) + aoff + m * 2048 + kofs); \
        PG8_SET8(AV, m, _lo, _hi); } } while (0)
#define PG8_LDB(dst, b, h) do { _Pragma("unroll") for (int n = 0; n < 2; ++n) { const i32x4 _lo = PG8_LD16(lds + PG8_SB(b, h) + boff + n * 2048), _hi = PG8_LD16(lds + PG8_SB(b, h) + boff + n * 2048 + kofs); \
        PG8_SET8(BV, (dst) + n, _lo, _hi); } } while (0)
#define PG8_MMA(ai, bj, At, Bt) do { __builtin_amdgcn_s_setprio(1); \
        if constexpr (F8) { _Pragma("unroll") for (int m = 0; m < 4; ++m) _Pragma("unroll") for (int n = 0; n < 2; ++n) \
            acc[ai][bj][m][n] = __builtin_amdgcn_mfma_scale_f32_16x16x128_f8f6f4(PG8_GET8(BV, (Bt) + n), PG8_GET8(AV, m), acc[ai][bj][m][n], 0, 0, 0, 0, 0, 0); } \
        else { _Pragma("unroll") for (int m = 0; m < 4; ++m) _Pragma("unroll") for (int n = 0; n < 2; ++n) { \
            acc[ai][bj][m][n] = __builtin_amdgcn_mfma_f32_16x16x32_bf16(PG8_GETLO(BV, (Bt) + n), PG8_GETLO(AV, m), acc[ai][bj][m][n], 0, 0, 0); \
            acc[ai][bj][m][n] = __builtin_amdgcn_mfma_f32_16x16x32_bf16(PG8_GETHI(BV, (Bt) + n), PG8_GETHI(AV, m), acc[ai][bj][m][n], 0, 0, 0); } } \
        __builtin_amdgcn_s_setprio(0); } while (0)
#define PG8_WAIT_V(n) asm volatile("s_waitcnt vmcnt(" #n ")" ::: "memory")
#define PG8_WAIT_L(n) asm volatile("s_waitcnt lgkmcnt(" #n ")" ::: "memory")
#define PG8_BAR __builtin_amdgcn_s_barrier()
#define PG8_SCHED __builtin_amdgcn_sched_barrier(0)
    Unit cur, nxt; int ui = 0;
    if (!S.next(0, cur)) return;
    constexpr bool BL = has_bias_lds<Epi>::value;
    constexpr int NST = EH::ON ? EH::N : epi_nstores<Epi>::value;
#define PG8_WAIT_VN(n) asm volatile("s_waitcnt vmcnt(%0)" :: "n"(n) : "memory")
    static_assert(!(BL && CV::ON), "the counted waits below know one or the other");
    unsigned bx = 0;
    unsigned cx[16];
    if constexpr (CV::ON) { cv.issue(cx, lane); cv.issue_b(cx, lane); asm volatile("s_waitcnt vmcnt(0)" ::: "memory"); asm volatile("" : PG8_X16(cx) :: "memory"); }
    if constexpr (STAGGER_TICKS > 0) {
        if (blockIdx.x & 1) { const unsigned long long t0 = __builtin_amdgcn_s_memrealtime(); while (__builtin_amdgcn_s_memrealtime() - t0 < (unsigned long long)STAGGER_TICKS) __builtin_amdgcn_s_sleep(8); } }
    i32x32 AV, BV;
    constexpr int At = 0, B0 = 0, B1 = 2;
    static_assert(!GI::ON || GS::LDA == 2048, "gather: 2 KiB token rows");
    int tfetch = 0; if constexpr (GI::ON) asm volatile("s_mov_b32 %0, 0" : "=s"(tfetch));
    unsigned voP[2] = {0u, 0u}, nvP[2] = {0u, 0u}, gcb = 0u;
    if constexpr (GI::ON) { int R, C; stage_rc(tid * 16, R, C); gcb = (unsigned)(C * 2);
        const int lb = cur.pm * BM - __builtin_amdgcn_readfirstlane((int)gi.pbase[cur.e]), cn = __builtin_amdgcn_readfirstlane((int)gi.cnt[cur.e]);
        const u32x2 pr = *(const u32x2*)(gi.list + (size_t)cur.e * 16384 + lb + 4 * R);
        voP[0] = gather_clamp(pr.x, lb + R, cn); voP[1] = gather_clamp(pr.y, lb + R + 128, cn); }
    const char* cA = GI::ON ? (const char*)g.A : (const char*)g.A + (size_t)cur.pm * tstepA; const char* cB = (const char*)g.Bt + (size_t)cur.e * GS::SB + (size_t)cur.pn * tstepB;
#define PG8_KO(u) (KROT ? ((((u).pn & 7) * 2 + ((u).pm & 3) * 4) * (nt / 16)) & (nt - 1) : 0)
    int ko = PG8_KO(cur);
    { const char* pA = cA + (size_t)ko * kstep; const char* pB = cB + (size_t)ko * kstep;
    PG8_STAGE(PG8_SB(0, 0), pB, voffB); PG8_SCHED; PG8_STAGE(PG8_SB(0, 1), pB + hstepB, voffB); PG8_SCHED; PG8_STA(PG8_SA(0, 0), pA, 0, false); PG8_SCHED; PG8_STA(PG8_SA(0, 1), pA, 1, false); PG8_SCHED;
    if (wr == 1) PG8_BAR;
    PG8_WAIT_V(2); PG8_BAR;
    PG8_STAGE(PG8_SB(1, 0), pB + kstep, voffB); PG8_SCHED; PG8_STA(PG8_SA(1, 0), pA + kstep, 0, false); PG8_SCHED; PG8_STAGE(PG8_SB(1, 1), pB + hstepB + kstep, voffB); PG8_SCHED; }
    PG8_WAIT_V(6); PG8_BAR; PG8_SCHED;
    f32x4 acc[2][2][4][2];
#pragma unroll
    for (int a = 0; a < 2; ++a)
#pragma unroll
        for (int b = 0; b < 2; ++b)
#pragma unroll
            for (int m = 0; m < 4; ++m)
#pragma unroll
                for (int n = 0; n < 2; ++n) acc[a][b][m][n] = (f32x4){0.f, 0.f, 0.f, 0.f};
    for (;;) {
        const bool has_next = S.next(ui + 1, nxt);
        const char* nA = (has_next && !GI::ON) ? (const char*)g.A + (size_t)nxt.pm * tstepA : cA;
        const char* nB = has_next ? (const char*)g.Bt + (size_t)nxt.e * GS::SB + (size_t)nxt.pn * tstepB : cB;
        const int nko = has_next ? PG8_KO(nxt) : ko;
        for (int t = 0; t < nt; t += 2) {
            const bool last = (t == nt - 2);
            const int kt = KROT ? ((ko + t) & (nt - 1)) : t, kt2 = KROT ? ((ko + t + 2) & (nt - 1)) : t + 2;
            const char* a1 = cA + (size_t)(kt + 1) * kstep;
            const char* a2 = last ? nA + (size_t)nko * kstep : cA + (size_t)kt2 * kstep; const char* b2 = last ? nB + (size_t)nko * kstep : cB + (size_t)kt2 * kstep;
            const char* a3 = a2 + kstep; const char* b3 = b2 + kstep;
            PG8_LDB(B0, 0, 0); PG8_LDB(B1, 0, 1); PG8_SCHED; PG8_LDA(At, 0, 0); PG8_STA(PG8_SA(1, 1), a1, 1, false);
            PG8_WAIT_V(8);
            if constexpr (CV::ON) asm volatile("" : PG8_X16(cx));
            PG8_WAIT_L(0); PG8_BAR;
            const bool xon = CV::ON && ((t & CV_XMASK) == 0);
            if constexpr (CV::ON) { if (xon) { cv.finish(cx, lane); cv.issue(cx, lane); } }
            if constexpr (GI::ON) { if (t == tfetch && has_next) {
                int R, C; stage_rc((wid * 64 + fresh_lane()) * 16, R, C); const unsigned lvo = (unsigned)R * 8u;
                const char* lp = (const char*)(gi.list + (size_t)nxt.e * 16384 + (nxt.pm * BM - __builtin_amdgcn_readfirstlane((int)gi.pbase[nxt.e])));
                u32x2 pr; asm volatile("s_nop 4\n\tglobal_load_dwordx2 %0, %1, %2" : "=&v"(pr) : "v"(lvo), "s"(lp) : "memory"); nvP[0] = pr.x; nvP[1] = pr.y; } }
            if constexpr (BL) { if (last) { const unsigned bvo = Epi::bias_voff((wid * 64 + fresh_lane()) & 255);
                asm volatile("s_nop 4\n\tglobal_load_dword %0, %1, %2" : "=v"(bx) : "v"(bvo), "s"(E.bias_base(cur)) : "memory"); } }
            PG8_MMA(0, 0, At, B0); PG8_MMA(0, 1, At, B1); PG8_BAR; PG8_SCHED;
            PG8_LDA(At, 0, 1); PG8_STAGE(PG8_SB(0, 0), b2, voffB); PG8_STAGE(PG8_SB(0, 1), b2 + hstepB, voffB); PG8_STA(PG8_SA(0, 0), a2, 0, last);
            if (xon) PG8_WAIT_V(17); else if (BL && last) PG8_WAIT_V(9); else if (GI::ON && t == tfetch && has_next) PG8_WAIT_V(9); else PG8_WAIT_V(8);
            PG8_WAIT_L(0); PG8_BAR;
            if constexpr (CV::ON) { if (xon) cv.issue_b(cx, lane); }
            PG8_MMA(1, 0, At, B0); PG8_MMA(1, 1, At, B1); PG8_BAR; PG8_SCHED;
            PG8_LDB(B0, 1, 0); PG8_LDB(B1, 1, 1); PG8_SCHED; PG8_LDA(At, 1, 0); PG8_STA(PG8_SA(0, 1), a2, 1, last);
            if (xon) PG8_WAIT_V(25); else PG8_WAIT_V(8);
            if constexpr (GI::ON) { if (t == tfetch && has_next) { asm volatile("" : "+v"(nvP[0]), "+v"(nvP[1]));
                int R, C; stage_rc((wid * 64 + fresh_lane()) * 16, R, C); const int lb = nxt.pm * BM - __builtin_amdgcn_readfirstlane((int)gi.pbase[nxt.e]), cn = __builtin_amdgcn_readfirstlane((int)gi.cnt[nxt.e]);
                nvP[0] = gather_clamp(nvP[0], lb + R, cn); nvP[1] = gather_clamp(nvP[1], lb + R + 128, cn); } }
            if constexpr (BL) { if (last) { asm volatile("" : "+v"(bx));
                *(LAS unsigned*)(lds + BIAS_LDS_OFF + 4 * ((wid * 64 + fresh_lane()) & 255)) = bx; } }
            PG8_WAIT_L(0); PG8_BAR; PG8_MMA(0, 0, At, B0); PG8_MMA(0, 1, At, B1); PG8_BAR; PG8_SCHED;
            PG8_LDA(At, 1, 1); PG8_STAGE(PG8_SB(1, 0), b3, voffB); PG8_STAGE(PG8_SB(1, 1), b3 + hstepB, voffB); PG8_STA(PG8_SA(1, 0), a3, 0, last);
            if constexpr (CV::ON) { if (xon) PG8_WAIT_V(16); else PG8_WAIT_V(8); } else PG8_WAIT_V(8);
            PG8_WAIT_L(0); PG8_BAR; PG8_MMA(1, 0, At, B0); PG8_MMA(1, 1, At, B1); PG8_BAR; PG8_SCHED;
        }
        if constexpr (ALIGN_EPI) { if (wr == 0) PG8_BAR; }
        { const int l2 = fresh_lane();
          const LAS float* bl = (const LAS float*)(lds + BIAS_LDS_OFF);
          if constexpr (EH::ON) {
              unsigned ex[16 * EH::N]; typename Epi::Bias eb;
              if constexpr (BL) { eh.issue(ex, l2); E.load_bias(cur, wc, l2 >> 4, eb, bl); }
              else { E.load_bias(cur, wc, l2 >> 4, eb, bl); eb.pin(); eh.issue(ex, l2); }
              E.apply(acc, cur, wr, wc, l2 & 15, l2 >> 4, eb);
              asm volatile("s_waitcnt vmcnt(0)" ::: "memory");
              if constexpr (EH::N == 3) asm volatile("" : PG8_X16A(ex, 0), PG8_X16A(ex, 16), PG8_X16A(ex, 32) :: "memory");
              else asm volatile("" : PG8_X16A(ex, 0), PG8_X16A(ex, 16), PG8_X16A(ex, 32), PG8_X16A(ex, 48) :: "memory");
              eh.finish(ex, l2);
          } else if constexpr (epi_takes_bl<Epi>::value) E(acc, cur, wr, wc, l2 & 15, l2 >> 4, bl);
          else E(acc, cur, wr, wc, l2 & 15, l2 >> 4); }
        if (!has_next) break;
#pragma unroll
        for (int a = 0; a < 2; ++a)
#pragma unroll
            for (int b = 0; b < 2; ++b)
#pragma unroll
                for (int m = 0; m < 4; ++m)
#pragma unroll
                    for (int n = 0; n < 2; ++n) acc[a][b][m][n] = (f32x4){0.f, 0.f, 0.f, 0.f};
        cur = nxt; cA = nA; cB = nB; ko = nko; ++ui;
        if constexpr (GI::ON) {
#pragma unroll
            for (int i = 0; i < 2; ++i) voP[i] = nvP[i]; }
        if constexpr (ALIGN_EPI) { if (wr == 1) PG8_BAR; }
    }
    if constexpr (CV::ON) { asm volatile("s_waitcnt vmcnt(0)" ::: "memory"); asm volatile("" : PG8_X16(cx) :: "memory"); cv.finish(cx, lane); }
    else PG8_WAIT_V(0);
    if constexpr (!ALIGN_EPI) { if (wr == 0) PG8_BAR; }
    PG8_BAR;
#undef PG8_SA
#undef PG8_KO
#undef PG8_SB
#undef PG8_STAGE
#undef PG8_STAGE_GA
#undef PG8_STA
#undef pstepvoffA
#undef pstepvoffB
#undef voffA_v
#undef voffB_v
#undef PG8_LDA
#undef PG8_LD16
#undef PG8_SET8
#undef PG8_GET8
#undef PG8_GETLO
#undef PG8_GETHI
#undef PG8_LDB
#undef PG8_MMA
#undef PG8_WAIT_V
#undef PG8_WAIT_VN
#undef PG8_WAIT_L
#undef PG8_BAR
#undef PG8_SCHED
}
}
struct Params {
    const float* in[22];
    float* out; unsigned char* ws;
    int ph_lo, ph_hi;
};
enum { I_X = 0, I_NMG, I_WIN, I_GWG, I_GBG, I_GNG, I_CW, I_CB, I_WA, I_BA, I_WI, I_BI, I_AP, I_WOUT, I_NFG, I_WR, I_BR, I_WGU, I_BGU, I_WDN, I_BDN, I_NFINAL };

struct Frame {
    LAS unsigned char* lds; volatile LAS unsigned* MISC;
    int tid, lane, wave, G, gw, NGW;
    unsigned char* ws;
};

__device__ __forceinline__ float gelu_tanh_f(float x) {
    const float u = 0.7978845608028654f * (x + 0.044715f * x * x * x);
    const float e = __expf(2.0f * u);
    const float th = 1.0f - 2.0f * __builtin_amdgcn_rcpf(e + 1.0f);
    return 0.5f * x * (1.0f + th);
}
__device__ __forceinline__ float log_sigmoid_f(float s) { return fminf(s, 0.f) - __logf(1.0f + __expf(-fabsf(s))); }

__device__ __forceinline__ void p0_item(const float* W, int ldw, int col0, bf16_t* WT, int ldt, size_t drow0, int k0, LAS float* scr, int lane) {
    (void)scr;
    const float* src = W + (size_t)k0 * ldw + col0 + lane;
    float v[64];
#pragma unroll
    for (int i = 0; i < 64; ++i) v[i] = src[(size_t)i * ldw];
    bf16_t* dst = WT + (drow0 + lane) * (size_t)ldt + k0;
#pragma unroll
    for (int c = 0; c < 8; ++c) { u32x4 o; o.x = pk2(v[8 * c], v[8 * c + 1]); o.y = pk2(v[8 * c + 2], v[8 * c + 3]); o.z = pk2(v[8 * c + 4], v[8 * c + 5]); o.w = pk2(v[8 * c + 6], v[8 * c + 7]);
        *(u32x4*)(dst + 8 * c) = o; }
}

__device__ __forceinline__ void p0_item8(const float* W, int ldw, int col0, unsigned char* WT, int ldt, size_t drow0, int k0, int lane) {
    const float* src = W + (size_t)k0 * ldw + col0 + lane;
    float v[64];
#pragma unroll
    for (int i = 0; i < 64; ++i) v[i] = src[(size_t)i * ldw];
    unsigned char* dst = WT + (drow0 + lane) * (size_t)ldt + k0;
#pragma unroll
    for (int c = 0; c < 4; ++c) { u32x4 o;
#pragma unroll
        for (int q = 0; q < 4; ++q) o[q] = pk4_fp8(v[16 * c + 4 * q] * 512.0f, v[16 * c + 4 * q + 1] * 512.0f, v[16 * c + 4 * q + 2] * 512.0f, v[16 * c + 4 * q + 3] * 512.0f);
        *(u32x4*)(dst + 16 * c) = o; }
}

constexpr int CONV_EXPERTS_P0 = 28, HOST_DN_EXPERTS_P0 = 24;
struct CoopTile { const float* W; int ldw; int col0; unsigned char* WT; int ldt_b; int mode; int k0; int gu; int drow0; };
__device__ __forceinline__ void coop_load(const CoopTile& t, int w, int l, f32x4 (&v)[16]) {
    if (t.mode == 0) {
#pragma unroll
        for (int i = 0; i < 8; ++i) { const float* r = t.W + (size_t)(t.k0 + 8 * w + i) * t.ldw + t.col0 + 4 * l; v[2 * i] = *(const f32x4*)r; v[2 * i + 1] = *(const f32x4*)(r + 256); }
    } else {
#pragma unroll
        for (int i = 0; i < 16; ++i) v[i] = *(const f32x4*)(t.W + (size_t)(t.k0 + 16 * w + i) * t.ldw + t.col0 + 4 * l);
    }
}
__device__ __forceinline__ void coop_to_lds(const CoopTile& t, int w, int l, const f32x4 (&v)[16], LAS unsigned char* buf) {
    const int sw = (w ^ (l & 7)) * 16;
    if (t.mode == 0) {
#pragma unroll
        for (int jp = 0; jp < 2; ++jp)
#pragma unroll
            for (int j = 0; j < 4; ++j) { u32x4 o; if (t.ldw == INC) { o.x = PK2W(v[0 + jp][j], v[2 + jp][j]); o.y = PK2W(v[4 + jp][j], v[6 + jp][j]); o.z = PK2W(v[8 + jp][j], v[10 + jp][j]); o.w = PK2W(v[12 + jp][j], v[14 + jp][j]); } else { o.x = pk2(v[0 + jp][j], v[2 + jp][j]); o.y = pk2(v[4 + jp][j], v[6 + jp][j]); o.z = pk2(v[8 + jp][j], v[10 + jp][j]); o.w = pk2(v[12 + jp][j], v[14 + jp][j]); }
                *(LAS u32x4*)(buf + (256 * jp + 4 * l + j) * 128 + sw) = o; }
    } else {
#pragma unroll
        for (int j = 0; j < 4; ++j) { u32x4 o;
#pragma unroll
            for (int q = 0; q < 4; ++q) o[q] = pk4_fp8(v[4 * q][j] * 512.0f, v[4 * q + 1][j] * 512.0f, v[4 * q + 2][j] * 512.0f, v[4 * q + 3][j] * 512.0f);
            *(LAS u32x4*)(buf + (4 * l + j) * 128 + sw) = o; }
    }
}
__device__ __forceinline__ void coop_store(const CoopTile& t, int w, int l, const LAS unsigned char* buf) {
    const int nrows = t.mode == 0 ? 512 : 256; const int cp = l & 7;
    for (int n = 8 * w + (l >> 3); n < nrows; n += 64) {
        const u32x4 o = *(const LAS u32x4*)(buf + n * 128 + cp * 16); const int c = cp ^ ((n >> 2) & 7);
        int drow;
        if (t.gu) { const int g = t.col0 + n; drow = (g < 2048) ? (256 * (g >> 7) + (g & 127)) : (256 * ((g - 2048) >> 7) + 128 + ((g - 2048) & 127)); } else drow = t.drow0 + n;
        *(u32x4*)(t.WT + (size_t)drow * t.ldt_b + (t.mode == 0 ? 2 * t.k0 : t.k0) + 16 * c) = o; }
}
__device__ __forceinline__ bool coop_tile(const Params& p, unsigned char* ws, int it, CoopTile& t) {
    constexpr int N_GU = (32 - CONV_EXPERTS_P0) * 256, N_DN = (32 - HOST_DN_EXPERTS_P0) * 128, N_INA = 32 * 6, N_INB = 32 * 4, N_OUT = 32 * 4;
    int r = it;
    if (r < N_GU) { const int e = CONV_EXPERTS_P0 + (r >> 8), q = r & 255, kb = q >> 4, nb = q & 15; t = CoopTile{p.in[I_WGU] + (size_t)e * DM * 4096, 4096, 256 * nb, ws + WS_WGUT + (size_t)e * 4096 * DM, DM, 1, 128 * kb, 1, 0}; return true; } r -= N_GU;
    if (r < N_DN) { const int e = HOST_DN_EXPERTS_P0 + (r >> 7), q = r & 127, kb = q >> 3, nb = q & 7; t = CoopTile{p.in[I_WDN] + (size_t)e * DM * DM, DM, 256 * nb, ws + WS_WDT + (size_t)e * DM * DM, DM, 1, 128 * kb, 0, 256 * nb}; return true; } r -= N_DN;
    if (r < N_INA) { const int kb = r / 6, nb = r % 6; t = CoopTile{p.in[I_WIN], INC, 512 * nb, ws + WS_WINT, DM * 2, 0, 64 * kb, 0, 512 * nb}; return true; } r -= N_INA;
    if (r < N_INB) { const int kb = r >> 2, nb = r & 3; t = CoopTile{p.in[I_WIN], INC, 3088 + 512 * nb, ws + WS_WINT, DM * 2, 0, 64 * kb, 0, 3072 + 512 * nb}; return true; } r -= N_INB;
    if (r < N_OUT) { const int kb = r >> 2, nb = r & 3; t = CoopTile{p.in[I_WOUT], DM, 512 * nb, ws + WS_WOUTT, DM * 2, 0, 64 * kb, 0, 512 * nb}; return true; }
    return false;
}
__device__ __forceinline__ void p0a(Frame& F, const Params& p) {
    const int w = F.wave, l = F.lane;
    CoopTile cur, nxt; f32x4 v[16];
    int it = blockIdx.x; bool have = coop_tile(p, F.ws, it, cur);
    if (have) coop_load(cur, w, l, v);
    int par = 0;
    while (have) {
        LAS unsigned char* buf = F.lds + par * 65536;
        coop_to_lds(cur, w, l, v, buf);
        it += F.G; const bool hn = coop_tile(p, F.ws, it, nxt);
        if (hn) coop_load(nxt, w, l, v);
        __syncthreads();
        coop_store(cur, w, l, buf);
        cur = nxt; have = hn; par ^= 1;
    }
    __syncthreads();
    { bf16_t* WaT = (bf16_t*)(F.ws + WS_WAT); bf16_t* WiT = (bf16_t*)(F.ws + WS_WIT);
      for (int r = F.gw; r < 128; r += F.NGW) { const int which = r >> 6, h = (r >> 4) & 3, kb = (r >> 2) & 3, nb = r & 3;
          p0_item((which ? p.in[I_WI] : p.in[I_WA]) + (size_t)h * 65536, 256, 64 * nb, (which ? WiT : WaT) + (size_t)h * 65536, 256, (size_t)64 * nb, 64 * kb, nullptr, F.lane); } }
    { bf16_t* WglT = (bf16_t*)(F.ws + WS_WGLT); const float* w_in = p.in[I_WIN];
      for (int idx = (int)blockIdx.x * 512 + F.tid; idx < 16 * DM; idx += F.G * 512) { const int cc = idx >> 11, k = idx & 2047; WglT[idx] = (bf16_t)f2bf(w_in[(size_t)k * INC + 3072 + cc]); } }
    { float* WrT = (float*)(F.ws + WS_WRT); const float* wr = p.in[I_WR]; const float* gf = p.in[I_NFG];
      for (int idx = (int)blockIdx.x * 512 + F.tid; idx < 32 * DM; idx += F.G * 512) { const int n = idx >> 11, k = idx & 2047; WrT[idx] = wr[k * 32 + n] * gf[k]; } }
}
__device__ __forceinline__ void p0b(Frame& F, const Params& p) {
    const float* x = p.in[I_X]; const float* g1 = p.in[I_NMG]; bf16_t* H = (bf16_t*)(F.ws + WS_H);
    const int l = F.lane;
    f32x4 gv[8], xn[8];
#pragma unroll
    for (int j = 0; j < 4; ++j) { gv[2 * j] = *(const f32x4*)(g1 + 8 * l + 512 * j); gv[2 * j + 1] = *(const f32x4*)(g1 + 8 * l + 512 * j + 4); }
#pragma unroll
    for (int j = 0; j < 4; ++j) { xn[2 * j] = (F.gw < T) ? *(const f32x4*)(x + (size_t)F.gw * DM + 8 * l + 512 * j) : (f32x4){0.f, 0.f, 0.f, 0.f}; xn[2 * j + 1] = (F.gw < T) ? *(const f32x4*)(x + (size_t)F.gw * DM + 8 * l + 512 * j + 4) : (f32x4){0.f, 0.f, 0.f, 0.f}; }
    for (int m = F.gw; m < T; m += F.NGW) {
        f32x4 xv[8]; float ss = 0.f;
#pragma unroll
        for (int j = 0; j < 8; ++j) { xv[j] = xn[j]; ss += (xv[j][0] * xv[j][0] + xv[j][1] * xv[j][1]) + (xv[j][2] * xv[j][2] + xv[j][3] * xv[j][3]); }
        if (m + F.NGW < T) {
#pragma unroll
            for (int j = 0; j < 4; ++j) { xn[2 * j] = *(const f32x4*)(x + (size_t)(m + F.NGW) * DM + 8 * l + 512 * j); xn[2 * j + 1] = *(const f32x4*)(x + (size_t)(m + F.NGW) * DM + 8 * l + 512 * j + 4); } }
        const float rs = rsqrtf_(wave_sum(ss) * (1.0f / DM) + 1e-6f);
#pragma unroll
        for (int j = 0; j < 4; ++j) { const f32x4 a = xv[2 * j] * rs * gv[2 * j], b = xv[2 * j + 1] * rs * gv[2 * j + 1];
            u32x4 o; o.x = pk2(a[0], a[1]); o.y = pk2(a[2], a[3]); o.z = pk2(b[0], b[1]); o.w = pk2(b[2], b[3]);
            *(u32x4*)(H + (size_t)m * DM + 8 * l + 512 * j) = o;
#ifdef SIM_FP8
            o.x = PK2A(a[0], a[1]); o.y = PK2A(a[2], a[3]); o.z = PK2A(b[0], b[1]); o.w = PK2A(b[2], b[3]); *(u32x4*)((bf16_t*)(F.ws + WS_MIX) + (size_t)m * DM + 8 * l + 512 * j) = o;
#endif
            }
    }
}

__device__ __forceinline__ void gla_cumsum(const LAS float* GL, const float* wg, const float* bgp, int h, LAS float* BC, LAS float* SEG, int tid) {
    const int seg = tid >> 7, kk = tid & 127;
    float wcol[16];
#pragma unroll
    for (int c = 0; c < 16; ++c) wcol[c] = wg[c * 512 + h * 128 + kk];
    const float bcol = bgp[h * 128 + kk];
    float v[16];
#pragma unroll
    for (int i = 0; i < 16; ++i) { const LAS f32x4* g4 = (const LAS f32x4*)(GL + (16 * seg + i) * 16); float sacc = bcol;
#pragma unroll
        for (int c4 = 0; c4 < 4; ++c4) { const f32x4 gq = g4[c4]; sacc += gq[0] * wcol[4 * c4] + gq[1] * wcol[4 * c4 + 1] + gq[2] * wcol[4 * c4 + 2] + gq[3] * wcol[4 * c4 + 3]; }
        v[i] = log_sigmoid_f(sacc) * 0.0625f; }
#pragma unroll
    for (int i = 1; i < 16; ++i) v[i] += v[i - 1];
    SEG[seg * 128 + kk] = v[15];
    __syncthreads();
    float off = 0.f;
#pragma unroll
    for (int s = 0; s < 3; ++s) off += (s < seg) ? SEG[s * 128 + kk] : 0.f;
#pragma unroll
    for (int i = 0; i < 16; ++i) BC[(16 * seg + i) * 128 + kk] = v[i] + off;
    __syncthreads();
}
__device__ __forceinline__ bf16x8 as_bf16x8(u32x4 v) { return __builtin_bit_cast(bf16x8, v); }
__device__ __forceinline__ bf16x8 cat4(bf16x4 lo, bf16x4 hi) { return __builtin_shufflevector(lo, hi, 0, 1, 2, 3, 4, 5, 6, 7); }

__device__ __forceinline__ void p2a(Frame& F, const Params& p) {
    const bf16_t* Z = (const bf16_t*)(F.ws + WS_Z);
    bf16_t* AN = (bf16_t*)(F.ws + WS_AN); float* DN = (float*)(F.ws + WS_DN);
    const bf16_t* WaT = (const bf16_t*)(F.ws + WS_WAT); const bf16_t* WiT = (const bf16_t*)(F.ws + WS_WIT);
    LAS float* BC = (LAS float*)(F.lds); LAS float* SEG = (LAS float*)(F.lds + 32768);
    LAS bf16_t* KDT = (LAS bf16_t*)(F.lds + 34816); LAS bf16_t* VT = (LAS bf16_t*)(F.lds + 53248); LAS bf16_t* XC = (LAS bf16_t*)(F.lds + 90112);
    const int w = F.wave;
    LAS float* GLR = (LAS float*)(F.lds + 90112);
    LAS float* GL = (LAS float*)(F.lds + 124928);
    const float* wg = p.in[I_GWG]; const float* bgp = p.in[I_GBG];
    for (int unit = blockIdx.x; unit < NCHUNK; unit += F.G) {
        const int b = unit >> 7, n = unit & 127, tok0 = b * SEQL + 64 * n;
        {
            const int lane = fresh_lane(), r16 = lane & 15, q4 = lane >> 4;
            const bf16_t* Hb = (const bf16_t*)(F.ws + WS_H) + (size_t)(tok0 + r16) * DM + 256 * w + 8 * q4;
            const bf16_t* Wb = (const bf16_t*)(F.ws + WS_WGLT) + (size_t)r16 * DM + 256 * w + 8 * q4;
            f32x4 gacc[4];
#pragma unroll
            for (int mb = 0; mb < 4; ++mb) gacc[mb] = (f32x4){0.f, 0.f, 0.f, 0.f};
#pragma unroll
            for (int sb = 0; sb < 2; ++sb) { bf16x8 af[4][4], bfr[4];
#pragma unroll
                for (int s4 = 0; s4 < 4; ++s4) { bfr[s4] = *(const bf16x8*)(Wb + 32 * (4 * sb + s4));
#pragma unroll
                    for (int mb = 0; mb < 4; ++mb) af[s4][mb] = *(const bf16x8*)(Hb + (size_t)(16 * mb) * DM + 32 * (4 * sb + s4)); }
#pragma unroll
                for (int s4 = 0; s4 < 4; ++s4)
#pragma unroll
                    for (int mb = 0; mb < 4; ++mb) gacc[mb] = __builtin_amdgcn_mfma_f32_16x16x32_bf16(af[s4][mb], bfr[s4], gacc[mb], 0, 0, 0); }
#pragma unroll
            for (int mb = 0; mb < 4; ++mb)
#pragma unroll
                for (int q = 0; q < 4; ++q) GLR[(w * 64 + 16 * mb + 4 * q4 + q) * 16 + r16] = gacc[mb][q];
            __syncthreads();
            const int tid2 = w * 64 + lane;
#pragma unroll
            for (int it = 0; it < 2; ++it) { const int o = tid2 + 512 * it; float sacc = 0.f;
#pragma unroll
                for (int w2 = 0; w2 < 8; ++w2) sacc += GLR[w2 * 1024 + o];
                GL[o] = sacc; ((float*)(F.ws + WS_LG))[(size_t)tok0 * 16 + o] = sacc; }
            __syncthreads();
        }
        for (int h = 0; h < 4; ++h) {
            int lane = fresh_lane(), tid = F.wave * 64 + lane;
            int r = lane & 31, hh = lane >> 5;
            u32x4 kvr[2], vvr[4];
#pragma unroll
            for (int it = 0; it < 2; ++it) { const int item = tid + 512 * it, t = item & 63, kk8 = item >> 6; kvr[it] = *(const u32x4*)(Z + (size_t)(tok0 + t) * ZC + ZK + h * 128 + kk8 * 8); }
#pragma unroll
            for (int it = 0; it < 4; ++it) { const int item = tid + 512 * it, t = item & 63, vc8 = item >> 6; vvr[it] = *(const u32x4*)(Z + (size_t)(tok0 + t) * ZC + ZV + h * 256 + vc8 * 8); }
            gla_cumsum(GL, wg, bgp, h, BC, SEG, tid);
            const int uh = (b * 4 + h) * 128 + n;
            if (tid < 128) DN[(size_t)uh * 128 + tid] = __expf(BC[63 * 128 + tid]);
#pragma unroll
            for (int it = 0; it < 2; ++it) { const int item = tid + 512 * it, t = item & 63, kk8 = item >> 6;
                const u32x4 kv = kvr[it];
#pragma unroll
                for (int i = 0; i < 8; ++i) { const int kk = kk8 * 8 + i; const unsigned wv = kv[i >> 1]; const float kf = (i & 1) ? bfhi(wv) : bflo(wv);
                    const float d = __expf(BC[63 * 128 + kk] - BC[t * 128 + kk]); KDT[kk * 72 + t] = (bf16_t)f2bf(kf * d); } }
#pragma unroll
            for (int it = 0; it < 4; ++it) { const int item = tid + 512 * it, t = item & 63, vc8 = item >> 6;
                const u32x4 vv = vvr[it];
#pragma unroll
                for (int i = 0; i < 8; ++i) { const unsigned wv = vv[i >> 1]; VT[(vc8 * 8 + i) * 72 + t] = (bf16_t)((i & 1) ? (wv >> 16) : (wv & 0xffffu)); } }
#ifndef P2A_NO_LRU
            u32x4 lv[7]; f32x4 cwv[4][2], cbv[2];
            { const float* cw = p.in[I_CW]; const float* cb = p.in[I_CB]; const int c8 = tid & 31, tq = tid >> 5, chc = h * 256 + c8 * 8;
#pragma unroll
              for (int i = 0; i < 7; ++i) { const int sq = 64 * n + 4 * tq - 3 + i;
                  lv[i] = (sq >= 0) ? *(const u32x4*)(Z + (size_t)(tok0 + 4 * tq - 3 + i) * ZC + ZLX + chc) : (u32x4){0u, 0u, 0u, 0u}; }
#pragma unroll
              for (int i = 0; i < 4; ++i) { cwv[i][0] = *(const f32x4*)(cw + i * 1024 + chc); cwv[i][1] = *(const f32x4*)(cw + i * 1024 + chc + 4); }
              cbv[0] = *(const f32x4*)(cb + chc); cbv[1] = *(const f32x4*)(cb + chc + 4); }
#endif
            __syncthreads();
            {
                f32x16 acc[4];
#pragma unroll
                for (int mb = 0; mb < 4; ++mb)
#pragma unroll
                    for (int q = 0; q < 16; ++q) acc[mb][q] = 0.f;
#pragma unroll
                for (int s = 0; s < 4; ++s) { const bf16x8 bfr = *(const LAS bf16x8*)(VT + (32 * w + r) * 72 + 16 * s + 8 * hh);
#pragma unroll
                    for (int mb = 0; mb < 4; ++mb) { const bf16x8 afr = *(const LAS bf16x8*)(KDT + (32 * mb + r) * 72 + 16 * s + 8 * hh);
                        acc[mb] = __builtin_amdgcn_mfma_f32_32x32x16_bf16(afr, bfr, acc[mb], 0, 0, 0); } }
                bf16_t* base = AN + (size_t)uh * 32768;
#pragma unroll
                for (int mb = 0; mb < 4; ++mb)
#pragma unroll
                    for (int s2 = 0; s2 < 2; ++s2) { u32x4 o;
#pragma unroll
                        for (int q = 0; q < 4; ++q) o[q] = pk2(acc[mb][8 * s2 + 2 * q], acc[mb][8 * s2 + 2 * q + 1]);
                        *(u32x4*)(base + (((mb * 8 + w) * 2 + s2) * 64 + lane) * 8) = o; }
            }
#ifndef P2A_NO_LRU
            {
                {
                    const int c8 = tid & 31, tq = tid >> 5;
#pragma unroll
                    for (int it = 0; it < 4; ++it) { float xc[8];
#pragma unroll
                        for (int q = 0; q < 4; ++q) { xc[q] = cbv[0][q]; xc[4 + q] = cbv[1][q]; }
#pragma unroll
                        for (int i = 0; i < 4; ++i) { const u32x4 l4 = lv[it + i];
                            xc[0] += bflo(l4[0]) * cwv[i][0][0]; xc[1] += bfhi(l4[0]) * cwv[i][0][1]; xc[2] += bflo(l4[1]) * cwv[i][0][2]; xc[3] += bfhi(l4[1]) * cwv[i][0][3];
                            xc[4] += bflo(l4[2]) * cwv[i][1][0]; xc[5] += bfhi(l4[2]) * cwv[i][1][1]; xc[6] += bflo(l4[3]) * cwv[i][1][2]; xc[7] += bfhi(l4[3]) * cwv[i][1][3]; }
                        u32x4 o; o.x = pk2(xc[0], xc[1]); o.y = pk2(xc[2], xc[3]); o.z = pk2(xc[4], xc[5]); o.w = pk2(xc[6], xc[7]);
                        *(LAS u32x4*)(XC + (4 * tq + it) * 264 + c8 * 8) = o; }
                }
                __builtin_amdgcn_sched_barrier(0);
                bf16x8 ba[16], bi[16];
                { const bf16_t* wa = WaT + (size_t)h * 65536 + (size_t)(32 * w + r) * 256 + 8 * hh;
                  const bf16_t* wi = WiT + (size_t)h * 65536 + (size_t)(32 * w + r) * 256 + 8 * hh;
#pragma unroll
                  for (int s = 0; s < 16; ++s) { ba[s] = *(const bf16x8*)(wa + 16 * s); bi[s] = *(const bf16x8*)(wi + 16 * s); } }
                __syncthreads();
                f32x16 aa[2], ai[2];
#pragma unroll
                for (int mb = 0; mb < 2; ++mb)
#pragma unroll
                    for (int q = 0; q < 16; ++q) { aa[mb][q] = 0.f; ai[mb][q] = 0.f; }
#pragma unroll
                for (int s = 0; s < 16; ++s) {
#pragma unroll
                    for (int mb = 0; mb < 2; ++mb) { const bf16x8 af = *(const LAS bf16x8*)(XC + (32 * mb + r) * 264 + 16 * s + 8 * hh);
                        aa[mb] = __builtin_amdgcn_mfma_f32_32x32x16_bf16(af, ba[s], aa[mb], 0, 0, 0); } }
                __builtin_amdgcn_sched_barrier(0);
#pragma unroll
                for (int s = 0; s < 16; ++s) {
#pragma unroll
                    for (int mb = 0; mb < 2; ++mb) { const bf16x8 af = *(const LAS bf16x8*)(XC + (32 * mb + r) * 264 + 16 * s + 8 * hh);
                        ai[mb] = __builtin_amdgcn_mfma_f32_32x32x16_bf16(af, bi[s], ai[mb], 0, 0, 0); } }
                const int ch = h * 256 + 32 * w + r;
                const float ba_ = p.in[I_BA][ch], bi_ = p.in[I_BI][ch]; const float L = p.in[I_AP][ch];
                const float sp = fmaxf(-L, 0.f) + log1pf(__expf(-fabsf(L)));
#pragma unroll
                for (int mb = 0; mb < 2; ++mb)
#pragma unroll
                    for (int q = 0; q < 16; ++q) { const int t = 32 * mb + (q & 3) + 8 * (q >> 2) + 4 * hh;
                        if ((q & 3) == 0) __builtin_amdgcn_sched_barrier(0);
                        const float ga = sigmoidf_(aa[mb][q] + ba_), gi = sigmoidf_(ai[mb][q] + bi_);
                        const float la = -8.0f * ga * sp; const float a = __expf(la);
                        const float xcv = bf2f(XC[t * 264 + 32 * w + r]);
                        aa[mb][q] = a; ai[mb][q] = xcv * gi * __builtin_amdgcn_sqrtf(fmaxf(1.0f - a * a, 0.f)); }
#pragma unroll
                for (int mb = 0; mb < 2; ++mb)
#pragma unroll
                    for (int g = 0; g < 4; ++g)
#pragma unroll
                        for (int i = 1; i < 4; ++i) { const int q = 4 * g + i; ai[mb][q] = aa[mb][q] * ai[mb][q - 1] + ai[mb][q]; aa[mb][q] = aa[mb][q] * aa[mb][q - 1]; }
                LAS bf16_t* HL = (LAS bf16_t*)(F.lds); LAS bf16_t* AC = (LAS bf16_t*)(F.lds + 34816);
                float carryH = 0.f, carryP = 1.f;
#pragma unroll
                for (int mb = 0; mb < 2; ++mb)
#pragma unroll
                    for (int g = 0; g < 4; ++g) { const float myP = aa[mb][4 * g + 3], myH = ai[mb][4 * g + 3];
                        const float pP = __shfl_xor(myP, 32), pH = __shfl_xor(myH, 32);
                        const float fP = hh ? pP : myP, fH = hh ? pH : myH, sP = hh ? myP : pP, sH = hh ? myH : pH;
                        const float c1H = fP * carryH + fH, c1P = carryP * fP;
                        const float Cin = hh ? c1H : carryH, Pin = hh ? c1P : carryP;
                        carryH = sP * c1H + sH; carryP = c1P * sP;
#pragma unroll
                        for (int i = 0; i < 4; ++i) { const int q = 4 * g + i, t = 32 * mb + 8 * g + 4 * hh + i;
                            HL[t * 264 + 32 * w + r] = (bf16_t)f2bf(ai[mb][q] + aa[mb][q] * Cin); AC[t * 264 + 32 * w + r] = (bf16_t)f2bf(aa[mb][q] * Pin); } }
                if (hh == 0) { float* SUMA = (float*)(F.ws + WS_SUMA); float* SUMH = (float*)(F.ws + WS_SUMH); SUMA[unit * 1024 + ch] = carryP; SUMH[unit * 1024 + ch] = carryH; }
                __syncthreads();
                { bf16_t* HLOC = (bf16_t*)(F.ws + WS_AUA); bf16_t* ACUM = (bf16_t*)(F.ws + WS_AUU);
#pragma unroll
                  for (int it = 0; it < 4; ++it) { const int item = tid + 512 * it, c8 = item & 31, t = item >> 5; const size_t o = (size_t)(tok0 + t) * 1024 + h * 256 + c8 * 8;
                      *(u32x4*)(HLOC + o) = *(const LAS u32x4*)(HL + t * 264 + c8 * 8); *(u32x4*)(ACUM + o) = *(const LAS u32x4*)(AC + t * 264 + c8 * 8); } }
            }
#endif
            __syncthreads();
        }
    }
}

__device__ __forceinline__ void p2b(Frame& F, const Params& p) {
    const bf16_t* AN = (const bf16_t*)(F.ws + WS_AN); const float* DN = (const float*)(F.ws + WS_DN); bf16_t* SP = (bf16_t*)(F.ws + WS_SP);
    if (F.tid < 128) {
        for (int st = (int)blockIdx.x * 128 + F.tid; st < 32768; st += F.G * 128) {
            const int bh = st >> 12, rem = st & 4095, ln = rem & 63, s2 = (rem >> 6) & 1, w = (rem >> 7) & 7, mb = (rem >> 10) & 3;
            const int kk0 = 32 * mb + 16 * s2 + 4 * (ln >> 5);
            const int offS = (((mb * 8 + w) * 2 + s2) * 64 + ln) * 8;
            f32x4 S0 = (f32x4){0.f, 0.f, 0.f, 0.f}, S1 = S0;
            for (int n0 = 0; n0 < 128; n0 += 8) {
                u32x4 av[8]; f32x4 d0[8], d1[8];
#pragma unroll
                for (int i = 0; i < 8; ++i) { const size_t uh = (size_t)bh * 128 + n0 + i;
                    av[i] = *(const u32x4*)(AN + uh * 32768 + offS);
                    d0[i] = *(const f32x4*)(DN + uh * 128 + kk0); d1[i] = *(const f32x4*)(DN + uh * 128 + kk0 + 8); }
#pragma unroll
                for (int i = 0; i < 8; ++i) { const size_t uh = (size_t)bh * 128 + n0 + i;
                    u32x4 o; o.x = pk2(S0[0], S0[1]); o.y = pk2(S0[2], S0[3]); o.z = pk2(S1[0], S1[1]); o.w = pk2(S1[2], S1[3]);
                    *(u32x4*)(SP + uh * 32768 + offS) = o;
                    const f32x4 a0 = (f32x4){bflo(av[i].x), bfhi(av[i].x), bflo(av[i].y), bfhi(av[i].y)}, a1 = (f32x4){bflo(av[i].z), bfhi(av[i].z), bflo(av[i].w), bfhi(av[i].w)};
                    S0 = d0[i] * S0 + a0; S1 = d1[i] * S1 + a1; } }
        }
    }
}

__device__ __forceinline__ void p2c(Frame& F, const Params& p) {
    const bf16_t* Z = (const bf16_t*)(F.ws + WS_Z); const float* GLOW = (const float*)(F.ws + WS_LG); const bf16_t* SP = (const bf16_t*)(F.ws + WS_SP);
    LAS float* GL = (LAS float*)(F.lds + 124928); const float* wg = p.in[I_GWG]; const float* bgp = p.in[I_GBG];
    bf16_t* MIX = (bf16_t*)(F.ws + WS_MIX);
    LAS float* BC = (LAS float*)(F.lds); LAS float* SEG = (LAS float*)(F.lds + 32768);
    LAS bf16_t* QE = (LAS bf16_t*)(F.lds + 34816); LAS bf16_t* KE = (LAS bf16_t*)(F.lds + 52224); LAS bf16_t* VT = (LAS bf16_t*)(F.lds + 69632);
    LAS float* SSQ = (LAS float*)(F.lds + 106496); LAS float* OS = (LAS float*)(F.lds);
    const int w = F.wave;
    const float* gng = p.in[I_GNG];
    for (int unit = blockIdx.x; unit < NCHUNK; unit += F.G) {
        const int b = unit >> 7, n = unit & 127, tok0 = b * SEQL + 64 * n;
        const int lane = fresh_lane(), tid = w * 64 + lane, r = lane & 31, hh = lane >> 5;
        { const float* SUMA = (const float*)(F.ws + WS_SUMA); const float* SUMH = (const float*)(F.ws + WS_SUMH);
          const int ch = 2 * tid; f32x2 hc = (f32x2){0.f, 0.f};
          int c2 = unit & ~127;
          for (; c2 + 16 <= unit; c2 += 16) { f32x2 a[16], hv[16];
#pragma unroll
              for (int q = 0; q < 16; ++q) { a[q] = *(const f32x2*)(SUMA + (c2 + q) * 1024 + ch); hv[q] = *(const f32x2*)(SUMH + (c2 + q) * 1024 + ch); }
#pragma unroll
              for (int q = 0; q < 16; ++q) hc = a[q] * hc + hv[q]; }
          { f32x2 a[16], hv[16];
#pragma unroll
              for (int q = 0; q < 16; ++q) { const bool ok = (c2 + q) < unit; a[q] = ok ? *(const f32x2*)(SUMA + (c2 + q) * 1024 + ch) : (f32x2){1.f, 1.f}; hv[q] = ok ? *(const f32x2*)(SUMH + (c2 + q) * 1024 + ch) : (f32x2){0.f, 0.f}; }
#pragma unroll
              for (int q = 0; q < 16; ++q) hc = a[q] * hc + hv[q]; }
          const bf16_t* HLOC = (const bf16_t*)(F.ws + WS_AUA); const bf16_t* ACUM = (const bf16_t*)(F.ws + WS_AUU);
          for (int t0 = 0; t0 < 64; t0 += 16) {
              unsigned hv[16], av[16], lgw[16];
#pragma unroll
              for (int i = 0; i < 16; ++i) { const size_t tok = (size_t)tok0 + t0 + i;
                  hv[i] = *(const unsigned*)(HLOC + tok * 1024 + ch); av[i] = *(const unsigned*)(ACUM + tok * 1024 + ch); lgw[i] = *(const unsigned*)(Z + tok * ZC + ZLG + ch); }
#pragma unroll
              for (int i = 0; i < 16; ++i) { const size_t tok = (size_t)tok0 + t0 + i;
                  const float h0 = bflo(hv[i]) + bflo(av[i]) * hc.x, h1 = bfhi(hv[i]) + bfhi(av[i]) * hc.y;
                  *(unsigned*)(MIX + tok * DM + 1024 + ch) = pk2(h0 * gelu_tanh_f(bflo(lgw[i])), h1 * gelu_tanh_f(bfhi(lgw[i]))); } } }
        { const f32x2 gq = *(const f32x2*)(GLOW + (size_t)tok0 * 16 + 2 * tid); *(LAS f32x2*)(GL + 2 * tid) = gq; }
        __syncthreads();
        for (int h = 0; h < 4; ++h) {
            const int uh = (b * 4 + h) * 128 + n;
            gla_cumsum(GL, wg, bgp, h, BC, SEG, tid);
            bf16x8 sf[4][2];
            { const bf16_t* spu = SP + (size_t)uh * 32768;
#pragma unroll
              for (int mb = 0; mb < 4; ++mb)
#pragma unroll
                  for (int s2 = 0; s2 < 2; ++s2) sf[mb][s2] = *(const bf16x8*)(spu + (((mb * 8 + w) * 2 + s2) * 64 + lane) * 8); }
#pragma unroll
            for (int it = 0; it < 2; ++it) { const int item = tid + 512 * it, kk8 = item & 15, t = item >> 4;
                const u32x4 qv = *(const u32x4*)(Z + (size_t)(tok0 + t) * ZC + ZQ + h * 128 + kk8 * 8);
                const u32x4 kv = *(const u32x4*)(Z + (size_t)(tok0 + t) * ZC + ZK + h * 128 + kk8 * 8);
                const f32x4 b0 = *(const LAS f32x4*)(BC + t * 128 + kk8 * 8), b1 = *(const LAS f32x4*)(BC + t * 128 + kk8 * 8 + 4);
                float qe[8], ke[8];
#pragma unroll
                for (int i = 0; i < 8; ++i) { const float bb = (i < 4) ? b0[i & 3] : b1[i & 3]; const unsigned qw = qv[i >> 1], kw = kv[i >> 1];
                    const float qf = (i & 1) ? bfhi(qw) : bflo(qw), kf = (i & 1) ? bfhi(kw) : bflo(kw);
                    qe[i] = qf * 0.08838834764831845f * __expf(bb); ke[i] = kf * __expf(-bb); }
                u32x4 oq, ok; oq.x = pk2(qe[0], qe[1]); oq.y = pk2(qe[2], qe[3]); oq.z = pk2(qe[4], qe[5]); oq.w = pk2(qe[6], qe[7]);
                ok.x = pk2(ke[0], ke[1]); ok.y = pk2(ke[2], ke[3]); ok.z = pk2(ke[4], ke[5]); ok.w = pk2(ke[6], ke[7]);
                *(LAS u32x4*)(QE + t * 136 + kk8 * 8) = oq; *(LAS u32x4*)(KE + t * 136 + kk8 * 8) = ok; }
#pragma unroll
            for (int it = 0; it < 4; ++it) { const int item = tid + 512 * it, t = item & 63, vc8 = item >> 6;
                const u32x4 vv = *(const u32x4*)(Z + (size_t)(tok0 + t) * ZC + ZV + h * 256 + vc8 * 8);
#pragma unroll
                for (int i = 0; i < 8; ++i) { const unsigned wv = vv[i >> 1]; VT[(vc8 * 8 + i) * 72 + t] = (bf16_t)((i & 1) ? (wv >> 16) : (wv & 0xffffu)); } }
            __syncthreads();
            f32x16 oacc[2];
            {
                f32x16 P00, P01, P11;
#pragma unroll
                for (int q = 0; q < 16; ++q) { P00[q] = 0.f; P01[q] = 0.f; P11[q] = 0.f; oacc[0][q] = 0.f; oacc[1][q] = 0.f; }
#pragma unroll
                for (int s = 0; s < 8; ++s) {
                    const bf16x8 a0 = *(const LAS bf16x8*)(KE + r * 136 + 16 * s + 8 * hh), a1 = *(const LAS bf16x8*)(KE + (32 + r) * 136 + 16 * s + 8 * hh);
                    const bf16x8 b0 = *(const LAS bf16x8*)(QE + r * 136 + 16 * s + 8 * hh), b1 = *(const LAS bf16x8*)(QE + (32 + r) * 136 + 16 * s + 8 * hh);
                    P00 = __builtin_amdgcn_mfma_f32_32x32x16_bf16(a0, b0, P00, 0, 0, 0);
                    P01 = __builtin_amdgcn_mfma_f32_32x32x16_bf16(a0, b1, P01, 0, 0, 0);
                    P11 = __builtin_amdgcn_mfma_f32_32x32x16_bf16(a1, b1, P11, 0, 0, 0); }
#pragma unroll
                for (int q = 0; q < 16; ++q) { const int jl = (q & 3) + 8 * (q >> 2) + 4 * hh; if (jl > r) { P00[q] = 0.f; P11[q] = 0.f; } }
                bf16x8 F00[2], F01[2], F11[2];
#pragma unroll
                for (int s2 = 0; s2 < 2; ++s2) {
                    u32x4 t0, t1, t2;
#pragma unroll
                    for (int q = 0; q < 4; ++q) { t0[q] = pk2(P00[8 * s2 + 2 * q], P00[8 * s2 + 2 * q + 1]); t1[q] = pk2(P01[8 * s2 + 2 * q], P01[8 * s2 + 2 * q + 1]); t2[q] = pk2(P11[8 * s2 + 2 * q], P11[8 * s2 + 2 * q + 1]); }
                    F00[s2] = as_bf16x8(t0); F01[s2] = as_bf16x8(t1); F11[s2] = as_bf16x8(t2); }
#pragma unroll
                for (int mb = 0; mb < 4; ++mb)
#pragma unroll
                    for (int s2 = 0; s2 < 2; ++s2) { const bf16x8 af = sf[mb][s2];
                        const int kkb = 32 * mb + 16 * s2 + 4 * hh;
#pragma unroll
                        for (int ib = 0; ib < 2; ++ib) { const bf16x4 lo = *(const LAS bf16x4*)(QE + (32 * ib + r) * 136 + kkb), hi = *(const LAS bf16x4*)(QE + (32 * ib + r) * 136 + kkb + 8);
                            oacc[ib] = __builtin_amdgcn_mfma_f32_32x32x16_bf16(af, cat4(lo, hi), oacc[ib], 0, 0, 0); } }
#pragma unroll
                for (int s2 = 0; s2 < 2; ++s2) {
                    const int tb0 = 16 * s2 + 4 * hh, tb1 = 32 + 16 * s2 + 4 * hh;
                    const bf16x8 v0 = cat4(*(const LAS bf16x4*)(VT + (32 * w + r) * 72 + tb0), *(const LAS bf16x4*)(VT + (32 * w + r) * 72 + tb0 + 8));
                    const bf16x8 v1 = cat4(*(const LAS bf16x4*)(VT + (32 * w + r) * 72 + tb1), *(const LAS bf16x4*)(VT + (32 * w + r) * 72 + tb1 + 8));
                    oacc[0] = __builtin_amdgcn_mfma_f32_32x32x16_bf16(v0, F00[s2], oacc[0], 0, 0, 0);
                    oacc[1] = __builtin_amdgcn_mfma_f32_32x32x16_bf16(v0, F01[s2], oacc[1], 0, 0, 0);
                    oacc[1] = __builtin_amdgcn_mfma_f32_32x32x16_bf16(v1, F11[s2], oacc[1], 0, 0, 0); }
            }
#pragma unroll
            for (int ib = 0; ib < 2; ++ib) { float sq = 0.f;
#pragma unroll
                for (int q = 0; q < 16; ++q) sq += oacc[ib][q] * oacc[ib][q];
                sq += __shfl_xor(sq, 32);
                if (hh == 0) SSQ[w * 64 + 32 * ib + r] = sq; }
            __syncthreads();
#pragma unroll
            for (int ib = 0; ib < 2; ++ib) { float tot = 0.f;
#pragma unroll
                for (int w2 = 0; w2 < 8; ++w2) tot += SSQ[w2 * 64 + 32 * ib + r];
                const float rs = rsqrtf_(tot * (1.0f / 256.0f) + 1e-6f);
#pragma unroll
                for (int g = 0; g < 4; ++g) *(LAS f32x4*)(OS + (32 * ib + r) * 260 + 32 * w + 8 * g + 4 * hh) =
                    (f32x4){oacc[ib][4 * g] * rs, oacc[ib][4 * g + 1] * rs, oacc[ib][4 * g + 2] * rs, oacc[ib][4 * g + 3] * rs}; }
            __syncthreads();
#pragma unroll
            for (int it = 0; it < 4; ++it) { const int item = tid + 512 * it, vc8 = item & 31, t = item >> 5; const int c = h * 256 + vc8 * 8;
                const f32x4 o0 = *(const LAS f32x4*)(OS + t * 260 + vc8 * 8), o1 = *(const LAS f32x4*)(OS + t * 260 + vc8 * 8 + 4);
                const u32x4 rv = *(const u32x4*)(Z + (size_t)(tok0 + t) * ZC + ZR + c);
                const f32x4 g0 = *(const f32x4*)(gng + c), g1 = *(const f32x4*)(gng + c + 4);
                float o[8];
#pragma unroll
                for (int i = 0; i < 8; ++i) { const unsigned rw = rv[i >> 1]; const float rf = (i & 1) ? bfhi(rw) : bflo(rw);
                    const float sil = rf * sigmoidf_(rf); o[i] = sil * ((i < 4) ? o0[i & 3] * g0[i & 3] : o1[i & 3] * g1[i & 3]); }
                u32x4 ov; ov.x = pk2(o[0], o[1]); ov.y = pk2(o[2], o[3]); ov.z = pk2(o[4], o[5]); ov.w = pk2(o[6], o[7]);
                *(u32x4*)(MIX + (size_t)(tok0 + t) * DM + c) = ov; }
            __syncthreads();
        }
    }
}

__device__ __forceinline__ void build_moe_tables(Frame& F) {
    unsigned* cnt = (unsigned*)(F.ws + WS_CTL) + CW_CNT;
    if (F.tid < 32) F.MISC[MI_LCNT + F.tid] = xb_ld(cnt + 64 * F.tid);
    __syncthreads();
    if (F.tid == 0) { int tiles = 0;
        for (int e = 0; e < NEXP; ++e) { const int c = (int)F.MISC[MI_LCNT + e]; const int mt = (c + 255) >> 8; F.MISC[MI_PBASE + e] = (unsigned)(tiles * 256); F.MISC[MI_CNT + e] = (unsigned)c;
            for (int q = 0; q < mt; ++q) F.MISC[MI_T2E + tiles + q] = (unsigned)e; tiles += mt; }
        F.MISC[MI_NMT] = (unsigned)tiles; }
    __syncthreads();
    if (F.tid < 32) F.MISC[MI_LCNT + F.tid] = 0u;
    __syncthreads();
}

__device__ __forceinline__ void p4a(Frame& F, const Params& p) {
    const bf16_t* XMID = (const bf16_t*)(F.ws + WS_XMID); const float* WrT = (const float*)(F.ws + WS_WRT); const float* br = p.in[I_BR];
    float* RSTD = (float*)(F.ws + WS_RSTD); unsigned* TOKE = (unsigned*)(F.ws + WS_TOKE); float* GATES = (float*)(F.ws + WS_GATES);
    unsigned* cnt = (unsigned*)(F.ws + WS_CTL) + CW_CNT;
    unsigned char* HF8 = F.ws + WS_HF8; unsigned short* LIST = (unsigned short*)(F.ws + WS_LIST); const float* gf = p.in[I_NFG];
    LAS float* RED = (LAS float*)(F.lds); LAS float* SSQ2 = (LAS float*)(F.lds + 32768); LAS float* LGT = (LAS float*)(F.lds + 33792); LAS float* RS = (LAS float*)(F.lds + 38016);
    const int tid = F.tid, lane = F.lane, w = F.wave, m = lane & 31, kh = lane >> 5;
    if (tid < 32) F.MISC[MI_LCNT + tid] = 0u;
    __syncthreads();
    f32x4 bw[32];
    { const float* bp = WrT + (size_t)m * DM + 256 * w + 128 * kh;
#pragma unroll
      for (int c = 0; c < 32; ++c) bw[c] = *(const f32x4*)(bp + 4 * c); }
    LAS float* RSA = (LAS float*)(F.lds + 38400);
    int ui = 0;
    for (int ut = blockIdx.x; ut < T / 32; ut += F.G, ++ui) {
        const int m0 = 32 * ut; const int kw = 256 * w + 128 * kh;
        f32x16 acc;
#pragma unroll
        for (int q = 0; q < 16; ++q) acc[q] = 0.f;
        float ss = 0.f;
        const bf16_t* ap = XMID + (size_t)(m0 + m) * DM + kw;
        u32x4 ar[16];
#pragma unroll
        for (int c = 0; c < 16; ++c) ar[c] = *(const u32x4*)(ap + 8 * c);
#pragma unroll
        for (int c = 0; c < 16; ++c) { const u32x4 r0 = ar[c];
            const f32x4 a0 = (f32x4){bflo(r0.x), bfhi(r0.x), bflo(r0.y), bfhi(r0.y)}, a1 = (f32x4){bflo(r0.z), bfhi(r0.z), bflo(r0.w), bfhi(r0.w)};
#pragma unroll
            for (int i = 0; i < 4; ++i) { acc = __builtin_amdgcn_mfma_f32_32x32x2f32(a0[i], bw[2 * c][i], acc, 0, 0, 0); ss += a0[i] * a0[i]; }
#pragma unroll
            for (int i = 0; i < 4; ++i) { acc = __builtin_amdgcn_mfma_f32_32x32x2f32(a1[i], bw[2 * c + 1][i], acc, 0, 0, 0); ss += a1[i] * a1[i]; } }
        ss += __shfl_xor(ss, 32);
#pragma unroll
        for (int q = 0; q < 16; ++q) RED[(w * 16 + q) * 64 + lane] = acc[q];
        if (kh == 0) SSQ2[w * 32 + m] = ss;
        __syncthreads();
#pragma unroll
        for (int it = 0; it < 2; ++it) { const int o = tid + 512 * it, reg = o >> 6, ln = o & 63, nn = ln & 31, h2 = ln >> 5; const int mm = (reg & 3) + 8 * (reg >> 2) + 4 * h2;
            float v = 0.f, s2 = 0.f;
#pragma unroll
            for (int w2 = 0; w2 < 8; ++w2) { v += RED[(w2 * 16 + reg) * 64 + ln]; s2 += SSQ2[w2 * 32 + mm]; }
            const float rs = rsqrtf_(s2 * (1.0f / DM) + 1e-6f);
            LGT[mm * 33 + nn] = v * rs + br[nn]; if (nn == 0) { RS[mm] = rs; RSA[32 * ui + mm] = rs; } }
        __syncthreads();
        int ex[4]; unsigned ls[4]; float gt[4];
        if (tid < 32) {
            float l[32];
#pragma unroll
            for (int i = 0; i < 32; ++i) l[i] = LGT[tid * 33 + i];
            float val[4];
#pragma unroll
            for (int k = 0; k < 4; ++k) { float best = -3.0e38f; int bi = 0;
#pragma unroll
                for (int i = 0; i < 32; ++i) if (l[i] > best) { best = l[i]; bi = i; }
                ex[k] = bi; val[k] = best;
#pragma unroll
                for (int i = 0; i < 32; ++i) if (i == bi) l[i] = -3.0e38f; }
            float s = 0.f;
#pragma unroll
            for (int k = 0; k < 4; ++k) { gt[k] = __expf(val[k] - val[0]); s += gt[k]; }
            const float inv = __builtin_amdgcn_rcpf(s);
#pragma unroll
            for (int k = 0; k < 4; ++k) { gt[k] *= inv; ls[k] = __hip_atomic_fetch_add((LAS unsigned*)(F.MISC + MI_LCNT + ex[k]), 1u, __ATOMIC_RELAXED, __HIP_MEMORY_SCOPE_WORKGROUP); }
        }
        __syncthreads();
        if (tid < 32) { const unsigned c = F.MISC[MI_LCNT + tid]; F.MISC[MI_LBASE + tid] = c ? xb_add(cnt + 64 * tid, c) : 0u; F.MISC[MI_LCNT + tid] = 0u; }
        __syncthreads();
        if (tid < 32) { const int tok = m0 + tid;
#pragma unroll
            for (int k = 0; k < 4; ++k) { const unsigned slot = F.MISC[MI_LBASE + ex[k]] + ls[k]; TOKE[tok * 4 + k] = (unsigned)ex[k] | (slot << 8); GATES[tok * 4 + k] = gt[k]; LIST[(size_t)ex[k] * 16384 + (slot & ~255u) + ((slot & 63u) << 2) + ((slot >> 6) & 3u)] = (unsigned short)tok; }
            RSTD[tok] = RS[tid]; }
        __syncthreads();
    }
    { const int ntok = 32 * ui; const int l = lane;
      f32x4 gv[8];
#pragma unroll
      for (int j = 0; j < 4; ++j) { gv[2 * j] = *(const f32x4*)(gf + 8 * l + 512 * j) * 16.0f; gv[2 * j + 1] = *(const f32x4*)(gf + 8 * l + 512 * j + 4) * 16.0f; }
      u32x4 xn[4];
      int jt = w;
      if (jt < ntok) { const size_t tk = (size_t)32 * (blockIdx.x + (jt >> 5) * F.G) + (jt & 31);
#pragma unroll
          for (int j = 0; j < 4; ++j) xn[j] = *(const u32x4*)(XMID + tk * DM + 8 * l + 512 * j); }
      for (; jt < ntok; jt += 8) {
          const size_t tk = (size_t)32 * (blockIdx.x + (jt >> 5) * F.G) + (jt & 31); const float rs = RSA[jt]; u32x2 o[4];
#pragma unroll
          for (int j = 0; j < 4; ++j) { const u32x4 xr = xn[j]; const f32x4 a = (f32x4){bflo(xr.x), bfhi(xr.x), bflo(xr.y), bfhi(xr.y)} * rs * gv[2 * j], b = (f32x4){bflo(xr.z), bfhi(xr.z), bflo(xr.w), bfhi(xr.w)} * rs * gv[2 * j + 1];
              o[j].x = pk4_fp8(a[0], a[1], a[2], a[3]); o[j].y = pk4_fp8(b[0], b[1], b[2], b[3]); }
          const int j2 = jt + 8;
          if (j2 < ntok) { const size_t t2 = (size_t)32 * (blockIdx.x + (j2 >> 5) * F.G) + (j2 & 31);
#pragma unroll
              for (int j = 0; j < 4; ++j) xn[j] = *(const u32x4*)(XMID + t2 * DM + 8 * l + 512 * j); }
#pragma unroll
          for (int j = 0; j < 4; ++j) *(u32x2*)(HF8 + tk * DM + 8 * l + 512 * j) = o[j]; } }
}

__device__ __forceinline__ void p4b(Frame& F, const Params& p) {
    build_moe_tables(F);
    const bf16_t* XMID = (const bf16_t*)(F.ws + WS_XMID); const float* RSTD = (const float*)(F.ws + WS_RSTD); const unsigned* TOKE = (const unsigned*)(F.ws + WS_TOKE);
    const float* gf = p.in[I_NFG]; unsigned char* ABUF = F.ws + WS_ABUF;
    const int l = F.lane;
    u32x4 xn[4]; float rsn = 0.f; unsigned ten[4] = {0u, 0u, 0u, 0u};
    if (F.gw < T) { rsn = RSTD[F.gw];
#pragma unroll
        for (int k = 0; k < 4; ++k) ten[k] = TOKE[F.gw * 4 + k];
#pragma unroll
        for (int j = 0; j < 4; ++j) xn[j] = *(const u32x4*)(XMID + (size_t)F.gw * DM + 8 * l + 512 * j); }
    f32x4 gv[8];
#pragma unroll
    for (int j = 0; j < 4; ++j) { gv[2 * j] = *(const f32x4*)(gf + 8 * l + 512 * j) * 16.0f; gv[2 * j + 1] = *(const f32x4*)(gf + 8 * l + 512 * j + 4) * 16.0f; }
    for (int tok = F.gw; tok < T; tok += F.NGW) {
        const float rs = rsn; unsigned te[4]; u32x2 o[4];
#pragma unroll
        for (int k = 0; k < 4; ++k) te[k] = ten[k];
#pragma unroll
        for (int j = 0; j < 4; ++j) { const u32x4 xr = xn[j]; const f32x4 a = (f32x4){bflo(xr.x), bfhi(xr.x), bflo(xr.y), bfhi(xr.y)} * rs * gv[2 * j], b = (f32x4){bflo(xr.z), bfhi(xr.z), bflo(xr.w), bfhi(xr.w)} * rs * gv[2 * j + 1];
            o[j].x = pk4_fp8(a[0], a[1], a[2], a[3]); o[j].y = pk4_fp8(b[0], b[1], b[2], b[3]); }
        const int t2 = tok + F.NGW;
        if (t2 < T) { rsn = RSTD[t2];
#pragma unroll
            for (int k = 0; k < 4; ++k) ten[k] = TOKE[t2 * 4 + k];
#pragma unroll
            for (int j = 0; j < 4; ++j) xn[j] = *(const u32x4*)(XMID + (size_t)t2 * DM + 8 * l + 512 * j); }
#pragma unroll
        for (int k = 0; k < 4; ++k) { const size_t row = (size_t)F.MISC[MI_PBASE + (te[k] & 255u)] + (te[k] >> 8);
#pragma unroll
            for (int j = 0; j < 4; ++j) *(u32x2*)(ABUF + row * DM + 8 * l + 512 * j) = o[j]; }
    }
}

__device__ __forceinline__ void p7(Frame& F, const Params& p) {
    build_moe_tables(F);
    const bf16_t* XMID = (const bf16_t*)(F.ws + WS_XMID); const unsigned* TOKE = (const unsigned*)(F.ws + WS_TOKE); const float* GATES = (const float*)(F.ws + WS_GATES);
    const unsigned char* Y = F.ws + WS_Y; const float* gfin = p.in[I_NFINAL];
    const int l = F.lane;
    u32x4 xn[4]; u32x2 yn[4][4]; float gkn[4] = {0.f, 0.f, 0.f, 0.f};
#define P7_FETCH(tk) do { \
        _Pragma("unroll") for (int k = 0; k < 4; ++k) { const unsigned te = TOKE[(tk) * 4 + k]; gkn[k] = GATES[(tk) * 4 + k]; const size_t row = (size_t)F.MISC[MI_PBASE + (te & 255u)] + (te >> 8); \
            _Pragma("unroll") for (int j = 0; j < 4; ++j) yn[k][j] = *(const u32x2*)(Y + row * DM + 8 * l + 512 * j); } \
        _Pragma("unroll") for (int j = 0; j < 4; ++j) xn[j] = *(const u32x4*)(XMID + (size_t)(tk) * DM + 8 * l + 512 * j); } while (0)
    if (F.gw < T) P7_FETCH(F.gw);
    f32x4 g0[4], g1[4];
#pragma unroll
    for (int j = 0; j < 4; ++j) { g0[j] = *(const f32x4*)(gfin + 8 * l + 512 * j); g1[j] = *(const f32x4*)(gfin + 8 * l + 512 * j + 4); }
    for (int tok = F.gw; tok < T; tok += F.NGW) {
        f32x4 xv[8];
#pragma unroll
        for (int j = 0; j < 4; ++j) { const u32x4 xr = xn[j]; xv[2 * j] = (f32x4){bflo(xr.x), bfhi(xr.x), bflo(xr.y), bfhi(xr.y)}; xv[2 * j + 1] = (f32x4){bflo(xr.z), bfhi(xr.z), bflo(xr.w), bfhi(xr.w)}; }
#pragma unroll
        for (int k = 0; k < 4; ++k)
#pragma unroll
            for (int j = 0; j < 4; ++j) { const u32x2 y2 = yn[k][j]; const float gk = gkn[k] * (1.0f / 32.0f);
                xv[2 * j][0] += gk * fp8f(y2.x, 0); xv[2 * j][1] += gk * fp8f(y2.x, 1); xv[2 * j][2] += gk * fp8f(y2.x, 2); xv[2 * j][3] += gk * fp8f(y2.x, 3);
                xv[2 * j + 1][0] += gk * fp8f(y2.y, 0); xv[2 * j + 1][1] += gk * fp8f(y2.y, 1); xv[2 * j + 1][2] += gk * fp8f(y2.y, 2); xv[2 * j + 1][3] += gk * fp8f(y2.y, 3); }
        const int t2 = tok + F.NGW;
        if (t2 < T) P7_FETCH(t2);
        float ss = 0.f;
#pragma unroll
        for (int j = 0; j < 8; ++j) ss += (xv[j][0] * xv[j][0] + xv[j][1] * xv[j][1]) + (xv[j][2] * xv[j][2] + xv[j][3] * xv[j][3]);
        const float rs = rsqrtf_(wave_sum(ss) * (1.0f / DM) + 1e-6f);
#pragma unroll
        for (int j = 0; j < 4; ++j) { *(f32x4*)(p.out + (size_t)tok * DM + 8 * l + 512 * j) = xv[2 * j] * rs * g0[j]; *(f32x4*)(p.out + (size_t)tok * DM + 8 * l + 512 * j + 4) = xv[2 * j + 1] * rs * g1[j]; }
    }
#undef P7_FETCH
}

#ifdef PROBE_STREAM
__device__ __forceinline__ void probe_stream(Frame& F, const Params& p) {
    const f32x4* src = (const f32x4*)p.in[I_WGU]; const size_t n4 = (size_t)32 * 2048 * 4096 / 4;
    const f32x4* src2 = (const f32x4*)p.in[I_WDN]; const size_t m4 = (size_t)32 * 2048 * 2048 / 4;
    f32x4 acc = (f32x4){0.f, 0.f, 0.f, 0.f};
    for (size_t base = (size_t)F.gw * 1024; base < n4; base += (size_t)F.NGW * 1024) {
        f32x4 v[16];
#pragma unroll
        for (int i = 0; i < 16; ++i) v[i] = src[base + i * 64 + F.lane];
#pragma unroll
        for (int i = 0; i < 16; ++i) acc += v[i]; }
    for (size_t base = (size_t)F.gw * 1024; base < m4; base += (size_t)F.NGW * 1024) {
        f32x4 v[16];
#pragma unroll
        for (int i = 0; i < 16; ++i) v[i] = src2[base + i * 64 + F.lane];
#pragma unroll
        for (int i = 0; i < 16; ++i) acc += v[i]; }
    if (acc[0] + acc[1] + acc[2] + acc[3] == 12345.678f) p.out[0] = 1.0f;
}
#endif
#ifdef PROBE_ORDER
__device__ __forceinline__ void probe_order(Frame& F, const Params& p) {
    volatile LAS unsigned* flag = F.MISC + 2000;
    if (F.wave < 4) {
        const unsigned* hot = (const unsigned*)p.in[I_X] + (size_t)blockIdx.x * 16384;
        unsigned idx = F.tid & 255, sm = 0;
        for (int it = 0; it < 600; ++it) {
            const unsigned b = idx * 4 + (it & 3) * 1024;
            const unsigned v0 = hot[b & 16383], v1 = hot[(b + 4096) & 16383], v2 = hot[(b + 8192) & 16383], v3 = hot[(b + 12288) & 16383];
            sm += v0 + v1 + v2 + v3; idx = (idx + (sm & 3)) & 255;
        }
        if (sm == 0x12345678u) p.out[0] = 1.0f;
        *flag = 1u;
    } else {
#if PROBE_ORDER == 2
        const f32x4* src = (const f32x4*)p.in[I_WGU];
        f32x4 acc = (f32x4){0.f, 0.f, 0.f, 0.f}; unsigned it = 0;
        const unsigned sw = blockIdx.x * 4 + (F.wave - 4);
        while (*flag == 0u) {
            const size_t base = (((size_t)it * 1024 + sw) * 1024) & (((size_t)1 << 26) - 1);
            f32x4 v[16];
#pragma unroll
            for (int i = 0; i < 16; ++i) v[i] = src[base + i * 64 + F.lane];
#pragma unroll
            for (int i = 0; i < 16; ++i) acc += v[i];
            ++it;
        }
        if (acc[0] + acc[1] + acc[2] + acc[3] == 12345.678f) p.out[1] = 1.0f;
#endif
    }
    __syncthreads();
}
#endif
constexpr int NPHASE = 11;
constexpr int HOST_DN_EXPERTS = 24;
constexpr int CONV_EXPERTS = 28, CONV_END = CONV_EXPERTS * 8192, CONV_P1 = 2048 * 81;
#ifndef KROT5
#define KROT5 false
#endif
#ifndef KROT6
#define KROT6 false
#endif
#ifndef STAG5
#define STAG5 0
#endif
#ifndef STAG6
#define STAG6 0
#endif
__global__ void __launch_bounds__(512, 2) mk_fwd(Params p) {
    extern __shared__ __attribute__((aligned(16))) unsigned char lds_raw[];
    Frame F;
    F.lds = (LAS unsigned char*)lds_raw; F.MISC = (volatile LAS unsigned*)(F.lds + MISC_OFF);
    F.wave = __builtin_amdgcn_readfirstlane((int)threadIdx.x >> 6);
#define FRESH() do { F.lane = fresh_lane(); F.tid = F.wave * 64 + F.lane; } while (0)
    FRESH();
    F.G = gridDim.x; F.gw = (int)blockIdx.x * 8 + F.wave; F.NGW = F.G * 8; F.ws = p.ws;
    for (int u = F.tid; u < (LDS_BYTES - MISC_OFF) / 4; u += 512) F.MISC[u] = 0u;
    __syncthreads();
    const int lo = p.ph_lo, hi = p.ph_hi;
    XcdBarrier bar; bar.bar = (unsigned*)(F.ws + WS_CTL) + CW_BAR; bar.x = 0; bar.st = F.MISC;
    if (hi - lo > 1) bar = xcd_barrier_post((unsigned*)(F.ws + WS_CTL) + CW_BAR, F.MISC, F.tid == 0);
#ifndef PHASE_MASK
#define PHASE_MASK 0x7ff
#endif
#define IN(k) (((PHASE_MASK >> (k)) & 1) && lo <= (k) && (k) < hi)
#define SEAM(k) do { if (IN(k) && IN((k) + 1)) xcd_barrier(bar, F.wave == 0 && fresh_lane() == 0); } while (0)
#ifndef REPEAT_MASK
#define REPEAT_MASK 0
#endif
#define REP(k) for (int rep_ = 0; rep_ < (((REPEAT_MASK >> (k)) & 1) ? 2 : 1); ++rep_)
    LAS unsigned char* ring = F.lds;
#ifdef PROBE_STREAM
    if (IN(0)) { probe_stream(F, p); }
#endif
#ifdef PROBE_ORDER
    if (IN(0)) { probe_order(F, p); }
#endif
    if (IN(0)) { REP(11) { FRESH(); p0a(F, p); } REP(12) { FRESH(); p0b(F, p); } SEAM(0); }
    if (IN(1)) REP(1) {

#ifdef SIM_FP8
        pg8::Gemm g{F.ws + WS_MIX, F.ws + WS_WINT};
#else
        pg8::Gemm g{F.ws + WS_H, F.ws + WS_WINT};
#endif
 using GS = pg8::GShape<DM * 2, DM * 2, DM * 2, 0>; pg8::StaticOrder S; S.init(T, ZC, F.G, (int)blockIdx.x);
        pg8::EpiBf16 E{(bf16_t*)(F.ws + WS_Z), ZC, nullptr, 0};
        pg8::ConvGU cv{p.in[I_WGU], F.ws + WS_WGUT, F.gw, CONV_END, F.NGW, 0};
        pg8::gemm_phase<pg8::EpiBf16, pg8::StaticOrder, GS, true, false, 0, pg8::ConvGU>(ring, g, S, E, F.wave, cv); SEAM(1); }
    if (IN(2)) REP(2) { FRESH(); p2a(F, p); SEAM(2); }
    if (IN(3)) REP(3) { FRESH(); p2b(F, p); SEAM(3); }
    if (IN(4)) REP(4) { FRESH(); p2c(F, p); SEAM(4); }
    if (IN(5)) REP(5) {
        pg8::Gemm g{F.ws + WS_MIX, F.ws + WS_WOUTT}; using GS = pg8::GShape<DM * 2, DM * 2, DM * 2, 0>; pg8::StaticOrder S; S.init(T, DM, F.G, (int)blockIdx.x);
        pg8::EpiBf16Res E{(bf16_t*)(F.ws + WS_XMID), p.in[I_X], DM};
        pg8::ConvGU cv{p.in[I_WGU], F.ws + WS_WGUT, CONV_P1 + F.gw, CONV_END, F.NGW, 0};
        pg8::gemm_phase<pg8::EpiBf16Res, pg8::StaticOrder, GS, true, false, 0, pg8::ConvGU>(ring, g, S, E, F.wave, cv); SEAM(5); }
    if (IN(6)) { FRESH(); p4a(F, p); SEAM(6); }
    if (IN(8)) {
        FRESH(); build_moe_tables(F);
        pg8::Gemm g{F.ws + WS_HF8, F.ws + WS_WGUT}; using GS = pg8::GShape<DM, DM, DM, (size_t)4096 * DM>;
        pg8::MoeOrder S{__builtin_amdgcn_readfirstlane((int)F.MISC[MI_NMT]), 16, F.G, (int)blockIdx.x, (const LAS int*)(F.lds + MISC_OFF + 4 * MI_T2E)};
        pg8::EpiSwiGLU8 E{F.ws + WS_ACT, DM, p.in[I_BGU]};
        pg8::Gather gi{(const unsigned short*)(F.ws + WS_LIST), (const LAS unsigned*)(F.lds + MISC_OFF + 4 * MI_PBASE), (const LAS unsigned*)(F.lds + MISC_OFF + 4 * MI_CNT)};
        pg8::EpiHost<3> eh{p.in[I_WDN], F.ws + WS_WDT, F.gw, HOST_DN_EXPERTS * 4096, F.NGW, DM, 5, 0, 0, {0, 0, 0}};
        pg8::gemm_phase<pg8::EpiSwiGLU8, pg8::MoeOrder, GS, true, true, STAG5, pg8::NoConv, pg8::EpiHost<3>, KROT5, pg8::Gather>(ring, g, S, E, F.wave, pg8::NoConv(), eh, gi); SEAM(8); }
#if (REPEAT_MASK & 0x100)
    if (IN(8)) {
        FRESH(); build_moe_tables(F);
        pg8::Gemm g{F.ws + WS_ABUF, F.ws + WS_WGUT}; using GS = pg8::GShape<DM, DM, DM, (size_t)4096 * DM>;
        pg8::MoeOrder S{__builtin_amdgcn_readfirstlane((int)F.MISC[MI_NMT]), 16, F.G, (int)blockIdx.x, (const LAS int*)(F.lds + MISC_OFF + 4 * MI_T2E)};
        pg8::EpiSwiGLU8 E{F.ws + WS_Y, DM, p.in[I_BGU]};
#if P5DUP == 2
        pg8::Gemm g2{F.ws + WS_HF8, F.ws + WS_WGUT};
        pg8::Gather gi{(const unsigned short*)(F.ws + WS_LIST), (const LAS unsigned*)(F.lds + MISC_OFF + 4 * MI_PBASE), (const LAS unsigned*)(F.lds + MISC_OFF + 4 * MI_CNT)};
        pg8::gemm_phase<pg8::EpiSwiGLU8, pg8::MoeOrder, GS, true, true, STAG5, pg8::NoConv, pg8::NoHost, false, pg8::Gather>(ring, g2, S, E, F.wave, pg8::NoConv(), pg8::NoHost(), gi); SEAM(8); }
#else
        pg8::gemm_phase<pg8::EpiSwiGLU8, pg8::MoeOrder, GS, true, true, STAG5>(ring, g, S, E, F.wave); SEAM(8); }
#endif
#endif
    if (IN(9)) {
        FRESH(); build_moe_tables(F);
        pg8::Gemm g{F.ws + WS_ACT, F.ws + WS_WDT}; using GS = pg8::GShape<DM, DM, DM, (size_t)DM * DM>;
        pg8::MoeOrder S{__builtin_amdgcn_readfirstlane((int)F.MISC[MI_NMT]), 8, F.G, (int)blockIdx.x, (const LAS int*)(F.lds + MISC_OFF + 4 * MI_T2E)};
        pg8::EpiFp8S E{F.ws + WS_Y, DM, p.in[I_BDN], DM, 1.0f / 2048.0f, 32.0f};
        pg8::gemm_phase<pg8::EpiFp8S, pg8::MoeOrder, GS, true, true, STAG6, pg8::NoConv, pg8::NoHost, KROT6>(ring, g, S, E, F.wave); SEAM(9); }
#if (REPEAT_MASK & 0x200)
    if (IN(9)) {
        FRESH(); build_moe_tables(F);
#ifdef P6_PITCH
        pg8::Gemm g{F.ws + WS_ACT, F.ws + WS_WDT}; using GS = pg8::GShape<P6_PITCH, P6_PITCH, DM, (size_t)DM * DM>;
#else
        pg8::Gemm g{F.ws + WS_ACT, F.ws + WS_WDT}; using GS = pg8::GShape<DM, DM, DM, (size_t)DM * DM>;
#endif
        pg8::MoeOrder S{__builtin_amdgcn_readfirstlane((int)F.MISC[MI_NMT]), 8, F.G, (int)blockIdx.x, (const LAS int*)(F.lds + MISC_OFF + 4 * MI_T2E)};
#ifdef P6_NOSTORE
        pg8::EpiNull_<P6_NOSTORE - 1> E{};

#ifndef P6_FLP
#define P6_FLP false
#endif
        pg8::gemm_phase<pg8::EpiNull_<P6_NOSTORE - 1>, pg8::MoeOrder, GS, true, true, STAG6, pg8::NoConv, pg8::NoHost, false, pg8::NoGather, P6_FLP>(ring, g, S, E, F.wave); SEAM(9); }
#elif defined(P6_MODE)
        pg8::EpiFp8S_<P6_MODE> E{F.ws + WS_Y, DM, p.in[I_BDN], DM, 1.0f / 2048.0f, 32.0f};
        pg8::gemm_phase<pg8::EpiFp8S_<P6_MODE>, pg8::MoeOrder, GS, true, true, STAG6>(ring, g, S, E, F.wave); SEAM(9); }
#else
        pg8::EpiFp8S E{F.ws + WS_Y, DM, p.in[I_BDN], DM, 1.0f / 2048.0f, 32.0f};
        pg8::gemm_phase<pg8::EpiFp8S, pg8::MoeOrder, GS, true, true, STAG6>(ring, g, S, E, F.wave); SEAM(9); }
#endif
#endif
    if (IN(10)) REP(10) { FRESH(); p7(F, p); if (((REPEAT_MASK >> 10) & 1)) xcd_barrier(bar, F.wave == 0 && fresh_lane() == 0); }
#undef IN
#undef SEAM
}
#ifndef STAGE
#define STAGE 4
#endif
#ifndef PER_PHASE_LAUNCH
#define PER_PHASE_LAUNCH 0
#endif

#if STAGE < 4
__global__ void adapt_z_kernel(const bf16_t* Z, float* z) {
    const long idx = (long)blockIdx.x * blockDim.x + threadIdx.x; const long t = idx / ZC; const int c = (int)(idx % ZC);
    z[t * INC + (c < 3072 ? c : c + 16)] = bf2f(Z[idx]);
}
__global__ void adapt_bf16_kernel(const bf16_t* src, float* dst) { const long idx = (long)blockIdx.x * blockDim.x + threadIdx.x; dst[idx] = bf2f(src[idx]); }
#endif

static void launch_mk(Params& a, int lo, int hi, int grid, hipStream_t stream) {
#if PER_PHASE_LAUNCH
    for (int k = lo; k < hi; ++k) { a.ph_lo = k; a.ph_hi = k + 1; hipLaunchKernelGGL(mk_fwd, dim3(grid), dim3(512), LDS_BYTES, stream, a); }
#else
    a.ph_lo = lo; a.ph_hi = hi; hipLaunchKernelGGL(mk_fwd, dim3(grid), dim3(512), LDS_BYTES, stream, a);
#endif
}

extern "C" void kernel_launch(void* const* d_in, const int* in_sizes, int n_in, void* d_out, int out_size, void* d_ws, size_t ws_size, hipStream_t stream) {
    static int grid = 0;
    if (grid == 0) {
        int dev = 0, cus = 0;
        if (hipGetDevice(&dev) != hipSuccess || hipDeviceGetAttribute(&cus, hipDeviceAttributeMultiprocessorCount, dev) != hipSuccess) { grid = -1; return; }
        if (hipFuncSetAttribute((const void*)mk_fwd, hipFuncAttributeMaxDynamicSharedMemorySize, LDS_BYTES) != hipSuccess) { grid = -1; return; }
        int per_cu = 0;
        (void)hipOccupancyMaxActiveBlocksPerMultiprocessor(&per_cu, (const void*)mk_fwd, 512, LDS_BYTES);
        (void)hipGetLastError();
        grid = cus < 256 ? cus : 256;
        if (per_cu < 1) fprintf(stderr, "kernel_launch: occupancy query reports %d\n", per_cu);
    }
    if (grid < 0) return;
    (void)hipMemsetAsync((char*)d_ws + WS_CTL, 0, CTL_ZERO_BYTES, stream);
    Params a{};
    for (int i = 0; i < 22; ++i) a.in[i] = (const float*)d_in[i];
    a.out = (float*)d_out; a.ws = (unsigned char*)d_ws;
#if STAGE >= 4
    launch_mk(a, 0, NPHASE, grid, stream);
#else
    const float* x = a.in[I_X];
    char* ws = (char*)d_ws + WS_ABUF; size_t off = 0;
    auto alloc = [&](size_t bytes) { void* p = ws + off; off += (bytes + 255) & ~(size_t)255; return p; };
    int* counts = (int*)alloc(256);
    float* z = (float*)alloc((size_t)T * INC * 4);
    float* ogla = (float*)alloc((size_t)T * 1024 * 4);
    float* xc = (float*)alloc((size_t)T * 1024 * 4);
    float* za = (float*)alloc((size_t)T * 1024 * 4);
    float* zi = (float*)alloc((size_t)T * 1024 * 4);
    float* mix = (float*)alloc((size_t)T * DM * 4);
    float* xmid = (float*)alloc((size_t)T * DM * 4);
    float* hf = (float*)alloc((size_t)T * DM * 4);
    float* logits = (float*)alloc((size_t)T * 32 * 4);
    float* gates = (float*)alloc((size_t)T * 4 * 4);
    int* list = (int*)alloc((size_t)NEXP * T * 4);
    float* act = (float*)alloc((size_t)T * 4 * DM * 4);
    float* y = (float*)alloc((size_t)T * 4 * DM * 4);
    (void)hipMemsetAsync(counts, 0, 256, stream);
#if STAGE == 1
    launch_mk(a, 0, 2, grid, stream);
    adapt_z_kernel<<<(unsigned)((size_t)T * ZC / 256), 256, 0, stream>>>((const bf16_t*)((char*)d_ws + WS_Z), z);
    gla_naive_kernel<<<64, 256, 0, stream>>>(z, (const float*)((char*)d_ws + WS_LG), ogla);
    gla_out_kernel<<<T, 256, 0, stream>>>(ogla, z, a.in[I_GNG], mix);
    lru_conv_kernel<<<T * 1024 / 256, 256, 0, stream>>>(z, a.in[I_CW], a.in[I_CB], xc);
    for (int h = 0; h < 4; ++h) {
        GemmArgs g{}; g.A = xc + h * 256; g.lda = 1024; g.ldb = 256; g.ldc = 1024; g.M = T; g.N = 256; g.K = 256; g.a_div = 1;
        g.B = a.in[I_WA] + (size_t)h * 65536; g.C = za + h * 256;
        sgemm_kernel<0><<<dim3(2, T / 128, 1), 256, 0, stream>>>(g);
        g.B = a.in[I_WI] + (size_t)h * 65536; g.C = zi + h * 256;
        sgemm_kernel<0><<<dim3(2, T / 128, 1), 256, 0, stream>>>(g);
    }
    lru_gate_kernel<<<T * 1024 / 256, 256, 0, stream>>>(xc, za, zi, a.in[I_BA], a.in[I_BI], a.in[I_AP]);
    lru_scan_kernel<<<2048 / 64, 64, 0, stream>>>(za, zi, z, mix);
#endif
#if STAGE == 2
    launch_mk(a, 0, 5, grid, stream);
    adapt_bf16_kernel<<<(unsigned)((size_t)T * DM / 256), 256, 0, stream>>>((const bf16_t*)((char*)d_ws + WS_MIX), mix);
#endif
#if STAGE <= 2
    { GemmArgs g{}; g.A = mix; g.lda = DM; g.B = a.in[I_WOUT]; g.ldb = DM; g.C = xmid; g.ldc = DM; g.M = T; g.N = DM; g.K = DM; g.a_div = 1; g.resid = x; g.ldr = DM;
      sgemm_kernel<1><<<dim3(DM / 128, T / 128, 1), 256, 0, stream>>>(g); }
#else
    launch_mk(a, 0, 6, grid, stream);
    xmid = (float*)((char*)d_ws + WS_XMID);
#endif
    rmsnorm_kernel<<<T, 256, 0, stream>>>(xmid, a.in[I_NFG], hf);
    { GemmArgs g{}; g.A = hf; g.lda = DM; g.B = a.in[I_WR]; g.ldb = 32; g.C = logits; g.ldc = 32; g.M = T; g.N = 32; g.K = DM; g.a_div = 1; g.bias = a.in[I_BR];
      sgemm_kernel<0><<<dim3(1, T / 128, 1), 256, 0, stream>>>(g); }
    route_kernel<<<T / 256, 256, 0, stream>>>(logits, counts, list, gates);
    { GemmArgs g{}; g.A = hf; g.lda = DM; g.B = a.in[I_WGU]; g.ldb = 4096; g.C = act; g.ldc = DM; g.M = 0; g.N = 4096; g.K = DM; g.a_div = 4; g.bias = a.in[I_BGU];
      g.rowlist = list; g.count = counts; g.strideB_e = (long)DM * 4096; g.strideBias_e = 4096; g.list_stride = T;
      sgemm_kernel<2><<<dim3(2048 / 64, T / 128, NEXP), 256, 0, stream>>>(g); }
    { GemmArgs g{}; g.A = act; g.lda = DM; g.B = a.in[I_WDN]; g.ldb = DM; g.C = y; g.ldc = DM; g.M = 0; g.N = DM; g.K = DM; g.a_div = 1; g.bias = a.in[I_BDN];
      g.rowlist = list; g.count = counts; g.strideB_e = (long)DM * DM; g.strideBias_e = DM; g.list_stride = T;
      sgemm_kernel<0><<<dim3(DM / 128, T / 128, NEXP), 256, 0, stream>>>(g); }
    final_kernel<<<T, 256, 0, stream>>>(xmid, y, gates, a.in[I_NFINAL], (float*)d_out);
#endif
}
```

```cpp
#define STAGE 4
#define PER_PHASE_LAUNCH 0
#define REPEAT_MASK 0
#include <hip/hip_runtime.h>
#include <stdint.h>
#include <stdio.h>

#define GAS __attribute__((address_space(1)))
#define LAS __attribute__((address_space(3)))
typedef unsigned short bf16_t;
typedef short bf16x8 __attribute__((ext_vector_type(8)));
typedef short bf16x4 __attribute__((ext_vector_type(4)));
typedef float f32x4 __attribute__((ext_vector_type(4)));
typedef float f32x2 __attribute__((ext_vector_type(2)));
typedef float f32x16 __attribute__((ext_vector_type(16)));
typedef unsigned u32x4 __attribute__((ext_vector_type(4)));
typedef unsigned u32x2 __attribute__((ext_vector_type(2)));
typedef int i32x8 __attribute__((ext_vector_type(8)));
typedef int i32x4 __attribute__((ext_vector_type(4)));
typedef int i32x32 __attribute__((ext_vector_type(32)));

constexpr int T = 16384, SEQL = 8192, DM = 2048, INC = 5136, ZC = 5120, NEXP = 32;
constexpr int ZQ = 0, ZK = 512, ZV = 1024, ZR = 2048, ZLX = 3072, ZLG = 4096;
constexpr int MPAD_MAX = 65536 + NEXP * 256;
constexpr int NCHUNK = 256;

constexpr size_t MiB = 1u << 20;
constexpr size_t WS_CTL = 0, CTL_ZERO_BYTES = 128 * 1024;
constexpr size_t WS_WINT = 1 * MiB;
constexpr size_t WS_WOUTT = WS_WINT + 20 * MiB;
constexpr size_t WS_WGUT = WS_WOUTT + 8 * MiB;
constexpr size_t WS_WDT = WS_WGUT + 512 * MiB;
constexpr size_t WS_WAT = WS_WDT + 256 * MiB;
constexpr size_t WS_WIT = WS_WAT + 512 * 1024;
constexpr size_t WS_WRT = WS_WIT + 512 * 1024;
constexpr size_t WS_WGLT = WS_WRT + 512 * 1024;
constexpr size_t WS_H = WS_WRT + 1 * MiB;
constexpr size_t WS_LG = WS_H + 64 * MiB;
constexpr size_t WS_Z = WS_LG + 32 * MiB;
constexpr size_t WS_AN = WS_Z + 160 * MiB;
constexpr size_t WS_DN = WS_AN + 128 * MiB;
constexpr size_t WS_SP = WS_DN + 1 * MiB;
constexpr size_t WS_AUA = WS_SP + 64 * MiB;
constexpr size_t WS_AUU = WS_AUA + 64 * MiB;
constexpr size_t WS_SUMA = WS_AUU + 64 * MiB;
constexpr size_t WS_SUMH = WS_SUMA + 1 * MiB;
constexpr size_t WS_MIX = WS_SUMH + 1 * MiB;
constexpr size_t WS_XMID = WS_MIX + 64 * MiB;
constexpr size_t WS_RSTD = WS_XMID + 128 * MiB;
constexpr size_t WS_TOKE = WS_RSTD + 1 * MiB;
constexpr size_t WS_GATES = WS_TOKE + 1 * MiB;
constexpr size_t WS_ABUF = WS_GATES + 1 * MiB;
constexpr size_t WS_HF8 = WS_ABUF, WS_LIST = WS_ABUF + 64 * MiB;
constexpr size_t WS_ACT = WS_ABUF + 288 * MiB;
constexpr size_t WS_Y = WS_ACT + 288 * MiB;
constexpr size_t WS_END = WS_Y + 288 * MiB;
constexpr int CW_BAR = 4096;
constexpr int CW_CNT = 16384;

constexpr int RING_BYTES = 131072;
constexpr int SCR_BYTES = 135168;
constexpr int MISC_OFF = SCR_BYTES;
constexpr int LDS_BYTES = 147456;
constexpr int MI_PBASE = 16, MI_NMT = 48, MI_LCNT = 64, MI_LBASE = 96, MI_T2E = 128, MI_CNT = 480;

#define LDS_WAIT() asm volatile("s_waitcnt lgkmcnt(0)" ::: "memory")
#define VM_WAIT() asm volatile("s_waitcnt vmcnt(0)" ::: "memory")

typedef __bf16 bf16v2_t __attribute__((ext_vector_type(2)));
__device__ __forceinline__ unsigned pk2(float lo, float hi) { const f32x2 v = {lo, hi}; return __builtin_bit_cast(unsigned, __builtin_convertvector(v, bf16v2_t)); }
#ifdef SIM_FP8
__device__ __forceinline__ float q8_(float x, float sc) { int p = 0; p = __builtin_amdgcn_cvt_pk_fp8_f32(__builtin_amdgcn_fmed3f(x * sc, -448.0f, 448.0f), 0.0f, p, false); return __builtin_amdgcn_cvt_f32_fp8(p, 0) * (1.0f / sc); }
#define PK2A(a, b) pk2(q8_(a, 16.0f), q8_(b, 16.0f))
#define PK2W(a, b) pk2(q8_(a, 512.0f), q8_(b, 512.0f))
#else
#define PK2A(a, b) pk2(a, b)
#define PK2W(a, b) pk2(a, b)
#endif
__device__ __forceinline__ unsigned f2bf(float f) { return pk2(f, 0.0f) & 0xffffu; }
__device__ __forceinline__ float bf2f(unsigned short b) { return __builtin_bit_cast(float, (unsigned)b << 16); }
__device__ __forceinline__ float bflo(unsigned w) { return __builtin_bit_cast(float, w << 16); }
__device__ __forceinline__ float bfhi(unsigned w) { return __builtin_bit_cast(float, w & 0xffff0000u); }
__device__ __forceinline__ float clamp448(float x) { return __builtin_amdgcn_fmed3f(x, -448.0f, 448.0f); }
__device__ __forceinline__ unsigned pk4_fp8(float a, float b, float c, float d) {
    int p = 0; p = __builtin_amdgcn_cvt_pk_fp8_f32(clamp448(a), clamp448(b), p, false); p = __builtin_amdgcn_cvt_pk_fp8_f32(clamp448(c), clamp448(d), p, true); return (unsigned)p; }
__device__ __forceinline__ unsigned pk4_fp8_nc(float a, float b, float c, float d) {
    int p = 0; p = __builtin_amdgcn_cvt_pk_fp8_f32(a, b, p, false); p = __builtin_amdgcn_cvt_pk_fp8_f32(c, d, p, true); return (unsigned)p; }
__device__ __forceinline__ float fp8f(unsigned w, int b) { return b == 0 ? __builtin_amdgcn_cvt_f32_fp8((int)w, 0) : b == 1 ? __builtin_amdgcn_cvt_f32_fp8((int)w, 1) : b == 2 ? __builtin_amdgcn_cvt_f32_fp8((int)w, 2) : __builtin_amdgcn_cvt_f32_fp8((int)w, 3); }
__device__ __forceinline__ float wave_sum(float v) {
#pragma unroll
    for (int o = 1; o < 64; o <<= 1) v += __shfl_xor(v, o);
    return v;
}
__device__ __forceinline__ int fresh_lane() { int l; asm volatile("v_mbcnt_lo_u32_b32 %0, -1, 0\n\tv_mbcnt_hi_u32_b32 %0, -1, %0" : "=v"(l)); return l; }
__device__ __forceinline__ float sigmoidf_(float x) { return __builtin_amdgcn_rcpf(1.0f + __expf(-x)); }
__device__ __forceinline__ float rsqrtf_(float x) { return __builtin_amdgcn_rsqf(x); }

#define XB_TMO      128
#define XB_XCNT(j)  (256  + 64 * (j))
#define XB_XSUB(j)  (1280 + 64 * (j))
#define XB_XGEN(j)  (2304 + 64 * (j))
#define XB_TOP      3328
#define XB_TOPGEN   3392
#define XCD_BAR_WORDS 3456
#define XB_SPIN_CAP (1u << 18)

__device__ __forceinline__ unsigned xb_ld(unsigned* p)              { return __hip_atomic_load(p, __ATOMIC_RELAXED, __HIP_MEMORY_SCOPE_AGENT); }
__device__ __forceinline__ unsigned xb_add(unsigned* p, unsigned v) { return __hip_atomic_fetch_add(p, v, __ATOMIC_RELAXED, __HIP_MEMORY_SCOPE_AGENT); }
__device__ __forceinline__ unsigned xb_xcc_id() { return (unsigned)__builtin_amdgcn_s_getreg((3 << 11) | 20) & 0xFu; }
#define XB_SPIN(cond, bar) do { unsigned _sp = 0; while (cond) { __builtin_amdgcn_s_sleep(1); \
    if ((++_sp & 255u) == 0u) { if (xb_ld(&(bar)[XB_TMO])) break; if (_sp > XB_SPIN_CAP) { atomicAdd(&(bar)[XB_TMO], 1u); break; } } } } while (0)

struct XcdBarrier { unsigned* bar; unsigned x; volatile LAS unsigned* st; };

__device__ __forceinline__ XcdBarrier xcd_barrier_post(unsigned* bar, volatile LAS unsigned* st, bool t0) {
    XcdBarrier b; b.bar = bar; b.x = xb_xcc_id(); b.st = st;
    if (t0) (void)xb_add(&bar[XB_XCNT(b.x)], 1u);
    return b;
}
__device__ __forceinline__ void xcd_barrier_complete(unsigned* bar, unsigned x, unsigned& nloc, unsigned& nx) {
    const unsigned G = gridDim.x * gridDim.y * gridDim.z;
    unsigned sum, cnt, mine, sp = 0u;
    for (;;) {
        sum = 0u; cnt = 0u; mine = 0u;
#pragma unroll
        for (unsigned j = 0; j < 16; ++j) { const unsigned c = xb_ld(&bar[XB_XCNT(j)]); sum += c; cnt += (c > 0u) ? 1u : 0u; mine = (j == x) ? c : mine; }
        if (sum == G) break;
        __builtin_amdgcn_s_sleep(1);
        if ((++sp & 255u) == 0u) { if (xb_ld(&bar[XB_TMO])) break; if (sp > XB_SPIN_CAP) { atomicAdd(&bar[XB_TMO], 1u); break; } }
    }
    nloc = mine > 0u ? mine : 1u; nx = cnt > 0u ? cnt : 1u;
}
__device__ __forceinline__ void xcd_barrier(const XcdBarrier& b, bool t0) {
    asm volatile("s_waitcnt vmcnt(0)" ::: "memory");
    __syncthreads();
    if (t0) {
        unsigned* bar = b.bar;
        __builtin_amdgcn_s_waitcnt(0);
        unsigned nloc = b.st[0], nx = b.st[1];
        if (nloc == 0u) { xcd_barrier_complete(bar, b.x, nloc, nx); b.st[0] = nloc; b.st[1] = nx; }
        const unsigned old = xb_add(&bar[XB_XSUB(b.x)], 1u);
        const unsigned gen = old / nloc;
        if (old + 1u == (gen + 1u) * nloc) {
            __builtin_amdgcn_fence(__ATOMIC_RELEASE, "agent");
            asm volatile("s_waitcnt vmcnt(0)" ::: "memory");
            const unsigned og = xb_add(&bar[XB_TOP], 1u);
            const unsigned tg = og / nx;
            if (og + 1u == (tg + 1u) * nx) xb_add(&bar[XB_TOPGEN], 1u);
            else XB_SPIN(xb_ld(&bar[XB_TOPGEN]) == tg, bar);
            __builtin_amdgcn_fence(__ATOMIC_ACQUIRE, "agent");
            xb_add(&bar[XB_XGEN(b.x)], 1u);
            asm volatile("s_waitcnt vmcnt(0)" ::: "memory");
        } else {
            XB_SPIN(xb_ld(&bar[XB_XGEN(b.x)]) == gen, bar);
            __builtin_amdgcn_fence(__ATOMIC_ACQUIRE, "agent");
            asm volatile("s_waitcnt vmcnt(0)" ::: "memory");
        }
    }
    __syncthreads();
}

namespace pg8 {
#ifndef PG8_WGM
#define PG8_WGM 4
#endif
constexpr int BM = 256, BK = 64, HALF = 128, HTB = HALF * BK * 2, STAGE_BYTES = 8 * HTB, NXCD = 8, WGM = PG8_WGM;
__host__ __device__ __forceinline__ int lds_byte(int r, int c) { const int st = (r >> 4) * 2 + (c >> 5), rr = r & 15, cc = c & 31, ob = rr * 64 + cc * 2; return st * 1024 + (ob ^ (((ob >> 9) & 1) << 5)); }
__host__ __device__ __forceinline__ void stage_rc(int b, int& R, int& C) { const int st = b / 1024, sb = b % 1024, swz = sb ^ (((sb >> 9) & 1) << 5); R = (st >> 1) * 16 + swz / 64; C = (st & 1) * 32 + (swz % 64) / 2; }
__host__ __device__ __forceinline__ int perm32(int rho) { const int n = rho >> 4, i = rho & 15; return 8 * (i >> 2) + 4 * n + (i & 3); }

struct Unit { int pm, pn, e; };
struct Gemm { const void* A; const void* Bt; };
template <int LDA_, int LDB_, int KB_, size_t SB_> struct GShape { static constexpr int LDA = LDA_, LDB = LDB_, KB = KB_; static constexpr size_t SB = SB_; };

__device__ __forceinline__ bool order_map(int L, int nM, int nN, int& pm, int& pn) {
    const int nwg = nM * nN; if (L >= nwg) return false;
    int wgid = L; { const int q = nwg / NXCD, r = nwg % NXCD, xcd = wgid % NXCD, off = wgid / NXCD; wgid = (xcd < r ? xcd * (q + 1) : r * (q + 1) + (xcd - r) * q) + off; }
    const int nig = WGM * nN, gid = wgid / nig, fm = gid * WGM, gsz = (nM - fm) < WGM ? (nM - fm) : WGM;
    pm = fm + ((wgid % nig) % gsz); pn = (wgid % nig) / gsz; return true;
}
struct StaticOrder {
    int nM, nN, G, c;
    __device__ void init(int M, int N, int G_, int c_) { nM = M / BM; nN = N / BM; G = G_; c = c_; }
    __device__ __forceinline__ bool next(int i, Unit& u) const { u.e = 0; return order_map(i * G + c, nM, nN, u.pm, u.pn); }
};
struct MoeOrder {
    int nM, nN, G, c; const LAS int* t2e;
    __device__ __forceinline__ bool next(int i, Unit& u) const { if (!order_map(i * G + c, nM, nN, u.pm, u.pn)) return false; u.e = __builtin_amdgcn_readfirstlane(t2e[u.pm]); return true; }
};

__device__ __forceinline__ unsigned cvt_pk_bf16(float lo, float hi) { return pk2(lo, hi); }

struct EpiBf16 {
    static constexpr bool PERM = true; static constexpr int NSTORES = 16;
    bf16_t* O; int ldc; const float* bias; int bias_stride;
    __device__ __forceinline__ void operator()(const f32x4 (&acc)[2][2][4][2], const Unit& u, int wr, int wc, int fr, int fq) const {
        const int row0 = u.pm * BM + wr * 64 + fr; const int col0 = u.pn * BM + wc * 32 + 8 * fq;
        f32x4 bv[2][2];
#pragma unroll
        for (int bj = 0; bj < 2; ++bj)
#pragma unroll
            for (int n = 0; n < 2; ++n) bv[bj][n] = bias ? *(const f32x4*)(bias + (size_t)u.e * bias_stride + col0 + bj * HALF + 4 * n) : (f32x4){0.f, 0.f, 0.f, 0.f};
#pragma unroll
        for (int ai = 0; ai < 2; ++ai)
#pragma unroll
            for (int m = 0; m < 4; ++m) { bf16_t* rowp = O + (size_t)(row0 + ai * HALF + m * 16) * ldc + col0;
#pragma unroll
                for (int bj = 0; bj < 2; ++bj) { const f32x4 v0 = acc[ai][bj][m][0] + bv[bj][0], v1 = acc[ai][bj][m][1] + bv[bj][1];
                    u32x4 w; w.x = cvt_pk_bf16(v0[0], v0[1]); w.y = cvt_pk_bf16(v0[2], v0[3]); w.z = cvt_pk_bf16(v1[0], v1[1]); w.w = cvt_pk_bf16(v1[2], v1[3]);
                    *(u32x4*)(rowp + bj * HALF) = w; } }
    }
};
struct EpiF32Res {
    static constexpr bool PERM = false;
    float* C; const float* resid; int ldc;
    __device__ __forceinline__ void operator()(const f32x4 (&acc)[2][2][4][2], const Unit& u, int wr, int wc, int fr, int fq) const {
        const int row0 = u.pm * BM + wr * 64 + fr, col0 = u.pn * BM + wc * 32 + 4 * fq;
#pragma unroll
        for (int ai = 0; ai < 2; ++ai)
#pragma unroll
            for (int m = 0; m < 4; ++m) { const size_t off = (size_t)(row0 + ai * HALF + m * 16) * ldc + col0;
#pragma unroll
                for (int bj = 0; bj < 2; ++bj)
#pragma unroll
                    for (int n = 0; n < 2; ++n) { const f32x4 r = *(const f32x4*)(resid + off + bj * HALF + n * 16); *(f32x4*)(C + off + bj * HALF + n * 16) = acc[ai][bj][m][n] + r; } }
    }
};
struct EpiSwiGLU {
    static constexpr bool PERM = true;
    bf16_t* O; int ldc; const float* bias;
    __device__ __forceinline__ void operator()(const f32x4 (&acc)[2][2][4][2], const Unit& u, int wr, int wc, int fr, int fq) const {
        const int row0 = u.pm * BM + wr * 64 + fr; const int j0 = u.pn * HALF + wc * 32 + 8 * fq;
        const float* be = bias + (size_t)u.e * 4096;
        f32x4 bg[2], bu[2];
#pragma unroll
        for (int n = 0; n < 2; ++n) { bg[n] = *(const f32x4*)(be + j0 + 4 * n); bu[n] = *(const f32x4*)(be + 2048 + j0 + 4 * n); }
#pragma unroll
        for (int ai = 0; ai < 2; ++ai)
#pragma unroll
            for (int m = 0; m < 4; ++m) { bf16_t* rowp = O + (size_t)(row0 + ai * HALF + m * 16) * ldc + j0;
                float o[8];
#pragma unroll
                for (int n = 0; n < 2; ++n) { const f32x4 g = acc[ai][0][m][n] + bg[n], up = acc[ai][1][m][n] + bu[n];
#pragma unroll
                    for (int q = 0; q < 4; ++q) { const float gt = fminf(g[q], 7.0f), ut = fminf(fmaxf(up[q], -7.0f), 7.0f);
                        const float glu = gt * __builtin_amdgcn_rcpf(1.0f + __expf(-1.702f * gt)); o[4 * n + q] = (ut + 1.0f) * glu; } }
                u32x4 w; w.x = cvt_pk_bf16(o[0], o[1]); w.y = cvt_pk_bf16(o[2], o[3]); w.z = cvt_pk_bf16(o[4], o[5]); w.w = cvt_pk_bf16(o[6], o[7]);
                *(u32x4*)rowp = w; }
    }
};

struct EpiBf16Res {
    static constexpr bool PERM = true; static constexpr int NSTORES = 16;
    bf16_t* O; const float* resid; int ldc;
    __device__ __forceinline__ void operator()(const f32x4 (&acc)[2][2][4][2], const Unit& u, int wr, int wc, int fr, int fq) const {
        const int row0 = u.pm * BM + wr * 64 + fr; const int col0 = u.pn * BM + wc * 32 + 8 * fq;
#pragma unroll
        for (int ai = 0; ai < 2; ++ai)
#pragma unroll
            for (int m = 0; m < 4; ++m) { const size_t off = (size_t)(row0 + ai * HALF + m * 16) * ldc + col0;
#pragma unroll
                for (int bj = 0; bj < 2; ++bj) { const f32x4 r0 = *(const f32x4*)(resid + off + bj * HALF), r1 = *(const f32x4*)(resid + off + bj * HALF + 4);
                    const f32x4 v0 = acc[ai][bj][m][0] + r0, v1 = acc[ai][bj][m][1] + r1;
                    u32x4 w; w.x = cvt_pk_bf16(v0[0], v0[1]); w.y = cvt_pk_bf16(v0[2], v0[3]); w.z = cvt_pk_bf16(v1[0], v1[1]); w.w = cvt_pk_bf16(v1[2], v1[3]);
                    *(u32x4*)(O + off + bj * HALF) = w; } }
    }
};
#ifndef USE_BIAS_LDS
#define USE_BIAS_LDS 0
#endif
template <int MODE = 0> struct EpiFp8S_ {
    static constexpr int NSTORES = 16;
    static constexpr bool PERM = true, BIAS_LDS = (USE_BIAS_LDS != 0);
    unsigned char* O; int ldc; const float* bias; int bias_stride; float scale, oscale;
    __device__ __forceinline__ const char* bias_base(const Unit& u) const { return (const char*)(bias + (size_t)u.e * bias_stride + u.pn * BM); }
    __device__ static __forceinline__ unsigned bias_voff(int i) { return (unsigned)i * 4u; }
    __device__ __forceinline__ void operator()(const f32x4 (&acc)[2][2][4][2], const Unit& u, int wr, int wc, int fr, int fq, const LAS float* bl) const {
        const int row0 = u.pm * BM + wr * 64 + fr; const int col0 = u.pn * BM + wc * 32 + 8 * fq;
        f32x4 bv[2][2];
#pragma unroll
        for (int bj = 0; bj < 2; ++bj)
#pragma unroll
            for (int n = 0; n < 2; ++n) { if constexpr (MODE == 2) bv[bj][n] = (f32x4){oscale, oscale, oscale, oscale}; else if constexpr (BIAS_LDS) bv[bj][n] = *(const LAS f32x4*)(bl + wc * 32 + 8 * fq + bj * HALF + 4 * n) * oscale; else bv[bj][n] = *(const f32x4*)(bias + (size_t)u.e * bias_stride + col0 + bj * HALF + 4 * n) * oscale; }
        const float sc = scale * oscale;
#pragma unroll
        for (int ai = 0; ai < 2; ++ai)
#pragma unroll
            for (int m = 0; m < 4; ++m) { unsigned char* rowp = O + (size_t)(row0 + ai * HALF + m * 16) * ldc + col0;
#pragma unroll
                for (int bj = 0; bj < 2; ++bj) { const f32x4 v0 = acc[ai][bj][m][0] * sc + bv[bj][0], v1 = acc[ai][bj][m][1] * sc + bv[bj][1];
                    u32x2 w; w.x = pk4_fp8(v0[0], v0[1], v0[2], v0[3]); w.y = pk4_fp8(v1[0], v1[1], v1[2], v1[3]);
                    if constexpr (MODE == 1) { if (u.pm < 0) *(u32x2*)(rowp + bj * HALF) = w; else asm volatile("" :: "v"(w)); } else *(u32x2*)(rowp + bj * HALF) = w; } }
    }
};
using EpiFp8S = EpiFp8S_<0>;
struct EpiSwiGLU8 {
    static constexpr bool PERM = true, BIAS_LDS = (USE_BIAS_LDS != 0); static constexpr int NSTORES = 8;
    unsigned char* O; int ldc; const float* bias;
    struct Bias { f32x4 bg[2], bu[2];
        __device__ __forceinline__ void pin() { asm volatile("" : "+v"(bg[0]), "+v"(bg[1]), "+v"(bu[0]), "+v"(bu[1])); } };
    __device__ __forceinline__ const char* bias_base(const Unit& u) const { return (const char*)(bias + (size_t)u.e * 4096 + u.pn * HALF); }
    __device__ static __forceinline__ unsigned bias_voff(int i) { return (unsigned)(i < 128 ? i : 2048 - 128 + i) * 4u; }
    __device__ __forceinline__ void load_bias(const Unit& u, int wc, int fq, Bias& b, const LAS float* bl) const {
        const int j0 = wc * 32 + 8 * fq;
        if constexpr (BIAS_LDS) {
#pragma unroll
            for (int n = 0; n < 2; ++n) { b.bg[n] = *(const LAS f32x4*)(bl + j0 + 4 * n); b.bu[n] = *(const LAS f32x4*)(bl + 128 + j0 + 4 * n); }
        } else { const float* be = bias + (size_t)u.e * 4096 + u.pn * HALF + j0;
#pragma unroll
            for (int n = 0; n < 2; ++n) { b.bg[n] = *(const f32x4*)(be + 4 * n); b.bu[n] = *(const f32x4*)(be + 2048 + 4 * n); } } }
    __device__ __forceinline__ void operator()(const f32x4 (&acc)[2][2][4][2], const Unit& u, int wr, int wc, int fr, int fq, const LAS float* bl) const { Bias b; load_bias(u, wc, fq, b, bl); apply(acc, u, wr, wc, fr, fq, b); }
    __device__ __forceinline__ void apply(const f32x4 (&acc)[2][2][4][2], const Unit& u, int wr, int wc, int fr, int fq, const Bias& b) const {
        const int row0 = u.pm * BM + wr * 64 + fr; const int j0 = u.pn * HALF + wc * 32 + 8 * fq;
        const f32x4 (&bg)[2] = b.bg; const f32x4 (&bu)[2] = b.bu;
#pragma unroll
        for (int ai = 0; ai < 2; ++ai)
#pragma unroll
            for (int m = 0; m < 4; ++m) { unsigned char* rowp = O + (size_t)(row0 + ai * HALF + m * 16) * ldc + j0;
                float o[8];
#pragma unroll
                for (int n = 0; n < 2; ++n) { const f32x4 g = acc[ai][0][m][n] * (1.0f / 8192.0f) + bg[n], up = acc[ai][1][m][n] * (1.0f / 8192.0f) + bu[n];
#pragma unroll
                    for (int q = 0; q < 4; ++q) { const float gt = fminf(g[q], 7.0f), ut = __builtin_amdgcn_fmed3f(up[q], -7.0f, 7.0f);
                        const float glu = gt * __builtin_amdgcn_rcpf(1.0f + __builtin_amdgcn_exp2f(-2.4554669595930156f * gt)); o[4 * n + q] = __builtin_fmaf(ut, 4.0f, 4.0f) * glu; } }
                u32x2 w; w.x = pk4_fp8_nc(o[0], o[1], o[2], o[3]); w.y = pk4_fp8_nc(o[4], o[5], o[6], o[7]);
                *(u32x2*)rowp = w; }
    }
};
template <int ALL> struct EpiNull_ { static constexpr bool PERM = true;
    __device__ __forceinline__ void operator()(const f32x4 (&acc)[2][2][4][2], const Unit& u, int wr, int wc, int fr, int fq) const {
        if constexpr (ALL == 0) asm volatile("" :: "v"(acc[0][0][0][0]), "v"(acc[1][1][3][1]));
        else {
#pragma unroll
        for (int a = 0; a < 2; ++a)
#pragma unroll
            for (int b = 0; b < 2; ++b) asm volatile("" :: "v"(acc[a][b][0][0]), "v"(acc[a][b][0][1]), "v"(acc[a][b][1][0]), "v"(acc[a][b][1][1]), "v"(acc[a][b][2][0]), "v"(acc[a][b][2][1]), "v"(acc[a][b][3][0]), "v"(acc[a][b][3][1])); } } };
using EpiNull = EpiNull_<1>;
struct EpiBf16S {
    static constexpr bool PERM = true;
    bf16_t* O; int ldc; const float* bias; int bias_stride; float scale;
    __device__ __forceinline__ void operator()(const f32x4 (&acc)[2][2][4][2], const Unit& u, int wr, int wc, int fr, int fq) const {
        const int row0 = u.pm * BM + wr * 64 + fr; const int col0 = u.pn * BM + wc * 32 + 8 * fq;
        f32x4 bv[2][2];
#pragma unroll
        for (int bj = 0; bj < 2; ++bj)
#pragma unroll
            for (int n = 0; n < 2; ++n) bv[bj][n] = *(const f32x4*)(bias + (size_t)u.e * bias_stride + col0 + bj * HALF + 4 * n);
#pragma unroll
        for (int ai = 0; ai < 2; ++ai)
#pragma unroll
            for (int m = 0; m < 4; ++m) { bf16_t* rowp = O + (size_t)(row0 + ai * HALF + m * 16) * ldc + col0;
#pragma unroll
                for (int bj = 0; bj < 2; ++bj) { const f32x4 v0 = acc[ai][bj][m][0] * scale + bv[bj][0], v1 = acc[ai][bj][m][1] * scale + bv[bj][1];
                    u32x4 w; w.x = cvt_pk_bf16(v0[0], v0[1]); w.y = cvt_pk_bf16(v0[2], v0[3]); w.z = cvt_pk_bf16(v1[0], v1[1]); w.w = cvt_pk_bf16(v1[2], v1[3]);
                    *(u32x4*)(rowp + bj * HALF) = w; } }
    }
};

__device__ __forceinline__ i32x8 pg8_get8(const i32x32& v, int idx) { i32x8 r;
#pragma unroll
    for (int j = 0; j < 8; ++j) r[j] = v[8 * idx + j];
    return r; }
__device__ __forceinline__ i32x4 pg8_get4(const i32x32& v, int idx) { i32x4 r;
#pragma unroll
    for (int j = 0; j < 4; ++j) r[j] = v[4 * idx + j];
    return r; }
struct NoHost { static constexpr bool ON = false; static constexpr int N = 0; };
template <int N_> struct EpiHost {
    static constexpr bool ON = true; static constexpr int N = N_;
    const float* W; unsigned char* WT; int cid, cend, cstride; int ldw, cbs, gu, e0; int pend[N_];
    __device__ __forceinline__ void issue(unsigned (&x)[16 * N_], int lane) {
        const unsigned vo = (unsigned)lane * 4u; const size_t rowb = (size_t)ldw * 4;
#pragma unroll
        for (int j = 0; j < N_; ++j) { const int id = cid < cend ? cid : cend - 1; pend[j] = id; cid += cstride;
            const int cb = id & ((1 << cbs) - 1), kb = (id >> cbs) & 127, e = e0 + (id >> (cbs + 7));
            const char* rb = (const char*)(W + (size_t)e * DM * ldw + (size_t)(16 * kb) * ldw + 64 * cb);
#pragma unroll
            for (int i = 0; i < 16; ++i) asm volatile("s_nop 4\n\tglobal_load_dword %0, %1, %2" : "=v"(x[16 * j + i]) : "v"(vo), "s"(rb + (size_t)i * rowb) : "memory"); }
    }
    __device__ __forceinline__ void finish(const unsigned (&x)[16 * N_], int lane) const {
#pragma unroll
        for (int j = 0; j < N_; ++j) { const int id = pend[j]; const int cb = id & ((1 << cbs) - 1), kb = (id >> cbs) & 127, e = e0 + (id >> (cbs + 7)); const int n0 = 64 * cb;
            const int drow0 = !gu ? n0 : (n0 < 2048) ? (256 * (n0 >> 7) + (n0 & 127)) : (256 * ((n0 - 2048) >> 7) + 128 + ((n0 - 2048) & 127));
            u32x4 o;
#pragma unroll
            for (int q = 0; q < 4; ++q) o[q] = pk4_fp8(__builtin_bit_cast(float, x[16 * j + 4 * q]) * 512.0f, __builtin_bit_cast(float, x[16 * j + 4 * q + 1]) * 512.0f, __builtin_bit_cast(float, x[16 * j + 4 * q + 2]) * 512.0f, __builtin_bit_cast(float, x[16 * j + 4 * q + 3]) * 512.0f);
            *(u32x4*)(WT + (size_t)e * ldw * DM + (size_t)(drow0 + lane) * DM + 16 * kb) = o; }
    }
};
struct NoGather { static constexpr bool ON = false; };
struct Gather { static constexpr bool ON = true; const unsigned short* list; const LAS unsigned* pbase; const LAS unsigned* cnt; };
__device__ __forceinline__ unsigned gather_clamp(unsigned P, int r0, int cn) { const unsigned lo = (r0 < cn) ? (P & 0xffffu) : 0u, hi = (r0 + 64 < cn) ? (P >> 16) : 0u; return lo | (hi << 16); }
struct NoConv { static constexpr bool ON = false; };
struct ConvGU {
    static constexpr bool ON = true;
    const float* W; unsigned char* WT; int cid, cend, cstride, pend; const char* rbase;
    __device__ __forceinline__ void issue(unsigned (&x)[16], int lane) {
        const int id = cid < cend ? cid : cend - 1; pend = id; cid += cstride;
        const int e = id >> 13, kb = (id >> 6) & 127, cb = id & 63;
        const char* rb = (const char*)(W + (size_t)e * DM * 4096 + (size_t)(16 * kb) * 4096 + 64 * cb);
        const unsigned vo = (unsigned)lane * 4u; rbase = rb;
#pragma unroll
        for (int i = 0; i < 8; ++i) asm volatile("s_nop 4\n\tglobal_load_dword %0, %1, %2" : "=v"(x[i]) : "v"(vo), "s"(rb + (size_t)i * 16384) : "memory");
    }
    __device__ __forceinline__ void issue_b(unsigned (&x)[16], int lane) {
        const unsigned vo = (unsigned)lane * 4u;
#pragma unroll
        for (int i = 8; i < 16; ++i) asm volatile("s_nop 4\n\tglobal_load_dword %0, %1, %2" : "=v"(x[i]) : "v"(vo), "s"(rbase + (size_t)i * 16384) : "memory");
    }
    __device__ __forceinline__ void finish(const unsigned (&x)[16], int lane) const {
        const int id = pend; const int e = id >> 13, kb = (id >> 6) & 127, cb = id & 63; const int n0 = 64 * cb;
        const int drow0 = (n0 < 2048) ? (256 * (n0 >> 7) + (n0 & 127)) : (256 * ((n0 - 2048) >> 7) + 128 + ((n0 - 2048) & 127));
        u32x4 o;
#pragma unroll
        for (int q = 0; q < 4; ++q) o[q] = pk4_fp8(__builtin_bit_cast(float, x[4 * q]) * 512.0f, __builtin_bit_cast(float, x[4 * q + 1]) * 512.0f, __builtin_bit_cast(float, x[4 * q + 2]) * 512.0f, __builtin_bit_cast(float, x[4 * q + 3]) * 512.0f);
        *(u32x4*)(WT + (size_t)e * 4096 * DM + (size_t)(drow0 + lane) * DM + 16 * kb) = o;
    }
};
#define PG8_X16A(x, b) "+v"(x[b+0]), "+v"(x[b+1]), "+v"(x[b+2]), "+v"(x[b+3]), "+v"(x[b+4]), "+v"(x[b+5]), "+v"(x[b+6]), "+v"(x[b+7]), "+v"(x[b+8]), "+v"(x[b+9]), "+v"(x[b+10]), "+v"(x[b+11]), "+v"(x[b+12]), "+v"(x[b+13]), "+v"(x[b+14]), "+v"(x[b+15])
#define PG8_X16(x) "+v"(x[0]), "+v"(x[1]), "+v"(x[2]), "+v"(x[3]), "+v"(x[4]), "+v"(x[5]), "+v"(x[6]), "+v"(x[7]), "+v"(x[8]), "+v"(x[9]), "+v"(x[10]), "+v"(x[11]), "+v"(x[12]), "+v"(x[13]), "+v"(x[14]), "+v"(x[15])

template <class E, class = void> struct epi_nstores { static constexpr int value = 0; };
template <class E> struct epi_nstores<E, decltype((void)E::NSTORES)> { static constexpr int value = E::NSTORES; };
template <class E, class = void> struct epi_takes_bl { static constexpr bool value = false; };
template <class E> struct epi_takes_bl<E, decltype((void)E::BIAS_LDS)> { static constexpr bool value = true; };
template <class E, class = void> struct has_bias_lds { static constexpr bool value = false; };
template <class E> struct has_bias_lds<E, decltype((void)E::BIAS_LDS)> { static constexpr bool value = E::BIAS_LDS; };
constexpr int BIAS_LDS_OFF = MISC_OFF + 4096;
#ifndef CV_XMASK
#define CV_XMASK 0
#endif
template <class Epi, class Sched, class GS, bool ALIGN_EPI = true, bool F8 = false, int STAGGER_TICKS = 0, class CV = NoConv, class EH = NoHost, bool KROT = false, class GI = NoGather, bool FLP = false>
__device__ __forceinline__ void gemm_phase(LAS unsigned char* lds, const Gemm g, const Sched& S, const Epi& E, int wave, CV cv = CV(), EH eh = EH(), GI gi = GI()) {
    const int wid = wave, lane = fresh_lane(), tid = wid * 64 + lane, wr = wid >> 2, wc = wid & 3, fr = lane & 15, fq = lane >> 4;
    constexpr int nt = GS::KB / 128;
    unsigned voffA, voffB;
    { int R, C; stage_rc(tid * 16, R, C); const int Rb = Epi::PERM ? ((R & ~31) + perm32(R & 31)) : R;
      voffA = (unsigned)(R * GS::LDA + C * 2); voffB = (unsigned)(Rb * GS::LDB + C * 2);
      if constexpr (FLP) { const int b = tid * 16; voffA = (unsigned)((b >> 7) * GS::LDA + (b & 127)); voffB = (unsigned)((b >> 7) * GS::LDB + (b & 127)); } }
    constexpr size_t pstepA = (size_t)64 * GS::LDA, pstepB = (size_t)64 * GS::LDB;
    constexpr size_t kstep = (size_t)(BK * 2);
    constexpr size_t hstepA = (size_t)HALF * GS::LDA, hstepB = (size_t)HALF * GS::LDB;
    constexpr size_t tstepA = 2 * hstepA, tstepB = 2 * hstepB;
    const unsigned ldsw = (unsigned)wid * 1024u;
    const unsigned ldsb = (unsigned)(size_t)lds + ldsw;
    const int aoff = lds_byte(wr * 64 + fr, F8 ? fq * 16 : fq * 8), boff = lds_byte(wc * 32 + fr, F8 ? fq * 16 : fq * 8);
    const int kofs = F8 ? 16 : 1024;
#define PG8_SA(b, h) (((b) * 2 + (h)) * HTB)
#define PG8_SB(b, h) ((4 + (b) * 2 + (h)) * HTB)
#define PG8_STAGE(bufoff, gbase, voff) do { _Pragma("unroll") for (int _i = 0; _i < 2; ++_i) { unsigned _keep; \
        asm volatile("s_mov_b32 %0, m0\n\ts_mov_b32 m0, %3\n\ts_nop 3\n\tglobal_load_lds_dwordx4 %1, %2\n\ts_mov_b32 m0, %0" \
            : "=&s"(_keep) : "v"(voff##_v), "s"((const char*)(gbase) + _i * pstep##voff), "s"(ldsb + (unsigned)((bufoff) + _i * 8192)) : "memory"); } } while (0)
#define PG8_STAGE_GA(bufoff, kp, vlo, vhi) do { unsigned _keep; \
        asm volatile("s_mov_b32 %0, m0\n\ts_mov_b32 m0, %3\n\ts_nop 3\n\tglobal_load_lds_dwordx4 %1, %2\n\ts_mov_b32 m0, %0" : "=&s"(_keep) : "v"(vlo), "s"((const char*)(kp)), "s"(ldsb + (unsigned)(bufoff)) : "memory"); \
        asm volatile("s_mov_b32 %0, m0\n\ts_mov_b32 m0, %3\n\ts_nop 3\n\tglobal_load_lds_dwordx4 %1, %2\n\ts_mov_b32 m0, %0" : "=&s"(_keep) : "v"(vhi), "s"((const char*)(kp)), "s"(ldsb + (unsigned)((bufoff) + 8192)) : "memory"); } while (0)
#define PG8_STA(bufoff, kp, h, nx) do { if constexpr (GI::ON) { const unsigned _p = (nx) ? nvP[h] : voP[h]; const unsigned _lo = ((_p & 0xffffu) << 11) + gcb, _hi = ((_p >> 16) << 11) + gcb; PG8_STAGE_GA(bufoff, kp, _lo, _hi); } \
        else PG8_STAGE(bufoff, (kp) + (h) * hstepA, voffA); } while (0)
#define pstepvoffA pstepA
#define pstepvoffB pstepB
#define voffA_v voffA
#define voffB_v voffB
#define PG8_LD16(p) (*(const LAS i32x4*)(p))
#define PG8_SET8(V, idx, lo, hi) do { _Pragma("unroll") for (int _j = 0; _j < 4; ++_j) { V[8 * (idx) + _j] = (lo)[_j]; V[8 * (idx) + 4 + _j] = (hi)[_j]; } } while (0)
#define PG8_GET8(V, idx) pg8_get8(V, idx)
#define PG8_GETLO(V, idx) __builtin_bit_cast(bf16x8, pg8_get4(V, 2 * (idx)))
#define PG8_GETHI(V, idx) __builtin_bit_cast(bf16x8, pg8_get4(V, 2 * (idx) + 1))
#define PG8_LDA(dst, b, h) do { _Pragma("unroll") for (int m = 0; m < 4; ++m) { const i32x4 _lo = PG8_LD16(lds + PG8_SA(b, h) + aoff + m * 2048), _hi = PG8_LD16(lds + PG8_SA(b, h) + aoff + m * 2048 + kofs); \
        PG8_SET8(AV, m, _lo, _hi); } } while (0)
#define PG8_LDB(dst, b, h) do { _Pragma("unroll") for (int n = 0; n < 2; ++n) { const i32x4 _lo = PG8_LD16(lds + PG8_SB(b, h) + boff + n * 2048), _hi = PG8_LD16(lds + PG8_SB(b, h) + boff + n * 2048 + kofs); \
        PG8_SET8(BV, (dst) + n, _lo, _hi); } } while (0)
#define PG8_MMA(ai, bj, At, Bt) do { __builtin_amdgcn_s_setprio(1); \
        if constexpr (F8) { _Pragma("unroll") for (int m = 0; m < 4; ++m) _Pragma("unroll") for (int n = 0; n < 2; ++n) \
            acc[ai][bj][m][n] = __builtin_amdgcn_mfma_scale_f32_16x16x128_f8f6f4(PG8_GET8(BV, (Bt) + n), PG8_GET8(AV, m), acc[ai][bj][m][n], 0, 0, 0, 0, 0, 0); } \
        else { _Pragma("unroll") for (int m = 0; m < 4; ++m) _Pragma("unroll") for (int n = 0; n < 2; ++n) { \
            acc[ai][bj][m][n] = __builtin_amdgcn_mfma_f32_16x16x32_bf16(PG8_GETLO(BV, (Bt) + n), PG8_GETLO(AV, m), acc[ai][bj][m][n], 0, 0, 0); \
            acc[ai][bj][m][n] = __builtin_amdgcn_mfma_f32_16x16x32_bf16(PG8_GETHI(BV, (Bt) + n), PG8_GETHI(AV, m), acc[ai][bj][m][n], 0, 0, 0); } } \
        __builtin_amdgcn_s_setprio(0); } while (0)
#define PG8_WAIT_V(n) asm volatile("s_waitcnt vmcnt(" #n ")" ::: "memory")
#define PG8_WAIT_L(n) asm volatile("s_waitcnt lgkmcnt(" #n ")" ::: "memory")
#define PG8_BAR __builtin_amdgcn_s_barrier()
#define PG8_SCHED __builtin_amdgcn_sched_barrier(0)
    Unit cur, nxt; int ui = 0;
    if (!S.next(0, cur)) return;
    constexpr bool BL = has_bias_lds<Epi>::value;
    constexpr int NST = EH::ON ? EH::N : epi_nstores<Epi>::value;
#define PG8_WAIT_VN(n) asm volatile("s_waitcnt vmcnt(%0)" :: "n"(n) : "memory")
    static_assert(!(BL && CV::ON), "the counted waits below know one or the other");
    unsigned bx = 0;
    unsigned cx[16];
    if constexpr (CV::ON) { cv.issue(cx, lane); cv.issue_b(cx, lane); asm volatile("s_waitcnt vmcnt(0)" ::: "memory"); asm volatile("" : PG8_X16(cx) :: "memory"); }
    if constexpr (STAGGER_TICKS > 0) {
        if (blockIdx.x & 1) { const unsigned long long t0 = __builtin_amdgcn_s_memrealtime(); while (__builtin_amdgcn_s_memrealtime() - t0 < (unsigned long long)STAGGER_TICKS) __builtin_amdgcn_s_sleep(8); } }
    i32x32 AV, BV;
    constexpr int At = 0, B0 = 0, B1 = 2;
    static_assert(!GI::ON || GS::LDA == 2048, "gather: 2 KiB token rows");
    int tfetch = 0; if constexpr (GI::ON) asm volatile("s_mov_b32 %0, 0" : "=s"(tfetch));
    unsigned voP[2] = {0u, 0u}, nvP[2] = {0u, 0u}, gcb = 0u;
    if constexpr (GI::ON) { int R, C; stage_rc(tid * 16, R, C); gcb = (unsigned)(C * 2);
        const int lb = cur.pm * BM - __builtin_amdgcn_readfirstlane((int)gi.pbase[cur.e]), cn = __builtin_amdgcn_readfirstlane((int)gi.cnt[cur.e]);
        const u32x2 pr = *(const u32x2*)(gi.list + (size_t)cur.e * 16384 + lb + 4 * R);
        voP[0] = gather_clamp(pr.x, lb + R, cn); voP[1] = gather_clamp(pr.y, lb + R + 128, cn); }
    const char* cA = GI::ON ? (const char*)g.A : (const char*)g.A + (size_t)cur.pm * tstepA; const char* cB = (const char*)g.Bt + (size_t)cur.e * GS::SB + (size_t)cur.pn * tstepB;
#define PG8_KO(u) (KROT ? ((((u).pn & 7) * 2 + ((u).pm & 3) * 4) * (nt / 16)) & (nt - 1) : 0)
    int ko = PG8_KO(cur);
    { const char* pA = cA + (size_t)ko * kstep; const char* pB = cB + (size_t)ko * kstep;
    PG8_STAGE(PG8_SB(0, 0), pB, voffB); PG8_SCHED; PG8_STAGE(PG8_SB(0, 1), pB + hstepB, voffB); PG8_SCHED; PG8_STA(PG8_SA(0, 0), pA, 0, false); PG8_SCHED; PG8_STA(PG8_SA(0, 1), pA, 1, false); PG8_SCHED;
    if (wr == 1) PG8_BAR;
    PG8_WAIT_V(2); PG8_BAR;
    PG8_STAGE(PG8_SB(1, 0), pB + kstep, voffB); PG8_SCHED; PG8_STA(PG8_SA(1, 0), pA + kstep, 0, false); PG8_SCHED; PG8_STAGE(PG8_SB(1, 1), pB + hstepB + kstep, voffB); PG8_SCHED; }
    PG8_WAIT_V(6); PG8_BAR; PG8_SCHED;
    f32x4 acc[2][2][4][2];
#pragma unroll
    for (int a = 0; a < 2; ++a)
#pragma unroll
        for (int b = 0; b < 2; ++b)
#pragma unroll
            for (int m = 0; m < 4; ++m)
#pragma unroll
                for (int n = 0; n < 2; ++n) acc[a][b][m][n] = (f32x4){0.f, 0.f, 0.f, 0.f};
    for (;;) {
        const bool has_next = S.next(ui + 1, nxt);
        const char* nA = (has_next && !GI::ON) ? (const char*)g.A + (size_t)nxt.pm * tstepA : cA;
        const char* nB = has_next ? (const char*)g.Bt + (size_t)nxt.e * GS::SB + (size_t)nxt.pn * tstepB : cB;
        const int nko = has_next ? PG8_KO(nxt) : ko;
        for (int t = 0; t < nt; t += 2) {
            const bool last = (t == nt - 2);
            const int kt = KROT ? ((ko + t) & (nt - 1)) : t, kt2 = KROT ? ((ko + t + 2) & (nt - 1)) : t + 2;
            const char* a1 = cA + (size_t)(kt + 1) * kstep;
            const char* a2 = last ? nA + (size_t)nko * kstep : cA + (size_t)kt2 * kstep; const char* b2 = last ? nB + (size_t)nko * kstep : cB + (size_t)kt2 * kstep;
            const char* a3 = a2 + kstep; const char* b3 = b2 + kstep;
            PG8_LDB(B0, 0, 0); PG8_LDB(B1, 0, 1); PG8_SCHED; PG8_LDA(At, 0, 0); PG8_STA(PG8_SA(1, 1), a1, 1, false);
            PG8_WAIT_V(8);
            if constexpr (CV::ON) asm volatile("" : PG8_X16(cx));
            PG8_WAIT_L(0); PG8_BAR;
            const bool xon = CV::ON && ((t & CV_XMASK) == 0);
            if constexpr (CV::ON) { if (xon) { cv.finish(cx, lane); cv.issue(cx, lane); } }
            if constexpr (GI::ON) { if (t == tfetch && has_next) {
                int R, C; stage_rc((wid * 64 + fresh_lane()) * 16, R, C); const unsigned lvo = (unsigned)R * 8u;
                const char* lp = (const char*)(gi.list + (size_t)nxt.e * 16384 + (nxt.pm * BM - __builtin_amdgcn_readfirstlane((int)gi.pbase[nxt.e])));
                u32x2 pr; asm volatile("s_nop 4\n\tglobal_load_dwordx2 %0, %1, %2" : "=&v"(pr) : "v"(lvo), "s"(lp) : "memory"); nvP[0] = pr.x; nvP[1] = pr.y; } }
            if constexpr (BL) { if (last) { const unsigned bvo = Epi::bias_voff((wid * 64 + fresh_lane()) & 255);
                asm volatile("s_nop 4\n\tglobal_load_dword %0, %1, %2" : "=v"(bx) : "v"(bvo), "s"(E.bias_base(cur)) : "memory"); } }
            PG8_MMA(0, 0, At, B0); PG8_MMA(0, 1, At, B1); PG8_BAR; PG8_SCHED;
            PG8_LDA(At, 0, 1); PG8_STAGE(PG8_SB(0, 0), b2, voffB); PG8_STAGE(PG8_SB(0, 1), b2 + hstepB, voffB); PG8_STA(PG8_SA(0, 0), a2, 0, last);
            if (xon) PG8_WAIT_V(17); else if (BL && last) PG8_WAIT_V(9); else if (GI::ON && t == tfetch && has_next) PG8_WAIT_V(9); else PG8_WAIT_V(8);
            PG8_WAIT_L(0); PG8_BAR;
            if constexpr (CV::ON) { if (xon) cv.issue_b(cx, lane); }
            PG8_MMA(1, 0, At, B0); PG8_MMA(1, 1, At, B1); PG8_BAR; PG8_SCHED;
            PG8_LDB(B0, 1, 0); PG8_LDB(B1, 1, 1); PG8_SCHED; PG8_LDA(At, 1, 0); PG8_STA(PG8_SA(0, 1), a2, 1, last);
            if (xon) PG8_WAIT_V(25); else PG8_WAIT_V(8);
            if constexpr (GI::ON) { if (t == tfetch && has_next) { asm volatile("" : "+v"(nvP[0]), "+v"(nvP[1]));
                int R, C; stage_rc((wid * 64 + fresh_lane()) * 16, R, C); const int lb = nxt.pm * BM - __builtin_amdgcn_readfirstlane((int)gi.pbase[nxt.e]), cn = __builtin_amdgcn_readfirstlane((int)gi.cnt[nxt.e]);
                nvP[0] = gather_clamp(nvP[0], lb + R, cn); nvP[1] = gather_clamp(nvP[1], lb + R + 128, cn); } }
            if constexpr (BL) { if (last) { asm volatile("" : "+v"(bx));
                *(LAS unsigned*)(lds + BIAS_LDS_OFF + 4 * ((wid * 64 + fresh_lane()) & 255)) = bx; } }
            PG8_WAIT_L(0); PG8_BAR; PG8_MMA(0, 0, At, B0); PG8_MMA(0, 1, At, B1); PG8_BAR; PG8_SCHED;
            PG8_LDA(At, 1, 1); PG8_STAGE(PG8_SB(1, 0), b3, voffB); PG8_STAGE(PG8_SB(1, 1), b3 + hstepB, voffB); PG8_STA(PG8_SA(1, 0), a3, 0, last);
            if constexpr (CV::ON) { if (xon) PG8_WAIT_V(16); else PG8_WAIT_V(8); } else PG8_WAIT_V(8);
            PG8_WAIT_L(0); PG8_BAR; PG8_MMA(1, 0, At, B0); PG8_MMA(1, 1, At, B1); PG8_BAR; PG8_SCHED;
        }
        if constexpr (ALIGN_EPI) { if (wr == 0) PG8_BAR; }
        { const int l2 = fresh_lane();
          const LAS float* bl = (const LAS float*)(lds + BIAS_LDS_OFF);
          if constexpr (EH::ON) {
              unsigned ex[16 * EH::N]; typename Epi::Bias eb;
              if constexpr (BL) { eh.issue(ex, l2); E.load_bias(cur, wc, l2 >> 4, eb, bl); }
              else { E.load_bias(cur, wc, l2 >> 4, eb, bl); eb.pin(); eh.issue(ex, l2); }
              E.apply(acc, cur, wr, wc, l2 & 15, l2 >> 4, eb);
              asm volatile("s_waitcnt vmcnt(0)" ::: "memory");
              if constexpr (EH::N == 3) asm volatile("" : PG8_X16A(ex, 0), PG8_X16A(ex, 16), PG8_X16A(ex, 32) :: "memory");
              else asm volatile("" : PG8_X16A(ex, 0), PG8_X16A(ex, 16), PG8_X16A(ex, 32), PG8_X16A(ex, 48) :: "memory");
              eh.finish(ex, l2);
          } else if constexpr (epi_takes_bl<Epi>::value) E(acc, cur, wr, wc, l2 & 15, l2 >> 4, bl);
          else E(acc, cur, wr, wc, l2 & 15, l2 >> 4); }
        if (!has_next) break;
#pragma unroll
        for (int a = 0; a < 2; ++a)
#pragma unroll
            for (int b = 0; b < 2; ++b)
#pragma unroll
                for (int m = 0; m < 4; ++m)
#pragma unroll
                    for (int n = 0; n < 2; ++n) acc[a][b][m][n] = (f32x4){0.f, 0.f, 0.f, 0.f};
        cur = nxt; cA = nA; cB = nB; ko = nko; ++ui;
        if constexpr (GI::ON) {
#pragma unroll
            for (int i = 0; i < 2; ++i) voP[i] = nvP[i]; }
        if constexpr (ALIGN_EPI) { if (wr == 1) PG8_BAR; }
    }
    if constexpr (CV::ON) { asm volatile("s_waitcnt vmcnt(0)" ::: "memory"); asm volatile("" : PG8_X16(cx) :: "memory"); cv.finish(cx, lane); }
    else PG8_WAIT_V(0);
    if constexpr (!ALIGN_EPI) { if (wr == 0) PG8_BAR; }
    PG8_BAR;
#undef PG8_SA
#undef PG8_KO
#undef PG8_SB
#undef PG8_STAGE
#undef PG8_STAGE_GA
#undef PG8_STA
#undef pstepvoffA
#undef pstepvoffB
#undef voffA_v
#undef voffB_v
#undef PG8_LDA
#undef PG8_LD16
#undef PG8_SET8
#undef PG8_GET8
#undef PG8_GETLO
#undef PG8_GETHI
#undef PG8_LDB
#undef PG8_MMA
#undef PG8_WAIT_V
#undef PG8_WAIT_VN
#undef PG8_WAIT_L
#undef PG8_BAR
#undef PG8_SCHED
}
}
struct Params {
    const float* in[22];
    float* out; unsigned char* ws;
    int ph_lo, ph_hi;
};
enum { I_X = 0, I_NMG, I_WIN, I_GWG, I_GBG, I_GNG, I_CW, I_CB, I_WA, I_BA, I_WI, I_BI, I_AP, I_WOUT, I_NFG, I_WR, I_BR, I_WGU, I_BGU, I_WDN, I_BDN, I_NFINAL };

struct Frame {
    LAS unsigned char* lds; volatile LAS unsigned* MISC;
    int tid, lane, wave, G, gw, NGW;
    unsigned char* ws;
};

__device__ __forceinline__ float gelu_tanh_f(float x) {
    const float u = 0.7978845608028654f * (x + 0.044715f * x * x * x);
    const float e = __expf(2.0f * u);
    const float th = 1.0f - 2.0f * __builtin_amdgcn_rcpf(e + 1.0f);
    return 0.5f * x * (1.0f + th);
}
__device__ __forceinline__ float log_sigmoid_f(float s) { return fminf(s, 0.f) - __logf(1.0f + __expf(-fabsf(s))); }

__device__ __forceinline__ void p0_item(const float* W, int ldw, int col0, bf16_t* WT, int ldt, size_t drow0, int k0, LAS float* scr, int lane) {
    (void)scr;
    const float* src = W + (size_t)k0 * ldw + col0 + lane;
    float v[64];
#pragma unroll
    for (int i = 0; i < 64; ++i) v[i] = src[(size_t)i * ldw];
    bf16_t* dst = WT + (drow0 + lane) * (size_t)ldt + k0;
#pragma unroll
    for (int c = 0; c < 8; ++c) { u32x4 o; o.x = pk2(v[8 * c], v[8 * c + 1]); o.y = pk2(v[8 * c + 2], v[8 * c + 3]); o.z = pk2(v[8 * c + 4], v[8 * c + 5]); o.w = pk2(v[8 * c + 6], v[8 * c + 7]);
        *(u32x4*)(dst + 8 * c) = o; }
}

__device__ __forceinline__ void p0_item8(const float* W, int ldw, int col0, unsigned char* WT, int ldt, size_t drow0, int k0, int lane) {
    const float* src = W + (size_t)k0 * ldw + col0 + lane;
    float v[64];
#pragma unroll
    for (int i = 0; i < 64; ++i) v[i] = src[(size_t)i * ldw];
    unsigned char* dst = WT + (drow0 + lane) * (size_t)ldt + k0;
#pragma unroll
    for (int c = 0; c < 4; ++c) { u32x4 o;
#pragma unroll
        for (int q = 0; q < 4; ++q) o[q] = pk4_fp8(v[16 * c + 4 * q] * 512.0f, v[16 * c + 4 * q + 1] * 512.0f, v[16 * c + 4 * q + 2] * 512.0f, v[16 * c + 4 * q + 3] * 512.0f);
        *(u32x4*)(dst + 16 * c) = o; }
}

constexpr int CONV_EXPERTS_P0 = 28, HOST_DN_EXPERTS_P0 = 24;
struct CoopTile { const float* W; int ldw; int col0; unsigned char* WT; int ldt_b; int mode; int k0; int gu; int drow0; };
__device__ __forceinline__ void coop_load(const CoopTile& t, int w, int l, f32x4 (&v)[16]) {
    if (t.mode == 0) {
#pragma unroll
        for (int i = 0; i < 8; ++i) { const float* r = t.W + (size_t)(t.k0 + 8 * w + i) * t.ldw + t.col0 + 4 * l; v[2 * i] = *(const f32x4*)r; v[2 * i + 1] = *(const f32x4*)(r + 256); }
    } else {
#pragma unroll
        for (int i = 0; i < 16; ++i) v[i] = *(const f32x4*)(t.W + (size_t)(t.k0 + 16 * w + i) * t.ldw + t.col0 + 4 * l);
    }
}
__device__ __forceinline__ void coop_to_lds(const CoopTile& t, int w, int l, const f32x4 (&v)[16], LAS unsigned char* buf) {
    const int sw = (w ^ (l & 7)) * 16;
    if (t.mode == 0) {
#pragma unroll
        for (int jp = 0; jp < 2; ++jp)
#pragma unroll
            for (int j = 0; j < 4; ++j) { u32x4 o; if (t.ldw == INC) { o.x = PK2W(v[0 + jp][j], v[2 + jp][j]); o.y = PK2W(v[4 + jp][j], v[6 + jp][j]); o.z = PK2W(v[8 + jp][j], v[10 + jp][j]); o.w = PK2W(v[12 + jp][j], v[14 + jp][j]); } else { o.x = pk2(v[0 + jp][j], v[2 + jp][j]); o.y = pk2(v[4 + jp][j], v[6 + jp][j]); o.z = pk2(v[8 + jp][j], v[10 + jp][j]); o.w = pk2(v[12 + jp][j], v[14 + jp][j]); }
                *(LAS u32x4*)(buf + (256 * jp + 4 * l + j) * 128 + sw) = o; }
    } else {
#pragma unroll
        for (int j = 0; j < 4; ++j) { u32x4 o;
#pragma unroll
            for (int q = 0; q < 4; ++q) o[q] = pk4_fp8(v[4 * q][j] * 512.0f, v[4 * q + 1][j] * 512.0f, v[4 * q + 2][j] * 512.0f, v[4 * q + 3][j] * 512.0f);
            *(LAS u32x4*)(buf + (4 * l + j) * 128 + sw) = o; }
    }
}
__device__ __forceinline__ void coop_store(const CoopTile& t, int w, int l, const LAS unsigned char* buf) {
    const int nrows = t.mode == 0 ? 512 : 256; const int cp = l & 7;
    for (int n = 8 * w + (l >> 3); n < nrows; n += 64) {
        const u32x4 o = *(const LAS u32x4*)(buf + n * 128 + cp * 16); const int c = cp ^ ((n >> 2) & 7);
        int drow;
        if (t.gu) { const int g = t.col0 + n; drow = (g < 2048) ? (256 * (g >> 7) + (g & 127)) : (256 * ((g - 2048) >> 7) + 128 + ((g - 2048) & 127)); } else drow = t.drow0 + n;
        *(u32x4*)(t.WT + (size_t)drow * t.ldt_b + (t.mode == 0 ? 2 * t.k0 : t.k0) + 16 * c) = o; }
}
__device__ __forceinline__ bool coop_tile(const Params& p, unsigned char* ws, int it, CoopTile& t) {
    constexpr int N_GU = (32 - CONV_EXPERTS_P0) * 256, N_DN = (32 - HOST_DN_EXPERTS_P0) * 128, N_INA = 32 * 6, N_INB = 32 * 4, N_OUT = 32 * 4;
    int r = it;
    if (r < N_GU) { const int e = CONV_EXPERTS_P0 + (r >> 8), q = r & 255, kb = q >> 4, nb = q & 15; t = CoopTile{p.in[I_WGU] + (size_t)e * DM * 4096, 4096, 256 * nb, ws + WS_WGUT + (size_t)e * 4096 * DM, DM, 1, 128 * kb, 1, 0}; return true; } r -= N_GU;
    if (r < N_DN) { const int e = HOST_DN_EXPERTS_P0 + (r >> 7), q = r & 127, kb = q >> 3, nb = q & 7; t = CoopTile{p.in[I_WDN] + (size_t)e * DM * DM, DM, 256 * nb, ws + WS_WDT + (size_t)e * DM * DM, DM, 1, 128 * kb, 0, 256 * nb}; return true; } r -= N_DN;
    if (r < N_INA) { const int kb = r / 6, nb = r % 6; t = CoopTile{p.in[I_WIN], INC, 512 * nb, ws + WS_WINT, DM * 2, 0, 64 * kb, 0, 512 * nb}; return true; } r -= N_INA;
    if (r < N_INB) { const int kb = r >> 2, nb = r & 3; t = CoopTile{p.in[I_WIN], INC, 3088 + 512 * nb, ws + WS_WINT, DM * 2, 0, 64 * kb, 0, 3072 + 512 * nb}; return true; } r -= N_INB;
    if (r < N_OUT) { const int kb = r >> 2, nb = r & 3; t = CoopTile{p.in[I_WOUT], DM, 512 * nb, ws + WS_WOUTT, DM * 2, 0, 64 * kb, 0, 512 * nb}; return true; }
    return false;
}
__device__ __forceinline__ void p0a(Frame& F, const Params& p) {
    const int w = F.wave, l = F.lane;
    CoopTile cur, nxt; f32x4 v[16];
    int it = blockIdx.x; bool have = coop_tile(p, F.ws, it, cur);
    if (have) coop_load(cur, w, l, v);
    int par = 0;
    while (have) {
        LAS unsigned char* buf = F.lds + par * 65536;
        coop_to_lds(cur, w, l, v, buf);
        it += F.G; const bool hn = coop_tile(p, F.ws, it, nxt);
        if (hn) coop_load(nxt, w, l, v);
        __syncthreads();
        coop_store(cur, w, l, buf);
        cur = nxt; have = hn; par ^= 1;
    }
    __syncthreads();
    { bf16_t* WaT = (bf16_t*)(F.ws + WS_WAT); bf16_t* WiT = (bf16_t*)(F.ws + WS_WIT);
      for (int r = F.gw; r < 128; r += F.NGW) { const int which = r >> 6, h = (r >> 4) & 3, kb = (r >> 2) & 3, nb = r & 3;
          p0_item((which ? p.in[I_WI] : p.in[I_WA]) + (size_t)h * 65536, 256, 64 * nb, (which ? WiT : WaT) + (size_t)h * 65536, 256, (size_t)64 * nb, 64 * kb, nullptr, F.lane); } }
    { bf16_t* WglT = (bf16_t*)(F.ws + WS_WGLT); const float* w_in = p.in[I_WIN];
      for (int idx = (int)blockIdx.x * 512 + F.tid; idx < 16 * DM; idx += F.G * 512) { const int cc = idx >> 11, k = idx & 2047; WglT[idx] = (bf16_t)f2bf(w_in[(size_t)k * INC + 3072 + cc]); } }
    { float* WrT = (float*)(F.ws + WS_WRT); const float* wr = p.in[I_WR]; const float* gf = p.in[I_NFG];
      for (int idx = (int)blockIdx.x * 512 + F.tid; idx < 32 * DM; idx += F.G * 512) { const int n = idx >> 11, k = idx & 2047; WrT[idx] = wr[k * 32 + n] * gf[k]; } }
}
__device__ __forceinline__ void p0b(Frame& F, const Params& p) {
    const float* x = p.in[I_X]; const float* g1 = p.in[I_NMG]; bf16_t* H = (bf16_t*)(F.ws + WS_H);
    const int l = F.lane;
    f32x4 gv[8], xn[8];
#pragma unroll
    for (int j = 0; j < 4; ++j) { gv[2 * j] = *(const f32x4*)(g1 + 8 * l + 512 * j); gv[2 * j + 1] = *(const f32x4*)(g1 + 8 * l + 512 * j + 4); }
#pragma unroll
    for (int j = 0; j < 4; ++j) { xn[2 * j] = (F.gw < T) ? *(const f32x4*)(x + (size_t)F.gw * DM + 8 * l + 512 * j) : (f32x4){0.f, 0.f, 0.f, 0.f}; xn[2 * j + 1] = (F.gw < T) ? *(const f32x4*)(x + (size_t)F.gw * DM + 8 * l + 512 * j + 4) : (f32x4){0.f, 0.f, 0.f, 0.f}; }
    for (int m = F.gw; m < T; m += F.NGW) {
        f32x4 xv[8]; float ss = 0.f;
#pragma unroll
        for (int j = 0; j < 8; ++j) { xv[j] = xn[j]; ss += (xv[j][0] * xv[j][0] + xv[j][1] * xv[j][1]) + (xv[j][2] * xv[j][2] + xv[j][3] * xv[j][3]); }
        if (m + F.NGW < T) {
#pragma unroll
            for (int j = 0; j < 4; ++j) { xn[2 * j] = *(const f32x4*)(x + (size_t)(m + F.NGW) * DM + 8 * l + 512 * j); xn[2 * j + 1] = *(const f32x4*)(x + (size_t)(m + F.NGW) * DM + 8 * l + 512 * j + 4); } }
        const float rs = rsqrtf_(wave_sum(ss) * (1.0f / DM) + 1e-6f);
#pragma unroll
        for (int j = 0; j < 4; ++j) { const f32x4 a = xv[2 * j] * rs * gv[2 * j], b = xv[2 * j + 1] * rs * gv[2 * j + 1];
            u32x4 o; o.x = pk2(a[0], a[1]); o.y = pk2(a[2], a[3]); o.z = pk2(b[0], b[1]); o.w = pk2(b[2], b[3]);
            *(u32x4*)(H + (size_t)m * DM + 8 * l + 512 * j) = o;
#ifdef SIM_FP8
            o.x = PK2A(a[0], a[1]); o.y = PK2A(a[2], a[3]); o.z = PK2A(b[0], b[1]); o.w = PK2A(b[2], b[3]); *(u32x4*)((bf16_t*)(F.ws + WS_MIX) + (size_t)m * DM + 8 * l + 512 * j) = o;
#endif
            }
    }
}

__device__ __forceinline__ void gla_cumsum(const LAS float* GL, const float* wg, const float* bgp, int h, LAS float* BC, LAS float* SEG, int tid) {
    const int seg = tid >> 7, kk = tid & 127;
    float wcol[16];
#pragma unroll
    for (int c = 0; c < 16; ++c) wcol[c] = wg[c * 512 + h * 128 + kk];
    const float bcol = bgp[h * 128 + kk];
    float v[16];
#pragma unroll
    for (int i = 0; i < 16; ++i) { const LAS f32x4* g4 = (const LAS f32x4*)(GL + (16 * seg + i) * 16); float sacc = bcol;
#pragma unroll
        for (int c4 = 0; c4 < 4; ++c4) { const f32x4 gq = g4[c4]; sacc += gq[0] * wcol[4 * c4] + gq[1] * wcol[4 * c4 + 1] + gq[2] * wcol[4 * c4 + 2] + gq[3] * wcol[4 * c4 + 3]; }
        v[i] = log_sigmoid_f(sacc) * 0.0625f; }
#pragma unroll
    for (int i = 1; i < 16; ++i) v[i] += v[i - 1];
    SEG[seg * 128 + kk] = v[15];
    __syncthreads();
    float off = 0.f;
#pragma unroll
    for (int s = 0; s < 3; ++s) off += (s < seg) ? SEG[s * 128 + kk] : 0.f;
#pragma unroll
    for (int i = 0; i < 16; ++i) BC[(16 * seg + i) * 128 + kk] = v[i] + off;
    __syncthreads();
}
__device__ __forceinline__ bf16x8 as_bf16x8(u32x4 v) { return __builtin_bit_cast(bf16x8, v); }
__device__ __forceinline__ bf16x8 cat4(bf16x4 lo, bf16x4 hi) { return __builtin_shufflevector(lo, hi, 0, 1, 2, 3, 4, 5, 6, 7); }

__device__ __forceinline__ void p2a(Frame& F, const Params& p) {
    const bf16_t* Z = (const bf16_t*)(F.ws + WS_Z);
    bf16_t* AN = (bf16_t*)(F.ws + WS_AN); float* DN = (float*)(F.ws + WS_DN);
    const bf16_t* WaT = (const bf16_t*)(F.ws + WS_WAT); const bf16_t* WiT = (const bf16_t*)(F.ws + WS_WIT);
    LAS float* BC = (LAS float*)(F.lds); LAS float* SEG = (LAS float*)(F.lds + 32768);
    LAS bf16_t* KDT = (LAS bf16_t*)(F.lds + 34816); LAS bf16_t* VT = (LAS bf16_t*)(F.lds + 53248); LAS bf16_t* XC = (LAS bf16_t*)(F.lds + 90112);
    const int w = F.wave;
    LAS float* GLR = (LAS float*)(F.lds + 90112);
    LAS float* GL = (LAS float*)(F.lds + 124928);
    const float* wg = p.in[I_GWG]; const float* bgp = p.in[I_GBG];
    for (int unit = blockIdx.x; unit < NCHUNK; unit += F.G) {
        const int b = unit >> 7, n = unit & 127, tok0 = b * SEQL + 64 * n;
        {
            const int lane = fresh_lane(), r16 = lane & 15, q4 = lane >> 4;
            const bf16_t* Hb = (const bf16_t*)(F.ws + WS_H) + (size_t)(tok0 + r16) * DM + 256 * w + 8 * q4;
            const bf16_t* Wb = (const bf16_t*)(F.ws + WS_WGLT) + (size_t)r16 * DM + 256 * w + 8 * q4;
            f32x4 gacc[4];
#pragma unroll
            for (int mb = 0; mb < 4; ++mb) gacc[mb] = (f32x4){0.f, 0.f, 0.f, 0.f};
#pragma unroll
            for (int sb = 0; sb < 2; ++sb) { bf16x8 af[4][4], bfr[4];
#pragma unroll
                for (int s4 = 0; s4 < 4; ++s4) { bfr[s4] = *(const bf16x8*)(Wb + 32 * (4 * sb + s4));
#pragma unroll
                    for (int mb = 0; mb < 4; ++mb) af[s4][mb] = *(const bf16x8*)(Hb + (size_t)(16 * mb) * DM + 32 * (4 * sb + s4)); }
#pragma unroll
                for (int s4 = 0; s4 < 4; ++s4)
#pragma unroll
                    for (int mb = 0; mb < 4; ++mb) gacc[mb] = __builtin_amdgcn_mfma_f32_16x16x32_bf16(af[s4][mb], bfr[s4], gacc[mb], 0, 0, 0); }
#pragma unroll
            for (int mb = 0; mb < 4; ++mb)
#pragma unroll
                for (int q = 0; q < 4; ++q) GLR[(w * 64 + 16 * mb + 4 * q4 + q) * 16 + r16] = gacc[mb][q];
            __syncthreads();
            const int tid2 = w * 64 + lane;
#pragma unroll
            for (int it = 0; it < 2; ++it) { const int o = tid2 + 512 * it; float sacc = 0.f;
#pragma unroll
                for (int w2 = 0; w2 < 8; ++w2) sacc += GLR[w2 * 1024 + o];
                GL[o] = sacc; ((float*)(F.ws + WS_LG))[(size_t)tok0 * 16 + o] = sacc; }
            __syncthreads();
        }
        for (int h = 0; h < 4; ++h) {
            int lane = fresh_lane(), tid = F.wave * 64 + lane;
            int r = lane & 31, hh = lane >> 5;
            u32x4 kvr[2], vvr[4];
#pragma unroll
            for (int it = 0; it < 2; ++it) { const int item = tid + 512 * it, t = item & 63, kk8 = item >> 6; kvr[it] = *(const u32x4*)(Z + (size_t)(tok0 + t) * ZC + ZK + h * 128 + kk8 * 8); }
#pragma unroll
            for (int it = 0; it < 4; ++it) { const int item = tid + 512 * it, t = item & 63, vc8 = item >> 6; vvr[it] = *(const u32x4*)(Z + (size_t)(tok0 + t) * ZC + ZV + h * 256 + vc8 * 8); }
            gla_cumsum(GL, wg, bgp, h, BC, SEG, tid);
            const int uh = (b * 4 + h) * 128 + n;
            if (tid < 128) DN[(size_t)uh * 128 + tid] = __expf(BC[63 * 128 + tid]);
#pragma unroll
            for (int it = 0; it < 2; ++it) { const int item = tid + 512 * it, t = item & 63, kk8 = item >> 6;
                const u32x4 kv = kvr[it];
#pragma unroll
                for (int i = 0; i < 8; ++i) { const int kk = kk8 * 8 + i; const unsigned wv = kv[i >> 1]; const float kf = (i & 1) ? bfhi(wv) : bflo(wv);
                    const float d = __expf(BC[63 * 128 + kk] - BC[t * 128 + kk]); KDT[kk * 72 + t] = (bf16_t)f2bf(kf * d); } }
#pragma unroll
            for (int it = 0; it < 4; ++it) { const int item = tid + 512 * it, t = item & 63, vc8 = item >> 6;
                const u32x4 vv = vvr[it];
#pragma unroll
                for (int i = 0; i < 8; ++i) { const unsigned wv = vv[i >> 1]; VT[(vc8 * 8 + i) * 72 + t] = (bf16_t)((i & 1) ? (wv >> 16) : (wv & 0xffffu)); } }
#ifndef P2A_NO_LRU
            u32x4 lv[7]; f32x4 cwv[4][2], cbv[2];
            { const float* cw = p.in[I_CW]; const float* cb = p.in[I_CB]; const int c8 = tid & 31, tq = tid >> 5, chc = h * 256 + c8 * 8;
#pragma unroll
              for (int i = 0; i < 7; ++i) { const int sq = 64 * n + 4 * tq - 3 + i;
                  lv[i] = (sq >= 0) ? *(const u32x4*)(Z + (size_t)(tok0 + 4 * tq - 3 + i) * ZC + ZLX + chc) : (u32x4){0u, 0u, 0u, 0u}; }
#pragma unroll
              for (int i = 0; i < 4; ++i) { cwv[i][0] = *(const f32x4*)(cw + i * 1024 + chc); cwv[i][1] = *(const f32x4*)(cw + i * 1024 + chc + 4); }
              cbv[0] = *(const f32x4*)(cb + chc); cbv[1] = *(const f32x4*)(cb + chc + 4); }
#endif
            __syncthreads();
            {
                f32x16 acc[4];
#pragma unroll
                for (int mb = 0; mb < 4; ++mb)
#pragma unroll
                    for (int q = 0; q < 16; ++q) acc[mb][q] = 0.f;
#pragma unroll
                for (int s = 0; s < 4; ++s) { const bf16x8 bfr = *(const LAS bf16x8*)(VT + (32 * w + r) * 72 + 16 * s + 8 * hh);
#pragma unroll
                    for (int mb = 0; mb < 4; ++mb) { const bf16x8 afr = *(const LAS bf16x8*)(KDT + (32 * mb + r) * 72 + 16 * s + 8 * hh);
                        acc[mb] = __builtin_amdgcn_mfma_f32_32x32x16_bf16(afr, bfr, acc[mb], 0, 0, 0); } }
                bf16_t* base = AN + (size_t)uh * 32768;
#pragma unroll
                for (int mb = 0; mb < 4; ++mb)
#pragma unroll
                    for (int s2 = 0; s2 < 2; ++s2) { u32x4 o;
#pragma unroll
                        for (int q = 0; q < 4; ++q) o[q] = pk2(acc[mb][8 * s2 + 2 * q], acc[mb][8 * s2 + 2 * q + 1]);
                        *(u32x4*)(base + (((mb * 8 + w) * 2 + s2) * 64 + lane) * 8) = o; }
            }
#ifndef P2A_NO_LRU
            {
                {
                    const int c8 = tid & 31, tq = tid >> 5;
#pragma unroll
                    for (int it = 0; it < 4; ++it) { float xc[8];
#pragma unroll
                        for (int q = 0; q < 4; ++q) { xc[q] = cbv[0][q]; xc[4 + q] = cbv[1][q]; }
#pragma unroll
                        for (int i = 0; i < 4; ++i) { const u32x4 l4 = lv[it + i];
                            xc[0] += bflo(l4[0]) * cwv[i][0][0]; xc[1] += bfhi(l4[0]) * cwv[i][0][1]; xc[2] += bflo(l4[1]) * cwv[i][0][2]; xc[3] += bfhi(l4[1]) * cwv[i][0][3];
                            xc[4] += bflo(l4[2]) * cwv[i][1][0]; xc[5] += bfhi(l4[2]) * cwv[i][1][1]; xc[6] += bflo(l4[3]) * cwv[i][1][2]; xc[7] += bfhi(l4[3]) * cwv[i][1][3]; }
                        u32x4 o; o.x = pk2(xc[0], xc[1]); o.y = pk2(xc[2], xc[3]); o.z = pk2(xc[4], xc[5]); o.w = pk2(xc[6], xc[7]);
                        *(LAS u32x4*)(XC + (4 * tq + it) * 264 + c8 * 8) = o; }
                }
                __builtin_amdgcn_sched_barrier(0);
                bf16x8 ba[16], bi[16];
                { const bf16_t* wa = WaT + (size_t)h * 65536 + (size_t)(32 * w + r) * 256 + 8 * hh;
                  const bf16_t* wi = WiT + (size_t)h * 65536 + (size_t)(32 * w + r) * 256 + 8 * hh;
#pragma unroll
                  for (int s = 0; s < 16; ++s) { ba[s] = *(const bf16x8*)(wa + 16 * s); bi[s] = *(const bf16x8*)(wi + 16 * s); } }
                __syncthreads();
                f32x16 aa[2], ai[2];
#pragma unroll
                for (int mb = 0; mb < 2; ++mb)
#pragma unroll
                    for (int q = 0; q < 16; ++q) { aa[mb][q] = 0.f; ai[mb][q] = 0.f; }
#pragma unroll
                for (int s = 0; s < 16; ++s) {
#pragma unroll
                    for (int mb = 0; mb < 2; ++mb) { const bf16x8 af = *(const LAS bf16x8*)(XC + (32 * mb + r) * 264 + 16 * s + 8 * hh);
                        aa[mb] = __builtin_amdgcn_mfma_f32_32x32x16_bf16(af, ba[s], aa[mb], 0, 0, 0); } }
                __builtin_amdgcn_sched_barrier(0);
#pragma unroll
                for (int s = 0; s < 16; ++s) {
#pragma unroll
                    for (int mb = 0; mb < 2; ++mb) { const bf16x8 af = *(const LAS bf16x8*)(XC + (32 * mb + r) * 264 + 16 * s + 8 * hh);
                        ai[mb] = __builtin_amdgcn_mfma_f32_32x32x16_bf16(af, bi[s], ai[mb], 0, 0, 0); } }
                const int ch = h * 256 + 32 * w + r;
                const float ba_ = p.in[I_BA][ch], bi_ = p.in[I_BI][ch]; const float L = p.in[I_AP][ch];
                const float sp = fmaxf(-L, 0.f) + log1pf(__expf(-fabsf(L)));
#pragma unroll
                for (int mb = 0; mb < 2; ++mb)
#pragma unroll
                    for (int q = 0; q < 16; ++q) { const int t = 32 * mb + (q & 3) + 8 * (q >> 2) + 4 * hh;
                        if ((q & 3) == 0) __builtin_amdgcn_sched_barrier(0);
                        const float ga = sigmoidf_(aa[mb][q] + ba_), gi = sigmoidf_(ai[mb][q] + bi_);
                        const float la = -8.0f * ga * sp; const float a = __expf(la);
                        const float xcv = bf2f(XC[t * 264 + 32 * w + r]);
                        aa[mb][q] = a; ai[mb][q] = xcv * gi * __builtin_amdgcn_sqrtf(fmaxf(1.0f - a * a, 0.f)); }
#pragma unroll
                for (int mb = 0; mb < 2; ++mb)
#pragma unroll
                    for (int g = 0; g < 4; ++g)
#pragma unroll
                        for (int i = 1; i < 4; ++i) { const int q = 4 * g + i; ai[mb][q] = aa[mb][q] * ai[mb][q - 1] + ai[mb][q]; aa[mb][q] = aa[mb][q] * aa[mb][q - 1]; }
                LAS bf16_t* HL = (LAS bf16_t*)(F.lds); LAS bf16_t* AC = (LAS bf16_t*)(F.lds + 34816);
                float carryH = 0.f, carryP = 1.f;
#pragma unroll
                for (int mb = 0; mb < 2; ++mb)
#pragma unroll
                    for (int g = 0; g < 4; ++g) { const float myP = aa[mb][4 * g + 3], myH = ai[mb][4 * g + 3];
                        const float pP = __shfl_xor(myP, 32), pH = __shfl_xor(myH, 32);
                        const float fP = hh ? pP : myP, fH = hh ? pH : myH, sP = hh ? myP : pP, sH = hh ? myH : pH;
                        const float c1H = fP * carryH + fH, c1P = carryP * fP;
                        const float Cin = hh ? c1H : carryH, Pin = hh ? c1P : carryP;
                        carryH = sP * c1H + sH; carryP = c1P * sP;
#pragma unroll
                        for (int i = 0; i < 4; ++i) { const int q = 4 * g + i, t = 32 * mb + 8 * g + 4 * hh + i;
                            HL[t * 264 + 32 * w + r] = (bf16_t)f2bf(ai[mb][q] + aa[mb][q] * Cin); AC[t * 264 + 32 * w + r] = (bf16_t)f2bf(aa[mb][q] * Pin); } }
                if (hh == 0) { float* SUMA = (float*)(F.ws + WS_SUMA); float* SUMH = (float*)(F.ws + WS_SUMH); SUMA[unit * 1024 + ch] = carryP; SUMH[unit * 1024 + ch] = carryH; }
                __syncthreads();
                { bf16_t* HLOC = (bf16_t*)(F.ws + WS_AUA); bf16_t* ACUM = (bf16_t*)(F.ws + WS_AUU);
#pragma unroll
                  for (int it = 0; it < 4; ++it) { const int item = tid + 512 * it, c8 = item & 31, t = item >> 5; const size_t o = (size_t)(tok0 + t) * 1024 + h * 256 + c8 * 8;
                      *(u32x4*)(HLOC + o) = *(const LAS u32x4*)(HL + t * 264 + c8 * 8); *(u32x4*)(ACUM + o) = *(const LAS u32x4*)(AC + t * 264 + c8 * 8); } }
            }
#endif
            __syncthreads();
        }
    }
}

__device__ __forceinline__ void p2b(Frame& F, const Params& p) {
    const bf16_t* AN = (const bf16_t*)(F.ws + WS_AN); const float* DN = (const float*)(F.ws + WS_DN); bf16_t* SP = (bf16_t*)(F.ws + WS_SP);
    if (F.tid < 128) {
        for (int st = (int)blockIdx.x * 128 + F.tid; st < 32768; st += F.G * 128) {
            const int bh = st >> 12, rem = st & 4095, ln = rem & 63, s2 = (rem >> 6) & 1, w = (rem >> 7) & 7, mb = (rem >> 10) & 3;
            const int kk0 = 32 * mb + 16 * s2 + 4 * (ln >> 5);
            const int offS = (((mb * 8 + w) * 2 + s2) * 64 + ln) * 8;
            f32x4 S0 = (f32x4){0.f, 0.f, 0.f, 0.f}, S1 = S0;
            for (int n0 = 0; n0 < 128; n0 += 8) {
                u32x4 av[8]; f32x4 d0[8], d1[8];
#pragma unroll
                for (int i = 0; i < 8; ++i) { const size_t uh = (size_t)bh * 128 + n0 + i;
                    av[i] = *(const u32x4*)(AN + uh * 32768 + offS);
                    d0[i] = *(const f32x4*)(DN + uh * 128 + kk0); d1[i] = *(const f32x4*)(DN + uh * 128 + kk0 + 8); }
#pragma unroll
                for (int i = 0; i < 8; ++i) { const size_t uh = (size_t)bh * 128 + n0 + i;
                    u32x4 o; o.x = pk2(S0[0], S0[1]); o.y = pk2(S0[2], S0[3]); o.z = pk2(S1[0], S1[1]); o.w = pk2(S1[2], S1[3]);
                    *(u32x4*)(SP + uh * 32768 + offS) = o;
                    const f32x4 a0 = (f32x4){bflo(av[i].x), bfhi(av[i].x), bflo(av[i].y), bfhi(av[i].y)}, a1 = (f32x4){bflo(av[i].z), bfhi(av[i].z), bflo(av[i].w), bfhi(av[i].w)};
                    S0 = d0[i] * S0 + a0; S1 = d1[i] * S1 + a1; } }
        }
    } else if (F.wave == 2) {
        const float* SUMA = (const float*)(F.ws + WS_SUMA); float* SUMH = (float*)(F.ws + WS_SUMH);
        for (int wv = (int)blockIdx.x; wv < 64; wv += F.G) {
            const int seg = F.lane >> 4, sid = wv * 16 + (F.lane & 15), b = sid >> 9, ch = 2 * (sid & 511);
            const size_t o0 = (size_t)(b * 128 + seg * 32) * 1024 + ch;
            f32x2 a[32], hv[32];
#pragma unroll
            for (int q = 0; q < 32; ++q) { a[q] = *(const f32x2*)(SUMA + o0 + (size_t)q * 1024); hv[q] = *(const f32x2*)(SUMH + o0 + (size_t)q * 1024); }
            f32x2 A = (f32x2){1.f, 1.f}, H = (f32x2){0.f, 0.f};
#pragma unroll
            for (int q = 0; q < 32; ++q) { H = a[q] * H + hv[q]; A = a[q] * A; }
            f32x2 hc = (f32x2){0.f, 0.f};
#pragma unroll
            for (int k = 0; k < 3; ++k) { const int src = k * 16 + (F.lane & 15);
                const f32x2 Ak = (f32x2){__shfl(A.x, src), __shfl(A.y, src)}, Hk = (f32x2){__shfl(H.x, src), __shfl(H.y, src)};
                if (k < seg) hc = Ak * hc + Hk; }
#pragma unroll
            for (int q = 0; q < 32; ++q) { *(f32x2*)(SUMH + o0 + (size_t)q * 1024) = hc; hc = a[q] * hc + hv[q]; }
        }
    }
}

__device__ __forceinline__ void p2c(Frame& F, const Params& p) {
    const bf16_t* Z = (const bf16_t*)(F.ws + WS_Z); const float* GLOW = (const float*)(F.ws + WS_LG); const bf16_t* SP = (const bf16_t*)(F.ws + WS_SP);
    LAS float* GL = (LAS float*)(F.lds + 124928); const float* wg = p.in[I_GWG]; const float* bgp = p.in[I_GBG];
    bf16_t* MIX = (bf16_t*)(F.ws + WS_MIX);
    LAS float* BC = (LAS float*)(F.lds); LAS float* SEG = (LAS float*)(F.lds + 32768);
    LAS bf16_t* QE = (LAS bf16_t*)(F.lds + 34816); LAS bf16_t* KE = (LAS bf16_t*)(F.lds + 52224); LAS bf16_t* VT = (LAS bf16_t*)(F.lds + 69632);
    LAS float* SSQ = (LAS float*)(F.lds + 106496); LAS float* OS = (LAS float*)(F.lds);
    const int w = F.wave;
    const float* gng = p.in[I_GNG];
    for (int unit = blockIdx.x; unit < NCHUNK; unit += F.G) {
        const int b = unit >> 7, n = unit & 127, tok0 = b * SEQL + 64 * n;
        const int lane = fresh_lane(), tid = w * 64 + lane, r = lane & 31, hh = lane >> 5;
        { const float* SUMH = (const float*)(F.ws + WS_SUMH);
          const int ch = 2 * tid; const f32x2 hc = *(const f32x2*)(SUMH + (size_t)unit * 1024 + ch);
          const bf16_t* HLOC = (const bf16_t*)(F.ws + WS_AUA); const bf16_t* ACUM = (const bf16_t*)(F.ws + WS_AUU);
          for (int t0 = 0; t0 < 64; t0 += 16) {
              unsigned hv[16], av[16], lgw[16];
#pragma unroll
              for (int i = 0; i < 16; ++i) { const size_t tok = (size_t)tok0 + t0 + i;
                  hv[i] = *(const unsigned*)(HLOC + tok * 1024 + ch); av[i] = *(const unsigned*)(ACUM + tok * 1024 + ch); lgw[i] = *(const unsigned*)(Z + tok * ZC + ZLG + ch); }
#pragma unroll
              for (int i = 0; i < 16; ++i) { const size_t tok = (size_t)tok0 + t0 + i;
                  const float h0 = bflo(hv[i]) + bflo(av[i]) * hc.x, h1 = bfhi(hv[i]) + bfhi(av[i]) * hc.y;
                  *(unsigned*)(MIX + tok * DM + 1024 + ch) = pk2(h0 * gelu_tanh_f(bflo(lgw[i])), h1 * gelu_tanh_f(bfhi(lgw[i]))); } } }
        { const f32x2 gq = *(const f32x2*)(GLOW + (size_t)tok0 * 16 + 2 * tid); *(LAS f32x2*)(GL + 2 * tid) = gq; }
        __syncthreads();
        for (int h = 0; h < 4; ++h) {
            const int uh = (b * 4 + h) * 128 + n;
            u32x4 qvr[2], kvr[2], vvr[4];
#pragma unroll
            for (int it = 0; it < 2; ++it) { const int item = tid + 512 * it, kk8 = item & 15, t = item >> 4;
                qvr[it] = *(const u32x4*)(Z + (size_t)(tok0 + t) * ZC + ZQ + h * 128 + kk8 * 8); kvr[it] = *(const u32x4*)(Z + (size_t)(tok0 + t) * ZC + ZK + h * 128 + kk8 * 8); }
#pragma unroll
            for (int it = 0; it < 4; ++it) { const int item = tid + 512 * it, t = item & 63, vc8 = item >> 6; vvr[it] = *(const u32x4*)(Z + (size_t)(tok0 + t) * ZC + ZV + h * 256 + vc8 * 8); }
            gla_cumsum(GL, wg, bgp, h, BC, SEG, tid);
            bf16x8 sf[4][2];
            { const bf16_t* spu = SP + (size_t)uh * 32768;
#pragma unroll
              for (int mb = 0; mb < 4; ++mb)
#pragma unroll
                  for (int s2 = 0; s2 < 2; ++s2) sf[mb][s2] = *(const bf16x8*)(spu + (((mb * 8 + w) * 2 + s2) * 64 + lane) * 8); }
#pragma unroll
            for (int it = 0; it < 2; ++it) { const int item = tid + 512 * it, kk8 = item & 15, t = item >> 4;
                const u32x4 qv = qvr[it];
                const u32x4 kv = kvr[it];
                const f32x4 b0 = *(const LAS f32x4*)(BC + t * 128 + kk8 * 8), b1 = *(const LAS f32x4*)(BC + t * 128 + kk8 * 8 + 4);
                float qe[8], ke[8];
#pragma unroll
                for (int i = 0; i < 8; ++i) { const float bb = (i < 4) ? b0[i & 3] : b1[i & 3]; const unsigned qw = qv[i >> 1], kw = kv[i >> 1];
                    const float qf = (i & 1) ? bfhi(qw) : bflo(qw), kf = (i & 1) ? bfhi(kw) : bflo(kw);
                    qe[i] = qf * 0.08838834764831845f * __expf(bb); ke[i] = kf * __expf(-bb); }
                u32x4 oq, ok; oq.x = pk2(qe[0], qe[1]); oq.y = pk2(qe[2], qe[3]); oq.z = pk2(qe[4], qe[5]); oq.w = pk2(qe[6], qe[7]);
                ok.x = pk2(ke[0], ke[1]); ok.y = pk2(ke[2], ke[3]); ok.z = pk2(ke[4], ke[5]); ok.w = pk2(ke[6], ke[7]);
                *(LAS u32x4*)(QE + t * 136 + kk8 * 8) = oq; *(LAS u32x4*)(KE + t * 136 + kk8 * 8) = ok; }
#pragma unroll
            for (int it = 0; it < 4; ++it) { const int item = tid + 512 * it, t = item & 63, vc8 = item >> 6;
                const u32x4 vv = vvr[it];
#pragma unroll
                for (int i = 0; i < 8; ++i) { const unsigned wv = vv[i >> 1]; VT[(vc8 * 8 + i) * 72 + t] = (bf16_t)((i & 1) ? (wv >> 16) : (wv & 0xffffu)); } }
            __syncthreads();
            f32x16 oacc[2];
            {
                f32x16 P00, P01, P11;
#pragma unroll
                for (int q = 0; q < 16; ++q) { P00[q] = 0.f; P01[q] = 0.f; P11[q] = 0.f; oacc[0][q] = 0.f; oacc[1][q] = 0.f; }
#pragma unroll
                for (int s = 0; s < 8; ++s) {
                    const bf16x8 a0 = *(const LAS bf16x8*)(KE + r * 136 + 16 * s + 8 * hh), a1 = *(const LAS bf16x8*)(KE + (32 + r) * 136 + 16 * s + 8 * hh);
                    const bf16x8 b0 = *(const LAS bf16x8*)(QE + r * 136 + 16 * s + 8 * hh), b1 = *(const LAS bf16x8*)(QE + (32 + r) * 136 + 16 * s + 8 * hh);
                    P00 = __builtin_amdgcn_mfma_f32_32x32x16_bf16(a0, b0, P00, 0, 0, 0);
                    P01 = __builtin_amdgcn_mfma_f32_32x32x16_bf16(a0, b1, P01, 0, 0, 0);
                    P11 = __builtin_amdgcn_mfma_f32_32x32x16_bf16(a1, b1, P11, 0, 0, 0); }
#pragma unroll
                for (int q = 0; q < 16; ++q) { const int jl = (q & 3) + 8 * (q >> 2) + 4 * hh; if (jl > r) { P00[q] = 0.f; P11[q] = 0.f; } }
                bf16x8 F00[2], F01[2], F11[2];
#pragma unroll
                for (int s2 = 0; s2 < 2; ++s2) {
                    u32x4 t0, t1, t2;
#pragma unroll
                    for (int q = 0; q < 4; ++q) { t0[q] = pk2(P00[8 * s2 + 2 * q], P00[8 * s2 + 2 * q + 1]); t1[q] = pk2(P01[8 * s2 + 2 * q], P01[8 * s2 + 2 * q + 1]); t2[q] = pk2(P11[8 * s2 + 2 * q], P11[8 * s2 + 2 * q + 1]); }
                    F00[s2] = as_bf16x8(t0); F01[s2] = as_bf16x8(t1); F11[s2] = as_bf16x8(t2); }
#pragma unroll
                for (int mb = 0; mb < 4; ++mb)
#pragma unroll
                    for (int s2 = 0; s2 < 2; ++s2) { const bf16x8 af = sf[mb][s2];
                        const int kkb = 32 * mb + 16 * s2 + 4 * hh;
#pragma unroll
                        for (int ib = 0; ib < 2; ++ib) { const bf16x4 lo = *(const LAS bf16x4*)(QE + (32 * ib + r) * 136 + kkb), hi = *(const LAS bf16x4*)(QE + (32 * ib + r) * 136 + kkb + 8);
                            oacc[ib] = __builtin_amdgcn_mfma_f32_32x32x16_bf16(af, cat4(lo, hi), oacc[ib], 0, 0, 0); } }
#pragma unroll
                for (int s2 = 0; s2 < 2; ++s2) {
                    const int tb0 = 16 * s2 + 4 * hh, tb1 = 32 + 16 * s2 + 4 * hh;
                    const bf16x8 v0 = cat4(*(const LAS bf16x4*)(VT + (32 * w + r) * 72 + tb0), *(const LAS bf16x4*)(VT + (32 * w + r) * 72 + tb0 + 8));
                    const bf16x8 v1 = cat4(*(const LAS bf16x4*)(VT + (32 * w + r) * 72 + tb1), *(const LAS bf16x4*)(VT + (32 * w + r) * 72 + tb1 + 8));
                    oacc[0] = __builtin_amdgcn_mfma_f32_32x32x16_bf16(v0, F00[s2], oacc[0], 0, 0, 0);
                    oacc[1] = __builtin_amdgcn_mfma_f32_32x32x16_bf16(v0, F01[s2], oacc[1], 0, 0, 0);
                    oacc[1] = __builtin_amdgcn_mfma_f32_32x32x16_bf16(v1, F11[s2], oacc[1], 0, 0, 0); }
            }
#pragma unroll
            for (int ib = 0; ib < 2; ++ib) { float sq = 0.f;
#pragma unroll
                for (int q = 0; q < 16; ++q) sq += oacc[ib][q] * oacc[ib][q];
                sq += __shfl_xor(sq, 32);
                if (hh == 0) SSQ[w * 64 + 32 * ib + r] = sq; }
            __syncthreads();
#pragma unroll
            for (int ib = 0; ib < 2; ++ib) { float tot = 0.f;
#pragma unroll
                for (int w2 = 0; w2 < 8; ++w2) tot += SSQ[w2 * 64 + 32 * ib + r];
                const float rs = rsqrtf_(tot * (1.0f / 256.0f) + 1e-6f);
#pragma unroll
                for (int g = 0; g < 4; ++g) *(LAS f32x4*)(OS + (32 * ib + r) * 260 + 32 * w + 8 * g + 4 * hh) =
                    (f32x4){oacc[ib][4 * g] * rs, oacc[ib][4 * g + 1] * rs, oacc[ib][4 * g + 2] * rs, oacc[ib][4 * g + 3] * rs}; }
            __syncthreads();
#pragma unroll
            for (int it = 0; it < 4; ++it) { const int item = tid + 512 * it, vc8 = item & 31, t = item >> 5; const int c = h * 256 + vc8 * 8;
                const f32x4 o0 = *(const LAS f32x4*)(OS + t * 260 + vc8 * 8), o1 = *(const LAS f32x4*)(OS + t * 260 + vc8 * 8 + 4);
                const u32x4 rv = *(const u32x4*)(Z + (size_t)(tok0 + t) * ZC + ZR + c);
                const f32x4 g0 = *(const f32x4*)(gng + c), g1 = *(const f32x4*)(gng + c + 4);
                float o[8];
#pragma unroll
                for (int i = 0; i < 8; ++i) { const unsigned rw = rv[i >> 1]; const float rf = (i & 1) ? bfhi(rw) : bflo(rw);
                    const float sil = rf * sigmoidf_(rf); o[i] = sil * ((i < 4) ? o0[i & 3] * g0[i & 3] : o1[i & 3] * g1[i & 3]); }
                u32x4 ov; ov.x = pk2(o[0], o[1]); ov.y = pk2(o[2], o[3]); ov.z = pk2(o[4], o[5]); ov.w = pk2(o[6], o[7]);
                *(u32x4*)(MIX + (size_t)(tok0 + t) * DM + c) = ov; }
            __syncthreads();
        }
    }
}

__device__ __forceinline__ void build_moe_tables(Frame& F) {
    unsigned* cnt = (unsigned*)(F.ws + WS_CTL) + CW_CNT;
    if (F.tid < 32) F.MISC[MI_LCNT + F.tid] = xb_ld(cnt + 64 * F.tid);
    __syncthreads();
    if (F.tid == 0) { int tiles = 0;
        for (int e = 0; e < NEXP; ++e) { const int c = (int)F.MISC[MI_LCNT + e]; const int mt = (c + 255) >> 8; F.MISC[MI_PBASE + e] = (unsigned)(tiles * 256); F.MISC[MI_CNT + e] = (unsigned)c;
            for (int q = 0; q < mt; ++q) F.MISC[MI_T2E + tiles + q] = (unsigned)e; tiles += mt; }
        F.MISC[MI_NMT] = (unsigned)tiles; }
    __syncthreads();
    if (F.tid < 32) F.MISC[MI_LCNT + F.tid] = 0u;
    __syncthreads();
}

__device__ __forceinline__ void p4a(Frame& F, const Params& p) {
    const bf16_t* XMID = (const bf16_t*)(F.ws + WS_XMID); const float* WrT = (const float*)(F.ws + WS_WRT); const float* br = p.in[I_BR];
    float* RSTD = (float*)(F.ws + WS_RSTD); unsigned* TOKE = (unsigned*)(F.ws + WS_TOKE); float* GATES = (float*)(F.ws + WS_GATES);
    unsigned* cnt = (unsigned*)(F.ws + WS_CTL) + CW_CNT;
    unsigned char* HF8 = F.ws + WS_HF8; unsigned short* LIST = (unsigned short*)(F.ws + WS_LIST); const float* gf = p.in[I_NFG];
    LAS float* RED = (LAS float*)(F.lds); LAS float* SSQ2 = (LAS float*)(F.lds + 32768); LAS float* LGT = (LAS float*)(F.lds + 33792); LAS float* RS = (LAS float*)(F.lds + 38016);
    const int tid = F.tid, lane = F.lane, w = F.wave, m = lane & 31, kh = lane >> 5;
    if (tid < 32) F.MISC[MI_LCNT + tid] = 0u;
    __syncthreads();
    f32x4 bw[32];
    { const float* bp = WrT + (size_t)m * DM + 256 * w + 128 * kh;
#pragma unroll
      for (int c = 0; c < 32; ++c) bw[c] = *(const f32x4*)(bp + 4 * c); }
    LAS float* RSA = (LAS float*)(F.lds + 38400);
    int ui = 0;
    for (int ut = blockIdx.x; ut < T / 32; ut += F.G, ++ui) {
        const int m0 = 32 * ut; const int kw = 256 * w + 128 * kh;
        f32x16 acc;
#pragma unroll
        for (int q = 0; q < 16; ++q) acc[q] = 0.f;
        float ss = 0.f;
        const bf16_t* ap = XMID + (size_t)(m0 + m) * DM + kw;
        u32x4 ar[16];
#pragma unroll
        for (int c = 0; c < 16; ++c) ar[c] = *(const u32x4*)(ap + 8 * c);
#pragma unroll
        for (int c = 0; c < 16; ++c) { const u32x4 r0 = ar[c];
            const f32x4 a0 = (f32x4){bflo(r0.x), bfhi(r0.x), bflo(r0.y), bfhi(r0.y)}, a1 = (f32x4){bflo(r0.z), bfhi(r0.z), bflo(r0.w), bfhi(r0.w)};
#pragma unroll
            for (int i = 0; i < 4; ++i) { acc = __builtin_amdgcn_mfma_f32_32x32x2f32(a0[i], bw[2 * c][i], acc, 0, 0, 0); ss += a0[i] * a0[i]; }
#pragma unroll
            for (int i = 0; i < 4; ++i) { acc = __builtin_amdgcn_mfma_f32_32x32x2f32(a1[i], bw[2 * c + 1][i], acc, 0, 0, 0); ss += a1[i] * a1[i]; } }
        ss += __shfl_xor(ss, 32);
#pragma unroll
        for (int q = 0; q < 16; ++q) RED[(w * 16 + q) * 64 + lane] = acc[q];
        if (kh == 0) SSQ2[w * 32 + m] = ss;
        __syncthreads();
#pragma unroll
        for (int it = 0; it < 2; ++it) { const int o = tid + 512 * it, reg = o >> 6, ln = o & 63, nn = ln & 31, h2 = ln >> 5; const int mm = (reg & 3) + 8 * (reg >> 2) + 4 * h2;
            float v = 0.f, s2 = 0.f;
#pragma unroll
            for (int w2 = 0; w2 < 8; ++w2) { v += RED[(w2 * 16 + reg) * 64 + ln]; s2 += SSQ2[w2 * 32 + mm]; }
            const float rs = rsqrtf_(s2 * (1.0f / DM) + 1e-6f);
            LGT[mm * 33 + nn] = v * rs + br[nn]; if (nn == 0) { RS[mm] = rs; RSA[32 * ui + mm] = rs; } }
        __syncthreads();
        int ex[4]; unsigned ls[4]; float gt[4];
        if (tid < 32) {
            float l[32];
#pragma unroll
            for (int i = 0; i < 32; ++i) l[i] = LGT[tid * 33 + i];
            float val[4];
#pragma unroll
            for (int k = 0; k < 4; ++k) { float best = -3.0e38f; int bi = 0;
#pragma unroll
                for (int i = 0; i < 32; ++i) if (l[i] > best) { best = l[i]; bi = i; }
                ex[k] = bi; val[k] = best;
#pragma unroll
                for (int i = 0; i < 32; ++i) if (i == bi) l[i] = -3.0e38f; }
            float s = 0.f;
#pragma unroll
            for (int k = 0; k < 4; ++k) { gt[k] = __expf(val[k] - val[0]); s += gt[k]; }
            const float inv = __builtin_amdgcn_rcpf(s);
#pragma unroll
            for (int k = 0; k < 4; ++k) { gt[k] *= inv; ls[k] = __hip_atomic_fetch_add((LAS unsigned*)(F.MISC + MI_LCNT + ex[k]), 1u, __ATOMIC_RELAXED, __HIP_MEMORY_SCOPE_WORKGROUP); }
        }
        __syncthreads();
        if (tid < 32) { const unsigned c = F.MISC[MI_LCNT + tid]; F.MISC[MI_LBASE + tid] = c ? xb_add(cnt + 64 * tid, c) : 0u; F.MISC[MI_LCNT + tid] = 0u; }
        __syncthreads();
        if (tid < 32) { const int tok = m0 + tid;
#pragma unroll
            for (int k = 0; k < 4; ++k) { const unsigned slot = F.MISC[MI_LBASE + ex[k]] + ls[k]; TOKE[tok * 4 + k] = (unsigned)ex[k] | (slot << 8); GATES[tok * 4 + k] = gt[k]; LIST[(size_t)ex[k] * 16384 + (slot & ~255u) + ((slot & 63u) << 2) + ((slot >> 6) & 3u)] = (unsigned short)tok; }
            RSTD[tok] = RS[tid]; }
        __syncthreads();
    }
    { const int ntok = 32 * ui; const int l = lane;
      f32x4 gv[8];
#pragma unroll
      for (int j = 0; j < 4; ++j) { gv[2 * j] = *(const f32x4*)(gf + 8 * l + 512 * j) * 16.0f; gv[2 * j + 1] = *(const f32x4*)(gf + 8 * l + 512 * j + 4) * 16.0f; }
      u32x4 xn[4];
      int jt = w;
      if (jt < ntok) { const size_t tk = (size_t)32 * (blockIdx.x + (jt >> 5) * F.G) + (jt & 31);
#pragma unroll
          for (int j = 0; j < 4; ++j) xn[j] = *(const u32x4*)(XMID + tk * DM + 8 * l + 512 * j); }
      for (; jt < ntok; jt += 8) {
          const size_t tk = (size_t)32 * (blockIdx.x + (jt >> 5) * F.G) + (jt & 31); const float rs = RSA[jt]; u32x2 o[4];
#pragma unroll
          for (int j = 0; j < 4; ++j) { const u32x4 xr = xn[j]; const f32x4 a = (f32x4){bflo(xr.x), bfhi(xr.x), bflo(xr.y), bfhi(xr.y)} * rs * gv[2 * j], b = (f32x4){bflo(xr.z), bfhi(xr.z), bflo(xr.w), bfhi(xr.w)} * rs * gv[2 * j + 1];
              o[j].x = pk4_fp8(a[0], a[1], a[2], a[3]); o[j].y = pk4_fp8(b[0], b[1], b[2], b[3]); }
          const int j2 = jt + 8;
          if (j2 < ntok) { const size_t t2 = (size_t)32 * (blockIdx.x + (j2 >> 5) * F.G) + (j2 & 31);
#pragma unroll
              for (int j = 0; j < 4; ++j) xn[j] = *(const u32x4*)(XMID + t2 * DM + 8 * l + 512 * j); }
#pragma unroll
          for (int j = 0; j < 4; ++j) *(u32x2*)(HF8 + tk * DM + 8 * l + 512 * j) = o[j]; } }
}

__device__ __forceinline__ void p4b(Frame& F, const Params& p) {
    build_moe_tables(F);
    const bf16_t* XMID = (const bf16_t*)(F.ws + WS_XMID); const float* RSTD = (const float*)(F.ws + WS_RSTD); const unsigned* TOKE = (const unsigned*)(F.ws + WS_TOKE);
    const float* gf = p.in[I_NFG]; unsigned char* ABUF = F.ws + WS_ABUF;
    const int l = F.lane;
    u32x4 xn[4]; float rsn = 0.f; unsigned ten[4] = {0u, 0u, 0u, 0u};
    if (F.gw < T) { rsn = RSTD[F.gw];
#pragma unroll
        for (int k = 0; k < 4; ++k) ten[k] = TOKE[F.gw * 4 + k];
#pragma unroll
        for (int j = 0; j < 4; ++j) xn[j] = *(const u32x4*)(XMID + (size_t)F.gw * DM + 8 * l + 512 * j); }
    f32x4 gv[8];
#pragma unroll
    for (int j = 0; j < 4; ++j) { gv[2 * j] = *(const f32x4*)(gf + 8 * l + 512 * j) * 16.0f; gv[2 * j + 1] = *(const f32x4*)(gf + 8 * l + 512 * j + 4) * 16.0f; }
    for (int tok = F.gw; tok < T; tok += F.NGW) {
        const float rs = rsn; unsigned te[4]; u32x2 o[4];
#pragma unroll
        for (int k = 0; k < 4; ++k) te[k] = ten[k];
#pragma unroll
        for (int j = 0; j < 4; ++j) { const u32x4 xr = xn[j]; const f32x4 a = (f32x4){bflo(xr.x), bfhi(xr.x), bflo(xr.y), bfhi(xr.y)} * rs * gv[2 * j], b = (f32x4){bflo(xr.z), bfhi(xr.z), bflo(xr.w), bfhi(xr.w)} * rs * gv[2 * j + 1];
            o[j].x = pk4_fp8(a[0], a[1], a[2], a[3]); o[j].y = pk4_fp8(b[0], b[1], b[2], b[3]); }
        const int t2 = tok + F.NGW;
        if (t2 < T) { rsn = RSTD[t2];
#pragma unroll
            for (int k = 0; k < 4; ++k) ten[k] = TOKE[t2 * 4 + k];
#pragma unroll
            for (int j = 0; j < 4; ++j) xn[j] = *(const u32x4*)(XMID + (size_t)t2 * DM + 8 * l + 512 * j); }
#pragma unroll
        for (int k = 0; k < 4; ++k) { const size_t row = (size_t)F.MISC[MI_PBASE + (te[k] & 255u)] + (te[k] >> 8);
#pragma unroll
            for (int j = 0; j < 4; ++j) *(u32x2*)(ABUF + row * DM + 8 * l + 512 * j) = o[j]; }
    }
}

__device__ __forceinline__ void p7(Frame& F, const Params& p) {
    build_moe_tables(F);
    const bf16_t* XMID = (const bf16_t*)(F.ws + WS_XMID); const unsigned* TOKE = (const unsigned*)(F.ws + WS_TOKE); const float* GATES = (const float*)(F.ws + WS_GATES);
    const unsigned char* Y = F.ws + WS_Y; const float* gfin = p.in[I_NFINAL];
    const int l = F.lane;
    u32x4 xn[4]; u32x2 yn[4][4]; float gkn[4] = {0.f, 0.f, 0.f, 0.f};
#define P7_FETCH(tk) do { \
        _Pragma("unroll") for (int k = 0; k < 4; ++k) { const unsigned te = TOKE[(tk) * 4 + k]; gkn[k] = GATES[(tk) * 4 + k]; const size_t row = (size_t)F.MISC[MI_PBASE + (te & 255u)] + (te >> 8); \
            _Pragma("unroll") for (int j = 0; j < 4; ++j) yn[k][j] = *(const u32x2*)(Y + row * DM + 8 * l + 512 * j); } \
        _Pragma("unroll") for (int j = 0; j < 4; ++j) xn[j] = *(const u32x4*)(XMID + (size_t)(tk) * DM + 8 * l + 512 * j); } while (0)
    if (F.gw < T) P7_FETCH(F.gw);
    f32x4 g0[4], g1[4];
#pragma unroll
    for (int j = 0; j < 4; ++j) { g0[j] = *(const f32x4*)(gfin + 8 * l + 512 * j); g1[j] = *(const f32x4*)(gfin + 8 * l + 512 * j + 4); }
    for (int tok = F.gw; tok < T; tok += F.NGW) {
        f32x4 xv[8];
#pragma unroll
        for (int j = 0; j < 4; ++j) { const u32x4 xr = xn[j]; xv[2 * j] = (f32x4){bflo(xr.x), bfhi(xr.x), bflo(xr.y), bfhi(xr.y)}; xv[2 * j + 1] = (f32x4){bflo(xr.z), bfhi(xr.z), bflo(xr.w), bfhi(xr.w)}; }
#pragma unroll
        for (int k = 0; k < 4; ++k)
#pragma unroll
            for (int j = 0; j < 4; ++j) { const u32x2 y2 = yn[k][j]; const float gk = gkn[k] * (1.0f / 32.0f);
                xv[2 * j][0] += gk * fp8f(y2.x, 0); xv[2 * j][1] += gk * fp8f(y2.x, 1); xv[2 * j][2] += gk * fp8f(y2.x, 2); xv[2 * j][3] += gk * fp8f(y2.x, 3);
                xv[2 * j + 1][0] += gk * fp8f(y2.y, 0); xv[2 * j + 1][1] += gk * fp8f(y2.y, 1); xv[2 * j + 1][2] += gk * fp8f(y2.y, 2); xv[2 * j + 1][3] += gk * fp8f(y2.y, 3); }
        const int t2 = tok + F.NGW;
        if (t2 < T) P7_FETCH(t2);
        float ss = 0.f;
#pragma unroll
        for (int j = 0; j < 8; ++j) ss += (xv[j][0] * xv[j][0] + xv[j][1] * xv[j][1]) + (xv[j][2] * xv[j][2] + xv[j][3] * xv[j][3]);
        const float rs = rsqrtf_(wave_sum(ss) * (1.0f / DM) + 1e-6f);
#pragma unroll
        for (int j = 0; j < 4; ++j) { *(f32x4*)(p.out + (size_t)tok * DM + 8 * l + 512 * j) = xv[2 * j] * rs * g0[j]; *(f32x4*)(p.out + (size_t)tok * DM + 8 * l + 512 * j + 4) = xv[2 * j + 1] * rs * g1[j]; }
    }
#undef P7_FETCH
}

#ifdef PROBE_STREAM
__device__ __forceinline__ void probe_stream(Frame& F, const Params& p) {
    const f32x4* src = (const f32x4*)p.in[I_WGU]; const size_t n4 = (size_t)32 * 2048 * 4096 / 4;
    const f32x4* src2 = (const f32x4*)p.in[I_WDN]; const size_t m4 = (size_t)32 * 2048 * 2048 / 4;
    f32x4 acc = (f32x4){0.f, 0.f, 0.f, 0.f};
    for (size_t base = (size_t)F.gw * 1024; base < n4; base += (size_t)F.NGW * 1024) {
        f32x4 v[16];
#pragma unroll
        for (int i = 0; i < 16; ++i) v[i] = src[base + i * 64 + F.lane];
#pragma unroll
        for (int i = 0; i < 16; ++i) acc += v[i]; }
    for (size_t base = (size_t)F.gw * 1024; base < m4; base += (size_t)F.NGW * 1024) {
        f32x4 v[16];
#pragma unroll
        for (int i = 0; i < 16; ++i) v[i] = src2[base + i * 64 + F.lane];
#pragma unroll
        for (int i = 0; i < 16; ++i) acc += v[i]; }
    if (acc[0] + acc[1] + acc[2] + acc[3] == 12345.678f) p.out[0] = 1.0f;
}
#endif
#ifdef PROBE_ORDER
__device__ __forceinline__ void probe_order(Frame& F, const Params& p) {
    volatile LAS unsigned* flag = F.MISC + 2000;
    if (F.wave < 4) {
        const unsigned* hot = (const unsigned*)p.in[I_X] + (size_t)blockIdx.x * 16384;
        unsigned idx = F.tid & 255, sm = 0;
        for (int it = 0; it < 600; ++it) {
            const unsigned b = idx * 4 + (it & 3) * 1024;
            const unsigned v0 = hot[b & 16383], v1 = hot[(b + 4096) & 16383], v2 = hot[(b + 8192) & 16383], v3 = hot[(b + 12288) & 16383];
            sm += v0 + v1 + v2 + v3; idx = (idx + (sm & 3)) & 255;
        }
        if (sm == 0x12345678u) p.out[0] = 1.0f;
        *flag = 1u;
    } else {
#if PROBE_ORDER == 2
        const f32x4* src = (const f32x4*)p.in[I_WGU];
        f32x4 acc = (f32x4){0.f, 0.f, 0.f, 0.f}; unsigned it = 0;
        const unsigned sw = blockIdx.x * 4 + (F.wave - 4);
        while (*flag == 0u) {
            const size_t base = (((size_t)it * 1024 + sw) * 1024) & (((size_t)1 << 26) - 1);
            f32x4 v[16];
#pragma unroll
            for (int i = 0; i < 16; ++i) v[i] = src[base + i * 64 + F.lane];
#pragma unroll
            for (int i = 0; i < 16; ++i) acc += v[i];
            ++it;
        }
        if (acc[0] + acc[1] + acc[2] + acc[3] == 12345.678f) p.out[1] = 1.0f;
#endif
    }
    __syncthreads();
}
#endif
constexpr int NPHASE = 11;
constexpr int HOST_DN_EXPERTS = 24;
constexpr int CONV_EXPERTS = 28, CONV_END = CONV_EXPERTS * 8192, CONV_P1 = 2048 * 81;
#ifndef KROT5
#define KROT5 false
#endif
#ifndef KROT6
#define KROT6 false
#endif
#ifndef STAG5
#define STAG5 0
#endif
#ifndef STAG6
#define STAG6 0
#endif
__global__ void __launch_bounds__(512, 2) mk_fwd(Params p) {
    extern __shared__ __attribute__((aligned(16))) unsigned char lds_raw[];
    Frame F;
    F.lds = (LAS unsigned char*)lds_raw; F.MISC = (volatile LAS unsigned*)(F.lds + MISC_OFF);
    F.wave = __builtin_amdgcn_readfirstlane((int)threadIdx.x >> 6);
#define FRESH() do { F.lane = fresh_lane(); F.tid = F.wave * 64 + F.lane; } while (0)
    FRESH();
    F.G = gridDim.x; F.gw = (int)blockIdx.x * 8 + F.wave; F.NGW = F.G * 8; F.ws = p.ws;
    for (int u = F.tid; u < (LDS_BYTES - MISC_OFF) / 4; u += 512) F.MISC[u] = 0u;
    __syncthreads();
    const int lo = p.ph_lo, hi = p.ph_hi;
    XcdBarrier bar; bar.bar = (unsigned*)(F.ws + WS_CTL) + CW_BAR; bar.x = 0; bar.st = F.MISC;
    if (hi - lo > 1) bar = xcd_barrier_post((unsigned*)(F.ws + WS_CTL) + CW_BAR, F.MISC, F.tid == 0);
#ifndef PHASE_MASK
#define PHASE_MASK 0x7ff
#endif
#define IN(k) (((PHASE_MASK >> (k)) & 1) && lo <= (k) && (k) < hi)
#define SEAM(k) do { if (IN(k) && IN((k) + 1)) xcd_barrier(bar, F.wave == 0 && fresh_lane() == 0); } while (0)
#ifndef REPEAT_MASK
#define REPEAT_MASK 0
#endif
#define REP(k) for (int rep_ = 0; rep_ < (((REPEAT_MASK >> (k)) & 1) ? 2 : 1); ++rep_)
    LAS unsigned char* ring = F.lds;
#ifdef PROBE_STREAM
    if (IN(0)) { probe_stream(F, p); }
#endif
#ifdef PROBE_ORDER
    if (IN(0)) { probe_order(F, p); }
#endif
    if (IN(0)) { REP(11) { FRESH(); p0a(F, p); } REP(12) { FRESH(); p0b(F, p); } SEAM(0); }
    if (IN(1)) REP(1) {

#ifdef SIM_FP8
        pg8::Gemm g{F.ws + WS_MIX, F.ws + WS_WINT};
#else
        pg8::Gemm g{F.ws + WS_H, F.ws + WS_WINT};
#endif
 using GS = pg8::GShape<DM * 2, DM * 2, DM * 2, 0>; pg8::StaticOrder S; S.init(T, ZC, F.G, (int)blockIdx.x);
        pg8::EpiBf16 E{(bf16_t*)(F.ws + WS_Z), ZC, nullptr, 0};
        pg8::ConvGU cv{p.in[I_WGU], F.ws + WS_WGUT, F.gw, CONV_END, F.NGW, 0};
        pg8::gemm_phase<pg8::EpiBf16, pg8::StaticOrder, GS, true, false, 0, pg8::ConvGU>(ring, g, S, E, F.wave, cv); SEAM(1); }
    if (IN(2)) REP(2) { FRESH(); p2a(F, p); SEAM(2); }
    if (IN(3)) REP(3) { FRESH(); p2b(F, p); SEAM(3); }
    if (IN(4)) REP(4) { FRESH(); p2c(F, p); SEAM(4); }
    if (IN(5)) REP(5) {
        pg8::Gemm g{F.ws + WS_MIX, F.ws + WS_WOUTT}; using GS = pg8::GShape<DM * 2, DM * 2, DM * 2, 0>; pg8::StaticOrder S; S.init(T, DM, F.G, (int)blockIdx.x);
        pg8::EpiBf16Res E{(bf16_t*)(F.ws + WS_XMID), p.in[I_X], DM};
        pg8::ConvGU cv{p.in[I_WGU], F.ws + WS_WGUT, CONV_P1 + F.gw, CONV_END, F.NGW, 0};
        pg8::gemm_phase<pg8::EpiBf16Res, pg8::StaticOrder, GS, true, false, 0, pg8::ConvGU>(ring, g, S, E, F.wave, cv); SEAM(5); }
    if (IN(6)) { FRESH(); p4a(F, p); SEAM(6); }
    if (IN(8)) {
        FRESH(); build_moe_tables(F);
        pg8::Gemm g{F.ws + WS_HF8, F.ws + WS_WGUT}; using GS = pg8::GShape<DM, DM, DM, (size_t)4096 * DM>;
        pg8::MoeOrder S{__builtin_amdgcn_readfirstlane((int)F.MISC[MI_NMT]), 16, F.G, (int)blockIdx.x, (const LAS int*)(F.lds + MISC_OFF + 4 * MI_T2E)};
        pg8::EpiSwiGLU8 E{F.ws + WS_ACT, DM, p.in[I_BGU]};
        pg8::Gather gi{(const unsigned short*)(F.ws + WS_LIST), (const LAS unsigned*)(F.lds + MISC_OFF + 4 * MI_PBASE), (const LAS unsigned*)(F.lds + MISC_OFF + 4 * MI_CNT)};
        pg8::EpiHost<3> eh{p.in[I_WDN], F.ws + WS_WDT, F.gw, HOST_DN_EXPERTS * 4096, F.NGW, DM, 5, 0, 0, {0, 0, 0}};
        pg8::gemm_phase<pg8::EpiSwiGLU8, pg8::MoeOrder, GS, true, true, STAG5, pg8::NoConv, pg8::EpiHost<3>, KROT5, pg8::Gather>(ring, g, S, E, F.wave, pg8::NoConv(), eh, gi); SEAM(8); }
#if (REPEAT_MASK & 0x100)
    if (IN(8)) {
        FRESH(); build_moe_tables(F);
        pg8::Gemm g{F.ws + WS_ABUF, F.ws + WS_WGUT}; using GS = pg8::GShape<DM, DM, DM, (size_t)4096 * DM>;
        pg8::MoeOrder S{__builtin_amdgcn_readfirstlane((int)F.MISC[MI_NMT]), 16, F.G, (int)blockIdx.x, (const LAS int*)(F.lds + MISC_OFF + 4 * MI_T2E)};
        pg8::EpiSwiGLU8 E{F.ws + WS_Y, DM, p.in[I_BGU]};
#if P5DUP == 2
        pg8::Gemm g2{F.ws + WS_HF8, F.ws + WS_WGUT};
        pg8::Gather gi{(const unsigned short*)(F.ws + WS_LIST), (const LAS unsigned*)(F.lds + MISC_OFF + 4 * MI_PBASE), (const LAS unsigned*)(F.lds + MISC_OFF + 4 * MI_CNT)};
        pg8::gemm_phase<pg8::EpiSwiGLU8, pg8::MoeOrder, GS, true, true, STAG5, pg8::NoConv, pg8::NoHost, false, pg8::Gather>(ring, g2, S, E, F.wave, pg8::NoConv(), pg8::NoHost(), gi); SEAM(8); }
#else
        pg8::gemm_phase<pg8::EpiSwiGLU8, pg8::MoeOrder, GS, true, true, STAG5>(ring, g, S, E, F.wave); SEAM(8); }
#endif
#endif
    if (IN(9)) {
        FRESH(); build_moe_tables(F);
        pg8::Gemm g{F.ws + WS_ACT, F.ws + WS_WDT}; using GS = pg8::GShape<DM, DM, DM, (size_t)DM * DM>;
        pg8::MoeOrder S{__builtin_amdgcn_readfirstlane((int)F.MISC[MI_NMT]), 8, F.G, (int)blockIdx.x, (const LAS int*)(F.lds + MISC_OFF + 4 * MI_T2E)};
        pg8::EpiFp8S E{F.ws + WS_Y, DM, p.in[I_BDN], DM, 1.0f / 2048.0f, 32.0f};
        pg8::gemm_phase<pg8::EpiFp8S, pg8::MoeOrder, GS, true, true, STAG6, pg8::NoConv, pg8::NoHost, KROT6>(ring, g, S, E, F.wave); SEAM(9); }
#if (REPEAT_MASK & 0x200)
    if (IN(9)) {
        FRESH(); build_moe_tables(F);
#ifdef P6_PITCH
        pg8::Gemm g{F.ws + WS_ACT, F.ws + WS_WDT}; using GS = pg8::GShape<P6_PITCH, P6_PITCH, DM, (size_t)DM * DM>;
#else
        pg8::Gemm g{F.ws + WS_ACT, F.ws + WS_WDT}; using GS = pg8::GShape<DM, DM, DM, (size_t)DM * DM>;
#endif
        pg8::MoeOrder S{__builtin_amdgcn_readfirstlane((int)F.MISC[MI_NMT]), 8, F.G, (int)blockIdx.x, (const LAS int*)(F.lds + MISC_OFF + 4 * MI_T2E)};
#ifdef P6_NOSTORE
        pg8::EpiNull_<P6_NOSTORE - 1> E{};

#ifndef P6_FLP
#define P6_FLP false
#endif
        pg8::gemm_phase<pg8::EpiNull_<P6_NOSTORE - 1>, pg8::MoeOrder, GS, true, true, STAG6, pg8::NoConv, pg8::NoHost, false, pg8::NoGather, P6_FLP>(ring, g, S, E, F.wave); SEAM(9); }
#elif defined(P6_MODE)
        pg8::EpiFp8S_<P6_MODE> E{F.ws + WS_Y, DM, p.in[I_BDN], DM, 1.0f / 2048.0f, 32.0f};
        pg8::gemm_phase<pg8::EpiFp8S_<P6_MODE>, pg8::MoeOrder, GS, true, true, STAG6>(ring, g, S, E, F.wave); SEAM(9); }
#else
        pg8::EpiFp8S E{F.ws + WS_Y, DM, p.in[I_BDN], DM, 1.0f / 2048.0f, 32.0f};
        pg8::gemm_phase<pg8::EpiFp8S, pg8::MoeOrder, GS, true, true, STAG6>(ring, g, S, E, F.wave); SEAM(9); }
#endif
#endif
    if (IN(10)) REP(10) { FRESH(); p7(F, p); if (((REPEAT_MASK >> 10) & 1)) xcd_barrier(bar, F.wave == 0 && fresh_lane() == 0); }
#undef IN
#undef SEAM
}
#ifndef STAGE
#define STAGE 4
#endif
#ifndef PER_PHASE_LAUNCH
#define PER_PHASE_LAUNCH 0
#endif

#if STAGE < 4
__global__ void adapt_z_kernel(const bf16_t* Z, float* z) {
    const long idx = (long)blockIdx.x * blockDim.x + threadIdx.x; const long t = idx / ZC; const int c = (int)(idx % ZC);
    z[t * INC + (c < 3072 ? c : c + 16)] = bf2f(Z[idx]);
}
__global__ void adapt_bf16_kernel(const bf16_t* src, float* dst) { const long idx = (long)blockIdx.x * blockDim.x + threadIdx.x; dst[idx] = bf2f(src[idx]); }
#endif

static void launch_mk(Params& a, int lo, int hi, int grid, hipStream_t stream) {
#if PER_PHASE_LAUNCH
    for (int k = lo; k < hi; ++k) { a.ph_lo = k; a.ph_hi = k + 1; hipLaunchKernelGGL(mk_fwd, dim3(grid), dim3(512), LDS_BYTES, stream, a); }
#else
    a.ph_lo = lo; a.ph_hi = hi; hipLaunchKernelGGL(mk_fwd, dim3(grid), dim3(512), LDS_BYTES, stream, a);
#endif
}

extern "C" void kernel_launch(void* const* d_in, const int* in_sizes, int n_in, void* d_out, int out_size, void* d_ws, size_t ws_size, hipStream_t stream) {
    static int grid = 0;
    if (grid == 0) {
        int dev = 0, cus = 0;
        if (hipGetDevice(&dev) != hipSuccess || hipDeviceGetAttribute(&cus, hipDeviceAttributeMultiprocessorCount, dev) != hipSuccess) { grid = -1; return; }
        if (hipFuncSetAttribute((const void*)mk_fwd, hipFuncAttributeMaxDynamicSharedMemorySize, LDS_BYTES) != hipSuccess) { grid = -1; return; }
        int per_cu = 0;
        (void)hipOccupancyMaxActiveBlocksPerMultiprocessor(&per_cu, (const void*)mk_fwd, 512, LDS_BYTES);
        (void)hipGetLastError();
        grid = cus < 256 ? cus : 256;
        if (per_cu < 1) fprintf(stderr, "kernel_launch: occupancy query reports %d\n", per_cu);
    }
    if (grid < 0) return;
    (void)hipMemsetAsync((char*)d_ws + WS_CTL, 0, CTL_ZERO_BYTES, stream);
    Params a{};
    for (int i = 0; i < 22; ++i) a.in[i] = (const float*)d_in[i];
    a.out = (float*)d_out; a.ws = (unsigned char*)d_ws;
#if STAGE >= 4
    launch_mk(a, 0, NPHASE, grid, stream);
#else
    const float* x = a.in[I_X];
    char* ws = (char*)d_ws + WS_ABUF; size_t off = 0;
    auto alloc = [&](size_t bytes) { void* p = ws + off; off += (bytes + 255) & ~(size_t)255; return p; };
    int* counts = (int*)alloc(256);
    float* z = (float*)alloc((size_t)T * INC * 4);
    float* ogla = (float*)alloc((size_t)T * 1024 * 4);
    float* xc = (float*)alloc((size_t)T * 1024 * 4);
    float* za = (float*)alloc((size_t)T * 1024 * 4);
    float* zi = (float*)alloc((size_t)T * 1024 * 4);
    float* mix = (float*)alloc((size_t)T * DM * 4);
    float* xmid = (float*)alloc((size_t)T * DM * 4);
    float* hf = (float*)alloc((size_t)T * DM * 4);
    float* logits = (float*)alloc((size_t)T * 32 * 4);
    float* gates = (float*)alloc((size_t)T * 4 * 4);
    int* list = (int*)alloc((size_t)NEXP * T * 4);
    float* act = (float*)alloc((size_t)T * 4 * DM * 4);
    float* y = (float*)alloc((size_t)T * 4 * DM * 4);
    (void)hipMemsetAsync(counts, 0, 256, stream);
#if STAGE == 1
    launch_mk(a, 0, 2, grid, stream);
    adapt_z_kernel<<<(unsigned)((size_t)T * ZC / 256), 256, 0, stream>>>((const bf16_t*)((char*)d_ws + WS_Z), z);
    gla_naive_kernel<<<64, 256, 0, stream>>>(z, (const float*)((char*)d_ws + WS_LG), ogla);
    gla_out_kernel<<<T, 256, 0, stream>>>(ogla, z, a.in[I_GNG], mix);
    lru_conv_kernel<<<T * 1024 / 256, 256, 0, stream>>>(z, a.in[I_CW], a.in[I_CB], xc);
    for (int h = 0; h < 4; ++h) {
        GemmArgs g{}; g.A = xc + h * 256; g.lda = 1024; g.ldb = 256; g.ldc = 1024; g.M = T; g.N = 256; g.K = 256; g.a_div = 1;
        g.B = a.in[I_WA] + (size_t)h * 65536; g.C = za + h * 256;
        sgemm_kernel<0><<<dim3(2, T / 128, 1), 256, 0, stream>>>(g);
        g.B = a.in[I_WI] + (size_t)h * 65536; g.C = zi + h * 256;
        sgemm_kernel<0><<<dim3(2, T / 128, 1), 256, 0, stream>>>(g);
    }
    lru_gate_kernel<<<T * 1024 / 256, 256, 0, stream>>>(xc, za, zi, a.in[I_BA], a.in[I_BI], a.in[I_AP]);
    lru_scan_kernel<<<2048 / 64, 64, 0, stream>>>(za, zi, z, mix);
#endif
#if STAGE == 2
    launch_mk(a, 0, 5, grid, stream);
    adapt_bf16_kernel<<<(unsigned)((size_t)T * DM / 256), 256, 0, stream>>>((const bf16_t*)((char*)d_ws + WS_MIX), mix);
#endif
#if STAGE <= 2
    { GemmArgs g{}; g.A = mix; g.lda = DM; g.B = a.in[I_WOUT]; g.ldb = DM; g.C = xmid; g.ldc = DM; g.M = T; g.N = DM; g.K = DM; g.a_div = 1; g.resid = x; g.ldr = DM;
      sgemm_kernel<1><<<dim3(DM / 128, T / 128, 1), 256, 0, stream>>>(g); }
#else
    launch_mk(a, 0, 6, grid, stream);
    xmid = (float*)((char*)d_ws + WS_XMID);
#endif
    rmsnorm_kernel<<<T, 256, 0, stream>>>(xmid, a.in[I_NFG], hf);
    { GemmArgs g{}; g.A = hf; g.lda = DM; g.B = a.in[I_WR]; g.ldb = 32; g.C = logits; g.ldc = 32; g.M = T; g.N = 32; g.K = DM; g.a_div = 1; g.bias = a.in[I_BR];
      sgemm_kernel<0><<<dim3(1, T / 128, 1), 256, 0, stream>>>(g); }
    route_kernel<<<T / 256, 256, 0, stream>>>(logits, counts, list, gates);
    { GemmArgs g{}; g.A = hf; g.lda = DM; g.B = a.in[I_WGU]; g.ldb = 4096; g.C = act; g.ldc = DM; g.M = 0; g.N = 4096; g.K = DM; g.a_div = 4; g.bias = a.in[I_BGU];
      g.rowlist = list; g.count = counts; g.strideB_e = (long)DM * 4096; g.strideBias_e = 4096; g.list_stride = T;
      sgemm_kernel<2><<<dim3(2048 / 64, T / 128, NEXP), 256, 0, stream>>>(g); }
    { GemmArgs g{}; g.A = act; g.lda = DM; g.B = a.in[I_WDN]; g.ldb = DM; g.C = y; g.ldc = DM; g.M = 0; g.N = DM; g.K = DM; g.a_div = 1; g.bias = a.in[I_BDN];
      g.rowlist = list; g.count = counts; g.strideB_e = (long)DM * DM; g.strideBias_e = DM; g.list_stride = T;
      sgemm_kernel<0><<<dim3(DM / 128, T / 128, NEXP), 256, 0, stream>>>(g); }
    final_kernel<<<T, 256, 0, stream>>>(xmid, y, gates, a.in[I_NFINAL], (float*)d_out);
#endif
}
```

```cpp
#define STAGE 4
#define PER_PHASE_LAUNCH 0
#define REPEAT_MASK 0
#include <hip/hip_runtime.h>
#include <stdint.h>
#include <stdio.h>

#define GAS __attribute__((address_space(1)))
#define LAS __attribute__((address_space(3)))
typedef unsigned short bf16_t;
typedef short bf16x8 __attribute__((ext_vector_type(8)));
typedef short bf16x4 __attribute__((ext_vector_type(4)));
typedef float f32x4 __attribute__((ext_vector_type(4)));
typedef float f32x2 __attribute__((ext_vector_type(2)));
typedef float f32x16 __attribute__((ext_vector_type(16)));
typedef unsigned u32x4 __attribute__((ext_vector_type(4)));
typedef unsigned u32x2 __attribute__((ext_vector_type(2)));
typedef int i32x8 __attribute__((ext_vector_type(8)));
typedef int i32x4 __attribute__((ext_vector_type(4)));
typedef int i32x32 __attribute__((ext_vector_type(32)));

constexpr int T = 16384, SEQL = 8192, DM = 2048, INC = 5136, ZC = 5120, NEXP = 32;
constexpr int ZQ = 0, ZK = 512, ZV = 1024, ZR = 2048, ZLX = 3072, ZLG = 4096;
constexpr int MPAD_MAX = 65536 + NEXP * 256;
constexpr int NCHUNK = 256;

constexpr size_t MiB = 1u << 20;
constexpr size_t WS_CTL = 0, CTL_ZERO_BYTES = 128 * 1024;
constexpr size_t WS_WINT = 1 * MiB;
constexpr size_t WS_WOUTT = WS_WINT + 20 * MiB;
constexpr size_t WS_WGUT = WS_WOUTT + 8 * MiB;
constexpr size_t WS_WDT = WS_WGUT + 512 * MiB;
constexpr size_t WS_WAT = WS_WDT + 256 * MiB;
constexpr size_t WS_WIT = WS_WAT + 512 * 1024;
constexpr size_t WS_WRT = WS_WIT + 512 * 1024;
constexpr size_t WS_WGLT = WS_WRT + 512 * 1024;
constexpr size_t WS_H = WS_WRT + 1 * MiB;
constexpr size_t WS_LG = WS_H + 64 * MiB;
constexpr size_t WS_Z = WS_LG + 32 * MiB;
constexpr size_t WS_AN = WS_Z + 160 * MiB;
constexpr size_t WS_DN = WS_AN + 128 * MiB;
constexpr size_t WS_SP = WS_DN + 1 * MiB;
constexpr size_t WS_AUA = WS_SP + 64 * MiB;
constexpr size_t WS_AUU = WS_AUA + 64 * MiB;
constexpr size_t WS_SUMA = WS_AUU + 64 * MiB;
constexpr size_t WS_SUMH = WS_SUMA + 1 * MiB;
constexpr size_t WS_MIX = WS_SUMH + 1 * MiB;
constexpr size_t WS_XMID = WS_MIX + 64 * MiB;
constexpr size_t WS_RSTD = WS_XMID + 128 * MiB;
constexpr size_t WS_TOKE = WS_RSTD + 1 * MiB;
constexpr size_t WS_GATES = WS_TOKE + 1 * MiB;
constexpr size_t WS_ABUF = WS_GATES + 1 * MiB;
constexpr size_t WS_HF8 = WS_ABUF, WS_LIST = WS_ABUF + 64 * MiB;
constexpr size_t WS_ACT = WS_ABUF + 288 * MiB;
constexpr size_t WS_Y = WS_ACT + 288 * MiB;
constexpr size_t WS_END = WS_Y + 288 * MiB;
constexpr int CW_BAR = 4096;
constexpr int CW_CNT = 16384;

constexpr int RING_BYTES = 131072;
constexpr int SCR_BYTES = 135168;
constexpr int MISC_OFF = SCR_BYTES;
constexpr int LDS_BYTES = 147456;
constexpr int MI_PBASE = 16, MI_NMT = 48, MI_LCNT = 64, MI_LBASE = 96, MI_T2E = 128, MI_CNT = 480;

#define LDS_WAIT() asm volatile("s_waitcnt lgkmcnt(0)" ::: "memory")
#define VM_WAIT() asm volatile("s_waitcnt vmcnt(0)" ::: "memory")

typedef __bf16 bf16v2_t __attribute__((ext_vector_type(2)));
__device__ __forceinline__ unsigned pk2(float lo, float hi) { const f32x2 v = {lo, hi}; return __builtin_bit_cast(unsigned, __builtin_convertvector(v, bf16v2_t)); }
#ifdef SIM_FP8
__device__ __forceinline__ float q8_(float x, float sc) { int p = 0; p = __builtin_amdgcn_cvt_pk_fp8_f32(__builtin_amdgcn_fmed3f(x * sc, -448.0f, 448.0f), 0.0f, p, false); return __builtin_amdgcn_cvt_f32_fp8(p, 0) * (1.0f / sc); }
#define PK2A(a, b) pk2(q8_(a, 16.0f), q8_(b, 16.0f))
#define PK2W(a, b) pk2(q8_(a, 512.0f), q8_(b, 512.0f))
#else
#define PK2A(a, b) pk2(a, b)
#define PK2W(a, b) pk2(a, b)
#endif
__device__ __forceinline__ unsigned f2bf(float f) { return pk2(f, 0.0f) & 0xffffu; }
__device__ __forceinline__ float bf2f(unsigned short b) { return __builtin_bit_cast(float, (unsigned)b << 16); }
__device__ __forceinline__ float bflo(unsigned w) { return __builtin_bit_cast(float, w << 16); }
__device__ __forceinline__ float bfhi(unsigned w) { return __builtin_bit_cast(float, w & 0xffff0000u); }
__device__ __forceinline__ float clamp448(float x) { return __builtin_amdgcn_fmed3f(x, -448.0f, 448.0f); }
__device__ __forceinline__ unsigned pk4_fp8(float a, float b, float c, float d) {
    int p = 0; p = __builtin_amdgcn_cvt_pk_fp8_f32(clamp448(a), clamp448(b), p, false); p = __builtin_amdgcn_cvt_pk_fp8_f32(clamp448(c), clamp448(d), p, true); return (unsigned)p; }
__device__ __forceinline__ unsigned pk4_fp8_nc(float a, float b, float c, float d) {
    int p = 0; p = __builtin_amdgcn_cvt_pk_fp8_f32(a, b, p, false); p = __builtin_amdgcn_cvt_pk_fp8_f32(c, d, p, true); return (unsigned)p; }
__device__ __forceinline__ float fp8f(unsigned w, int b) { return b == 0 ? __builtin_amdgcn_cvt_f32_fp8((int)w, 0) : b == 1 ? __builtin_amdgcn_cvt_f32_fp8((int)w, 1) : b == 2 ? __builtin_amdgcn_cvt_f32_fp8((int)w, 2) : __builtin_amdgcn_cvt_f32_fp8((int)w, 3); }
__device__ __forceinline__ float wave_sum(float v) {
#pragma unroll
    for (int o = 1; o < 64; o <<= 1) v += __shfl_xor(v, o);
    return v;
}
__device__ __forceinline__ int fresh_lane() { int l; asm volatile("v_mbcnt_lo_u32_b32 %0, -1, 0\n\tv_mbcnt_hi_u32_b32 %0, -1, %0" : "=v"(l)); return l; }
__device__ __forceinline__ float sigmoidf_(float x) { return __builtin_amdgcn_rcpf(1.0f + __expf(-x)); }
__device__ __forceinline__ float rsqrtf_(float x) { return __builtin_amdgcn_rsqf(x); }

#define XB_TMO      128
#define XB_XCNT(j)  (256  + 64 * (j))
#define XB_XSUB(j)  (1280 + 64 * (j))
#define XB_XGEN(j)  (2304 + 64 * (j))
#define XB_TOP      3328
#define XB_TOPGEN   3392
#define XCD_BAR_WORDS 3456
#define XB_SPIN_CAP (1u << 18)

__device__ __forceinline__ unsigned xb_ld(unsigned* p)              { return __hip_atomic_load(p, __ATOMIC_RELAXED, __HIP_MEMORY_SCOPE_AGENT); }
__device__ __forceinline__ unsigned xb_add(unsigned* p, unsigned v) { return __hip_atomic_fetch_add(p, v, __ATOMIC_RELAXED, __HIP_MEMORY_SCOPE_AGENT); }
__device__ __forceinline__ unsigned xb_xcc_id() { return (unsigned)__builtin_amdgcn_s_getreg((3 << 11) | 20) & 0xFu; }
#define XB_SPIN(cond, bar) do { unsigned _sp = 0; while (cond) { __builtin_amdgcn_s_sleep(1); \
    if ((++_sp & 255u) == 0u) { if (xb_ld(&(bar)[XB_TMO])) break; if (_sp > XB_SPIN_CAP) { atomicAdd(&(bar)[XB_TMO], 1u); break; } } } } while (0)

struct XcdBarrier { unsigned* bar; unsigned x; volatile LAS unsigned* st; };

__device__ __forceinline__ XcdBarrier xcd_barrier_post(unsigned* bar, volatile LAS unsigned* st, bool t0) {
    XcdBarrier b; b.bar = bar; b.x = xb_xcc_id(); b.st = st;
    if (t0) (void)xb_add(&bar[XB_XCNT(b.x)], 1u);
    return b;
}
__device__ __forceinline__ void xcd_barrier_complete(unsigned* bar, unsigned x, unsigned& nloc, unsigned& nx) {
    const unsigned G = gridDim.x * gridDim.y * gridDim.z;
    unsigned sum, cnt, mine, sp = 0u;
    for (;;) {
        sum = 0u; cnt = 0u; mine = 0u;
#pragma unroll
        for (unsigned j = 0; j < 16; ++j) { const unsigned c = xb_ld(&bar[XB_XCNT(j)]); sum += c; cnt += (c > 0u) ? 1u : 0u; mine = (j == x) ? c : mine; }
        if (sum == G) break;
        __builtin_amdgcn_s_sleep(1);
        if ((++sp & 255u) == 0u) { if (xb_ld(&bar[XB_TMO])) break; if (sp > XB_SPIN_CAP) { atomicAdd(&bar[XB_TMO], 1u); break; } }
    }
    nloc = mine > 0u ? mine : 1u; nx = cnt > 0u ? cnt : 1u;
}
__device__ __forceinline__ void xcd_barrier(const XcdBarrier& b, bool t0) {
    asm volatile("s_waitcnt vmcnt(0)" ::: "memory");
    __syncthreads();
    if (t0) {
        unsigned* bar = b.bar;
        __builtin_amdgcn_s_waitcnt(0);
        unsigned nloc = b.st[0], nx = b.st[1];
        if (nloc == 0u) { xcd_barrier_complete(bar, b.x, nloc, nx); b.st[0] = nloc; b.st[1] = nx; }
        const unsigned old = xb_add(&bar[XB_XSUB(b.x)], 1u);
        const unsigned gen = old / nloc;
        if (old + 1u == (gen + 1u) * nloc) {
            __builtin_amdgcn_fence(__ATOMIC_RELEASE, "agent");
            asm volatile("s_waitcnt vmcnt(0)" ::: "memory");
            const unsigned og = xb_add(&bar[XB_TOP], 1u);
            const unsigned tg = og / nx;
            if (og + 1u == (tg + 1u) * nx) xb_add(&bar[XB_TOPGEN], 1u);
            else XB_SPIN(xb_ld(&bar[XB_TOPGEN]) == tg, bar);
            __builtin_amdgcn_fence(__ATOMIC_ACQUIRE, "agent");
            xb_add(&bar[XB_XGEN(b.x)], 1u);
            asm volatile("s_waitcnt vmcnt(0)" ::: "memory");
        } else {
            XB_SPIN(xb_ld(&bar[XB_XGEN(b.x)]) == gen, bar);
            __builtin_amdgcn_fence(__ATOMIC_ACQUIRE, "agent");
            asm volatile("s_waitcnt vmcnt(0)" ::: "memory");
        }
    }
    __syncthreads();
}

namespace pg8 {
#ifndef PG8_WGM
#define PG8_WGM 4
#endif
constexpr int BM = 256, BK = 64, HALF = 128, HTB = HALF * BK * 2, STAGE_BYTES = 8 * HTB, NXCD = 8, WGM = PG8_WGM;
__host__ __device__ __forceinline__ int lds_byte(int r, int c) { const int st = (r >> 4) * 2 + (c >> 5), rr = r & 15, cc = c & 31, ob = rr * 64 + cc * 2; return st * 1024 + (ob ^ (((ob >> 9) & 1) << 5)); }
__host__ __device__ __forceinline__ void stage_rc(int b, int& R, int& C) { const int st = b / 1024, sb = b % 1024, swz = sb ^ (((sb >> 9) & 1) << 5); R = (st >> 1) * 16 + swz / 64; C = (st & 1) * 32 + (swz % 64) / 2; }
__host__ __device__ __forceinline__ int perm32(int rho) { const int n = rho >> 4, i = rho & 15; return 8 * (i >> 2) + 4 * n + (i & 3); }

struct Unit { int pm, pn, e; };
struct Gemm { const void* A; const void* Bt; };
template <int LDA_, int LDB_, int KB_, size_t SB_> struct GShape { static constexpr int LDA = LDA_, LDB = LDB_, KB = KB_; static constexpr size_t SB = SB_; };

__device__ __forceinline__ bool order_map(int L, int nM, int nN, int& pm, int& pn) {
    const int nwg = nM * nN; if (L >= nwg) return false;
    int wgid = L; { const int q = nwg / NXCD, r = nwg % NXCD, xcd = wgid % NXCD, off = wgid / NXCD; wgid = (xcd < r ? xcd * (q + 1) : r * (q + 1) + (xcd - r) * q) + off; }
    const int nig = WGM * nN, gid = wgid / nig, fm = gid * WGM, gsz = (nM - fm) < WGM ? (nM - fm) : WGM;
    pm = fm + ((wgid % nig) % gsz); pn = (wgid % nig) / gsz; return true;
}
struct StaticOrder {
    int nM, nN, G, c;
    __device__ void init(int M, int N, int G_, int c_) { nM = M / BM; nN = N / BM; G = G_; c = c_; }
    __device__ __forceinline__ bool next(int i, Unit& u) const { u.e = 0; return order_map(i * G + c, nM, nN, u.pm, u.pn); }
};
struct MoeOrder {
    int nM, nN, G, c; const LAS int* t2e;
    __device__ __forceinline__ bool next(int i, Unit& u) const { if (!order_map(i * G + c, nM, nN, u.pm, u.pn)) return false; u.e = __builtin_amdgcn_readfirstlane(t2e[u.pm]); return true; }
};

__device__ __forceinline__ unsigned cvt_pk_bf16(float lo, float hi) { return pk2(lo, hi); }

struct EpiBf16 {
    static constexpr bool PERM = true; static constexpr int NSTORES = 16;
    bf16_t* O; int ldc; const float* bias; int bias_stride;
    __device__ __forceinline__ void operator()(const f32x4 (&acc)[2][2][4][2], const Unit& u, int wr, int wc, int fr, int fq) const {
        const int row0 = u.pm * BM + wr * 64 + fr; const int col0 = u.pn * BM + wc * 32 + 8 * fq;
        f32x4 bv[2][2];
#pragma unroll
        for (int bj = 0; bj < 2; ++bj)
#pragma unroll
            for (int n = 0; n < 2; ++n) bv[bj][n] = bias ? *(const f32x4*)(bias + (size_t)u.e * bias_stride + col0 + bj * HALF + 4 * n) : (f32x4){0.f, 0.f, 0.f, 0.f};
#pragma unroll
        for (int ai = 0; ai < 2; ++ai)
#pragma unroll
            for (int m = 0; m < 4; ++m) { bf16_t* rowp = O + (size_t)(row0 + ai * HALF + m * 16) * ldc + col0;
#pragma unroll
                for (int bj = 0; bj < 2; ++bj) { const f32x4 v0 = acc[ai][bj][m][0] + bv[bj][0], v1 = acc[ai][bj][m][1] + bv[bj][1];
                    u32x4 w; w.x = cvt_pk_bf16(v0[0], v0[1]); w.y = cvt_pk_bf16(v0[2], v0[3]); w.z = cvt_pk_bf16(v1[0], v1[1]); w.w = cvt_pk_bf16(v1[2], v1[3]);
                    *(u32x4*)(rowp + bj * HALF) = w; } }
    }
};
struct EpiF32Res {
    static constexpr bool PERM = false;
    float* C; const float* resid; int ldc;
    __device__ __forceinline__ void operator()(const f32x4 (&acc)[2][2][4][2], const Unit& u, int wr, int wc, int fr, int fq) const {
        const int row0 = u.pm * BM + wr * 64 + fr, col0 = u.pn * BM + wc * 32 + 4 * fq;
#pragma unroll
        for (int ai = 0; ai < 2; ++ai)
#pragma unroll
            for (int m = 0; m < 4; ++m) { const size_t off = (size_t)(row0 + ai * HALF + m * 16) * ldc + col0;
#pragma unroll
                for (int bj = 0; bj < 2; ++bj)
#pragma unroll
                    for (int n = 0; n < 2; ++n) { const f32x4 r = *(const f32x4*)(resid + off + bj * HALF + n * 16); *(f32x4*)(C + off + bj * HALF + n * 16) = acc[ai][bj][m][n] + r; } }
    }
};
struct EpiSwiGLU {
    static constexpr bool PERM = true;
    bf16_t* O; int ldc; const float* bias;
    __device__ __forceinline__ void operator()(const f32x4 (&acc)[2][2][4][2], const Unit& u, int wr, int wc, int fr, int fq) const {
        const int row0 = u.pm * BM + wr * 64 + fr; const int j0 = u.pn * HALF + wc * 32 + 8 * fq;
        const float* be = bias + (size_t)u.e * 4096;
        f32x4 bg[2], bu[2];
#pragma unroll
        for (int n = 0; n < 2; ++n) { bg[n] = *(const f32x4*)(be + j0 + 4 * n); bu[n] = *(const f32x4*)(be + 2048 + j0 + 4 * n); }
#pragma unroll
        for (int ai = 0; ai < 2; ++ai)
#pragma unroll
            for (int m = 0; m < 4; ++m) { bf16_t* rowp = O + (size_t)(row0 + ai * HALF + m * 16) * ldc + j0;
                float o[8];
#pragma unroll
                for (int n = 0; n < 2; ++n) { const f32x4 g = acc[ai][0][m][n] + bg[n], up = acc[ai][1][m][n] + bu[n];
#pragma unroll
                    for (int q = 0; q < 4; ++q) { const float gt = fminf(g[q], 7.0f), ut = fminf(fmaxf(up[q], -7.0f), 7.0f);
                        const float glu = gt * __builtin_amdgcn_rcpf(1.0f + __expf(-1.702f * gt)); o[4 * n + q] = (ut + 1.0f) * glu; } }
                u32x4 w; w.x = cvt_pk_bf16(o[0], o[1]); w.y = cvt_pk_bf16(o[2], o[3]); w.z = cvt_pk_bf16(o[4], o[5]); w.w = cvt_pk_bf16(o[6], o[7]);
                *(u32x4*)rowp = w; }
    }
};

struct EpiBf16Res {
    static constexpr bool PERM = true; static constexpr int NSTORES = 16;
    bf16_t* O; const float* resid; int ldc;
    __device__ __forceinline__ void operator()(const f32x4 (&acc)[2][2][4][2], const Unit& u, int wr, int wc, int fr, int fq) const {
        const int row0 = u.pm * BM + wr * 64 + fr; const int col0 = u.pn * BM + wc * 32 + 8 * fq;
#pragma unroll
        for (int ai = 0; ai < 2; ++ai)
#pragma unroll
            for (int m = 0; m < 4; ++m) { const size_t off = (size_t)(row0 + ai * HALF + m * 16) * ldc + col0;
#pragma unroll
                for (int bj = 0; bj < 2; ++bj) { const f32x4 r0 = *(const f32x4*)(resid + off + bj * HALF), r1 = *(const f32x4*)(resid + off + bj * HALF + 4);
                    const f32x4 v0 = acc[ai][bj][m][0] + r0, v1 = acc[ai][bj][m][1] + r1;
                    u32x4 w; w.x = cvt_pk_bf16(v0[0], v0[1]); w.y = cvt_pk_bf16(v0[2], v0[3]); w.z = cvt_pk_bf16(v1[0], v1[1]); w.w = cvt_pk_bf16(v1[2], v1[3]);
                    *(u32x4*)(O + off + bj * HALF) = w; } }
    }
};
#ifndef USE_BIAS_LDS
#define USE_BIAS_LDS 0
#endif
template <int MODE = 0> struct EpiFp8S_ {
    static constexpr int NSTORES = 16;
    static constexpr bool PERM = true, BIAS_LDS = (USE_BIAS_LDS != 0);
    unsigned char* O; int ldc; const float* bias; int bias_stride; float scale, oscale;
    __device__ __forceinline__ const char* bias_base(const Unit& u) const { return (const char*)(bias + (size_t)u.e * bias_stride + u.pn * BM); }
    __device__ static __forceinline__ unsigned bias_voff(int i) { return (unsigned)i * 4u; }
    __device__ __forceinline__ void operator()(const f32x4 (&acc)[2][2][4][2], const Unit& u, int wr, int wc, int fr, int fq, const LAS float* bl) const {
        const int row0 = u.pm * BM + wr * 64 + fr; const int col0 = u.pn * BM + wc * 32 + 8 * fq;
        f32x4 bv[2][2];
#pragma unroll
        for (int bj = 0; bj < 2; ++bj)
#pragma unroll
            for (int n = 0; n < 2; ++n) { if constexpr (MODE == 2) bv[bj][n] = (f32x4){oscale, oscale, oscale, oscale}; else if constexpr (BIAS_LDS) bv[bj][n] = *(const LAS f32x4*)(bl + wc * 32 + 8 * fq + bj * HALF + 4 * n) * oscale; else bv[bj][n] = *(const f32x4*)(bias + (size_t)u.e * bias_stride + col0 + bj * HALF + 4 * n) * oscale; }
        const float sc = scale * oscale;
#pragma unroll
        for (int ai = 0; ai < 2; ++ai)
#pragma unroll
            for (int m = 0; m < 4; ++m) { unsigned char* rowp = O + (size_t)(row0 + ai * HALF + m * 16) * ldc + col0;
#pragma unroll
                for (int bj = 0; bj < 2; ++bj) { const f32x4 v0 = acc[ai][bj][m][0] * sc + bv[bj][0], v1 = acc[ai][bj][m][1] * sc + bv[bj][1];
                    u32x2 w; w.x = pk4_fp8(v0[0], v0[1], v0[2], v0[3]); w.y = pk4_fp8(v1[0], v1[1], v1[2], v1[3]);
                    if constexpr (MODE == 1) { if (u.pm < 0) *(u32x2*)(rowp + bj * HALF) = w; else asm volatile("" :: "v"(w)); } else *(u32x2*)(rowp + bj * HALF) = w; } }
    }
};
using EpiFp8S = EpiFp8S_<0>;
struct EpiSwiGLU8 {
    static constexpr bool PERM = true, BIAS_LDS = (USE_BIAS_LDS != 0); static constexpr int NSTORES = 8;
    unsigned char* O; int ldc; const float* bias;
    struct Bias { f32x4 bg[2], bu[2];
        __device__ __forceinline__ void pin() { asm volatile("" : "+v"(bg[0]), "+v"(bg[1]), "+v"(bu[0]), "+v"(bu[1])); } };
    __device__ __forceinline__ const char* bias_base(const Unit& u) const { return (const char*)(bias + (size_t)u.e * 4096 + u.pn * HALF); }
    __device__ static __forceinline__ unsigned bias_voff(int i) { return (unsigned)(i < 128 ? i : 2048 - 128 + i) * 4u; }
    __device__ __forceinline__ void load_bias(const Unit& u, int wc, int fq, Bias& b, const LAS float* bl) const {
        const int j0 = wc * 32 + 8 * fq;
        if constexpr (BIAS_LDS) {
#pragma unroll
            for (int n = 0; n < 2; ++n) { b.bg[n] = *(const LAS f32x4*)(bl + j0 + 4 * n); b.bu[n] = *(const LAS f32x4*)(bl + 128 + j0 + 4 * n); }
        } else { const float* be = bias + (size_t)u.e * 4096 + u.pn * HALF + j0;
#pragma unroll
            for (int n = 0; n < 2; ++n) { b.bg[n] = *(const f32x4*)(be + 4 * n); b.bu[n] = *(const f32x4*)(be + 2048 + 4 * n); } } }
    __device__ __forceinline__ void operator()(const f32x4 (&acc)[2][2][4][2], const Unit& u, int wr, int wc, int fr, int fq, const LAS float* bl) const { Bias b; load_bias(u, wc, fq, b, bl); apply(acc, u, wr, wc, fr, fq, b); }
    __device__ __forceinline__ void apply(const f32x4 (&acc)[2][2][4][2], const Unit& u, int wr, int wc, int fr, int fq, const Bias& b) const {
        const int row0 = u.pm * BM + wr * 64 + fr; const int j0 = u.pn * HALF + wc * 32 + 8 * fq;
        const f32x4 (&bg)[2] = b.bg; const f32x4 (&bu)[2] = b.bu;
#pragma unroll
        for (int ai = 0; ai < 2; ++ai)
#pragma unroll
            for (int m = 0; m < 4; ++m) { unsigned char* rowp = O + (size_t)(row0 + ai * HALF + m * 16) * ldc + j0;
                float o[8];
#pragma unroll
                for (int n = 0; n < 2; ++n) { const f32x4 g = acc[ai][0][m][n] * (1.0f / 8192.0f) + bg[n], up = acc[ai][1][m][n] * (1.0f / 8192.0f) + bu[n];
#pragma unroll
                    for (int q = 0; q < 4; ++q) { const float gt = fminf(g[q], 7.0f), ut = __builtin_amdgcn_fmed3f(up[q], -7.0f, 7.0f);
                        const float glu = gt * __builtin_amdgcn_rcpf(1.0f + __builtin_amdgcn_exp2f(-2.4554669595930156f * gt)); o[4 * n + q] = __builtin_fmaf(ut, 4.0f, 4.0f) * glu; } }
                u32x2 w; w.x = pk4_fp8_nc(o[0], o[1], o[2], o[3]); w.y = pk4_fp8_nc(o[4], o[5], o[6], o[7]);
                *(u32x2*)rowp = w; }
    }
};
template <int ALL> struct EpiNull_ { static constexpr bool PERM = true;
    __device__ __forceinline__ void operator()(const f32x4 (&acc)[2][2][4][2], const Unit& u, int wr, int wc, int fr, int fq) const {
        if constexpr (ALL == 0) asm volatile("" :: "v"(acc[0][0][0][0]), "v"(acc[1][1][3][1]));
        else {
#pragma unroll
        for (int a = 0; a < 2; ++a)
#pragma unroll
            for (int b = 0; b < 2; ++b) asm volatile("" :: "v"(acc[a][b][0][0]), "v"(acc[a][b][0][1]), "v"(acc[a][b][1][0]), "v"(acc[a][b][1][1]), "v"(acc[a][b][2][0]), "v"(acc[a][b][2][1]), "v"(acc[a][b][3][0]), "v"(acc[a][b][3][1])); } } };
using EpiNull = EpiNull_<1>;
struct EpiBf16S {
    static constexpr bool PERM = true;
    bf16_t* O; int ldc; const float* bias; int bias_stride; float scale;
    __device__ __forceinline__ void operator()(const f32x4 (&acc)[2][2][4][2], const Unit& u, int wr, int wc, int fr, int fq) const {
        const int row0 = u.pm * BM + wr * 64 + fr; const int col0 = u.pn * BM + wc * 32 + 8 * fq;
        f32x4 bv[2][2];
#pragma unroll
        for (int bj = 0; bj < 2; ++bj)
#pragma unroll
            for (int n = 0; n < 2; ++n) bv[bj][n] = *(const f32x4*)(bias + (size_t)u.e * bias_stride + col0 + bj * HALF + 4 * n);
#pragma unroll
        for (int ai = 0; ai < 2; ++ai)
#pragma unroll
            for (int m = 0; m < 4; ++m) { bf16_t* rowp = O + (size_t)(row0 + ai * HALF + m * 16) * ldc + col0;
#pragma unroll
                for (int bj = 0; bj < 2; ++bj) { const f32x4 v0 = acc[ai][bj][m][0] * scale + bv[bj][0], v1 = acc[ai][bj][m][1] * scale + bv[bj][1];
                    u32x4 w; w.x = cvt_pk_bf16(v0[0], v0[1]); w.y = cvt_pk_bf16(v0[2], v0[3]); w.z = cvt_pk_bf16(v1[0], v1[1]); w.w = cvt_pk_bf16(v1[2], v1[3]);
                    *(u32x4*)(rowp + bj * HALF) = w; } }
    }
};

__device__ __forceinline__ i32x8 pg8_get8(const i32x32& v, int idx) { i32x8 r;
#pragma unroll
    for (int j = 0; j < 8; ++j) r[j] = v[8 * idx + j];
    return r; }
__device__ __forceinline__ i32x4 pg8_get4(const i32x32& v, int idx) { i32x4 r;
#pragma unroll
    for (int j = 0; j < 4; ++j) r[j] = v[4 * idx + j];
    return r; }
struct NoHost { static constexpr bool ON = false; static constexpr int N = 0; };
template <int N_> struct EpiHost {
    static constexpr bool ON = true; static constexpr int N = N_;
    const float* W; unsigned char* WT; int cid, cend, cstride; int ldw, cbs, gu, e0; int pend[N_];
    __device__ __forceinline__ void issue(unsigned (&x)[16 * N_], int lane) {
        const unsigned vo = (unsigned)lane * 4u; const size_t rowb = (size_t)ldw * 4;
#pragma unroll
        for (int j = 0; j < N_; ++j) { const int id = cid < cend ? cid : cend - 1; pend[j] = id; cid += cstride;
            const int cb = id & ((1 << cbs) - 1), kb = (id >> cbs) & 127, e = e0 + (id >> (cbs + 7));
            const char* rb = (const char*)(W + (size_t)e * DM * ldw + (size_t)(16 * kb) * ldw + 64 * cb);
#pragma unroll
            for (int i = 0; i < 16; ++i) asm volatile("s_nop 4\n\tglobal_load_dword %0, %1, %2" : "=v"(x[16 * j + i]) : "v"(vo), "s"(rb + (size_t)i * rowb) : "memory"); }
    }
    __device__ __forceinline__ void finish(const unsigned (&x)[16 * N_], int lane) const {
#pragma unroll
        for (int j = 0; j < N_; ++j) { const int id = pend[j]; const int cb = id & ((1 << cbs) - 1), kb = (id >> cbs) & 127, e = e0 + (id >> (cbs + 7)); const int n0 = 64 * cb;
            const int drow0 = !gu ? n0 : (n0 < 2048) ? (256 * (n0 >> 7) + (n0 & 127)) : (256 * ((n0 - 2048) >> 7) + 128 + ((n0 - 2048) & 127));
            u32x4 o;
#pragma unroll
            for (int q = 0; q < 4; ++q) o[q] = pk4_fp8(__builtin_bit_cast(float, x[16 * j + 4 * q]) * 512.0f, __builtin_bit_cast(float, x[16 * j + 4 * q + 1]) * 512.0f, __builtin_bit_cast(float, x[16 * j + 4 * q + 2]) * 512.0f, __builtin_bit_cast(float, x[16 * j + 4 * q + 3]) * 512.0f);
            *(u32x4*)(WT + (size_t)e * ldw * DM + (size_t)(drow0 + lane) * DM + 16 * kb) = o; }
    }
};
struct NoGather { static constexpr bool ON = false; };
struct Gather { static constexpr bool ON = true; const unsigned short* list; const LAS unsigned* pbase; const LAS unsigned* cnt; };
__device__ __forceinline__ unsigned gather_clamp(unsigned P, int r0, int cn) { const unsigned lo = (r0 < cn) ? (P & 0xffffu) : 0u, hi = (r0 + 64 < cn) ? (P >> 16) : 0u; return lo | (hi << 16); }
struct NoConv { static constexpr bool ON = false; };
struct ConvGU {
    static constexpr bool ON = true;
    const float* W; unsigned char* WT; int cid, cend, cstride, pend; const char* rbase;
    __device__ __forceinline__ void issue(unsigned (&x)[16], int lane) {
        const int id = cid < cend ? cid : cend - 1; pend = id; cid += cstride;
        const int e = id >> 13, kb = (id >> 6) & 127, cb = id & 63;
        const char* rb = (const char*)(W + (size_t)e * DM * 4096 + (size_t)(16 * kb) * 4096 + 64 * cb);
        const unsigned vo = (unsigned)lane * 4u; rbase = rb;
#pragma unroll
        for (int i = 0; i < 8; ++i) asm volatile("s_nop 4\n\tglobal_load_dword %0, %1, %2" : "=v"(x[i]) : "v"(vo), "s"(rb + (size_t)i * 16384) : "memory");
    }
    __device__ __forceinline__ void issue_b(unsigned (&x)[16], int lane) {
        const unsigned vo = (unsigned)lane * 4u;
#pragma unroll
        for (int i = 8; i < 16; ++i) asm volatile("s_nop 4\n\tglobal_load_dword %0, %1, %2" : "=v"(x[i]) : "v"(vo), "s"(rbase + (size_t)i * 16384) : "memory");
    }
    __device__ __forceinline__ void finish(const unsigned (&x)[16], int lane) const {
        const int id = pend; const int e = id >> 13, kb = (id >> 6) & 127, cb = id & 63; const int n0 = 64 * cb;
        const int drow0 = (n0 < 2048) ? (256 * (n0 >> 7) + (n0 & 127)) : (256 * ((n0 - 2048) >> 7) + 128 + ((n0 - 2048) & 127));
        u32x4 o;
#pragma unroll
        for (int q = 0; q < 4; ++q) o[q] = pk4_fp8(__builtin_bit_cast(float, x[4 * q]) * 512.0f, __builtin_bit_cast(float, x[4 * q + 1]) * 512.0f, __builtin_bit_cast(float, x[4 * q + 2]) * 512.0f, __builtin_bit_cast(float, x[4 * q + 3]) * 512.0f);
        *(u32x4*)(WT + (size_t)e * 4096 * DM + (size_t)(drow0 + lane) * DM + 16 * kb) = o;
    }
};
#define PG8_X16A(x, b) "+v"(x[b+0]), "+v"(x[b+1]), "+v"(x[b+2]), "+v"(x[b+3]), "+v"(x[b+4]), "+v"(x[b+5]), "+v"(x[b+6]), "+v"(x[b+7]), "+v"(x[b+8]), "+v"(x[b+9]), "+v"(x[b+10]), "+v"(x[b+11]), "+v"(x[b+12]), "+v"(x[b+13]), "+v"(x[b+14]), "+v"(x[b+15])
#define PG8_X16(x) "+v"(x[0]), "+v"(x[1]), "+v"(x[2]), "+v"(x[3]), "+v"(x[4]), "+v"(x[5]), "+v"(x[6]), "+v"(x[7]), "+v"(x[8]), "+v"(x[9]), "+v"(x[10]), "+v"(x[11]), "+v"(x[12]), "+v"(x[13]), "+v"(x[14]), "+v"(x[15])

template <class E, class = void> struct epi_nstores { static constexpr int value = 0; };
template <class E> struct epi_nstores<E, decltype((void)E::NSTORES)> { static constexpr int value = E::NSTORES; };
template <class E, class = void> struct epi_takes_bl { static constexpr bool value = false; };
template <class E> struct epi_takes_bl<E, decltype((void)E::BIAS_LDS)> { static constexpr bool value = true; };
template <class E, class = void> struct has_bias_lds { static constexpr bool value = false; };
template <class E> struct has_bias_lds<E, decltype((void)E::BIAS_LDS)> { static constexpr bool value = E::BIAS_LDS; };
constexpr int BIAS_LDS_OFF = MISC_OFF + 4096;
#ifndef CV_XMASK
#define CV_XMASK 0
#endif
template <class Epi, class Sched, class GS, bool ALIGN_EPI = true, bool F8 = false, int STAGGER_TICKS = 0, class CV = NoConv, class EH = NoHost, bool KROT = false, class GI = NoGather, bool FLP = false>
__device__ __forceinline__ void gemm_phase(LAS unsigned char* lds, const Gemm g, const Sched& S, const Epi& E, int wave, CV cv = CV(), EH eh = EH(), GI gi = GI()) {
    const int wid = wave, lane = fresh_lane(), tid = wid * 64 + lane, wr = wid >> 2, wc = wid & 3, fr = lane & 15, fq = lane >> 4;
    constexpr int nt = GS::KB / 128;
    unsigned voffA, voffB;
    { int R, C; stage_rc(tid * 16, R, C); const int Rb = Epi::PERM ? ((R & ~31) + perm32(R & 31)) : R;
      voffA = (unsigned)(R * GS::LDA + C * 2); voffB = (unsigned)(Rb * GS::LDB + C * 2);
      if constexpr (FLP) { const int b = tid * 16; voffA = (unsigned)((b >> 7) * GS::LDA + (b & 127)); voffB = (unsigned)((b >> 7) * GS::LDB + (b & 127)); } }
    constexpr size_t pstepA = (size_t)64 * GS::LDA, pstepB = (size_t)64 * GS::LDB;
    constexpr size_t kstep = (size_t)(BK * 2);
    constexpr size_t hstepA = (size_t)HALF * GS::LDA, hstepB = (size_t)HALF * GS::LDB;
    constexpr size_t tstepA = 2 * hstepA, tstepB = 2 * hstepB;
    const unsigned ldsw = (unsigned)wid * 1024u;
    const unsigned ldsb = (unsigned)(size_t)lds + ldsw;
    const int aoff = lds_byte(wr * 64 + fr, F8 ? fq * 16 : fq * 8), boff = lds_byte(wc * 32 + fr, F8 ? fq * 16 : fq * 8);
    const int kofs = F8 ? 16 : 1024;
#define PG8_SA(b, h) (((b) * 2 + (h)) * HTB)
#define PG8_SB(b, h) ((4 + (b) * 2 + (h)) * HTB)
#define PG8_STAGE(bufoff, gbase, voff) do { _Pragma("unroll") for (int _i = 0; _i < 2; ++_i) { unsigned _keep; \
        asm volatile("s_mov_b32 %0, m0\n\ts_mov_b32 m0, %3\n\ts_nop 3\n\tglobal_load_lds_dwordx4 %1, %2\n\ts_mov_b32 m0, %0" \
            : "=&s"(_keep) : "v"(voff##_v), "s"((const char*)(gbase) + _i * pstep##voff), "s"(ldsb + (unsigned)((bufoff) + _i * 8192)) : "memory"); } } while (0)
#define PG8_STAGE_GA(bufoff, kp, vlo, vhi) do { unsigned _keep; \
        asm volatile("s_mov_b32 %0, m0\n\ts_mov_b32 m0, %3\n\ts_nop 3\n\tglobal_load_lds_dwordx4 %1, %2\n\ts_mov_b32 m0, %0" : "=&s"(_keep) : "v"(vlo), "s"((const char*)(kp)), "s"(ldsb + (unsigned)(bufoff)) : "memory"); \
        asm volatile("s_mov_b32 %0, m0\n\ts_mov_b32 m0, %3\n\ts_nop 3\n\tglobal_load_lds_dwordx4 %1, %2\n\ts_mov_b32 m0, %0" : "=&s"(_keep) : "v"(vhi), "s"((const char*)(kp)), "s"(ldsb + (unsigned)((bufoff) + 8192)) : "memory"); } while (0)
#define PG8_STA(bufoff, kp, h, nx) do { if constexpr (GI::ON) { const unsigned _p = (nx) ? nvP[h] : voP[h]; const unsigned _lo = ((_p & 0xffffu) << 11) + gcb, _hi = ((_p >> 16) << 11) + gcb; PG8_STAGE_GA(bufoff, kp, _lo, _hi); } \
        else PG8_STAGE(bufoff, (kp) + (h) * hstepA, voffA); } while (0)
#define pstepvoffA pstepA
#define pstepvoffB pstepB
#define voffA_v voffA
#define voffB_v voffB
#define PG8_LD16(p) (*(const LAS i32x4*)(p))
#define PG8_SET8(V, idx, lo, hi) do { _Pragma("unroll") for (int _j = 0; _j < 4; ++_j) { V[8 * (idx) + _j] = (lo)[_j]; V[8 * (idx) + 4 + _j] = (hi)[_j]; } } while (0)
#define PG8_GET8(V, idx) pg8_get8(V, idx)
#define PG8_GETLO(V, idx) __builtin_bit_cast(bf16x8, pg8_get4(V, 2 * (idx)))
#define PG8_GETHI(V, idx) __builtin_bit_cast(bf16x8, pg8_get4(V, 2 * (idx) + 1))
#define PG8_LDA(dst, b, h) do { _Pragma("unroll") for (int m = 0; m < 4; ++m) { const i32x4 _lo = PG8_LD16(lds + PG8_SA(b, h) + aoff + m * 2048), _hi = PG8_LD16(lds + PG8_SA(b, h) + aoff + m * 2048 + kofs); \
        PG8_SET8(AV, m, _lo, _hi); } } while (0)
#define PG8_LDB(dst, b, h) do { _Pragma("unroll") for (int n = 0; n < 2; ++n) { const i32x4 _lo = PG8_LD16(lds + PG8_SB(b, h) + boff + n * 2048), _hi = PG8_LD16(lds + PG8_SB(b, h) + boff + n * 2048 + kofs); \
        PG8_SET8(BV, (dst) + n, _lo, _hi); } } while (0)
#define PG8_MMA(ai, bj, At, Bt) do { __builtin_amdgcn_s_setprio(1); \
        if constexpr (F8) { _Pragma("unroll") for (int m = 0; m < 4; ++m) _Pragma("unroll") for (int n = 0; n < 2; ++n) \
            acc[ai][bj][m][n] = __builtin_amdgcn_mfma_scale_f32_16x16x128_f8f6f4(PG8_GET8(BV, (Bt) + n), PG8_GET8(AV, m), acc[ai][bj][m][n], 0, 0, 0, 0, 0, 0); } \
        else { _Pragma("unroll") for (int m = 0; m < 4; ++m) _Pragma("unroll") for (int n = 0; n < 2; ++n) { \
            acc[ai][bj][m][n] = __builtin_amdgcn_mfma_f32_16x16x32_bf16(PG8_GETLO(BV, (Bt) + n), PG8_GETLO(AV, m), acc[ai][bj][m][n], 0, 0, 0); \
            acc[ai][bj][m][n] = __builtin_amdgcn_mfma_f32_16x16x32_bf16(PG8_GETHI(BV, (Bt) + n), PG8_GETHI(AV, m), acc[ai][bj][m][n], 0, 0, 0); } } \
        __builtin_amdgcn_s_setprio(0); } while (0)
#define PG8_WAIT_V(n) asm volatile("s_waitcnt vmcnt(" #n ")" ::: "memory")
#define PG8_WAIT_L(n) asm volatile("s_waitcnt lgkmcnt(" #n ")" ::: "memory")
#define PG8_BAR __builtin_amdgcn_s_barrier()
#define PG8_SCHED __builtin_amdgcn_sched_barrier(0)
    Unit cur, nxt; int ui = 0;
    if (!S.next(0, cur)) return;
    constexpr bool BL = has_bias_lds<Epi>::value;
    constexpr int NST = EH::ON ? EH::N : epi_nstores<Epi>::value;
#define PG8_WAIT_VN(n) asm volatile("s_waitcnt vmcnt(%0)" :: "n"(n) : "memory")
    static_assert(!(BL && CV::ON), "the counted waits below know one or the other");
    unsigned bx = 0;
    unsigned cx[16];
    if constexpr (CV::ON) { cv.issue(cx, lane); cv.issue_b(cx, lane); asm volatile("s_waitcnt vmcnt(0)" ::: "memory"); asm volatile("" : PG8_X16(cx) :: "memory"); }
    if constexpr (STAGGER_TICKS > 0) {
        if (blockIdx.x & 1) { const unsigned long long t0 = __builtin_amdgcn_s_memrealtime(); while (__builtin_amdgcn_s_memrealtime() - t0 < (unsigned long long)STAGGER_TICKS) __builtin_amdgcn_s_sleep(8); } }
    i32x32 AV, BV;
    constexpr int At = 0, B0 = 0, B1 = 2;
    static_assert(!GI::ON || GS::LDA == 2048, "gather: 2 KiB token rows");
    int tfetch = 0; if constexpr (GI::ON) asm volatile("s_mov_b32 %0, 0" : "=s"(tfetch));
    unsigned voP[2] = {0u, 0u}, nvP[2] = {0u, 0u}, gcb = 0u;
    if constexpr (GI::ON) { int R, C; stage_rc(tid * 16, R, C); gcb = (unsigned)(C * 2);
        const int lb = cur.pm * BM - __builtin_amdgcn_readfirstlane((int)gi.pbase[cur.e]), cn = __builtin_amdgcn_readfirstlane((int)gi.cnt[cur.e]);
        const u32x2 pr = *(const u32x2*)(gi.list + (size_t)cur.e * 16384 + lb + 4 * R);
        voP[0] = gather_clamp(pr.x, lb + R, cn); voP[1] = gather_clamp(pr.y, lb + R + 128, cn); }
    const char* cA = GI::ON ? (const char*)g.A : (const char*)g.A + (size_t)cur.pm * tstepA; const char* cB = (const char*)g.Bt + (size_t)cur.e * GS::SB + (size_t)cur.pn * tstepB;
#define PG8_KO(u) (KROT ? ((((u).pn & 7) * 2 + ((u).pm & 3) * 4) * (nt / 16)) & (nt - 1) : 0)
    int ko = PG8_KO(cur);
    { const char* pA = cA + (size_t)ko * kstep; const char* pB = cB + (size_t)ko * kstep;
    PG8_STAGE(PG8_SB(0, 0), pB, voffB); PG8_SCHED; PG8_STAGE(PG8_SB(0, 1), pB + hstepB, voffB); PG8_SCHED; PG8_STA(PG8_SA(0, 0), pA, 0, false); PG8_SCHED; PG8_STA(PG8_SA(0, 1), pA, 1, false); PG8_SCHED;
    if (wr == 1) PG8_BAR;
    PG8_WAIT_V(2); PG8_BAR;
    PG8_STAGE(PG8_SB(1, 0), pB + kstep, voffB); PG8_SCHED; PG8_STA(PG8_SA(1, 0), pA + kstep, 0, false); PG8_SCHED; PG8_STAGE(PG8_SB(1, 1), pB + hstepB + kstep, voffB); PG8_SCHED; }
    PG8_WAIT_V(6); PG8_BAR; PG8_SCHED;
    f32x4 acc[2][2][4][2];
#pragma unroll
    for (int a = 0; a < 2; ++a)
#pragma unroll
        for (int b = 0; b < 2; ++b)
#pragma unroll
            for (int m = 0; m < 4; ++m)
#pragma unroll
                for (int n = 0; n < 2; ++n) acc[a][b][m][n] = (f32x4){0.f, 0.f, 0.f, 0.f};
    for (;;) {
        const bool has_next = S.next(ui + 1, nxt);
        const char* nA = (has_next && !GI::ON) ? (const char*)g.A + (size_t)nxt.pm * tstepA : cA;
        const char* nB = has_next ? (const char*)g.Bt + (size_t)nxt.e * GS::SB + (size_t)nxt.pn * tstepB : cB;
        const int nko = has_next ? PG8_KO(nxt) : ko;
        for (int t = 0; t < nt; t += 2) {
            const bool last = (t == nt - 2);
            const int kt = KROT ? ((ko + t) & (nt - 1)) : t, kt2 = KROT ? ((ko + t + 2) & (nt - 1)) : t + 2;
            const char* a1 = cA + (size_t)(kt + 1) * kstep;
            const char* a2 = last ? nA + (size_t)nko * kstep : cA + (size_t)kt2 * kstep; const char* b2 = last ? nB + (size_t)nko * kstep : cB + (size_t)kt2 * kstep;
            const char* a3 = a2 + kstep; const char* b3 = b2 + kstep;
            PG8_LDB(B0, 0, 0); PG8_LDB(B1, 0, 1); PG8_SCHED; PG8_LDA(At, 0, 0); PG8_STA(PG8_SA(1, 1), a1, 1, false);
            PG8_WAIT_V(8);
            if constexpr (CV::ON) asm volatile("" : PG8_X16(cx));
            PG8_WAIT_L(0); PG8_BAR;
            const bool xon = CV::ON && ((t & CV_XMASK) == 0);
            if constexpr (CV::ON) { if (xon) { cv.finish(cx, lane); cv.issue(cx, lane); } }
            if constexpr (GI::ON) { if (t == tfetch && has_next) {
                int R, C; stage_rc((wid * 64 + fresh_lane()) * 16, R, C); const unsigned lvo = (unsigned)R * 8u;
                const char* lp = (const char*)(gi.list + (size_t)nxt.e * 16384 + (nxt.pm * BM - __builtin_amdgcn_readfirstlane((int)gi.pbase[nxt.e])));
                u32x2 pr; asm volatile("s_nop 4\n\tglobal_load_dwordx2 %0, %1, %2" : "=&v"(pr) : "v"(lvo), "s"(lp) : "memory"); nvP[0] = pr.x; nvP[1] = pr.y; } }
            if constexpr (BL) { if (last) { const unsigned bvo = Epi::bias_voff((wid * 64 + fresh_lane()) & 255);
                asm volatile("s_nop 4\n\tglobal_load_dword %0, %1, %2" : "=v"(bx) : "v"(bvo), "s"(E.bias_base(cur)) : "memory"); } }
            PG8_MMA(0, 0, At, B0); PG8_MMA(0, 1, At, B1); PG8_BAR; PG8_SCHED;
            PG8_LDA(At, 0, 1); PG8_STAGE(PG8_SB(0, 0), b2, voffB); PG8_STAGE(PG8_SB(0, 1), b2 + hstepB, voffB); PG8_STA(PG8_SA(0, 0), a2, 0, last);
            if (xon) PG8_WAIT_V(17); else if (BL && last) PG8_WAIT_V(9); else if (GI::ON && t == tfetch && has_next) PG8_WAIT_V(9); else PG8_WAIT_V(8);
            PG8_WAIT_L(0); PG8_BAR;
            if constexpr (CV::ON) { if (xon) cv.issue_b(cx, lane); }
            PG8_MMA(1, 0, At, B0); PG8_MMA(1, 1, At, B1); PG8_BAR; PG8_SCHED;
            PG8_LDB(B0, 1, 0); PG8_LDB(B1, 1, 1); PG8_SCHED; PG8_LDA(At, 1, 0); PG8_STA(PG8_SA(0, 1), a2, 1, last);
            if (xon) PG8_WAIT_V(25); else PG8_WAIT_V(8);
            if constexpr (GI::ON) { if (t == tfetch && has_next) { asm volatile("" : "+v"(nvP[0]), "+v"(nvP[1]));
                int R, C; stage_rc((wid * 64 + fresh_lane()) * 16, R, C); const int lb = nxt.pm * BM - __builtin_amdgcn_readfirstlane((int)gi.pbase[nxt.e]), cn = __builtin_amdgcn_readfirstlane((int)gi.cnt[nxt.e]);
                nvP[0] = gather_clamp(nvP[0], lb + R, cn); nvP[1] = gather_clamp(nvP[1], lb + R + 128, cn); } }
            if constexpr (BL) { if (last) { asm volatile("" : "+v"(bx));
                *(LAS unsigned*)(lds + BIAS_LDS_OFF + 4 * ((wid * 64 + fresh_lane()) & 255)) = bx; } }
            PG8_WAIT_L(0); PG8_BAR; PG8_MMA(0, 0, At, B0); PG8_MMA(0, 1, At, B1); PG8_BAR; PG8_SCHED;
            PG8_LDA(At, 1, 1); PG8_STAGE(PG8_SB(1, 0), b3, voffB); PG8_STAGE(PG8_SB(1, 1), b3 + hstepB, voffB); PG8_STA(PG8_SA(1, 0), a3, 0, last);
            if constexpr (CV::ON) { if (xon) PG8_WAIT_V(16); else PG8_WAIT_V(8); } else PG8_WAIT_V(8);
            PG8_WAIT_L(0); PG8_BAR; PG8_MMA(1, 0, At, B0); PG8_MMA(1, 1, At, B1); PG8_BAR; PG8_SCHED;
        }
        if constexpr (ALIGN_EPI) { if (wr == 0) PG8_BAR; }
        { const int l2 = fresh_lane();
          const LAS float* bl = (const LAS float*)(lds + BIAS_LDS_OFF);
          if constexpr (EH::ON) {
              unsigned ex[16 * EH::N]; typename Epi::Bias eb;
              if constexpr (BL) { eh.issue(ex, l2); E.load_bias(cur, wc, l2 >> 4, eb, bl); }
              else { E.load_bias(cur, wc, l2 >> 4, eb, bl); eb.pin(); eh.issue(ex, l2); }
              E.apply(acc, cur, wr, wc, l2 & 15, l2 >> 4, eb);
              asm volatile("s_waitcnt vmcnt(0)" ::: "memory");
              if constexpr (EH::N == 3) asm volatile("" : PG8_X16A(ex, 0), PG8_X16A(ex, 16), PG8_X16A(ex, 32) :: "memory");
              else asm volatile("" : PG8_X16A(ex, 0), PG8_X16A(ex, 16), PG8_X16A(ex, 32), PG8_X16A(ex, 48) :: "memory");
              eh.finish(ex, l2);
          } else if constexpr (epi_takes_bl<Epi>::value) E(acc, cur, wr, wc, l2 & 15, l2 >> 4, bl);
          else E(acc, cur, wr, wc, l2 & 15, l2 >> 4); }
        if (!has_next) break;
#pragma unroll
        for (int a = 0; a < 2; ++a)
#pragma unroll
            for (int b = 0; b < 2; ++b)
#pragma unroll
                for (int m = 0; m < 4; ++m)
#pragma unroll
                    for (int n = 0; n < 2; ++n) acc[a][b][m][n] = (f32x4){0.f, 0.f, 0.f, 0.f};
        cur = nxt; cA = nA; cB = nB; ko = nko; ++ui;
        if constexpr (GI::ON) {
#pragma unroll
            for (int i = 0; i < 2; ++i) voP[i] = nvP[i]; }
        if constexpr (ALIGN_EPI) { if (wr == 1) PG8_BAR; }
    }
    if constexpr (CV::ON) { asm volatile("s_waitcnt vmcnt(0)" ::: "memory"); asm volatile("" : PG8_X16(cx) :: "memory"); cv.finish(cx, lane); }
    else PG8_WAIT_V(0);
    if constexpr (!ALIGN_EPI) { if (wr == 0) PG8_BAR; }
    PG8_BAR;
#undef PG8_SA
#undef PG8_KO
#undef PG8_SB
#undef PG8_STAGE
#undef PG8_STAGE_GA
#undef PG8_STA
#undef pstepvoffA
#undef pstepvoffB
#undef voffA_v
#undef voffB_v
#undef PG8_LDA
#undef PG8_LD16
#undef PG8_SET8
#undef PG8_GET8
#undef PG8_GETLO
#undef PG8_GETHI
#undef PG8_LDB
#undef PG8_MMA
#undef PG8_WAIT_V
#undef PG8_WAIT_VN
#undef PG8_WAIT_L
#undef PG8_BAR
#undef PG8_SCHED
}
}
struct Params {
    const float* in[22];
    float* out; unsigned char* ws;
    int ph_lo, ph_hi;
};
enum { I_X = 0, I_NMG, I_WIN, I_GWG, I_GBG, I_GNG, I_CW, I_CB, I_WA, I_BA, I_WI, I_BI, I_AP, I_WOUT, I_NFG, I_WR, I_BR, I_WGU, I_BGU, I_WDN, I_BDN, I_NFINAL };

struct Frame {
    LAS unsigned char* lds; volatile LAS unsigned* MISC;
    int tid, lane, wave, G, gw, NGW;
    unsigned char* ws;
};

__device__ __forceinline__ float gelu_tanh_f(float x) {
    const float u = 0.7978845608028654f * (x + 0.044715f * x * x * x);
    const float e = __expf(2.0f * u);
    const float th = 1.0f - 2.0f * __builtin_amdgcn_rcpf(e + 1.0f);
    return 0.5f * x * (1.0f + th);
}
__device__ __forceinline__ float log_sigmoid_f(float s) { return fminf(s, 0.f) - __logf(1.0f + __expf(-fabsf(s))); }

__device__ __forceinline__ void p0_item(const float* W, int ldw, int col0, bf16_t* WT, int ldt, size_t drow0, int k0, LAS float* scr, int lane) {
    (void)scr;
    const float* src = W + (size_t)k0 * ldw + col0 + lane;
    float v[64];
#pragma unroll
    for (int i = 0; i < 64; ++i) v[i] = src[(size_t)i * ldw];
    bf16_t* dst = WT + (drow0 + lane) * (size_t)ldt + k0;
#pragma unroll
    for (int c = 0; c < 8; ++c) { u32x4 o; o.x = pk2(v[8 * c], v[8 * c + 1]); o.y = pk2(v[8 * c + 2], v[8 * c + 3]); o.z = pk2(v[8 * c + 4], v[8 * c + 5]); o.w = pk2(v[8 * c + 6], v[8 * c + 7]);
        *(u32x4*)(dst + 8 * c) = o; }
}

__device__ __forceinline__ void p0_item8(const float* W, int ldw, int col0, unsigned char* WT, int ldt, size_t drow0, int k0, int lane) {
    const float* src = W + (size_t)k0 * ldw + col0 + lane;
    float v[64];
#pragma unroll
    for (int i = 0; i < 64; ++i) v[i] = src[(size_t)i * ldw];
    unsigned char* dst = WT + (drow0 + lane) * (size_t)ldt + k0;
#pragma unroll
    for (int c = 0; c < 4; ++c) { u32x4 o;
#pragma unroll
        for (int q = 0; q < 4; ++q) o[q] = pk4_fp8(v[16 * c + 4 * q] * 512.0f, v[16 * c + 4 * q + 1] * 512.0f, v[16 * c + 4 * q + 2] * 512.0f, v[16 * c + 4 * q + 3] * 512.0f);
        *(u32x4*)(dst + 16 * c) = o; }
}

constexpr int CONV_EXPERTS_P0 = 28, HOST_DN_EXPERTS_P0 = 24;
struct CoopTile { const float* W; int ldw; int col0; unsigned char* WT; int ldt_b; int mode; int k0; int gu; int drow0; };
__device__ __forceinline__ void coop_load(const CoopTile& t, int w, int l, f32x4 (&v)[16]) {
    if (t.mode == 0) {
#pragma unroll
        for (int i = 0; i < 8; ++i) { const float* r = t.W + (size_t)(t.k0 + 8 * w + i) * t.ldw + t.col0 + 4 * l; v[2 * i] = *(const f32x4*)r; v[2 * i + 1] = *(const f32x4*)(r + 256); }
    } else {
#pragma unroll
        for (int i = 0; i < 16; ++i) v[i] = *(const f32x4*)(t.W + (size_t)(t.k0 + 16 * w + i) * t.ldw + t.col0 + 4 * l);
    }
}
__device__ __forceinline__ void coop_to_lds(const CoopTile& t, int w, int l, const f32x4 (&v)[16], LAS unsigned char* buf) {
    const int sw = (w ^ (l & 7)) * 16;
    if (t.mode == 0) {
#pragma unroll
        for (int jp = 0; jp < 2; ++jp)
#pragma unroll
            for (int j = 0; j < 4; ++j) { u32x4 o; if (t.ldw == INC) { o.x = PK2W(v[0 + jp][j], v[2 + jp][j]); o.y = PK2W(v[4 + jp][j], v[6 + jp][j]); o.z = PK2W(v[8 + jp][j], v[10 + jp][j]); o.w = PK2W(v[12 + jp][j], v[14 + jp][j]); } else { o.x = pk2(v[0 + jp][j], v[2 + jp][j]); o.y = pk2(v[4 + jp][j], v[6 + jp][j]); o.z = pk2(v[8 + jp][j], v[10 + jp][j]); o.w = pk2(v[12 + jp][j], v[14 + jp][j]); }
                *(LAS u32x4*)(buf + (256 * jp + 4 * l + j) * 128 + sw) = o; }
    } else {
#pragma unroll
        for (int j = 0; j < 4; ++j) { u32x4 o;
#pragma unroll
            for (int q = 0; q < 4; ++q) o[q] = pk4_fp8(v[4 * q][j] * 512.0f, v[4 * q + 1][j] * 512.0f, v[4 * q + 2][j] * 512.0f, v[4 * q + 3][j] * 512.0f);
            *(LAS u32x4*)(buf + (4 * l + j) * 128 + sw) = o; }
    }
}
__device__ __forceinline__ void coop_store(const CoopTile& t, int w, int l, const LAS unsigned char* buf) {
    const int nrows = t.mode == 0 ? 512 : 256; const int cp = l & 7;
    for (int n = 8 * w + (l >> 3); n < nrows; n += 64) {
        const u32x4 o = *(const LAS u32x4*)(buf + n * 128 + cp * 16); const int c = cp ^ ((n >> 2) & 7);
        int drow;
        if (t.gu) { const int g = t.col0 + n; drow = (g < 2048) ? (256 * (g >> 7) + (g & 127)) : (256 * ((g - 2048) >> 7) + 128 + ((g - 2048) & 127)); } else drow = t.drow0 + n;
        *(u32x4*)(t.WT + (size_t)drow * t.ldt_b + (t.mode == 0 ? 2 * t.k0 : t.k0) + 16 * c) = o; }
}
__device__ __forceinline__ bool coop_tile(const Params& p, unsigned char* ws, int it, CoopTile& t) {
    constexpr int N_GU = (32 - CONV_EXPERTS_P0) * 256, N_DN = (32 - HOST_DN_EXPERTS_P0) * 128, N_INA = 32 * 6, N_INB = 32 * 4, N_OUT = 32 * 4;
    int r = it;
    if (r < N_GU) { const int e = CONV_EXPERTS_P0 + (r >> 8), q = r & 255, kb = q >> 4, nb = q & 15; t = CoopTile{p.in[I_WGU] + (size_t)e * DM * 4096, 4096, 256 * nb, ws + WS_WGUT + (size_t)e * 4096 * DM, DM, 1, 128 * kb, 1, 0}; return true; } r -= N_GU;
    if (r < N_DN) { const int e = HOST_DN_EXPERTS_P0 + (r >> 7), q = r & 127, kb = q >> 3, nb = q & 7; t = CoopTile{p.in[I_WDN] + (size_t)e * DM * DM, DM, 256 * nb, ws + WS_WDT + (size_t)e * DM * DM, DM, 1, 128 * kb, 0, 256 * nb}; return true; } r -= N_DN;
    if (r < N_INA) { const int kb = r / 6, nb = r % 6; t = CoopTile{p.in[I_WIN], INC, 512 * nb, ws + WS_WINT, DM * 2, 0, 64 * kb, 0, 512 * nb}; return true; } r -= N_INA;
    if (r < N_INB) { const int kb = r >> 2, nb = r & 3; t = CoopTile{p.in[I_WIN], INC, 3088 + 512 * nb, ws + WS_WINT, DM * 2, 0, 64 * kb, 0, 3072 + 512 * nb}; return true; } r -= N_INB;
    if (r < N_OUT) { const int kb = r >> 2, nb = r & 3; t = CoopTile{p.in[I_WOUT], DM, 512 * nb, ws + WS_WOUTT, DM * 2, 0, 64 * kb, 0, 512 * nb}; return true; }
    return false;
}
__device__ __forceinline__ void p0a(Frame& F, const Params& p) {
    const int w = F.wave, l = F.lane;
    CoopTile cur, nxt; f32x4 v[16];
    int it = blockIdx.x; bool have = coop_tile(p, F.ws, it, cur);
    if (have) coop_load(cur, w, l, v);
    int par = 0;
    while (have) {
        LAS unsigned char* buf = F.lds + par * 65536;
        coop_to_lds(cur, w, l, v, buf);
        it += F.G; const bool hn = coop_tile(p, F.ws, it, nxt);
        if (hn) coop_load(nxt, w, l, v);
        __syncthreads();
        coop_store(cur, w, l, buf);
        cur = nxt; have = hn; par ^= 1;
    }
    __syncthreads();
    { bf16_t* WaT = (bf16_t*)(F.ws + WS_WAT); bf16_t* WiT = (bf16_t*)(F.ws + WS_WIT);
      for (int r = F.gw; r < 128; r += F.NGW) { const int which = r >> 6, h = (r >> 4) & 3, kb = (r >> 2) & 3, nb = r & 3;
          p0_item((which ? p.in[I_WI] : p.in[I_WA]) + (size_t)h * 65536, 256, 64 * nb, (which ? WiT : WaT) + (size_t)h * 65536, 256, (size_t)64 * nb, 64 * kb, nullptr, F.lane); } }
    { bf16_t* WglT = (bf16_t*)(F.ws + WS_WGLT); const float* w_in = p.in[I_WIN];
      for (int idx = (int)blockIdx.x * 512 + F.tid; idx < 16 * DM; idx += F.G * 512) { const int cc = idx >> 11, k = idx & 2047; WglT[idx] = (bf16_t)f2bf(w_in[(size_t)k * INC + 3072 + cc]); } }
    { float* WrT = (float*)(F.ws + WS_WRT); const float* wr = p.in[I_WR]; const float* gf = p.in[I_NFG];
      for (int idx = (int)blockIdx.x * 512 + F.tid; idx < 32 * DM; idx += F.G * 512) { const int n = idx >> 11, k = idx & 2047; WrT[idx] = wr[k * 32 + n] * gf[k]; } }
}
__device__ __forceinline__ void p0b(Frame& F, const Params& p) {
    const float* x = p.in[I_X]; const float* g1 = p.in[I_NMG]; bf16_t* H = (bf16_t*)(F.ws + WS_H);
    const int l = F.lane;
    f32x4 gv[8], xn[8];
#pragma unroll
    for (int j = 0; j < 4; ++j) { gv[2 * j] = *(const f32x4*)(g1 + 8 * l + 512 * j); gv[2 * j + 1] = *(const f32x4*)(g1 + 8 * l + 512 * j + 4); }
#pragma unroll
    for (int j = 0; j < 4; ++j) { xn[2 * j] = (F.gw < T) ? *(const f32x4*)(x + (size_t)F.gw * DM + 8 * l + 512 * j) : (f32x4){0.f, 0.f, 0.f, 0.f}; xn[2 * j + 1] = (F.gw < T) ? *(const f32x4*)(x + (size_t)F.gw * DM + 8 * l + 512 * j + 4) : (f32x4){0.f, 0.f, 0.f, 0.f}; }
    for (int m = F.gw; m < T; m += F.NGW) {
        f32x4 xv[8]; float ss = 0.f;
#pragma unroll
        for (int j = 0; j < 8; ++j) { xv[j] = xn[j]; ss += (xv[j][0] * xv[j][0] + xv[j][1] * xv[j][1]) + (xv[j][2] * xv[j][2] + xv[j][3] * xv[j][3]); }
        if (m + F.NGW < T) {
#pragma unroll
            for (int j = 0; j < 4; ++j) { xn[2 * j] = *(const f32x4*)(x + (size_t)(m + F.NGW) * DM + 8 * l + 512 * j); xn[2 * j + 1] = *(const f32x4*)(x + (size_t)(m + F.NGW) * DM + 8 * l + 512 * j + 4); } }
        const float rs = rsqrtf_(wave_sum(ss) * (1.0f / DM) + 1e-6f);
#pragma unroll
        for (int j = 0; j < 4; ++j) { const f32x4 a = xv[2 * j] * rs * gv[2 * j], b = xv[2 * j + 1] * rs * gv[2 * j + 1];
            u32x4 o; o.x = pk2(a[0], a[1]); o.y = pk2(a[2], a[3]); o.z = pk2(b[0], b[1]); o.w = pk2(b[2], b[3]);
            *(u32x4*)(H + (size_t)m * DM + 8 * l + 512 * j) = o;
#ifdef SIM_FP8
            o.x = PK2A(a[0], a[1]); o.y = PK2A(a[2], a[3]); o.z = PK2A(b[0], b[1]); o.w = PK2A(b[2], b[3]); *(u32x4*)((bf16_t*)(F.ws + WS_MIX) + (size_t)m * DM + 8 * l + 512 * j) = o;
#endif
            }
    }
}

__device__ __forceinline__ void gla_cumsum(const LAS float* GL, const float* wg, const float* bgp, int h, LAS float* BC, LAS float* SEG, int tid) {
    const int seg = tid >> 7, kk = tid & 127;
    float wcol[16];
#pragma unroll
    for (int c = 0; c < 16; ++c) wcol[c] = wg[c * 512 + h * 128 + kk];
    const float bcol = bgp[h * 128 + kk];
    float v[16];
#pragma unroll
    for (int i = 0; i < 16; ++i) { const LAS f32x4* g4 = (const LAS f32x4*)(GL + (16 * seg + i) * 16); float sacc = bcol;
#pragma unroll
        for (int c4 = 0; c4 < 4; ++c4) { const f32x4 gq = g4[c4]; sacc += gq[0] * wcol[4 * c4] + gq[1] * wcol[4 * c4 + 1] + gq[2] * wcol[4 * c4 + 2] + gq[3] * wcol[4 * c4 + 3]; }
        v[i] = log_sigmoid_f(sacc) * 0.0625f; }
#pragma unroll
    for (int i = 1; i < 16; ++i) v[i] += v[i - 1];
    SEG[seg * 128 + kk] = v[15];
    __syncthreads();
    float off = 0.f;
#pragma unroll
    for (int s = 0; s < 3; ++s) off += (s < seg) ? SEG[s * 128 + kk] : 0.f;
#pragma unroll
    for (int i = 0; i < 16; ++i) BC[(16 * seg + i) * 128 + kk] = v[i] + off;
    __syncthreads();
}
__device__ __forceinline__ bf16x8 as_bf16x8(u32x4 v) { return __builtin_bit_cast(bf16x8, v); }
__device__ __forceinline__ bf16x8 cat4(bf16x4 lo, bf16x4 hi) { return __builtin_shufflevector(lo, hi, 0, 1, 2, 3, 4, 5, 6, 7); }

__device__ __forceinline__ void p2a(Frame& F, const Params& p) {
    const bf16_t* Z = (const bf16_t*)(F.ws + WS_Z);
    bf16_t* AN = (bf16_t*)(F.ws + WS_AN); float* DN = (float*)(F.ws + WS_DN);
    const bf16_t* WaT = (const bf16_t*)(F.ws + WS_WAT); const bf16_t* WiT = (const bf16_t*)(F.ws + WS_WIT);
    LAS float* BC = (LAS float*)(F.lds); LAS float* SEG = (LAS float*)(F.lds + 32768);
    LAS bf16_t* KDT = (LAS bf16_t*)(F.lds + 34816); LAS bf16_t* VT = (LAS bf16_t*)(F.lds + 53248); LAS bf16_t* XC = (LAS bf16_t*)(F.lds + 90112);
    const int w = F.wave;
    LAS float* GLR = (LAS float*)(F.lds + 90112);
    LAS float* GL = (LAS float*)(F.lds + 124928);
    const float* wg = p.in[I_GWG]; const float* bgp = p.in[I_GBG];
    for (int unit = blockIdx.x; unit < NCHUNK; unit += F.G) {
        const int b = unit >> 7, n = unit & 127, tok0 = b * SEQL + 64 * n;
        {
            const int lane = fresh_lane(), r16 = lane & 15, q4 = lane >> 4;
            const bf16_t* Hb = (const bf16_t*)(F.ws + WS_H) + (size_t)(tok0 + r16) * DM + 256 * w + 8 * q4;
            const bf16_t* Wb = (const bf16_t*)(F.ws + WS_WGLT) + (size_t)r16 * DM + 256 * w + 8 * q4;
            f32x4 gacc[4];
#pragma unroll
            for (int mb = 0; mb < 4; ++mb) gacc[mb] = (f32x4){0.f, 0.f, 0.f, 0.f};
#pragma unroll
            for (int sb = 0; sb < 2; ++sb) { bf16x8 af[4][4], bfr[4];
#pragma unroll
                for (int s4 = 0; s4 < 4; ++s4) { bfr[s4] = *(const bf16x8*)(Wb + 32 * (4 * sb + s4));
#pragma unroll
                    for (int mb = 0; mb < 4; ++mb) af[s4][mb] = *(const bf16x8*)(Hb + (size_t)(16 * mb) * DM + 32 * (4 * sb + s4)); }
#pragma unroll
                for (int s4 = 0; s4 < 4; ++s4)
#pragma unroll
                    for (int mb = 0; mb < 4; ++mb) gacc[mb] = __builtin_amdgcn_mfma_f32_16x16x32_bf16(af[s4][mb], bfr[s4], gacc[mb], 0, 0, 0); }
#pragma unroll
            for (int mb = 0; mb < 4; ++mb)
#pragma unroll
                for (int q = 0; q < 4; ++q) GLR[(w * 64 + 16 * mb + 4 * q4 + q) * 16 + r16] = gacc[mb][q];
            __syncthreads();
            const int tid2 = w * 64 + lane;
#pragma unroll
            for (int it = 0; it < 2; ++it) { const int o = tid2 + 512 * it; float sacc = 0.f;
#pragma unroll
                for (int w2 = 0; w2 < 8; ++w2) sacc += GLR[w2 * 1024 + o];
                GL[o] = sacc; ((float*)(F.ws + WS_LG))[(size_t)tok0 * 16 + o] = sacc; }
            __syncthreads();
        }
        for (int h = 0; h < 4; ++h) {
            int lane = fresh_lane(), tid = F.wave * 64 + lane;
            int r = lane & 31, hh = lane >> 5;
            u32x4 kvr[2], vvr[4];
#pragma unroll
            for (int it = 0; it < 2; ++it) { const int item = tid + 512 * it, t = item & 63, kk8 = item >> 6; kvr[it] = *(const u32x4*)(Z + (size_t)(tok0 + t) * ZC + ZK + h * 128 + kk8 * 8); }
#pragma unroll
            for (int it = 0; it < 4; ++it) { const int item = tid + 512 * it, t = item & 63, vc8 = item >> 6; vvr[it] = *(const u32x4*)(Z + (size_t)(tok0 + t) * ZC + ZV + h * 256 + vc8 * 8); }
            gla_cumsum(GL, wg, bgp, h, BC, SEG, tid);
            const int uh = (b * 4 + h) * 128 + n;
            if (tid < 128) DN[(size_t)uh * 128 + tid] = __expf(BC[63 * 128 + tid]);
#pragma unroll
            for (int it = 0; it < 2; ++it) { const int item = tid + 512 * it, t = item & 63, kk8 = item >> 6;
                const u32x4 kv = kvr[it];
#pragma unroll
                for (int i = 0; i < 8; ++i) { const int kk = kk8 * 8 + i; const unsigned wv = kv[i >> 1]; const float kf = (i & 1) ? bfhi(wv) : bflo(wv);
                    const float d = __expf(BC[63 * 128 + kk] - BC[t * 128 + kk]); KDT[kk * 72 + t] = (bf16_t)f2bf(kf * d); } }
#pragma unroll
            for (int it = 0; it < 4; ++it) { const int item = tid + 512 * it, t = item & 63, vc8 = item >> 6;
                const u32x4 vv = vvr[it];
#pragma unroll
                for (int i = 0; i < 8; ++i) { const unsigned wv = vv[i >> 1]; VT[(vc8 * 8 + i) * 72 + t] = (bf16_t)((i & 1) ? (wv >> 16) : (wv & 0xffffu)); } }
#ifndef P2A_NO_LRU
            u32x4 lv[7]; f32x4 cwv[4][2], cbv[2];
            { const float* cw = p.in[I_CW]; const float* cb = p.in[I_CB]; const int c8 = tid & 31, tq = tid >> 5, chc = h * 256 + c8 * 8;
#pragma unroll
              for (int i = 0; i < 7; ++i) { const int sq = 64 * n + 4 * tq - 3 + i;
                  lv[i] = (sq >= 0) ? *(const u32x4*)(Z + (size_t)(tok0 + 4 * tq - 3 + i) * ZC + ZLX + chc) : (u32x4){0u, 0u, 0u, 0u}; }
#pragma unroll
              for (int i = 0; i < 4; ++i) { cwv[i][0] = *(const f32x4*)(cw + i * 1024 + chc); cwv[i][1] = *(const f32x4*)(cw + i * 1024 + chc + 4); }
              cbv[0] = *(const f32x4*)(cb + chc); cbv[1] = *(const f32x4*)(cb + chc + 4); }
#endif
            __syncthreads();
            {
                f32x16 acc[4];
#pragma unroll
                for (int mb = 0; mb < 4; ++mb)
#pragma unroll
                    for (int q = 0; q < 16; ++q) acc[mb][q] = 0.f;
#pragma unroll
                for (int s = 0; s < 4; ++s) { const bf16x8 bfr = *(const LAS bf16x8*)(VT + (32 * w + r) * 72 + 16 * s + 8 * hh);
#pragma unroll
                    for (int mb = 0; mb < 4; ++mb) { const bf16x8 afr = *(const LAS bf16x8*)(KDT + (32 * mb + r) * 72 + 16 * s + 8 * hh);
                        acc[mb] = __builtin_amdgcn_mfma_f32_32x32x16_bf16(afr, bfr, acc[mb], 0, 0, 0); } }
                bf16_t* base = AN + (size_t)uh * 32768;
#pragma unroll
                for (int mb = 0; mb < 4; ++mb)
#pragma unroll
                    for (int s2 = 0; s2 < 2; ++s2) { u32x4 o;
#pragma unroll
                        for (int q = 0; q < 4; ++q) o[q] = pk2(acc[mb][8 * s2 + 2 * q], acc[mb][8 * s2 + 2 * q + 1]);
                        *(u32x4*)(base + (((mb * 8 + w) * 2 + s2) * 64 + lane) * 8) = o; }
            }
#ifndef P2A_NO_LRU
            {
                {
                    const int c8 = tid & 31, tq = tid >> 5;
#pragma unroll
                    for (int it = 0; it < 4; ++it) { float xc[8];
#pragma unroll
                        for (int q = 0; q < 4; ++q) { xc[q] = cbv[0][q]; xc[4 + q] = cbv[1][q]; }
#pragma unroll
                        for (int i = 0; i < 4; ++i) { const u32x4 l4 = lv[it + i];
                            xc[0] += bflo(l4[0]) * cwv[i][0][0]; xc[1] += bfhi(l4[0]) * cwv[i][0][1]; xc[2] += bflo(l4[1]) * cwv[i][0][2]; xc[3] += bfhi(l4[1]) * cwv[i][0][3];
                            xc[4] += bflo(l4[2]) * cwv[i][1][0]; xc[5] += bfhi(l4[2]) * cwv[i][1][1]; xc[6] += bflo(l4[3]) * cwv[i][1][2]; xc[7] += bfhi(l4[3]) * cwv[i][1][3]; }
                        u32x4 o; o.x = pk2(xc[0], xc[1]); o.y = pk2(xc[2], xc[3]); o.z = pk2(xc[4], xc[5]); o.w = pk2(xc[6], xc[7]);
                        *(LAS u32x4*)(XC + (4 * tq + it) * 264 + c8 * 8) = o; }
                }
                __builtin_amdgcn_sched_barrier(0);
                bf16x8 ba[16], bi[16];
                { const bf16_t* wa = WaT + (size_t)h * 65536 + (size_t)(32 * w + r) * 256 + 8 * hh;
                  const bf16_t* wi = WiT + (size_t)h * 65536 + (size_t)(32 * w + r) * 256 + 8 * hh;
#pragma unroll
                  for (int s = 0; s < 16; ++s) { ba[s] = *(const bf16x8*)(wa + 16 * s); bi[s] = *(const bf16x8*)(wi + 16 * s); } }
                const int ch = h * 256 + 32 * w + r;
                const float ba_ = p.in[I_BA][ch], bi_ = p.in[I_BI][ch]; const float L = p.in[I_AP][ch];
                __syncthreads();
                f32x16 aa[2], ai[2];
#pragma unroll
                for (int mb = 0; mb < 2; ++mb)
#pragma unroll
                    for (int q = 0; q < 16; ++q) { aa[mb][q] = 0.f; ai[mb][q] = 0.f; }
#pragma unroll
                for (int s = 0; s < 16; ++s) {
#pragma unroll
                    for (int mb = 0; mb < 2; ++mb) { const bf16x8 af = *(const LAS bf16x8*)(XC + (32 * mb + r) * 264 + 16 * s + 8 * hh);
                        aa[mb] = __builtin_amdgcn_mfma_f32_32x32x16_bf16(af, ba[s], aa[mb], 0, 0, 0); } }
                __builtin_amdgcn_sched_barrier(0);
#pragma unroll
                for (int s = 0; s < 16; ++s) {
#pragma unroll
                    for (int mb = 0; mb < 2; ++mb) { const bf16x8 af = *(const LAS bf16x8*)(XC + (32 * mb + r) * 264 + 16 * s + 8 * hh);
                        ai[mb] = __builtin_amdgcn_mfma_f32_32x32x16_bf16(af, bi[s], ai[mb], 0, 0, 0); } }
                const float sp = fmaxf(-L, 0.f) + log1pf(__expf(-fabsf(L)));
#pragma unroll
                for (int mb = 0; mb < 2; ++mb)
#pragma unroll
                    for (int q = 0; q < 16; ++q) { const int t = 32 * mb + (q & 3) + 8 * (q >> 2) + 4 * hh;
                        if ((q & 3) == 0) __builtin_amdgcn_sched_barrier(0);
                        const float ga = sigmoidf_(aa[mb][q] + ba_), gi = sigmoidf_(ai[mb][q] + bi_);
                        const float la = -8.0f * ga * sp; const float a = __expf(la);
                        const float xcv = bf2f(XC[t * 264 + 32 * w + r]);
                        aa[mb][q] = a; ai[mb][q] = xcv * gi * __builtin_amdgcn_sqrtf(fmaxf(1.0f - a * a, 0.f)); }
#pragma unroll
                for (int mb = 0; mb < 2; ++mb)
#pragma unroll
                    for (int g = 0; g < 4; ++g)
#pragma unroll
                        for (int i = 1; i < 4; ++i) { const int q = 4 * g + i; ai[mb][q] = aa[mb][q] * ai[mb][q - 1] + ai[mb][q]; aa[mb][q] = aa[mb][q] * aa[mb][q - 1]; }
                LAS bf16_t* HL = (LAS bf16_t*)(F.lds); LAS bf16_t* AC = (LAS bf16_t*)(F.lds + 34816);
                float carryH = 0.f, carryP = 1.f;
#pragma unroll
                for (int mb = 0; mb < 2; ++mb)
#pragma unroll
                    for (int g = 0; g < 4; ++g) { const float myP = aa[mb][4 * g + 3], myH = ai[mb][4 * g + 3];
                        const float pP = __shfl_xor(myP, 32), pH = __shfl_xor(myH, 32);
                        const float fP = hh ? pP : myP, fH = hh ? pH : myH, sP = hh ? myP : pP, sH = hh ? myH : pH;
                        const float c1H = fP * carryH + fH, c1P = carryP * fP;
                        const float Cin = hh ? c1H : carryH, Pin = hh ? c1P : carryP;
                        carryH = sP * c1H + sH; carryP = c1P * sP;
#pragma unroll
                        for (int i = 0; i < 4; ++i) { const int q = 4 * g + i, t = 32 * mb + 8 * g + 4 * hh + i;
                            HL[t * 264 + 32 * w + r] = (bf16_t)f2bf(ai[mb][q] + aa[mb][q] * Cin); AC[t * 264 + 32 * w + r] = (bf16_t)f2bf(aa[mb][q] * Pin); } }
                if (hh == 0) { float* SUMA = (float*)(F.ws + WS_SUMA); float* SUMH = (float*)(F.ws + WS_SUMH); SUMA[unit * 1024 + ch] = carryP; SUMH[unit * 1024 + ch] = carryH; }
                __syncthreads();
                { bf16_t* HLOC = (bf16_t*)(F.ws + WS_AUA); bf16_t* ACUM = (bf16_t*)(F.ws + WS_AUU);
#pragma unroll
                  for (int it = 0; it < 4; ++it) { const int item = tid + 512 * it, c8 = item & 31, t = item >> 5; const size_t o = (size_t)(tok0 + t) * 1024 + h * 256 + c8 * 8;
                      *(u32x4*)(HLOC + o) = *(const LAS u32x4*)(HL + t * 264 + c8 * 8); *(u32x4*)(ACUM + o) = *(const LAS u32x4*)(AC + t * 264 + c8 * 8); } }
            }
#endif
            __syncthreads();
        }
    }
}

__device__ __forceinline__ void p2b(Frame& F, const Params& p) {
    const bf16_t* AN = (const bf16_t*)(F.ws + WS_AN); const float* DN = (const float*)(F.ws + WS_DN); bf16_t* SP = (bf16_t*)(F.ws + WS_SP);
    if (F.tid < 128) {
        for (int st = (int)blockIdx.x * 128 + F.tid; st < 32768; st += F.G * 128) {
            const int bh = st >> 12, rem = st & 4095, ln = rem & 63, s2 = (rem >> 6) & 1, w = (rem >> 7) & 7, mb = (rem >> 10) & 3;
            const int kk0 = 32 * mb + 16 * s2 + 4 * (ln >> 5);
            const int offS = (((mb * 8 + w) * 2 + s2) * 64 + ln) * 8;
            f32x4 S0 = (f32x4){0.f, 0.f, 0.f, 0.f}, S1 = S0;
            for (int n0 = 0; n0 < 128; n0 += 8) {
                u32x4 av[8]; f32x4 d0[8], d1[8];
#pragma unroll
                for (int i = 0; i < 8; ++i) { const size_t uh = (size_t)bh * 128 + n0 + i;
                    av[i] = *(const u32x4*)(AN + uh * 32768 + offS);
                    d0[i] = *(const f32x4*)(DN + uh * 128 + kk0); d1[i] = *(const f32x4*)(DN + uh * 128 + kk0 + 8); }
#pragma unroll
                for (int i = 0; i < 8; ++i) { const size_t uh = (size_t)bh * 128 + n0 + i;
                    u32x4 o; o.x = pk2(S0[0], S0[1]); o.y = pk2(S0[2], S0[3]); o.z = pk2(S1[0], S1[1]); o.w = pk2(S1[2], S1[3]);
                    *(u32x4*)(SP + uh * 32768 + offS) = o;
                    const f32x4 a0 = (f32x4){bflo(av[i].x), bfhi(av[i].x), bflo(av[i].y), bfhi(av[i].y)}, a1 = (f32x4){bflo(av[i].z), bfhi(av[i].z), bflo(av[i].w), bfhi(av[i].w)};
                    S0 = d0[i] * S0 + a0; S1 = d1[i] * S1 + a1; } }
        }
    } else if (F.wave == 2) {
        const float* SUMA = (const float*)(F.ws + WS_SUMA); float* SUMH = (float*)(F.ws + WS_SUMH);
        for (int wv = (int)blockIdx.x; wv < 64; wv += F.G) {
            const int seg = F.lane >> 4, sid = wv * 16 + (F.lane & 15), b = sid >> 9, ch = 2 * (sid & 511);
            const size_t o0 = (size_t)(b * 128 + seg * 32) * 1024 + ch;
            f32x2 a[32], hv[32];
#pragma unroll
            for (int q = 0; q < 32; ++q) { a[q] = *(const f32x2*)(SUMA + o0 + (size_t)q * 1024); hv[q] = *(const f32x2*)(SUMH + o0 + (size_t)q * 1024); }
            f32x2 A = (f32x2){1.f, 1.f}, H = (f32x2){0.f, 0.f};
#pragma unroll
            for (int q = 0; q < 32; ++q) { H = a[q] * H + hv[q]; A = a[q] * A; }
            f32x2 hc = (f32x2){0.f, 0.f};
#pragma unroll
            for (int k = 0; k < 3; ++k) { const int src = k * 16 + (F.lane & 15);
                const f32x2 Ak = (f32x2){__shfl(A.x, src), __shfl(A.y, src)}, Hk = (f32x2){__shfl(H.x, src), __shfl(H.y, src)};
                if (k < seg) hc = Ak * hc + Hk; }
#pragma unroll
            for (int q = 0; q < 32; ++q) { *(f32x2*)(SUMH + o0 + (size_t)q * 1024) = hc; hc = a[q] * hc + hv[q]; }
        }
    }
}

__device__ __forceinline__ void p2c(Frame& F, const Params& p) {
    const bf16_t* Z = (const bf16_t*)(F.ws + WS_Z); const float* GLOW = (const float*)(F.ws + WS_LG); const bf16_t* SP = (const bf16_t*)(F.ws + WS_SP);
    LAS float* GL = (LAS float*)(F.lds + 124928); const float* wg = p.in[I_GWG]; const float* bgp = p.in[I_GBG];
    bf16_t* MIX = (bf16_t*)(F.ws + WS_MIX);
    LAS float* BC = (LAS float*)(F.lds); LAS float* SEG = (LAS float*)(F.lds + 32768);
    LAS bf16_t* QE = (LAS bf16_t*)(F.lds + 34816); LAS bf16_t* KE = (LAS bf16_t*)(F.lds + 52224); LAS bf16_t* VT = (LAS bf16_t*)(F.lds + 69632);
    LAS float* SSQ = (LAS float*)(F.lds + 106496); LAS float* OS = (LAS float*)(F.lds);
    const int w = F.wave;
    const float* gng = p.in[I_GNG];
    for (int unit = blockIdx.x; unit < NCHUNK; unit += F.G) {
        const int b = unit >> 7, n = unit & 127, tok0 = b * SEQL + 64 * n;
        const int lane = fresh_lane(), tid = w * 64 + lane, r = lane & 31, hh = lane >> 5;
        { const float* SUMH = (const float*)(F.ws + WS_SUMH);
          const int ch = 2 * tid; const f32x2 hc = *(const f32x2*)(SUMH + (size_t)unit * 1024 + ch);
          const bf16_t* HLOC = (const bf16_t*)(F.ws + WS_AUA); const bf16_t* ACUM = (const bf16_t*)(F.ws + WS_AUU);
          for (int t0 = 0; t0 < 64; t0 += 16) {
              unsigned hv[16], av[16], lgw[16];
#pragma unroll
              for (int i = 0; i < 16; ++i) { const size_t tok = (size_t)tok0 + t0 + i;
                  hv[i] = *(const unsigned*)(HLOC + tok * 1024 + ch); av[i] = *(const unsigned*)(ACUM + tok * 1024 + ch); lgw[i] = *(const unsigned*)(Z + tok * ZC + ZLG + ch); }
#pragma unroll
              for (int i = 0; i < 16; ++i) { const size_t tok = (size_t)tok0 + t0 + i;
                  const float h0 = bflo(hv[i]) + bflo(av[i]) * hc.x, h1 = bfhi(hv[i]) + bfhi(av[i]) * hc.y;
                  *(unsigned*)(MIX + tok * DM + 1024 + ch) = pk2(h0 * gelu_tanh_f(bflo(lgw[i])), h1 * gelu_tanh_f(bfhi(lgw[i]))); } } }
        { const f32x2 gq = *(const f32x2*)(GLOW + (size_t)tok0 * 16 + 2 * tid); *(LAS f32x2*)(GL + 2 * tid) = gq; }
        __syncthreads();
        for (int h = 0; h < 4; ++h) {
            const int uh = (b * 4 + h) * 128 + n;
            u32x4 qvr[2], kvr[2], vvr[4];
#pragma unroll
            for (int it = 0; it < 2; ++it) { const int item = tid + 512 * it, kk8 = item & 15, t = item >> 4;
                qvr[it] = *(const u32x4*)(Z + (size_t)(tok0 + t) * ZC + ZQ + h * 128 + kk8 * 8); kvr[it] = *(const u32x4*)(Z + (size_t)(tok0 + t) * ZC + ZK + h * 128 + kk8 * 8); }
#pragma unroll
            for (int it = 0; it < 4; ++it) { const int item = tid + 512 * it, t = item & 63, vc8 = item >> 6; vvr[it] = *(const u32x4*)(Z + (size_t)(tok0 + t) * ZC + ZV + h * 256 + vc8 * 8); }
            gla_cumsum(GL, wg, bgp, h, BC, SEG, tid);
            bf16x8 sf[4][2];
            { const bf16_t* spu = SP + (size_t)uh * 32768;
#pragma unroll
              for (int mb = 0; mb < 4; ++mb)
#pragma unroll
                  for (int s2 = 0; s2 < 2; ++s2) sf[mb][s2] = *(const bf16x8*)(spu + (((mb * 8 + w) * 2 + s2) * 64 + lane) * 8); }
#pragma unroll
            for (int it = 0; it < 2; ++it) { const int item = tid + 512 * it, kk8 = item & 15, t = item >> 4;
                const u32x4 qv = qvr[it];
                const u32x4 kv = kvr[it];
                const f32x4 b0 = *(const LAS f32x4*)(BC + t * 128 + kk8 * 8), b1 = *(const LAS f32x4*)(BC + t * 128 + kk8 * 8 + 4);
                float qe[8], ke[8];
#pragma unroll
                for (int i = 0; i < 8; ++i) { const float bb = (i < 4) ? b0[i & 3] : b1[i & 3]; const unsigned qw = qv[i >> 1], kw = kv[i >> 1];
                    const float qf = (i & 1) ? bfhi(qw) : bflo(qw), kf = (i & 1) ? bfhi(kw) : bflo(kw);
                    qe[i] = qf * 0.08838834764831845f * __expf(bb); ke[i] = kf * __expf(-bb); }
                u32x4 oq, ok; oq.x = pk2(qe[0], qe[1]); oq.y = pk2(qe[2], qe[3]); oq.z = pk2(qe[4], qe[5]); oq.w = pk2(qe[6], qe[7]);
                ok.x = pk2(ke[0], ke[1]); ok.y = pk2(ke[2], ke[3]); ok.z = pk2(ke[4], ke[5]); ok.w = pk2(ke[6], ke[7]);
                *(LAS u32x4*)(QE + t * 136 + kk8 * 8) = oq; *(LAS u32x4*)(KE + t * 136 + kk8 * 8) = ok; }
#pragma unroll
            for (int it = 0; it < 4; ++it) { const int item = tid + 512 * it, t = item & 63, vc8 = item >> 6;
                const u32x4 vv = vvr[it];
#pragma unroll
                for (int i = 0; i < 8; ++i) { const unsigned wv = vv[i >> 1]; VT[(vc8 * 8 + i) * 72 + t] = (bf16_t)((i & 1) ? (wv >> 16) : (wv & 0xffffu)); } }
            __syncthreads();
            f32x16 oacc[2];
            {
                f32x16 P00, P01, P11;
#pragma unroll
                for (int q = 0; q < 16; ++q) { P00[q] = 0.f; P01[q] = 0.f; P11[q] = 0.f; oacc[0][q] = 0.f; oacc[1][q] = 0.f; }
#pragma unroll
                for (int s = 0; s < 8; ++s) {
                    const bf16x8 a0 = *(const LAS bf16x8*)(KE + r * 136 + 16 * s + 8 * hh), a1 = *(const LAS bf16x8*)(KE + (32 + r) * 136 + 16 * s + 8 * hh);
                    const bf16x8 b0 = *(const LAS bf16x8*)(QE + r * 136 + 16 * s + 8 * hh), b1 = *(const LAS bf16x8*)(QE + (32 + r) * 136 + 16 * s + 8 * hh);
                    P00 = __builtin_amdgcn_mfma_f32_32x32x16_bf16(a0, b0, P00, 0, 0, 0);
                    P01 = __builtin_amdgcn_mfma_f32_32x32x16_bf16(a0, b1, P01, 0, 0, 0);
                    P11 = __builtin_amdgcn_mfma_f32_32x32x16_bf16(a1, b1, P11, 0, 0, 0); }
#pragma unroll
                for (int q = 0; q < 16; ++q) { const int jl = (q & 3) + 8 * (q >> 2) + 4 * hh; if (jl > r) { P00[q] = 0.f; P11[q] = 0.f; } }
                bf16x8 F00[2], F01[2], F11[2];
#pragma unroll
                for (int s2 = 0; s2 < 2; ++s2) {
                    u32x4 t0, t1, t2;
#pragma unroll
                    for (int q = 0; q < 4; ++q) { t0[q] = pk2(P00[8 * s2 + 2 * q], P00[8 * s2 + 2 * q + 1]); t1[q] = pk2(P01[8 * s2 + 2 * q], P01[8 * s2 + 2 * q + 1]); t2[q] = pk2(P11[8 * s2 + 2 * q], P11[8 * s2 + 2 * q + 1]); }
                    F00[s2] = as_bf16x8(t0); F01[s2] = as_bf16x8(t1); F11[s2] = as_bf16x8(t2); }
#pragma unroll
                for (int mb = 0; mb < 4; ++mb)
#pragma unroll
                    for (int s2 = 0; s2 < 2; ++s2) { const bf16x8 af = sf[mb][s2];
                        const int kkb = 32 * mb + 16 * s2 + 4 * hh;
#pragma unroll
                        for (int ib = 0; ib < 2; ++ib) { const bf16x4 lo = *(const LAS bf16x4*)(QE + (32 * ib + r) * 136 + kkb), hi = *(const LAS bf16x4*)(QE + (32 * ib + r) * 136 + kkb + 8);
                            oacc[ib] = __builtin_amdgcn_mfma_f32_32x32x16_bf16(af, cat4(lo, hi), oacc[ib], 0, 0, 0); } }
#pragma unroll
                for (int s2 = 0; s2 < 2; ++s2) {
                    const int tb0 = 16 * s2 + 4 * hh, tb1 = 32 + 16 * s2 + 4 * hh;
                    const bf16x8 v0 = cat4(*(const LAS bf16x4*)(VT + (32 * w + r) * 72 + tb0), *(const LAS bf16x4*)(VT + (32 * w + r) * 72 + tb0 + 8));
                    const bf16x8 v1 = cat4(*(const LAS bf16x4*)(VT + (32 * w + r) * 72 + tb1), *(const LAS bf16x4*)(VT + (32 * w + r) * 72 + tb1 + 8));
                    oacc[0] = __builtin_amdgcn_mfma_f32_32x32x16_bf16(v0, F00[s2], oacc[0], 0, 0, 0);
                    oacc[1] = __builtin_amdgcn_mfma_f32_32x32x16_bf16(v0, F01[s2], oacc[1], 0, 0, 0);
                    oacc[1] = __builtin_amdgcn_mfma_f32_32x32x16_bf16(v1, F11[s2], oacc[1], 0, 0, 0); }
            }
            u32x4 rvr[4];
#pragma unroll
            for (int it = 0; it < 4; ++it) { const int item = tid + 512 * it, vc8 = item & 31, t = item >> 5; rvr[it] = *(const u32x4*)(Z + (size_t)(tok0 + t) * ZC + ZR + h * 256 + vc8 * 8); }
#pragma unroll
            for (int ib = 0; ib < 2; ++ib) { float sq = 0.f;
#pragma unroll
                for (int q = 0; q < 16; ++q) sq += oacc[ib][q] * oacc[ib][q];
                sq += __shfl_xor(sq, 32);
                if (hh == 0) SSQ[w * 64 + 32 * ib + r] = sq; }
            __syncthreads();
#pragma unroll
            for (int ib = 0; ib < 2; ++ib) { float tot = 0.f;
#pragma unroll
                for (int w2 = 0; w2 < 8; ++w2) tot += SSQ[w2 * 64 + 32 * ib + r];
                const float rs = rsqrtf_(tot * (1.0f / 256.0f) + 1e-6f);
#pragma unroll
                for (int g = 0; g < 4; ++g) *(LAS f32x4*)(OS + (32 * ib + r) * 260 + 32 * w + 8 * g + 4 * hh) =
                    (f32x4){oacc[ib][4 * g] * rs, oacc[ib][4 * g + 1] * rs, oacc[ib][4 * g + 2] * rs, oacc[ib][4 * g + 3] * rs}; }
            __syncthreads();
#pragma unroll
            for (int it = 0; it < 4; ++it) { const int item = tid + 512 * it, vc8 = item & 31, t = item >> 5; const int c = h * 256 + vc8 * 8;
                const f32x4 o0 = *(const LAS f32x4*)(OS + t * 260 + vc8 * 8), o1 = *(const LAS f32x4*)(OS + t * 260 + vc8 * 8 + 4);
                const u32x4 rv = rvr[it];
                const f32x4 g0 = *(const f32x4*)(gng + c), g1 = *(const f32x4*)(gng + c + 4);
                float o[8];
#pragma unroll
                for (int i = 0; i < 8; ++i) { const unsigned rw = rv[i >> 1]; const float rf = (i & 1) ? bfhi(rw) : bflo(rw);
                    const float sil = rf * sigmoidf_(rf); o[i] = sil * ((i < 4) ? o0[i & 3] * g0[i & 3] : o1[i & 3] * g1[i & 3]); }
                u32x4 ov; ov.x = pk2(o[0], o[1]); ov.y = pk2(o[2], o[3]); ov.z = pk2(o[4], o[5]); ov.w = pk2(o[6], o[7]);
                *(u32x4*)(MIX + (size_t)(tok0 + t) * DM + c) = ov; }
            __syncthreads();
        }
    }
}

__device__ __forceinline__ void build_moe_tables(Frame& F) {
    unsigned* cnt = (unsigned*)(F.ws + WS_CTL) + CW_CNT;
    if (F.tid < 64) {
        const int e = F.tid; const int c = (e < NEXP) ? (int)xb_ld(cnt + 64 * e) : 0; const int mt = (c + 255) >> 8;
        int inc = mt;
#pragma unroll
        for (int d = 1; d < 32; d <<= 1) { const int o = __shfl_up(inc, d); if ((e & 63) >= d) inc += o; }
        const int first = inc - mt;
        if (e < NEXP) { F.MISC[MI_PBASE + e] = (unsigned)(first * 256); F.MISC[MI_CNT + e] = (unsigned)c;
            for (int q = 0; q < mt; ++q) F.MISC[MI_T2E + first + q] = (unsigned)e;
            if (e == NEXP - 1) F.MISC[MI_NMT] = (unsigned)inc; }
    }
    __syncthreads();
}

__device__ __forceinline__ void p4a(Frame& F, const Params& p) {
    const bf16_t* XMID = (const bf16_t*)(F.ws + WS_XMID); const float* WrT = (const float*)(F.ws + WS_WRT); const float* br = p.in[I_BR];
    float* RSTD = (float*)(F.ws + WS_RSTD); unsigned* TOKE = (unsigned*)(F.ws + WS_TOKE); float* GATES = (float*)(F.ws + WS_GATES);
    unsigned* cnt = (unsigned*)(F.ws + WS_CTL) + CW_CNT;
    unsigned char* HF8 = F.ws + WS_HF8; unsigned short* LIST = (unsigned short*)(F.ws + WS_LIST); const float* gf = p.in[I_NFG];
    LAS float* RED = (LAS float*)(F.lds); LAS float* SSQ2 = (LAS float*)(F.lds + 32768); LAS float* LGT = (LAS float*)(F.lds + 33792); LAS float* RS = (LAS float*)(F.lds + 38016);
    const int tid = F.tid, lane = F.lane, w = F.wave, m = lane & 31, kh = lane >> 5;
    if (tid < 32) F.MISC[MI_LCNT + tid] = 0u;
    __syncthreads();
    f32x4 bw[32];
    { const float* bp = WrT + (size_t)m * DM + 256 * w + 128 * kh;
#pragma unroll
      for (int c = 0; c < 32; ++c) bw[c] = *(const f32x4*)(bp + 4 * c); }
    LAS float* RSA = (LAS float*)(F.lds + 38400);
    int ui = 0;
    for (int ut = blockIdx.x; ut < T / 32; ut += F.G, ++ui) {
        const int m0 = 32 * ut; const int kw = 256 * w + 128 * kh;
        f32x16 acc;
#pragma unroll
        for (int q = 0; q < 16; ++q) acc[q] = 0.f;
        float ss = 0.f;
        const bf16_t* ap = XMID + (size_t)(m0 + m) * DM + kw;
        u32x4 ar[16];
#pragma unroll
        for (int c = 0; c < 16; ++c) ar[c] = *(const u32x4*)(ap + 8 * c);
#pragma unroll
        for (int c = 0; c < 16; ++c) { const u32x4 r0 = ar[c];
            const f32x4 a0 = (f32x4){bflo(r0.x), bfhi(r0.x), bflo(r0.y), bfhi(r0.y)}, a1 = (f32x4){bflo(r0.z), bfhi(r0.z), bflo(r0.w), bfhi(r0.w)};
#pragma unroll
            for (int i = 0; i < 4; ++i) { acc = __builtin_amdgcn_mfma_f32_32x32x2f32(a0[i], bw[2 * c][i], acc, 0, 0, 0); ss += a0[i] * a0[i]; }
#pragma unroll
            for (int i = 0; i < 4; ++i) { acc = __builtin_amdgcn_mfma_f32_32x32x2f32(a1[i], bw[2 * c + 1][i], acc, 0, 0, 0); ss += a1[i] * a1[i]; } }
        ss += __shfl_xor(ss, 32);
#pragma unroll
        for (int q = 0; q < 16; ++q) RED[(w * 16 + q) * 64 + lane] = acc[q];
        if (kh == 0) SSQ2[w * 32 + m] = ss;
        __syncthreads();
#pragma unroll
        for (int it = 0; it < 2; ++it) { const int o = tid + 512 * it, reg = o >> 6, ln = o & 63, nn = ln & 31, h2 = ln >> 5; const int mm = (reg & 3) + 8 * (reg >> 2) + 4 * h2;
            float v = 0.f, s2 = 0.f;
#pragma unroll
            for (int w2 = 0; w2 < 8; ++w2) { v += RED[(w2 * 16 + reg) * 64 + ln]; s2 += SSQ2[w2 * 32 + mm]; }
            const float rs = rsqrtf_(s2 * (1.0f / DM) + 1e-6f);
            LGT[mm * 33 + nn] = v * rs + br[nn]; if (nn == 0) { RS[mm] = rs; RSA[32 * ui + mm] = rs; } }
        __syncthreads();
        int ex[4]; unsigned ls[4]; float gt[4];
        if (tid < 32) {
            float l[32];
#pragma unroll
            for (int i = 0; i < 32; ++i) l[i] = LGT[tid * 33 + i];
            float val[4];
#pragma unroll
            for (int k = 0; k < 4; ++k) { float best = -3.0e38f; int bi = 0;
#pragma unroll
                for (int i = 0; i < 32; ++i) if (l[i] > best) { best = l[i]; bi = i; }
                ex[k] = bi; val[k] = best;
#pragma unroll
                for (int i = 0; i < 32; ++i) if (i == bi) l[i] = -3.0e38f; }
            float s = 0.f;
#pragma unroll
            for (int k = 0; k < 4; ++k) { gt[k] = __expf(val[k] - val[0]); s += gt[k]; }
            const float inv = __builtin_amdgcn_rcpf(s);
#pragma unroll
            for (int k = 0; k < 4; ++k) { gt[k] *= inv; ls[k] = __hip_atomic_fetch_add((LAS unsigned*)(F.MISC + MI_LCNT + ex[k]), 1u, __ATOMIC_RELAXED, __HIP_MEMORY_SCOPE_WORKGROUP); }
        }
        __syncthreads();
        if (tid < 32) { const unsigned c = F.MISC[MI_LCNT + tid]; F.MISC[MI_LBASE + tid] = c ? xb_add(cnt + 64 * tid, c) : 0u; F.MISC[MI_LCNT + tid] = 0u; }
        __syncthreads();
        if (tid < 32) { const int tok = m0 + tid;
#pragma unroll
            for (int k = 0; k < 4; ++k) { const unsigned slot = F.MISC[MI_LBASE + ex[k]] + ls[k]; TOKE[tok * 4 + k] = (unsigned)ex[k] | (slot << 8); GATES[tok * 4 + k] = gt[k]; LIST[(size_t)ex[k] * 16384 + (slot & ~255u) + ((slot & 63u) << 2) + ((slot >> 6) & 3u)] = (unsigned short)tok; }
            RSTD[tok] = RS[tid]; }
        __syncthreads();
    }
    { const int ntok = 32 * ui; const int l = lane;
      f32x4 gv[8];
#pragma unroll
      for (int j = 0; j < 4; ++j) { gv[2 * j] = *(const f32x4*)(gf + 8 * l + 512 * j) * 16.0f; gv[2 * j + 1] = *(const f32x4*)(gf + 8 * l + 512 * j + 4) * 16.0f; }
      u32x4 xn[4];
      int jt = w;
      if (jt < ntok) { const size_t tk = (size_t)32 * (blockIdx.x + (jt >> 5) * F.G) + (jt & 31);
#pragma unroll
          for (int j = 0; j < 4; ++j) xn[j] = *(const u32x4*)(XMID + tk * DM + 8 * l + 512 * j); }
      for (; jt < ntok; jt += 8) {
          const size_t tk = (size_t)32 * (blockIdx.x + (jt >> 5) * F.G) + (jt & 31); const float rs = RSA[jt]; u32x2 o[4];
#pragma unroll
          for (int j = 0; j < 4; ++j) { const u32x4 xr = xn[j]; const f32x4 a = (f32x4){bflo(xr.x), bfhi(xr.x), bflo(xr.y), bfhi(xr.y)} * rs * gv[2 * j], b = (f32x4){bflo(xr.z), bfhi(xr.z), bflo(xr.w), bfhi(xr.w)} * rs * gv[2 * j + 1];
              o[j].x = pk4_fp8(a[0], a[1], a[2], a[3]); o[j].y = pk4_fp8(b[0], b[1], b[2], b[3]); }
          const int j2 = jt + 8;
          if (j2 < ntok) { const size_t t2 = (size_t)32 * (blockIdx.x + (j2 >> 5) * F.G) + (j2 & 31);
#pragma unroll
              for (int j = 0; j < 4; ++j) xn[j] = *(const u32x4*)(XMID + t2 * DM + 8 * l + 512 * j); }
#pragma unroll
          for (int j = 0; j < 4; ++j) *(u32x2*)(HF8 + tk * DM + 8 * l + 512 * j) = o[j]; } }
}

__device__ __forceinline__ void p4b(Frame& F, const Params& p) {
    build_moe_tables(F);
    const bf16_t* XMID = (const bf16_t*)(F.ws + WS_XMID); const float* RSTD = (const float*)(F.ws + WS_RSTD); const unsigned* TOKE = (const unsigned*)(F.ws + WS_TOKE);
    const float* gf = p.in[I_NFG]; unsigned char* ABUF = F.ws + WS_ABUF;
    const int l = F.lane;
    u32x4 xn[4]; float rsn = 0.f; unsigned ten[4] = {0u, 0u, 0u, 0u};
    if (F.gw < T) { rsn = RSTD[F.gw];
#pragma unroll
        for (int k = 0; k < 4; ++k) ten[k] = TOKE[F.gw * 4 + k];
#pragma unroll
        for (int j = 0; j < 4; ++j) xn[j] = *(const u32x4*)(XMID + (size_t)F.gw * DM + 8 * l + 512 * j); }
    f32x4 gv[8];
#pragma unroll
    for (int j = 0; j < 4; ++j) { gv[2 * j] = *(const f32x4*)(gf + 8 * l + 512 * j) * 16.0f; gv[2 * j + 1] = *(const f32x4*)(gf + 8 * l + 512 * j + 4) * 16.0f; }
    for (int tok = F.gw; tok < T; tok += F.NGW) {
        const float rs = rsn; unsigned te[4]; u32x2 o[4];
#pragma unroll
        for (int k = 0; k < 4; ++k) te[k] = ten[k];
#pragma unroll
        for (int j = 0; j < 4; ++j) { const u32x4 xr = xn[j]; const f32x4 a = (f32x4){bflo(xr.x), bfhi(xr.x), bflo(xr.y), bfhi(xr.y)} * rs * gv[2 * j], b = (f32x4){bflo(xr.z), bfhi(xr.z), bflo(xr.w), bfhi(xr.w)} * rs * gv[2 * j + 1];
            o[j].x = pk4_fp8(a[0], a[1], a[2], a[3]); o[j].y = pk4_fp8(b[0], b[1], b[2], b[3]); }
        const int t2 = tok + F.NGW;
        if (t2 < T) { rsn = RSTD[t2];
#pragma unroll
            for (int k = 0; k < 4; ++k) ten[k] = TOKE[t2 * 4 + k];
#pragma unroll
            for (int j = 0; j < 4; ++j) xn[j] = *(const u32x4*)(XMID + (size_t)t2 * DM + 8 * l + 512 * j); }
#pragma unroll
        for (int k = 0; k < 4; ++k) { const size_t row = (size_t)F.MISC[MI_PBASE + (te[k] & 255u)] + (te[k] >> 8);
#pragma unroll
            for (int j = 0; j < 4; ++j) *(u32x2*)(ABUF + row * DM + 8 * l + 512 * j) = o[j]; }
    }
}

__device__ __forceinline__ void p7(Frame& F, const Params& p) {
    build_moe_tables(F);
    const bf16_t* XMID = (const bf16_t*)(F.ws + WS_XMID); const unsigned* TOKE = (const unsigned*)(F.ws + WS_TOKE); const float* GATES = (const float*)(F.ws + WS_GATES);
    const unsigned char* Y = F.ws + WS_Y; const float* gfin = p.in[I_NFINAL];
    const int l = F.lane;
    u32x4 xn[4]; u32x2 yn[4][4]; float gkn[4] = {0.f, 0.f, 0.f, 0.f};
#define P7_FETCH(tk) do { \
        _Pragma("unroll") for (int k = 0; k < 4; ++k) { const unsigned te = TOKE[(tk) * 4 + k]; gkn[k] = GATES[(tk) * 4 + k]; const size_t row = (size_t)F.MISC[MI_PBASE + (te & 255u)] + (te >> 8); \
            _Pragma("unroll") for (int j = 0; j < 4; ++j) yn[k][j] = *(const u32x2*)(Y + row * DM + 8 * l + 512 * j); } \
        _Pragma("unroll") for (int j = 0; j < 4; ++j) xn[j] = *(const u32x4*)(XMID + (size_t)(tk) * DM + 8 * l + 512 * j); } while (0)
    if (F.gw < T) P7_FETCH(F.gw);
    f32x4 g0[4], g1[4];
#pragma unroll
    for (int j = 0; j < 4; ++j) { g0[j] = *(const f32x4*)(gfin + 8 * l + 512 * j); g1[j] = *(const f32x4*)(gfin + 8 * l + 512 * j + 4); }
    for (int tok = F.gw; tok < T; tok += F.NGW) {
        f32x4 xv[8];
#pragma unroll
        for (int j = 0; j < 4; ++j) { const u32x4 xr = xn[j]; xv[2 * j] = (f32x4){bflo(xr.x), bfhi(xr.x), bflo(xr.y), bfhi(xr.y)}; xv[2 * j + 1] = (f32x4){bflo(xr.z), bfhi(xr.z), bflo(xr.w), bfhi(xr.w)}; }
#pragma unroll
        for (int k = 0; k < 4; ++k)
#pragma unroll
            for (int j = 0; j < 4; ++j) { const u32x2 y2 = yn[k][j]; const float gk = gkn[k] * (1.0f / 32.0f);
                xv[2 * j][0] += gk * fp8f(y2.x, 0); xv[2 * j][1] += gk * fp8f(y2.x, 1); xv[2 * j][2] += gk * fp8f(y2.x, 2); xv[2 * j][3] += gk * fp8f(y2.x, 3);
                xv[2 * j + 1][0] += gk * fp8f(y2.y, 0); xv[2 * j + 1][1] += gk * fp8f(y2.y, 1); xv[2 * j + 1][2] += gk * fp8f(y2.y, 2); xv[2 * j + 1][3] += gk * fp8f(y2.y, 3); }
        const int t2 = tok + F.NGW;
        if (t2 < T) P7_FETCH(t2);
        float ss = 0.f;
#pragma unroll
        for (int j = 0; j < 8; ++j) ss += (xv[j][0] * xv[j][0] + xv[j][1] * xv[j][1]) + (xv[j][2] * xv[j][2] + xv[j][3] * xv[j][3]);
        const float rs = rsqrtf_(wave_sum(ss) * (1.0f / DM) + 1e-6f);
#pragma unroll
        for (int j = 0; j < 4; ++j) { *(f32x4*)(p.out + (size_t)tok * DM + 8 * l + 512 * j) = xv[2 * j] * rs * g0[j]; *(f32x4*)(p.out + (size_t)tok * DM + 8 * l + 512 * j + 4) = xv[2 * j + 1] * rs * g1[j]; }
    }
#undef P7_FETCH
}

#ifdef PROBE_STREAM
__device__ __forceinline__ void probe_stream(Frame& F, const Params& p) {
    const f32x4* src = (const f32x4*)p.in[I_WGU]; const size_t n4 = (size_t)32 * 2048 * 4096 / 4;
    const f32x4* src2 = (const f32x4*)p.in[I_WDN]; const size_t m4 = (size_t)32 * 2048 * 2048 / 4;
    f32x4 acc = (f32x4){0.f, 0.f, 0.f, 0.f};
    for (size_t base = (size_t)F.gw * 1024; base < n4; base += (size_t)F.NGW * 1024) {
        f32x4 v[16];
#pragma unroll
        for (int i = 0; i < 16; ++i) v[i] = src[base + i * 64 + F.lane];
#pragma unroll
        for (int i = 0; i < 16; ++i) acc += v[i]; }
    for (size_t base = (size_t)F.gw * 1024; base < m4; base += (size_t)F.NGW * 1024) {
        f32x4 v[16];
#pragma unroll
        for (int i = 0; i < 16; ++i) v[i] = src2[base + i * 64 + F.lane];
#pragma unroll
        for (int i = 0; i < 16; ++i) acc += v[i]; }
    if (acc[0] + acc[1] + acc[2] + acc[3] == 12345.678f) p.out[0] = 1.0f;
}
#endif
#ifdef PROBE_ORDER
__device__ __forceinline__ void probe_order(Frame& F, const Params& p) {
    volatile LAS unsigned* flag = F.MISC + 2000;
    if (F.wave < 4) {
        const unsigned* hot = (const unsigned*)p.in[I_X] + (size_t)blockIdx.x * 16384;
        unsigned idx = F.tid & 255, sm = 0;
        for (int it = 0; it < 600; ++it) {
            const unsigned b = idx * 4 + (it & 3) * 1024;
            const unsigned v0 = hot[b & 16383], v1 = hot[(b + 4096) & 16383], v2 = hot[(b + 8192) & 16383], v3 = hot[(b + 12288) & 16383];
            sm += v0 + v1 + v2 + v3; idx = (idx + (sm & 3)) & 255;
        }
        if (sm == 0x12345678u) p.out[0] = 1.0f;
        *flag = 1u;
    } else {
#if PROBE_ORDER == 2
        const f32x4* src = (const f32x4*)p.in[I_WGU];
        f32x4 acc = (f32x4){0.f, 0.f, 0.f, 0.f}; unsigned it = 0;
        const unsigned sw = blockIdx.x * 4 + (F.wave - 4);
        while (*flag == 0u) {
            const size_t base = (((size_t)it * 1024 + sw) * 1024) & (((size_t)1 << 26) - 1);
            f32x4 v[16];
#pragma unroll
            for (int i = 0; i < 16; ++i) v[i] = src[base + i * 64 + F.lane];
#pragma unroll
            for (int i = 0; i < 16; ++i) acc += v[i];
            ++it;
        }
        if (acc[0] + acc[1] + acc[2] + acc[3] == 12345.678f) p.out[1] = 1.0f;
#endif
    }
    __syncthreads();
}
#endif
constexpr int NPHASE = 11;
constexpr int HOST_DN_EXPERTS = 24;
constexpr int CONV_EXPERTS = 28, CONV_END = CONV_EXPERTS * 8192, CONV_P1 = 2048 * 81;
#ifndef KROT5
#define KROT5 false
#endif
#ifndef KROT6
#define KROT6 false
#endif
#ifndef STAG5
#define STAG5 0
#endif
#ifndef STAG6
#define STAG6 0
#endif
__global__ void __launch_bounds__(512, 2) mk_fwd(Params p) {
    extern __shared__ __attribute__((aligned(16))) unsigned char lds_raw[];
    Frame F;
    F.lds = (LAS unsigned char*)lds_raw; F.MISC = (volatile LAS unsigned*)(F.lds + MISC_OFF);
    F.wave = __builtin_amdgcn_readfirstlane((int)threadIdx.x >> 6);
#define FRESH() do { F.lane = fresh_lane(); F.tid = F.wave * 64 + F.lane; } while (0)
    FRESH();
    F.G = gridDim.x; F.gw = (int)blockIdx.x * 8 + F.wave; F.NGW = F.G * 8; F.ws = p.ws;
    for (int u = F.tid; u < (LDS_BYTES - MISC_OFF) / 4; u += 512) F.MISC[u] = 0u;
    __syncthreads();
    const int lo = p.ph_lo, hi = p.ph_hi;
    XcdBarrier bar; bar.bar = (unsigned*)(F.ws + WS_CTL) + CW_BAR; bar.x = 0; bar.st = F.MISC;
    if (hi - lo > 1) bar = xcd_barrier_post((unsigned*)(F.ws + WS_CTL) + CW_BAR, F.MISC, F.tid == 0);
#ifndef PHASE_MASK
#define PHASE_MASK 0x7ff
#endif
#define IN(k) (((PHASE_MASK >> (k)) & 1) && lo <= (k) && (k) < hi)
#define SEAM(k) do { if (IN(k) && IN((k) + 1)) xcd_barrier(bar, F.wave == 0 && fresh_lane() == 0); } while (0)
#ifndef REPEAT_MASK
#define REPEAT_MASK 0
#endif
#define REP(k) for (int rep_ = 0; rep_ < (((REPEAT_MASK >> (k)) & 1) ? 2 : 1); ++rep_)
    LAS unsigned char* ring = F.lds;
#ifdef PROBE_STREAM
    if (IN(0)) { probe_stream(F, p); }
#endif
#ifdef PROBE_ORDER
    if (IN(0)) { probe_order(F, p); }
#endif
    if (IN(0)) { REP(11) { FRESH(); p0a(F, p); } REP(12) { FRESH(); p0b(F, p); } SEAM(0); }
    if (IN(1)) REP(1) {

#ifdef SIM_FP8
        pg8::Gemm g{F.ws + WS_MIX, F.ws + WS_WINT};
#else
        pg8::Gemm g{F.ws + WS_H, F.ws + WS_WINT};
#endif
 using GS = pg8::GShape<DM * 2, DM * 2, DM * 2, 0>; pg8::StaticOrder S; S.init(T, ZC, F.G, (int)blockIdx.x);
        pg8::EpiBf16 E{(bf16_t*)(F.ws + WS_Z), ZC, nullptr, 0};
        pg8::ConvGU cv{p.in[I_WGU], F.ws + WS_WGUT, F.gw, CONV_END, F.NGW, 0};
        pg8::gemm_phase<pg8::EpiBf16, pg8::StaticOrder, GS, true, false, 0, pg8::ConvGU>(ring, g, S, E, F.wave, cv); SEAM(1); }
    if (IN(2)) REP(2) { FRESH(); p2a(F, p); SEAM(2); }
    if (IN(3)) REP(3) { FRESH(); p2b(F, p); SEAM(3); }
    if (IN(4)) REP(4) { FRESH(); p2c(F, p); SEAM(4); }
    if (IN(5)) REP(5) {
        pg8::Gemm g{F.ws + WS_MIX, F.ws + WS_WOUTT}; using GS = pg8::GShape<DM * 2, DM * 2, DM * 2, 0>; pg8::StaticOrder S; S.init(T, DM, F.G, (int)blockIdx.x);
        pg8::EpiBf16Res E{(bf16_t*)(F.ws + WS_XMID), p.in[I_X], DM};
        pg8::ConvGU cv{p.in[I_WGU], F.ws + WS_WGUT, CONV_P1 + F.gw, CONV_END, F.NGW, 0};
        pg8::gemm_phase<pg8::EpiBf16Res, pg8::StaticOrder, GS, true, false, 0, pg8::ConvGU>(ring, g, S, E, F.wave, cv); SEAM(5); }
    if (IN(6)) { FRESH(); p4a(F, p); SEAM(6); }
    if (IN(8)) {
        FRESH(); build_moe_tables(F);
        pg8::Gemm g{F.ws + WS_HF8, F.ws + WS_WGUT}; using GS = pg8::GShape<DM, DM, DM, (size_t)4096 * DM>;
        pg8::MoeOrder S{__builtin_amdgcn_readfirstlane((int)F.MISC[MI_NMT]), 16, F.G, (int)blockIdx.x, (const LAS int*)(F.lds + MISC_OFF + 4 * MI_T2E)};
        pg8::EpiSwiGLU8 E{F.ws + WS_ACT, DM, p.in[I_BGU]};
        pg8::Gather gi{(const unsigned short*)(F.ws + WS_LIST), (const LAS unsigned*)(F.lds + MISC_OFF + 4 * MI_PBASE), (const LAS unsigned*)(F.lds + MISC_OFF + 4 * MI_CNT)};
        pg8::EpiHost<3> eh{p.in[I_WDN], F.ws + WS_WDT, F.gw, HOST_DN_EXPERTS * 4096, F.NGW, DM, 5, 0, 0, {0, 0, 0}};
        pg8::gemm_phase<pg8::EpiSwiGLU8, pg8::MoeOrder, GS, true, true, STAG5, pg8::NoConv, pg8::EpiHost<3>, KROT5, pg8::Gather>(ring, g, S, E, F.wave, pg8::NoConv(), eh, gi); SEAM(8); }
#if (REPEAT_MASK & 0x100)
    if (IN(8)) {
        FRESH(); build_moe_tables(F);
        pg8::Gemm g{F.ws + WS_ABUF, F.ws + WS_WGUT}; using GS = pg8::GShape<DM, DM, DM, (size_t)4096 * DM>;
        pg8::MoeOrder S{__builtin_amdgcn_readfirstlane((int)F.MISC[MI_NMT]), 16, F.G, (int)blockIdx.x, (const LAS int*)(F.lds + MISC_OFF + 4 * MI_T2E)};
        pg8::EpiSwiGLU8 E{F.ws + WS_Y, DM, p.in[I_BGU]};
#if P5DUP == 2
        pg8::Gemm g2{F.ws + WS_HF8, F.ws + WS_WGUT};
        pg8::Gather gi{(const unsigned short*)(F.ws + WS_LIST), (const LAS unsigned*)(F.lds + MISC_OFF + 4 * MI_PBASE), (const LAS unsigned*)(F.lds + MISC_OFF + 4 * MI_CNT)};
        pg8::gemm_phase<pg8::EpiSwiGLU8, pg8::MoeOrder, GS, true, true, STAG5, pg8::NoConv, pg8::NoHost, false, pg8::Gather>(ring, g2, S, E, F.wave, pg8::NoConv(), pg8::NoHost(), gi); SEAM(8); }
#else
        pg8::gemm_phase<pg8::EpiSwiGLU8, pg8::MoeOrder, GS, true, true, STAG5>(ring, g, S, E, F.wave); SEAM(8); }
#endif
#endif
    if (IN(9)) {
        FRESH(); build_moe_tables(F);
        pg8::Gemm g{F.ws + WS_ACT, F.ws + WS_WDT}; using GS = pg8::GShape<DM, DM, DM, (size_t)DM * DM>;
        pg8::MoeOrder S{__builtin_amdgcn_readfirstlane((int)F.MISC[MI_NMT]), 8, F.G, (int)blockIdx.x, (const LAS int*)(F.lds + MISC_OFF + 4 * MI_T2E)};
        pg8::EpiFp8S E{F.ws + WS_Y, DM, p.in[I_BDN], DM, 1.0f / 2048.0f, 32.0f};
        pg8::gemm_phase<pg8::EpiFp8S, pg8::MoeOrder, GS, true, true, STAG6, pg8::NoConv, pg8::NoHost, KROT6>(ring, g, S, E, F.wave); SEAM(9); }
#if (REPEAT_MASK & 0x200)
    if (IN(9)) {
        FRESH(); build_moe_tables(F);
#ifdef P6_PITCH
        pg8::Gemm g{F.ws + WS_ACT, F.ws + WS_WDT}; using GS = pg8::GShape<P6_PITCH, P6_PITCH, DM, (size_t)DM * DM>;
#else
        pg8::Gemm g{F.ws + WS_ACT, F.ws + WS_WDT}; using GS = pg8::GShape<DM, DM, DM, (size_t)DM * DM>;
#endif
        pg8::MoeOrder S{__builtin_amdgcn_readfirstlane((int)F.MISC[MI_NMT]), 8, F.G, (int)blockIdx.x, (const LAS int*)(F.lds + MISC_OFF + 4 * MI_T2E)};
#ifdef P6_NOSTORE
        pg8::EpiNull_<P6_NOSTORE - 1> E{};

#ifndef P6_FLP
#define P6_FLP false
#endif
        pg8::gemm_phase<pg8::EpiNull_<P6_NOSTORE - 1>, pg8::MoeOrder, GS, true, true, STAG6, pg8::NoConv, pg8::NoHost, false, pg8::NoGather, P6_FLP>(ring, g, S, E, F.wave); SEAM(9); }
#elif defined(P6_MODE)
        pg8::EpiFp8S_<P6_MODE> E{F.ws + WS_Y, DM, p.in[I_BDN], DM, 1.0f / 2048.0f, 32.0f};
        pg8::gemm_phase<pg8::EpiFp8S_<P6_MODE>, pg8::MoeOrder, GS, true, true, STAG6>(ring, g, S, E, F.wave); SEAM(9); }
#else
        pg8::EpiFp8S E{F.ws + WS_Y, DM, p.in[I_BDN], DM, 1.0f / 2048.0f, 32.0f};
        pg8::gemm_phase<pg8::EpiFp8S, pg8::MoeOrder, GS, true, true, STAG6>(ring, g, S, E, F.wave); SEAM(9); }
#endif
#endif
    if (IN(10)) REP(10) { FRESH(); p7(F, p); if (((REPEAT_MASK >> 10) & 1)) xcd_barrier(bar, F.wave == 0 && fresh_lane() == 0); }
#undef IN
#undef SEAM
}
#ifndef STAGE
#define STAGE 4
#endif
#ifndef PER_PHASE_LAUNCH
#define PER_PHASE_LAUNCH 0
#endif

#if STAGE < 4
__global__ void adapt_z_kernel(const bf16_t* Z, float* z) {
    const long idx = (long)blockIdx.x * blockDim.x + threadIdx.x; const long t = idx / ZC; const int c = (int)(idx % ZC);
    z[t * INC + (c < 3072 ? c : c + 16)] = bf2f(Z[idx]);
}
__global__ void adapt_bf16_kernel(const bf16_t* src, float* dst) { const long idx = (long)blockIdx.x * blockDim.x + threadIdx.x; dst[idx] = bf2f(src[idx]); }
#endif

static void launch_mk(Params& a, int lo, int hi, int grid, hipStream_t stream) {
#if PER_PHASE_LAUNCH
    for (int k = lo; k < hi; ++k) { a.ph_lo = k; a.ph_hi = k + 1; hipLaunchKernelGGL(mk_fwd, dim3(grid), dim3(512), LDS_BYTES, stream, a); }
#else
    a.ph_lo = lo; a.ph_hi = hi; hipLaunchKernelGGL(mk_fwd, dim3(grid), dim3(512), LDS_BYTES, stream, a);
#endif
}

extern "C" void kernel_launch(void* const* d_in, const int* in_sizes, int n_in, void* d_out, int out_size, void* d_ws, size_t ws_size, hipStream_t stream) {
    static int grid = 0;
    if (grid == 0) {
        int dev = 0, cus = 0;
        if (hipGetDevice(&dev) != hipSuccess || hipDeviceGetAttribute(&cus, hipDeviceAttributeMultiprocessorCount, dev) != hipSuccess) { grid = -1; return; }
        if (hipFuncSetAttribute((const void*)mk_fwd, hipFuncAttributeMaxDynamicSharedMemorySize, LDS_BYTES) != hipSuccess) { grid = -1; return; }
        int per_cu = 0;
        (void)hipOccupancyMaxActiveBlocksPerMultiprocessor(&per_cu, (const void*)mk_fwd, 512, LDS_BYTES);
        (void)hipGetLastError();
        grid = cus < 256 ? cus : 256;
        if (per_cu < 1) fprintf(stderr, "kernel_launch: occupancy query reports %d\n", per_cu);
    }
    if (grid < 0) return;
    (void)hipMemsetAsync((char*)d_ws + WS_CTL, 0, CTL_ZERO_BYTES, stream);
    Params a{};
    for (int i = 0; i < 22; ++i) a.in[i] = (const float*)d_in[i];
    a.out = (float*)d_out; a.ws = (unsigned char*)d_ws;
#if STAGE >= 4
    launch_mk(a, 0, NPHASE, grid, stream);
#else
    const float* x = a.in[I_X];
    char* ws = (char*)d_ws + WS_ABUF; size_t off = 0;
    auto alloc = [&](size_t bytes) { void* p = ws + off; off += (bytes + 255) & ~(size_t)255; return p; };
    int* counts = (int*)alloc(256);
    float* z = (float*)alloc((size_t)T * INC * 4);
    float* ogla = (float*)alloc((size_t)T * 1024 * 4);
    float* xc = (float*)alloc((size_t)T * 1024 * 4);
    float* za = (float*)alloc((size_t)T * 1024 * 4);
    float* zi = (float*)alloc((size_t)T * 1024 * 4);
    float* mix = (float*)alloc((size_t)T * DM * 4);
    float* xmid = (float*)alloc((size_t)T * DM * 4);
    float* hf = (float*)alloc((size_t)T * DM * 4);
    float* logits = (float*)alloc((size_t)T * 32 * 4);
    float* gates = (float*)alloc((size_t)T * 4 * 4);
    int* list = (int*)alloc((size_t)NEXP * T * 4);
    float* act = (float*)alloc((size_t)T * 4 * DM * 4);
    float* y = (float*)alloc((size_t)T * 4 * DM * 4);
    (void)hipMemsetAsync(counts, 0, 256, stream);
#if STAGE == 1
    launch_mk(a, 0, 2, grid, stream);
    adapt_z_kernel<<<(unsigned)((size_t)T * ZC / 256), 256, 0, stream>>>((const bf16_t*)((char*)d_ws + WS_Z), z);
    gla_naive_kernel<<<64, 256, 0, stream>>>(z, (const float*)((char*)d_ws + WS_LG), ogla);
    gla_out_kernel<<<T, 256, 0, stream>>>(ogla, z, a.in[I_GNG], mix);
    lru_conv_kernel<<<T * 1024 / 256, 256, 0, stream>>>(z, a.in[I_CW], a.in[I_CB], xc);
    for (int h = 0; h < 4; ++h) {
        GemmArgs g{}; g.A = xc + h * 256; g.lda = 1024; g.ldb = 256; g.ldc = 1024; g.M = T; g.N = 256; g.K = 256; g.a_div = 1;
        g.B = a.in[I_WA] + (size_t)h * 65536; g.C = za + h * 256;
        sgemm_kernel<0><<<dim3(2, T / 128, 1), 256, 0, stream>>>(g);
        g.B = a.in[I_WI] + (size_t)h * 65536; g.C = zi + h * 256;
        sgemm_kernel<0><<<dim3(2, T / 128, 1), 256, 0, stream>>>(g);
    }
    lru_gate_kernel<<<T * 1024 / 256, 256, 0, stream>>>(xc, za, zi, a.in[I_BA], a.in[I_BI], a.in[I_AP]);
    lru_scan_kernel<<<2048 / 64, 64, 0, stream>>>(za, zi, z, mix);
#endif
#if STAGE == 2
    launch_mk(a, 0, 5, grid, stream);
    adapt_bf16_kernel<<<(unsigned)((size_t)T * DM / 256), 256, 0, stream>>>((const bf16_t*)((char*)d_ws + WS_MIX), mix);
#endif
#if STAGE <= 2
    { GemmArgs g{}; g.A = mix; g.lda = DM; g.B = a.in[I_WOUT]; g.ldb = DM; g.C = xmid; g.ldc = DM; g.M = T; g.N = DM; g.K = DM; g.a_div = 1; g.resid = x; g.ldr = DM;
      sgemm_kernel<1><<<dim3(DM / 128, T / 128, 1), 256, 0, stream>>>(g); }
#else
    launch_mk(a, 0, 6, grid, stream);
    xmid = (float*)((char*)d_ws + WS_XMID);
#endif
    rmsnorm_kernel<<<T, 256, 0, stream>>>(xmid, a.in[I_NFG], hf);
    { GemmArgs g{}; g.A = hf; g.lda = DM; g.B = a.in[I_WR]; g.ldb = 32; g.C = logits; g.ldc = 32; g.M = T; g.N = 32; g.K = DM; g.a_div = 1; g.bias = a.in[I_BR];
      sgemm_kernel<0><<<dim3(1, T / 128, 1), 256, 0, stream>>>(g); }
    route_kernel<<<T / 256, 256, 0, stream>>>(logits, counts, list, gates);
    { GemmArgs g{}; g.A = hf; g.lda = DM; g.B = a.in[I_WGU]; g.ldb = 4096; g.C = act; g.ldc = DM; g.M = 0; g.N = 4096; g.K = DM; g.a_div = 4; g.bias = a.in[I_BGU];
      g.rowlist = list; g.count = counts; g.strideB_e = (long)DM * 4096; g.strideBias_e = 4096; g.list_stride = T;
      sgemm_kernel<2><<<dim3(2048 / 64, T / 128, NEXP), 256, 0, stream>>>(g); }
    { GemmArgs g{}; g.A = act; g.lda = DM; g.B = a.in[I_WDN]; g.ldb = DM; g.C = y; g.ldc = DM; g.M = 0; g.N = DM; g.K = DM; g.a_div = 1; g.bias = a.in[I_BDN];
      g.rowlist = list; g.count = counts; g.strideB_e = (long)DM * DM; g.strideBias_e = DM; g.list_stride = T;
      sgemm_kernel<0><<<dim3(DM / 128, T / 128, NEXP), 256, 0, stream>>>(g); }
    final_kernel<<<T, 256, 0, stream>>>(xmid, y, gates, a.in[I_NFINAL], (float*)d_out);
#endif
}
```

```cpp
#define STAGE 4
#define PER_PHASE_LAUNCH 0
#define REPEAT_MASK 0
#include <hip/hip_runtime.h>
#include <stdint.h>
#include <stdio.h>

#define GAS __attribute__((address_space(1)))
#define LAS __attribute__((address_space(3)))
typedef unsigned short bf16_t;
typedef short bf16x8 __attribute__((ext_vector_type(8)));
typedef short bf16x4 __attribute__((ext_vector_type(4)));
typedef float f32x4 __attribute__((ext_vector_type(4)));
typedef float f32x2 __attribute__((ext_vector_type(2)));
typedef float f32x16 __attribute__((ext_vector_type(16)));
typedef unsigned u32x4 __attribute__((ext_vector_type(4)));
typedef unsigned u32x2 __attribute__((ext_vector_type(2)));
typedef int i32x8 __attribute__((ext_vector_type(8)));
typedef int i32x4 __attribute__((ext_vector_type(4)));
typedef int i32x32 __attribute__((ext_vector_type(32)));

constexpr int T = 16384, SEQL = 8192, DM = 2048, INC = 5136, ZC = 5120, NEXP = 32;
constexpr int ZQ = 0, ZK = 512, ZV = 1024, ZR = 2048, ZLX = 3072, ZLG = 4096;
constexpr int MPAD_MAX = 65536 + NEXP * 256;
constexpr int NCHUNK = 256;

constexpr size_t MiB = 1u << 20;
constexpr size_t WS_CTL = 0, CTL_ZERO_BYTES = 128 * 1024;
constexpr size_t WS_WINT = 1 * MiB;
constexpr size_t WS_WOUTT = WS_WINT + 20 * MiB;
constexpr size_t WS_WGUT = WS_WOUTT + 8 * MiB;
constexpr size_t WS_WDT = WS_WGUT + 512 * MiB;
constexpr size_t WS_WAT = WS_WDT + 256 * MiB;
constexpr size_t WS_WIT = WS_WAT + 512 * 1024;
constexpr size_t WS_WRT = WS_WIT + 512 * 1024;
constexpr size_t WS_WGLT = WS_WRT + 512 * 1024;
constexpr size_t WS_H = WS_WRT + 1 * MiB;
constexpr size_t WS_LG = WS_H + 64 * MiB;
constexpr size_t WS_Z = WS_LG + 32 * MiB;
constexpr size_t WS_AN = WS_Z + 160 * MiB;
constexpr size_t WS_DN = WS_AN + 128 * MiB;
constexpr size_t WS_SP = WS_DN + 1 * MiB;
constexpr size_t WS_AUA = WS_SP + 64 * MiB;
constexpr size_t WS_AUU = WS_AUA + 64 * MiB;
constexpr size_t WS_SUMA = WS_AUU + 64 * MiB;
constexpr size_t WS_SUMH = WS_SUMA + 1 * MiB;
constexpr size_t WS_MIX = WS_SUMH + 1 * MiB;
constexpr size_t WS_XMID = WS_MIX + 64 * MiB;
constexpr size_t WS_RSTD = WS_XMID + 128 * MiB;
constexpr size_t WS_TOKE = WS_RSTD + 1 * MiB;
constexpr size_t WS_GATES = WS_TOKE + 1 * MiB;
constexpr size_t WS_ABUF = WS_GATES + 1 * MiB;
constexpr size_t WS_HF8 = WS_ABUF, WS_LIST = WS_ABUF + 64 * MiB;
constexpr size_t WS_ACT = WS_ABUF + 288 * MiB;
constexpr size_t WS_Y = WS_ACT + 288 * MiB;
constexpr size_t WS_END = WS_Y + 288 * MiB;
constexpr int CW_BAR = 4096;
constexpr int CW_CNT = 16384;

constexpr int RING_BYTES = 131072;
constexpr int SCR_BYTES = 135168;
constexpr int MISC_OFF = SCR_BYTES;
constexpr int LDS_BYTES = 147456;
constexpr int MI_PBASE = 16, MI_NMT = 48, MI_LCNT = 64, MI_LBASE = 96, MI_T2E = 128, MI_CNT = 480;

#define LDS_WAIT() asm volatile("s_waitcnt lgkmcnt(0)" ::: "memory")
#define VM_WAIT() asm volatile("s_waitcnt vmcnt(0)" ::: "memory")

typedef __bf16 bf16v2_t __attribute__((ext_vector_type(2)));
__device__ __forceinline__ unsigned pk2(float lo, float hi) { const f32x2 v = {lo, hi}; return __builtin_bit_cast(unsigned, __builtin_convertvector(v, bf16v2_t)); }
#ifdef SIM_FP8
__device__ __forceinline__ float q8_(float x, float sc) { int p = 0; p = __builtin_amdgcn_cvt_pk_fp8_f32(__builtin_amdgcn_fmed3f(x * sc, -448.0f, 448.0f), 0.0f, p, false); return __builtin_amdgcn_cvt_f32_fp8(p, 0) * (1.0f / sc); }
#define PK2A(a, b) pk2(q8_(a, 16.0f), q8_(b, 16.0f))
#define PK2W(a, b) pk2(q8_(a, 512.0f), q8_(b, 512.0f))
#else
#define PK2A(a, b) pk2(a, b)
#define PK2W(a, b) pk2(a, b)
#endif
__device__ __forceinline__ unsigned f2bf(float f) { return pk2(f, 0.0f) & 0xffffu; }
__device__ __forceinline__ float bf2f(unsigned short b) { return __builtin_bit_cast(float, (unsigned)b << 16); }
__device__ __forceinline__ float bflo(unsigned w) { return __builtin_bit_cast(float, w << 16); }
__device__ __forceinline__ float bfhi(unsigned w) { return __builtin_bit_cast(float, w & 0xffff0000u); }
__device__ __forceinline__ float clamp448(float x) { return __builtin_amdgcn_fmed3f(x, -448.0f, 448.0f); }
__device__ __forceinline__ unsigned pk4_fp8(float a, float b, float c, float d) {
    int p = 0; p = __builtin_amdgcn_cvt_pk_fp8_f32(clamp448(a), clamp448(b), p, false); p = __builtin_amdgcn_cvt_pk_fp8_f32(clamp448(c), clamp448(d), p, true); return (unsigned)p; }
__device__ __forceinline__ unsigned pk4_fp8_nc(float a, float b, float c, float d) {
    int p = 0; p = __builtin_amdgcn_cvt_pk_fp8_f32(a, b, p, false); p = __builtin_amdgcn_cvt_pk_fp8_f32(c, d, p, true); return (unsigned)p; }
__device__ __forceinline__ float fp8f(unsigned w, int b) { return b == 0 ? __builtin_amdgcn_cvt_f32_fp8((int)w, 0) : b == 1 ? __builtin_amdgcn_cvt_f32_fp8((int)w, 1) : b == 2 ? __builtin_amdgcn_cvt_f32_fp8((int)w, 2) : __builtin_amdgcn_cvt_f32_fp8((int)w, 3); }
__device__ __forceinline__ float wave_sum(float v) {
#pragma unroll
    for (int o = 1; o < 64; o <<= 1) v += __shfl_xor(v, o);
    return v;
}
__device__ __forceinline__ int fresh_lane() { int l; asm volatile("v_mbcnt_lo_u32_b32 %0, -1, 0\n\tv_mbcnt_hi_u32_b32 %0, -1, %0" : "=v"(l)); return l; }
__device__ __forceinline__ float sigmoidf_(float x) { return __builtin_amdgcn_rcpf(1.0f + __expf(-x)); }
__device__ __forceinline__ float rsqrtf_(float x) { return __builtin_amdgcn_rsqf(x); }

#define XB_TMO      128
#define XB_XCNT(j)  (256  + 64 * (j))
#define XB_XSUB(j)  (1280 + 64 * (j))
#define XB_XGEN(j)  (2304 + 64 * (j))
#define XB_TOP      3328
#define XB_TOPGEN   3392
#define XCD_BAR_WORDS 3456
#define XB_SPIN_CAP (1u << 18)

__device__ __forceinline__ unsigned xb_ld(unsigned* p)              { return __hip_atomic_load(p, __ATOMIC_RELAXED, __HIP_MEMORY_SCOPE_AGENT); }
__device__ __forceinline__ unsigned xb_add(unsigned* p, unsigned v) { return __hip_atomic_fetch_add(p, v, __ATOMIC_RELAXED, __HIP_MEMORY_SCOPE_AGENT); }
__device__ __forceinline__ unsigned xb_xcc_id() { return (unsigned)__builtin_amdgcn_s_getreg((3 << 11) | 20) & 0xFu; }
#define XB_SPIN(cond, bar) do { unsigned _sp = 0; while (cond) { __builtin_amdgcn_s_sleep(1); \
    if ((++_sp & 255u) == 0u) { if (xb_ld(&(bar)[XB_TMO])) break; if (_sp > XB_SPIN_CAP) { atomicAdd(&(bar)[XB_TMO], 1u); break; } } } } while (0)

struct XcdBarrier { unsigned* bar; unsigned x; volatile LAS unsigned* st; };

__device__ __forceinline__ XcdBarrier xcd_barrier_post(unsigned* bar, volatile LAS unsigned* st, bool t0) {
    XcdBarrier b; b.bar = bar; b.x = xb_xcc_id(); b.st = st;
    if (t0) (void)xb_add(&bar[XB_XCNT(b.x)], 1u);
    return b;
}
__device__ __forceinline__ void xcd_barrier_complete(unsigned* bar, unsigned x, unsigned& nloc, unsigned& nx) {
    const unsigned G = gridDim.x * gridDim.y * gridDim.z;
    unsigned sum, cnt, mine, sp = 0u;
    for (;;) {
        sum = 0u; cnt = 0u; mine = 0u;
#pragma unroll
        for (unsigned j = 0; j < 16; ++j) { const unsigned c = xb_ld(&bar[XB_XCNT(j)]); sum += c; cnt += (c > 0u) ? 1u : 0u; mine = (j == x) ? c : mine; }
        if (sum == G) break;
        __builtin_amdgcn_s_sleep(1);
        if ((++sp & 255u) == 0u) { if (xb_ld(&bar[XB_TMO])) break; if (sp > XB_SPIN_CAP) { atomicAdd(&bar[XB_TMO], 1u); break; } }
    }
    nloc = mine > 0u ? mine : 1u; nx = cnt > 0u ? cnt : 1u;
}
__device__ __forceinline__ void xcd_barrier(const XcdBarrier& b, bool t0) {
    asm volatile("s_waitcnt vmcnt(0)" ::: "memory");
    __syncthreads();
    if (t0) {
        unsigned* bar = b.bar;
        __builtin_amdgcn_s_waitcnt(0);
        unsigned nloc = b.st[0], nx = b.st[1];
        if (nloc == 0u) { xcd_barrier_complete(bar, b.x, nloc, nx); b.st[0] = nloc; b.st[1] = nx; }
        const unsigned old = xb_add(&bar[XB_XSUB(b.x)], 1u);
        const unsigned gen = old / nloc;
        if (old + 1u == (gen + 1u) * nloc) {
            __builtin_amdgcn_fence(__ATOMIC_RELEASE, "agent");
            asm volatile("s_waitcnt vmcnt(0)" ::: "memory");
            const unsigned og = xb_add(&bar[XB_TOP], 1u);
            const unsigned tg = og / nx;
            if (og + 1u == (tg + 1u) * nx) xb_add(&bar[XB_TOPGEN], 1u);
            else XB_SPIN(xb_ld(&bar[XB_TOPGEN]) == tg, bar);
            __builtin_amdgcn_fence(__ATOMIC_ACQUIRE, "agent");
            xb_add(&bar[XB_XGEN(b.x)], 1u);
            asm volatile("s_waitcnt vmcnt(0)" ::: "memory");
        } else {
            XB_SPIN(xb_ld(&bar[XB_XGEN(b.x)]) == gen, bar);
            __builtin_amdgcn_fence(__ATOMIC_ACQUIRE, "agent");
            asm volatile("s_waitcnt vmcnt(0)" ::: "memory");
        }
    }
    __syncthreads();
}

namespace pg8 {
#ifndef PG8_WGM
#define PG8_WGM 4
#endif
constexpr int BM = 256, BK = 64, HALF = 128, HTB = HALF * BK * 2, STAGE_BYTES = 8 * HTB, NXCD = 8, WGM = PG8_WGM;
__host__ __device__ __forceinline__ int lds_byte(int r, int c) { const int st = (r >> 4) * 2 + (c >> 5), rr = r & 15, cc = c & 31, ob = rr * 64 + cc * 2; return st * 1024 + (ob ^ (((ob >> 9) & 1) << 5)); }
__host__ __device__ __forceinline__ void stage_rc(int b, int& R, int& C) { const int st = b / 1024, sb = b % 1024, swz = sb ^ (((sb >> 9) & 1) << 5); R = (st >> 1) * 16 + swz / 64; C = (st & 1) * 32 + (swz % 64) / 2; }
__host__ __device__ __forceinline__ int perm32(int rho) { const int n = rho >> 4, i = rho & 15; return 8 * (i >> 2) + 4 * n + (i & 3); }

struct Unit { int pm, pn, e; };
struct Gemm { const void* A; const void* Bt; };
template <int LDA_, int LDB_, int KB_, size_t SB_> struct GShape { static constexpr int LDA = LDA_, LDB = LDB_, KB = KB_; static constexpr size_t SB = SB_; };

__device__ __forceinline__ bool order_map(int L, int nM, int nN, int& pm, int& pn) {
    const int nwg = nM * nN; if (L >= nwg) return false;
    int wgid = L; { const int q = nwg / NXCD, r = nwg % NXCD, xcd = wgid % NXCD, off = wgid / NXCD; wgid = (xcd < r ? xcd * (q + 1) : r * (q + 1) + (xcd - r) * q) + off; }
    const int nig = WGM * nN, gid = wgid / nig, fm = gid * WGM, gsz = (nM - fm) < WGM ? (nM - fm) : WGM;
    pm = fm + ((wgid % nig) % gsz); pn = (wgid % nig) / gsz; return true;
}
struct StaticOrder {
    int nM, nN, G, c;
    __device__ void init(int M, int N, int G_, int c_) { nM = M / BM; nN = N / BM; G = G_; c = c_; }
    __device__ __forceinline__ bool next(int i, Unit& u) const { u.e = 0; return order_map(i * G + c, nM, nN, u.pm, u.pn); }
};
struct MoeOrder {
    int nM, nN, G, c; const LAS int* t2e;
    __device__ __forceinline__ bool next(int i, Unit& u) const { if (!order_map(i * G + c, nM, nN, u.pm, u.pn)) return false; u.e = __builtin_amdgcn_readfirstlane(t2e[u.pm]); return true; }
};

__device__ __forceinline__ unsigned cvt_pk_bf16(float lo, float hi) { return pk2(lo, hi); }

struct EpiBf16 {
    static constexpr bool PERM = true; static constexpr int NSTORES = 16;
    bf16_t* O; int ldc; const float* bias; int bias_stride;
    __device__ __forceinline__ void operator()(const f32x4 (&acc)[2][2][4][2], const Unit& u, int wr, int wc, int fr, int fq) const {
        const int row0 = u.pm * BM + wr * 64 + fr; const int col0 = u.pn * BM + wc * 32 + 8 * fq;
        f32x4 bv[2][2];
#pragma unroll
        for (int bj = 0; bj < 2; ++bj)
#pragma unroll
            for (int n = 0; n < 2; ++n) bv[bj][n] = bias ? *(const f32x4*)(bias + (size_t)u.e * bias_stride + col0 + bj * HALF + 4 * n) : (f32x4){0.f, 0.f, 0.f, 0.f};
#pragma unroll
        for (int ai = 0; ai < 2; ++ai)
#pragma unroll
            for (int m = 0; m < 4; ++m) { bf16_t* rowp = O + (size_t)(row0 + ai * HALF + m * 16) * ldc + col0;
#pragma unroll
                for (int bj = 0; bj < 2; ++bj) { const f32x4 v0 = acc[ai][bj][m][0] + bv[bj][0], v1 = acc[ai][bj][m][1] + bv[bj][1];
                    u32x4 w; w.x = cvt_pk_bf16(v0[0], v0[1]); w.y = cvt_pk_bf16(v0[2], v0[3]); w.z = cvt_pk_bf16(v1[0], v1[1]); w.w = cvt_pk_bf16(v1[2], v1[3]);
                    *(u32x4*)(rowp + bj * HALF) = w; } }
    }
};
struct EpiF32Res {
    static constexpr bool PERM = false;
    float* C; const float* resid; int ldc;
    __device__ __forceinline__ void operator()(const f32x4 (&acc)[2][2][4][2], const Unit& u, int wr, int wc, int fr, int fq) const {
        const int row0 = u.pm * BM + wr * 64 + fr, col0 = u.pn * BM + wc * 32 + 4 * fq;
#pragma unroll
        for (int ai = 0; ai < 2; ++ai)
#pragma unroll
            for (int m = 0; m < 4; ++m) { const size_t off = (size_t)(row0 + ai * HALF + m * 16) * ldc + col0;
#pragma unroll
                for (int bj = 0; bj < 2; ++bj)
#pragma unroll
                    for (int n = 0; n < 2; ++n) { const f32x4 r = *(const f32x4*)(resid + off + bj * HALF + n * 16); *(f32x4*)(C + off + bj * HALF + n * 16) = acc[ai][bj][m][n] + r; } }
    }
};
struct EpiSwiGLU {
    static constexpr bool PERM = true;
    bf16_t* O; int ldc; const float* bias;
    __device__ __forceinline__ void operator()(const f32x4 (&acc)[2][2][4][2], const Unit& u, int wr, int wc, int fr, int fq) const {
        const int row0 = u.pm * BM + wr * 64 + fr; const int j0 = u.pn * HALF + wc * 32 + 8 * fq;
        const float* be = bias + (size_t)u.e * 4096;
        f32x4 bg[2], bu[2];
#pragma unroll
        for (int n = 0; n < 2; ++n) { bg[n] = *(const f32x4*)(be + j0 + 4 * n); bu[n] = *(const f32x4*)(be + 2048 + j0 + 4 * n); }
#pragma unroll
        for (int ai = 0; ai < 2; ++ai)
#pragma unroll
            for (int m = 0; m < 4; ++m) { bf16_t* rowp = O + (size_t)(row0 + ai * HALF + m * 16) * ldc + j0;
                float o[8];
#pragma unroll
                for (int n = 0; n < 2; ++n) { const f32x4 g = acc[ai][0][m][n] + bg[n], up = acc[ai][1][m][n] + bu[n];
#pragma unroll
                    for (int q = 0; q < 4; ++q) { const float gt = fminf(g[q], 7.0f), ut = fminf(fmaxf(up[q], -7.0f), 7.0f);
                        const float glu = gt * __builtin_amdgcn_rcpf(1.0f + __expf(-1.702f * gt)); o[4 * n + q] = (ut + 1.0f) * glu; } }
                u32x4 w; w.x = cvt_pk_bf16(o[0], o[1]); w.y = cvt_pk_bf16(o[2], o[3]); w.z = cvt_pk_bf16(o[4], o[5]); w.w = cvt_pk_bf16(o[6], o[7]);
                *(u32x4*)rowp = w; }
    }
};

struct EpiBf16Res {
    static constexpr bool PERM = true; static constexpr int NSTORES = 16;
    bf16_t* O; const float* resid; int ldc;
    __device__ __forceinline__ void operator()(const f32x4 (&acc)[2][2][4][2], const Unit& u, int wr, int wc, int fr, int fq) const {
        const int row0 = u.pm * BM + wr * 64 + fr; const int col0 = u.pn * BM + wc * 32 + 8 * fq;
#pragma unroll
        for (int ai = 0; ai < 2; ++ai)
#pragma unroll
            for (int m = 0; m < 4; ++m) { const size_t off = (size_t)(row0 + ai * HALF + m * 16) * ldc + col0;
#pragma unroll
                for (int bj = 0; bj < 2; ++bj) { const f32x4 r0 = *(const f32x4*)(resid + off + bj * HALF), r1 = *(const f32x4*)(resid + off + bj * HALF + 4);
                    const f32x4 v0 = acc[ai][bj][m][0] + r0, v1 = acc[ai][bj][m][1] + r1;
                    u32x4 w; w.x = cvt_pk_bf16(v0[0], v0[1]); w.y = cvt_pk_bf16(v0[2], v0[3]); w.z = cvt_pk_bf16(v1[0], v1[1]); w.w = cvt_pk_bf16(v1[2], v1[3]);
                    *(u32x4*)(O + off + bj * HALF) = w; } }
    }
};
#ifndef USE_BIAS_LDS
#define USE_BIAS_LDS 0
#endif
template <int MODE = 0> struct EpiFp8S_ {
    static constexpr int NSTORES = 16;
    static constexpr bool PERM = true, BIAS_LDS = (USE_BIAS_LDS != 0);
    unsigned char* O; int ldc; const float* bias; int bias_stride; float scale, oscale;
    __device__ __forceinline__ const char* bias_base(const Unit& u) const { return (const char*)(bias + (size_t)u.e * bias_stride + u.pn * BM); }
    __device__ static __forceinline__ unsigned bias_voff(int i) { return (unsigned)i * 4u; }
    __device__ __forceinline__ void operator()(const f32x4 (&acc)[2][2][4][2], const Unit& u, int wr, int wc, int fr, int fq, const LAS float* bl) const {
        const int row0 = u.pm * BM + wr * 64 + fr; const int col0 = u.pn * BM + wc * 32 + 8 * fq;
        f32x4 bv[2][2];
#pragma unroll
        for (int bj = 0; bj < 2; ++bj)
#pragma unroll
            for (int n = 0; n < 2; ++n) { if constexpr (MODE == 2) bv[bj][n] = (f32x4){oscale, oscale, oscale, oscale}; else if constexpr (BIAS_LDS) bv[bj][n] = *(const LAS f32x4*)(bl + wc * 32 + 8 * fq + bj * HALF + 4 * n) * oscale; else bv[bj][n] = *(const f32x4*)(bias + (size_t)u.e * bias_stride + col0 + bj * HALF + 4 * n) * oscale; }
        const float sc = scale * oscale;
#pragma unroll
        for (int ai = 0; ai < 2; ++ai)
#pragma unroll
            for (int m = 0; m < 4; ++m) { unsigned char* rowp = O + (size_t)(row0 + ai * HALF + m * 16) * ldc + col0;
#pragma unroll
                for (int bj = 0; bj < 2; ++bj) { const f32x4 v0 = acc[ai][bj][m][0] * sc + bv[bj][0], v1 = acc[ai][bj][m][1] * sc + bv[bj][1];
                    u32x2 w; w.x = pk4_fp8(v0[0], v0[1], v0[2], v0[3]); w.y = pk4_fp8(v1[0], v1[1], v1[2], v1[3]);
                    if constexpr (MODE == 1) { if (u.pm < 0) *(u32x2*)(rowp + bj * HALF) = w; else asm volatile("" :: "v"(w)); } else *(u32x2*)(rowp + bj * HALF) = w; } }
    }
};
using EpiFp8S = EpiFp8S_<0>;
struct EpiSwiGLU8 {
    static constexpr bool PERM = true, BIAS_LDS = (USE_BIAS_LDS != 0); static constexpr int NSTORES = 8;
    unsigned char* O; int ldc; const float* bias;
    struct Bias { f32x4 bg[2], bu[2];
        __device__ __forceinline__ void pin() { asm volatile("" : "+v"(bg[0]), "+v"(bg[1]), "+v"(bu[0]), "+v"(bu[1])); } };
    __device__ __forceinline__ const char* bias_base(const Unit& u) const { return (const char*)(bias + (size_t)u.e * 4096 + u.pn * HALF); }
    __device__ static __forceinline__ unsigned bias_voff(int i) { return (unsigned)(i < 128 ? i : 2048 - 128 + i) * 4u; }
    __device__ __forceinline__ void load_bias(const Unit& u, int wc, int fq, Bias& b, const LAS float* bl) const {
        const int j0 = wc * 32 + 8 * fq;
        if constexpr (BIAS_LDS) {
#pragma unroll
            for (int n = 0; n < 2; ++n) { b.bg[n] = *(const LAS f32x4*)(bl + j0 + 4 * n); b.bu[n] = *(const LAS f32x4*)(bl + 128 + j0 + 4 * n); }
        } else { const float* be = bias + (size_t)u.e * 4096 + u.pn * HALF + j0;
#pragma unroll
            for (int n = 0; n < 2; ++n) { b.bg[n] = *(const f32x4*)(be + 4 * n); b.bu[n] = *(const f32x4*)(be + 2048 + 4 * n); } } }
    __device__ __forceinline__ void operator()(const f32x4 (&acc)[2][2][4][2], const Unit& u, int wr, int wc, int fr, int fq, const LAS float* bl) const { Bias b; load_bias(u, wc, fq, b, bl); apply(acc, u, wr, wc, fr, fq, b); }
    __device__ __forceinline__ void apply(const f32x4 (&acc)[2][2][4][2], const Unit& u, int wr, int wc, int fr, int fq, const Bias& b) const {
        const int row0 = u.pm * BM + wr * 64 + fr; const int j0 = u.pn * HALF + wc * 32 + 8 * fq;
        const f32x4 (&bg)[2] = b.bg; const f32x4 (&bu)[2] = b.bu;
#pragma unroll
        for (int ai = 0; ai < 2; ++ai)
#pragma unroll
            for (int m = 0; m < 4; ++m) { unsigned char* rowp = O + (size_t)(row0 + ai * HALF + m * 16) * ldc + j0;
                float o[8];
#pragma unroll
                for (int n = 0; n < 2; ++n) { const f32x4 g = acc[ai][0][m][n] * (1.0f / 8192.0f) + bg[n], up = acc[ai][1][m][n] * (1.0f / 8192.0f) + bu[n];
#pragma unroll
                    for (int q = 0; q < 4; ++q) { const float gt = fminf(g[q], 7.0f), ut = __builtin_amdgcn_fmed3f(up[q], -7.0f, 7.0f);
                        const float glu = gt * __builtin_amdgcn_rcpf(1.0f + __builtin_amdgcn_exp2f(-2.4554669595930156f * gt)); o[4 * n + q] = __builtin_fmaf(ut, 4.0f, 4.0f) * glu; } }
                u32x2 w; w.x = pk4_fp8_nc(o[0], o[1], o[2], o[3]); w.y = pk4_fp8_nc(o[4], o[5], o[6], o[7]);
                *(u32x2*)rowp = w; }
    }
};
template <int ALL> struct EpiNull_ { static constexpr bool PERM = true;
    __device__ __forceinline__ void operator()(const f32x4 (&acc)[2][2][4][2], const Unit& u, int wr, int wc, int fr, int fq) const {
        if constexpr (ALL == 0) asm volatile("" :: "v"(acc[0][0][0][0]), "v"(acc[1][1][3][1]));
        else {
#pragma unroll
        for (int a = 0; a < 2; ++a)
#pragma unroll
            for (int b = 0; b < 2; ++b) asm volatile("" :: "v"(acc[a][b][0][0]), "v"(acc[a][b][0][1]), "v"(acc[a][b][1][0]), "v"(acc[a][b][1][1]), "v"(acc[a][b][2][0]), "v"(acc[a][b][2][1]), "v"(acc[a][b][3][0]), "v"(acc[a][b][3][1])); } } };
using EpiNull = EpiNull_<1>;
struct EpiBf16S {
    static constexpr bool PERM = true;
    bf16_t* O; int ldc; const float* bias; int bias_stride; float scale;
    __device__ __forceinline__ void operator()(const f32x4 (&acc)[2][2][4][2], const Unit& u, int wr, int wc, int fr, int fq) const {
        const int row0 = u.pm * BM + wr * 64 + fr; const int col0 = u.pn * BM + wc * 32 + 8 * fq;
        f32x4 bv[2][2];
#pragma unroll
        for (int bj = 0; bj < 2; ++bj)
#pragma unroll
            for (int n = 0; n < 2; ++n) bv[bj][n] = *(const f32x4*)(bias + (size_t)u.e * bias_stride + col0 + bj * HALF + 4 * n);
#pragma unroll
        for (int ai = 0; ai < 2; ++ai)
#pragma unroll
            for (int m = 0; m < 4; ++m) { bf16_t* rowp = O + (size_t)(row0 + ai * HALF + m * 16) * ldc + col0;
#pragma unroll
                for (int bj = 0; bj < 2; ++bj) { const f32x4 v0 = acc[ai][bj][m][0] * scale + bv[bj][0], v1 = acc[ai][bj][m][1] * scale + bv[bj][1];
                    u32x4 w; w.x = cvt_pk_bf16(v0[0], v0[1]); w.y = cvt_pk_bf16(v0[2], v0[3]); w.z = cvt_pk_bf16(v1[0], v1[1]); w.w = cvt_pk_bf16(v1[2], v1[3]);
                    *(u32x4*)(rowp + bj * HALF) = w; } }
    }
};

__device__ __forceinline__ i32x8 pg8_get8(const i32x32& v, int idx) { i32x8 r;
#pragma unroll
    for (int j = 0; j < 8; ++j) r[j] = v[8 * idx + j];
    return r; }
__device__ __forceinline__ i32x4 pg8_get4(const i32x32& v, int idx) { i32x4 r;
#pragma unroll
    for (int j = 0; j < 4; ++j) r[j] = v[4 * idx + j];
    return r; }
struct NoHost { static constexpr bool ON = false; static constexpr int N = 0; };
template <int N_> struct EpiHost {
    static constexpr bool ON = true; static constexpr int N = N_;
    const float* W; unsigned char* WT; int cid, cend, cstride; int ldw, cbs, gu, e0; int pend[N_];
    __device__ __forceinline__ void issue(unsigned (&x)[16 * N_], int lane) {
        const unsigned vo = (unsigned)lane * 4u; const size_t rowb = (size_t)ldw * 4;
#pragma unroll
        for (int j = 0; j < N_; ++j) { const int id = cid < cend ? cid : cend - 1; pend[j] = id; cid += cstride;
            const int cb = id & ((1 << cbs) - 1), kb = (id >> cbs) & 127, e = e0 + (id >> (cbs + 7));
            const char* rb = (const char*)(W + (size_t)e * DM * ldw + (size_t)(16 * kb) * ldw + 64 * cb);
#pragma unroll
            for (int i = 0; i < 16; ++i) asm volatile("s_nop 4\n\tglobal_load_dword %0, %1, %2" : "=v"(x[16 * j + i]) : "v"(vo), "s"(rb + (size_t)i * rowb) : "memory"); }
    }
    __device__ __forceinline__ void finish(const unsigned (&x)[16 * N_], int lane) const {
#pragma unroll
        for (int j = 0; j < N_; ++j) { const int id = pend[j]; const int cb = id & ((1 << cbs) - 1), kb = (id >> cbs) & 127, e = e0 + (id >> (cbs + 7)); const int n0 = 64 * cb;
            const int drow0 = !gu ? n0 : (n0 < 2048) ? (256 * (n0 >> 7) + (n0 & 127)) : (256 * ((n0 - 2048) >> 7) + 128 + ((n0 - 2048) & 127));
            u32x4 o;
#pragma unroll
            for (int q = 0; q < 4; ++q) o[q] = pk4_fp8(__builtin_bit_cast(float, x[16 * j + 4 * q]) * 512.0f, __builtin_bit_cast(float, x[16 * j + 4 * q + 1]) * 512.0f, __builtin_bit_cast(float, x[16 * j + 4 * q + 2]) * 512.0f, __builtin_bit_cast(float, x[16 * j + 4 * q + 3]) * 512.0f);
            *(u32x4*)(WT + (size_t)e * ldw * DM + (size_t)(drow0 + lane) * DM + 16 * kb) = o; }
    }
};
struct NoGather { static constexpr bool ON = false; };
struct Gather { static constexpr bool ON = true; const unsigned short* list; const LAS unsigned* pbase; const LAS unsigned* cnt; };
__device__ __forceinline__ unsigned gather_clamp(unsigned P, int r0, int cn) { const unsigned lo = (r0 < cn) ? (P & 0xffffu) : 0u, hi = (r0 + 64 < cn) ? (P >> 16) : 0u; return lo | (hi << 16); }
struct NoConv { static constexpr bool ON = false; };
struct ConvGU {
    static constexpr bool ON = true;
    const float* W; unsigned char* WT; int cid, cend, cstride, pend; const char* rbase;
    __device__ __forceinline__ void issue(unsigned (&x)[16], int lane) {
        const int id = cid < cend ? cid : cend - 1; pend = id; cid += cstride;
        const int e = id >> 13, kb = (id >> 6) & 127, cb = id & 63;
        const char* rb = (const char*)(W + (size_t)e * DM * 4096 + (size_t)(16 * kb) * 4096 + 64 * cb);
        const unsigned vo = (unsigned)lane * 4u; rbase = rb;
#pragma unroll
        for (int i = 0; i < 8; ++i) asm volatile("s_nop 4\n\tglobal_load_dword %0, %1, %2" : "=v"(x[i]) : "v"(vo), "s"(rb + (size_t)i * 16384) : "memory");
    }
    __device__ __forceinline__ void issue_b(unsigned (&x)[16], int lane) {
        const unsigned vo = (unsigned)lane * 4u;
#pragma unroll
        for (int i = 8; i < 16; ++i) asm volatile("s_nop 4\n\tglobal_load_dword %0, %1, %2" : "=v"(x[i]) : "v"(vo), "s"(rbase + (size_t)i * 16384) : "memory");
    }
    __device__ __forceinline__ void finish(const unsigned (&x)[16], int lane) const {
        const int id = pend; const int e = id >> 13, kb = (id >> 6) & 127, cb = id & 63; const int n0 = 64 * cb;
        const int drow0 = (n0 < 2048) ? (256 * (n0 >> 7) + (n0 & 127)) : (256 * ((n0 - 2048) >> 7) + 128 + ((n0 - 2048) & 127));
        u32x4 o;
#pragma unroll
        for (int q = 0; q < 4; ++q) o[q] = pk4_fp8(__builtin_bit_cast(float, x[4 * q]) * 512.0f, __builtin_bit_cast(float, x[4 * q + 1]) * 512.0f, __builtin_bit_cast(float, x[4 * q + 2]) * 512.0f, __builtin_bit_cast(float, x[4 * q + 3]) * 512.0f);
        *(u32x4*)(WT + (size_t)e * 4096 * DM + (size_t)(drow0 + lane) * DM + 16 * kb) = o;
    }
};
#define PG8_X16A(x, b) "+v"(x[b+0]), "+v"(x[b+1]), "+v"(x[b+2]), "+v"(x[b+3]), "+v"(x[b+4]), "+v"(x[b+5]), "+v"(x[b+6]), "+v"(x[b+7]), "+v"(x[b+8]), "+v"(x[b+9]), "+v"(x[b+10]), "+v"(x[b+11]), "+v"(x[b+12]), "+v"(x[b+13]), "+v"(x[b+14]), "+v"(x[b+15])
#define PG8_X16(x) "+v"(x[0]), "+v"(x[1]), "+v"(x[2]), "+v"(x[3]), "+v"(x[4]), "+v"(x[5]), "+v"(x[6]), "+v"(x[7]), "+v"(x[8]), "+v"(x[9]), "+v"(x[10]), "+v"(x[11]), "+v"(x[12]), "+v"(x[13]), "+v"(x[14]), "+v"(x[15])

template <class E, class = void> struct epi_nstores { static constexpr int value = 0; };
template <class E> struct epi_nstores<E, decltype((void)E::NSTORES)> { static constexpr int value = E::NSTORES; };
template <class E, class = void> struct epi_takes_bl { static constexpr bool value = false; };
template <class E> struct epi_takes_bl<E, decltype((void)E::BIAS_LDS)> { static constexpr bool value = true; };
template <class E, class = void> struct has_bias_lds { static constexpr bool value = false; };
template <class E> struct has_bias_lds<E, decltype((void)E::BIAS_LDS)> { static constexpr bool value = E::BIAS_LDS; };
constexpr int BIAS_LDS_OFF = MISC_OFF + 4096;
#ifndef CV_XMASK
#define CV_XMASK 0
#endif
template <class Epi, class Sched, class GS, bool ALIGN_EPI = true, bool F8 = false, int STAGGER_TICKS = 0, class CV = NoConv, class EH = NoHost, bool KROT = false, class GI = NoGather, bool FLP = false>
__device__ __forceinline__ void gemm_phase(LAS unsigned char* lds, const Gemm g, const Sched& S, const Epi& E, int wave, CV cv = CV(), EH eh = EH(), GI gi = GI()) {
    const int wid = wave, lane = fresh_lane(), tid = wid * 64 + lane, wr = wid >> 2, wc = wid & 3, fr = lane & 15, fq = lane >> 4;
    constexpr int nt = GS::KB / 128;
    unsigned voffA, voffB;
    { int R, C; stage_rc(tid * 16, R, C); const int Rb = Epi::PERM ? ((R & ~31) + perm32(R & 31)) : R;
      voffA = (unsigned)(R * GS::LDA + C * 2); voffB = (unsigned)(Rb * GS::LDB + C * 2);
      if constexpr (FLP) { const int b = tid * 16; voffA = (unsigned)((b >> 7) * GS::LDA + (b & 127)); voffB = (unsigned)((b >> 7) * GS::LDB + (b & 127)); } }
    constexpr size_t pstepA = (size_t)64 * GS::LDA, pstepB = (size_t)64 * GS::LDB;
    constexpr size_t kstep = (size_t)(BK * 2);
    constexpr size_t hstepA = (size_t)HALF * GS::LDA, hstepB = (size_t)HALF * GS::LDB;
    constexpr size_t tstepA = 2 * hstepA, tstepB = 2 * hstepB;
    const unsigned ldsw = (unsigned)wid * 1024u;
    const unsigned ldsb = (unsigned)(size_t)lds + ldsw;
    const int aoff = lds_byte(wr * 64 + fr, F8 ? fq * 16 : fq * 8), boff = lds_byte(wc * 32 + fr, F8 ? fq * 16 : fq * 8);
    const int kofs = F8 ? 16 : 1024;
#define PG8_SA(b, h) (((b) * 2 + (h)) * HTB)
#define PG8_SB(b, h) ((4 + (b) * 2 + (h)) * HTB)
#define PG8_STAGE(bufoff, gbase, voff) do { _Pragma("unroll") for (int _i = 0; _i < 2; ++_i) { unsigned _keep; \
        asm volatile("s_mov_b32 %0, m0\n\ts_mov_b32 m0, %3\n\ts_nop 3\n\tglobal_load_lds_dwordx4 %1, %2\n\ts_mov_b32 m0, %0" \
            : "=&s"(_keep) : "v"(voff##_v), "s"((const char*)(gbase) + _i * pstep##voff), "s"(ldsb + (unsigned)((bufoff) + _i * 8192)) : "memory"); } } while (0)
#define PG8_STAGE_GA(bufoff, kp, vlo, vhi) do { unsigned _keep; \
        asm volatile("s_mov_b32 %0, m0\n\ts_mov_b32 m0, %3\n\ts_nop 3\n\tglobal_load_lds_dwordx4 %1, %2\n\ts_mov_b32 m0, %0" : "=&s"(_keep) : "v"(vlo), "s"((const char*)(kp)), "s"(ldsb + (unsigned)(bufoff)) : "memory"); \
        asm volatile("s_mov_b32 %0, m0\n\ts_mov_b32 m0, %3\n\ts_nop 3\n\tglobal_load_lds_dwordx4 %1, %2\n\ts_mov_b32 m0, %0" : "=&s"(_keep) : "v"(vhi), "s"((const char*)(kp)), "s"(ldsb + (unsigned)((bufoff) + 8192)) : "memory"); } while (0)
#define PG8_STA(bufoff, kp, h, nx) do { if constexpr (GI::ON) { const unsigned _p = (nx) ? nvP[h] : voP[h]; const unsigned _lo = ((_p & 0xffffu) << 11) + gcb, _hi = ((_p >> 16) << 11) + gcb; PG8_STAGE_GA(bufoff, kp, _lo, _hi); } \
        else PG8_STAGE(bufoff, (kp) + (h) * hstepA, voffA); } while (0)
#define pstepvoffA pstepA
#define pstepvoffB pstepB
#define voffA_v voffA
#define voffB_v voffB
#define PG8_LD16(p) (*(const LAS i32x4*)(p))
#define PG8_SET8(V, idx, lo, hi) do { _Pragma("unroll") for (int _j = 0; _j < 4; ++_j) { V[8 * (idx) + _j] = (lo)[_j]; V[8 * (idx) + 4 + _j] = (hi)[_j]; } } while (0)
#define PG8_GET8(V, idx) pg8_get8(V, idx)
#define PG8_GETLO(V, idx) __builtin_bit_cast(bf16x8, pg8_get4(V, 2 * (idx)))
#define PG8_GETHI(V, idx) __builtin_bit_cast(bf16x8, pg8_get4(V, 2 * (idx) + 1))
#define PG8_LDA(dst, b, h) do { _Pragma("unroll") for (int m = 0; m < 4; ++m) { const i32x4 _lo = PG8_LD16(lds + PG8_SA(b, h) + aoff + m * 2048), _hi = PG8_LD16(lds + PG8_SA(b, h) + aoff + m * 2048 + kofs); \
        PG8_SET8(AV, m, _lo, _hi); } } while (0)
#define PG8_LDB(dst, b, h) do { _Pragma("unroll") for (int n = 0; n < 2; ++n) { const i32x4 _lo = PG8_LD16(lds + PG8_SB(b, h) + boff + n * 2048), _hi = PG8_LD16(lds + PG8_SB(b, h) + boff + n * 2048 + kofs); \
        PG8_SET8(BV, (dst) + n, _lo, _hi); } } while (0)
#define PG8_MMA(ai, bj, At, Bt) do { __builtin_amdgcn_s_setprio(1); \
        if constexpr (F8) { _Pragma("unroll") for (int m = 0; m < 4; ++m) _Pragma("unroll") for (int n = 0; n < 2; ++n) \
            acc[ai][bj][m][n] = __builtin_amdgcn_mfma_scale_f32_16x16x128_f8f6f4(PG8_GET8(BV, (Bt) + n), PG8_GET8(AV, m), acc[ai][bj][m][n], 0, 0, 0, 0, 0, 0); } \
        else { _Pragma("unroll") for (int m = 0; m < 4; ++m) _Pragma("unroll") for (int n = 0; n < 2; ++n) { \
            acc[ai][bj][m][n] = __builtin_amdgcn_mfma_f32_16x16x32_bf16(PG8_GETLO(BV, (Bt) + n), PG8_GETLO(AV, m), acc[ai][bj][m][n], 0, 0, 0); \
            acc[ai][bj][m][n] = __builtin_amdgcn_mfma_f32_16x16x32_bf16(PG8_GETHI(BV, (Bt) + n), PG8_GETHI(AV, m), acc[ai][bj][m][n], 0, 0, 0); } } \
        __builtin_amdgcn_s_setprio(0); } while (0)
#define PG8_WAIT_V(n) asm volatile("s_waitcnt vmcnt(" #n ")" ::: "memory")
#define PG8_WAIT_L(n) asm volatile("s_waitcnt lgkmcnt(" #n ")" ::: "memory")
#define PG8_BAR __builtin_amdgcn_s_barrier()
#define PG8_SCHED __builtin_amdgcn_sched_barrier(0)
    Unit cur, nxt; int ui = 0;
    if (!S.next(0, cur)) return;
    constexpr bool BL = has_bias_lds<Epi>::value;
    constexpr int NST = EH::ON ? EH::N : epi_nstores<Epi>::value;
#define PG8_WAIT_VN(n) asm volatile("s_waitcnt vmcnt(%0)" :: "n"(n) : "memory")
    static_assert(!(BL && CV::ON), "the counted waits below know one or the other");
    unsigned bx = 0;
    unsigned cx[16];
    if constexpr (CV::ON) { cv.issue(cx, lane); cv.issue_b(cx, lane); asm volatile("s_waitcnt vmcnt(0)" ::: "memory"); asm volatile("" : PG8_X16(cx) :: "memory"); }
    if constexpr (STAGGER_TICKS > 0) {
        if (blockIdx.x & 1) { const unsigned long long t0 = __builtin_amdgcn_s_memrealtime(); while (__builtin_amdgcn_s_memrealtime() - t0 < (unsigned long long)STAGGER_TICKS) __builtin_amdgcn_s_sleep(8); } }
    i32x32 AV, BV;
    constexpr int At = 0, B0 = 0, B1 = 2;
    static_assert(!GI::ON || GS::LDA == 2048, "gather: 2 KiB token rows");
    int tfetch = 0; if constexpr (GI::ON) asm volatile("s_mov_b32 %0, 0" : "=s"(tfetch));
    unsigned voP[2] = {0u, 0u}, nvP[2] = {0u, 0u}, gcb = 0u;
    if constexpr (GI::ON) { int R, C; stage_rc(tid * 16, R, C); gcb = (unsigned)(C * 2);
        const int lb = cur.pm * BM - __builtin_amdgcn_readfirstlane((int)gi.pbase[cur.e]), cn = __builtin_amdgcn_readfirstlane((int)gi.cnt[cur.e]);
        const u32x2 pr = *(const u32x2*)(gi.list + (size_t)cur.e * 16384 + lb + 4 * R);
        voP[0] = gather_clamp(pr.x, lb + R, cn); voP[1] = gather_clamp(pr.y, lb + R + 128, cn); }
    const char* cA = GI::ON ? (const char*)g.A : (const char*)g.A + (size_t)cur.pm * tstepA; const char* cB = (const char*)g.Bt + (size_t)cur.e * GS::SB + (size_t)cur.pn * tstepB;
#define PG8_KO(u) (KROT ? ((((u).pn & 7) * 2 + ((u).pm & 3) * 4) * (nt / 16)) & (nt - 1) : 0)
    int ko = PG8_KO(cur);
    { const char* pA = cA + (size_t)ko * kstep; const char* pB = cB + (size_t)ko * kstep;
    PG8_STAGE(PG8_SB(0, 0), pB, voffB); PG8_SCHED; PG8_STAGE(PG8_SB(0, 1), pB + hstepB, voffB); PG8_SCHED; PG8_STA(PG8_SA(0, 0), pA, 0, false); PG8_SCHED; PG8_STA(PG8_SA(0, 1), pA, 1, false); PG8_SCHED;
    if (wr == 1) PG8_BAR;
    PG8_WAIT_V(2); PG8_BAR;
    PG8_STAGE(PG8_SB(1, 0), pB + kstep, voffB); PG8_SCHED; PG8_STA(PG8_SA(1, 0), pA + kstep, 0, false); PG8_SCHED; PG8_STAGE(PG8_SB(1, 1), pB + hstepB + kstep, voffB); PG8_SCHED; }
    PG8_WAIT_V(6); PG8_BAR; PG8_SCHED;
    f32x4 acc[2][2][4][2];
#pragma unroll
    for (int a = 0; a < 2; ++a)
#pragma unroll
        for (int b = 0; b < 2; ++b)
#pragma unroll
            for (int m = 0; m < 4; ++m)
#pragma unroll
                for (int n = 0; n < 2; ++n) acc[a][b][m][n] = (f32x4){0.f, 0.f, 0.f, 0.f};
    for (;;) {
        const bool has_next = S.next(ui + 1, nxt);
        const char* nA = (has_next && !GI::ON) ? (const char*)g.A + (size_t)nxt.pm * tstepA : cA;
        const char* nB = has_next ? (const char*)g.Bt + (size_t)nxt.e * GS::SB + (size_t)nxt.pn * tstepB : cB;
        const int nko = has_next ? PG8_KO(nxt) : ko;
        for (int t = 0; t < nt; t += 2) {
            const bool last = (t == nt - 2);
            const int kt = KROT ? ((ko + t) & (nt - 1)) : t, kt2 = KROT ? ((ko + t + 2) & (nt - 1)) : t + 2;
            const char* a1 = cA + (size_t)(kt + 1) * kstep;
            const char* a2 = last ? nA + (size_t)nko * kstep : cA + (size_t)kt2 * kstep; const char* b2 = last ? nB + (size_t)nko * kstep : cB + (size_t)kt2 * kstep;
            const char* a3 = a2 + kstep; const char* b3 = b2 + kstep;
            PG8_LDB(B0, 0, 0); PG8_LDB(B1, 0, 1); PG8_SCHED; PG8_LDA(At, 0, 0); PG8_STA(PG8_SA(1, 1), a1, 1, false);
            PG8_WAIT_V(8);
            if constexpr (CV::ON) asm volatile("" : PG8_X16(cx));
            PG8_WAIT_L(0); PG8_BAR;
            const bool xon = CV::ON && ((t & CV_XMASK) == 0);
            if constexpr (CV::ON) { if (xon) { cv.finish(cx, lane); cv.issue(cx, lane); } }
            if constexpr (GI::ON) { if (t == tfetch && has_next) {
                int R, C; stage_rc((wid * 64 + fresh_lane()) * 16, R, C); const unsigned lvo = (unsigned)R * 8u;
                const char* lp = (const char*)(gi.list + (size_t)nxt.e * 16384 + (nxt.pm * BM - __builtin_amdgcn_readfirstlane((int)gi.pbase[nxt.e])));
                u32x2 pr; asm volatile("s_nop 4\n\tglobal_load_dwordx2 %0, %1, %2" : "=&v"(pr) : "v"(lvo), "s"(lp) : "memory"); nvP[0] = pr.x; nvP[1] = pr.y; } }
            if constexpr (BL) { if (last) { const unsigned bvo = Epi::bias_voff((wid * 64 + fresh_lane()) & 255);
                asm volatile("s_nop 4\n\tglobal_load_dword %0, %1, %2" : "=v"(bx) : "v"(bvo), "s"(E.bias_base(cur)) : "memory"); } }
            PG8_MMA(0, 0, At, B0); PG8_MMA(0, 1, At, B1); PG8_BAR; PG8_SCHED;
            PG8_LDA(At, 0, 1); PG8_STAGE(PG8_SB(0, 0), b2, voffB); PG8_STAGE(PG8_SB(0, 1), b2 + hstepB, voffB); PG8_STA(PG8_SA(0, 0), a2, 0, last);
            if (xon) PG8_WAIT_V(17); else if (BL && last) PG8_WAIT_V(9); else if (GI::ON && t == tfetch && has_next) PG8_WAIT_V(9); else PG8_WAIT_V(8);
            PG8_WAIT_L(0); PG8_BAR;
            if constexpr (CV::ON) { if (xon) cv.issue_b(cx, lane); }
            PG8_MMA(1, 0, At, B0); PG8_MMA(1, 1, At, B1); PG8_BAR; PG8_SCHED;
            PG8_LDB(B0, 1, 0); PG8_LDB(B1, 1, 1); PG8_SCHED; PG8_LDA(At, 1, 0); PG8_STA(PG8_SA(0, 1), a2, 1, last);
            if (xon) PG8_WAIT_V(25); else PG8_WAIT_V(8);
            if constexpr (GI::ON) { if (t == tfetch && has_next) { asm volatile("" : "+v"(nvP[0]), "+v"(nvP[1]));
                int R, C; stage_rc((wid * 64 + fresh_lane()) * 16, R, C); const int lb = nxt.pm * BM - __builtin_amdgcn_readfirstlane((int)gi.pbase[nxt.e]), cn = __builtin_amdgcn_readfirstlane((int)gi.cnt[nxt.e]);
                nvP[0] = gather_clamp(nvP[0], lb + R, cn); nvP[1] = gather_clamp(nvP[1], lb + R + 128, cn); } }
            if constexpr (BL) { if (last) { asm volatile("" : "+v"(bx));
                *(LAS unsigned*)(lds + BIAS_LDS_OFF + 4 * ((wid * 64 + fresh_lane()) & 255)) = bx; } }
            PG8_WAIT_L(0); PG8_BAR; PG8_MMA(0, 0, At, B0); PG8_MMA(0, 1, At, B1); PG8_BAR; PG8_SCHED;
            PG8_LDA(At, 1, 1); PG8_STAGE(PG8_SB(1, 0), b3, voffB); PG8_STAGE(PG8_SB(1, 1), b3 + hstepB, voffB); PG8_STA(PG8_SA(1, 0), a3, 0, last);
            if constexpr (CV::ON) { if (xon) PG8_WAIT_V(16); else PG8_WAIT_V(8); } else PG8_WAIT_V(8);
            PG8_WAIT_L(0); PG8_BAR; PG8_MMA(1, 0, At, B0); PG8_MMA(1, 1, At, B1); PG8_BAR; PG8_SCHED;
        }
        if constexpr (ALIGN_EPI) { if (wr == 0) PG8_BAR; }
        { const int l2 = fresh_lane();
          const LAS float* bl = (const LAS float*)(lds + BIAS_LDS_OFF);
          if constexpr (EH::ON) {
              unsigned ex[16 * EH::N]; typename Epi::Bias eb;
              if constexpr (BL) { eh.issue(ex, l2); E.load_bias(cur, wc, l2 >> 4, eb, bl); }
              else { E.load_bias(cur, wc, l2 >> 4, eb, bl); eb.pin(); eh.issue(ex, l2); }
              E.apply(acc, cur, wr, wc, l2 & 15, l2 >> 4, eb);
              asm volatile("s_waitcnt vmcnt(0)" ::: "memory");
              if constexpr (EH::N == 3) asm volatile("" : PG8_X16A(ex, 0), PG8_X16A(ex, 16), PG8_X16A(ex, 32) :: "memory");
              else asm volatile("" : PG8_X16A(ex, 0), PG8_X16A(ex, 16), PG8_X16A(ex, 32), PG8_X16A(ex, 48) :: "memory");
              eh.finish(ex, l2);
          } else if constexpr (epi_takes_bl<Epi>::value) E(acc, cur, wr, wc, l2 & 15, l2 >> 4, bl);
          else E(acc, cur, wr, wc, l2 & 15, l2 >> 4); }
        if (!has_next) break;
#pragma unroll
        for (int a = 0; a < 2; ++a)
#pragma unroll
            for (int b = 0; b < 2; ++b)
#pragma unroll
                for (int m = 0; m < 4; ++m)
#pragma unroll
                    for (int n = 0; n < 2; ++n) acc[a][b][m][n] = (f32x4){0.f, 0.f, 0.f, 0.f};
        cur = nxt; cA = nA; cB = nB; ko = nko; ++ui;
        if constexpr (GI::ON) {
#pragma unroll
            for (int i = 0; i < 2; ++i) voP[i] = nvP[i]; }
        if constexpr (ALIGN_EPI) { if (wr == 1) PG8_BAR; }
    }
    if constexpr (CV::ON) { asm volatile("s_waitcnt vmcnt(0)" ::: "memory"); asm volatile("" : PG8_X16(cx) :: "memory"); cv.finish(cx, lane); }
    else PG8_WAIT_V(0);
    if constexpr (!ALIGN_EPI) { if (wr == 0) PG8_BAR; }
    PG8_BAR;
#undef PG8_SA
#undef PG8_KO
#undef PG8_SB
#undef PG8_STAGE
#undef PG8_STAGE_GA
#undef PG8_STA
#undef pstepvoffA
#undef pstepvoffB
#undef voffA_v
#undef voffB_v
#undef PG8_LDA
#undef PG8_LD16
#undef PG8_SET8
#undef PG8_GET8
#undef PG8_GETLO
#undef PG8_GETHI
#undef PG8_LDB
#undef PG8_MMA
#undef PG8_WAIT_V
#undef PG8_WAIT_VN
#undef PG8_WAIT_L
#undef PG8_BAR
#undef PG8_SCHED
}
}
struct Params {
    const float* in[22];
    float* out; unsigned char* ws;
    int ph_lo, ph_hi;
};
enum { I_X = 0, I_NMG, I_WIN, I_GWG, I_GBG, I_GNG, I_CW, I_CB, I_WA, I_BA, I_WI, I_BI, I_AP, I_WOUT, I_NFG, I_WR, I_BR, I_WGU, I_BGU, I_WDN, I_BDN, I_NFINAL };

struct Frame {
    LAS unsigned char* lds; volatile LAS unsigned* MISC;
    int tid, lane, wave, G, gw, NGW;
    unsigned char* ws;
};

__device__ __forceinline__ float gelu_tanh_f(float x) {
    const float u = 0.7978845608028654f * (x + 0.044715f * x * x * x);
    const float e = __expf(2.0f * u);
    const float th = 1.0f - 2.0f * __builtin_amdgcn_rcpf(e + 1.0f);
    return 0.5f * x * (1.0f + th);
}
__device__ __forceinline__ float log_sigmoid_f(float s) { return fminf(s, 0.f) - __logf(1.0f + __expf(-fabsf(s))); }

__device__ __forceinline__ void p0_item(const float* W, int ldw, int col0, bf16_t* WT, int ldt, size_t drow0, int k0, LAS float* scr, int lane) {
    (void)scr;
    const float* src = W + (size_t)k0 * ldw + col0 + lane;
    float v[64];
#pragma unroll
    for (int i = 0; i < 64; ++i) v[i] = src[(size_t)i * ldw];
    bf16_t* dst = WT + (drow0 + lane) * (size_t)ldt + k0;
#pragma unroll
    for (int c = 0; c < 8; ++c) { u32x4 o; o.x = pk2(v[8 * c], v[8 * c + 1]); o.y = pk2(v[8 * c + 2], v[8 * c + 3]); o.z = pk2(v[8 * c + 4], v[8 * c + 5]); o.w = pk2(v[8 * c + 6], v[8 * c + 7]);
        *(u32x4*)(dst + 8 * c) = o; }
}

__device__ __forceinline__ void p0_item8(const float* W, int ldw, int col0, unsigned char* WT, int ldt, size_t drow0, int k0, int lane) {
    const float* src = W + (size_t)k0 * ldw + col0 + lane;
    float v[64];
#pragma unroll
    for (int i = 0; i < 64; ++i) v[i] = src[(size_t)i * ldw];
    unsigned char* dst = WT + (drow0 + lane) * (size_t)ldt + k0;
#pragma unroll
    for (int c = 0; c < 4; ++c) { u32x4 o;
#pragma unroll
        for (int q = 0; q < 4; ++q) o[q] = pk4_fp8(v[16 * c + 4 * q] * 512.0f, v[16 * c + 4 * q + 1] * 512.0f, v[16 * c + 4 * q + 2] * 512.0f, v[16 * c + 4 * q + 3] * 512.0f);
        *(u32x4*)(dst + 16 * c) = o; }
}

constexpr int CONV_EXPERTS_P0 = 28, HOST_DN_EXPERTS_P0 = 24;
struct CoopTile { const float* W; int ldw; int col0; unsigned char* WT; int ldt_b; int mode; int k0; int gu; int drow0; };
__device__ __forceinline__ void coop_load(const CoopTile& t, int w, int l, f32x4 (&v)[16]) {
    if (t.mode == 0) {
#pragma unroll
        for (int i = 0; i < 8; ++i) { const float* r = t.W + (size_t)(t.k0 + 8 * w + i) * t.ldw + t.col0 + 4 * l; v[2 * i] = *(const f32x4*)r; v[2 * i + 1] = *(const f32x4*)(r + 256); }
    } else {
#pragma unroll
        for (int i = 0; i < 16; ++i) v[i] = *(const f32x4*)(t.W + (size_t)(t.k0 + 16 * w + i) * t.ldw + t.col0 + 4 * l);
    }
}
__device__ __forceinline__ void coop_to_lds(const CoopTile& t, int w, int l, const f32x4 (&v)[16], LAS unsigned char* buf) {
    const int sw = (w ^ (l & 7)) * 16;
    if (t.mode == 0) {
#pragma unroll
        for (int jp = 0; jp < 2; ++jp)
#pragma unroll
            for (int j = 0; j < 4; ++j) { u32x4 o; if (t.ldw == INC) { o.x = PK2W(v[0 + jp][j], v[2 + jp][j]); o.y = PK2W(v[4 + jp][j], v[6 + jp][j]); o.z = PK2W(v[8 + jp][j], v[10 + jp][j]); o.w = PK2W(v[12 + jp][j], v[14 + jp][j]); } else { o.x = pk2(v[0 + jp][j], v[2 + jp][j]); o.y = pk2(v[4 + jp][j], v[6 + jp][j]); o.z = pk2(v[8 + jp][j], v[10 + jp][j]); o.w = pk2(v[12 + jp][j], v[14 + jp][j]); }
                *(LAS u32x4*)(buf + (256 * jp + 4 * l + j) * 128 + sw) = o; }
    } else {
#pragma unroll
        for (int j = 0; j < 4; ++j) { u32x4 o;
#pragma unroll
            for (int q = 0; q < 4; ++q) o[q] = pk4_fp8(v[4 * q][j] * 512.0f, v[4 * q + 1][j] * 512.0f, v[4 * q + 2][j] * 512.0f, v[4 * q + 3][j] * 512.0f);
            *(LAS u32x4*)(buf + (4 * l + j) * 128 + sw) = o; }
    }
}
__device__ __forceinline__ void coop_store(const CoopTile& t, int w, int l, const LAS unsigned char* buf) {
    const int nrows = t.mode == 0 ? 512 : 256; const int cp = l & 7;
    for (int n = 8 * w + (l >> 3); n < nrows; n += 64) {
        const u32x4 o = *(const LAS u32x4*)(buf + n * 128 + cp * 16); const int c = cp ^ ((n >> 2) & 7);
        int drow;
        if (t.gu) { const int g = t.col0 + n; drow = (g < 2048) ? (256 * (g >> 7) + (g & 127)) : (256 * ((g - 2048) >> 7) + 128 + ((g - 2048) & 127)); } else drow = t.drow0 + n;
        *(u32x4*)(t.WT + (size_t)drow * t.ldt_b + (t.mode == 0 ? 2 * t.k0 : t.k0) + 16 * c) = o; }
}
__device__ __forceinline__ bool coop_tile(const Params& p, unsigned char* ws, int it, CoopTile& t) {
    constexpr int N_GU = (32 - CONV_EXPERTS_P0) * 256, N_DN = (32 - HOST_DN_EXPERTS_P0) * 128, N_INA = 32 * 6, N_INB = 32 * 4, N_OUT = 32 * 4;
    int r = it;
    if (r < N_GU) { const int e = CONV_EXPERTS_P0 + (r >> 8), q = r & 255, kb = q >> 4, nb = q & 15; t = CoopTile{p.in[I_WGU] + (size_t)e * DM * 4096, 4096, 256 * nb, ws + WS_WGUT + (size_t)e * 4096 * DM, DM, 1, 128 * kb, 1, 0}; return true; } r -= N_GU;
    if (r < N_DN) { const int e = HOST_DN_EXPERTS_P0 + (r >> 7), q = r & 127, kb = q >> 3, nb = q & 7; t = CoopTile{p.in[I_WDN] + (size_t)e * DM * DM, DM, 256 * nb, ws + WS_WDT + (size_t)e * DM * DM, DM, 1, 128 * kb, 0, 256 * nb}; return true; } r -= N_DN;
    if (r < N_INA) { const int kb = r / 6, nb = r % 6; t = CoopTile{p.in[I_WIN], INC, 512 * nb, ws + WS_WINT, DM * 2, 0, 64 * kb, 0, 512 * nb}; return true; } r -= N_INA;
    if (r < N_INB) { const int kb = r >> 2, nb = r & 3; t = CoopTile{p.in[I_WIN], INC, 3088 + 512 * nb, ws + WS_WINT, DM * 2, 0, 64 * kb, 0, 3072 + 512 * nb}; return true; } r -= N_INB;
    if (r < N_OUT) { const int kb = r >> 2, nb = r & 3; t = CoopTile{p.in[I_WOUT], DM, 512 * nb, ws + WS_WOUTT, DM * 2, 0, 64 * kb, 0, 512 * nb}; return true; }
    return false;
}
__device__ __forceinline__ void p0a(Frame& F, const Params& p) {
    const int w = F.wave, l = F.lane;
    CoopTile cur, nxt; f32x4 v[16];
    int it = blockIdx.x; bool have = coop_tile(p, F.ws, it, cur);
    if (have) coop_load(cur, w, l, v);
    int par = 0;
    while (have) {
        LAS unsigned char* buf = F.lds + par * 65536;
        coop_to_lds(cur, w, l, v, buf);
        it += F.G; const bool hn = coop_tile(p, F.ws, it, nxt);
        if (hn) coop_load(nxt, w, l, v);
        __syncthreads();
        coop_store(cur, w, l, buf);
        cur = nxt; have = hn; par ^= 1;
    }
    __syncthreads();
    { bf16_t* WaT = (bf16_t*)(F.ws + WS_WAT); bf16_t* WiT = (bf16_t*)(F.ws + WS_WIT);
      for (int r = F.gw; r < 128; r += F.NGW) { const int which = r >> 6, h = (r >> 4) & 3, kb = (r >> 2) & 3, nb = r & 3;
          p0_item((which ? p.in[I_WI] : p.in[I_WA]) + (size_t)h * 65536, 256, 64 * nb, (which ? WiT : WaT) + (size_t)h * 65536, 256, (size_t)64 * nb, 64 * kb, nullptr, F.lane); } }
    { bf16_t* WglT = (bf16_t*)(F.ws + WS_WGLT); const float* w_in = p.in[I_WIN];
      for (int idx = (int)blockIdx.x * 512 + F.tid; idx < 16 * DM; idx += F.G * 512) { const int cc = idx >> 11, k = idx & 2047; WglT[idx] = (bf16_t)f2bf(w_in[(size_t)k * INC + 3072 + cc]); } }
    { float* WrT = (float*)(F.ws + WS_WRT); const float* wr = p.in[I_WR]; const float* gf = p.in[I_NFG];
      for (int idx = (int)blockIdx.x * 512 + F.tid; idx < 32 * DM; idx += F.G * 512) { const int n = idx >> 11, k = idx & 2047; WrT[idx] = wr[k * 32 + n] * gf[k]; } }
}
__device__ __forceinline__ void p0b(Frame& F, const Params& p) {
    const float* x = p.in[I_X]; const float* g1 = p.in[I_NMG]; bf16_t* H = (bf16_t*)(F.ws + WS_H);
    const int l = F.lane;
    f32x4 gv[8], xn[8];
#pragma unroll
    for (int j = 0; j < 4; ++j) { gv[2 * j] = *(const f32x4*)(g1 + 8 * l + 512 * j); gv[2 * j + 1] = *(const f32x4*)(g1 + 8 * l + 512 * j + 4); }
#pragma unroll
    for (int j = 0; j < 4; ++j) { xn[2 * j] = (F.gw < T) ? *(const f32x4*)(x + (size_t)F.gw * DM + 8 * l + 512 * j) : (f32x4){0.f, 0.f, 0.f, 0.f}; xn[2 * j + 1] = (F.gw < T) ? *(const f32x4*)(x + (size_t)F.gw * DM + 8 * l + 512 * j + 4) : (f32x4){0.f, 0.f, 0.f, 0.f}; }
    for (int m = F.gw; m < T; m += F.NGW) {
        f32x4 xv[8]; float ss = 0.f;
#pragma unroll
        for (int j = 0; j < 8; ++j) { xv[j] = xn[j]; ss += (xv[j][0] * xv[j][0] + xv[j][1] * xv[j][1]) + (xv[j][2] * xv[j][2] + xv[j][3] * xv[j][3]); }
        if (m + F.NGW < T) {
#pragma unroll
            for (int j = 0; j < 4; ++j) { xn[2 * j] = *(const f32x4*)(x + (size_t)(m + F.NGW) * DM + 8 * l + 512 * j); xn[2 * j + 1] = *(const f32x4*)(x + (size_t)(m + F.NGW) * DM + 8 * l + 512 * j + 4); } }
        const float rs = rsqrtf_(wave_sum(ss) * (1.0f / DM) + 1e-6f);
#pragma unroll
        for (int j = 0; j < 4; ++j) { const f32x4 a = xv[2 * j] * rs * gv[2 * j], b = xv[2 * j + 1] * rs * gv[2 * j + 1];
            u32x4 o; o.x = pk2(a[0], a[1]); o.y = pk2(a[2], a[3]); o.z = pk2(b[0], b[1]); o.w = pk2(b[2], b[3]);
            *(u32x4*)(H + (size_t)m * DM + 8 * l + 512 * j) = o;
#ifdef SIM_FP8
            o.x = PK2A(a[0], a[1]); o.y = PK2A(a[2], a[3]); o.z = PK2A(b[0], b[1]); o.w = PK2A(b[2], b[3]); *(u32x4*)((bf16_t*)(F.ws + WS_MIX) + (size_t)m * DM + 8 * l + 512 * j) = o;
#endif
            }
    }
}

__device__ __forceinline__ void gla_cumsum(const LAS float* GL, const float* wg, const float* bgp, int h, LAS float* BC, LAS float* SEG, int tid) {
    const int seg = tid >> 7, kk = tid & 127;
    float wcol[16];
#pragma unroll
    for (int c = 0; c < 16; ++c) wcol[c] = wg[c * 512 + h * 128 + kk];
    const float bcol = bgp[h * 128 + kk];
    float v[16];
#pragma unroll
    for (int i = 0; i < 16; ++i) { const LAS f32x4* g4 = (const LAS f32x4*)(GL + (16 * seg + i) * 16); float sacc = bcol;
#pragma unroll
        for (int c4 = 0; c4 < 4; ++c4) { const f32x4 gq = g4[c4]; sacc += gq[0] * wcol[4 * c4] + gq[1] * wcol[4 * c4 + 1] + gq[2] * wcol[4 * c4 + 2] + gq[3] * wcol[4 * c4 + 3]; }
        v[i] = log_sigmoid_f(sacc) * 0.0625f; }
#pragma unroll
    for (int i = 1; i < 16; ++i) v[i] += v[i - 1];
    SEG[seg * 128 + kk] = v[15];
    __syncthreads();
    float off = 0.f;
#pragma unroll
    for (int s = 0; s < 3; ++s) off += (s < seg) ? SEG[s * 128 + kk] : 0.f;
#pragma unroll
    for (int i = 0; i < 16; ++i) BC[(16 * seg + i) * 128 + kk] = v[i] + off;
    __syncthreads();
}
__device__ __forceinline__ bf16x8 as_bf16x8(u32x4 v) { return __builtin_bit_cast(bf16x8, v); }
__device__ __forceinline__ bf16x8 cat4(bf16x4 lo, bf16x4 hi) { return __builtin_shufflevector(lo, hi, 0, 1, 2, 3, 4, 5, 6, 7); }

__device__ __forceinline__ void p2a(Frame& F, const Params& p) {
    const bf16_t* Z = (const bf16_t*)(F.ws + WS_Z);
    bf16_t* AN = (bf16_t*)(F.ws + WS_AN); float* DN = (float*)(F.ws + WS_DN);
    const bf16_t* WaT = (const bf16_t*)(F.ws + WS_WAT); const bf16_t* WiT = (const bf16_t*)(F.ws + WS_WIT);
    LAS float* BC = (LAS float*)(F.lds); LAS float* SEG = (LAS float*)(F.lds + 32768);
    LAS bf16_t* KDT = (LAS bf16_t*)(F.lds + 34816); LAS bf16_t* VT = (LAS bf16_t*)(F.lds + 53248); LAS bf16_t* XC = (LAS bf16_t*)(F.lds + 90112);
    const int w = F.wave;
    LAS float* GLR = (LAS float*)(F.lds + 90112);
    LAS float* GL = (LAS float*)(F.lds + 124928);
    const float* wg = p.in[I_GWG]; const float* bgp = p.in[I_GBG];
    for (int unit = blockIdx.x; unit < NCHUNK; unit += F.G) {
        const int b = unit >> 7, n = unit & 127, tok0 = b * SEQL + 64 * n;
        {
            const int lane = fresh_lane(), r16 = lane & 15, q4 = lane >> 4;
            const bf16_t* Hb = (const bf16_t*)(F.ws + WS_H) + (size_t)(tok0 + r16) * DM + 256 * w + 8 * q4;
            const bf16_t* Wb = (const bf16_t*)(F.ws + WS_WGLT) + (size_t)r16 * DM + 256 * w + 8 * q4;
            f32x4 gacc[4];
#pragma unroll
            for (int mb = 0; mb < 4; ++mb) gacc[mb] = (f32x4){0.f, 0.f, 0.f, 0.f};
#pragma unroll
            for (int sb = 0; sb < 2; ++sb) { bf16x8 af[4][4], bfr[4];
#pragma unroll
                for (int s4 = 0; s4 < 4; ++s4) { bfr[s4] = *(const bf16x8*)(Wb + 32 * (4 * sb + s4));
#pragma unroll
                    for (int mb = 0; mb < 4; ++mb) af[s4][mb] = *(const bf16x8*)(Hb + (size_t)(16 * mb) * DM + 32 * (4 * sb + s4)); }
#pragma unroll
                for (int s4 = 0; s4 < 4; ++s4)
#pragma unroll
                    for (int mb = 0; mb < 4; ++mb) gacc[mb] = __builtin_amdgcn_mfma_f32_16x16x32_bf16(af[s4][mb], bfr[s4], gacc[mb], 0, 0, 0); }
#pragma unroll
            for (int mb = 0; mb < 4; ++mb)
#pragma unroll
                for (int q = 0; q < 4; ++q) GLR[(w * 64 + 16 * mb + 4 * q4 + q) * 16 + r16] = gacc[mb][q];
            __syncthreads();
            const int tid2 = w * 64 + lane;
#pragma unroll
            for (int it = 0; it < 2; ++it) { const int o = tid2 + 512 * it; float sacc = 0.f;
#pragma unroll
                for (int w2 = 0; w2 < 8; ++w2) sacc += GLR[w2 * 1024 + o];
                GL[o] = sacc; ((float*)(F.ws + WS_LG))[(size_t)tok0 * 16 + o] = sacc; }
            __syncthreads();
        }
        for (int h = 0; h < 4; ++h) {
            int lane = fresh_lane(), tid = F.wave * 64 + lane;
            int r = lane & 31, hh = lane >> 5;
            u32x4 kvr[2], vvr[4];
#pragma unroll
            for (int it = 0; it < 2; ++it) { const int item = tid + 512 * it, t = item & 63, kk8 = item >> 6; kvr[it] = *(const u32x4*)(Z + (size_t)(tok0 + t) * ZC + ZK + h * 128 + kk8 * 8); }
#pragma unroll
            for (int it = 0; it < 4; ++it) { const int item = tid + 512 * it, t = item & 63, vc8 = item >> 6; vvr[it] = *(const u32x4*)(Z + (size_t)(tok0 + t) * ZC + ZV + h * 256 + vc8 * 8); }
            gla_cumsum(GL, wg, bgp, h, BC, SEG, tid);
            const int uh = (b * 4 + h) * 128 + n;
            if (tid < 128) DN[(size_t)uh * 128 + tid] = __expf(BC[63 * 128 + tid]);
#pragma unroll
            for (int it = 0; it < 2; ++it) { const int item = tid + 512 * it, t = item & 63, kk8 = item >> 6;
                const u32x4 kv = kvr[it];
#pragma unroll
                for (int i = 0; i < 8; ++i) { const int kk = kk8 * 8 + i; const unsigned wv = kv[i >> 1]; const float kf = (i & 1) ? bfhi(wv) : bflo(wv);
                    const float d = __expf(BC[63 * 128 + kk] - BC[t * 128 + kk]); KDT[kk * 72 + t] = (bf16_t)f2bf(kf * d); } }
#pragma unroll
            for (int it = 0; it < 4; ++it) { const int item = tid + 512 * it, t = item & 63, vc8 = item >> 6;
                const u32x4 vv = vvr[it];
#pragma unroll
                for (int i = 0; i < 8; ++i) { const unsigned wv = vv[i >> 1]; VT[(vc8 * 8 + i) * 72 + t] = (bf16_t)((i & 1) ? (wv >> 16) : (wv & 0xffffu)); } }
#ifndef P2A_NO_LRU
            u32x4 lv[7]; f32x4 cwv[4][2], cbv[2];
            { const float* cw = p.in[I_CW]; const float* cb = p.in[I_CB]; const int c8 = tid & 31, tq = tid >> 5, chc = h * 256 + c8 * 8;
#pragma unroll
              for (int i = 0; i < 7; ++i) { const int sq = 64 * n + 4 * tq - 3 + i;
                  lv[i] = (sq >= 0) ? *(const u32x4*)(Z + (size_t)(tok0 + 4 * tq - 3 + i) * ZC + ZLX + chc) : (u32x4){0u, 0u, 0u, 0u}; }
#pragma unroll
              for (int i = 0; i < 4; ++i) { cwv[i][0] = *(const f32x4*)(cw + i * 1024 + chc); cwv[i][1] = *(const f32x4*)(cw + i * 1024 + chc + 4); }
              cbv[0] = *(const f32x4*)(cb + chc); cbv[1] = *(const f32x4*)(cb + chc + 4); }
#endif
            __syncthreads();
            {
                f32x16 acc[4];
#pragma unroll
                for (int mb = 0; mb < 4; ++mb)
#pragma unroll
                    for (int q = 0; q < 16; ++q) acc[mb][q] = 0.f;
#pragma unroll
                for (int s = 0; s < 4; ++s) { const bf16x8 bfr = *(const LAS bf16x8*)(VT + (32 * w + r) * 72 + 16 * s + 8 * hh);
#pragma unroll
                    for (int mb = 0; mb < 4; ++mb) { const bf16x8 afr = *(const LAS bf16x8*)(KDT + (32 * mb + r) * 72 + 16 * s + 8 * hh);
                        acc[mb] = __builtin_amdgcn_mfma_f32_32x32x16_bf16(afr, bfr, acc[mb], 0, 0, 0); } }
                bf16_t* base = AN + (size_t)uh * 32768;
#pragma unroll
                for (int mb = 0; mb < 4; ++mb)
#pragma unroll
                    for (int s2 = 0; s2 < 2; ++s2) { u32x4 o;
#pragma unroll
                        for (int q = 0; q < 4; ++q) o[q] = pk2(acc[mb][8 * s2 + 2 * q], acc[mb][8 * s2 + 2 * q + 1]);
                        *(u32x4*)(base + (((mb * 8 + w) * 2 + s2) * 64 + lane) * 8) = o; }
            }
#ifndef P2A_NO_LRU
            {
                {
                    const int c8 = tid & 31, tq = tid >> 5;
#pragma unroll
                    for (int it = 0; it < 4; ++it) { float xc[8];
#pragma unroll
                        for (int q = 0; q < 4; ++q) { xc[q] = cbv[0][q]; xc[4 + q] = cbv[1][q]; }
#pragma unroll
                        for (int i = 0; i < 4; ++i) { const u32x4 l4 = lv[it + i];
                            xc[0] += bflo(l4[0]) * cwv[i][0][0]; xc[1] += bfhi(l4[0]) * cwv[i][0][1]; xc[2] += bflo(l4[1]) * cwv[i][0][2]; xc[3] += bfhi(l4[1]) * cwv[i][0][3];
                            xc[4] += bflo(l4[2]) * cwv[i][1][0]; xc[5] += bfhi(l4[2]) * cwv[i][1][1]; xc[6] += bflo(l4[3]) * cwv[i][1][2]; xc[7] += bfhi(l4[3]) * cwv[i][1][3]; }
                        u32x4 o; o.x = pk2(xc[0], xc[1]); o.y = pk2(xc[2], xc[3]); o.z = pk2(xc[4], xc[5]); o.w = pk2(xc[6], xc[7]);
                        *(LAS u32x4*)(XC + (4 * tq + it) * 264 + c8 * 8) = o; }
                }
                __builtin_amdgcn_sched_barrier(0);
                bf16x8 ba[16], bi[16];
                { const bf16_t* wa = WaT + (size_t)h * 65536 + (size_t)(32 * w + r) * 256 + 8 * hh;
                  const bf16_t* wi = WiT + (size_t)h * 65536 + (size_t)(32 * w + r) * 256 + 8 * hh;
#pragma unroll
                  for (int s = 0; s < 16; ++s) { ba[s] = *(const bf16x8*)(wa + 16 * s); bi[s] = *(const bf16x8*)(wi + 16 * s); } }
                const int ch = h * 256 + 32 * w + r;
                const float ba_ = p.in[I_BA][ch], bi_ = p.in[I_BI][ch]; const float L = p.in[I_AP][ch];
                __syncthreads();
                f32x16 aa[2], ai[2];
#pragma unroll
                for (int mb = 0; mb < 2; ++mb)
#pragma unroll
                    for (int q = 0; q < 16; ++q) { aa[mb][q] = 0.f; ai[mb][q] = 0.f; }
#pragma unroll
                for (int s = 0; s < 16; ++s) {
#pragma unroll
                    for (int mb = 0; mb < 2; ++mb) { const bf16x8 af = *(const LAS bf16x8*)(XC + (32 * mb + r) * 264 + 16 * s + 8 * hh);
                        aa[mb] = __builtin_amdgcn_mfma_f32_32x32x16_bf16(af, ba[s], aa[mb], 0, 0, 0); } }
                __builtin_amdgcn_sched_barrier(0);
#pragma unroll
                for (int s = 0; s < 16; ++s) {
#pragma unroll
                    for (int mb = 0; mb < 2; ++mb) { const bf16x8 af = *(const LAS bf16x8*)(XC + (32 * mb + r) * 264 + 16 * s + 8 * hh);
                        ai[mb] = __builtin_amdgcn_mfma_f32_32x32x16_bf16(af, bi[s], ai[mb], 0, 0, 0); } }
                const float sp = fmaxf(-L, 0.f) + log1pf(__expf(-fabsf(L)));
#pragma unroll
                for (int mb = 0; mb < 2; ++mb)
#pragma unroll
                    for (int q = 0; q < 16; ++q) { const int t = 32 * mb + (q & 3) + 8 * (q >> 2) + 4 * hh;
                        if ((q & 3) == 0) __builtin_amdgcn_sched_barrier(0);
                        const float ga = sigmoidf_(aa[mb][q] + ba_), gi = sigmoidf_(ai[mb][q] + bi_);
                        const float la = -8.0f * ga * sp; const float a = __expf(la);
                        const float xcv = bf2f(XC[t * 264 + 32 * w + r]);
                        aa[mb][q] = a; ai[mb][q] = xcv * gi * __builtin_amdgcn_sqrtf(fmaxf(1.0f - a * a, 0.f)); }
#pragma unroll
                for (int mb = 0; mb < 2; ++mb)
#pragma unroll
                    for (int g = 0; g < 4; ++g)
#pragma unroll
                        for (int i = 1; i < 4; ++i) { const int q = 4 * g + i; ai[mb][q] = aa[mb][q] * ai[mb][q - 1] + ai[mb][q]; aa[mb][q] = aa[mb][q] * aa[mb][q - 1]; }
                LAS bf16_t* HL = (LAS bf16_t*)(F.lds); LAS bf16_t* AC = (LAS bf16_t*)(F.lds + 34816);
                float carryH = 0.f, carryP = 1.f;
#pragma unroll
                for (int mb = 0; mb < 2; ++mb)
#pragma unroll
                    for (int g = 0; g < 4; ++g) { const float myP = aa[mb][4 * g + 3], myH = ai[mb][4 * g + 3];
                        const float pP = __shfl_xor(myP, 32), pH = __shfl_xor(myH, 32);
                        const float fP = hh ? pP : myP, fH = hh ? pH : myH, sP = hh ? myP : pP, sH = hh ? myH : pH;
                        const float c1H = fP * carryH + fH, c1P = carryP * fP;
                        const float Cin = hh ? c1H : carryH, Pin = hh ? c1P : carryP;
                        carryH = sP * c1H + sH; carryP = c1P * sP;
#pragma unroll
                        for (int i = 0; i < 4; ++i) { const int q = 4 * g + i, t = 32 * mb + 8 * g + 4 * hh + i;
                            HL[t * 264 + 32 * w + r] = (bf16_t)f2bf(ai[mb][q] + aa[mb][q] * Cin); AC[t * 264 + 32 * w + r] = (bf16_t)f2bf(aa[mb][q] * Pin); } }
                if (hh == 0) { float* SUMA = (float*)(F.ws + WS_SUMA); float* SUMH = (float*)(F.ws + WS_SUMH); SUMA[unit * 1024 + ch] = carryP; SUMH[unit * 1024 + ch] = carryH; }
                __syncthreads();
                { bf16_t* HLOC = (bf16_t*)(F.ws + WS_AUA); bf16_t* ACUM = (bf16_t*)(F.ws + WS_AUU);
#pragma unroll
                  for (int it = 0; it < 4; ++it) { const int item = tid + 512 * it, c8 = item & 31, t = item >> 5; const size_t o = (size_t)(tok0 + t) * 1024 + h * 256 + c8 * 8;
                      *(u32x4*)(HLOC + o) = *(const LAS u32x4*)(HL + t * 264 + c8 * 8); *(u32x4*)(ACUM + o) = *(const LAS u32x4*)(AC + t * 264 + c8 * 8); } }
            }
#endif
            __syncthreads();
        }
    }
}

__device__ __forceinline__ void p2b(Frame& F, const Params& p) {
    const bf16_t* AN = (const bf16_t*)(F.ws + WS_AN); const float* DN = (const float*)(F.ws + WS_DN); bf16_t* SP = (bf16_t*)(F.ws + WS_SP);
    if (F.tid < 128) {
        for (int st = (int)blockIdx.x * 128 + F.tid; st < 32768; st += F.G * 128) {
            const int bh = st >> 12, rem = st & 4095, ln = rem & 63, s2 = (rem >> 6) & 1, w = (rem >> 7) & 7, mb = (rem >> 10) & 3;
            const int kk0 = 32 * mb + 16 * s2 + 4 * (ln >> 5);
            const int offS = (((mb * 8 + w) * 2 + s2) * 64 + ln) * 8;
            f32x4 S0 = (f32x4){0.f, 0.f, 0.f, 0.f}, S1 = S0;
            for (int n0 = 0; n0 < 128; n0 += 16) {
                u32x4 av[16]; f32x4 d0[16], d1[16];
#pragma unroll
                for (int i = 0; i < 16; ++i) { const size_t uh = (size_t)bh * 128 + n0 + i;
                    av[i] = *(const u32x4*)(AN + uh * 32768 + offS);
                    d0[i] = *(const f32x4*)(DN + uh * 128 + kk0); d1[i] = *(const f32x4*)(DN + uh * 128 + kk0 + 8); }
#pragma unroll
                for (int i = 0; i < 16; ++i) { const size_t uh = (size_t)bh * 128 + n0 + i;
                    u32x4 o; o.x = pk2(S0[0], S0[1]); o.y = pk2(S0[2], S0[3]); o.z = pk2(S1[0], S1[1]); o.w = pk2(S1[2], S1[3]);
                    *(u32x4*)(SP + uh * 32768 + offS) = o;
                    const f32x4 a0 = (f32x4){bflo(av[i].x), bfhi(av[i].x), bflo(av[i].y), bfhi(av[i].y)}, a1 = (f32x4){bflo(av[i].z), bfhi(av[i].z), bflo(av[i].w), bfhi(av[i].w)};
                    S0 = d0[i] * S0 + a0; S1 = d1[i] * S1 + a1; } }
        }
    } else if (F.wave == 2) {
        const float* SUMA = (const float*)(F.ws + WS_SUMA); float* SUMH = (float*)(F.ws + WS_SUMH);
        for (int wv = (int)blockIdx.x; wv < 64; wv += F.G) {
            const int seg = F.lane >> 4, sid = wv * 16 + (F.lane & 15), b = sid >> 9, ch = 2 * (sid & 511);
            const size_t o0 = (size_t)(b * 128 + seg * 32) * 1024 + ch;
            f32x2 a[32], hv[32];
#pragma unroll
            for (int q = 0; q < 32; ++q) { a[q] = *(const f32x2*)(SUMA + o0 + (size_t)q * 1024); hv[q] = *(const f32x2*)(SUMH + o0 + (size_t)q * 1024); }
            f32x2 A = (f32x2){1.f, 1.f}, H = (f32x2){0.f, 0.f};
#pragma unroll
            for (int q = 0; q < 32; ++q) { H = a[q] * H + hv[q]; A = a[q] * A; }
            f32x2 hc = (f32x2){0.f, 0.f};
#pragma unroll
            for (int k = 0; k < 3; ++k) { const int src = k * 16 + (F.lane & 15);
                const f32x2 Ak = (f32x2){__shfl(A.x, src), __shfl(A.y, src)}, Hk = (f32x2){__shfl(H.x, src), __shfl(H.y, src)};
                if (k < seg) hc = Ak * hc + Hk; }
#pragma unroll
            for (int q = 0; q < 32; ++q) { *(f32x2*)(SUMH + o0 + (size_t)q * 1024) = hc; hc = a[q] * hc + hv[q]; }
        }
    }
}

__device__ __forceinline__ void p2c(Frame& F, const Params& p) {
    const bf16_t* Z = (const bf16_t*)(F.ws + WS_Z); const float* GLOW = (const float*)(F.ws + WS_LG); const bf16_t* SP = (const bf16_t*)(F.ws + WS_SP);
    LAS float* GL = (LAS float*)(F.lds + 124928); const float* wg = p.in[I_GWG]; const float* bgp = p.in[I_GBG];
    bf16_t* MIX = (bf16_t*)(F.ws + WS_MIX);
    LAS float* BC = (LAS float*)(F.lds); LAS float* SEG = (LAS float*)(F.lds + 32768);
    LAS bf16_t* QE = (LAS bf16_t*)(F.lds + 34816); LAS bf16_t* KE = (LAS bf16_t*)(F.lds + 52224); LAS bf16_t* VT = (LAS bf16_t*)(F.lds + 69632);
    LAS float* SSQ = (LAS float*)(F.lds + 106496); LAS float* OS = (LAS float*)(F.lds);
    const int w = F.wave;
    const float* gng = p.in[I_GNG];
    for (int unit = blockIdx.x; unit < NCHUNK; unit += F.G) {
        const int b = unit >> 7, n = unit & 127, tok0 = b * SEQL + 64 * n;
        const int lane = fresh_lane(), tid = w * 64 + lane, r = lane & 31, hh = lane >> 5;
        { const float* SUMH = (const float*)(F.ws + WS_SUMH);
          const int ch = 2 * tid; const f32x2 hc = *(const f32x2*)(SUMH + (size_t)unit * 1024 + ch);
          const bf16_t* HLOC = (const bf16_t*)(F.ws + WS_AUA); const bf16_t* ACUM = (const bf16_t*)(F.ws + WS_AUU);
          unsigned hv[16], av[16], lgw[16];
#pragma unroll
          for (int i = 0; i < 16; ++i) { const size_t tok = (size_t)tok0 + i;
              hv[i] = *(const unsigned*)(HLOC + tok * 1024 + ch); av[i] = *(const unsigned*)(ACUM + tok * 1024 + ch); lgw[i] = *(const unsigned*)(Z + tok * ZC + ZLG + ch); }
#pragma unroll 1
          for (int t0 = 0; t0 < 64; t0 += 16) {
              unsigned hc_[16], ac_[16], lc_[16];
#pragma unroll
              for (int i = 0; i < 16; ++i) { hc_[i] = hv[i]; ac_[i] = av[i]; lc_[i] = lgw[i]; }
              if (t0 + 16 < 64) {
#pragma unroll
                  for (int i = 0; i < 16; ++i) { const size_t tok = (size_t)tok0 + t0 + 16 + i;
                      hv[i] = *(const unsigned*)(HLOC + tok * 1024 + ch); av[i] = *(const unsigned*)(ACUM + tok * 1024 + ch); lgw[i] = *(const unsigned*)(Z + tok * ZC + ZLG + ch); } }
#pragma unroll
              for (int i = 0; i < 16; ++i) { const size_t tok = (size_t)tok0 + t0 + i;
                  const float h0 = bflo(hc_[i]) + bflo(ac_[i]) * hc.x, h1 = bfhi(hc_[i]) + bfhi(ac_[i]) * hc.y;
                  *(unsigned*)(MIX + tok * DM + 1024 + ch) = pk2(h0 * gelu_tanh_f(bflo(lc_[i])), h1 * gelu_tanh_f(bfhi(lc_[i]))); } } }
        { const f32x2 gq = *(const f32x2*)(GLOW + (size_t)tok0 * 16 + 2 * tid); *(LAS f32x2*)(GL + 2 * tid) = gq; }
        __syncthreads();
        for (int h = 0; h < 4; ++h) {
            const int uh = (b * 4 + h) * 128 + n;
            u32x4 qvr[2], kvr[2], vvr[4];
#pragma unroll
            for (int it = 0; it < 2; ++it) { const int item = tid + 512 * it, kk8 = item & 15, t = item >> 4;
                qvr[it] = *(const u32x4*)(Z + (size_t)(tok0 + t) * ZC + ZQ + h * 128 + kk8 * 8); kvr[it] = *(const u32x4*)(Z + (size_t)(tok0 + t) * ZC + ZK + h * 128 + kk8 * 8); }
#pragma unroll
            for (int it = 0; it < 4; ++it) { const int item = tid + 512 * it, t = item & 63, vc8 = item >> 6; vvr[it] = *(const u32x4*)(Z + (size_t)(tok0 + t) * ZC + ZV + h * 256 + vc8 * 8); }
            gla_cumsum(GL, wg, bgp, h, BC, SEG, tid);
            bf16x8 sf[4][2];
            { const bf16_t* spu = SP + (size_t)uh * 32768;
#pragma unroll
              for (int mb = 0; mb < 4; ++mb)
#pragma unroll
                  for (int s2 = 0; s2 < 2; ++s2) sf[mb][s2] = *(const bf16x8*)(spu + (((mb * 8 + w) * 2 + s2) * 64 + lane) * 8); }
#pragma unroll
            for (int it = 0; it < 2; ++it) { const int item = tid + 512 * it, kk8 = item & 15, t = item >> 4;
                const u32x4 qv = qvr[it];
                const u32x4 kv = kvr[it];
                const f32x4 b0 = *(const LAS f32x4*)(BC + t * 128 + kk8 * 8), b1 = *(const LAS f32x4*)(BC + t * 128 + kk8 * 8 + 4);
                float qe[8], ke[8];
#pragma unroll
                for (int i = 0; i < 8; ++i) { const float bb = (i < 4) ? b0[i & 3] : b1[i & 3]; const unsigned qw = qv[i >> 1], kw = kv[i >> 1];
                    const float qf = (i & 1) ? bfhi(qw) : bflo(qw), kf = (i & 1) ? bfhi(kw) : bflo(kw);
                    qe[i] = qf * 0.08838834764831845f * __expf(bb); ke[i] = kf * __expf(-bb); }
                u32x4 oq, ok; oq.x = pk2(qe[0], qe[1]); oq.y = pk2(qe[2], qe[3]); oq.z = pk2(qe[4], qe[5]); oq.w = pk2(qe[6], qe[7]);
                ok.x = pk2(ke[0], ke[1]); ok.y = pk2(ke[2], ke[3]); ok.z = pk2(ke[4], ke[5]); ok.w = pk2(ke[6], ke[7]);
                *(LAS u32x4*)(QE + t * 136 + kk8 * 8) = oq; *(LAS u32x4*)(KE + t * 136 + kk8 * 8) = ok; }
#pragma unroll
            for (int it = 0; it < 4; ++it) { const int item = tid + 512 * it, t = item & 63, vc8 = item >> 6;
                const u32x4 vv = vvr[it];
#pragma unroll
                for (int i = 0; i < 8; ++i) { const unsigned wv = vv[i >> 1]; VT[(vc8 * 8 + i) * 72 + t] = (bf16_t)((i & 1) ? (wv >> 16) : (wv & 0xffffu)); } }
            __syncthreads();
            f32x16 oacc[2];
            {
                f32x16 P00, P01, P11;
#pragma unroll
                for (int q = 0; q < 16; ++q) { P00[q] = 0.f; P01[q] = 0.f; P11[q] = 0.f; oacc[0][q] = 0.f; oacc[1][q] = 0.f; }
#pragma unroll
                for (int s = 0; s < 8; ++s) {
                    const bf16x8 a0 = *(const LAS bf16x8*)(KE + r * 136 + 16 * s + 8 * hh), a1 = *(const LAS bf16x8*)(KE + (32 + r) * 136 + 16 * s + 8 * hh);
                    const bf16x8 b0 = *(const LAS bf16x8*)(QE + r * 136 + 16 * s + 8 * hh), b1 = *(const LAS bf16x8*)(QE + (32 + r) * 136 + 16 * s + 8 * hh);
                    P00 = __builtin_amdgcn_mfma_f32_32x32x16_bf16(a0, b0, P00, 0, 0, 0);
                    P01 = __builtin_amdgcn_mfma_f32_32x32x16_bf16(a0, b1, P01, 0, 0, 0);
                    P11 = __builtin_amdgcn_mfma_f32_32x32x16_bf16(a1, b1, P11, 0, 0, 0); }
#pragma unroll
                for (int q = 0; q < 16; ++q) { const int jl = (q & 3) + 8 * (q >> 2) + 4 * hh; if (jl > r) { P00[q] = 0.f; P11[q] = 0.f; } }
                bf16x8 F00[2], F01[2], F11[2];
#pragma unroll
                for (int s2 = 0; s2 < 2; ++s2) {
                    u32x4 t0, t1, t2;
#pragma unroll
                    for (int q = 0; q < 4; ++q) { t0[q] = pk2(P00[8 * s2 + 2 * q], P00[8 * s2 + 2 * q + 1]); t1[q] = pk2(P01[8 * s2 + 2 * q], P01[8 * s2 + 2 * q + 1]); t2[q] = pk2(P11[8 * s2 + 2 * q], P11[8 * s2 + 2 * q + 1]); }
                    F00[s2] = as_bf16x8(t0); F01[s2] = as_bf16x8(t1); F11[s2] = as_bf16x8(t2); }
#pragma unroll
                for (int mb = 0; mb < 4; ++mb)
#pragma unroll
                    for (int s2 = 0; s2 < 2; ++s2) { const bf16x8 af = sf[mb][s2];
                        const int kkb = 32 * mb + 16 * s2 + 4 * hh;
#pragma unroll
                        for (int ib = 0; ib < 2; ++ib) { const bf16x4 lo = *(const LAS bf16x4*)(QE + (32 * ib + r) * 136 + kkb), hi = *(const LAS bf16x4*)(QE + (32 * ib + r) * 136 + kkb + 8);
                            oacc[ib] = __builtin_amdgcn_mfma_f32_32x32x16_bf16(af, cat4(lo, hi), oacc[ib], 0, 0, 0); } }
#pragma unroll
                for (int s2 = 0; s2 < 2; ++s2) {
                    const int tb0 = 16 * s2 + 4 * hh, tb1 = 32 + 16 * s2 + 4 * hh;
                    const bf16x8 v0 = cat4(*(const LAS bf16x4*)(VT + (32 * w + r) * 72 + tb0), *(const LAS bf16x4*)(VT + (32 * w + r) * 72 + tb0 + 8));
                    const bf16x8 v1 = cat4(*(const LAS bf16x4*)(VT + (32 * w + r) * 72 + tb1), *(const LAS bf16x4*)(VT + (32 * w + r) * 72 + tb1 + 8));
                    oacc[0] = __builtin_amdgcn_mfma_f32_32x32x16_bf16(v0, F00[s2], oacc[0], 0, 0, 0);
                    oacc[1] = __builtin_amdgcn_mfma_f32_32x32x16_bf16(v0, F01[s2], oacc[1], 0, 0, 0);
                    oacc[1] = __builtin_amdgcn_mfma_f32_32x32x16_bf16(v1, F11[s2], oacc[1], 0, 0, 0); }
            }
            u32x4 rvr[4];
#pragma unroll
            for (int it = 0; it < 4; ++it) { const int item = tid + 512 * it, vc8 = item & 31, t = item >> 5; rvr[it] = *(const u32x4*)(Z + (size_t)(tok0 + t) * ZC + ZR + h * 256 + vc8 * 8); }
#pragma unroll
            for (int ib = 0; ib < 2; ++ib) { float sq = 0.f;
#pragma unroll
                for (int q = 0; q < 16; ++q) sq += oacc[ib][q] * oacc[ib][q];
                sq += __shfl_xor(sq, 32);
                if (hh == 0) SSQ[w * 64 + 32 * ib + r] = sq; }
            __syncthreads();
#pragma unroll
            for (int ib = 0; ib < 2; ++ib) { float tot = 0.f;
#pragma unroll
                for (int w2 = 0; w2 < 8; ++w2) tot += SSQ[w2 * 64 + 32 * ib + r];
                const float rs = rsqrtf_(tot * (1.0f / 256.0f) + 1e-6f);
#pragma unroll
                for (int g = 0; g < 4; ++g) *(LAS f32x4*)(OS + (32 * ib + r) * 260 + 32 * w + 8 * g + 4 * hh) =
                    (f32x4){oacc[ib][4 * g] * rs, oacc[ib][4 * g + 1] * rs, oacc[ib][4 * g + 2] * rs, oacc[ib][4 * g + 3] * rs}; }
            __syncthreads();
#pragma unroll
            for (int it = 0; it < 4; ++it) { const int item = tid + 512 * it, vc8 = item & 31, t = item >> 5; const int c = h * 256 + vc8 * 8;
                const f32x4 o0 = *(const LAS f32x4*)(OS + t * 260 + vc8 * 8), o1 = *(const LAS f32x4*)(OS + t * 260 + vc8 * 8 + 4);
                const u32x4 rv = rvr[it];
                const f32x4 g0 = *(const f32x4*)(gng + c), g1 = *(const f32x4*)(gng + c + 4);
                float o[8];
#pragma unroll
                for (int i = 0; i < 8; ++i) { const unsigned rw = rv[i >> 1]; const float rf = (i & 1) ? bfhi(rw) : bflo(rw);
                    const float sil = rf * sigmoidf_(rf); o[i] = sil * ((i < 4) ? o0[i & 3] * g0[i & 3] : o1[i & 3] * g1[i & 3]); }
                u32x4 ov; ov.x = pk2(o[0], o[1]); ov.y = pk2(o[2], o[3]); ov.z = pk2(o[4], o[5]); ov.w = pk2(o[6], o[7]);
                *(u32x4*)(MIX + (size_t)(tok0 + t) * DM + c) = ov; }
            __syncthreads();
        }
    }
}

__device__ __forceinline__ void build_moe_tables(Frame& F) {
    unsigned* cnt = (unsigned*)(F.ws + WS_CTL) + CW_CNT;
    if (F.tid < 64) {
        const int e = F.tid; const int c = (e < NEXP) ? (int)xb_ld(cnt + 64 * e) : 0; const int mt = (c + 255) >> 8;
        int inc = mt;
#pragma unroll
        for (int d = 1; d < 32; d <<= 1) { const int o = __shfl_up(inc, d); if ((e & 63) >= d) inc += o; }
        const int first = inc - mt;
        if (e < NEXP) { F.MISC[MI_PBASE + e] = (unsigned)(first * 256); F.MISC[MI_CNT + e] = (unsigned)c;
            for (int q = 0; q < mt; ++q) F.MISC[MI_T2E + first + q] = (unsigned)e;
            if (e == NEXP - 1) F.MISC[MI_NMT] = (unsigned)inc; }
    }
    __syncthreads();
}

__device__ __forceinline__ void p4a(Frame& F, const Params& p) {
    const bf16_t* XMID = (const bf16_t*)(F.ws + WS_XMID); const float* WrT = (const float*)(F.ws + WS_WRT); const float* br = p.in[I_BR];
    float* RSTD = (float*)(F.ws + WS_RSTD); unsigned* TOKE = (unsigned*)(F.ws + WS_TOKE); float* GATES = (float*)(F.ws + WS_GATES);
    unsigned* cnt = (unsigned*)(F.ws + WS_CTL) + CW_CNT;
    unsigned char* HF8 = F.ws + WS_HF8; unsigned short* LIST = (unsigned short*)(F.ws + WS_LIST); const float* gf = p.in[I_NFG];
    LAS float* RED = (LAS float*)(F.lds); LAS float* SSQ2 = (LAS float*)(F.lds + 32768); LAS float* LGT = (LAS float*)(F.lds + 33792); LAS float* RS = (LAS float*)(F.lds + 38016);
    const int tid = F.tid, lane = F.lane, w = F.wave, m = lane & 31, kh = lane >> 5;
    if (tid < 32) F.MISC[MI_LCNT + tid] = 0u;
    __syncthreads();
    f32x4 bw[32];
    { const float* bp = WrT + (size_t)m * DM + 256 * w + 128 * kh;
#pragma unroll
      for (int c = 0; c < 32; ++c) bw[c] = *(const f32x4*)(bp + 4 * c); }
    LAS float* RSA = (LAS float*)(F.lds + 38400);
    int ui = 0;
    for (int ut = blockIdx.x; ut < T / 32; ut += F.G, ++ui) {
        const int m0 = 32 * ut; const int kw = 256 * w + 128 * kh;
        f32x16 acc;
#pragma unroll
        for (int q = 0; q < 16; ++q) acc[q] = 0.f;
        float ss = 0.f;
        const bf16_t* ap = XMID + (size_t)(m0 + m) * DM + kw;
        u32x4 ar[16];
#pragma unroll
        for (int c = 0; c < 16; ++c) ar[c] = *(const u32x4*)(ap + 8 * c);
#pragma unroll
        for (int c = 0; c < 16; ++c) { const u32x4 r0 = ar[c];
            const f32x4 a0 = (f32x4){bflo(r0.x), bfhi(r0.x), bflo(r0.y), bfhi(r0.y)}, a1 = (f32x4){bflo(r0.z), bfhi(r0.z), bflo(r0.w), bfhi(r0.w)};
#pragma unroll
            for (int i = 0; i < 4; ++i) { acc = __builtin_amdgcn_mfma_f32_32x32x2f32(a0[i], bw[2 * c][i], acc, 0, 0, 0); ss += a0[i] * a0[i]; }
#pragma unroll
            for (int i = 0; i < 4; ++i) { acc = __builtin_amdgcn_mfma_f32_32x32x2f32(a1[i], bw[2 * c + 1][i], acc, 0, 0, 0); ss += a1[i] * a1[i]; } }
        ss += __shfl_xor(ss, 32);
#pragma unroll
        for (int q = 0; q < 16; ++q) RED[(w * 16 + q) * 64 + lane] = acc[q];
        if (kh == 0) SSQ2[w * 32 + m] = ss;
        __syncthreads();
#pragma unroll
        for (int it = 0; it < 2; ++it) { const int o = tid + 512 * it, reg = o >> 6, ln = o & 63, nn = ln & 31, h2 = ln >> 5; const int mm = (reg & 3) + 8 * (reg >> 2) + 4 * h2;
            float v = 0.f, s2 = 0.f;
#pragma unroll
            for (int w2 = 0; w2 < 8; ++w2) { v += RED[(w2 * 16 + reg) * 64 + ln]; s2 += SSQ2[w2 * 32 + mm]; }
            const float rs = rsqrtf_(s2 * (1.0f / DM) + 1e-6f);
            LGT[mm * 33 + nn] = v * rs + br[nn]; if (nn == 0) { RS[mm] = rs; RSA[32 * ui + mm] = rs; } }
        __syncthreads();
        int ex[4]; unsigned ls[4]; float gt[4];
        if (tid < 32) {
            float l[32];
#pragma unroll
            for (int i = 0; i < 32; ++i) l[i] = LGT[tid * 33 + i];
            float val[4];
#pragma unroll
            for (int k = 0; k < 4; ++k) { float best = -3.0e38f; int bi = 0;
#pragma unroll
                for (int i = 0; i < 32; ++i) if (l[i] > best) { best = l[i]; bi = i; }
                ex[k] = bi; val[k] = best;
#pragma unroll
                for (int i = 0; i < 32; ++i) if (i == bi) l[i] = -3.0e38f; }
            float s = 0.f;
#pragma unroll
            for (int k = 0; k < 4; ++k) { gt[k] = __expf(val[k] - val[0]); s += gt[k]; }
            const float inv = __builtin_amdgcn_rcpf(s);
#pragma unroll
            for (int k = 0; k < 4; ++k) { gt[k] *= inv; ls[k] = __hip_atomic_fetch_add((LAS unsigned*)(F.MISC + MI_LCNT + ex[k]), 1u, __ATOMIC_RELAXED, __HIP_MEMORY_SCOPE_WORKGROUP); }
        }
        __syncthreads();
        if (tid < 32) { const unsigned c = F.MISC[MI_LCNT + tid]; F.MISC[MI_LBASE + tid] = c ? xb_add(cnt + 64 * tid, c) : 0u; F.MISC[MI_LCNT + tid] = 0u; }
        __syncthreads();
        if (tid < 32) { const int tok = m0 + tid;
#pragma unroll
            for (int k = 0; k < 4; ++k) { const unsigned slot = F.MISC[MI_LBASE + ex[k]] + ls[k]; TOKE[tok * 4 + k] = (unsigned)ex[k] | (slot << 8); GATES[tok * 4 + k] = gt[k]; LIST[(size_t)ex[k] * 16384 + (slot & ~255u) + ((slot & 63u) << 2) + ((slot >> 6) & 3u)] = (unsigned short)tok; }
            RSTD[tok] = RS[tid]; }
        __syncthreads();
    }
    { const int ntok = 32 * ui; const int l = lane;
      f32x4 gv[8];
#pragma unroll
      for (int j = 0; j < 4; ++j) { gv[2 * j] = *(const f32x4*)(gf + 8 * l + 512 * j) * 16.0f; gv[2 * j + 1] = *(const f32x4*)(gf + 8 * l + 512 * j + 4) * 16.0f; }
      u32x4 xn[4];
      int jt = w;
      if (jt < ntok) { const size_t tk = (size_t)32 * (blockIdx.x + (jt >> 5) * F.G) + (jt & 31);
#pragma unroll
          for (int j = 0; j < 4; ++j) xn[j] = *(const u32x4*)(XMID + tk * DM + 8 * l + 512 * j); }
      for (; jt < ntok; jt += 8) {
          const size_t tk = (size_t)32 * (blockIdx.x + (jt >> 5) * F.G) + (jt & 31); const float rs = RSA[jt]; u32x2 o[4];
#pragma unroll
          for (int j = 0; j < 4; ++j) { const u32x4 xr = xn[j]; const f32x4 a = (f32x4){bflo(xr.x), bfhi(xr.x), bflo(xr.y), bfhi(xr.y)} * rs * gv[2 * j], b = (f32x4){bflo(xr.z), bfhi(xr.z), bflo(xr.w), bfhi(xr.w)} * rs * gv[2 * j + 1];
              o[j].x = pk4_fp8(a[0], a[1], a[2], a[3]); o[j].y = pk4_fp8(b[0], b[1], b[2], b[3]); }
          const int j2 = jt + 8;
          if (j2 < ntok) { const size_t t2 = (size_t)32 * (blockIdx.x + (j2 >> 5) * F.G) + (j2 & 31);
#pragma unroll
              for (int j = 0; j < 4; ++j) xn[j] = *(const u32x4*)(XMID + t2 * DM + 8 * l + 512 * j); }
#pragma unroll
          for (int j = 0; j < 4; ++j) *(u32x2*)(HF8 + tk * DM + 8 * l + 512 * j) = o[j]; } }
}

__device__ __forceinline__ void p4b(Frame& F, const Params& p) {
    build_moe_tables(F);
    const bf16_t* XMID = (const bf16_t*)(F.ws + WS_XMID); const float* RSTD = (const float*)(F.ws + WS_RSTD); const unsigned* TOKE = (const unsigned*)(F.ws + WS_TOKE);
    const float* gf = p.in[I_NFG]; unsigned char* ABUF = F.ws + WS_ABUF;
    const int l = F.lane;
    u32x4 xn[4]; float rsn = 0.f; unsigned ten[4] = {0u, 0u, 0u, 0u};
    if (F.gw < T) { rsn = RSTD[F.gw];
#pragma unroll
        for (int k = 0; k < 4; ++k) ten[k] = TOKE[F.gw * 4 + k];
#pragma unroll
        for (int j = 0; j < 4; ++j) xn[j] = *(const u32x4*)(XMID + (size_t)F.gw * DM + 8 * l + 512 * j); }
    f32x4 gv[8];
#pragma unroll
    for (int j = 0; j < 4; ++j) { gv[2 * j] = *(const f32x4*)(gf + 8 * l + 512 * j) * 16.0f; gv[2 * j + 1] = *(const f32x4*)(gf + 8 * l + 512 * j + 4) * 16.0f; }
    for (int tok = F.gw; tok < T; tok += F.NGW) {
        const float rs = rsn; unsigned te[4]; u32x2 o[4];
#pragma unroll
        for (int k = 0; k < 4; ++k) te[k] = ten[k];
#pragma unroll
        for (int j = 0; j < 4; ++j) { const u32x4 xr = xn[j]; const f32x4 a = (f32x4){bflo(xr.x), bfhi(xr.x), bflo(xr.y), bfhi(xr.y)} * rs * gv[2 * j], b = (f32x4){bflo(xr.z), bfhi(xr.z), bflo(xr.w), bfhi(xr.w)} * rs * gv[2 * j + 1];
            o[j].x = pk4_fp8(a[0], a[1], a[2], a[3]); o[j].y = pk4_fp8(b[0], b[1], b[2], b[3]); }
        const int t2 = tok + F.NGW;
        if (t2 < T) { rsn = RSTD[t2];
#pragma unroll
            for (int k = 0; k < 4; ++k) ten[k] = TOKE[t2 * 4 + k];
#pragma unroll
            for (int j = 0; j < 4; ++j) xn[j] = *(const u32x4*)(XMID + (size_t)t2 * DM + 8 * l + 512 * j); }
#pragma unroll
        for (int k = 0; k < 4; ++k) { const size_t row = (size_t)F.MISC[MI_PBASE + (te[k] & 255u)] + (te[k] >> 8);
#pragma unroll
            for (int j = 0; j < 4; ++j) *(u32x2*)(ABUF + row * DM + 8 * l + 512 * j) = o[j]; }
    }
}

__device__ __forceinline__ void p7(Frame& F, const Params& p) {
    build_moe_tables(F);
    const bf16_t* XMID = (const bf16_t*)(F.ws + WS_XMID); const unsigned* TOKE = (const unsigned*)(F.ws + WS_TOKE); const float* GATES = (const float*)(F.ws + WS_GATES);
    const unsigned char* Y = F.ws + WS_Y; const float* gfin = p.in[I_NFINAL];
    const int l = F.lane;
    u32x4 xn[4]; u32x2 yn[4][4]; float gkn[4] = {0.f, 0.f, 0.f, 0.f};
#define P7_FETCH(tk) do { \
        _Pragma("unroll") for (int k = 0; k < 4; ++k) { const unsigned te = TOKE[(tk) * 4 + k]; gkn[k] = GATES[(tk) * 4 + k]; const size_t row = (size_t)F.MISC[MI_PBASE + (te & 255u)] + (te >> 8); \
            _Pragma("unroll") for (int j = 0; j < 4; ++j) yn[k][j] = *(const u32x2*)(Y + row * DM + 8 * l + 512 * j); } \
        _Pragma("unroll") for (int j = 0; j < 4; ++j) xn[j] = *(const u32x4*)(XMID + (size_t)(tk) * DM + 8 * l + 512 * j); } while (0)
    if (F.gw < T) P7_FETCH(F.gw);
    f32x4 g0[4], g1[4];
#pragma unroll
    for (int j = 0; j < 4; ++j) { g0[j] = *(const f32x4*)(gfin + 8 * l + 512 * j); g1[j] = *(const f32x4*)(gfin + 8 * l + 512 * j + 4); }
    for (int tok = F.gw; tok < T; tok += F.NGW) {
        f32x4 xv[8];
#pragma unroll
        for (int j = 0; j < 4; ++j) { const u32x4 xr = xn[j]; xv[2 * j] = (f32x4){bflo(xr.x), bfhi(xr.x), bflo(xr.y), bfhi(xr.y)}; xv[2 * j + 1] = (f32x4){bflo(xr.z), bfhi(xr.z), bflo(xr.w), bfhi(xr.w)}; }
#pragma unroll
        for (int k = 0; k < 4; ++k)
#pragma unroll
            for (int j = 0; j < 4; ++j) { const u32x2 y2 = yn[k][j]; const float gk = gkn[k] * (1.0f / 32.0f);
                xv[2 * j][0] += gk * fp8f(y2.x, 0); xv[2 * j][1] += gk * fp8f(y2.x, 1); xv[2 * j][2] += gk * fp8f(y2.x, 2); xv[2 * j][3] += gk * fp8f(y2.x, 3);
                xv[2 * j + 1][0] += gk * fp8f(y2.y, 0); xv[2 * j + 1][1] += gk * fp8f(y2.y, 1); xv[2 * j + 1][2] += gk * fp8f(y2.y, 2); xv[2 * j + 1][3] += gk * fp8f(y2.y, 3); }
        const int t2 = tok + F.NGW;
        if (t2 < T) P7_FETCH(t2);
        float ss = 0.f;
#pragma unroll
        for (int j = 0; j < 8; ++j) ss += (xv[j][0] * xv[j][0] + xv[j][1] * xv[j][1]) + (xv[j][2] * xv[j][2] + xv[j][3] * xv[j][3]);
        const float rs = rsqrtf_(wave_sum(ss) * (1.0f / DM) + 1e-6f);
#pragma unroll
        for (int j = 0; j < 4; ++j) { *(f32x4*)(p.out + (size_t)tok * DM + 8 * l + 512 * j) = xv[2 * j] * rs * g0[j]; *(f32x4*)(p.out + (size_t)tok * DM + 8 * l + 512 * j + 4) = xv[2 * j + 1] * rs * g1[j]; }
    }
#undef P7_FETCH
}

#ifdef PROBE_STREAM
__device__ __forceinline__ void probe_stream(Frame& F, const Params& p) {
    const f32x4* src = (const f32x4*)p.in[I_WGU]; const size_t n4 = (size_t)32 * 2048 * 4096 / 4;
    const f32x4* src2 = (const f32x4*)p.in[I_WDN]; const size_t m4 = (size_t)32 * 2048 * 2048 / 4;
    f32x4 acc = (f32x4){0.f, 0.f, 0.f, 0.f};
    for (size_t base = (size_t)F.gw * 1024; base < n4; base += (size_t)F.NGW * 1024) {
        f32x4 v[16];
#pragma unroll
        for (int i = 0; i < 16; ++i) v[i] = src[base + i * 64 + F.lane];
#pragma unroll
        for (int i = 0; i < 16; ++i) acc += v[i]; }
    for (size_t base = (size_t)F.gw * 1024; base < m4; base += (size_t)F.NGW * 1024) {
        f32x4 v[16];
#pragma unroll
        for (int i = 0; i < 16; ++i) v[i] = src2[base + i * 64 + F.lane];
#pragma unroll
        for (int i = 0; i < 16; ++i) acc += v[i]; }
    if (acc[0] + acc[1] + acc[2] + acc[3] == 12345.678f) p.out[0] = 1.0f;
}
#endif
#ifdef PROBE_ORDER
__device__ __forceinline__ void probe_order(Frame& F, const Params& p) {
    volatile LAS unsigned* flag = F.MISC + 2000;
    if (F.wave < 4) {
        const unsigned* hot = (const unsigned*)p.in[I_X] + (size_t)blockIdx.x * 16384;
        unsigned idx = F.tid & 255, sm = 0;
        for (int it = 0; it < 600; ++it) {
            const unsigned b = idx * 4 + (it & 3) * 1024;
            const unsigned v0 = hot[b & 16383], v1 = hot[(b + 4096) & 16383], v2 = hot[(b + 8192) & 16383], v3 = hot[(b + 12288) & 16383];
            sm += v0 + v1 + v2 + v3; idx = (idx + (sm & 3)) & 255;
        }
        if (sm == 0x12345678u) p.out[0] = 1.0f;
        *flag = 1u;
    } else {
#if PROBE_ORDER == 2
        const f32x4* src = (const f32x4*)p.in[I_WGU];
        f32x4 acc = (f32x4){0.f, 0.f, 0.f, 0.f}; unsigned it = 0;
        const unsigned sw = blockIdx.x * 4 + (F.wave - 4);
        while (*flag == 0u) {
            const size_t base = (((size_t)it * 1024 + sw) * 1024) & (((size_t)1 << 26) - 1);
            f32x4 v[16];
#pragma unroll
            for (int i = 0; i < 16; ++i) v[i] = src[base + i * 64 + F.lane];
#pragma unroll
            for (int i = 0; i < 16; ++i) acc += v[i];
            ++it;
        }
        if (acc[0] + acc[1] + acc[2] + acc[3] == 12345.678f) p.out[1] = 1.0f;
#endif
    }
    __syncthreads();
}
#endif
constexpr int NPHASE = 11;
constexpr int HOST_DN_EXPERTS = 24;
constexpr int CONV_EXPERTS = 28, CONV_END = CONV_EXPERTS * 8192, CONV_P1 = 2048 * 81;
#ifndef KROT5
#define KROT5 false
#endif
#ifndef KROT6
#define KROT6 false
#endif
#ifndef STAG5
#define STAG5 0
#endif
#ifndef STAG6
#define STAG6 0
#endif
__global__ void __launch_bounds__(512, 2) mk_fwd(Params p) {
    extern __shared__ __attribute__((aligned(16))) unsigned char lds_raw[];
    Frame F;
    F.lds = (LAS unsigned char*)lds_raw; F.MISC = (volatile LAS unsigned*)(F.lds + MISC_OFF);
    F.wave = __builtin_amdgcn_readfirstlane((int)threadIdx.x >> 6);
#define FRESH() do { F.lane = fresh_lane(); F.tid = F.wave * 64 + F.lane; } while (0)
    FRESH();
    F.G = gridDim.x; F.gw = (int)blockIdx.x * 8 + F.wave; F.NGW = F.G * 8; F.ws = p.ws;
    for (int u = F.tid; u < (LDS_BYTES - MISC_OFF) / 4; u += 512) F.MISC[u] = 0u;
    __syncthreads();
    const int lo = p.ph_lo, hi = p.ph_hi;
    XcdBarrier bar; bar.bar = (unsigned*)(F.ws + WS_CTL) + CW_BAR; bar.x = 0; bar.st = F.MISC;
    if (hi - lo > 1) bar = xcd_barrier_post((unsigned*)(F.ws + WS_CTL) + CW_BAR, F.MISC, F.tid == 0);
#ifndef PHASE_MASK
#define PHASE_MASK 0x7ff
#endif
#define IN(k) (((PHASE_MASK >> (k)) & 1) && lo <= (k) && (k) < hi)
#define SEAM(k) do { if (IN(k) && IN((k) + 1)) xcd_barrier(bar, F.wave == 0 && fresh_lane() == 0); } while (0)
#ifndef REPEAT_MASK
#define REPEAT_MASK 0
#endif
#define REP(k) for (int rep_ = 0; rep_ < (((REPEAT_MASK >> (k)) & 1) ? 2 : 1); ++rep_)
    LAS unsigned char* ring = F.lds;
#ifdef PROBE_STREAM
    if (IN(0)) { probe_stream(F, p); }
#endif
#ifdef PROBE_ORDER
    if (IN(0)) { probe_order(F, p); }
#endif
    if (IN(0)) { REP(11) { FRESH(); p0a(F, p); } REP(12) { FRESH(); p0b(F, p); } SEAM(0); }
    if (IN(1)) REP(1) {

#ifdef SIM_FP8
        pg8::Gemm g{F.ws + WS_MIX, F.ws + WS_WINT};
#else
        pg8::Gemm g{F.ws + WS_H, F.ws + WS_WINT};
#endif
 using GS = pg8::GShape<DM * 2, DM * 2, DM * 2, 0>; pg8::StaticOrder S; S.init(T, ZC, F.G, (int)blockIdx.x);
        pg8::EpiBf16 E{(bf16_t*)(F.ws + WS_Z), ZC, nullptr, 0};
        pg8::ConvGU cv{p.in[I_WGU], F.ws + WS_WGUT, F.gw, CONV_END, F.NGW, 0};
        pg8::gemm_phase<pg8::EpiBf16, pg8::StaticOrder, GS, true, false, 0, pg8::ConvGU>(ring, g, S, E, F.wave, cv); SEAM(1); }
    if (IN(2)) REP(2) { FRESH(); p2a(F, p); SEAM(2); }
    if (IN(3)) REP(3) { FRESH(); p2b(F, p); SEAM(3); }
    if (IN(4)) REP(4) { FRESH(); p2c(F, p); SEAM(4); }
    if (IN(5)) REP(5) {
        pg8::Gemm g{F.ws + WS_MIX, F.ws + WS_WOUTT}; using GS = pg8::GShape<DM * 2, DM * 2, DM * 2, 0>; pg8::StaticOrder S; S.init(T, DM, F.G, (int)blockIdx.x);
        pg8::EpiBf16Res E{(bf16_t*)(F.ws + WS_XMID), p.in[I_X], DM};
        pg8::ConvGU cv{p.in[I_WGU], F.ws + WS_WGUT, CONV_P1 + F.gw, CONV_END, F.NGW, 0};
        pg8::gemm_phase<pg8::EpiBf16Res, pg8::StaticOrder, GS, true, false, 0, pg8::ConvGU>(ring, g, S, E, F.wave, cv); SEAM(5); }
    if (IN(6)) { FRESH(); p4a(F, p); SEAM(6); }
    if (IN(8)) {
        FRESH(); build_moe_tables(F);
        pg8::Gemm g{F.ws + WS_HF8, F.ws + WS_WGUT}; using GS = pg8::GShape<DM, DM, DM, (size_t)4096 * DM>;
        pg8::MoeOrder S{__builtin_amdgcn_readfirstlane((int)F.MISC[MI_NMT]), 16, F.G, (int)blockIdx.x, (const LAS int*)(F.lds + MISC_OFF + 4 * MI_T2E)};
        pg8::EpiSwiGLU8 E{F.ws + WS_ACT, DM, p.in[I_BGU]};
        pg8::Gather gi{(const unsigned short*)(F.ws + WS_LIST), (const LAS unsigned*)(F.lds + MISC_OFF + 4 * MI_PBASE), (const LAS unsigned*)(F.lds + MISC_OFF + 4 * MI_CNT)};
        pg8::EpiHost<3> eh{p.in[I_WDN], F.ws + WS_WDT, F.gw, HOST_DN_EXPERTS * 4096, F.NGW, DM, 5, 0, 0, {0, 0, 0}};
        pg8::gemm_phase<pg8::EpiSwiGLU8, pg8::MoeOrder, GS, true, true, STAG5, pg8::NoConv, pg8::EpiHost<3>, KROT5, pg8::Gather>(ring, g, S, E, F.wave, pg8::NoConv(), eh, gi); SEAM(8); }
#if (REPEAT_MASK & 0x100)
    if (IN(8)) {
        FRESH(); build_moe_tables(F);
        pg8::Gemm g{F.ws + WS_ABUF, F.ws + WS_WGUT}; using GS = pg8::GShape<DM, DM, DM, (size_t)4096 * DM>;
        pg8::MoeOrder S{__builtin_amdgcn_readfirstlane((int)F.MISC[MI_NMT]), 16, F.G, (int)blockIdx.x, (const LAS int*)(F.lds + MISC_OFF + 4 * MI_T2E)};
        pg8::EpiSwiGLU8 E{F.ws + WS_Y, DM, p.in[I_BGU]};
#if P5DUP == 2
        pg8::Gemm g2{F.ws + WS_HF8, F.ws + WS_WGUT};
        pg8::Gather gi{(const unsigned short*)(F.ws + WS_LIST), (const LAS unsigned*)(F.lds + MISC_OFF + 4 * MI_PBASE), (const LAS unsigned*)(F.lds + MISC_OFF + 4 * MI_CNT)};
        pg8::gemm_phase<pg8::EpiSwiGLU8, pg8::MoeOrder, GS, true, true, STAG5, pg8::NoConv, pg8::NoHost, false, pg8::Gather>(ring, g2, S, E, F.wave, pg8::NoConv(), pg8::NoHost(), gi); SEAM(8); }
#else
        pg8::gemm_phase<pg8::EpiSwiGLU8, pg8::MoeOrder, GS, true, true, STAG5>(ring, g, S, E, F.wave); SEAM(8); }
#endif
#endif
    if (IN(9)) {
        FRESH(); build_moe_tables(F);
        pg8::Gemm g{F.ws + WS_ACT, F.ws + WS_WDT}; using GS = pg8::GShape<DM, DM, DM, (size_t)DM * DM>;
        pg8::MoeOrder S{__builtin_amdgcn_readfirstlane((int)F.MISC[MI_NMT]), 8, F.G, (int)blockIdx.x, (const LAS int*)(F.lds + MISC_OFF + 4 * MI_T2E)};
        pg8::EpiFp8S E{F.ws + WS_Y, DM, p.in[I_BDN], DM, 1.0f / 2048.0f, 32.0f};
        pg8::gemm_phase<pg8::EpiFp8S, pg8::MoeOrder, GS, true, true, STAG6, pg8::NoConv, pg8::NoHost, KROT6>(ring, g, S, E, F.wave); SEAM(9); }
#if (REPEAT_MASK & 0x200)
    if (IN(9)) {
        FRESH(); build_moe_tables(F);
#ifdef P6_PITCH
        pg8::Gemm g{F.ws + WS_ACT, F.ws + WS_WDT}; using GS = pg8::GShape<P6_PITCH, P6_PITCH, DM, (size_t)DM * DM>;
#else
        pg8::Gemm g{F.ws + WS_ACT, F.ws + WS_WDT}; using GS = pg8::GShape<DM, DM, DM, (size_t)DM * DM>;
#endif
        pg8::MoeOrder S{__builtin_amdgcn_readfirstlane((int)F.MISC[MI_NMT]), 8, F.G, (int)blockIdx.x, (const LAS int*)(F.lds + MISC_OFF + 4 * MI_T2E)};
#ifdef P6_NOSTORE
        pg8::EpiNull_<P6_NOSTORE - 1> E{};

#ifndef P6_FLP
#define P6_FLP false
#endif
        pg8::gemm_phase<pg8::EpiNull_<P6_NOSTORE - 1>, pg8::MoeOrder, GS, true, true, STAG6, pg8::NoConv, pg8::NoHost, false, pg8::NoGather, P6_FLP>(ring, g, S, E, F.wave); SEAM(9); }
#elif defined(P6_MODE)
        pg8::EpiFp8S_<P6_MODE> E{F.ws + WS_Y, DM, p.in[I_BDN], DM, 1.0f / 2048.0f, 32.0f};
        pg8::gemm_phase<pg8::EpiFp8S_<P6_MODE>, pg8::MoeOrder, GS, true, true, STAG6>(ring, g, S, E, F.wave); SEAM(9); }
#else
        pg8::EpiFp8S E{F.ws + WS_Y, DM, p.in[I_BDN], DM, 1.0f / 2048.0f, 32.0f};
        pg8::gemm_phase<pg8::EpiFp8S, pg8::MoeOrder, GS, true, true, STAG6>(ring, g, S, E, F.wave); SEAM(9); }
#endif
#endif
    if (IN(10)) REP(10) { FRESH(); p7(F, p); if (((REPEAT_MASK >> 10) & 1)) xcd_barrier(bar, F.wave == 0 && fresh_lane() == 0); }
#undef IN
#undef SEAM
}
#ifndef STAGE
#define STAGE 4
#endif
#ifndef PER_PHASE_LAUNCH
#define PER_PHASE_LAUNCH 0
#endif

#if STAGE < 4
__global__ void adapt_z_kernel(const bf16_t* Z, float* z) {
    const long idx = (long)blockIdx.x * blockDim.x + threadIdx.x; const long t = idx / ZC; const int c = (int)(idx % ZC);
    z[t * INC + (c < 3072 ? c : c + 16)] = bf2f(Z[idx]);
}
__global__ void adapt_bf16_kernel(const bf16_t* src, float* dst) { const long idx = (long)blockIdx.x * blockDim.x + threadIdx.x; dst[idx] = bf2f(src[idx]); }
#endif

static void launch_mk(Params& a, int lo, int hi, int grid, hipStream_t stream) {
#if PER_PHASE_LAUNCH
    for (int k = lo; k < hi; ++k) { a.ph_lo = k; a.ph_hi = k + 1; hipLaunchKernelGGL(mk_fwd, dim3(grid), dim3(512), LDS_BYTES, stream, a); }
#else
    a.ph_lo = lo; a.ph_hi = hi; hipLaunchKernelGGL(mk_fwd, dim3(grid), dim3(512), LDS_BYTES, stream, a);
#endif
}

extern "C" void kernel_launch(void* const* d_in, const int* in_sizes, int n_in, void* d_out, int out_size, void* d_ws, size_t ws_size, hipStream_t stream) {
    static int grid = 0;
    if (grid == 0) {
        int dev = 0, cus = 0;
        if (hipGetDevice(&dev) != hipSuccess || hipDeviceGetAttribute(&cus, hipDeviceAttributeMultiprocessorCount, dev) != hipSuccess) { grid = -1; return; }
        if (hipFuncSetAttribute((const void*)mk_fwd, hipFuncAttributeMaxDynamicSharedMemorySize, LDS_BYTES) != hipSuccess) { grid = -1; return; }
        int per_cu = 0;
        (void)hipOccupancyMaxActiveBlocksPerMultiprocessor(&per_cu, (const void*)mk_fwd, 512, LDS_BYTES);
        (void)hipGetLastError();
        grid = cus < 256 ? cus : 256;
        if (per_cu < 1) fprintf(stderr, "kernel_launch: occupancy query reports %d\n", per_cu);
    }
    if (grid < 0) return;
    (void)hipMemsetAsync((char*)d_ws + WS_CTL, 0, CTL_ZERO_BYTES, stream);
    Params a{};
    for (int i = 0; i < 22; ++i) a.in[i] = (const float*)d_in[i];
    a.out = (float*)d_out; a.ws = (unsigned char*)d_ws;
#if STAGE >= 4
    launch_mk(a, 0, NPHASE, grid, stream);
#else
    const float* x = a.in[I_X];
    char* ws = (char*)d_ws + WS_ABUF; size_t off = 0;
    auto alloc = [&](size_t bytes) { void* p = ws + off; off += (bytes + 255) & ~(size_t)255; return p; };
    int* counts = (int*)alloc(256);
    float* z = (float*)alloc((size_t)T * INC * 4);
    float* ogla = (float*)alloc((size_t)T * 1024 * 4);
    float* xc = (float*)alloc((size_t)T * 1024 * 4);
    float* za = (float*)alloc((size_t)T * 1024 * 4);
    float* zi = (float*)alloc((size_t)T * 1024 * 4);
    float* mix = (float*)alloc((size_t)T * DM * 4);
    float* xmid = (float*)alloc((size_t)T * DM * 4);
    float* hf = (float*)alloc((size_t)T * DM * 4);
    float* logits = (float*)alloc((size_t)T * 32 * 4);
    float* gates = (float*)alloc((size_t)T * 4 * 4);
    int* list = (int*)alloc((size_t)NEXP * T * 4);
    float* act = (float*)alloc((size_t)T * 4 * DM * 4);
    float* y = (float*)alloc((size_t)T * 4 * DM * 4);
    (void)hipMemsetAsync(counts, 0, 256, stream);
#if STAGE == 1
    launch_mk(a, 0, 2, grid, stream);
    adapt_z_kernel<<<(unsigned)((size_t)T * ZC / 256), 256, 0, stream>>>((const bf16_t*)((char*)d_ws + WS_Z), z);
    gla_naive_kernel<<<64, 256, 0, stream>>>(z, (const float*)((char*)d_ws + WS_LG), ogla);
    gla_out_kernel<<<T, 256, 0, stream>>>(ogla, z, a.in[I_GNG], mix);
    lru_conv_kernel<<<T * 1024 / 256, 256, 0, stream>>>(z, a.in[I_CW], a.in[I_CB], xc);
    for (int h = 0; h < 4; ++h) {
        GemmArgs g{}; g.A = xc + h * 256; g.lda = 1024; g.ldb = 256; g.ldc = 1024; g.M = T; g.N = 256; g.K = 256; g.a_div = 1;
        g.B = a.in[I_WA] + (size_t)h * 65536; g.C = za + h * 256;
        sgemm_kernel<0><<<dim3(2, T / 128, 1), 256, 0, stream>>>(g);
        g.B = a.in[I_WI] + (size_t)h * 65536; g.C = zi + h * 256;
        sgemm_kernel<0><<<dim3(2, T / 128, 1), 256, 0, stream>>>(g);
    }
    lru_gate_kernel<<<T * 1024 / 256, 256, 0, stream>>>(xc, za, zi, a.in[I_BA], a.in[I_BI], a.in[I_AP]);
    lru_scan_kernel<<<2048 / 64, 64, 0, stream>>>(za, zi, z, mix);
#endif
#if STAGE == 2
    launch_mk(a, 0, 5, grid, stream);
    adapt_bf16_kernel<<<(unsigned)((size_t)T * DM / 256), 256, 0, stream>>>((const bf16_t*)((char*)d_ws + WS_MIX), mix);
#endif
#if STAGE <= 2
    { GemmArgs g{}; g.A = mix; g.lda = DM; g.B = a.in[I_WOUT]; g.ldb = DM; g.C = xmid; g.ldc = DM; g.M = T; g.N = DM; g.K = DM; g.a_div = 1; g.resid = x; g.ldr = DM;
      sgemm_kernel<1><<<dim3(DM / 128, T / 128, 1), 256, 0, stream>>>(g); }
#else
    launch_mk(a, 0, 6, grid, stream);
    xmid = (float*)((char*)d_ws + WS_XMID);
#endif
    rmsnorm_kernel<<<T, 256, 0, stream>>>(xmid, a.in[I_NFG], hf);
    { GemmArgs g{}; g.A = hf; g.lda = DM; g.B = a.in[I_WR]; g.ldb = 32; g.C = logits; g.ldc = 32; g.M = T; g.N = 32; g.K = DM; g.a_div = 1; g.bias = a.in[I_BR];
      sgemm_kernel<0><<<dim3(1, T / 128, 1), 256, 0, stream>>>(g); }
    route_kernel<<<T / 256, 256, 0, stream>>>(logits, counts, list, gates);
    { GemmArgs g{}; g.A = hf; g.lda = DM; g.B = a.in[I_WGU]; g.ldb = 4096; g.C = act; g.ldc = DM; g.M = 0; g.N = 4096; g.K = DM; g.a_div = 4; g.bias = a.in[I_BGU];
      g.rowlist = list; g.count = counts; g.strideB_e = (long)DM * 4096; g.strideBias_e = 4096; g.list_stride = T;
      sgemm_kernel<2><<<dim3(2048 / 64, T / 128, NEXP), 256, 0, stream>>>(g); }
    { GemmArgs g{}; g.A = act; g.lda = DM; g.B = a.in[I_WDN]; g.ldb = DM; g.C = y; g.ldc = DM; g.M = 0; g.N = DM; g.K = DM; g.a_div = 1; g.bias = a.in[I_BDN];
      g.rowlist = list; g.count = counts; g.strideB_e = (long)DM * DM; g.strideBias_e = DM; g.list_stride = T;
      sgemm_kernel<0><<<dim3(DM / 128, T / 128, NEXP), 256, 0, stream>>>(g); }
    final_kernel<<<T, 256, 0, stream>>>(xmid, y, gates, a.in[I_NFINAL], (float*)d_out);
#endif
}
```

```cpp
#define STAGE 4
#define PER_PHASE_LAUNCH 0
#define REPEAT_MASK 0
#include <hip/hip_runtime.h>
#include <stdint.h>
#include <stdio.h>

#define GAS __attribute__((address_space(1)))
#define LAS __attribute__((address_space(3)))
typedef unsigned short bf16_t;
typedef short bf16x8 __attribute__((ext_vector_type(8)));
typedef short bf16x4 __attribute__((ext_vector_type(4)));
typedef float f32x4 __attribute__((ext_vector_type(4)));
typedef float f32x2 __attribute__((ext_vector_type(2)));
typedef float f32x16 __attribute__((ext_vector_type(16)));
typedef unsigned u32x4 __attribute__((ext_vector_type(4)));
typedef unsigned u32x2 __attribute__((ext_vector_type(2)));
typedef int i32x8 __attribute__((ext_vector_type(8)));
typedef int i32x4 __attribute__((ext_vector_type(4)));
typedef int i32x32 __attribute__((ext_vector_type(32)));

constexpr int T = 16384, SEQL = 8192, DM = 2048, INC = 5136, ZC = 5120, NEXP = 32;
constexpr int ZQ = 0, ZK = 512, ZV = 1024, ZR = 2048, ZLX = 3072, ZLG = 4096;
constexpr int MPAD_MAX = 65536 + NEXP * 256;
constexpr int NCHUNK = 256;

constexpr size_t MiB = 1u << 20;
constexpr size_t WS_CTL = 0, CTL_ZERO_BYTES = 128 * 1024;
constexpr size_t WS_WINT = 1 * MiB;
constexpr size_t WS_WOUTT = WS_WINT + 20 * MiB;
constexpr size_t WS_WGUT = WS_WOUTT + 8 * MiB;
constexpr size_t WS_WDT = WS_WGUT + 512 * MiB;
constexpr size_t WS_WAT = WS_WDT + 256 * MiB;
constexpr size_t WS_WIT = WS_WAT + 512 * 1024;
constexpr size_t WS_WRT = WS_WIT + 512 * 1024;
constexpr size_t WS_WGLT = WS_WRT + 512 * 1024;
constexpr size_t WS_H = WS_WRT + 1 * MiB;
constexpr size_t WS_LG = WS_H + 64 * MiB;
constexpr size_t WS_Z = WS_LG + 32 * MiB;
constexpr size_t WS_AN = WS_Z + 160 * MiB;
constexpr size_t WS_DN = WS_AN + 128 * MiB;
constexpr size_t WS_SP = WS_DN + 1 * MiB;
constexpr size_t WS_AUA = WS_SP + 64 * MiB;
constexpr size_t WS_AUU = WS_AUA + 64 * MiB;
constexpr size_t WS_SUMA = WS_AUU + 64 * MiB;
constexpr size_t WS_SUMH = WS_SUMA + 1 * MiB;
constexpr size_t WS_MIX = WS_SUMH + 1 * MiB;
constexpr size_t WS_XMID = WS_MIX + 64 * MiB;
constexpr size_t WS_RSTD = WS_XMID + 128 * MiB;
constexpr size_t WS_TOKE = WS_RSTD + 1 * MiB;
constexpr size_t WS_GATES = WS_TOKE + 1 * MiB;
constexpr size_t WS_ABUF = WS_GATES + 1 * MiB;
constexpr size_t WS_HF8 = WS_ABUF, WS_LIST = WS_ABUF + 64 * MiB;
constexpr size_t WS_ACT = WS_ABUF + 288 * MiB;
constexpr size_t WS_Y = WS_ACT + 288 * MiB;
constexpr size_t WS_END = WS_Y + 288 * MiB;
constexpr int CW_BAR = 4096;
constexpr int CW_CNT = 16384;

constexpr int RING_BYTES = 131072;
constexpr int SCR_BYTES = 135168;
constexpr int MISC_OFF = SCR_BYTES;
constexpr int LDS_BYTES = 147456;
constexpr int MI_PBASE = 16, MI_NMT = 48, MI_LCNT = 64, MI_LBASE = 96, MI_T2E = 128, MI_CNT = 480;

#define LDS_WAIT() asm volatile("s_waitcnt lgkmcnt(0)" ::: "memory")
#define VM_WAIT() asm volatile("s_waitcnt vmcnt(0)" ::: "memory")

typedef __bf16 bf16v2_t __attribute__((ext_vector_type(2)));
__device__ __forceinline__ unsigned pk2(float lo, float hi) { const f32x2 v = {lo, hi}; return __builtin_bit_cast(unsigned, __builtin_convertvector(v, bf16v2_t)); }
#ifdef SIM_FP8
__device__ __forceinline__ float q8_(float x, float sc) { int p = 0; p = __builtin_amdgcn_cvt_pk_fp8_f32(__builtin_amdgcn_fmed3f(x * sc, -448.0f, 448.0f), 0.0f, p, false); return __builtin_amdgcn_cvt_f32_fp8(p, 0) * (1.0f / sc); }
#define PK2A(a, b) pk2(q8_(a, 16.0f), q8_(b, 16.0f))
#define PK2W(a, b) pk2(q8_(a, 512.0f), q8_(b, 512.0f))
#else
#define PK2A(a, b) pk2(a, b)
#define PK2W(a, b) pk2(a, b)
#endif
__device__ __forceinline__ unsigned f2bf(float f) { return pk2(f, 0.0f) & 0xffffu; }
__device__ __forceinline__ float bf2f(unsigned short b) { return __builtin_bit_cast(float, (unsigned)b << 16); }
__device__ __forceinline__ float bflo(unsigned w) { return __builtin_bit_cast(float, w << 16); }
__device__ __forceinline__ float bfhi(unsigned w) { return __builtin_bit_cast(float, w & 0xffff0000u); }
__device__ __forceinline__ float clamp448(float x) { return __builtin_amdgcn_fmed3f(x, -448.0f, 448.0f); }
__device__ __forceinline__ unsigned pk4_fp8(float a, float b, float c, float d) {
    int p = 0; p = __builtin_amdgcn_cvt_pk_fp8_f32(clamp448(a), clamp448(b), p, false); p = __builtin_amdgcn_cvt_pk_fp8_f32(clamp448(c), clamp448(d), p, true); return (unsigned)p; }
__device__ __forceinline__ unsigned pk4_fp8_nc(float a, float b, float c, float d) {
    int p = 0; p = __builtin_amdgcn_cvt_pk_fp8_f32(a, b, p, false); p = __builtin_amdgcn_cvt_pk_fp8_f32(c, d, p, true); return (unsigned)p; }
__device__ __forceinline__ float fp8f(unsigned w, int b) { return b == 0 ? __builtin_amdgcn_cvt_f32_fp8((int)w, 0) : b == 1 ? __builtin_amdgcn_cvt_f32_fp8((int)w, 1) : b == 2 ? __builtin_amdgcn_cvt_f32_fp8((int)w, 2) : __builtin_amdgcn_cvt_f32_fp8((int)w, 3); }
__device__ __forceinline__ float wave_sum(float v) {
#pragma unroll
    for (int o = 1; o < 64; o <<= 1) v += __shfl_xor(v, o);
    return v;
}
__device__ __forceinline__ int fresh_lane() { int l; asm volatile("v_mbcnt_lo_u32_b32 %0, -1, 0\n\tv_mbcnt_hi_u32_b32 %0, -1, %0" : "=v"(l)); return l; }
__device__ __forceinline__ float sigmoidf_(float x) { return __builtin_amdgcn_rcpf(1.0f + __expf(-x)); }
__device__ __forceinline__ float rsqrtf_(float x) { return __builtin_amdgcn_rsqf(x); }

#define XB_TMO      128
#define XB_XCNT(j)  (256  + 64 * (j))
#define XB_XSUB(j)  (1280 + 64 * (j))
#define XB_XGEN(j)  (2304 + 64 * (j))
#define XB_TOP      3328
#define XB_TOPGEN   3392
#define XCD_BAR_WORDS 3456
#define XB_SPIN_CAP (1u << 18)

__device__ __forceinline__ unsigned xb_ld(unsigned* p)              { return __hip_atomic_load(p, __ATOMIC_RELAXED, __HIP_MEMORY_SCOPE_AGENT); }
__device__ __forceinline__ unsigned xb_add(unsigned* p, unsigned v) { return __hip_atomic_fetch_add(p, v, __ATOMIC_RELAXED, __HIP_MEMORY_SCOPE_AGENT); }
__device__ __forceinline__ unsigned xb_xcc_id() { return (unsigned)__builtin_amdgcn_s_getreg((3 << 11) | 20) & 0xFu; }
#define XB_SPIN(cond, bar) do { unsigned _sp = 0; while (cond) { __builtin_amdgcn_s_sleep(1); \
    if ((++_sp & 255u) == 0u) { if (xb_ld(&(bar)[XB_TMO])) break; if (_sp > XB_SPIN_CAP) { atomicAdd(&(bar)[XB_TMO], 1u); break; } } } } while (0)

struct XcdBarrier { unsigned* bar; unsigned x; volatile LAS unsigned* st; };

__device__ __forceinline__ XcdBarrier xcd_barrier_post(unsigned* bar, volatile LAS unsigned* st, bool t0) {
    XcdBarrier b; b.bar = bar; b.x = xb_xcc_id(); b.st = st;
    if (t0) (void)xb_add(&bar[XB_XCNT(b.x)], 1u);
    return b;
}
__device__ __forceinline__ void xcd_barrier_complete(unsigned* bar, unsigned x, unsigned& nloc, unsigned& nx) {
    const unsigned G = gridDim.x * gridDim.y * gridDim.z;
    unsigned sum, cnt, mine, sp = 0u;
    for (;;) {
        sum = 0u; cnt = 0u; mine = 0u;
#pragma unroll
        for (unsigned j = 0; j < 16; ++j) { const unsigned c = xb_ld(&bar[XB_XCNT(j)]); sum += c; cnt += (c > 0u) ? 1u : 0u; mine = (j == x) ? c : mine; }
        if (sum == G) break;
        __builtin_amdgcn_s_sleep(1);
        if ((++sp & 255u) == 0u) { if (xb_ld(&bar[XB_TMO])) break; if (sp > XB_SPIN_CAP) { atomicAdd(&bar[XB_TMO], 1u); break; } }
    }
    nloc = mine > 0u ? mine : 1u; nx = cnt > 0u ? cnt : 1u;
}
__device__ __forceinline__ void xcd_barrier(const XcdBarrier& b, bool t0) {
    asm volatile("s_waitcnt vmcnt(0)" ::: "memory");
    __syncthreads();
    if (t0) {
        unsigned* bar = b.bar;
        __builtin_amdgcn_s_waitcnt(0);
        unsigned nloc = b.st[0], nx = b.st[1];
        if (nloc == 0u) { xcd_barrier_complete(bar, b.x, nloc, nx); b.st[0] = nloc; b.st[1] = nx; }
        const unsigned old = xb_add(&bar[XB_XSUB(b.x)], 1u);
        const unsigned gen = old / nloc;
        if (old + 1u == (gen + 1u) * nloc) {
            __builtin_amdgcn_fence(__ATOMIC_RELEASE, "agent");
            asm volatile("s_waitcnt vmcnt(0)" ::: "memory");
            const unsigned og = xb_add(&bar[XB_TOP], 1u);
            const unsigned tg = og / nx;
            if (og + 1u == (tg + 1u) * nx) xb_add(&bar[XB_TOPGEN], 1u);
            else XB_SPIN(xb_ld(&bar[XB_TOPGEN]) == tg, bar);
            __builtin_amdgcn_fence(__ATOMIC_ACQUIRE, "agent");
            xb_add(&bar[XB_XGEN(b.x)], 1u);
            asm volatile("s_waitcnt vmcnt(0)" ::: "memory");
        } else {
            XB_SPIN(xb_ld(&bar[XB_XGEN(b.x)]) == gen, bar);
            __builtin_amdgcn_fence(__ATOMIC_ACQUIRE, "agent");
            asm volatile("s_waitcnt vmcnt(0)" ::: "memory");
        }
    }
    __syncthreads();
}

namespace pg8 {
#ifndef PG8_WGM
#define PG8_WGM 4
#endif
constexpr int BM = 256, BK = 64, HALF = 128, HTB = HALF * BK * 2, STAGE_BYTES = 8 * HTB, NXCD = 8, WGM = PG8_WGM;
__host__ __device__ __forceinline__ int lds_byte(int r, int c) { const int st = (r >> 4) * 2 + (c >> 5), rr = r & 15, cc = c & 31, ob = rr * 64 + cc * 2; return st * 1024 + (ob ^ (((ob >> 9) & 1) << 5)); }
__host__ __device__ __forceinline__ void stage_rc(int b, int& R, int& C) { const int st = b / 1024, sb = b % 1024, swz = sb ^ (((sb >> 9) & 1) << 5); R = (st >> 1) * 16 + swz / 64; C = (st & 1) * 32 + (swz % 64) / 2; }
__host__ __device__ __forceinline__ int perm32(int rho) { const int n = rho >> 4, i = rho & 15; return 8 * (i >> 2) + 4 * n + (i & 3); }

struct Unit { int pm, pn, e; };
struct Gemm { const void* A; const void* Bt; };
template <int LDA_, int LDB_, int KB_, size_t SB_> struct GShape { static constexpr int LDA = LDA_, LDB = LDB_, KB = KB_; static constexpr size_t SB = SB_; };

__device__ __forceinline__ bool order_map(int L, int nM, int nN, int& pm, int& pn) {
    const int nwg = nM * nN; if (L >= nwg) return false;
    int wgid = L; { const int q = nwg / NXCD, r = nwg % NXCD, xcd = wgid % NXCD, off = wgid / NXCD; wgid = (xcd < r ? xcd * (q + 1) : r * (q + 1) + (xcd - r) * q) + off; }
    const int nig = WGM * nN, gid = wgid / nig, fm = gid * WGM, gsz = (nM - fm) < WGM ? (nM - fm) : WGM;
    pm = fm + ((wgid % nig) % gsz); pn = (wgid % nig) / gsz; return true;
}
struct StaticOrder {
    int nM, nN, G, c;
    __device__ void init(int M, int N, int G_, int c_) { nM = M / BM; nN = N / BM; G = G_; c = c_; }
    __device__ __forceinline__ bool next(int i, Unit& u) const { u.e = 0; return order_map(i * G + c, nM, nN, u.pm, u.pn); }
};
struct MoeOrder {
    int nM, nN, G, c; const LAS int* t2e;
    __device__ __forceinline__ bool next(int i, Unit& u) const { if (!order_map(i * G + c, nM, nN, u.pm, u.pn)) return false; u.e = __builtin_amdgcn_readfirstlane(t2e[u.pm]); return true; }
};

__device__ __forceinline__ unsigned cvt_pk_bf16(float lo, float hi) { return pk2(lo, hi); }

struct EpiBf16 {
    static constexpr bool PERM = true; static constexpr int NSTORES = 16;
    bf16_t* O; int ldc; const float* bias; int bias_stride;
    __device__ __forceinline__ void operator()(const f32x4 (&acc)[2][2][4][2], const Unit& u, int wr, int wc, int fr, int fq) const {
        const int row0 = u.pm * BM + wr * 64 + fr; const int col0 = u.pn * BM + wc * 32 + 8 * fq;
        f32x4 bv[2][2];
#pragma unroll
        for (int bj = 0; bj < 2; ++bj)
#pragma unroll
            for (int n = 0; n < 2; ++n) bv[bj][n] = bias ? *(const f32x4*)(bias + (size_t)u.e * bias_stride + col0 + bj * HALF + 4 * n) : (f32x4){0.f, 0.f, 0.f, 0.f};
#pragma unroll
        for (int ai = 0; ai < 2; ++ai)
#pragma unroll
            for (int m = 0; m < 4; ++m) { bf16_t* rowp = O + (size_t)(row0 + ai * HALF + m * 16) * ldc + col0;
#pragma unroll
                for (int bj = 0; bj < 2; ++bj) { const f32x4 v0 = acc[ai][bj][m][0] + bv[bj][0], v1 = acc[ai][bj][m][1] + bv[bj][1];
                    u32x4 w; w.x = cvt_pk_bf16(v0[0], v0[1]); w.y = cvt_pk_bf16(v0[2], v0[3]); w.z = cvt_pk_bf16(v1[0], v1[1]); w.w = cvt_pk_bf16(v1[2], v1[3]);
                    *(u32x4*)(rowp + bj * HALF) = w; } }
    }
};
struct EpiF32Res {
    static constexpr bool PERM = false;
    float* C; const float* resid; int ldc;
    __device__ __forceinline__ void operator()(const f32x4 (&acc)[2][2][4][2], const Unit& u, int wr, int wc, int fr, int fq) const {
        const int row0 = u.pm * BM + wr * 64 + fr, col0 = u.pn * BM + wc * 32 + 4 * fq;
#pragma unroll
        for (int ai = 0; ai < 2; ++ai)
#pragma unroll
            for (int m = 0; m < 4; ++m) { const size_t off = (size_t)(row0 + ai * HALF + m * 16) * ldc + col0;
#pragma unroll
                for (int bj = 0; bj < 2; ++bj)
#pragma unroll
                    for (int n = 0; n < 2; ++n) { const f32x4 r = *(const f32x4*)(resid + off + bj * HALF + n * 16); *(f32x4*)(C + off + bj * HALF + n * 16) = acc[ai][bj][m][n] + r; } }
    }
};
struct EpiSwiGLU {
    static constexpr bool PERM = true;
    bf16_t* O; int ldc; const float* bias;
    __device__ __forceinline__ void operator()(const f32x4 (&acc)[2][2][4][2], const Unit& u, int wr, int wc, int fr, int fq) const {
        const int row0 = u.pm * BM + wr * 64 + fr; const int j0 = u.pn * HALF + wc * 32 + 8 * fq;
        const float* be = bias + (size_t)u.e * 4096;
        f32x4 bg[2], bu[2];
#pragma unroll
        for (int n = 0; n < 2; ++n) { bg[n] = *(const f32x4*)(be + j0 + 4 * n); bu[n] = *(const f32x4*)(be + 2048 + j0 + 4 * n); }
#pragma unroll
        for (int ai = 0; ai < 2; ++ai)
#pragma unroll
            for (int m = 0; m < 4; ++m) { bf16_t* rowp = O + (size_t)(row0 + ai * HALF + m * 16) * ldc + j0;
                float o[8];
#pragma unroll
                for (int n = 0; n < 2; ++n) { const f32x4 g = acc[ai][0][m][n] + bg[n], up = acc[ai][1][m][n] + bu[n];
#pragma unroll
                    for (int q = 0; q < 4; ++q) { const float gt = fminf(g[q], 7.0f), ut = fminf(fmaxf(up[q], -7.0f), 7.0f);
                        const float glu = gt * __builtin_amdgcn_rcpf(1.0f + __expf(-1.702f * gt)); o[4 * n + q] = (ut + 1.0f) * glu; } }
                u32x4 w; w.x = cvt_pk_bf16(o[0], o[1]); w.y = cvt_pk_bf16(o[2], o[3]); w.z = cvt_pk_bf16(o[4], o[5]); w.w = cvt_pk_bf16(o[6], o[7]);
                *(u32x4*)rowp = w; }
    }
};

struct EpiBf16Res {
    static constexpr bool PERM = true; static constexpr int NSTORES = 16;
    bf16_t* O; const float* resid; int ldc;
    __device__ __forceinline__ void operator()(const f32x4 (&acc)[2][2][4][2], const Unit& u, int wr, int wc, int fr, int fq) const {
        const int row0 = u.pm * BM + wr * 64 + fr; const int col0 = u.pn * BM + wc * 32 + 8 * fq;
#pragma unroll
        for (int ai = 0; ai < 2; ++ai)
#pragma unroll
            for (int m = 0; m < 4; ++m) { const size_t off = (size_t)(row0 + ai * HALF + m * 16) * ldc + col0;
#pragma unroll
                for (int bj = 0; bj < 2; ++bj) { const f32x4 r0 = *(const f32x4*)(resid + off + bj * HALF), r1 = *(const f32x4*)(resid + off + bj * HALF + 4);
                    const f32x4 v0 = acc[ai][bj][m][0] + r0, v1 = acc[ai][bj][m][1] + r1;
                    u32x4 w; w.x = cvt_pk_bf16(v0[0], v0[1]); w.y = cvt_pk_bf16(v0[2], v0[3]); w.z = cvt_pk_bf16(v1[0], v1[1]); w.w = cvt_pk_bf16(v1[2], v1[3]);
                    *(u32x4*)(O + off + bj * HALF) = w; } }
    }
};
#ifndef USE_BIAS_LDS
#define USE_BIAS_LDS 0
#endif
template <int MODE = 0> struct EpiFp8S_ {
    static constexpr int NSTORES = 16;
    static constexpr bool PERM = true, BIAS_LDS = (USE_BIAS_LDS != 0);
    unsigned char* O; int ldc; const float* bias; int bias_stride; float scale, oscale;
    __device__ __forceinline__ const char* bias_base(const Unit& u) const { return (const char*)(bias + (size_t)u.e * bias_stride + u.pn * BM); }
    __device__ static __forceinline__ unsigned bias_voff(int i) { return (unsigned)i * 4u; }
    __device__ __forceinline__ void operator()(const f32x4 (&acc)[2][2][4][2], const Unit& u, int wr, int wc, int fr, int fq, const LAS float* bl) const {
        const int row0 = u.pm * BM + wr * 64 + fr; const int col0 = u.pn * BM + wc * 32 + 8 * fq;
        f32x4 bv[2][2];
#pragma unroll
        for (int bj = 0; bj < 2; ++bj)
#pragma unroll
            for (int n = 0; n < 2; ++n) { if constexpr (MODE == 2) bv[bj][n] = (f32x4){oscale, oscale, oscale, oscale}; else if constexpr (BIAS_LDS) bv[bj][n] = *(const LAS f32x4*)(bl + wc * 32 + 8 * fq + bj * HALF + 4 * n) * oscale; else bv[bj][n] = *(const f32x4*)(bias + (size_t)u.e * bias_stride + col0 + bj * HALF + 4 * n) * oscale; }
        const float sc = scale * oscale;
#pragma unroll
        for (int ai = 0; ai < 2; ++ai)
#pragma unroll
            for (int m = 0; m < 4; ++m) { unsigned char* rowp = O + (size_t)(row0 + ai * HALF + m * 16) * ldc + col0;
#pragma unroll
                for (int bj = 0; bj < 2; ++bj) { const f32x4 v0 = acc[ai][bj][m][0] * sc + bv[bj][0], v1 = acc[ai][bj][m][1] * sc + bv[bj][1];
                    u32x2 w; w.x = pk4_fp8(v0[0], v0[1], v0[2], v0[3]); w.y = pk4_fp8(v1[0], v1[1], v1[2], v1[3]);
                    if constexpr (MODE == 1) { if (u.pm < 0) *(u32x2*)(rowp + bj * HALF) = w; else asm volatile("" :: "v"(w)); } else *(u32x2*)(rowp + bj * HALF) = w; } }
    }
};
using EpiFp8S = EpiFp8S_<0>;
struct EpiSwiGLU8 {
    static constexpr bool PERM = true, BIAS_LDS = (USE_BIAS_LDS != 0); static constexpr int NSTORES = 8;
    unsigned char* O; int ldc; const float* bias;
    struct Bias { f32x4 bg[2], bu[2];
        __device__ __forceinline__ void pin() { asm volatile("" : "+v"(bg[0]), "+v"(bg[1]), "+v"(bu[0]), "+v"(bu[1])); } };
    __device__ __forceinline__ const char* bias_base(const Unit& u) const { return (const char*)(bias + (size_t)u.e * 4096 + u.pn * HALF); }
    __device__ static __forceinline__ unsigned bias_voff(int i) { return (unsigned)(i < 128 ? i : 2048 - 128 + i) * 4u; }
    __device__ __forceinline__ void load_bias(const Unit& u, int wc, int fq, Bias& b, const LAS float* bl) const {
        const int j0 = wc * 32 + 8 * fq;
        if constexpr (BIAS_LDS) {
#pragma unroll
            for (int n = 0; n < 2; ++n) { b.bg[n] = *(const LAS f32x4*)(bl + j0 + 4 * n); b.bu[n] = *(const LAS f32x4*)(bl + 128 + j0 + 4 * n); }
        } else { const float* be = bias + (size_t)u.e * 4096 + u.pn * HALF + j0;
#pragma unroll
            for (int n = 0; n < 2; ++n) { b.bg[n] = *(const f32x4*)(be + 4 * n); b.bu[n] = *(const f32x4*)(be + 2048 + 4 * n); } } }
    __device__ __forceinline__ void operator()(const f32x4 (&acc)[2][2][4][2], const Unit& u, int wr, int wc, int fr, int fq, const LAS float* bl) const { Bias b; load_bias(u, wc, fq, b, bl); apply(acc, u, wr, wc, fr, fq, b); }
    __device__ __forceinline__ void apply(const f32x4 (&acc)[2][2][4][2], const Unit& u, int wr, int wc, int fr, int fq, const Bias& b) const {
        const int row0 = u.pm * BM + wr * 64 + fr; const int j0 = u.pn * HALF + wc * 32 + 8 * fq;
        const f32x4 (&bg)[2] = b.bg; const f32x4 (&bu)[2] = b.bu;
#pragma unroll
        for (int ai = 0; ai < 2; ++ai)
#pragma unroll
            for (int m = 0; m < 4; ++m) { unsigned char* rowp = O + (size_t)(row0 + ai * HALF + m * 16) * ldc + j0;
                float o[8];
#pragma unroll
                for (int n = 0; n < 2; ++n) { const f32x4 g = acc[ai][0][m][n] * (1.0f / 8192.0f) + bg[n], up = acc[ai][1][m][n] * (1.0f / 8192.0f) + bu[n];
#pragma unroll
                    for (int q = 0; q < 4; ++q) { const float gt = fminf(g[q], 7.0f), ut = __builtin_amdgcn_fmed3f(up[q], -7.0f, 7.0f);
                        const float glu = gt * __builtin_amdgcn_rcpf(1.0f + __builtin_amdgcn_exp2f(-2.4554669595930156f * gt)); o[4 * n + q] = __builtin_fmaf(ut, 4.0f, 4.0f) * glu; } }
                u32x2 w; w.x = pk4_fp8_nc(o[0], o[1], o[2], o[3]); w.y = pk4_fp8_nc(o[4], o[5], o[6], o[7]);
                *(u32x2*)rowp = w; }
    }
};
template <int ALL> struct EpiNull_ { static constexpr bool PERM = true;
    __device__ __forceinline__ void operator()(const f32x4 (&acc)[2][2][4][2], const Unit& u, int wr, int wc, int fr, int fq) const {
        if constexpr (ALL == 0) asm volatile("" :: "v"(acc[0][0][0][0]), "v"(acc[1][1][3][1]));
        else {
#pragma unroll
        for (int a = 0; a < 2; ++a)
#pragma unroll
            for (int b = 0; b < 2; ++b) asm volatile("" :: "v"(acc[a][b][0][0]), "v"(acc[a][b][0][1]), "v"(acc[a][b][1][0]), "v"(acc[a][b][1][1]), "v"(acc[a][b][2][0]), "v"(acc[a][b][2][1]), "v"(acc[a][b][3][0]), "v"(acc[a][b][3][1])); } } };
using EpiNull = EpiNull_<1>;
struct EpiBf16S {
    static constexpr bool PERM = true;
    bf16_t* O; int ldc; const float* bias; int bias_stride; float scale;
    __device__ __forceinline__ void operator()(const f32x4 (&acc)[2][2][4][2], const Unit& u, int wr, int wc, int fr, int fq) const {
        const int row0 = u.pm * BM + wr * 64 + fr; const int col0 = u.pn * BM + wc * 32 + 8 * fq;
        f32x4 bv[2][2];
#pragma unroll
        for (int bj = 0; bj < 2; ++bj)
#pragma unroll
            for (int n = 0; n < 2; ++n) bv[bj][n] = *(const f32x4*)(bias + (size_t)u.e * bias_stride + col0 + bj * HALF + 4 * n);
#pragma unroll
        for (int ai = 0; ai < 2; ++ai)
#pragma unroll
            for (int m = 0; m < 4; ++m) { bf16_t* rowp = O + (size_t)(row0 + ai * HALF + m * 16) * ldc + col0;
#pragma unroll
                for (int bj = 0; bj < 2; ++bj) { const f32x4 v0 = acc[ai][bj][m][0] * scale + bv[bj][0], v1 = acc[ai][bj][m][1] * scale + bv[bj][1];
                    u32x4 w; w.x = cvt_pk_bf16(v0[0], v0[1]); w.y = cvt_pk_bf16(v0[2], v0[3]); w.z = cvt_pk_bf16(v1[0], v1[1]); w.w = cvt_pk_bf16(v1[2], v1[3]);
                    *(u32x4*)(rowp + bj * HALF) = w; } }
    }
};

__device__ __forceinline__ i32x8 pg8_get8(const i32x32& v, int idx) { i32x8 r;
#pragma unroll
    for (int j = 0; j < 8; ++j) r[j] = v[8 * idx + j];
    return r; }
__device__ __forceinline__ i32x4 pg8_get4(const i32x32& v, int idx) { i32x4 r;
#pragma unroll
    for (int j = 0; j < 4; ++j) r[j] = v[4 * idx + j];
    return r; }
struct NoHost { static constexpr bool ON = false; static constexpr int N = 0; };
template <int N_> struct EpiHost {
    static constexpr bool ON = true; static constexpr int N = N_;
    const float* W; unsigned char* WT; int cid, cend, cstride; int ldw, cbs, gu, e0; int pend[N_];
    __device__ __forceinline__ void issue(unsigned (&x)[16 * N_], int lane) {
        const unsigned vo = (unsigned)lane * 4u; const size_t rowb = (size_t)ldw * 4;
#pragma unroll
        for (int j = 0; j < N_; ++j) { const int id = cid < cend ? cid : cend - 1; pend[j] = id; cid += cstride;
            const int cb = id & ((1 << cbs) - 1), kb = (id >> cbs) & 127, e = e0 + (id >> (cbs + 7));
            const char* rb = (const char*)(W + (size_t)e * DM * ldw + (size_t)(16 * kb) * ldw + 64 * cb);
#pragma unroll
            for (int i = 0; i < 16; ++i) asm volatile("s_nop 4\n\tglobal_load_dword %0, %1, %2" : "=v"(x[16 * j + i]) : "v"(vo), "s"(rb + (size_t)i * rowb) : "memory"); }
    }
    __device__ __forceinline__ void finish(const unsigned (&x)[16 * N_], int lane) const {
#pragma unroll
        for (int j = 0; j < N_; ++j) { const int id = pend[j]; const int cb = id & ((1 << cbs) - 1), kb = (id >> cbs) & 127, e = e0 + (id >> (cbs + 7)); const int n0 = 64 * cb;
            const int drow0 = !gu ? n0 : (n0 < 2048) ? (256 * (n0 >> 7) + (n0 & 127)) : (256 * ((n0 - 2048) >> 7) + 128 + ((n0 - 2048) & 127));
            u32x4 o;
#pragma unroll
            for (int q = 0; q < 4; ++q) o[q] = pk4_fp8(__builtin_bit_cast(float, x[16 * j + 4 * q]) * 512.0f, __builtin_bit_cast(float, x[16 * j + 4 * q + 1]) * 512.0f, __builtin_bit_cast(float, x[16 * j + 4 * q + 2]) * 512.0f, __builtin_bit_cast(float, x[16 * j + 4 * q + 3]) * 512.0f);
            *(u32x4*)(WT + (size_t)e * ldw * DM + (size_t)(drow0 + lane) * DM + 16 * kb) = o; }
    }
};
struct NoGather { static constexpr bool ON = false; };
struct Gather { static constexpr bool ON = true; const unsigned short* list; const LAS unsigned* pbase; const LAS unsigned* cnt; };
__device__ __forceinline__ unsigned gather_clamp(unsigned P, int r0, int cn) { const unsigned lo = (r0 < cn) ? (P & 0xffffu) : 0u, hi = (r0 + 64 < cn) ? (P >> 16) : 0u; return lo | (hi << 16); }
struct NoConv { static constexpr bool ON = false; };
struct ConvGU {
    static constexpr bool ON = true;
    const float* W; unsigned char* WT; int cid, cend, cstride, pend; const char* rbase;
    __device__ __forceinline__ void issue(unsigned (&x)[16], int lane) {
        const int id = cid < cend ? cid : cend - 1; pend = id; cid += cstride;
        const int e = id >> 13, kb = (id >> 6) & 127, cb = id & 63;
        const char* rb = (const char*)(W + (size_t)e * DM * 4096 + (size_t)(16 * kb) * 4096 + 64 * cb);
        const unsigned vo = (unsigned)lane * 4u; rbase = rb;
#pragma unroll
        for (int i = 0; i < 8; ++i) asm volatile("s_nop 4\n\tglobal_load_dword %0, %1, %2" : "=v"(x[i]) : "v"(vo), "s"(rb + (size_t)i * 16384) : "memory");
    }
    __device__ __forceinline__ void issue_b(unsigned (&x)[16], int lane) {
        const unsigned vo = (unsigned)lane * 4u;
#pragma unroll
        for (int i = 8; i < 16; ++i) asm volatile("s_nop 4\n\tglobal_load_dword %0, %1, %2" : "=v"(x[i]) : "v"(vo), "s"(rbase + (size_t)i * 16384) : "memory");
    }
    __device__ __forceinline__ void finish(const unsigned (&x)[16], int lane) const {
        const int id = pend; const int e = id >> 13, kb = (id >> 6) & 127, cb = id & 63; const int n0 = 64 * cb;
        const int drow0 = (n0 < 2048) ? (256 * (n0 >> 7) + (n0 & 127)) : (256 * ((n0 - 2048) >> 7) + 128 + ((n0 - 2048) & 127));
        u32x4 o;
#pragma unroll
        for (int q = 0; q < 4; ++q) o[q] = pk4_fp8(__builtin_bit_cast(float, x[4 * q]) * 512.0f, __builtin_bit_cast(float, x[4 * q + 1]) * 512.0f, __builtin_bit_cast(float, x[4 * q + 2]) * 512.0f, __builtin_bit_cast(float, x[4 * q + 3]) * 512.0f);
        *(u32x4*)(WT + (size_t)e * 4096 * DM + (size_t)(drow0 + lane) * DM + 16 * kb) = o;
    }
};
#define PG8_X16A(x, b) "+v"(x[b+0]), "+v"(x[b+1]), "+v"(x[b+2]), "+v"(x[b+3]), "+v"(x[b+4]), "+v"(x[b+5]), "+v"(x[b+6]), "+v"(x[b+7]), "+v"(x[b+8]), "+v"(x[b+9]), "+v"(x[b+10]), "+v"(x[b+11]), "+v"(x[b+12]), "+v"(x[b+13]), "+v"(x[b+14]), "+v"(x[b+15])
#define PG8_X16(x) "+v"(x[0]), "+v"(x[1]), "+v"(x[2]), "+v"(x[3]), "+v"(x[4]), "+v"(x[5]), "+v"(x[6]), "+v"(x[7]), "+v"(x[8]), "+v"(x[9]), "+v"(x[10]), "+v"(x[11]), "+v"(x[12]), "+v"(x[13]), "+v"(x[14]), "+v"(x[15])

template <class E, class = void> struct epi_nstores { static constexpr int value = 0; };
template <class E> struct epi_nstores<E, decltype((void)E::NSTORES)> { static constexpr int value = E::NSTORES; };
template <class E, class = void> struct epi_takes_bl { static constexpr bool value = false; };
template <class E> struct epi_takes_bl<E, decltype((void)E::BIAS_LDS)> { static constexpr bool value = true; };
template <class E, class = void> struct has_bias_lds { static constexpr bool value = false; };
template <class E> struct has_bias_lds<E, decltype((void)E::BIAS_LDS)> { static constexpr bool value = E::BIAS_LDS; };
constexpr int BIAS_LDS_OFF = MISC_OFF + 4096;
#ifndef CV_XMASK
#define CV_XMASK 0
#endif
template <class Epi, class Sched, class GS, bool ALIGN_EPI = true, bool F8 = false, int STAGGER_TICKS = 0, class CV = NoConv, class EH = NoHost, bool KROT = false, class GI = NoGather, bool FLP = false>
__device__ __forceinline__ void gemm_phase(LAS unsigned char* lds, const Gemm g, const Sched& S, const Epi& E, int wave, CV cv = CV(), EH eh = EH(), GI gi = GI()) {
    const int wid = wave, lane = fresh_lane(), tid = wid * 64 + lane, wr = wid >> 2, wc = wid & 3, fr = lane & 15, fq = lane >> 4;
    constexpr int nt = GS::KB / 128;
    unsigned voffA, voffB;
    { int R, C; stage_rc(tid * 16, R, C); const int Rb = Epi::PERM ? ((R & ~31) + perm32(R & 31)) : R;
      voffA = (unsigned)(R * GS::LDA + C * 2); voffB = (unsigned)(Rb * GS::LDB + C * 2);
      if constexpr (FLP) { const int b = tid * 16; voffA = (unsigned)((b >> 7) * GS::LDA + (b & 127)); voffB = (unsigned)((b >> 7) * GS::LDB + (b & 127)); } }
    constexpr size_t pstepA = (size_t)64 * GS::LDA, pstepB = (size_t)64 * GS::LDB;
    constexpr size_t kstep = (size_t)(BK * 2);
    constexpr size_t hstepA = (size_t)HALF * GS::LDA, hstepB = (size_t)HALF * GS::LDB;
    constexpr size_t tstepA = 2 * hstepA, tstepB = 2 * hstepB;
    const unsigned ldsw = (unsigned)wid * 1024u;
    const unsigned ldsb = (unsigned)(size_t)lds + ldsw;
    const int aoff = lds_byte(wr * 64 + fr, F8 ? fq * 16 : fq * 8), boff = lds_byte(wc * 32 + fr, F8 ? fq * 16 : fq * 8);
    const int kofs = F8 ? 16 : 1024;
#define PG8_SA(b, h) (((b) * 2 + (h)) * HTB)
#define PG8_SB(b, h) ((4 + (b) * 2 + (h)) * HTB)
#define PG8_STAGE(bufoff, gbase, voff) do { _Pragma("unroll") for (int _i = 0; _i < 2; ++_i) { unsigned _keep; \
        asm volatile("s_mov_b32 %0, m0\n\ts_mov_b32 m0, %3\n\ts_nop 3\n\tglobal_load_lds_dwordx4 %1, %2\n\ts_mov_b32 m0, %0" \
            : "=&s"(_keep) : "v"(voff##_v), "s"((const char*)(gbase) + _i * pstep##voff), "s"(ldsb + (unsigned)((bufoff) + _i * 8192)) : "memory"); } } while (0)
#define PG8_STAGE_GA(bufoff, kp, vlo, vhi) do { unsigned _keep; \
        asm volatile("s_mov_b32 %0, m0\n\ts_mov_b32 m0, %3\n\ts_nop 3\n\tglobal_load_lds_dwordx4 %1, %2\n\ts_mov_b32 m0, %0" : "=&s"(_keep) : "v"(vlo), "s"((const char*)(kp)), "s"(ldsb + (unsigned)(bufoff)) : "memory"); \
        asm volatile("s_mov_b32 %0, m0\n\ts_mov_b32 m0, %3\n\ts_nop 3\n\tglobal_load_lds_dwordx4 %1, %2\n\ts_mov_b32 m0, %0" : "=&s"(_keep) : "v"(vhi), "s"((const char*)(kp)), "s"(ldsb + (unsigned)((bufoff) + 8192)) : "memory"); } while (0)
#define PG8_STA(bufoff, kp, h, nx) do { if constexpr (GI::ON) { const unsigned _p = (nx) ? nvP[h] : voP[h]; const unsigned _lo = ((_p & 0xffffu) << 11) + gcb, _hi = ((_p >> 16) << 11) + gcb; PG8_STAGE_GA(bufoff, kp, _lo, _hi); } \
        else PG8_STAGE(bufoff, (kp) + (h) * hstepA, voffA); } while (0)
#define pstepvoffA pstepA
#define pstepvoffB pstepB
#define voffA_v voffA
#define voffB_v voffB
#define PG8_LD16(p) (*(const LAS i32x4*)(p))
#define PG8_SET8(V, idx, lo, hi) do { _Pragma("unroll") for (int _j = 0; _j < 4; ++_j) { V[8 * (idx) + _j] = (lo)[_j]; V[8 * (idx) + 4 + _j] = (hi)[_j]; } } while (0)
#define PG8_GET8(V, idx) pg8_get8(V, idx)
#define PG8_GETLO(V, idx) __builtin_bit_cast(bf16x8, pg8_get4(V, 2 * (idx)))
#define PG8_GETHI(V, idx) __builtin_bit_cast(bf16x8, pg8_get4(V, 2 * (idx) + 1))
#define PG8_LDA(dst, b, h) do { _Pragma("unroll") for (int m = 0; m < 4; ++m) { const i32x4 _lo = PG8_LD16(lds + PG8_SA(b, h) + aoff + m * 2048), _hi = PG8_LD16(lds + PG8_SA(b, h) + aoff + m * 2048 + kofs); \
        PG8_SET8(AV, m, _lo, _hi); } } while (0)
#define PG8_LDB(dst, b, h) do { _Pragma("unroll") for (int n = 0; n < 2; ++n) { const i32x4 _lo = PG8_LD16(lds + PG8_SB(b, h) + boff + n * 2048), _hi = PG8_LD16(lds + PG8_SB(b, h) + boff + n * 2048 + kofs); \
        PG8_SET8(BV, (dst) + n, _lo, _hi); } } while (0)
#define PG8_MMA(ai, bj, At, Bt) do { __builtin_amdgcn_s_setprio(1); \
        if constexpr (F8) { _Pragma("unroll") for (int m = 0; m < 4; ++m) _Pragma("unroll") for (int n = 0; n < 2; ++n) \
            acc[ai][bj][m][n] = __builtin_amdgcn_mfma_scale_f32_16x16x128_f8f6f4(PG8_GET8(BV, (Bt) + n), PG8_GET8(AV, m), acc[ai][bj][m][n], 0, 0, 0, 0, 0, 0); } \
        else { _Pragma("unroll") for (int m = 0; m < 4; ++m) _Pragma("unroll") for (int n = 0; n < 2; ++n) { \
            acc[ai][bj][m][n] = __builtin_amdgcn_mfma_f32_16x16x32_bf16(PG8_GETLO(BV, (Bt) + n), PG8_GETLO(AV, m), acc[ai][bj][m][n], 0, 0, 0); \
            acc[ai][bj][m][n] = __builtin_amdgcn_mfma_f32_16x16x32_bf16(PG8_GETHI(BV, (Bt) + n), PG8_GETHI(AV, m), acc[ai][bj][m][n], 0, 0, 0); } } \
        __builtin_amdgcn_s_setprio(0); } while (0)
#define PG8_WAIT_V(n) asm volatile("s_waitcnt vmcnt(" #n ")" ::: "memory")
#define PG8_WAIT_L(n) asm volatile("s_waitcnt lgkmcnt(" #n ")" ::: "memory")
#define PG8_BAR __builtin_amdgcn_s_barrier()
#define PG8_SCHED __builtin_amdgcn_sched_barrier(0)
    Unit cur, nxt; int ui = 0;
    if (!S.next(0, cur)) return;
    constexpr bool BL = has_bias_lds<Epi>::value;
    constexpr int NST = EH::ON ? EH::N : epi_nstores<Epi>::value;
#define PG8_WAIT_VN(n) asm volatile("s_waitcnt vmcnt(%0)" :: "n"(n) : "memory")
    static_assert(!(BL && CV::ON), "the counted waits below know one or the other");
    unsigned bx = 0;
    unsigned cx[16];
    if constexpr (CV::ON) { cv.issue(cx, lane); cv.issue_b(cx, lane); asm volatile("s_waitcnt vmcnt(0)" ::: "memory"); asm volatile("" : PG8_X16(cx) :: "memory"); }
    if constexpr (STAGGER_TICKS > 0) {
        if (blockIdx.x & 1) { const unsigned long long t0 = __builtin_amdgcn_s_memrealtime(); while (__builtin_amdgcn_s_memrealtime() - t0 < (unsigned long long)STAGGER_TICKS) __builtin_amdgcn_s_sleep(8); } }
    i32x32 AV, BV;
    constexpr int At = 0, B0 = 0, B1 = 2;
    static_assert(!GI::ON || GS::LDA == 2048, "gather: 2 KiB token rows");
    int tfetch = 0; if constexpr (GI::ON) asm volatile("s_mov_b32 %0, 0" : "=s"(tfetch));
    unsigned voP[2] = {0u, 0u}, nvP[2] = {0u, 0u}, gcb = 0u;
    if constexpr (GI::ON) { int R, C; stage_rc(tid * 16, R, C); gcb = (unsigned)(C * 2);
        const int lb = cur.pm * BM - __builtin_amdgcn_readfirstlane((int)gi.pbase[cur.e]), cn = __builtin_amdgcn_readfirstlane((int)gi.cnt[cur.e]);
        const u32x2 pr = *(const u32x2*)(gi.list + (size_t)cur.e * 16384 + lb + 4 * R);
        voP[0] = gather_clamp(pr.x, lb + R, cn); voP[1] = gather_clamp(pr.y, lb + R + 128, cn); }
    const char* cA = GI::ON ? (const char*)g.A : (const char*)g.A + (size_t)cur.pm * tstepA; const char* cB = (const char*)g.Bt + (size_t)cur.e * GS::SB + (size_t)cur.pn * tstepB;
#define PG8_KO(u) (KROT ? ((((u).pn & 7) * 2 + ((u).pm & 3) * 4) * (nt / 16)) & (nt - 1) : 0)
    int ko = PG8_KO(cur);
    { const char* pA = cA + (size_t)ko * kstep; const char* pB = cB + (size_t)ko * kstep;
    PG8_STAGE(PG8_SB(0, 0), pB, voffB); PG8_SCHED; PG8_STAGE(PG8_SB(0, 1), pB + hstepB, voffB); PG8_SCHED; PG8_STA(PG8_SA(0, 0), pA, 0, false); PG8_SCHED; PG8_STA(PG8_SA(0, 1), pA, 1, false); PG8_SCHED;
    if (wr == 1) PG8_BAR;
    PG8_WAIT_V(2); PG8_BAR;
    PG8_STAGE(PG8_SB(1, 0), pB + kstep, voffB); PG8_SCHED; PG8_STA(PG8_SA(1, 0), pA + kstep, 0, false); PG8_SCHED; PG8_STAGE(PG8_SB(1, 1), pB + hstepB + kstep, voffB); PG8_SCHED; }
    PG8_WAIT_V(6); PG8_BAR; PG8_SCHED;
    f32x4 acc[2][2][4][2];
#pragma unroll
    for (int a = 0; a < 2; ++a)
#pragma unroll
        for (int b = 0; b < 2; ++b)
#pragma unroll
            for (int m = 0; m < 4; ++m)
#pragma unroll
                for (int n = 0; n < 2; ++n) acc[a][b][m][n] = (f32x4){0.f, 0.f, 0.f, 0.f};
    for (;;) {
        const bool has_next = S.next(ui + 1, nxt);
        const char* nA = (has_next && !GI::ON) ? (const char*)g.A + (size_t)nxt.pm * tstepA : cA;
        const char* nB = has_next ? (const char*)g.Bt + (size_t)nxt.e * GS::SB + (size_t)nxt.pn * tstepB : cB;
        const int nko = has_next ? PG8_KO(nxt) : ko;
        for (int t = 0; t < nt; t += 2) {
            const bool last = (t == nt - 2);
            const int kt = KROT ? ((ko + t) & (nt - 1)) : t, kt2 = KROT ? ((ko + t + 2) & (nt - 1)) : t + 2;
            const char* a1 = cA + (size_t)(kt + 1) * kstep;
            const char* a2 = last ? nA + (size_t)nko * kstep : cA + (size_t)kt2 * kstep; const char* b2 = last ? nB + (size_t)nko * kstep : cB + (size_t)kt2 * kstep;
            const char* a3 = a2 + kstep; const char* b3 = b2 + kstep;
            PG8_LDB(B0, 0, 0); PG8_LDB(B1, 0, 1); PG8_SCHED; PG8_LDA(At, 0, 0); PG8_STA(PG8_SA(1, 1), a1, 1, false);
            PG8_WAIT_V(8);
            if constexpr (CV::ON) asm volatile("" : PG8_X16(cx));
            PG8_WAIT_L(0); PG8_BAR;
            const bool xon = CV::ON && ((t & CV_XMASK) == 0);
            if constexpr (CV::ON) { if (xon) { cv.finish(cx, lane); cv.issue(cx, lane); } }
            if constexpr (GI::ON) { if (t == tfetch && has_next) {
                int R, C; stage_rc((wid * 64 + fresh_lane()) * 16, R, C); const unsigned lvo = (unsigned)R * 8u;
                const char* lp = (const char*)(gi.list + (size_t)nxt.e * 16384 + (nxt.pm * BM - __builtin_amdgcn_readfirstlane((int)gi.pbase[nxt.e])));
                u32x2 pr; asm volatile("s_nop 4\n\tglobal_load_dwordx2 %0, %1, %2" : "=&v"(pr) : "v"(lvo), "s"(lp) : "memory"); nvP[0] = pr.x; nvP[1] = pr.y; } }
            if constexpr (BL) { if (last) { const unsigned bvo = Epi::bias_voff((wid * 64 + fresh_lane()) & 255);
                asm volatile("s_nop 4\n\tglobal_load_dword %0, %1, %2" : "=v"(bx) : "v"(bvo), "s"(E.bias_base(cur)) : "memory"); } }
            PG8_MMA(0, 0, At, B0); PG8_MMA(0, 1, At, B1); PG8_BAR; PG8_SCHED;
            PG8_LDA(At, 0, 1); PG8_STAGE(PG8_SB(0, 0), b2, voffB); PG8_STAGE(PG8_SB(0, 1), b2 + hstepB, voffB); PG8_STA(PG8_SA(0, 0), a2, 0, last);
            if (xon) PG8_WAIT_V(17); else if (BL && last) PG8_WAIT_V(9); else if (GI::ON && t == tfetch && has_next) PG8_WAIT_V(9); else PG8_WAIT_V(8);
            PG8_WAIT_L(0); PG8_BAR;
            if constexpr (CV::ON) { if (xon) cv.issue_b(cx, lane); }
            PG8_MMA(1, 0, At, B0); PG8_MMA(1, 1, At, B1); PG8_BAR; PG8_SCHED;
            PG8_LDB(B0, 1, 0); PG8_LDB(B1, 1, 1); PG8_SCHED; PG8_LDA(At, 1, 0); PG8_STA(PG8_SA(0, 1), a2, 1, last);
            if (xon) PG8_WAIT_V(25); else PG8_WAIT_V(8);
            if constexpr (GI::ON) { if (t == tfetch && has_next) { asm volatile("" : "+v"(nvP[0]), "+v"(nvP[1]));
                int R, C; stage_rc((wid * 64 + fresh_lane()) * 16, R, C); const int lb = nxt.pm * BM - __builtin_amdgcn_readfirstlane((int)gi.pbase[nxt.e]), cn = __builtin_amdgcn_readfirstlane((int)gi.cnt[nxt.e]);
                nvP[0] = gather_clamp(nvP[0], lb + R, cn); nvP[1] = gather_clamp(nvP[1], lb + R + 128, cn); } }
            if constexpr (BL) { if (last) { asm volatile("" : "+v"(bx));
                *(LAS unsigned*)(lds + BIAS_LDS_OFF + 4 * ((wid * 64 + fresh_lane()) & 255)) = bx; } }
            PG8_WAIT_L(0); PG8_BAR; PG8_MMA(0, 0, At, B0); PG8_MMA(0, 1, At, B1); PG8_BAR; PG8_SCHED;
            PG8_LDA(At, 1, 1); PG8_STAGE(PG8_SB(1, 0), b3, voffB); PG8_STAGE(PG8_SB(1, 1), b3 + hstepB, voffB); PG8_STA(PG8_SA(1, 0), a3, 0, last);
            if constexpr (CV::ON) { if (xon) PG8_WAIT_V(16); else PG8_WAIT_V(8); } else PG8_WAIT_V(8);
            PG8_WAIT_L(0); PG8_BAR; PG8_MMA(1, 0, At, B0); PG8_MMA(1, 1, At, B1); PG8_BAR; PG8_SCHED;
        }
        if constexpr (ALIGN_EPI) { if (wr == 0) PG8_BAR; }
        { const int l2 = fresh_lane();
          const LAS float* bl = (const LAS float*)(lds + BIAS_LDS_OFF);
          if constexpr (EH::ON) {
              unsigned ex[16 * EH::N]; typename Epi::Bias eb;
              if constexpr (BL) { eh.issue(ex, l2); E.load_bias(cur, wc, l2 >> 4, eb, bl); }
              else { E.load_bias(cur, wc, l2 >> 4, eb, bl); eb.pin(); eh.issue(ex, l2); }
              E.apply(acc, cur, wr, wc, l2 & 15, l2 >> 4, eb);
              asm volatile("s_waitcnt vmcnt(0)" ::: "memory");
              if constexpr (EH::N == 3) asm volatile("" : PG8_X16A(ex, 0), PG8_X16A(ex, 16), PG8_X16A(ex, 32) :: "memory");
              else asm volatile("" : PG8_X16A(ex, 0), PG8_X16A(ex, 16), PG8_X16A(ex, 32), PG8_X16A(ex, 48) :: "memory");
              eh.finish(ex, l2);
          } else if constexpr (epi_takes_bl<Epi>::value) E(acc, cur, wr, wc, l2 & 15, l2 >> 4, bl);
          else E(acc, cur, wr, wc, l2 & 15, l2 >> 4); }
        if (!has_next) break;
#pragma unroll
        for (int a = 0; a < 2; ++a)
#pragma unroll
            for (int b = 0; b < 2; ++b)
#pragma unroll
                for (int m = 0; m < 4; ++m)
#pragma unroll
                    for (int n = 0; n < 2; ++n) acc[a][b][m][n] = (f32x4){0.f, 0.f, 0.f, 0.f};
        cur = nxt; cA = nA; cB = nB; ko = nko; ++ui;
        if constexpr (GI::ON) {
#pragma unroll
            for (int i = 0; i < 2; ++i) voP[i] = nvP[i]; }
        if constexpr (ALIGN_EPI) { if (wr == 1) PG8_BAR; }
    }
    if constexpr (CV::ON) { asm volatile("s_waitcnt vmcnt(0)" ::: "memory"); asm volatile("" : PG8_X16(cx) :: "memory"); cv.finish(cx, lane); }
    else PG8_WAIT_V(0);
    if constexpr (!ALIGN_EPI) { if (wr == 0) PG8_BAR; }
    PG8_BAR;
#undef PG8_SA
#undef PG8_KO
#undef PG8_SB
#undef PG8_STAGE
#undef PG8_STAGE_GA
#undef PG8_STA
#undef pstepvoffA
#undef pstepvoffB
#undef voffA_v
#undef voffB_v
#undef PG8_LDA
#undef PG8_LD16
#undef PG8_SET8
#undef PG8_GET8
#undef PG8_GETLO
#undef PG8_GETHI
#undef PG8_LDB
#undef PG8_MMA
#undef PG8_WAIT_V
#undef PG8_WAIT_VN
#undef PG8_WAIT_L
#undef PG8_BAR
#undef PG8_SCHED
}
}
struct Params {
    const float* in[22];
    float* out; unsigned char* ws;
    int ph_lo, ph_hi;
};
enum { I_X = 0, I_NMG, I_WIN, I_GWG, I_GBG, I_GNG, I_CW, I_CB, I_WA, I_BA, I_WI, I_BI, I_AP, I_WOUT, I_NFG, I_WR, I_BR, I_WGU, I_BGU, I_WDN, I_BDN, I_NFINAL };

struct Frame {
    LAS unsigned char* lds; volatile LAS unsigned* MISC;
    int tid, lane, wave, G, gw, NGW;
    unsigned char* ws;
};

__device__ __forceinline__ float gelu_tanh_f(float x) {
    const float u = 0.7978845608028654f * (x + 0.044715f * x * x * x);
    const float e = __expf(2.0f * u);
    const float th = 1.0f - 2.0f * __builtin_amdgcn_rcpf(e + 1.0f);
    return 0.5f * x * (1.0f + th);
}
__device__ __forceinline__ float log_sigmoid_f(float s) { return fminf(s, 0.f) - __logf(1.0f + __expf(-fabsf(s))); }

__device__ __forceinline__ void p0_item(const float* W, int ldw, int col0, bf16_t* WT, int ldt, size_t drow0, int k0, LAS float* scr, int lane) {
    (void)scr;
    const float* src = W + (size_t)k0 * ldw + col0 + lane;
    float v[64];
#pragma unroll
    for (int i = 0; i < 64; ++i) v[i] = src[(size_t)i * ldw];
    bf16_t* dst = WT + (drow0 + lane) * (size_t)ldt + k0;
#pragma unroll
    for (int c = 0; c < 8; ++c) { u32x4 o; o.x = pk2(v[8 * c], v[8 * c + 1]); o.y = pk2(v[8 * c + 2], v[8 * c + 3]); o.z = pk2(v[8 * c + 4], v[8 * c + 5]); o.w = pk2(v[8 * c + 6], v[8 * c + 7]);
        *(u32x4*)(dst + 8 * c) = o; }
}

__device__ __forceinline__ void p0_item8(const float* W, int ldw, int col0, unsigned char* WT, int ldt, size_t drow0, int k0, int lane) {
    const float* src = W + (size_t)k0 * ldw + col0 + lane;
    float v[64];
#pragma unroll
    for (int i = 0; i < 64; ++i) v[i] = src[(size_t)i * ldw];
    unsigned char* dst = WT + (drow0 + lane) * (size_t)ldt + k0;
#pragma unroll
    for (int c = 0; c < 4; ++c) { u32x4 o;
#pragma unroll
        for (int q = 0; q < 4; ++q) o[q] = pk4_fp8(v[16 * c + 4 * q] * 512.0f, v[16 * c + 4 * q + 1] * 512.0f, v[16 * c + 4 * q + 2] * 512.0f, v[16 * c + 4 * q + 3] * 512.0f);
        *(u32x4*)(dst + 16 * c) = o; }
}

constexpr int CONV_EXPERTS_P0 = 28, HOST_DN_EXPERTS_P0 = 24;
struct CoopTile { const float* W; int ldw; int col0; unsigned char* WT; int ldt_b; int mode; int k0; int gu; int drow0; };
__device__ __forceinline__ void coop_load(const CoopTile& t, int w, int l, f32x4 (&v)[16]) {
    if (t.mode == 0) {
#pragma unroll
        for (int i = 0; i < 8; ++i) { const float* r = t.W + (size_t)(t.k0 + 8 * w + i) * t.ldw + t.col0 + 4 * l; v[2 * i] = *(const f32x4*)r; v[2 * i + 1] = *(const f32x4*)(r + 256); }
    } else {
#pragma unroll
        for (int i = 0; i < 16; ++i) v[i] = *(const f32x4*)(t.W + (size_t)(t.k0 + 16 * w + i) * t.ldw + t.col0 + 4 * l);
    }
}
__device__ __forceinline__ void coop_to_lds(const CoopTile& t, int w, int l, const f32x4 (&v)[16], LAS unsigned char* buf) {
    const int sw = (w ^ (l & 7)) * 16;
    if (t.mode == 0) {
#pragma unroll
        for (int jp = 0; jp < 2; ++jp)
#pragma unroll
            for (int j = 0; j < 4; ++j) { u32x4 o; if (t.ldw == INC) { o.x = PK2W(v[0 + jp][j], v[2 + jp][j]); o.y = PK2W(v[4 + jp][j], v[6 + jp][j]); o.z = PK2W(v[8 + jp][j], v[10 + jp][j]); o.w = PK2W(v[12 + jp][j], v[14 + jp][j]); } else { o.x = pk2(v[0 + jp][j], v[2 + jp][j]); o.y = pk2(v[4 + jp][j], v[6 + jp][j]); o.z = pk2(v[8 + jp][j], v[10 + jp][j]); o.w = pk2(v[12 + jp][j], v[14 + jp][j]); }
                *(LAS u32x4*)(buf + (256 * jp + 4 * l + j) * 128 + sw) = o; }
    } else {
#pragma unroll
        for (int j = 0; j < 4; ++j) { u32x4 o;
#pragma unroll
            for (int q = 0; q < 4; ++q) o[q] = pk4_fp8(v[4 * q][j] * 512.0f, v[4 * q + 1][j] * 512.0f, v[4 * q + 2][j] * 512.0f, v[4 * q + 3][j] * 512.0f);
            *(LAS u32x4*)(buf + (4 * l + j) * 128 + sw) = o; }
    }
}
__device__ __forceinline__ void coop_store(const CoopTile& t, int w, int l, const LAS unsigned char* buf) {
    const int nrows = t.mode == 0 ? 512 : 256; const int cp = l & 7;
    for (int n = 8 * w + (l >> 3); n < nrows; n += 64) {
        const u32x4 o = *(const LAS u32x4*)(buf + n * 128 + cp * 16); const int c = cp ^ ((n >> 2) & 7);
        int drow;
        if (t.gu) { const int g = t.col0 + n; drow = (g < 2048) ? (256 * (g >> 7) + (g & 127)) : (256 * ((g - 2048) >> 7) + 128 + ((g - 2048) & 127)); } else drow = t.drow0 + n;
        *(u32x4*)(t.WT + (size_t)drow * t.ldt_b + (t.mode == 0 ? 2 * t.k0 : t.k0) + 16 * c) = o; }
}
__device__ __forceinline__ bool coop_tile(const Params& p, unsigned char* ws, int it, CoopTile& t) {
    constexpr int N_GU = (32 - CONV_EXPERTS_P0) * 256, N_DN = (32 - HOST_DN_EXPERTS_P0) * 128, N_INA = 32 * 6, N_INB = 32 * 4, N_OUT = 32 * 4;
    int r = it;
    if (r < N_GU) { const int e = CONV_EXPERTS_P0 + (r >> 8), q = r & 255, kb = q >> 4, nb = q & 15; t = CoopTile{p.in[I_WGU] + (size_t)e * DM * 4096, 4096, 256 * nb, ws + WS_WGUT + (size_t)e * 4096 * DM, DM, 1, 128 * kb, 1, 0}; return true; } r -= N_GU;
    if (r < N_DN) { const int e = HOST_DN_EXPERTS_P0 + (r >> 7), q = r & 127, kb = q >> 3, nb = q & 7; t = CoopTile{p.in[I_WDN] + (size_t)e * DM * DM, DM, 256 * nb, ws + WS_WDT + (size_t)e * DM * DM, DM, 1, 128 * kb, 0, 256 * nb}; return true; } r -= N_DN;
    if (r < N_INA) { const int kb = r / 6, nb = r % 6; t = CoopTile{p.in[I_WIN], INC, 512 * nb, ws + WS_WINT, DM * 2, 0, 64 * kb, 0, 512 * nb}; return true; } r -= N_INA;
    if (r < N_INB) { const int kb = r >> 2, nb = r & 3; t = CoopTile{p.in[I_WIN], INC, 3088 + 512 * nb, ws + WS_WINT, DM * 2, 0, 64 * kb, 0, 3072 + 512 * nb}; return true; } r -= N_INB;
    if (r < N_OUT) { const int kb = r >> 2, nb = r & 3; t = CoopTile{p.in[I_WOUT], DM, 512 * nb, ws + WS_WOUTT, DM * 2, 0, 64 * kb, 0, 512 * nb}; return true; }
    return false;
}
__device__ __forceinline__ void p0a(Frame& F, const Params& p) {
    const int w = F.wave, l = F.lane;
    CoopTile cur, nxt; f32x4 v[16];
    int it = blockIdx.x; bool have = coop_tile(p, F.ws, it, cur);
    if (have) coop_load(cur, w, l, v);
    { bf16_t* WaT = (bf16_t*)(F.ws + WS_WAT); bf16_t* WiT = (bf16_t*)(F.ws + WS_WIT);
      for (int r = F.gw; r < 128; r += F.NGW) { const int which = r >> 6, h = (r >> 4) & 3, kb = (r >> 2) & 3, nb = r & 3;
          p0_item((which ? p.in[I_WI] : p.in[I_WA]) + (size_t)h * 65536, 256, 64 * nb, (which ? WiT : WaT) + (size_t)h * 65536, 256, (size_t)64 * nb, 64 * kb, nullptr, F.lane); } }
    { bf16_t* WglT = (bf16_t*)(F.ws + WS_WGLT); const float* w_in = p.in[I_WIN];
      for (int idx = (int)blockIdx.x * 512 + F.tid; idx < 16 * DM; idx += F.G * 512) { const int cc = idx >> 11, k = idx & 2047; WglT[idx] = (bf16_t)f2bf(w_in[(size_t)k * INC + 3072 + cc]); } }
    { float* WrT = (float*)(F.ws + WS_WRT); const float* wr = p.in[I_WR]; const float* gf = p.in[I_NFG];
      for (int idx = (int)blockIdx.x * 512 + F.tid; idx < 32 * DM; idx += F.G * 512) { const int n = idx >> 11, k = idx & 2047; WrT[idx] = wr[k * 32 + n] * gf[k]; } }
    int par = 0;
    while (have) {
        LAS unsigned char* buf = F.lds + par * 65536;
        coop_to_lds(cur, w, l, v, buf);
        it += F.G; const bool hn = coop_tile(p, F.ws, it, nxt);
        if (hn) coop_load(nxt, w, l, v);
        __syncthreads();
        coop_store(cur, w, l, buf);
        cur = nxt; have = hn; par ^= 1;
    }
    __syncthreads();
}
__device__ __forceinline__ void p0b(Frame& F, const Params& p) {
    const float* x = p.in[I_X]; const float* g1 = p.in[I_NMG]; bf16_t* H = (bf16_t*)(F.ws + WS_H);
    const int l = F.lane;
    f32x4 gv[8], xn[8];
#pragma unroll
    for (int j = 0; j < 4; ++j) { gv[2 * j] = *(const f32x4*)(g1 + 8 * l + 512 * j); gv[2 * j + 1] = *(const f32x4*)(g1 + 8 * l + 512 * j + 4); }
#pragma unroll
    for (int j = 0; j < 4; ++j) { xn[2 * j] = (F.gw < T) ? *(const f32x4*)(x + (size_t)F.gw * DM + 8 * l + 512 * j) : (f32x4){0.f, 0.f, 0.f, 0.f}; xn[2 * j + 1] = (F.gw < T) ? *(const f32x4*)(x + (size_t)F.gw * DM + 8 * l + 512 * j + 4) : (f32x4){0.f, 0.f, 0.f, 0.f}; }
    for (int m = F.gw; m < T; m += F.NGW) {
        f32x4 xv[8]; float ss = 0.f;
#pragma unroll
        for (int j = 0; j < 8; ++j) { xv[j] = xn[j]; ss += (xv[j][0] * xv[j][0] + xv[j][1] * xv[j][1]) + (xv[j][2] * xv[j][2] + xv[j][3] * xv[j][3]); }
        if (m + F.NGW < T) {
#pragma unroll
            for (int j = 0; j < 4; ++j) { xn[2 * j] = *(const f32x4*)(x + (size_t)(m + F.NGW) * DM + 8 * l + 512 * j); xn[2 * j + 1] = *(const f32x4*)(x + (size_t)(m + F.NGW) * DM + 8 * l + 512 * j + 4); } }
        const float rs = rsqrtf_(wave_sum(ss) * (1.0f / DM) + 1e-6f);
#pragma unroll
        for (int j = 0; j < 4; ++j) { const f32x4 a = xv[2 * j] * rs * gv[2 * j], b = xv[2 * j + 1] * rs * gv[2 * j + 1];
            u32x4 o; o.x = pk2(a[0], a[1]); o.y = pk2(a[2], a[3]); o.z = pk2(b[0], b[1]); o.w = pk2(b[2], b[3]);
            *(u32x4*)(H + (size_t)m * DM + 8 * l + 512 * j) = o;
#ifdef SIM_FP8
            o.x = PK2A(a[0], a[1]); o.y = PK2A(a[2], a[3]); o.z = PK2A(b[0], b[1]); o.w = PK2A(b[2], b[3]); *(u32x4*)((bf16_t*)(F.ws + WS_MIX) + (size_t)m * DM + 8 * l + 512 * j) = o;
#endif
            }
    }
}

struct GlaW { float wcol[16], bcol; };
__device__ __forceinline__ void gla_load_w(const float* wg, const float* bgp, int h, int tid, GlaW& gw_) {
    const int kk = tid & 127;
#pragma unroll
    for (int c = 0; c < 16; ++c) gw_.wcol[c] = wg[c * 512 + h * 128 + kk];
    gw_.bcol = bgp[h * 128 + kk];
}
__device__ __forceinline__ void gla_cumsum(const LAS float* GL, const GlaW& gw_, LAS float* BC, LAS float* SEG, int tid) {
    const int seg = tid >> 7, kk = tid & 127;
    const float (&wcol)[16] = gw_.wcol; const float bcol = gw_.bcol;
    float v[16];
#pragma unroll
    for (int i = 0; i < 16; ++i) { const LAS f32x4* g4 = (const LAS f32x4*)(GL + (16 * seg + i) * 16); float sacc = bcol;
#pragma unroll
        for (int c4 = 0; c4 < 4; ++c4) { const f32x4 gq = g4[c4]; sacc += gq[0] * wcol[4 * c4] + gq[1] * wcol[4 * c4 + 1] + gq[2] * wcol[4 * c4 + 2] + gq[3] * wcol[4 * c4 + 3]; }
        v[i] = log_sigmoid_f(sacc) * 0.0625f; }
#pragma unroll
    for (int i = 1; i < 16; ++i) v[i] += v[i - 1];
    SEG[seg * 128 + kk] = v[15];
    __syncthreads();
    float off = 0.f;
#pragma unroll
    for (int s = 0; s < 3; ++s) off += (s < seg) ? SEG[s * 128 + kk] : 0.f;
#pragma unroll
    for (int i = 0; i < 16; ++i) BC[(16 * seg + i) * 128 + kk] = v[i] + off;
    __syncthreads();
}
__device__ __forceinline__ bf16x8 as_bf16x8(u32x4 v) { return __builtin_bit_cast(bf16x8, v); }
__device__ __forceinline__ bf16x8 cat4(bf16x4 lo, bf16x4 hi) { return __builtin_shufflevector(lo, hi, 0, 1, 2, 3, 4, 5, 6, 7); }

__device__ __forceinline__ void p2a(Frame& F, const Params& p) {
    const bf16_t* Z = (const bf16_t*)(F.ws + WS_Z);
    bf16_t* AN = (bf16_t*)(F.ws + WS_AN); float* DN = (float*)(F.ws + WS_DN);
    const bf16_t* WaT = (const bf16_t*)(F.ws + WS_WAT); const bf16_t* WiT = (const bf16_t*)(F.ws + WS_WIT);
    LAS float* BC = (LAS float*)(F.lds); LAS float* SEG = (LAS float*)(F.lds + 32768);
    LAS bf16_t* KDT = (LAS bf16_t*)(F.lds + 34816); LAS bf16_t* VT = (LAS bf16_t*)(F.lds + 53248); LAS bf16_t* XC = (LAS bf16_t*)(F.lds + 90112);
    const int w = F.wave;
    LAS float* GLR = (LAS float*)(F.lds + 90112);
    LAS float* GL = (LAS float*)(F.lds + 124928);
    const float* wg = p.in[I_GWG]; const float* bgp = p.in[I_GBG];
    for (int unit = blockIdx.x; unit < NCHUNK; unit += F.G) {
        const int b = unit >> 7, n = unit & 127, tok0 = b * SEQL + 64 * n;
        {
            const int lane = fresh_lane(), r16 = lane & 15, q4 = lane >> 4;
            const bf16_t* Hb = (const bf16_t*)(F.ws + WS_H) + (size_t)(tok0 + r16) * DM + 256 * w + 8 * q4;
            const bf16_t* Wb = (const bf16_t*)(F.ws + WS_WGLT) + (size_t)r16 * DM + 256 * w + 8 * q4;
            f32x4 gacc[4];
#pragma unroll
            for (int mb = 0; mb < 4; ++mb) gacc[mb] = (f32x4){0.f, 0.f, 0.f, 0.f};
#pragma unroll
            for (int sb = 0; sb < 2; ++sb) { bf16x8 af[4][4], bfr[4];
#pragma unroll
                for (int s4 = 0; s4 < 4; ++s4) { bfr[s4] = *(const bf16x8*)(Wb + 32 * (4 * sb + s4));
#pragma unroll
                    for (int mb = 0; mb < 4; ++mb) af[s4][mb] = *(const bf16x8*)(Hb + (size_t)(16 * mb) * DM + 32 * (4 * sb + s4)); }
#pragma unroll
                for (int s4 = 0; s4 < 4; ++s4)
#pragma unroll
                    for (int mb = 0; mb < 4; ++mb) gacc[mb] = __builtin_amdgcn_mfma_f32_16x16x32_bf16(af[s4][mb], bfr[s4], gacc[mb], 0, 0, 0); }
#pragma unroll
            for (int mb = 0; mb < 4; ++mb)
#pragma unroll
                for (int q = 0; q < 4; ++q) GLR[(w * 64 + 16 * mb + 4 * q4 + q) * 16 + r16] = gacc[mb][q];
            __syncthreads();
            const int tid2 = w * 64 + lane;
#pragma unroll
            for (int it = 0; it < 2; ++it) { const int o = tid2 + 512 * it; float sacc = 0.f;
#pragma unroll
                for (int w2 = 0; w2 < 8; ++w2) sacc += GLR[w2 * 1024 + o];
                GL[o] = sacc; ((float*)(F.ws + WS_LG))[(size_t)tok0 * 16 + o] = sacc; }
            __syncthreads();
        }
        for (int h = 0; h < 4; ++h) {
            int lane = fresh_lane(), tid = F.wave * 64 + lane;
            int r = lane & 31, hh = lane >> 5;
            GlaW gw_; gla_load_w(wg, bgp, h, tid, gw_);
            u32x4 kvr[2], vvr[4];
#pragma unroll
            for (int it = 0; it < 2; ++it) { const int item = tid + 512 * it, t = item & 63, kk8 = item >> 6; kvr[it] = *(const u32x4*)(Z + (size_t)(tok0 + t) * ZC + ZK + h * 128 + kk8 * 8); }
#pragma unroll
            for (int it = 0; it < 4; ++it) { const int item = tid + 512 * it, t = item & 63, vc8 = item >> 6; vvr[it] = *(const u32x4*)(Z + (size_t)(tok0 + t) * ZC + ZV + h * 256 + vc8 * 8); }
            gla_cumsum(GL, gw_, BC, SEG, tid);
            const int uh = (b * 4 + h) * 128 + n;
            if (tid < 128) DN[(size_t)uh * 128 + tid] = __expf(BC[63 * 128 + tid]);
#pragma unroll
            for (int it = 0; it < 2; ++it) { const int item = tid + 512 * it, t = item & 63, kk8 = item >> 6;
                const u32x4 kv = kvr[it];
#pragma unroll
                for (int i = 0; i < 8; ++i) { const int kk = kk8 * 8 + i; const unsigned wv = kv[i >> 1]; const float kf = (i & 1) ? bfhi(wv) : bflo(wv);
                    const float d = __expf(BC[63 * 128 + kk] - BC[t * 128 + kk]); KDT[kk * 72 + t] = (bf16_t)f2bf(kf * d); } }
#pragma unroll
            for (int it = 0; it < 4; ++it) { const int item = tid + 512 * it, t = item & 63, vc8 = item >> 6;
                const u32x4 vv = vvr[it];
#pragma unroll
                for (int i = 0; i < 8; ++i) { const unsigned wv = vv[i >> 1]; VT[(vc8 * 8 + i) * 72 + t] = (bf16_t)((i & 1) ? (wv >> 16) : (wv & 0xffffu)); } }
#ifndef P2A_NO_LRU
            u32x4 lv[7]; f32x4 cwv[4][2], cbv[2];
            { const float* cw = p.in[I_CW]; const float* cb = p.in[I_CB]; const int c8 = tid & 31, tq = tid >> 5, chc = h * 256 + c8 * 8;
#pragma unroll
              for (int i = 0; i < 7; ++i) { const int sq = 64 * n + 4 * tq - 3 + i;
                  lv[i] = (sq >= 0) ? *(const u32x4*)(Z + (size_t)(tok0 + 4 * tq - 3 + i) * ZC + ZLX + chc) : (u32x4){0u, 0u, 0u, 0u}; }
#pragma unroll
              for (int i = 0; i < 4; ++i) { cwv[i][0] = *(const f32x4*)(cw + i * 1024 + chc); cwv[i][1] = *(const f32x4*)(cw + i * 1024 + chc + 4); }
              cbv[0] = *(const f32x4*)(cb + chc); cbv[1] = *(const f32x4*)(cb + chc + 4); }
#endif
            __syncthreads();
            {
                f32x16 acc[4];
#pragma unroll
                for (int mb = 0; mb < 4; ++mb)
#pragma unroll
                    for (int q = 0; q < 16; ++q) acc[mb][q] = 0.f;
#pragma unroll
                for (int s = 0; s < 4; ++s) { const bf16x8 bfr = *(const LAS bf16x8*)(VT + (32 * w + r) * 72 + 16 * s + 8 * hh);
#pragma unroll
                    for (int mb = 0; mb < 4; ++mb) { const bf16x8 afr = *(const LAS bf16x8*)(KDT + (32 * mb + r) * 72 + 16 * s + 8 * hh);
                        acc[mb] = __builtin_amdgcn_mfma_f32_32x32x16_bf16(afr, bfr, acc[mb], 0, 0, 0); } }
                bf16_t* base = AN + (size_t)uh * 32768;
#pragma unroll
                for (int mb = 0; mb < 4; ++mb)
#pragma unroll
                    for (int s2 = 0; s2 < 2; ++s2) { u32x4 o;
#pragma unroll
                        for (int q = 0; q < 4; ++q) o[q] = pk2(acc[mb][8 * s2 + 2 * q], acc[mb][8 * s2 + 2 * q + 1]);
                        *(u32x4*)(base + (((mb * 8 + w) * 2 + s2) * 64 + lane) * 8) = o; }
            }
#ifndef P2A_NO_LRU
            {
                {
                    const int c8 = tid & 31, tq = tid >> 5;
#pragma unroll
                    for (int it = 0; it < 4; ++it) { float xc[8];
#pragma unroll
                        for (int q = 0; q < 4; ++q) { xc[q] = cbv[0][q]; xc[4 + q] = cbv[1][q]; }
#pragma unroll
                        for (int i = 0; i < 4; ++i) { const u32x4 l4 = lv[it + i];
                            xc[0] += bflo(l4[0]) * cwv[i][0][0]; xc[1] += bfhi(l4[0]) * cwv[i][0][1]; xc[2] += bflo(l4[1]) * cwv[i][0][2]; xc[3] += bfhi(l4[1]) * cwv[i][0][3];
                            xc[4] += bflo(l4[2]) * cwv[i][1][0]; xc[5] += bfhi(l4[2]) * cwv[i][1][1]; xc[6] += bflo(l4[3]) * cwv[i][1][2]; xc[7] += bfhi(l4[3]) * cwv[i][1][3]; }
                        u32x4 o; o.x = pk2(xc[0], xc[1]); o.y = pk2(xc[2], xc[3]); o.z = pk2(xc[4], xc[5]); o.w = pk2(xc[6], xc[7]);
                        *(LAS u32x4*)(XC + (4 * tq + it) * 264 + c8 * 8) = o; }
                }
                __builtin_amdgcn_sched_barrier(0);
                bf16x8 ba[16], bi[16];
                { const bf16_t* wa = WaT + (size_t)h * 65536 + (size_t)(32 * w + r) * 256 + 8 * hh;
                  const bf16_t* wi = WiT + (size_t)h * 65536 + (size_t)(32 * w + r) * 256 + 8 * hh;
#pragma unroll
                  for (int s = 0; s < 16; ++s) { ba[s] = *(const bf16x8*)(wa + 16 * s); bi[s] = *(const bf16x8*)(wi + 16 * s); } }
                const int ch = h * 256 + 32 * w + r;
                const float ba_ = p.in[I_BA][ch], bi_ = p.in[I_BI][ch]; const float L = p.in[I_AP][ch];
                __syncthreads();
                f32x16 aa[2], ai[2];
#pragma unroll
                for (int mb = 0; mb < 2; ++mb)
#pragma unroll
                    for (int q = 0; q < 16; ++q) { aa[mb][q] = 0.f; ai[mb][q] = 0.f; }
#pragma unroll
                for (int s = 0; s < 16; ++s) {
#pragma unroll
                    for (int mb = 0; mb < 2; ++mb) { const bf16x8 af = *(const LAS bf16x8*)(XC + (32 * mb + r) * 264 + 16 * s + 8 * hh);
                        aa[mb] = __builtin_amdgcn_mfma_f32_32x32x16_bf16(af, ba[s], aa[mb], 0, 0, 0); } }
                __builtin_amdgcn_sched_barrier(0);
#pragma unroll
                for (int s = 0; s < 16; ++s) {
#pragma unroll
                    for (int mb = 0; mb < 2; ++mb) { const bf16x8 af = *(const LAS bf16x8*)(XC + (32 * mb + r) * 264 + 16 * s + 8 * hh);
                        ai[mb] = __builtin_amdgcn_mfma_f32_32x32x16_bf16(af, bi[s], ai[mb], 0, 0, 0); } }
                const float sp = fmaxf(-L, 0.f) + log1pf(__expf(-fabsf(L)));
#pragma unroll
                for (int mb = 0; mb < 2; ++mb)
#pragma unroll
                    for (int q = 0; q < 16; ++q) { const int t = 32 * mb + (q & 3) + 8 * (q >> 2) + 4 * hh;
                        if ((q & 3) == 0) __builtin_amdgcn_sched_barrier(0);
                        const float ga = sigmoidf_(aa[mb][q] + ba_), gi = sigmoidf_(ai[mb][q] + bi_);
                        const float la = -8.0f * ga * sp; const float a = __expf(la);
                        const float xcv = bf2f(XC[t * 264 + 32 * w + r]);
                        aa[mb][q] = a; ai[mb][q] = xcv * gi * __builtin_amdgcn_sqrtf(fmaxf(1.0f - a * a, 0.f)); }
#pragma unroll
                for (int mb = 0; mb < 2; ++mb)
#pragma unroll
                    for (int g = 0; g < 4; ++g)
#pragma unroll
                        for (int i = 1; i < 4; ++i) { const int q = 4 * g + i; ai[mb][q] = aa[mb][q] * ai[mb][q - 1] + ai[mb][q]; aa[mb][q] = aa[mb][q] * aa[mb][q - 1]; }
                LAS bf16_t* HL = (LAS bf16_t*)(F.lds); LAS bf16_t* AC = (LAS bf16_t*)(F.lds + 34816);
                float carryH = 0.f, carryP = 1.f;
#pragma unroll
                for (int mb = 0; mb < 2; ++mb)
#pragma unroll
                    for (int g = 0; g < 4; ++g) { const float myP = aa[mb][4 * g + 3], myH = ai[mb][4 * g + 3];
                        const float pP = __shfl_xor(myP, 32), pH = __shfl_xor(myH, 32);
                        const float fP = hh ? pP : myP, fH = hh ? pH : myH, sP = hh ? myP : pP, sH = hh ? myH : pH;
                        const float c1H = fP * carryH + fH, c1P = carryP * fP;
                        const float Cin = hh ? c1H : carryH, Pin = hh ? c1P : carryP;
                        carryH = sP * c1H + sH; carryP = c1P * sP;
#pragma unroll
                        for (int i = 0; i < 4; ++i) { const int q = 4 * g + i, t = 32 * mb + 8 * g + 4 * hh + i;
                            HL[t * 264 + 32 * w + r] = (bf16_t)f2bf(ai[mb][q] + aa[mb][q] * Cin); AC[t * 264 + 32 * w + r] = (bf16_t)f2bf(aa[mb][q] * Pin); } }
                if (hh == 0) { float* SUMA = (float*)(F.ws + WS_SUMA); float* SUMH = (float*)(F.ws + WS_SUMH); SUMA[unit * 1024 + ch] = carryP; SUMH[unit * 1024 + ch] = carryH; }
                __syncthreads();
                { bf16_t* HLOC = (bf16_t*)(F.ws + WS_AUA); bf16_t* ACUM = (bf16_t*)(F.ws + WS_AUU);
#pragma unroll
                  for (int it = 0; it < 4; ++it) { const int item = tid + 512 * it, c8 = item & 31, t = item >> 5; const size_t o = (size_t)(tok0 + t) * 1024 + h * 256 + c8 * 8;
                      *(u32x4*)(HLOC + o) = *(const LAS u32x4*)(HL + t * 264 + c8 * 8); *(u32x4*)(ACUM + o) = *(const LAS u32x4*)(AC + t * 264 + c8 * 8); } }
            }
#endif
            __syncthreads();
        }
    }
}

__device__ __forceinline__ void p2b(Frame& F, const Params& p) {
    const bf16_t* AN = (const bf16_t*)(F.ws + WS_AN); const float* DN = (const float*)(F.ws + WS_DN); bf16_t* SP = (bf16_t*)(F.ws + WS_SP);
    if (F.tid < 128) {
        for (int st = (int)blockIdx.x * 128 + F.tid; st < 32768; st += F.G * 128) {
            const int bh = st >> 12, rem = st & 4095, ln = rem & 63, s2 = (rem >> 6) & 1, w = (rem >> 7) & 7, mb = (rem >> 10) & 3;
            const int kk0 = 32 * mb + 16 * s2 + 4 * (ln >> 5);
            const int offS = (((mb * 8 + w) * 2 + s2) * 64 + ln) * 8;
            f32x4 S0 = (f32x4){0.f, 0.f, 0.f, 0.f}, S1 = S0;
            for (int n0 = 0; n0 < 128; n0 += 16) {
                u32x4 av[16]; f32x4 d0[16], d1[16];
#pragma unroll
                for (int i = 0; i < 16; ++i) { const size_t uh = (size_t)bh * 128 + n0 + i;
                    av[i] = *(const u32x4*)(AN + uh * 32768 + offS);
                    d0[i] = *(const f32x4*)(DN + uh * 128 + kk0); d1[i] = *(const f32x4*)(DN + uh * 128 + kk0 + 8); }
#pragma unroll
                for (int i = 0; i < 16; ++i) { const size_t uh = (size_t)bh * 128 + n0 + i;
                    u32x4 o; o.x = pk2(S0[0], S0[1]); o.y = pk2(S0[2], S0[3]); o.z = pk2(S1[0], S1[1]); o.w = pk2(S1[2], S1[3]);
                    *(u32x4*)(SP + uh * 32768 + offS) = o;
                    const f32x4 a0 = (f32x4){bflo(av[i].x), bfhi(av[i].x), bflo(av[i].y), bfhi(av[i].y)}, a1 = (f32x4){bflo(av[i].z), bfhi(av[i].z), bflo(av[i].w), bfhi(av[i].w)};
                    S0 = d0[i] * S0 + a0; S1 = d1[i] * S1 + a1; } }
        }
    } else if (F.wave == 2) {
        const float* SUMA = (const float*)(F.ws + WS_SUMA); float* SUMH = (float*)(F.ws + WS_SUMH);
        for (int wv = (int)blockIdx.x; wv < 64; wv += F.G) {
            const int seg = F.lane >> 4, sid = wv * 16 + (F.lane & 15), b = sid >> 9, ch = 2 * (sid & 511);
            const size_t o0 = (size_t)(b * 128 + seg * 32) * 1024 + ch;
            f32x2 a[32], hv[32];
#pragma unroll
            for (int q = 0; q < 32; ++q) { a[q] = *(const f32x2*)(SUMA + o0 + (size_t)q * 1024); hv[q] = *(const f32x2*)(SUMH + o0 + (size_t)q * 1024); }
            f32x2 A = (f32x2){1.f, 1.f}, H = (f32x2){0.f, 0.f};
#pragma unroll
            for (int q = 0; q < 32; ++q) { H = a[q] * H + hv[q]; A = a[q] * A; }
            f32x2 hc = (f32x2){0.f, 0.f};
#pragma unroll
            for (int k = 0; k < 3; ++k) { const int src = k * 16 + (F.lane & 15);
                const f32x2 Ak = (f32x2){__shfl(A.x, src), __shfl(A.y, src)}, Hk = (f32x2){__shfl(H.x, src), __shfl(H.y, src)};
                if (k < seg) hc = Ak * hc + Hk; }
#pragma unroll
            for (int q = 0; q < 32; ++q) { *(f32x2*)(SUMH + o0 + (size_t)q * 1024) = hc; hc = a[q] * hc + hv[q]; }
        }
    }
}

__device__ __forceinline__ void p2c(Frame& F, const Params& p) {
    const bf16_t* Z = (const bf16_t*)(F.ws + WS_Z); const float* GLOW = (const float*)(F.ws + WS_LG); const bf16_t* SP = (const bf16_t*)(F.ws + WS_SP);
    LAS float* GL = (LAS float*)(F.lds + 124928); const float* wg = p.in[I_GWG]; const float* bgp = p.in[I_GBG];
    bf16_t* MIX = (bf16_t*)(F.ws + WS_MIX);
    LAS float* BC = (LAS float*)(F.lds); LAS float* SEG = (LAS float*)(F.lds + 32768);
    LAS bf16_t* QE = (LAS bf16_t*)(F.lds + 34816); LAS bf16_t* KE = (LAS bf16_t*)(F.lds + 52224); LAS bf16_t* VT = (LAS bf16_t*)(F.lds + 69632);
    LAS float* SSQ = (LAS float*)(F.lds + 106496); LAS float* OS = (LAS float*)(F.lds);
    const int w = F.wave;
    const float* gng = p.in[I_GNG];
    for (int unit = blockIdx.x; unit < NCHUNK; unit += F.G) {
        const int b = unit >> 7, n = unit & 127, tok0 = b * SEQL + 64 * n;
        const int lane = fresh_lane(), tid = w * 64 + lane, r = lane & 31, hh = lane >> 5;
        { const float* SUMH = (const float*)(F.ws + WS_SUMH);
          const int ch = 2 * tid; const f32x2 hc = *(const f32x2*)(SUMH + (size_t)unit * 1024 + ch);
          const bf16_t* HLOC = (const bf16_t*)(F.ws + WS_AUA); const bf16_t* ACUM = (const bf16_t*)(F.ws + WS_AUU);
          unsigned hv[16], av[16], lgw[16];
#pragma unroll
          for (int i = 0; i < 16; ++i) { const size_t tok = (size_t)tok0 + i;
              hv[i] = *(const unsigned*)(HLOC + tok * 1024 + ch); av[i] = *(const unsigned*)(ACUM + tok * 1024 + ch); lgw[i] = *(const unsigned*)(Z + tok * ZC + ZLG + ch); }
#pragma unroll 1
          for (int t0 = 0; t0 < 64; t0 += 16) {
              unsigned hc_[16], ac_[16], lc_[16];
#pragma unroll
              for (int i = 0; i < 16; ++i) { hc_[i] = hv[i]; ac_[i] = av[i]; lc_[i] = lgw[i]; }
              if (t0 + 16 < 64) {
#pragma unroll
                  for (int i = 0; i < 16; ++i) { const size_t tok = (size_t)tok0 + t0 + 16 + i;
                      hv[i] = *(const unsigned*)(HLOC + tok * 1024 + ch); av[i] = *(const unsigned*)(ACUM + tok * 1024 + ch); lgw[i] = *(const unsigned*)(Z + tok * ZC + ZLG + ch); } }
#pragma unroll
              for (int i = 0; i < 16; ++i) { const size_t tok = (size_t)tok0 + t0 + i;
                  const float h0 = bflo(hc_[i]) + bflo(ac_[i]) * hc.x, h1 = bfhi(hc_[i]) + bfhi(ac_[i]) * hc.y;
                  *(unsigned*)(MIX + tok * DM + 1024 + ch) = pk2(h0 * gelu_tanh_f(bflo(lc_[i])), h1 * gelu_tanh_f(bfhi(lc_[i]))); } } }
        { const f32x2 gq = *(const f32x2*)(GLOW + (size_t)tok0 * 16 + 2 * tid); *(LAS f32x2*)(GL + 2 * tid) = gq; }
        __syncthreads();
        for (int h = 0; h < 4; ++h) {
            const int uh = (b * 4 + h) * 128 + n;
            GlaW gw_; gla_load_w(wg, bgp, h, tid, gw_);
            u32x4 qvr[2], kvr[2], vvr[4];
#pragma unroll
            for (int it = 0; it < 2; ++it) { const int item = tid + 512 * it, kk8 = item & 15, t = item >> 4;
                qvr[it] = *(const u32x4*)(Z + (size_t)(tok0 + t) * ZC + ZQ + h * 128 + kk8 * 8); kvr[it] = *(const u32x4*)(Z + (size_t)(tok0 + t) * ZC + ZK + h * 128 + kk8 * 8); }
#pragma unroll
            for (int it = 0; it < 4; ++it) { const int item = tid + 512 * it, t = item & 63, vc8 = item >> 6; vvr[it] = *(const u32x4*)(Z + (size_t)(tok0 + t) * ZC + ZV + h * 256 + vc8 * 8); }
            gla_cumsum(GL, gw_, BC, SEG, tid);
            bf16x8 sf[4][2];
            { const bf16_t* spu = SP + (size_t)uh * 32768;
#pragma unroll
              for (int mb = 0; mb < 4; ++mb)
#pragma unroll
                  for (int s2 = 0; s2 < 2; ++s2) sf[mb][s2] = *(const bf16x8*)(spu + (((mb * 8 + w) * 2 + s2) * 64 + lane) * 8); }
#pragma unroll
            for (int it = 0; it < 2; ++it) { const int item = tid + 512 * it, kk8 = item & 15, t = item >> 4;
                const u32x4 qv = qvr[it];
                const u32x4 kv = kvr[it];
                const f32x4 b0 = *(const LAS f32x4*)(BC + t * 128 + kk8 * 8), b1 = *(const LAS f32x4*)(BC + t * 128 + kk8 * 8 + 4);
                float qe[8], ke[8];
#pragma unroll
                for (int i = 0; i < 8; ++i) { const float bb = (i < 4) ? b0[i & 3] : b1[i & 3]; const unsigned qw = qv[i >> 1], kw = kv[i >> 1];
                    const float qf = (i & 1) ? bfhi(qw) : bflo(qw), kf = (i & 1) ? bfhi(kw) : bflo(kw);
                    qe[i] = qf * 0.08838834764831845f * __expf(bb); ke[i] = kf * __expf(-bb); }
                u32x4 oq, ok; oq.x = pk2(qe[0], qe[1]); oq.y = pk2(qe[2], qe[3]); oq.z = pk2(qe[4], qe[5]); oq.w = pk2(qe[6], qe[7]);
                ok.x = pk2(ke[0], ke[1]); ok.y = pk2(ke[2], ke[3]); ok.z = pk2(ke[4], ke[5]); ok.w = pk2(ke[6], ke[7]);
                *(LAS u32x4*)(QE + t * 136 + kk8 * 8) = oq; *(LAS u32x4*)(KE + t * 136 + kk8 * 8) = ok; }
#pragma unroll
            for (int it = 0; it < 4; ++it) { const int item = tid + 512 * it, t = item & 63, vc8 = item >> 6;
                const u32x4 vv = vvr[it];
#pragma unroll
                for (int i = 0; i < 8; ++i) { const unsigned wv = vv[i >> 1]; VT[(vc8 * 8 + i) * 72 + t] = (bf16_t)((i & 1) ? (wv >> 16) : (wv & 0xffffu)); } }
            __syncthreads();
            f32x16 oacc[2];
            {
                f32x16 P00, P01, P11;
#pragma unroll
                for (int q = 0; q < 16; ++q) { P00[q] = 0.f; P01[q] = 0.f; P11[q] = 0.f; oacc[0][q] = 0.f; oacc[1][q] = 0.f; }
#pragma unroll
                for (int s = 0; s < 8; ++s) {
                    const bf16x8 a0 = *(const LAS bf16x8*)(KE + r * 136 + 16 * s + 8 * hh), a1 = *(const LAS bf16x8*)(KE + (32 + r) * 136 + 16 * s + 8 * hh);
                    const bf16x8 b0 = *(const LAS bf16x8*)(QE + r * 136 + 16 * s + 8 * hh), b1 = *(const LAS bf16x8*)(QE + (32 + r) * 136 + 16 * s + 8 * hh);
                    P00 = __builtin_amdgcn_mfma_f32_32x32x16_bf16(a0, b0, P00, 0, 0, 0);
                    P01 = __builtin_amdgcn_mfma_f32_32x32x16_bf16(a0, b1, P01, 0, 0, 0);
                    P11 = __builtin_amdgcn_mfma_f32_32x32x16_bf16(a1, b1, P11, 0, 0, 0); }
#pragma unroll
                for (int q = 0; q < 16; ++q) { const int jl = (q & 3) + 8 * (q >> 2) + 4 * hh; if (jl > r) { P00[q] = 0.f; P11[q] = 0.f; } }
                bf16x8 F00[2], F01[2], F11[2];
#pragma unroll
                for (int s2 = 0; s2 < 2; ++s2) {
                    u32x4 t0, t1, t2;
#pragma unroll
                    for (int q = 0; q < 4; ++q) { t0[q] = pk2(P00[8 * s2 + 2 * q], P00[8 * s2 + 2 * q + 1]); t1[q] = pk2(P01[8 * s2 + 2 * q], P01[8 * s2 + 2 * q + 1]); t2[q] = pk2(P11[8 * s2 + 2 * q], P11[8 * s2 + 2 * q + 1]); }
                    F00[s2] = as_bf16x8(t0); F01[s2] = as_bf16x8(t1); F11[s2] = as_bf16x8(t2); }
#pragma unroll
                for (int mb = 0; mb < 4; ++mb)
#pragma unroll
                    for (int s2 = 0; s2 < 2; ++s2) { const bf16x8 af = sf[mb][s2];
                        const int kkb = 32 * mb + 16 * s2 + 4 * hh;
#pragma unroll
                        for (int ib = 0; ib < 2; ++ib) { const bf16x4 lo = *(const LAS bf16x4*)(QE + (32 * ib + r) * 136 + kkb), hi = *(const LAS bf16x4*)(QE + (32 * ib + r) * 136 + kkb + 8);
                            oacc[ib] = __builtin_amdgcn_mfma_f32_32x32x16_bf16(af, cat4(lo, hi), oacc[ib], 0, 0, 0); } }
#pragma unroll
                for (int s2 = 0; s2 < 2; ++s2) {
                    const int tb0 = 16 * s2 + 4 * hh, tb1 = 32 + 16 * s2 + 4 * hh;
                    const bf16x8 v0 = cat4(*(const LAS bf16x4*)(VT + (32 * w + r) * 72 + tb0), *(const LAS bf16x4*)(VT + (32 * w + r) * 72 + tb0 + 8));
                    const bf16x8 v1 = cat4(*(const LAS bf16x4*)(VT + (32 * w + r) * 72 + tb1), *(const LAS bf16x4*)(VT + (32 * w + r) * 72 + tb1 + 8));
                    oacc[0] = __builtin_amdgcn_mfma_f32_32x32x16_bf16(v0, F00[s2], oacc[0], 0, 0, 0);
                    oacc[1] = __builtin_amdgcn_mfma_f32_32x32x16_bf16(v0, F01[s2], oacc[1], 0, 0, 0);
                    oacc[1] = __builtin_amdgcn_mfma_f32_32x32x16_bf16(v1, F11[s2], oacc[1], 0, 0, 0); }
            }
            u32x4 rvr[4];
#pragma unroll
            for (int it = 0; it < 4; ++it) { const int item = tid + 512 * it, vc8 = item & 31, t = item >> 5; rvr[it] = *(const u32x4*)(Z + (size_t)(tok0 + t) * ZC + ZR + h * 256 + vc8 * 8); }
#pragma unroll
            for (int ib = 0; ib < 2; ++ib) { float sq = 0.f;
#pragma unroll
                for (int q = 0; q < 16; ++q) sq += oacc[ib][q] * oacc[ib][q];
                sq += __shfl_xor(sq, 32);
                if (hh == 0) SSQ[w * 64 + 32 * ib + r] = sq; }
            __syncthreads();
#pragma unroll
            for (int ib = 0; ib < 2; ++ib) { float tot = 0.f;
#pragma unroll
                for (int w2 = 0; w2 < 8; ++w2) tot += SSQ[w2 * 64 + 32 * ib + r];
                const float rs = rsqrtf_(tot * (1.0f / 256.0f) + 1e-6f);
#pragma unroll
                for (int g = 0; g < 4; ++g) *(LAS f32x4*)(OS + (32 * ib + r) * 260 + 32 * w + 8 * g + 4 * hh) =
                    (f32x4){oacc[ib][4 * g] * rs, oacc[ib][4 * g + 1] * rs, oacc[ib][4 * g + 2] * rs, oacc[ib][4 * g + 3] * rs}; }
            __syncthreads();
#pragma unroll
            for (int it = 0; it < 4; ++it) { const int item = tid + 512 * it, vc8 = item & 31, t = item >> 5; const int c = h * 256 + vc8 * 8;
                const f32x4 o0 = *(const LAS f32x4*)(OS + t * 260 + vc8 * 8), o1 = *(const LAS f32x4*)(OS + t * 260 + vc8 * 8 + 4);
                const u32x4 rv = rvr[it];
                const f32x4 g0 = *(const f32x4*)(gng + c), g1 = *(const f32x4*)(gng + c + 4);
                float o[8];
#pragma unroll
                for (int i = 0; i < 8; ++i) { const unsigned rw = rv[i >> 1]; const float rf = (i & 1) ? bfhi(rw) : bflo(rw);
                    const float sil = rf * sigmoidf_(rf); o[i] = sil * ((i < 4) ? o0[i & 3] * g0[i & 3] : o1[i & 3] * g1[i & 3]); }
                u32x4 ov; ov.x = pk2(o[0], o[1]); ov.y = pk2(o[2], o[3]); ov.z = pk2(o[4], o[5]); ov.w = pk2(o[6], o[7]);
                *(u32x4*)(MIX + (size_t)(tok0 + t) * DM + c) = ov; }
            __syncthreads();
        }
    }
}

__device__ __forceinline__ void build_moe_tables(Frame& F) {
    unsigned* cnt = (unsigned*)(F.ws + WS_CTL) + CW_CNT;
    if (F.tid < 64) {
        const int e = F.tid; const int c = (e < NEXP) ? (int)xb_ld(cnt + 64 * e) : 0; const int mt = (c + 255) >> 8;
        int inc = mt;
#pragma unroll
        for (int d = 1; d < 32; d <<= 1) { const int o = __shfl_up(inc, d); if ((e & 63) >= d) inc += o; }
        const int first = inc - mt;
        if (e < NEXP) { F.MISC[MI_PBASE + e] = (unsigned)(first * 256); F.MISC[MI_CNT + e] = (unsigned)c;
            for (int q = 0; q < mt; ++q) F.MISC[MI_T2E + first + q] = (unsigned)e;
            if (e == NEXP - 1) F.MISC[MI_NMT] = (unsigned)inc; }
    }
    __syncthreads();
}

__device__ __forceinline__ void p4a(Frame& F, const Params& p) {
    const bf16_t* XMID = (const bf16_t*)(F.ws + WS_XMID); const float* WrT = (const float*)(F.ws + WS_WRT); const float* br = p.in[I_BR];
    float* RSTD = (float*)(F.ws + WS_RSTD); unsigned* TOKE = (unsigned*)(F.ws + WS_TOKE); float* GATES = (float*)(F.ws + WS_GATES);
    unsigned* cnt = (unsigned*)(F.ws + WS_CTL) + CW_CNT;
    unsigned char* HF8 = F.ws + WS_HF8; unsigned short* LIST = (unsigned short*)(F.ws + WS_LIST); const float* gf = p.in[I_NFG];
    LAS float* RED = (LAS float*)(F.lds); LAS float* SSQ2 = (LAS float*)(F.lds + 32768); LAS float* LGT = (LAS float*)(F.lds + 33792); LAS float* RS = (LAS float*)(F.lds + 38016);
    const int tid = F.tid, lane = F.lane, w = F.wave, m = lane & 31, kh = lane >> 5;
    if (tid < 32) F.MISC[MI_LCNT + tid] = 0u;
    __syncthreads();
    f32x4 bw[32];
    { const float* bp = WrT + (size_t)m * DM + 256 * w + 128 * kh;
#pragma unroll
      for (int c = 0; c < 32; ++c) bw[c] = *(const f32x4*)(bp + 4 * c); }
    LAS float* RSA = (LAS float*)(F.lds + 38400);
    int ui = 0;
    for (int ut = blockIdx.x; ut < T / 32; ut += F.G, ++ui) {
        const int m0 = 32 * ut; const int kw = 256 * w + 128 * kh;
        f32x16 acc;
#pragma unroll
        for (int q = 0; q < 16; ++q) acc[q] = 0.f;
        float ss = 0.f;
        const bf16_t* ap = XMID + (size_t)(m0 + m) * DM + kw;
        u32x4 ar[16];
#pragma unroll
        for (int c = 0; c < 16; ++c) ar[c] = *(const u32x4*)(ap + 8 * c);
#pragma unroll
        for (int c = 0; c < 16; ++c) { const u32x4 r0 = ar[c];
            const f32x4 a0 = (f32x4){bflo(r0.x), bfhi(r0.x), bflo(r0.y), bfhi(r0.y)}, a1 = (f32x4){bflo(r0.z), bfhi(r0.z), bflo(r0.w), bfhi(r0.w)};
#pragma unroll
            for (int i = 0; i < 4; ++i) { acc = __builtin_amdgcn_mfma_f32_32x32x2f32(a0[i], bw[2 * c][i], acc, 0, 0, 0); ss += a0[i] * a0[i]; }
#pragma unroll
            for (int i = 0; i < 4; ++i) { acc = __builtin_amdgcn_mfma_f32_32x32x2f32(a1[i], bw[2 * c + 1][i], acc, 0, 0, 0); ss += a1[i] * a1[i]; } }
        ss += __shfl_xor(ss, 32);
#pragma unroll
        for (int q = 0; q < 16; ++q) RED[(w * 16 + q) * 64 + lane] = acc[q];
        if (kh == 0) SSQ2[w * 32 + m] = ss;
        __syncthreads();
#pragma unroll
        for (int it = 0; it < 2; ++it) { const int o = tid + 512 * it, reg = o >> 6, ln = o & 63, nn = ln & 31, h2 = ln >> 5; const int mm = (reg & 3) + 8 * (reg >> 2) + 4 * h2;
            float v = 0.f, s2 = 0.f;
#pragma unroll
            for (int w2 = 0; w2 < 8; ++w2) { v += RED[(w2 * 16 + reg) * 64 + ln]; s2 += SSQ2[w2 * 32 + mm]; }
            const float rs = rsqrtf_(s2 * (1.0f / DM) + 1e-6f);
            LGT[mm * 33 + nn] = v * rs + br[nn]; if (nn == 0) { RS[mm] = rs; RSA[32 * ui + mm] = rs; } }
        __syncthreads();
        int ex[4]; unsigned ls[4]; float gt[4];
        if (tid < 32) {
            float l[32];
#pragma unroll
            for (int i = 0; i < 32; ++i) l[i] = LGT[tid * 33 + i];
            float val[4];
#pragma unroll
            for (int k = 0; k < 4; ++k) { float best = -3.0e38f; int bi = 0;
#pragma unroll
                for (int i = 0; i < 32; ++i) if (l[i] > best) { best = l[i]; bi = i; }
                ex[k] = bi; val[k] = best;
#pragma unroll
                for (int i = 0; i < 32; ++i) if (i == bi) l[i] = -3.0e38f; }
            float s = 0.f;
#pragma unroll
            for (int k = 0; k < 4; ++k) { gt[k] = __expf(val[k] - val[0]); s += gt[k]; }
            const float inv = __builtin_amdgcn_rcpf(s);
#pragma unroll
            for (int k = 0; k < 4; ++k) { gt[k] *= inv; ls[k] = __hip_atomic_fetch_add((LAS unsigned*)(F.MISC + MI_LCNT + ex[k]), 1u, __ATOMIC_RELAXED, __HIP_MEMORY_SCOPE_WORKGROUP); }
        }
        __syncthreads();
        if (tid < 32) { const unsigned c = F.MISC[MI_LCNT + tid]; F.MISC[MI_LBASE + tid] = c ? xb_add(cnt + 64 * tid, c) : 0u; F.MISC[MI_LCNT + tid] = 0u; }
        __syncthreads();
        if (tid < 32) { const int tok = m0 + tid;
#pragma unroll
            for (int k = 0; k < 4; ++k) { const unsigned slot = F.MISC[MI_LBASE + ex[k]] + ls[k]; TOKE[tok * 4 + k] = (unsigned)ex[k] | (slot << 8); GATES[tok * 4 + k] = gt[k]; LIST[(size_t)ex[k] * 16384 + (slot & ~255u) + ((slot & 63u) << 2) + ((slot >> 6) & 3u)] = (unsigned short)tok; }
            RSTD[tok] = RS[tid]; }
        __syncthreads();
    }
    { const int ntok = 32 * ui; const int l = lane;
      f32x4 gv[8];
#pragma unroll
      for (int j = 0; j < 4; ++j) { gv[2 * j] = *(const f32x4*)(gf + 8 * l + 512 * j) * 16.0f; gv[2 * j + 1] = *(const f32x4*)(gf + 8 * l + 512 * j + 4) * 16.0f; }
      u32x4 xn[4];
      int jt = w;
      if (jt < ntok) { const size_t tk = (size_t)32 * (blockIdx.x + (jt >> 5) * F.G) + (jt & 31);
#pragma unroll
          for (int j = 0; j < 4; ++j) xn[j] = *(const u32x4*)(XMID + tk * DM + 8 * l + 512 * j); }
      for (; jt < ntok; jt += 8) {
          const size_t tk = (size_t)32 * (blockIdx.x + (jt >> 5) * F.G) + (jt & 31); const float rs = RSA[jt]; u32x2 o[4];
#pragma unroll
          for (int j = 0; j < 4; ++j) { const u32x4 xr = xn[j]; const f32x4 a = (f32x4){bflo(xr.x), bfhi(xr.x), bflo(xr.y), bfhi(xr.y)} * rs * gv[2 * j], b = (f32x4){bflo(xr.z), bfhi(xr.z), bflo(xr.w), bfhi(xr.w)} * rs * gv[2 * j + 1];
              o[j].x = pk4_fp8(a[0], a[1], a[2], a[3]); o[j].y = pk4_fp8(b[0], b[1], b[2], b[3]); }
          const int j2 = jt + 8;
          if (j2 < ntok) { const size_t t2 = (size_t)32 * (blockIdx.x + (j2 >> 5) * F.G) + (j2 & 31);
#pragma unroll
              for (int j = 0; j < 4; ++j) xn[j] = *(const u32x4*)(XMID + t2 * DM + 8 * l + 512 * j); }
#pragma unroll
          for (int j = 0; j < 4; ++j) *(u32x2*)(HF8 + tk * DM + 8 * l + 512 * j) = o[j]; } }
}

__device__ __forceinline__ void p4b(Frame& F, const Params& p) {
    build_moe_tables(F);
    const bf16_t* XMID = (const bf16_t*)(F.ws + WS_XMID); const float* RSTD = (const float*)(F.ws + WS_RSTD); const unsigned* TOKE = (const unsigned*)(F.ws + WS_TOKE);
    const float* gf = p.in[I_NFG]; unsigned char* ABUF = F.ws + WS_ABUF;
    const int l = F.lane;
    u32x4 xn[4]; float rsn = 0.f; unsigned ten[4] = {0u, 0u, 0u, 0u};
    if (F.gw < T) { rsn = RSTD[F.gw];
#pragma unroll
        for (int k = 0; k < 4; ++k) ten[k] = TOKE[F.gw * 4 + k];
#pragma unroll
        for (int j = 0; j < 4; ++j) xn[j] = *(const u32x4*)(XMID + (size_t)F.gw * DM + 8 * l + 512 * j); }
    f32x4 gv[8];
#pragma unroll
    for (int j = 0; j < 4; ++j) { gv[2 * j] = *(const f32x4*)(gf + 8 * l + 512 * j) * 16.0f; gv[2 * j + 1] = *(const f32x4*)(gf + 8 * l + 512 * j + 4) * 16.0f; }
    for (int tok = F.gw; tok < T; tok += F.NGW) {
        const float rs = rsn; unsigned te[4]; u32x2 o[4];
#pragma unroll
        for (int k = 0; k < 4; ++k) te[k] = ten[k];
#pragma unroll
        for (int j = 0; j < 4; ++j) { const u32x4 xr = xn[j]; const f32x4 a = (f32x4){bflo(xr.x), bfhi(xr.x), bflo(xr.y), bfhi(xr.y)} * rs * gv[2 * j], b = (f32x4){bflo(xr.z), bfhi(xr.z), bflo(xr.w), bfhi(xr.w)} * rs * gv[2 * j + 1];
            o[j].x = pk4_fp8(a[0], a[1], a[2], a[3]); o[j].y = pk4_fp8(b[0], b[1], b[2], b[3]); }
        const int t2 = tok + F.NGW;
        if (t2 < T) { rsn = RSTD[t2];
#pragma unroll
            for (int k = 0; k < 4; ++k) ten[k] = TOKE[t2 * 4 + k];
#pragma unroll
            for (int j = 0; j < 4; ++j) xn[j] = *(const u32x4*)(XMID + (size_t)t2 * DM + 8 * l + 512 * j); }
#pragma unroll
        for (int k = 0; k < 4; ++k) { const size_t row = (size_t)F.MISC[MI_PBASE + (te[k] & 255u)] + (te[k] >> 8);
#pragma unroll
            for (int j = 0; j < 4; ++j) *(u32x2*)(ABUF + row * DM + 8 * l + 512 * j) = o[j]; }
    }
}

__device__ __forceinline__ void p7(Frame& F, const Params& p) {
    build_moe_tables(F);
    const bf16_t* XMID = (const bf16_t*)(F.ws + WS_XMID); const unsigned* TOKE = (const unsigned*)(F.ws + WS_TOKE); const float* GATES = (const float*)(F.ws + WS_GATES);
    const unsigned char* Y = F.ws + WS_Y; const float* gfin = p.in[I_NFINAL];
    const int l = F.lane;
    u32x4 xn[4]; u32x2 yn[4][4]; float gkn[4] = {0.f, 0.f, 0.f, 0.f};
#define P7_FETCH(tk) do { \
        _Pragma("unroll") for (int k = 0; k < 4; ++k) { const unsigned te = TOKE[(tk) * 4 + k]; gkn[k] = GATES[(tk) * 4 + k]; const size_t row = (size_t)F.MISC[MI_PBASE + (te & 255u)] + (te >> 8); \
            _Pragma("unroll") for (int j = 0; j < 4; ++j) yn[k][j] = *(const u32x2*)(Y + row * DM + 8 * l + 512 * j); } \
        _Pragma("unroll") for (int j = 0; j < 4; ++j) xn[j] = *(const u32x4*)(XMID + (size_t)(tk) * DM + 8 * l + 512 * j); } while (0)
    if (F.gw < T) P7_FETCH(F.gw);
    f32x4 g0[4], g1[4];
#pragma unroll
    for (int j = 0; j < 4; ++j) { g0[j] = *(const f32x4*)(gfin + 8 * l + 512 * j); g1[j] = *(const f32x4*)(gfin + 8 * l + 512 * j + 4); }
    for (int tok = F.gw; tok < T; tok += F.NGW) {
        f32x4 xv[8];
#pragma unroll
        for (int j = 0; j < 4; ++j) { const u32x4 xr = xn[j]; xv[2 * j] = (f32x4){bflo(xr.x), bfhi(xr.x), bflo(xr.y), bfhi(xr.y)}; xv[2 * j + 1] = (f32x4){bflo(xr.z), bfhi(xr.z), bflo(xr.w), bfhi(xr.w)}; }
#pragma unroll
        for (int k = 0; k < 4; ++k)
#pragma unroll
            for (int j = 0; j < 4; ++j) { const u32x2 y2 = yn[k][j]; const float gk = gkn[k] * (1.0f / 32.0f);
                xv[2 * j][0] += gk * fp8f(y2.x, 0); xv[2 * j][1] += gk * fp8f(y2.x, 1); xv[2 * j][2] += gk * fp8f(y2.x, 2); xv[2 * j][3] += gk * fp8f(y2.x, 3);
                xv[2 * j + 1][0] += gk * fp8f(y2.y, 0); xv[2 * j + 1][1] += gk * fp8f(y2.y, 1); xv[2 * j + 1][2] += gk * fp8f(y2.y, 2); xv[2 * j + 1][3] += gk * fp8f(y2.y, 3); }
        const int t2 = tok + F.NGW;
        if (t2 < T) P7_FETCH(t2);
        float ss = 0.f;
#pragma unroll
        for (int j = 0; j < 8; ++j) ss += (xv[j][0] * xv[j][0] + xv[j][1] * xv[j][1]) + (xv[j][2] * xv[j][2] + xv[j][3] * xv[j][3]);
        const float rs = rsqrtf_(wave_sum(ss) * (1.0f / DM) + 1e-6f);
#pragma unroll
        for (int j = 0; j < 4; ++j) { *(f32x4*)(p.out + (size_t)tok * DM + 8 * l + 512 * j) = xv[2 * j] * rs * g0[j]; *(f32x4*)(p.out + (size_t)tok * DM + 8 * l + 512 * j + 4) = xv[2 * j + 1] * rs * g1[j]; }
    }
#undef P7_FETCH
}

#ifdef PROBE_STREAM
__device__ __forceinline__ void probe_stream(Frame& F, const Params& p) {
    const f32x4* src = (const f32x4*)p.in[I_WGU]; const size_t n4 = (size_t)32 * 2048 * 4096 / 4;
    const f32x4* src2 = (const f32x4*)p.in[I_WDN]; const size_t m4 = (size_t)32 * 2048 * 2048 / 4;
    f32x4 acc = (f32x4){0.f, 0.f, 0.f, 0.f};
    for (size_t base = (size_t)F.gw * 1024; base < n4; base += (size_t)F.NGW * 1024) {
        f32x4 v[16];
#pragma unroll
        for (int i = 0; i < 16; ++i) v[i] = src[base + i * 64 + F.lane];
#pragma unroll
        for (int i = 0; i < 16; ++i) acc += v[i]; }
    for (size_t base = (size_t)F.gw * 1024; base < m4; base += (size_t)F.NGW * 1024) {
        f32x4 v[16];
#pragma unroll
        for (int i = 0; i < 16; ++i) v[i] = src2[base + i * 64 + F.lane];
#pragma unroll
        for (int i = 0; i < 16; ++i) acc += v[i]; }
    if (acc[0] + acc[1] + acc[2] + acc[3] == 12345.678f) p.out[0] = 1.0f;
}
#endif
#ifdef PROBE_ORDER
__device__ __forceinline__ void probe_order(Frame& F, const Params& p) {
    volatile LAS unsigned* flag = F.MISC + 2000;
    if (F.wave < 4) {
        const unsigned* hot = (const unsigned*)p.in[I_X] + (size_t)blockIdx.x * 16384;
        unsigned idx = F.tid & 255, sm = 0;
        for (int it = 0; it < 600; ++it) {
            const unsigned b = idx * 4 + (it & 3) * 1024;
            const unsigned v0 = hot[b & 16383], v1 = hot[(b + 4096) & 16383], v2 = hot[(b + 8192) & 16383], v3 = hot[(b + 12288) & 16383];
            sm += v0 + v1 + v2 + v3; idx = (idx + (sm & 3)) & 255;
        }
        if (sm == 0x12345678u) p.out[0] = 1.0f;
        *flag = 1u;
    } else {
#if PROBE_ORDER == 2
        const f32x4* src = (const f32x4*)p.in[I_WGU];
        f32x4 acc = (f32x4){0.f, 0.f, 0.f, 0.f}; unsigned it = 0;
        const unsigned sw = blockIdx.x * 4 + (F.wave - 4);
        while (*flag == 0u) {
            const size_t base = (((size_t)it * 1024 + sw) * 1024) & (((size_t)1 << 26) - 1);
            f32x4 v[16];
#pragma unroll
            for (int i = 0; i < 16; ++i) v[i] = src[base + i * 64 + F.lane];
#pragma unroll
            for (int i = 0; i < 16; ++i) acc += v[i];
            ++it;
        }
        if (acc[0] + acc[1] + acc[2] + acc[3] == 12345.678f) p.out[1] = 1.0f;
#endif
    }
    __syncthreads();
}
#endif
constexpr int NPHASE = 11;
constexpr int HOST_DN_EXPERTS = 24;
constexpr int CONV_EXPERTS = 28, CONV_END = CONV_EXPERTS * 8192, CONV_P1 = 2048 * 81;
#ifndef KROT5
#define KROT5 false
#endif
#ifndef KROT6
#define KROT6 false
#endif
#ifndef STAG5
#define STAG5 0
#endif
#ifndef STAG6
#define STAG6 0
#endif
__global__ void __launch_bounds__(512, 2) mk_fwd(Params p) {
    extern __shared__ __attribute__((aligned(16))) unsigned char lds_raw[];
    Frame F;
    F.lds = (LAS unsigned char*)lds_raw; F.MISC = (volatile LAS unsigned*)(F.lds + MISC_OFF);
    F.wave = __builtin_amdgcn_readfirstlane((int)threadIdx.x >> 6);
#define FRESH() do { F.lane = fresh_lane(); F.tid = F.wave * 64 + F.lane; } while (0)
    FRESH();
    F.G = gridDim.x; F.gw = (int)blockIdx.x * 8 + F.wave; F.NGW = F.G * 8; F.ws = p.ws;
    for (int u = F.tid; u < (LDS_BYTES - MISC_OFF) / 4; u += 512) F.MISC[u] = 0u;
    __syncthreads();
    const int lo = p.ph_lo, hi = p.ph_hi;
    XcdBarrier bar; bar.bar = (unsigned*)(F.ws + WS_CTL) + CW_BAR; bar.x = 0; bar.st = F.MISC;
    if (hi - lo > 1) bar = xcd_barrier_post((unsigned*)(F.ws + WS_CTL) + CW_BAR, F.MISC, F.tid == 0);
#ifndef PHASE_MASK
#define PHASE_MASK 0x7ff
#endif
#define IN(k) (((PHASE_MASK >> (k)) & 1) && lo <= (k) && (k) < hi)
#define SEAM(k) do { if (IN(k) && IN((k) + 1)) xcd_barrier(bar, F.wave == 0 && fresh_lane() == 0); } while (0)
#ifndef REPEAT_MASK
#define REPEAT_MASK 0
#endif
#define REP(k) for (int rep_ = 0; rep_ < (((REPEAT_MASK >> (k)) & 1) ? 2 : 1); ++rep_)
    LAS unsigned char* ring = F.lds;
#ifdef PROBE_STREAM
    if (IN(0)) { probe_stream(F, p); }
#endif
#ifdef PROBE_ORDER
    if (IN(0)) { probe_order(F, p); }
#endif
    if (IN(0)) { REP(11) { FRESH(); p0a(F, p); } REP(12) { FRESH(); p0b(F, p); } SEAM(0); }
    if (IN(1)) REP(1) {

#ifdef SIM_FP8
        pg8::Gemm g{F.ws + WS_MIX, F.ws + WS_WINT};
#else
        pg8::Gemm g{F.ws + WS_H, F.ws + WS_WINT};
#endif
 using GS = pg8::GShape<DM * 2, DM * 2, DM * 2, 0>; pg8::StaticOrder S; S.init(T, ZC, F.G, (int)blockIdx.x);
        pg8::EpiBf16 E{(bf16_t*)(F.ws + WS_Z), ZC, nullptr, 0};
        pg8::ConvGU cv{p.in[I_WGU], F.ws + WS_WGUT, F.gw, CONV_END, F.NGW, 0};
        pg8::gemm_phase<pg8::EpiBf16, pg8::StaticOrder, GS, true, false, 0, pg8::ConvGU>(ring, g, S, E, F.wave, cv); SEAM(1); }
    if (IN(2)) REP(2) { FRESH(); p2a(F, p); SEAM(2); }
    if (IN(3)) REP(3) { FRESH(); p2b(F, p); SEAM(3); }
    if (IN(4)) REP(4) { FRESH(); p2c(F, p); SEAM(4); }
    if (IN(5)) REP(5) {
        pg8::Gemm g{F.ws + WS_MIX, F.ws + WS_WOUTT}; using GS = pg8::GShape<DM * 2, DM * 2, DM * 2, 0>; pg8::StaticOrder S; S.init(T, DM, F.G, (int)blockIdx.x);
        pg8::EpiBf16Res E{(bf16_t*)(F.ws + WS_XMID), p.in[I_X], DM};
        pg8::ConvGU cv{p.in[I_WGU], F.ws + WS_WGUT, CONV_P1 + F.gw, CONV_END, F.NGW, 0};
        pg8::gemm_phase<pg8::EpiBf16Res, pg8::StaticOrder, GS, true, false, 0, pg8::ConvGU>(ring, g, S, E, F.wave, cv); SEAM(5); }
    if (IN(6)) { FRESH(); p4a(F, p); SEAM(6); }
    if (IN(8)) {
        FRESH(); build_moe_tables(F);
        pg8::Gemm g{F.ws + WS_HF8, F.ws + WS_WGUT}; using GS = pg8::GShape<DM, DM, DM, (size_t)4096 * DM>;
        pg8::MoeOrder S{__builtin_amdgcn_readfirstlane((int)F.MISC[MI_NMT]), 16, F.G, (int)blockIdx.x, (const LAS int*)(F.lds + MISC_OFF + 4 * MI_T2E)};
        pg8::EpiSwiGLU8 E{F.ws + WS_ACT, DM, p.in[I_BGU]};
        pg8::Gather gi{(const unsigned short*)(F.ws + WS_LIST), (const LAS unsigned*)(F.lds + MISC_OFF + 4 * MI_PBASE), (const LAS unsigned*)(F.lds + MISC_OFF + 4 * MI_CNT)};
        pg8::EpiHost<3> eh{p.in[I_WDN], F.ws + WS_WDT, F.gw, HOST_DN_EXPERTS * 4096, F.NGW, DM, 5, 0, 0, {0, 0, 0}};
        pg8::gemm_phase<pg8::EpiSwiGLU8, pg8::MoeOrder, GS, true, true, STAG5, pg8::NoConv, pg8::EpiHost<3>, KROT5, pg8::Gather>(ring, g, S, E, F.wave, pg8::NoConv(), eh, gi); SEAM(8); }
#if (REPEAT_MASK & 0x100)
    if (IN(8)) {
        FRESH(); build_moe_tables(F);
        pg8::Gemm g{F.ws + WS_ABUF, F.ws + WS_WGUT}; using GS = pg8::GShape<DM, DM, DM, (size_t)4096 * DM>;
        pg8::MoeOrder S{__builtin_amdgcn_readfirstlane((int)F.MISC[MI_NMT]), 16, F.G, (int)blockIdx.x, (const LAS int*)(F.lds + MISC_OFF + 4 * MI_T2E)};
        pg8::EpiSwiGLU8 E{F.ws + WS_Y, DM, p.in[I_BGU]};
#if P5DUP == 2
        pg8::Gemm g2{F.ws + WS_HF8, F.ws + WS_WGUT};
        pg8::Gather gi{(const unsigned short*)(F.ws + WS_LIST), (const LAS unsigned*)(F.lds + MISC_OFF + 4 * MI_PBASE), (const LAS unsigned*)(F.lds + MISC_OFF + 4 * MI_CNT)};
        pg8::gemm_phase<pg8::EpiSwiGLU8, pg8::MoeOrder, GS, true, true, STAG5, pg8::NoConv, pg8::NoHost, false, pg8::Gather>(ring, g2, S, E, F.wave, pg8::NoConv(), pg8::NoHost(), gi); SEAM(8); }
#else
        pg8::gemm_phase<pg8::EpiSwiGLU8, pg8::MoeOrder, GS, true, true, STAG5>(ring, g, S, E, F.wave); SEAM(8); }
#endif
#endif
    if (IN(9)) {
        FRESH(); build_moe_tables(F);
        pg8::Gemm g{F.ws + WS_ACT, F.ws + WS_WDT}; using GS = pg8::GShape<DM, DM, DM, (size_t)DM * DM>;
        pg8::MoeOrder S{__builtin_amdgcn_readfirstlane((int)F.MISC[MI_NMT]), 8, F.G, (int)blockIdx.x, (const LAS int*)(F.lds + MISC_OFF + 4 * MI_T2E)};
        pg8::EpiFp8S E{F.ws + WS_Y, DM, p.in[I_BDN], DM, 1.0f / 2048.0f, 32.0f};
        pg8::gemm_phase<pg8::EpiFp8S, pg8::MoeOrder, GS, true, true, STAG6, pg8::NoConv, pg8::NoHost, KROT6>(ring, g, S, E, F.wave); SEAM(9); }
#if (REPEAT_MASK & 0x200)
    if (IN(9)) {
        FRESH(); build_moe_tables(F);
#ifdef P6_PITCH
        pg8::Gemm g{F.ws + WS_ACT, F.ws + WS_WDT}; using GS = pg8::GShape<P6_PITCH, P6_PITCH, DM, (size_t)DM * DM>;
#else
        pg8::Gemm g{F.ws + WS_ACT, F.ws + WS_WDT}; using GS = pg8::GShape<DM, DM, DM, (size_t)DM * DM>;
#endif
        pg8::MoeOrder S{__builtin_amdgcn_readfirstlane((int)F.MISC[MI_NMT]), 8, F.G, (int)blockIdx.x, (const LAS int*)(F.lds + MISC_OFF + 4 * MI_T2E)};
#ifdef P6_NOSTORE
        pg8::EpiNull_<P6_NOSTORE - 1> E{};

#ifndef P6_FLP
#define P6_FLP false
#endif
        pg8::gemm_phase<pg8::EpiNull_<P6_NOSTORE - 1>, pg8::MoeOrder, GS, true, true, STAG6, pg8::NoConv, pg8::NoHost, false, pg8::NoGather, P6_FLP>(ring, g, S, E, F.wave); SEAM(9); }
#elif defined(P6_MODE)
        pg8::EpiFp8S_<P6_MODE> E{F.ws + WS_Y, DM, p.in[I_BDN], DM, 1.0f / 2048.0f, 32.0f};
        pg8::gemm_phase<pg8::EpiFp8S_<P6_MODE>, pg8::MoeOrder, GS, true, true, STAG6>(ring, g, S, E, F.wave); SEAM(9); }
#else
        pg8::EpiFp8S E{F.ws + WS_Y, DM, p.in[I_BDN], DM, 1.0f / 2048.0f, 32.0f};
        pg8::gemm_phase<pg8::EpiFp8S, pg8::MoeOrder, GS, true, true, STAG6>(ring, g, S, E, F.wave); SEAM(9); }
#endif
#endif
    if (IN(10)) REP(10) { FRESH(); p7(F, p); if (((REPEAT_MASK >> 10) & 1)) xcd_barrier(bar, F.wave == 0 && fresh_lane() == 0); }
#undef IN
#undef SEAM
}
#ifndef STAGE
#define STAGE 4
#endif
#ifndef PER_PHASE_LAUNCH
#define PER_PHASE_LAUNCH 0
#endif

#if STAGE < 4
__global__ void adapt_z_kernel(const bf16_t* Z, float* z) {
    const long idx = (long)blockIdx.x * blockDim.x + threadIdx.x; const long t = idx / ZC; const int c = (int)(idx % ZC);
    z[t * INC + (c < 3072 ? c : c + 16)] = bf2f(Z[idx]);
}
__global__ void adapt_bf16_kernel(const bf16_t* src, float* dst) { const long idx = (long)blockIdx.x * blockDim.x + threadIdx.x; dst[idx] = bf2f(src[idx]); }
#endif

static void launch_mk(Params& a, int lo, int hi, int grid, hipStream_t stream) {
#if PER_PHASE_LAUNCH
    for (int k = lo; k < hi; ++k) { a.ph_lo = k; a.ph_hi = k + 1; hipLaunchKernelGGL(mk_fwd, dim3(grid), dim3(512), LDS_BYTES, stream, a); }
#else
    a.ph_lo = lo; a.ph_hi = hi; hipLaunchKernelGGL(mk_fwd, dim3(grid), dim3(512), LDS_BYTES, stream, a);
#endif
}

extern "C" void kernel_launch(void* const* d_in, const int* in_sizes, int n_in, void* d_out, int out_size, void* d_ws, size_t ws_size, hipStream_t stream) {
    static int grid = 0;
    if (grid == 0) {
        int dev = 0, cus = 0;
        if (hipGetDevice(&dev) != hipSuccess || hipDeviceGetAttribute(&cus, hipDeviceAttributeMultiprocessorCount, dev) != hipSuccess) { grid = -1; return; }
        if (hipFuncSetAttribute((const void*)mk_fwd, hipFuncAttributeMaxDynamicSharedMemorySize, LDS_BYTES) != hipSuccess) { grid = -1; return; }
        int per_cu = 0;
        (void)hipOccupancyMaxActiveBlocksPerMultiprocessor(&per_cu, (const void*)mk_fwd, 512, LDS_BYTES);
        (void)hipGetLastError();
        grid = cus < 256 ? cus : 256;
        if (per_cu < 1) fprintf(stderr, "kernel_launch: occupancy query reports %d\n", per_cu);
    }
    if (grid < 0) return;
    (void)hipMemsetAsync((char*)d_ws + WS_CTL, 0, CTL_ZERO_BYTES, stream);
    Params a{};
    for (int i = 0; i < 22; ++i) a.in[i] = (const float*)d_in[i];
    a.out = (float*)d_out; a.ws = (unsigned char*)d_ws;
#if STAGE >= 4
    launch_mk(a, 0, NPHASE, grid, stream);
#else
    const float* x = a.in[I_X];
    char* ws = (char*)d_ws + WS_ABUF; size_t off = 0;
    auto alloc = [&](size_t bytes) { void* p = ws + off; off += (bytes + 255) & ~(size_t)255; return p; };
    int* counts = (int*)alloc(256);
    float* z = (float*)alloc((size_t)T * INC * 4);
    float* ogla = (float*)alloc((size_t)T * 1024 * 4);
    float* xc = (float*)alloc((size_t)T * 1024 * 4);
    float* za = (float*)alloc((size_t)T * 1024 * 4);
    float* zi = (float*)alloc((size_t)T * 1024 * 4);
    float* mix = (float*)alloc((size_t)T * DM * 4);
    float* xmid = (float*)alloc((size_t)T * DM * 4);
    float* hf = (float*)alloc((size_t)T * DM * 4);
    float* logits = (float*)alloc((size_t)T * 32 * 4);
    float* gates = (float*)alloc((size_t)T * 4 * 4);
    int* list = (int*)alloc((size_t)NEXP * T * 4);
    float* act = (float*)alloc((size_t)T * 4 * DM * 4);
    float* y = (float*)alloc((size_t)T * 4 * DM * 4);
    (void)hipMemsetAsync(counts, 0, 256, stream);
#if STAGE == 1
    launch_mk(a, 0, 2, grid, stream);
    adapt_z_kernel<<<(unsigned)((size_t)T * ZC / 256), 256, 0, stream>>>((const bf16_t*)((char*)d_ws + WS_Z), z);
    gla_naive_kernel<<<64, 256, 0, stream>>>(z, (const float*)((char*)d_ws + WS_LG), ogla);
    gla_out_kernel<<<T, 256, 0, stream>>>(ogla, z, a.in[I_GNG], mix);
    lru_conv_kernel<<<T * 1024 / 256, 256, 0, stream>>>(z, a.in[I_CW], a.in[I_CB], xc);
    for (int h = 0; h < 4; ++h) {
        GemmArgs g{}; g.A = xc + h * 256; g.lda = 1024; g.ldb = 256; g.ldc = 1024; g.M = T; g.N = 256; g.K = 256; g.a_div = 1;
        g.B = a.in[I_WA] + (size_t)h * 65536; g.C = za + h * 256;
        sgemm_kernel<0><<<dim3(2, T / 128, 1), 256, 0, stream>>>(g);
        g.B = a.in[I_WI] + (size_t)h * 65536; g.C = zi + h * 256;
        sgemm_kernel<0><<<dim3(2, T / 128, 1), 256, 0, stream>>>(g);
    }
    lru_gate_kernel<<<T * 1024 / 256, 256, 0, stream>>>(xc, za, zi, a.in[I_BA], a.in[I_BI], a.in[I_AP]);
    lru_scan_kernel<<<2048 / 64, 64, 0, stream>>>(za, zi, z, mix);
#endif
#if STAGE == 2
    launch_mk(a, 0, 5, grid, stream);
    adapt_bf16_kernel<<<(unsigned)((size_t)T * DM / 256), 256, 0, stream>>>((const bf16_t*)((char*)d_ws + WS_MIX), mix);
#endif
#if STAGE <= 2
    { GemmArgs g{}; g.A = mix; g.lda = DM; g.B = a.in[I_WOUT]; g.ldb = DM; g.C = xmid; g.ldc = DM; g.M = T; g.N = DM; g.K = DM; g.a_div = 1; g.resid = x; g.ldr = DM;
      sgemm_kernel<1><<<dim3(DM / 128, T / 128, 1), 256, 0, stream>>>(g); }
#else
    launch_mk(a, 0, 6, grid, stream);
    xmid = (float*)((char*)d_ws + WS_XMID);
#endif
    rmsnorm_kernel<<<T, 256, 0, stream>>>(xmid, a.in[I_NFG], hf);
    { GemmArgs g{}; g.A = hf; g.lda = DM; g.B = a.in[I_WR]; g.ldb = 32; g.C = logits; g.ldc = 32; g.M = T; g.N = 32; g.K = DM; g.a_div = 1; g.bias = a.in[I_BR];
      sgemm_kernel<0><<<dim3(1, T / 128, 1), 256, 0, stream>>>(g); }
    route_kernel<<<T / 256, 256, 0, stream>>>(logits, counts, list, gates);
    { GemmArgs g{}; g.A = hf; g.lda = DM; g.B = a.in[I_WGU]; g.ldb = 4096; g.C = act; g.ldc = DM; g.M = 0; g.N = 4096; g.K = DM; g.a_div = 4; g.bias = a.in[I_BGU];
      g.rowlist = list; g.count = counts; g.strideB_e = (long)DM * 4096; g.strideBias_e = 4096; g.list_stride = T;
      sgemm_kernel<2><<<dim3(2048 / 64, T / 128, NEXP), 256, 0, stream>>>(g); }
    { GemmArgs g{}; g.A = act; g.lda = DM; g.B = a.in[I_WDN]; g.ldb = DM; g.C = y; g.ldc = DM; g.M = 0; g.N = DM; g.K = DM; g.a_div = 1; g.bias = a.in[I_BDN];
      g.rowlist = list; g.count = counts; g.strideB_e = (long)DM * DM; g.strideBias_e = DM; g.list_stride = T;
      sgemm_kernel<0><<<dim3(DM / 128, T / 128, NEXP), 256, 0, stream>>>(g); }
    final_kernel<<<T, 256, 0, stream>>>(xmid, y, gates, a.in[I_NFINAL], (float*)d_out);
#endif
}
```

```cpp
#define STAGE 4
#define PER_PHASE_LAUNCH 0
#define REPEAT_MASK 0
#include <hip/hip_runtime.h>
#include <stdint.h>
#include <stdio.h>

#define GAS __attribute__((address_space(1)))
#define LAS __attribute__((address_space(3)))
typedef unsigned short bf16_t;
typedef short bf16x8 __attribute__((ext_vector_type(8)));
typedef short bf16x4 __attribute__((ext_vector_type(4)));
typedef float f32x4 __attribute__((ext_vector_type(4)));
typedef float f32x2 __attribute__((ext_vector_type(2)));
typedef float f32x16 __attribute__((ext_vector_type(16)));
typedef unsigned u32x4 __attribute__((ext_vector_type(4)));
typedef unsigned u32x2 __attribute__((ext_vector_type(2)));
typedef int i32x8 __attribute__((ext_vector_type(8)));
typedef int i32x4 __attribute__((ext_vector_type(4)));
typedef int i32x32 __attribute__((ext_vector_type(32)));

constexpr int T = 16384, SEQL = 8192, DM = 2048, INC = 5136, ZC = 5120, NEXP = 32;
constexpr int ZQ = 0, ZK = 512, ZV = 1024, ZR = 2048, ZLX = 3072, ZLG = 4096;
constexpr int MPAD_MAX = 65536 + NEXP * 256;
constexpr int NCHUNK = 256;

constexpr size_t MiB = 1u << 20;
constexpr size_t WS_CTL = 0, CTL_ZERO_BYTES = 128 * 1024;
constexpr size_t WS_WINT = 1 * MiB;
constexpr size_t WS_WOUTT = WS_WINT + 20 * MiB;
constexpr size_t WS_WGUT = WS_WOUTT + 8 * MiB;
constexpr size_t WS_WDT = WS_WGUT + 512 * MiB;
constexpr size_t WS_WAT = WS_WDT + 256 * MiB;
constexpr size_t WS_WIT = WS_WAT + 512 * 1024;
constexpr size_t WS_WRT = WS_WIT + 512 * 1024;
constexpr size_t WS_WGLT = WS_WRT + 512 * 1024;
constexpr size_t WS_H = WS_WRT + 1 * MiB;
constexpr size_t WS_LG = WS_H + 64 * MiB;
constexpr size_t WS_Z = WS_LG + 32 * MiB;
constexpr size_t WS_AN = WS_Z + 160 * MiB;
constexpr size_t WS_DN = WS_AN + 128 * MiB;
constexpr size_t WS_SP = WS_DN + 1 * MiB;
constexpr size_t WS_AUA = WS_SP + 64 * MiB;
constexpr size_t WS_AUU = WS_AUA + 64 * MiB;
constexpr size_t WS_SUMA = WS_AUU + 64 * MiB;
constexpr size_t WS_SUMH = WS_SUMA + 1 * MiB;
constexpr size_t WS_MIX = WS_SUMH + 1 * MiB;
constexpr size_t WS_XMID = WS_MIX + 64 * MiB;
constexpr size_t WS_RSTD = WS_XMID + 128 * MiB;
constexpr size_t WS_TOKE = WS_RSTD + 1 * MiB;
constexpr size_t WS_GATES = WS_TOKE + 1 * MiB;
constexpr size_t WS_ABUF = WS_GATES + 1 * MiB;
constexpr size_t WS_HF8 = WS_ABUF, WS_LIST = WS_ABUF + 64 * MiB;
constexpr size_t WS_ACT = WS_ABUF + 288 * MiB;
constexpr size_t WS_Y = WS_ACT + 288 * MiB;
constexpr size_t WS_END = WS_Y + 288 * MiB;
constexpr int CW_BAR = 4096;
constexpr int CW_CNT = 16384;

constexpr int RING_BYTES = 131072;
constexpr int SCR_BYTES = 135168;
constexpr int MISC_OFF = SCR_BYTES;
constexpr int LDS_BYTES = 147456;
constexpr int MI_PBASE = 16, MI_NMT = 48, MI_LCNT = 64, MI_LBASE = 96, MI_T2E = 128, MI_CNT = 480;

#define LDS_WAIT() asm volatile("s_waitcnt lgkmcnt(0)" ::: "memory")
#define VM_WAIT() asm volatile("s_waitcnt vmcnt(0)" ::: "memory")

typedef __bf16 bf16v2_t __attribute__((ext_vector_type(2)));
__device__ __forceinline__ unsigned pk2(float lo, float hi) { const f32x2 v = {lo, hi}; return __builtin_bit_cast(unsigned, __builtin_convertvector(v, bf16v2_t)); }
#ifdef SIM_FP8
__device__ __forceinline__ float q8_(float x, float sc) { int p = 0; p = __builtin_amdgcn_cvt_pk_fp8_f32(__builtin_amdgcn_fmed3f(x * sc, -448.0f, 448.0f), 0.0f, p, false); return __builtin_amdgcn_cvt_f32_fp8(p, 0) * (1.0f / sc); }
#define PK2A(a, b) pk2(q8_(a, 16.0f), q8_(b, 16.0f))
#define PK2W(a, b) pk2(q8_(a, 512.0f), q8_(b, 512.0f))
#else
#define PK2A(a, b) pk2(a, b)
#define PK2W(a, b) pk2(a, b)
#endif
__device__ __forceinline__ unsigned f2bf(float f) { return pk2(f, 0.0f) & 0xffffu; }
__device__ __forceinline__ float bf2f(unsigned short b) { return __builtin_bit_cast(float, (unsigned)b << 16); }
__device__ __forceinline__ float bflo(unsigned w) { return __builtin_bit_cast(float, w << 16); }
__device__ __forceinline__ float bfhi(unsigned w) { return __builtin_bit_cast(float, w & 0xffff0000u); }
__device__ __forceinline__ float clamp448(float x) { return __builtin_amdgcn_fmed3f(x, -448.0f, 448.0f); }
__device__ __forceinline__ unsigned pk4_fp8(float a, float b, float c, float d) {
    int p = 0; p = __builtin_amdgcn_cvt_pk_fp8_f32(clamp448(a), clamp448(b), p, false); p = __builtin_amdgcn_cvt_pk_fp8_f32(clamp448(c), clamp448(d), p, true); return (unsigned)p; }
__device__ __forceinline__ unsigned pk4_fp8_nc(float a, float b, float c, float d) {
    int p = 0; p = __builtin_amdgcn_cvt_pk_fp8_f32(a, b, p, false); p = __builtin_amdgcn_cvt_pk_fp8_f32(c, d, p, true); return (unsigned)p; }
__device__ __forceinline__ float fp8f(unsigned w, int b) { return b == 0 ? __builtin_amdgcn_cvt_f32_fp8((int)w, 0) : b == 1 ? __builtin_amdgcn_cvt_f32_fp8((int)w, 1) : b == 2 ? __builtin_amdgcn_cvt_f32_fp8((int)w, 2) : __builtin_amdgcn_cvt_f32_fp8((int)w, 3); }
__device__ __forceinline__ float wave_sum(float v) {
#pragma unroll
    for (int o = 1; o < 64; o <<= 1) v += __shfl_xor(v, o);
    return v;
}
__device__ __forceinline__ int fresh_lane() { int l; asm volatile("v_mbcnt_lo_u32_b32 %0, -1, 0\n\tv_mbcnt_hi_u32_b32 %0, -1, %0" : "=v"(l)); return l; }
__device__ __forceinline__ float sigmoidf_(float x) { return __builtin_amdgcn_rcpf(1.0f + __expf(-x)); }
__device__ __forceinline__ float rsqrtf_(float x) { return __builtin_amdgcn_rsqf(x); }

#define XB_TMO      128
#define XB_XCNT(j)  (256  + 64 * (j))
#define XB_XSUB(j)  (1280 + 64 * (j))
#define XB_XGEN(j)  (2304 + 64 * (j))
#define XB_TOP      3328
#define XB_TOPGEN   3392
#define XCD_BAR_WORDS 3456
#define XB_SPIN_CAP (1u << 18)

__device__ __forceinline__ unsigned xb_ld(unsigned* p)              { return __hip_atomic_load(p, __ATOMIC_RELAXED, __HIP_MEMORY_SCOPE_AGENT); }
__device__ __forceinline__ unsigned xb_add(unsigned* p, unsigned v) { return __hip_atomic_fetch_add(p, v, __ATOMIC_RELAXED, __HIP_MEMORY_SCOPE_AGENT); }
__device__ __forceinline__ unsigned xb_xcc_id() { return (unsigned)__builtin_amdgcn_s_getreg((3 << 11) | 20) & 0xFu; }
#define XB_SPIN(cond, bar) do { unsigned _sp = 0; while (cond) { __builtin_amdgcn_s_sleep(1); \
    if ((++_sp & 255u) == 0u) { if (xb_ld(&(bar)[XB_TMO])) break; if (_sp > XB_SPIN_CAP) { atomicAdd(&(bar)[XB_TMO], 1u); break; } } } } while (0)

struct XcdBarrier { unsigned* bar; unsigned x; volatile LAS unsigned* st; };

__device__ __forceinline__ XcdBarrier xcd_barrier_post(unsigned* bar, volatile LAS unsigned* st, bool t0) {
    XcdBarrier b; b.bar = bar; b.x = xb_xcc_id(); b.st = st;
    if (t0) (void)xb_add(&bar[XB_XCNT(b.x)], 1u);
    return b;
}
__device__ __forceinline__ void xcd_barrier_complete(unsigned* bar, unsigned x, unsigned& nloc, unsigned& nx) {
    const unsigned G = gridDim.x * gridDim.y * gridDim.z;
    unsigned sum, cnt, mine, sp = 0u;
    for (;;) {
        sum = 0u; cnt = 0u; mine = 0u;
#pragma unroll
        for (unsigned j = 0; j < 16; ++j) { const unsigned c = xb_ld(&bar[XB_XCNT(j)]); sum += c; cnt += (c > 0u) ? 1u : 0u; mine = (j == x) ? c : mine; }
        if (sum == G) break;
        __builtin_amdgcn_s_sleep(1);
        if ((++sp & 255u) == 0u) { if (xb_ld(&bar[XB_TMO])) break; if (sp > XB_SPIN_CAP) { atomicAdd(&bar[XB_TMO], 1u); break; } }
    }
    nloc = mine > 0u ? mine : 1u; nx = cnt > 0u ? cnt : 1u;
}
__device__ __forceinline__ void xcd_barrier(const XcdBarrier& b, bool t0) {
    asm volatile("s_waitcnt vmcnt(0)" ::: "memory");
    __syncthreads();
    if (t0) {
        unsigned* bar = b.bar;
        __builtin_amdgcn_s_waitcnt(0);
        unsigned nloc = b.st[0], nx = b.st[1];
        if (nloc == 0u) { xcd_barrier_complete(bar, b.x, nloc, nx); b.st[0] = nloc; b.st[1] = nx; }
        const unsigned old = xb_add(&bar[XB_XSUB(b.x)], 1u);
        const unsigned gen = old / nloc;
        if (old + 1u == (gen + 1u) * nloc) {
            __builtin_amdgcn_fence(__ATOMIC_RELEASE, "agent");
            asm volatile("s_waitcnt vmcnt(0)" ::: "memory");
            const unsigned og = xb_add(&bar[XB_TOP], 1u);
            const unsigned tg = og / nx;
            if (og + 1u == (tg + 1u) * nx) xb_add(&bar[XB_TOPGEN], 1u);
            else XB_SPIN(xb_ld(&bar[XB_TOPGEN]) == tg, bar);
            __builtin_amdgcn_fence(__ATOMIC_ACQUIRE, "agent");
            xb_add(&bar[XB_XGEN(b.x)], 1u);
            asm volatile("s_waitcnt vmcnt(0)" ::: "memory");
        } else {
            XB_SPIN(xb_ld(&bar[XB_XGEN(b.x)]) == gen, bar);
            __builtin_amdgcn_fence(__ATOMIC_ACQUIRE, "agent");
            asm volatile("s_waitcnt vmcnt(0)" ::: "memory");
        }
    }
    __syncthreads();
}

namespace pg8 {
#ifndef PG8_WGM
#define PG8_WGM 4
#endif
constexpr int BM = 256, BK = 64, HALF = 128, HTB = HALF * BK * 2, STAGE_BYTES = 8 * HTB, NXCD = 8, WGM = PG8_WGM;
__host__ __device__ __forceinline__ int lds_byte(int r, int c) { const int st = (r >> 4) * 2 + (c >> 5), rr = r & 15, cc = c & 31, ob = rr * 64 + cc * 2; return st * 1024 + (ob ^ (((ob >> 9) & 1) << 5)); }
__host__ __device__ __forceinline__ void stage_rc(int b, int& R, int& C) { const int st = b / 1024, sb = b % 1024, swz = sb ^ (((sb >> 9) & 1) << 5); R = (st >> 1) * 16 + swz / 64; C = (st & 1) * 32 + (swz % 64) / 2; }
__host__ __device__ __forceinline__ int perm32(int rho) { const int n = rho >> 4, i = rho & 15; return 8 * (i >> 2) + 4 * n + (i & 3); }

struct Unit { int pm, pn, e; };
struct Gemm { const void* A; const void* Bt; };
template <int LDA_, int LDB_, int KB_, size_t SB_> struct GShape { static constexpr int LDA = LDA_, LDB = LDB_, KB = KB_; static constexpr size_t SB = SB_; };

__device__ __forceinline__ bool order_map(int L, int nM, int nN, int& pm, int& pn) {
    const int nwg = nM * nN; if (L >= nwg) return false;
    int wgid = L; { const int q = nwg / NXCD, r = nwg % NXCD, xcd = wgid % NXCD, off = wgid / NXCD; wgid = (xcd < r ? xcd * (q + 1) : r * (q + 1) + (xcd - r) * q) + off; }
    const int nig = WGM * nN, gid = wgid / nig, fm = gid * WGM, gsz = (nM - fm) < WGM ? (nM - fm) : WGM;
    pm = fm + ((wgid % nig) % gsz); pn = (wgid % nig) / gsz; return true;
}
struct StaticOrder {
    int nM, nN, G, c;
    __device__ void init(int M, int N, int G_, int c_) { nM = M / BM; nN = N / BM; G = G_; c = c_; }
    __device__ __forceinline__ bool next(int i, Unit& u) const { u.e = 0; return order_map(i * G + c, nM, nN, u.pm, u.pn); }
};
struct MoeOrder {
    int nM, nN, G, c; const LAS int* t2e;
    __device__ __forceinline__ bool next(int i, Unit& u) const { if (!order_map(i * G + c, nM, nN, u.pm, u.pn)) return false; u.e = __builtin_amdgcn_readfirstlane(t2e[u.pm]); return true; }
};

__device__ __forceinline__ unsigned cvt_pk_bf16(float lo, float hi) { return pk2(lo, hi); }

struct EpiBf16 {
    static constexpr bool PERM = true; static constexpr int NSTORES = 16;
    bf16_t* O; int ldc; const float* bias; int bias_stride;
    __device__ __forceinline__ void operator()(const f32x4 (&acc)[2][2][4][2], const Unit& u, int wr, int wc, int fr, int fq) const {
        const int row0 = u.pm * BM + wr * 64 + fr; const int col0 = u.pn * BM + wc * 32 + 8 * fq;
        f32x4 bv[2][2];
#pragma unroll
        for (int bj = 0; bj < 2; ++bj)
#pragma unroll
            for (int n = 0; n < 2; ++n) bv[bj][n] = bias ? *(const f32x4*)(bias + (size_t)u.e * bias_stride + col0 + bj * HALF + 4 * n) : (f32x4){0.f, 0.f, 0.f, 0.f};
#pragma unroll
        for (int ai = 0; ai < 2; ++ai)
#pragma unroll
            for (int m = 0; m < 4; ++m) { bf16_t* rowp = O + (size_t)(row0 + ai * HALF + m * 16) * ldc + col0;
#pragma unroll
                for (int bj = 0; bj < 2; ++bj) { const f32x4 v0 = acc[ai][bj][m][0] + bv[bj][0], v1 = acc[ai][bj][m][1] + bv[bj][1];
                    u32x4 w; w.x = cvt_pk_bf16(v0[0], v0[1]); w.y = cvt_pk_bf16(v0[2], v0[3]); w.z = cvt_pk_bf16(v1[0], v1[1]); w.w = cvt_pk_bf16(v1[2], v1[3]);
                    *(u32x4*)(rowp + bj * HALF) = w; } }
    }
};
struct EpiF32Res {
    static constexpr bool PERM = false;
    float* C; const float* resid; int ldc;
    __device__ __forceinline__ void operator()(const f32x4 (&acc)[2][2][4][2], const Unit& u, int wr, int wc, int fr, int fq) const {
        const int row0 = u.pm * BM + wr * 64 + fr, col0 = u.pn * BM + wc * 32 + 4 * fq;
#pragma unroll
        for (int ai = 0; ai < 2; ++ai)
#pragma unroll
            for (int m = 0; m < 4; ++m) { const size_t off = (size_t)(row0 + ai * HALF + m * 16) * ldc + col0;
#pragma unroll
                for (int bj = 0; bj < 2; ++bj)
#pragma unroll
                    for (int n = 0; n < 2; ++n) { const f32x4 r = *(const f32x4*)(resid + off + bj * HALF + n * 16); *(f32x4*)(C + off + bj * HALF + n * 16) = acc[ai][bj][m][n] + r; } }
    }
};
struct EpiSwiGLU {
    static constexpr bool PERM = true;
    bf16_t* O; int ldc; const float* bias;
    __device__ __forceinline__ void operator()(const f32x4 (&acc)[2][2][4][2], const Unit& u, int wr, int wc, int fr, int fq) const {
        const int row0 = u.pm * BM + wr * 64 + fr; const int j0 = u.pn * HALF + wc * 32 + 8 * fq;
        const float* be = bias + (size_t)u.e * 4096;
        f32x4 bg[2], bu[2];
#pragma unroll
        for (int n = 0; n < 2; ++n) { bg[n] = *(const f32x4*)(be + j0 + 4 * n); bu[n] = *(const f32x4*)(be + 2048 + j0 + 4 * n); }
#pragma unroll
        for (int ai = 0; ai < 2; ++ai)
#pragma unroll
            for (int m = 0; m < 4; ++m) { bf16_t* rowp = O + (size_t)(row0 + ai * HALF + m * 16) * ldc + j0;
                float o[8];
#pragma unroll
                for (int n = 0; n < 2; ++n) { const f32x4 g = acc[ai][0][m][n] + bg[n], up = acc[ai][1][m][n] + bu[n];
#pragma unroll
                    for (int q = 0; q < 4; ++q) { const float gt = fminf(g[q], 7.0f), ut = fminf(fmaxf(up[q], -7.0f), 7.0f);
                        const float glu = gt * __builtin_amdgcn_rcpf(1.0f + __expf(-1.702f * gt)); o[4 * n + q] = (ut + 1.0f) * glu; } }
                u32x4 w; w.x = cvt_pk_bf16(o[0], o[1]); w.y = cvt_pk_bf16(o[2], o[3]); w.z = cvt_pk_bf16(o[4], o[5]); w.w = cvt_pk_bf16(o[6], o[7]);
                *(u32x4*)rowp = w; }
    }
};

struct EpiBf16Res {
    static constexpr bool PERM = true; static constexpr int NSTORES = 16;
    bf16_t* O; const float* resid; int ldc;
    __device__ __forceinline__ void operator()(const f32x4 (&acc)[2][2][4][2], const Unit& u, int wr, int wc, int fr, int fq) const {
        const int row0 = u.pm * BM + wr * 64 + fr; const int col0 = u.pn * BM + wc * 32 + 8 * fq;
#pragma unroll
        for (int ai = 0; ai < 2; ++ai)
#pragma unroll
            for (int m = 0; m < 4; ++m) { const size_t off = (size_t)(row0 + ai * HALF + m * 16) * ldc + col0;
#pragma unroll
                for (int bj = 0; bj < 2; ++bj) { const f32x4 r0 = *(const f32x4*)(resid + off + bj * HALF), r1 = *(const f32x4*)(resid + off + bj * HALF + 4);
                    const f32x4 v0 = acc[ai][bj][m][0] + r0, v1 = acc[ai][bj][m][1] + r1;
                    u32x4 w; w.x = cvt_pk_bf16(v0[0], v0[1]); w.y = cvt_pk_bf16(v0[2], v0[3]); w.z = cvt_pk_bf16(v1[0], v1[1]); w.w = cvt_pk_bf16(v1[2], v1[3]);
                    *(u32x4*)(O + off + bj * HALF) = w; } }
    }
};
#ifndef USE_BIAS_LDS
#define USE_BIAS_LDS 0
#endif
template <int MODE = 0> struct EpiFp8S_ {
    static constexpr int NSTORES = 16;
    static constexpr bool PERM = true, BIAS_LDS = (USE_BIAS_LDS != 0);
    unsigned char* O; int ldc; const float* bias; int bias_stride; float scale, oscale;
    __device__ __forceinline__ const char* bias_base(const Unit& u) const { return (const char*)(bias + (size_t)u.e * bias_stride + u.pn * BM); }
    __device__ static __forceinline__ unsigned bias_voff(int i) { return (unsigned)i * 4u; }
    __device__ __forceinline__ void operator()(const f32x4 (&acc)[2][2][4][2], const Unit& u, int wr, int wc, int fr, int fq, const LAS float* bl) const {
        const int row0 = u.pm * BM + wr * 64 + fr; const int col0 = u.pn * BM + wc * 32 + 8 * fq;
        f32x4 bv[2][2];
#pragma unroll
        for (int bj = 0; bj < 2; ++bj)
#pragma unroll
            for (int n = 0; n < 2; ++n) { if constexpr (MODE == 2) bv[bj][n] = (f32x4){oscale, oscale, oscale, oscale}; else if constexpr (BIAS_LDS) bv[bj][n] = *(const LAS f32x4*)(bl + wc * 32 + 8 * fq + bj * HALF + 4 * n) * oscale; else bv[bj][n] = *(const f32x4*)(bias + (size_t)u.e * bias_stride + col0 + bj * HALF + 4 * n) * oscale; }
        const float sc = scale * oscale;
#pragma unroll
        for (int ai = 0; ai < 2; ++ai)
#pragma unroll
            for (int m = 0; m < 4; ++m) { unsigned char* rowp = O + (size_t)(row0 + ai * HALF + m * 16) * ldc + col0;
#pragma unroll
                for (int bj = 0; bj < 2; ++bj) { const f32x4 v0 = acc[ai][bj][m][0] * sc + bv[bj][0], v1 = acc[ai][bj][m][1] * sc + bv[bj][1];
                    u32x2 w; w.x = pk4_fp8(v0[0], v0[1], v0[2], v0[3]); w.y = pk4_fp8(v1[0], v1[1], v1[2], v1[3]);
                    if constexpr (MODE == 1) { if (u.pm < 0) *(u32x2*)(rowp + bj * HALF) = w; else asm volatile("" :: "v"(w)); } else *(u32x2*)(rowp + bj * HALF) = w; } }
    }
};
using EpiFp8S = EpiFp8S_<0>;
struct EpiSwiGLU8 {
    static constexpr bool PERM = true, BIAS_LDS = (USE_BIAS_LDS != 0); static constexpr int NSTORES = 8;
    unsigned char* O; int ldc; const float* bias;
    struct Bias { f32x4 bg[2], bu[2];
        __device__ __forceinline__ void pin() { asm volatile("" : "+v"(bg[0]), "+v"(bg[1]), "+v"(bu[0]), "+v"(bu[1])); } };
    __device__ __forceinline__ const char* bias_base(const Unit& u) const { return (const char*)(bias + (size_t)u.e * 4096 + u.pn * HALF); }
    __device__ static __forceinline__ unsigned bias_voff(int i) { return (unsigned)(i < 128 ? i : 2048 - 128 + i) * 4u; }
    __device__ __forceinline__ void load_bias(const Unit& u, int wc, int fq, Bias& b, const LAS float* bl) const {
        const int j0 = wc * 32 + 8 * fq;
        if constexpr (BIAS_LDS) {
#pragma unroll
            for (int n = 0; n < 2; ++n) { b.bg[n] = *(const LAS f32x4*)(bl + j0 + 4 * n); b.bu[n] = *(const LAS f32x4*)(bl + 128 + j0 + 4 * n); }
        } else { const float* be = bias + (size_t)u.e * 4096 + u.pn * HALF + j0;
#pragma unroll
            for (int n = 0; n < 2; ++n) { b.bg[n] = *(const f32x4*)(be + 4 * n); b.bu[n] = *(const f32x4*)(be + 2048 + 4 * n); } } }
    __device__ __forceinline__ void operator()(const f32x4 (&acc)[2][2][4][2], const Unit& u, int wr, int wc, int fr, int fq, const LAS float* bl) const { Bias b; load_bias(u, wc, fq, b, bl); apply(acc, u, wr, wc, fr, fq, b); }
    __device__ __forceinline__ void apply(const f32x4 (&acc)[2][2][4][2], const Unit& u, int wr, int wc, int fr, int fq, const Bias& b) const {
        const int row0 = u.pm * BM + wr * 64 + fr; const int j0 = u.pn * HALF + wc * 32 + 8 * fq;
        const f32x4 (&bg)[2] = b.bg; const f32x4 (&bu)[2] = b.bu;
#pragma unroll
        for (int ai = 0; ai < 2; ++ai)
#pragma unroll
            for (int m = 0; m < 4; ++m) { unsigned char* rowp = O + (size_t)(row0 + ai * HALF + m * 16) * ldc + j0;
                float o[8];
#pragma unroll
                for (int n = 0; n < 2; ++n) { const f32x4 g = acc[ai][0][m][n] * (1.0f / 8192.0f) + bg[n], up = acc[ai][1][m][n] * (1.0f / 8192.0f) + bu[n];
#pragma unroll
                    for (int q = 0; q < 4; ++q) { const float gt = fminf(g[q], 7.0f), ut = __builtin_amdgcn_fmed3f(up[q], -7.0f, 7.0f);
                        const float glu = gt * __builtin_amdgcn_rcpf(1.0f + __builtin_amdgcn_exp2f(-2.4554669595930156f * gt)); o[4 * n + q] = __builtin_fmaf(ut, 4.0f, 4.0f) * glu; } }
                u32x2 w; w.x = pk4_fp8_nc(o[0], o[1], o[2], o[3]); w.y = pk4_fp8_nc(o[4], o[5], o[6], o[7]);
                *(u32x2*)rowp = w; }
    }
};
template <int ALL> struct EpiNull_ { static constexpr bool PERM = true;
    __device__ __forceinline__ void operator()(const f32x4 (&acc)[2][2][4][2], const Unit& u, int wr, int wc, int fr, int fq) const {
        if constexpr (ALL == 0) asm volatile("" :: "v"(acc[0][0][0][0]), "v"(acc[1][1][3][1]));
        else {
#pragma unroll
        for (int a = 0; a < 2; ++a)
#pragma unroll
            for (int b = 0; b < 2; ++b) asm volatile("" :: "v"(acc[a][b][0][0]), "v"(acc[a][b][0][1]), "v"(acc[a][b][1][0]), "v"(acc[a][b][1][1]), "v"(acc[a][b][2][0]), "v"(acc[a][b][2][1]), "v"(acc[a][b][3][0]), "v"(acc[a][b][3][1])); } } };
using EpiNull = EpiNull_<1>;
struct EpiBf16S {
    static constexpr bool PERM = true;
    bf16_t* O; int ldc; const float* bias; int bias_stride; float scale;
    __device__ __forceinline__ void operator()(const f32x4 (&acc)[2][2][4][2], const Unit& u, int wr, int wc, int fr, int fq) const {
        const int row0 = u.pm * BM + wr * 64 + fr; const int col0 = u.pn * BM + wc * 32 + 8 * fq;
        f32x4 bv[2][2];
#pragma unroll
        for (int bj = 0; bj < 2; ++bj)
#pragma unroll
            for (int n = 0; n < 2; ++n) bv[bj][n] = *(const f32x4*)(bias + (size_t)u.e * bias_stride + col0 + bj * HALF + 4 * n);
#pragma unroll
        for (int ai = 0; ai < 2; ++ai)
#pragma unroll
            for (int m = 0; m < 4; ++m) { bf16_t* rowp = O + (size_t)(row0 + ai * HALF + m * 16) * ldc + col0;
#pragma unroll
                for (int bj = 0; bj < 2; ++bj) { const f32x4 v0 = acc[ai][bj][m][0] * scale + bv[bj][0], v1 = acc[ai][bj][m][1] * scale + bv[bj][1];
                    u32x4 w; w.x = cvt_pk_bf16(v0[0], v0[1]); w.y = cvt_pk_bf16(v0[2], v0[3]); w.z = cvt_pk_bf16(v1[0], v1[1]); w.w = cvt_pk_bf16(v1[2], v1[3]);
                    *(u32x4*)(rowp + bj * HALF) = w; } }
    }
};

__device__ __forceinline__ i32x8 pg8_get8(const i32x32& v, int idx) { i32x8 r;
#pragma unroll
    for (int j = 0; j < 8; ++j) r[j] = v[8 * idx + j];
    return r; }
__device__ __forceinline__ i32x4 pg8_get4(const i32x32& v, int idx) { i32x4 r;
#pragma unroll
    for (int j = 0; j < 4; ++j) r[j] = v[4 * idx + j];
    return r; }
struct NoHost { static constexpr bool ON = false; static constexpr int N = 0; };
template <int N_> struct EpiHost {
    static constexpr bool ON = true; static constexpr int N = N_;
    const float* W; unsigned char* WT; int cid, cend, cstride; int ldw, cbs, gu, e0; int pend[N_];
    __device__ __forceinline__ void issue(unsigned (&x)[16 * N_], int lane) {
        const unsigned vo = (unsigned)lane * 4u; const size_t rowb = (size_t)ldw * 4;
#pragma unroll
        for (int j = 0; j < N_; ++j) { const int id = cid < cend ? cid : cend - 1; pend[j] = id; cid += cstride;
            const int cb = id & ((1 << cbs) - 1), kb = (id >> cbs) & 127, e = e0 + (id >> (cbs + 7));
            const char* rb = (const char*)(W + (size_t)e * DM * ldw + (size_t)(16 * kb) * ldw + 64 * cb);
#pragma unroll
            for (int i = 0; i < 16; ++i) asm volatile("s_nop 4\n\tglobal_load_dword %0, %1, %2" : "=v"(x[16 * j + i]) : "v"(vo), "s"(rb + (size_t)i * rowb) : "memory"); }
    }
    __device__ __forceinline__ void finish(const unsigned (&x)[16 * N_], int lane) const {
#pragma unroll
        for (int j = 0; j < N_; ++j) { const int id = pend[j]; const int cb = id & ((1 << cbs) - 1), kb = (id >> cbs) & 127, e = e0 + (id >> (cbs + 7)); const int n0 = 64 * cb;
            const int drow0 = !gu ? n0 : (n0 < 2048) ? (256 * (n0 >> 7) + (n0 & 127)) : (256 * ((n0 - 2048) >> 7) + 128 + ((n0 - 2048) & 127));
            u32x4 o;
#pragma unroll
            for (int q = 0; q < 4; ++q) o[q] = pk4_fp8(__builtin_bit_cast(float, x[16 * j + 4 * q]) * 512.0f, __builtin_bit_cast(float, x[16 * j + 4 * q + 1]) * 512.0f, __builtin_bit_cast(float, x[16 * j + 4 * q + 2]) * 512.0f, __builtin_bit_cast(float, x[16 * j + 4 * q + 3]) * 512.0f);
            *(u32x4*)(WT + (size_t)e * ldw * DM + (size_t)(drow0 + lane) * DM + 16 * kb) = o; }
    }
};
struct NoGather { static constexpr bool ON = false; };
struct Gather { static constexpr bool ON = true; const unsigned short* list; const LAS unsigned* pbase; const LAS unsigned* cnt; };
__device__ __forceinline__ unsigned gather_clamp(unsigned P, int r0, int cn) { const unsigned lo = (r0 < cn) ? (P & 0xffffu) : 0u, hi = (r0 + 64 < cn) ? (P >> 16) : 0u; return lo | (hi << 16); }
struct NoConv { static constexpr bool ON = false; };
struct ConvGU {
    static constexpr bool ON = true;
    const float* W; unsigned char* WT; int cid, cend, cstride, pend; const char* rbase;
    __device__ __forceinline__ void issue(unsigned (&x)[16], int lane) {
        const int id = cid < cend ? cid : cend - 1; pend = id; cid += cstride;
        const int e = id >> 13, kb = (id >> 6) & 127, cb = id & 63;
        const char* rb = (const char*)(W + (size_t)e * DM * 4096 + (size_t)(16 * kb) * 4096 + 64 * cb);
        const unsigned vo = (unsigned)lane * 4u; rbase = rb;
#pragma unroll
        for (int i = 0; i < 8; ++i) asm volatile("s_nop 4\n\tglobal_load_dword %0, %1, %2" : "=v"(x[i]) : "v"(vo), "s"(rb + (size_t)i * 16384) : "memory");
    }
    __device__ __forceinline__ void issue_b(unsigned (&x)[16], int lane) {
        const unsigned vo = (unsigned)lane * 4u;
#pragma unroll
        for (int i = 8; i < 16; ++i) asm volatile("s_nop 4\n\tglobal_load_dword %0, %1, %2" : "=v"(x[i]) : "v"(vo), "s"(rbase + (size_t)i * 16384) : "memory");
    }
    __device__ __forceinline__ void finish(const unsigned (&x)[16], int lane) const {
        const int id = pend; const int e = id >> 13, kb = (id >> 6) & 127, cb = id & 63; const int n0 = 64 * cb;
        const int drow0 = (n0 < 2048) ? (256 * (n0 >> 7) + (n0 & 127)) : (256 * ((n0 - 2048) >> 7) + 128 + ((n0 - 2048) & 127));
        u32x4 o;
#pragma unroll
        for (int q = 0; q < 4; ++q) o[q] = pk4_fp8(__builtin_bit_cast(float, x[4 * q]) * 512.0f, __builtin_bit_cast(float, x[4 * q + 1]) * 512.0f, __builtin_bit_cast(float, x[4 * q + 2]) * 512.0f, __builtin_bit_cast(float, x[4 * q + 3]) * 512.0f);
        *(u32x4*)(WT + (size_t)e * 4096 * DM + (size_t)(drow0 + lane) * DM + 16 * kb) = o;
    }
};
#define PG8_X16A(x, b) "+v"(x[b+0]), "+v"(x[b+1]), "+v"(x[b+2]), "+v"(x[b+3]), "+v"(x[b+4]), "+v"(x[b+5]), "+v"(x[b+6]), "+v"(x[b+7]), "+v"(x[b+8]), "+v"(x[b+9]), "+v"(x[b+10]), "+v"(x[b+11]), "+v"(x[b+12]), "+v"(x[b+13]), "+v"(x[b+14]), "+v"(x[b+15])
#define PG8_X16(x) "+v"(x[0]), "+v"(x[1]), "+v"(x[2]), "+v"(x[3]), "+v"(x[4]), "+v"(x[5]), "+v"(x[6]), "+v"(x[7]), "+v"(x[8]), "+v"(x[9]), "+v"(x[10]), "+v"(x[11]), "+v"(x[12]), "+v"(x[13]), "+v"(x[14]), "+v"(x[15])

template <class E, class = void> struct epi_nstores { static constexpr int value = 0; };
template <class E> struct epi_nstores<E, decltype((void)E::NSTORES)> { static constexpr int value = E::NSTORES; };
template <class E, class = void> struct epi_takes_bl { static constexpr bool value = false; };
template <class E> struct epi_takes_bl<E, decltype((void)E::BIAS_LDS)> { static constexpr bool value = true; };
template <class E, class = void> struct has_bias_lds { static constexpr bool value = false; };
template <class E> struct has_bias_lds<E, decltype((void)E::BIAS_LDS)> { static constexpr bool value = E::BIAS_LDS; };
constexpr int BIAS_LDS_OFF = MISC_OFF + 4096;
#ifndef CV_XMASK
#define CV_XMASK 0
#endif
template <class Epi, class Sched, class GS, bool ALIGN_EPI = true, bool F8 = false, int STAGGER_TICKS = 0, class CV = NoConv, class EH = NoHost, bool KROT = false, class GI = NoGather, bool FLP = false>
__device__ __forceinline__ void gemm_phase(LAS unsigned char* lds, const Gemm g, const Sched& S, const Epi& E, int wave, CV cv = CV(), EH eh = EH(), GI gi = GI()) {
    const int wid = wave, lane = fresh_lane(), tid = wid * 64 + lane, wr = wid >> 2, wc = wid & 3, fr = lane & 15, fq = lane >> 4;
    constexpr int nt = GS::KB / 128;
    unsigned voffA, voffB;
    { int R, C; stage_rc(tid * 16, R, C); const int Rb = Epi::PERM ? ((R & ~31) + perm32(R & 31)) : R;
      voffA = (unsigned)(R * GS::LDA + C * 2); voffB = (unsigned)(Rb * GS::LDB + C * 2);
      if constexpr (FLP) { const int b = tid * 16; voffA = (unsigned)((b >> 7) * GS::LDA + (b & 127)); voffB = (unsigned)((b >> 7) * GS::LDB + (b & 127)); } }
    constexpr size_t pstepA = (size_t)64 * GS::LDA, pstepB = (size_t)64 * GS::LDB;
    constexpr size_t kstep = (size_t)(BK * 2);
    constexpr size_t hstepA = (size_t)HALF * GS::LDA, hstepB = (size_t)HALF * GS::LDB;
    constexpr size_t tstepA = 2 * hstepA, tstepB = 2 * hstepB;
    const unsigned ldsw = (unsigned)wid * 1024u;
    const unsigned ldsb = (unsigned)(size_t)lds + ldsw;
    const int aoff = lds_byte(wr * 64 + fr, F8 ? fq * 16 : fq * 8), boff = lds_byte(wc * 32 + fr, F8 ? fq * 16 : fq * 8);
    const int kofs = F8 ? 16 : 1024;
#define PG8_SA(b, h) (((b) * 2 + (h)) * HTB)
#define PG8_SB(b, h) ((4 + (b) * 2 + (h)) * HTB)
#define PG8_STAGE(bufoff, gbase, voff) do { _Pragma("unroll") for (int _i = 0; _i < 2; ++_i) { unsigned _keep; \
        asm volatile("s_mov_b32 %0, m0\n\ts_mov_b32 m0, %3\n\ts_nop 3\n\tglobal_load_lds_dwordx4 %1, %2\n\ts_mov_b32 m0, %0" \
            : "=&s"(_keep) : "v"(voff##_v), "s"((const char*)(gbase) + _i * pstep##voff), "s"(ldsb + (unsigned)((bufoff) + _i * 8192)) : "memory"); } } while (0)
#define PG8_STAGE_GA(bufoff, kp, vlo, vhi) do { unsigned _keep; \
        asm volatile("s_mov_b32 %0, m0\n\ts_mov_b32 m0, %3\n\ts_nop 3\n\tglobal_load_lds_dwordx4 %1, %2\n\ts_mov_b32 m0, %0" : "=&s"(_keep) : "v"(vlo), "s"((const char*)(kp)), "s"(ldsb + (unsigned)(bufoff)) : "memory"); \
        asm volatile("s_mov_b32 %0, m0\n\ts_mov_b32 m0, %3\n\ts_nop 3\n\tglobal_load_lds_dwordx4 %1, %2\n\ts_mov_b32 m0, %0" : "=&s"(_keep) : "v"(vhi), "s"((const char*)(kp)), "s"(ldsb + (unsigned)((bufoff) + 8192)) : "memory"); } while (0)
#define PG8_STA(bufoff, kp, h, nx) do { if constexpr (GI::ON) { const unsigned _p = (nx) ? nvP[h] : voP[h]; const unsigned _lo = ((_p & 0xffffu) << 11) + gcb, _hi = ((_p >> 16) << 11) + gcb; PG8_STAGE_GA(bufoff, kp, _lo, _hi); } \
        else PG8_STAGE(bufoff, (kp) + (h) * hstepA, voffA); } while (0)
#define pstepvoffA pstepA
#define pstepvoffB pstepB
#define voffA_v voffA
#define voffB_v voffB
#define PG8_LD16(p) (*(const LAS i32x4*)(p))
#define PG8_SET8(V, idx, lo, hi) do { _Pragma("unroll") for (int _j = 0; _j < 4; ++_j) { V[8 * (idx) + _j] = (lo)[_j]; V[8 * (idx) + 4 + _j] = (hi)[_j]; } } while (0)
#define PG8_GET8(V, idx) pg8_get8(V, idx)
#define PG8_GETLO(V, idx) __builtin_bit_cast(bf16x8, pg8_get4(V, 2 * (idx)))
#define PG8_GETHI(V, idx) __builtin_bit_cast(bf16x8, pg8_get4(V, 2 * (idx) + 1))
#define PG8_LDA(dst, b, h) do { _Pragma("unroll") for (int m = 0; m < 4; ++m) { const i32x4 _lo = PG8_LD16(lds + PG8_SA(b, h) + aoff + m * 2048), _hi = PG8_LD16(lds + PG8_SA(b, h) + aoff + m * 2048 + kofs); \
        PG8_SET8(AV, m, _lo, _hi); } } while (0)
#define PG8_LDB(dst, b, h) do { _Pragma("unroll") for (int n = 0; n < 2; ++n) { const i32x4 _lo = PG8_LD16(lds + PG8_SB(b, h) + boff + n * 2048), _hi = PG8_LD16(lds + PG8_SB(b, h) + boff + n * 2048 + kofs); \
        PG8_SET8(BV, (dst) + n, _lo, _hi); } } while (0)
#define PG8_MMA(ai, bj, At, Bt) do { __builtin_amdgcn_s_setprio(1); \
        if constexpr (F8) { _Pragma("unroll") for (int m = 0; m < 4; ++m) _Pragma("unroll") for (int n = 0; n < 2; ++n) \
            acc[ai][bj][m][n] = __builtin_amdgcn_mfma_scale_f32_16x16x128_f8f6f4(PG8_GET8(BV, (Bt) + n), PG8_GET8(AV, m), acc[ai][bj][m][n], 0, 0, 0, 0, 0, 0); } \
        else { _Pragma("unroll") for (int m = 0; m < 4; ++m) _Pragma("unroll") for (int n = 0; n < 2; ++n) { \
            acc[ai][bj][m][n] = __builtin_amdgcn_mfma_f32_16x16x32_bf16(PG8_GETLO(BV, (Bt) + n), PG8_GETLO(AV, m), acc[ai][bj][m][n], 0, 0, 0); \
            acc[ai][bj][m][n] = __builtin_amdgcn_mfma_f32_16x16x32_bf16(PG8_GETHI(BV, (Bt) + n), PG8_GETHI(AV, m), acc[ai][bj][m][n], 0, 0, 0); } } \
        __builtin_amdgcn_s_setprio(0); } while (0)
#define PG8_WAIT_V(n) asm volatile("s_waitcnt vmcnt(" #n ")" ::: "memory")
#define PG8_WAIT_L(n) asm volatile("s_waitcnt lgkmcnt(" #n ")" ::: "memory")
#define PG8_BAR __builtin_amdgcn_s_barrier()
#define PG8_SCHED __builtin_amdgcn_sched_barrier(0)
    Unit cur, nxt; int ui = 0;
    if (!S.next(0, cur)) return;
    constexpr bool BL = has_bias_lds<Epi>::value;
    constexpr int NST = EH::ON ? EH::N : epi_nstores<Epi>::value;
#define PG8_WAIT_VN(n) asm volatile("s_waitcnt vmcnt(%0)" :: "n"(n) : "memory")
    static_assert(!(BL && CV::ON), "the counted waits below know one or the other");
    unsigned bx = 0;
    unsigned cx[16];
    if constexpr (CV::ON) { cv.issue(cx, lane); cv.issue_b(cx, lane); asm volatile("s_waitcnt vmcnt(0)" ::: "memory"); asm volatile("" : PG8_X16(cx) :: "memory"); }
    if constexpr (STAGGER_TICKS > 0) {
        if (blockIdx.x & 1) { const unsigned long long t0 = __builtin_amdgcn_s_memrealtime(); while (__builtin_amdgcn_s_memrealtime() - t0 < (unsigned long long)STAGGER_TICKS) __builtin_amdgcn_s_sleep(8); } }
    i32x32 AV, BV;
    constexpr int At = 0, B0 = 0, B1 = 2;
    static_assert(!GI::ON || GS::LDA == 2048, "gather: 2 KiB token rows");
    int tfetch = 0; if constexpr (GI::ON) asm volatile("s_mov_b32 %0, 0" : "=s"(tfetch));
    unsigned voP[2] = {0u, 0u}, nvP[2] = {0u, 0u}, gcb = 0u;
    if constexpr (GI::ON) { int R, C; stage_rc(tid * 16, R, C); gcb = (unsigned)(C * 2);
        const int lb = cur.pm * BM - __builtin_amdgcn_readfirstlane((int)gi.pbase[cur.e]), cn = __builtin_amdgcn_readfirstlane((int)gi.cnt[cur.e]);
        const u32x2 pr = *(const u32x2*)(gi.list + (size_t)cur.e * 16384 + lb + 4 * R);
        voP[0] = gather_clamp(pr.x, lb + R, cn); voP[1] = gather_clamp(pr.y, lb + R + 128, cn); }
    const char* cA = GI::ON ? (const char*)g.A : (const char*)g.A + (size_t)cur.pm * tstepA; const char* cB = (const char*)g.Bt + (size_t)cur.e * GS::SB + (size_t)cur.pn * tstepB;
#define PG8_KO(u) (KROT ? ((((u).pn & 7) * 2 + ((u).pm & 3) * 4) * (nt / 16)) & (nt - 1) : 0)
    int ko = PG8_KO(cur);
    { const char* pA = cA + (size_t)ko * kstep; const char* pB = cB + (size_t)ko * kstep;
    PG8_STAGE(PG8_SB(0, 0), pB, voffB); PG8_SCHED; PG8_STAGE(PG8_SB(0, 1), pB + hstepB, voffB); PG8_SCHED; PG8_STA(PG8_SA(0, 0), pA, 0, false); PG8_SCHED; PG8_STA(PG8_SA(0, 1), pA, 1, false); PG8_SCHED;
    if (wr == 1) PG8_BAR;
    PG8_WAIT_V(2); PG8_BAR;
    PG8_STAGE(PG8_SB(1, 0), pB + kstep, voffB); PG8_SCHED; PG8_STA(PG8_SA(1, 0), pA + kstep, 0, false); PG8_SCHED; PG8_STAGE(PG8_SB(1, 1), pB + hstepB + kstep, voffB); PG8_SCHED; }
    PG8_WAIT_V(6); PG8_BAR; PG8_SCHED;
    f32x4 acc[2][2][4][2];
#pragma unroll
    for (int a = 0; a < 2; ++a)
#pragma unroll
        for (int b = 0; b < 2; ++b)
#pragma unroll
            for (int m = 0; m < 4; ++m)
#pragma unroll
                for (int n = 0; n < 2; ++n) acc[a][b][m][n] = (f32x4){0.f, 0.f, 0.f, 0.f};
    for (;;) {
        const bool has_next = S.next(ui + 1, nxt);
        const char* nA = (has_next && !GI::ON) ? (const char*)g.A + (size_t)nxt.pm * tstepA : cA;
        const char* nB = has_next ? (const char*)g.Bt + (size_t)nxt.e * GS::SB + (size_t)nxt.pn * tstepB : cB;
        const int nko = has_next ? PG8_KO(nxt) : ko;
        for (int t = 0; t < nt; t += 2) {
            const bool last = (t == nt - 2);
            const int kt = KROT ? ((ko + t) & (nt - 1)) : t, kt2 = KROT ? ((ko + t + 2) & (nt - 1)) : t + 2;
            const char* a1 = cA + (size_t)(kt + 1) * kstep;
            const char* a2 = last ? nA + (size_t)nko * kstep : cA + (size_t)kt2 * kstep; const char* b2 = last ? nB + (size_t)nko * kstep : cB + (size_t)kt2 * kstep;
            const char* a3 = a2 + kstep; const char* b3 = b2 + kstep;
            PG8_LDB(B0, 0, 0); PG8_LDB(B1, 0, 1); PG8_SCHED; PG8_LDA(At, 0, 0); PG8_STA(PG8_SA(1, 1), a1, 1, false);
            PG8_WAIT_V(8);
            if constexpr (CV::ON) asm volatile("" : PG8_X16(cx));
            PG8_WAIT_L(0); PG8_BAR;
            const bool xon = CV::ON && ((t & CV_XMASK) == 0);
            if constexpr (CV::ON) { if (xon) { cv.finish(cx, lane); cv.issue(cx, lane); } }
            if constexpr (GI::ON) { if (t == tfetch && has_next) {
                int R, C; stage_rc((wid * 64 + fresh_lane()) * 16, R, C); const unsigned lvo = (unsigned)R * 8u;
                const char* lp = (const char*)(gi.list + (size_t)nxt.e * 16384 + (nxt.pm * BM - __builtin_amdgcn_readfirstlane((int)gi.pbase[nxt.e])));
                u32x2 pr; asm volatile("s_nop 4\n\tglobal_load_dwordx2 %0, %1, %2" : "=&v"(pr) : "v"(lvo), "s"(lp) : "memory"); nvP[0] = pr.x; nvP[1] = pr.y; } }
            if constexpr (BL) { if (last) { const unsigned bvo = Epi::bias_voff((wid * 64 + fresh_lane()) & 255);
                asm volatile("s_nop 4\n\tglobal_load_dword %0, %1, %2" : "=v"(bx) : "v"(bvo), "s"(E.bias_base(cur)) : "memory"); } }
            PG8_MMA(0, 0, At, B0); PG8_MMA(0, 1, At, B1); PG8_BAR; PG8_SCHED;
            PG8_LDA(At, 0, 1); PG8_STAGE(PG8_SB(0, 0), b2, voffB); PG8_STAGE(PG8_SB(0, 1), b2 + hstepB, voffB); PG8_STA(PG8_SA(0, 0), a2, 0, last);
            if (xon) PG8_WAIT_V(17); else if (BL && last) PG8_WAIT_V(9); else if (GI::ON && t == tfetch && has_next) PG8_WAIT_V(9); else PG8_WAIT_V(8);
            PG8_WAIT_L(0); PG8_BAR;
            if constexpr (CV::ON) { if (xon) cv.issue_b(cx, lane); }
            PG8_MMA(1, 0, At, B0); PG8_MMA(1, 1, At, B1); PG8_BAR; PG8_SCHED;
            PG8_LDB(B0, 1, 0); PG8_LDB(B1, 1, 1); PG8_SCHED; PG8_LDA(At, 1, 0); PG8_STA(PG8_SA(0, 1), a2, 1, last);
            if (xon) PG8_WAIT_V(25); else PG8_WAIT_V(8);
            if constexpr (GI::ON) { if (t == tfetch && has_next) { asm volatile("" : "+v"(nvP[0]), "+v"(nvP[1]));
                int R, C; stage_rc((wid * 64 + fresh_lane()) * 16, R, C); const int lb = nxt.pm * BM - __builtin_amdgcn_readfirstlane((int)gi.pbase[nxt.e]), cn = __builtin_amdgcn_readfirstlane((int)gi.cnt[nxt.e]);
                nvP[0] = gather_clamp(nvP[0], lb + R, cn); nvP[1] = gather_clamp(nvP[1], lb + R + 128, cn); } }
            if constexpr (BL) { if (last) { asm volatile("" : "+v"(bx));
                *(LAS unsigned*)(lds + BIAS_LDS_OFF + 4 * ((wid * 64 + fresh_lane()) & 255)) = bx; } }
            PG8_WAIT_L(0); PG8_BAR; PG8_MMA(0, 0, At, B0); PG8_MMA(0, 1, At, B1); PG8_BAR; PG8_SCHED;
            PG8_LDA(At, 1, 1); PG8_STAGE(PG8_SB(1, 0), b3, voffB); PG8_STAGE(PG8_SB(1, 1), b3 + hstepB, voffB); PG8_STA(PG8_SA(1, 0), a3, 0, last);
            if constexpr (CV::ON) { if (xon) PG8_WAIT_V(16); else PG8_WAIT_V(8); } else PG8_WAIT_V(8);
            PG8_WAIT_L(0); PG8_BAR; PG8_MMA(1, 0, At, B0); PG8_MMA(1, 1, At, B1); PG8_BAR; PG8_SCHED;
        }
        if constexpr (ALIGN_EPI) { if (wr == 0) PG8_BAR; }
        { const int l2 = fresh_lane();
          const LAS float* bl = (const LAS float*)(lds + BIAS_LDS_OFF);
          if constexpr (EH::ON) {
              unsigned ex[16 * EH::N]; typename Epi::Bias eb;
              if constexpr (BL) { eh.issue(ex, l2); E.load_bias(cur, wc, l2 >> 4, eb, bl); }
              else { E.load_bias(cur, wc, l2 >> 4, eb, bl); eb.pin(); eh.issue(ex, l2); }
              E.apply(acc, cur, wr, wc, l2 & 15, l2 >> 4, eb);
              asm volatile("s_waitcnt vmcnt(0)" ::: "memory");
              if constexpr (EH::N == 3) asm volatile("" : PG8_X16A(ex, 0), PG8_X16A(ex, 16), PG8_X16A(ex, 32) :: "memory");
              else asm volatile("" : PG8_X16A(ex, 0), PG8_X16A(ex, 16), PG8_X16A(ex, 32), PG8_X16A(ex, 48) :: "memory");
              eh.finish(ex, l2);
          } else if constexpr (epi_takes_bl<Epi>::value) E(acc, cur, wr, wc, l2 & 15, l2 >> 4, bl);
          else E(acc, cur, wr, wc, l2 & 15, l2 >> 4); }
        if (!has_next) break;
#pragma unroll
        for (int a = 0; a < 2; ++a)
#pragma unroll
            for (int b = 0; b < 2; ++b)
#pragma unroll
                for (int m = 0; m < 4; ++m)
#pragma unroll
                    for (int n = 0; n < 2; ++n) acc[a][b][m][n] = (f32x4){0.f, 0.f, 0.f, 0.f};
        cur = nxt; cA = nA; cB = nB; ko = nko; ++ui;
        if constexpr (GI::ON) {
#pragma unroll
            for (int i = 0; i < 2; ++i) voP[i] = nvP[i]; }
        if constexpr (ALIGN_EPI) { if (wr == 1) PG8_BAR; }
    }
    if constexpr (CV::ON) { asm volatile("s_waitcnt vmcnt(0)" ::: "memory"); asm volatile("" : PG8_X16(cx) :: "memory"); cv.finish(cx, lane); }
    else PG8_WAIT_V(0);
    if constexpr (!ALIGN_EPI) { if (wr == 0) PG8_BAR; }
    PG8_BAR;
#undef PG8_SA
#undef PG8_KO
#undef PG8_SB
#undef PG8_STAGE
#undef PG8_STAGE_GA
#undef PG8_STA
#undef pstepvoffA
#undef pstepvoffB
#undef voffA_v
#undef voffB_v
#undef PG8_LDA
#undef PG8_LD16
#undef PG8_SET8
#undef PG8_GET8
#undef PG8_GETLO
#undef PG8_GETHI
#undef PG8_LDB
#undef PG8_MMA
#undef PG8_WAIT_V
#undef PG8_WAIT_VN
#undef PG8_WAIT_L
#undef PG8_BAR
#undef PG8_SCHED
}
}
struct Params {
    const float* in[22];
    float* out; unsigned char* ws;
    int ph_lo, ph_hi;
};
enum { I_X = 0, I_NMG, I_WIN, I_GWG, I_GBG, I_GNG, I_CW, I_CB, I_WA, I_BA, I_WI, I_BI, I_AP, I_WOUT, I_NFG, I_WR, I_BR, I_WGU, I_BGU, I_WDN, I_BDN, I_NFINAL };

struct Frame {
    LAS unsigned char* lds; volatile LAS unsigned* MISC;
    int tid, lane, wave, G, gw, NGW;
    unsigned char* ws;
};

__device__ __forceinline__ float gelu_tanh_f(float x) {
    const float u = 0.7978845608028654f * (x + 0.044715f * x * x * x);
    const float e = __expf(2.0f * u);
    const float th = 1.0f - 2.0f * __builtin_amdgcn_rcpf(e + 1.0f);
    return 0.5f * x * (1.0f + th);
}
__device__ __forceinline__ float log_sigmoid_f(float s) { return fminf(s, 0.f) - __logf(1.0f + __expf(-fabsf(s))); }

__device__ __forceinline__ void p0_item(const float* W, int ldw, int col0, bf16_t* WT, int ldt, size_t drow0, int k0, LAS float* scr, int lane) {
    (void)scr;
    const float* src = W + (size_t)k0 * ldw + col0 + lane;
    float v[64];
#pragma unroll
    for (int i = 0; i < 64; ++i) v[i] = src[(size_t)i * ldw];
    bf16_t* dst = WT + (drow0 + lane) * (size_t)ldt + k0;
#pragma unroll
    for (int c = 0; c < 8; ++c) { u32x4 o; o.x = pk2(v[8 * c], v[8 * c + 1]); o.y = pk2(v[8 * c + 2], v[8 * c + 3]); o.z = pk2(v[8 * c + 4], v[8 * c + 5]); o.w = pk2(v[8 * c + 6], v[8 * c + 7]);
        *(u32x4*)(dst + 8 * c) = o; }
}

__device__ __forceinline__ void p0_item8(const float* W, int ldw, int col0, unsigned char* WT, int ldt, size_t drow0, int k0, int lane) {
    const float* src = W + (size_t)k0 * ldw + col0 + lane;
    float v[64];
#pragma unroll
    for (int i = 0; i < 64; ++i) v[i] = src[(size_t)i * ldw];
    unsigned char* dst = WT + (drow0 + lane) * (size_t)ldt + k0;
#pragma unroll
    for (int c = 0; c < 4; ++c) { u32x4 o;
#pragma unroll
        for (int q = 0; q < 4; ++q) o[q] = pk4_fp8(v[16 * c + 4 * q] * 512.0f, v[16 * c + 4 * q + 1] * 512.0f, v[16 * c + 4 * q + 2] * 512.0f, v[16 * c + 4 * q + 3] * 512.0f);
        *(u32x4*)(dst + 16 * c) = o; }
}

constexpr int CONV_EXPERTS_P0 = 28, HOST_DN_EXPERTS_P0 = 24;
struct CoopTile { const float* W; int ldw; int col0; unsigned char* WT; int ldt_b; int mode; int k0; int gu; int drow0; };
__device__ __forceinline__ void coop_load(const CoopTile& t, int w, int l, f32x4 (&v)[16]) {
    if (t.mode == 0) {
#pragma unroll
        for (int i = 0; i < 8; ++i) { const float* r = t.W + (size_t)(t.k0 + 8 * w + i) * t.ldw + t.col0 + 4 * l; v[2 * i] = *(const f32x4*)r; v[2 * i + 1] = *(const f32x4*)(r + 256); }
    } else {
#pragma unroll
        for (int i = 0; i < 16; ++i) v[i] = *(const f32x4*)(t.W + (size_t)(t.k0 + 16 * w + i) * t.ldw + t.col0 + 4 * l);
    }
}
__device__ __forceinline__ void coop_to_lds(const CoopTile& t, int w, int l, const f32x4 (&v)[16], LAS unsigned char* buf) {
    const int sw = (w ^ (l & 7)) * 16;
    if (t.mode == 0) {
#pragma unroll
        for (int jp = 0; jp < 2; ++jp)
#pragma unroll
            for (int j = 0; j < 4; ++j) { u32x4 o; if (t.ldw == INC) { o.x = PK2W(v[0 + jp][j], v[2 + jp][j]); o.y = PK2W(v[4 + jp][j], v[6 + jp][j]); o.z = PK2W(v[8 + jp][j], v[10 + jp][j]); o.w = PK2W(v[12 + jp][j], v[14 + jp][j]); } else { o.x = pk2(v[0 + jp][j], v[2 + jp][j]); o.y = pk2(v[4 + jp][j], v[6 + jp][j]); o.z = pk2(v[8 + jp][j], v[10 + jp][j]); o.w = pk2(v[12 + jp][j], v[14 + jp][j]); }
                *(LAS u32x4*)(buf + (256 * jp + 4 * l + j) * 128 + sw) = o; }
    } else {
#pragma unroll
        for (int j = 0; j < 4; ++j) { u32x4 o;
#pragma unroll
            for (int q = 0; q < 4; ++q) o[q] = pk4_fp8(v[4 * q][j] * 512.0f, v[4 * q + 1][j] * 512.0f, v[4 * q + 2][j] * 512.0f, v[4 * q + 3][j] * 512.0f);
            *(LAS u32x4*)(buf + (4 * l + j) * 128 + sw) = o; }
    }
}
__device__ __forceinline__ void coop_store(const CoopTile& t, int w, int l, const LAS unsigned char* buf) {
    const int nrows = t.mode == 0 ? 512 : 256; const int cp = l & 7;
    for (int n = 8 * w + (l >> 3); n < nrows; n += 64) {
        const u32x4 o = *(const LAS u32x4*)(buf + n * 128 + cp * 16); const int c = cp ^ ((n >> 2) & 7);
        int drow;
        if (t.gu) { const int g = t.col0 + n; drow = (g < 2048) ? (256 * (g >> 7) + (g & 127)) : (256 * ((g - 2048) >> 7) + 128 + ((g - 2048) & 127)); } else drow = t.drow0 + n;
        *(u32x4*)(t.WT + (size_t)drow * t.ldt_b + (t.mode == 0 ? 2 * t.k0 : t.k0) + 16 * c) = o; }
}
__device__ __forceinline__ bool coop_tile(const Params& p, unsigned char* ws, int it, CoopTile& t) {
    constexpr int N_GU = (32 - CONV_EXPERTS_P0) * 256, N_DN = (32 - HOST_DN_EXPERTS_P0) * 128, N_INA = 32 * 6, N_INB = 32 * 4, N_OUT = 32 * 4;
    int r = it;
    if (r < N_GU) { const int e = CONV_EXPERTS_P0 + (r >> 8), q = r & 255, kb = q >> 4, nb = q & 15; t = CoopTile{p.in[I_WGU] + (size_t)e * DM * 4096, 4096, 256 * nb, ws + WS_WGUT + (size_t)e * 4096 * DM, DM, 1, 128 * kb, 1, 0}; return true; } r -= N_GU;
    if (r < N_DN) { const int e = HOST_DN_EXPERTS_P0 + (r >> 7), q = r & 127, kb = q >> 3, nb = q & 7; t = CoopTile{p.in[I_WDN] + (size_t)e * DM * DM, DM, 256 * nb, ws + WS_WDT + (size_t)e * DM * DM, DM, 1, 128 * kb, 0, 256 * nb}; return true; } r -= N_DN;
    if (r < N_INA) { const int kb = r / 6, nb = r % 6; t = CoopTile{p.in[I_WIN], INC, 512 * nb, ws + WS_WINT, DM * 2, 0, 64 * kb, 0, 512 * nb}; return true; } r -= N_INA;
    if (r < N_INB) { const int kb = r >> 2, nb = r & 3; t = CoopTile{p.in[I_WIN], INC, 3088 + 512 * nb, ws + WS_WINT, DM * 2, 0, 64 * kb, 0, 3072 + 512 * nb}; return true; } r -= N_INB;
    if (r < N_OUT) { const int kb = r >> 2, nb = r & 3; t = CoopTile{p.in[I_WOUT], DM, 512 * nb, ws + WS_WOUTT, DM * 2, 0, 64 * kb, 0, 512 * nb}; return true; }
    return false;
}
__device__ __forceinline__ void p0a(Frame& F, const Params& p) {
    const int w = F.wave, l = F.lane;
    CoopTile cur, nxt; f32x4 v[16];
    int it = blockIdx.x; bool have = coop_tile(p, F.ws, it, cur);
    if (have) coop_load(cur, w, l, v);
    { bf16_t* WaT = (bf16_t*)(F.ws + WS_WAT); bf16_t* WiT = (bf16_t*)(F.ws + WS_WIT);
      for (int r = F.gw; r < 128; r += F.NGW) { const int which = r >> 6, h = (r >> 4) & 3, kb = (r >> 2) & 3, nb = r & 3;
          p0_item((which ? p.in[I_WI] : p.in[I_WA]) + (size_t)h * 65536, 256, 64 * nb, (which ? WiT : WaT) + (size_t)h * 65536, 256, (size_t)64 * nb, 64 * kb, nullptr, F.lane); } }
    { bf16_t* WglT = (bf16_t*)(F.ws + WS_WGLT); const float* w_in = p.in[I_WIN];
      for (int idx = (int)blockIdx.x * 512 + F.tid; idx < 16 * DM; idx += F.G * 512) { const int cc = idx >> 11, k = idx & 2047; WglT[idx] = (bf16_t)f2bf(w_in[(size_t)k * INC + 3072 + cc]); } }
    { float* WrT = (float*)(F.ws + WS_WRT); const float* wr = p.in[I_WR]; const float* gf = p.in[I_NFG];
      for (int idx = (int)blockIdx.x * 512 + F.tid; idx < 32 * DM; idx += F.G * 512) { const int n = idx >> 11, k = idx & 2047; WrT[idx] = wr[k * 32 + n] * gf[k]; } }
    int par = 0;
    while (have) {
        LAS unsigned char* buf = F.lds + par * 65536;
        coop_to_lds(cur, w, l, v, buf);
        it += F.G; const bool hn = coop_tile(p, F.ws, it, nxt);
        if (hn) coop_load(nxt, w, l, v);
        __syncthreads();
        coop_store(cur, w, l, buf);
        cur = nxt; have = hn; par ^= 1;
    }
    __syncthreads();
}
__device__ __forceinline__ void p0b(Frame& F, const Params& p) {
    const float* x = p.in[I_X]; const float* g1 = p.in[I_NMG]; bf16_t* H = (bf16_t*)(F.ws + WS_H);
    const int l = F.lane;
    f32x4 gv[8], xn[8];
#pragma unroll
    for (int j = 0; j < 4; ++j) { gv[2 * j] = *(const f32x4*)(g1 + 8 * l + 512 * j); gv[2 * j + 1] = *(const f32x4*)(g1 + 8 * l + 512 * j + 4); }
#pragma unroll
    for (int j = 0; j < 4; ++j) { xn[2 * j] = (F.gw < T) ? *(const f32x4*)(x + (size_t)F.gw * DM + 8 * l + 512 * j) : (f32x4){0.f, 0.f, 0.f, 0.f}; xn[2 * j + 1] = (F.gw < T) ? *(const f32x4*)(x + (size_t)F.gw * DM + 8 * l + 512 * j + 4) : (f32x4){0.f, 0.f, 0.f, 0.f}; }
    for (int m = F.gw; m < T; m += F.NGW) {
        f32x4 xv[8]; float ss = 0.f;
#pragma unroll
        for (int j = 0; j < 8; ++j) { xv[j] = xn[j]; ss += (xv[j][0] * xv[j][0] + xv[j][1] * xv[j][1]) + (xv[j][2] * xv[j][2] + xv[j][3] * xv[j][3]); }
        if (m + F.NGW < T) {
#pragma unroll
            for (int j = 0; j < 4; ++j) { xn[2 * j] = *(const f32x4*)(x + (size_t)(m + F.NGW) * DM + 8 * l + 512 * j); xn[2 * j + 1] = *(const f32x4*)(x + (size_t)(m + F.NGW) * DM + 8 * l + 512 * j + 4); } }
        const float rs = rsqrtf_(wave_sum(ss) * (1.0f / DM) + 1e-6f);
#pragma unroll
        for (int j = 0; j < 4; ++j) { const f32x4 a = xv[2 * j] * rs * gv[2 * j], b = xv[2 * j + 1] * rs * gv[2 * j + 1];
            u32x4 o; o.x = pk2(a[0], a[1]); o.y = pk2(a[2], a[3]); o.z = pk2(b[0], b[1]); o.w = pk2(b[2], b[3]);
            *(u32x4*)(H + (size_t)m * DM + 8 * l + 512 * j) = o;
#ifdef SIM_FP8
            o.x = PK2A(a[0], a[1]); o.y = PK2A(a[2], a[3]); o.z = PK2A(b[0], b[1]); o.w = PK2A(b[2], b[3]); *(u32x4*)((bf16_t*)(F.ws + WS_MIX) + (size_t)m * DM + 8 * l + 512 * j) = o;
#endif
            }
    }
}

struct GlaW { float wcol[16], bcol; };
__device__ __forceinline__ void gla_load_w(const float* wg, const float* bgp, int h, int tid, GlaW& gw_) {
    const int kk = tid & 127;
#pragma unroll
    for (int c = 0; c < 16; ++c) gw_.wcol[c] = wg[c * 512 + h * 128 + kk];
    gw_.bcol = bgp[h * 128 + kk];
}
__device__ __forceinline__ void gla_cumsum(const LAS float* GL, const GlaW& gw_, LAS float* BC, LAS float* SEG, int tid) {
    const int seg = tid >> 7, kk = tid & 127;
    const float (&wcol)[16] = gw_.wcol; const float bcol = gw_.bcol;
    float v[16];
#pragma unroll
    for (int i = 0; i < 16; ++i) { const LAS f32x4* g4 = (const LAS f32x4*)(GL + (16 * seg + i) * 16); float sacc = bcol;
#pragma unroll
        for (int c4 = 0; c4 < 4; ++c4) { const f32x4 gq = g4[c4]; sacc += gq[0] * wcol[4 * c4] + gq[1] * wcol[4 * c4 + 1] + gq[2] * wcol[4 * c4 + 2] + gq[3] * wcol[4 * c4 + 3]; }
        v[i] = log_sigmoid_f(sacc) * 0.0625f; }
#pragma unroll
    for (int i = 1; i < 16; ++i) v[i] += v[i - 1];
    SEG[seg * 128 + kk] = v[15];
    __syncthreads();
    float off = 0.f;
#pragma unroll
    for (int s = 0; s < 3; ++s) off += (s < seg) ? SEG[s * 128 + kk] : 0.f;
#pragma unroll
    for (int i = 0; i < 16; ++i) BC[(16 * seg + i) * 128 + kk] = v[i] + off;
    __syncthreads();
}
__device__ __forceinline__ bf16x8 as_bf16x8(u32x4 v) { return __builtin_bit_cast(bf16x8, v); }
__device__ __forceinline__ bf16x8 cat4(bf16x4 lo, bf16x4 hi) { return __builtin_shufflevector(lo, hi, 0, 1, 2, 3, 4, 5, 6, 7); }

__device__ __forceinline__ void p2a(Frame& F, const Params& p) {
    const bf16_t* Z = (const bf16_t*)(F.ws + WS_Z);
    bf16_t* AN = (bf16_t*)(F.ws + WS_AN); float* DN = (float*)(F.ws + WS_DN);
    const bf16_t* WaT = (const bf16_t*)(F.ws + WS_WAT); const bf16_t* WiT = (const bf16_t*)(F.ws + WS_WIT);
    LAS float* BC = (LAS float*)(F.lds); LAS float* SEG = (LAS float*)(F.lds + 32768);
    LAS bf16_t* KDT = (LAS bf16_t*)(F.lds + 34816); LAS bf16_t* VT = (LAS bf16_t*)(F.lds + 53248); LAS bf16_t* XC = (LAS bf16_t*)(F.lds + 90112);
    const int w = F.wave;
    LAS float* GLR = (LAS float*)(F.lds + 90112);
    LAS float* GL = (LAS float*)(F.lds + 124928);
    const float* wg = p.in[I_GWG]; const float* bgp = p.in[I_GBG];
    for (int unit = blockIdx.x; unit < NCHUNK; unit += F.G) {
        const int b = unit >> 7, n = unit & 127, tok0 = b * SEQL + 64 * n;
        {
            const int lane = fresh_lane(), r16 = lane & 15, q4 = lane >> 4;
            const bf16_t* Hb = (const bf16_t*)(F.ws + WS_H) + (size_t)(tok0 + r16) * DM + 256 * w + 8 * q4;
            const bf16_t* Wb = (const bf16_t*)(F.ws + WS_WGLT) + (size_t)r16 * DM + 256 * w + 8 * q4;
            f32x4 gacc[4];
#pragma unroll
            for (int mb = 0; mb < 4; ++mb) gacc[mb] = (f32x4){0.f, 0.f, 0.f, 0.f};
#pragma unroll
            for (int sb = 0; sb < 2; ++sb) { bf16x8 af[4][4], bfr[4];
#pragma unroll
                for (int s4 = 0; s4 < 4; ++s4) { bfr[s4] = *(const bf16x8*)(Wb + 32 * (4 * sb + s4));
#pragma unroll
                    for (int mb = 0; mb < 4; ++mb) af[s4][mb] = *(const bf16x8*)(Hb + (size_t)(16 * mb) * DM + 32 * (4 * sb + s4)); }
#pragma unroll
                for (int s4 = 0; s4 < 4; ++s4)
#pragma unroll
                    for (int mb = 0; mb < 4; ++mb) gacc[mb] = __builtin_amdgcn_mfma_f32_16x16x32_bf16(af[s4][mb], bfr[s4], gacc[mb], 0, 0, 0); }
#pragma unroll
            for (int mb = 0; mb < 4; ++mb)
#pragma unroll
                for (int q = 0; q < 4; ++q) GLR[(w * 64 + 16 * mb + 4 * q4 + q) * 16 + r16] = gacc[mb][q];
            __syncthreads();
            const int tid2 = w * 64 + lane;
#pragma unroll
            for (int it = 0; it < 2; ++it) { const int o = tid2 + 512 * it; float sacc = 0.f;
#pragma unroll
                for (int w2 = 0; w2 < 8; ++w2) sacc += GLR[w2 * 1024 + o];
                GL[o] = sacc; ((float*)(F.ws + WS_LG))[(size_t)tok0 * 16 + o] = sacc; }
            __syncthreads();
        }
        for (int h = 0; h < 4; ++h) {
            int lane = fresh_lane(), tid = F.wave * 64 + lane;
            int r = lane & 31, hh = lane >> 5;
            GlaW gw_; gla_load_w(wg, bgp, h, tid, gw_);
            u32x4 kvr[2], vvr[4];
#pragma unroll
            for (int it = 0; it < 2; ++it) { const int item = tid + 512 * it, t = item & 63, kk8 = item >> 6; kvr[it] = *(const u32x4*)(Z + (size_t)(tok0 + t) * ZC + ZK + h * 128 + kk8 * 8); }
#pragma unroll
            for (int it = 0; it < 4; ++it) { const int item = tid + 512 * it, t = item & 63, vc8 = item >> 6; vvr[it] = *(const u32x4*)(Z + (size_t)(tok0 + t) * ZC + ZV + h * 256 + vc8 * 8); }
            gla_cumsum(GL, gw_, BC, SEG, tid);
            const int uh = (b * 4 + h) * 128 + n;
            if (tid < 128) DN[(size_t)uh * 128 + tid] = __expf(BC[63 * 128 + tid]);
#pragma unroll
            for (int it = 0; it < 2; ++it) { const int item = tid + 512 * it, t = item & 63, kk8 = item >> 6;
                const u32x4 kv = kvr[it];
#pragma unroll
                for (int i = 0; i < 8; ++i) { const int kk = kk8 * 8 + i; const unsigned wv = kv[i >> 1]; const float kf = (i & 1) ? bfhi(wv) : bflo(wv);
                    const float d = __expf(BC[63 * 128 + kk] - BC[t * 128 + kk]); KDT[kk * 72 + t] = (bf16_t)f2bf(kf * d); } }
#pragma unroll
            for (int it = 0; it < 4; ++it) { const int item = tid + 512 * it, t = item & 63, vc8 = item >> 6;
                const u32x4 vv = vvr[it];
#pragma unroll
                for (int i = 0; i < 8; ++i) { const unsigned wv = vv[i >> 1]; VT[(vc8 * 8 + i) * 72 + t] = (bf16_t)((i & 1) ? (wv >> 16) : (wv & 0xffffu)); } }
#ifndef P2A_NO_LRU
            u32x4 lv[7]; f32x4 cwv[4][2], cbv[2];
            { const float* cw = p.in[I_CW]; const float* cb = p.in[I_CB]; const int c8 = tid & 31, tq = tid >> 5, chc = h * 256 + c8 * 8;
#pragma unroll
              for (int i = 0; i < 7; ++i) { const int sq = 64 * n + 4 * tq - 3 + i;
                  lv[i] = (sq >= 0) ? *(const u32x4*)(Z + (size_t)(tok0 + 4 * tq - 3 + i) * ZC + ZLX + chc) : (u32x4){0u, 0u, 0u, 0u}; }
#pragma unroll
              for (int i = 0; i < 4; ++i) { cwv[i][0] = *(const f32x4*)(cw + i * 1024 + chc); cwv[i][1] = *(const f32x4*)(cw + i * 1024 + chc + 4); }
              cbv[0] = *(const f32x4*)(cb + chc); cbv[1] = *(const f32x4*)(cb + chc + 4); }
#endif
            __syncthreads();
            {
                f32x16 acc[4];
#pragma unroll
                for (int mb = 0; mb < 4; ++mb)
#pragma unroll
                    for (int q = 0; q < 16; ++q) acc[mb][q] = 0.f;
#pragma unroll
                for (int s = 0; s < 4; ++s) { const bf16x8 bfr = *(const LAS bf16x8*)(VT + (32 * w + r) * 72 + 16 * s + 8 * hh);
#pragma unroll
                    for (int mb = 0; mb < 4; ++mb) { const bf16x8 afr = *(const LAS bf16x8*)(KDT + (32 * mb + r) * 72 + 16 * s + 8 * hh);
                        acc[mb] = __builtin_amdgcn_mfma_f32_32x32x16_bf16(afr, bfr, acc[mb], 0, 0, 0); } }
                bf16_t* base = AN + (size_t)uh * 32768;
#pragma unroll
                for (int mb = 0; mb < 4; ++mb)
#pragma unroll
                    for (int s2 = 0; s2 < 2; ++s2) { u32x4 o;
#pragma unroll
                        for (int q = 0; q < 4; ++q) o[q] = pk2(acc[mb][8 * s2 + 2 * q], acc[mb][8 * s2 + 2 * q + 1]);
                        *(u32x4*)(base + (((mb * 8 + w) * 2 + s2) * 64 + lane) * 8) = o; }
            }
#ifndef P2A_NO_LRU
            {
                {
                    const int c8 = tid & 31, tq = tid >> 5;
#pragma unroll
                    for (int it = 0; it < 4; ++it) { float xc[8];
#pragma unroll
                        for (int q = 0; q < 4; ++q) { xc[q] = cbv[0][q]; xc[4 + q] = cbv[1][q]; }
#pragma unroll
                        for (int i = 0; i < 4; ++i) { const u32x4 l4 = lv[it + i];
                            xc[0] += bflo(l4[0]) * cwv[i][0][0]; xc[1] += bfhi(l4[0]) * cwv[i][0][1]; xc[2] += bflo(l4[1]) * cwv[i][0][2]; xc[3] += bfhi(l4[1]) * cwv[i][0][3];
                            xc[4] += bflo(l4[2]) * cwv[i][1][0]; xc[5] += bfhi(l4[2]) * cwv[i][1][1]; xc[6] += bflo(l4[3]) * cwv[i][1][2]; xc[7] += bfhi(l4[3]) * cwv[i][1][3]; }
                        u32x4 o; o.x = pk2(xc[0], xc[1]); o.y = pk2(xc[2], xc[3]); o.z = pk2(xc[4], xc[5]); o.w = pk2(xc[6], xc[7]);
                        *(LAS u32x4*)(XC + (4 * tq + it) * 264 + c8 * 8) = o; }
                }
                __builtin_amdgcn_sched_barrier(0);
                bf16x8 ba[16], bi[16];
                { const bf16_t* wa = WaT + (size_t)h * 65536 + (size_t)(32 * w + r) * 256 + 8 * hh;
                  const bf16_t* wi = WiT + (size_t)h * 65536 + (size_t)(32 * w + r) * 256 + 8 * hh;
#pragma unroll
                  for (int s = 0; s < 16; ++s) { ba[s] = *(const bf16x8*)(wa + 16 * s); bi[s] = *(const bf16x8*)(wi + 16 * s); } }
                const int ch = h * 256 + 32 * w + r;
                const float ba_ = p.in[I_BA][ch], bi_ = p.in[I_BI][ch]; const float L = p.in[I_AP][ch];
                __syncthreads();
                f32x16 aa[2], ai[2];
#pragma unroll
                for (int mb = 0; mb < 2; ++mb)
#pragma unroll
                    for (int q = 0; q < 16; ++q) { aa[mb][q] = 0.f; ai[mb][q] = 0.f; }
#pragma unroll
                for (int s = 0; s < 16; ++s) {
#pragma unroll
                    for (int mb = 0; mb < 2; ++mb) { const bf16x8 af = *(const LAS bf16x8*)(XC + (32 * mb + r) * 264 + 16 * s + 8 * hh);
                        aa[mb] = __builtin_amdgcn_mfma_f32_32x32x16_bf16(af, ba[s], aa[mb], 0, 0, 0); } }
                __builtin_amdgcn_sched_barrier(0);
#pragma unroll
                for (int s = 0; s < 16; ++s) {
#pragma unroll
                    for (int mb = 0; mb < 2; ++mb) { const bf16x8 af = *(const LAS bf16x8*)(XC + (32 * mb + r) * 264 + 16 * s + 8 * hh);
                        ai[mb] = __builtin_amdgcn_mfma_f32_32x32x16_bf16(af, bi[s], ai[mb], 0, 0, 0); } }
                const float sp = fmaxf(-L, 0.f) + log1pf(__expf(-fabsf(L)));
#pragma unroll
                for (int mb = 0; mb < 2; ++mb)
#pragma unroll
                    for (int q = 0; q < 16; ++q) { const int t = 32 * mb + (q & 3) + 8 * (q >> 2) + 4 * hh;
                        if ((q & 3) == 0) __builtin_amdgcn_sched_barrier(0);
                        const float ga = sigmoidf_(aa[mb][q] + ba_), gi = sigmoidf_(ai[mb][q] + bi_);
                        const float la = -8.0f * ga * sp; const float a = __expf(la);
                        const float xcv = bf2f(XC[t * 264 + 32 * w + r]);
                        aa[mb][q] = a; ai[mb][q] = xcv * gi * __builtin_amdgcn_sqrtf(fmaxf(1.0f - a * a, 0.f)); }
#pragma unroll
                for (int mb = 0; mb < 2; ++mb)
#pragma unroll
                    for (int g = 0; g < 4; ++g)
#pragma unroll
                        for (int i = 1; i < 4; ++i) { const int q = 4 * g + i; ai[mb][q] = aa[mb][q] * ai[mb][q - 1] + ai[mb][q]; aa[mb][q] = aa[mb][q] * aa[mb][q - 1]; }
                LAS bf16_t* HL = (LAS bf16_t*)(F.lds); LAS bf16_t* AC = (LAS bf16_t*)(F.lds + 34816);
                float carryH = 0.f, carryP = 1.f;
#pragma unroll
                for (int mb = 0; mb < 2; ++mb)
#pragma unroll
                    for (int g = 0; g < 4; ++g) { const float myP = aa[mb][4 * g + 3], myH = ai[mb][4 * g + 3];
                        const float pP = __shfl_xor(myP, 32), pH = __shfl_xor(myH, 32);
                        const float fP = hh ? pP : myP, fH = hh ? pH : myH, sP = hh ? myP : pP, sH = hh ? myH : pH;
                        const float c1H = fP * carryH + fH, c1P = carryP * fP;
                        const float Cin = hh ? c1H : carryH, Pin = hh ? c1P : carryP;
                        carryH = sP * c1H + sH; carryP = c1P * sP;
#pragma unroll
                        for (int i = 0; i < 4; ++i) { const int q = 4 * g + i, t = 32 * mb + 8 * g + 4 * hh + i;
                            HL[t * 264 + 32 * w + r] = (bf16_t)f2bf(ai[mb][q] + aa[mb][q] * Cin); AC[t * 264 + 32 * w + r] = (bf16_t)f2bf(aa[mb][q] * Pin); } }
                if (hh == 0) { float* SUMA = (float*)(F.ws + WS_SUMA); float* SUMH = (float*)(F.ws + WS_SUMH); SUMA[unit * 1024 + ch] = carryP; SUMH[unit * 1024 + ch] = carryH; }
                __syncthreads();
                { bf16_t* HLOC = (bf16_t*)(F.ws + WS_AUA); bf16_t* ACUM = (bf16_t*)(F.ws + WS_AUU);
#pragma unroll
                  for (int it = 0; it < 4; ++it) { const int item = tid + 512 * it, c8 = item & 31, t = item >> 5; const size_t o = (size_t)(tok0 + t) * 1024 + h * 256 + c8 * 8;
                      *(u32x4*)(HLOC + o) = *(const LAS u32x4*)(HL + t * 264 + c8 * 8); *(u32x4*)(ACUM + o) = *(const LAS u32x4*)(AC + t * 264 + c8 * 8); } }
            }
#endif
            __syncthreads();
        }
    }
}

__device__ __forceinline__ void p2b(Frame& F, const Params& p) {
    const bf16_t* AN = (const bf16_t*)(F.ws + WS_AN); const float* DN = (const float*)(F.ws + WS_DN); bf16_t* SP = (bf16_t*)(F.ws + WS_SP);
    if (F.tid < 128) {
        for (int st = (int)blockIdx.x * 128 + F.tid; st < 32768; st += F.G * 128) {
            const int bh = st >> 12, rem = st & 4095, ln = rem & 63, s2 = (rem >> 6) & 1, w = (rem >> 7) & 7, mb = (rem >> 10) & 3;
            const int kk0 = 32 * mb + 16 * s2 + 4 * (ln >> 5);
            const int offS = (((mb * 8 + w) * 2 + s2) * 64 + ln) * 8;
            f32x4 S0 = (f32x4){0.f, 0.f, 0.f, 0.f}, S1 = S0;
            for (int n0 = 0; n0 < 128; n0 += 16) {
                u32x4 av[16]; f32x4 d0[16], d1[16];
#pragma unroll
                for (int i = 0; i < 16; ++i) { const size_t uh = (size_t)bh * 128 + n0 + i;
                    av[i] = *(const u32x4*)(AN + uh * 32768 + offS);
                    d0[i] = *(const f32x4*)(DN + uh * 128 + kk0); d1[i] = *(const f32x4*)(DN + uh * 128 + kk0 + 8); }
#pragma unroll
                for (int i = 0; i < 16; ++i) { const size_t uh = (size_t)bh * 128 + n0 + i;
                    u32x4 o; o.x = pk2(S0[0], S0[1]); o.y = pk2(S0[2], S0[3]); o.z = pk2(S1[0], S1[1]); o.w = pk2(S1[2], S1[3]);
                    *(u32x4*)(SP + uh * 32768 + offS) = o;
                    const f32x4 a0 = (f32x4){bflo(av[i].x), bfhi(av[i].x), bflo(av[i].y), bfhi(av[i].y)}, a1 = (f32x4){bflo(av[i].z), bfhi(av[i].z), bflo(av[i].w), bfhi(av[i].w)};
                    S0 = d0[i] * S0 + a0; S1 = d1[i] * S1 + a1; } }
        }
    } else if (F.wave == 2) {
        const float* SUMA = (const float*)(F.ws + WS_SUMA); float* SUMH = (float*)(F.ws + WS_SUMH);
        for (int wv = (int)blockIdx.x; wv < 64; wv += F.G) {
            const int seg = F.lane >> 4, sid = wv * 16 + (F.lane & 15), b = sid >> 9, ch = 2 * (sid & 511);
            const size_t o0 = (size_t)(b * 128 + seg * 32) * 1024 + ch;
            f32x2 a[32], hv[32];
#pragma unroll
            for (int q = 0; q < 32; ++q) { a[q] = *(const f32x2*)(SUMA + o0 + (size_t)q * 1024); hv[q] = *(const f32x2*)(SUMH + o0 + (size_t)q * 1024); }
            f32x2 A = (f32x2){1.f, 1.f}, H = (f32x2){0.f, 0.f};
#pragma unroll
            for (int q = 0; q < 32; ++q) { H = a[q] * H + hv[q]; A = a[q] * A; }
            f32x2 hc = (f32x2){0.f, 0.f};
#pragma unroll
            for (int k = 0; k < 3; ++k) { const int src = k * 16 + (F.lane & 15);
                const f32x2 Ak = (f32x2){__shfl(A.x, src), __shfl(A.y, src)}, Hk = (f32x2){__shfl(H.x, src), __shfl(H.y, src)};
                if (k < seg) hc = Ak * hc + Hk; }
#pragma unroll
            for (int q = 0; q < 32; ++q) { *(f32x2*)(SUMH + o0 + (size_t)q * 1024) = hc; hc = a[q] * hc + hv[q]; }
        }
    }
}

__device__ __forceinline__ void p2c(Frame& F, const Params& p) {
    const bf16_t* Z = (const bf16_t*)(F.ws + WS_Z); const float* GLOW = (const float*)(F.ws + WS_LG); const bf16_t* SP = (const bf16_t*)(F.ws + WS_SP);
    LAS float* GL = (LAS float*)(F.lds + 124928); const float* wg = p.in[I_GWG]; const float* bgp = p.in[I_GBG];
    bf16_t* MIX = (bf16_t*)(F.ws + WS_MIX);
    LAS float* BC = (LAS float*)(F.lds); LAS float* SEG = (LAS float*)(F.lds + 32768);
    LAS bf16_t* QE = (LAS bf16_t*)(F.lds + 34816); LAS bf16_t* KE = (LAS bf16_t*)(F.lds + 52224); LAS bf16_t* VT = (LAS bf16_t*)(F.lds + 69632);
    LAS float* SSQ = (LAS float*)(F.lds + 106496); LAS float* OS = (LAS float*)(F.lds);
    const int w = F.wave;
    const float* gng = p.in[I_GNG];
    for (int unit = blockIdx.x; unit < NCHUNK; unit += F.G) {
        const int b = unit >> 7, n = unit & 127, tok0 = b * SEQL + 64 * n;
        const int lane = fresh_lane(), tid = w * 64 + lane, r = lane & 31, hh = lane >> 5;
        const f32x2 gq = *(const f32x2*)(GLOW + (size_t)tok0 * 16 + 2 * tid);
        { const float* SUMH = (const float*)(F.ws + WS_SUMH);
          const int ch = 2 * tid; const f32x2 hc = *(const f32x2*)(SUMH + (size_t)unit * 1024 + ch);
          const bf16_t* HLOC = (const bf16_t*)(F.ws + WS_AUA); const bf16_t* ACUM = (const bf16_t*)(F.ws + WS_AUU);
          unsigned hv[16], av[16], lgw[16];
#pragma unroll
          for (int i = 0; i < 16; ++i) { const size_t tok = (size_t)tok0 + i;
              hv[i] = *(const unsigned*)(HLOC + tok * 1024 + ch); av[i] = *(const unsigned*)(ACUM + tok * 1024 + ch); lgw[i] = *(const unsigned*)(Z + tok * ZC + ZLG + ch); }
#pragma unroll 1
          for (int t0 = 0; t0 < 64; t0 += 16) {
              unsigned hc_[16], ac_[16], lc_[16];
#pragma unroll
              for (int i = 0; i < 16; ++i) { hc_[i] = hv[i]; ac_[i] = av[i]; lc_[i] = lgw[i]; }
              if (t0 + 16 < 64) {
#pragma unroll
                  for (int i = 0; i < 16; ++i) { const size_t tok = (size_t)tok0 + t0 + 16 + i;
                      hv[i] = *(const unsigned*)(HLOC + tok * 1024 + ch); av[i] = *(const unsigned*)(ACUM + tok * 1024 + ch); lgw[i] = *(const unsigned*)(Z + tok * ZC + ZLG + ch); } }
#pragma unroll
              for (int i = 0; i < 16; ++i) { const size_t tok = (size_t)tok0 + t0 + i;
                  const float h0 = bflo(hc_[i]) + bflo(ac_[i]) * hc.x, h1 = bfhi(hc_[i]) + bfhi(ac_[i]) * hc.y;
                  *(unsigned*)(MIX + tok * DM + 1024 + ch) = pk2(h0 * gelu_tanh_f(bflo(lc_[i])), h1 * gelu_tanh_f(bfhi(lc_[i]))); } } }
        *(LAS f32x2*)(GL + 2 * tid) = gq;
        __syncthreads();
        for (int h = 0; h < 4; ++h) {
            const int uh = (b * 4 + h) * 128 + n;
            GlaW gw_; gla_load_w(wg, bgp, h, tid, gw_);
            u32x4 qvr[2], kvr[2], vvr[4];
#pragma unroll
            for (int it = 0; it < 2; ++it) { const int item = tid + 512 * it, kk8 = item & 15, t = item >> 4;
                qvr[it] = *(const u32x4*)(Z + (size_t)(tok0 + t) * ZC + ZQ + h * 128 + kk8 * 8); kvr[it] = *(const u32x4*)(Z + (size_t)(tok0 + t) * ZC + ZK + h * 128 + kk8 * 8); }
#pragma unroll
            for (int it = 0; it < 4; ++it) { const int item = tid + 512 * it, t = item & 63, vc8 = item >> 6; vvr[it] = *(const u32x4*)(Z + (size_t)(tok0 + t) * ZC + ZV + h * 256 + vc8 * 8); }
            gla_cumsum(GL, gw_, BC, SEG, tid);
            bf16x8 sf[4][2];
            { const bf16_t* spu = SP + (size_t)uh * 32768;
#pragma unroll
              for (int mb = 0; mb < 4; ++mb)
#pragma unroll
                  for (int s2 = 0; s2 < 2; ++s2) sf[mb][s2] = *(const bf16x8*)(spu + (((mb * 8 + w) * 2 + s2) * 64 + lane) * 8); }
#pragma unroll
            for (int it = 0; it < 2; ++it) { const int item = tid + 512 * it, kk8 = item & 15, t = item >> 4;
                const u32x4 qv = qvr[it];
                const u32x4 kv = kvr[it];
                const f32x4 b0 = *(const LAS f32x4*)(BC + t * 128 + kk8 * 8), b1 = *(const LAS f32x4*)(BC + t * 128 + kk8 * 8 + 4);
                float qe[8], ke[8];
#pragma unroll
                for (int i = 0; i < 8; ++i) { const float bb = (i < 4) ? b0[i & 3] : b1[i & 3]; const unsigned qw = qv[i >> 1], kw = kv[i >> 1];
                    const float qf = (i & 1) ? bfhi(qw) : bflo(qw), kf = (i & 1) ? bfhi(kw) : bflo(kw);
                    qe[i] = qf * 0.08838834764831845f * __expf(bb); ke[i] = kf * __expf(-bb); }
                u32x4 oq, ok; oq.x = pk2(qe[0], qe[1]); oq.y = pk2(qe[2], qe[3]); oq.z = pk2(qe[4], qe[5]); oq.w = pk2(qe[6], qe[7]);
                ok.x = pk2(ke[0], ke[1]); ok.y = pk2(ke[2], ke[3]); ok.z = pk2(ke[4], ke[5]); ok.w = pk2(ke[6], ke[7]);
                *(LAS u32x4*)(QE + t * 136 + kk8 * 8) = oq; *(LAS u32x4*)(KE + t * 136 + kk8 * 8) = ok; }
#pragma unroll
            for (int it = 0; it < 4; ++it) { const int item = tid + 512 * it, t = item & 63, vc8 = item >> 6;
                const u32x4 vv = vvr[it];
#pragma unroll
                for (int i = 0; i < 8; ++i) { const unsigned wv = vv[i >> 1]; VT[(vc8 * 8 + i) * 72 + t] = (bf16_t)((i & 1) ? (wv >> 16) : (wv & 0xffffu)); } }
            __syncthreads();
            f32x16 oacc[2];
            {
                f32x16 P00, P01, P11;
#pragma unroll
                for (int q = 0; q < 16; ++q) { P00[q] = 0.f; P01[q] = 0.f; P11[q] = 0.f; oacc[0][q] = 0.f; oacc[1][q] = 0.f; }
#pragma unroll
                for (int s = 0; s < 8; ++s) {
                    const bf16x8 a0 = *(const LAS bf16x8*)(KE + r * 136 + 16 * s + 8 * hh), a1 = *(const LAS bf16x8*)(KE + (32 + r) * 136 + 16 * s + 8 * hh);
                    const bf16x8 b0 = *(const LAS bf16x8*)(QE + r * 136 + 16 * s + 8 * hh), b1 = *(const LAS bf16x8*)(QE + (32 + r) * 136 + 16 * s + 8 * hh);
                    P00 = __builtin_amdgcn_mfma_f32_32x32x16_bf16(a0, b0, P00, 0, 0, 0);
                    P01 = __builtin_amdgcn_mfma_f32_32x32x16_bf16(a0, b1, P01, 0, 0, 0);
                    P11 = __builtin_amdgcn_mfma_f32_32x32x16_bf16(a1, b1, P11, 0, 0, 0); }
#pragma unroll
                for (int q = 0; q < 16; ++q) { const int jl = (q & 3) + 8 * (q >> 2) + 4 * hh; if (jl > r) { P00[q] = 0.f; P11[q] = 0.f; } }
                bf16x8 F00[2], F01[2], F11[2];
#pragma unroll
                for (int s2 = 0; s2 < 2; ++s2) {
                    u32x4 t0, t1, t2;
#pragma unroll
                    for (int q = 0; q < 4; ++q) { t0[q] = pk2(P00[8 * s2 + 2 * q], P00[8 * s2 + 2 * q + 1]); t1[q] = pk2(P01[8 * s2 + 2 * q], P01[8 * s2 + 2 * q + 1]); t2[q] = pk2(P11[8 * s2 + 2 * q], P11[8 * s2 + 2 * q + 1]); }
                    F00[s2] = as_bf16x8(t0); F01[s2] = as_bf16x8(t1); F11[s2] = as_bf16x8(t2); }
#pragma unroll
                for (int mb = 0; mb < 4; ++mb)
#pragma unroll
                    for (int s2 = 0; s2 < 2; ++s2) { const bf16x8 af = sf[mb][s2];
                        const int kkb = 32 * mb + 16 * s2 + 4 * hh;
#pragma unroll
                        for (int ib = 0; ib < 2; ++ib) { const bf16x4 lo = *(const LAS bf16x4*)(QE + (32 * ib + r) * 136 + kkb), hi = *(const LAS bf16x4*)(QE + (32 * ib + r) * 136 + kkb + 8);
                            oacc[ib] = __builtin_amdgcn_mfma_f32_32x32x16_bf16(af, cat4(lo, hi), oacc[ib], 0, 0, 0); } }
#pragma unroll
                for (int s2 = 0; s2 < 2; ++s2) {
                    const int tb0 = 16 * s2 + 4 * hh, tb1 = 32 + 16 * s2 + 4 * hh;
                    const bf16x8 v0 = cat4(*(const LAS bf16x4*)(VT + (32 * w + r) * 72 + tb0), *(const LAS bf16x4*)(VT + (32 * w + r) * 72 + tb0 + 8));
                    const bf16x8 v1 = cat4(*(const LAS bf16x4*)(VT + (32 * w + r) * 72 + tb1), *(const LAS bf16x4*)(VT + (32 * w + r) * 72 + tb1 + 8));
                    oacc[0] = __builtin_amdgcn_mfma_f32_32x32x16_bf16(v0, F00[s2], oacc[0], 0, 0, 0);
                    oacc[1] = __builtin_amdgcn_mfma_f32_32x32x16_bf16(v0, F01[s2], oacc[1], 0, 0, 0);
                    oacc[1] = __builtin_amdgcn_mfma_f32_32x32x16_bf16(v1, F11[s2], oacc[1], 0, 0, 0); }
            }
            u32x4 rvr[4];
#pragma unroll
            for (int it = 0; it < 4; ++it) { const int item = tid + 512 * it, vc8 = item & 31, t = item >> 5; rvr[it] = *(const u32x4*)(Z + (size_t)(tok0 + t) * ZC + ZR + h * 256 + vc8 * 8); }
#pragma unroll
            for (int ib = 0; ib < 2; ++ib) { float sq = 0.f;
#pragma unroll
                for (int q = 0; q < 16; ++q) sq += oacc[ib][q] * oacc[ib][q];
                sq += __shfl_xor(sq, 32);
                if (hh == 0) SSQ[w * 64 + 32 * ib + r] = sq; }
            __syncthreads();
#pragma unroll
            for (int ib = 0; ib < 2; ++ib) { float tot = 0.f;
#pragma unroll
                for (int w2 = 0; w2 < 8; ++w2) tot += SSQ[w2 * 64 + 32 * ib + r];
                const float rs = rsqrtf_(tot * (1.0f / 256.0f) + 1e-6f);
#pragma unroll
                for (int g = 0; g < 4; ++g) *(LAS f32x4*)(OS + (32 * ib + r) * 260 + 32 * w + 8 * g + 4 * hh) =
                    (f32x4){oacc[ib][4 * g] * rs, oacc[ib][4 * g + 1] * rs, oacc[ib][4 * g + 2] * rs, oacc[ib][4 * g + 3] * rs}; }
            __syncthreads();
#pragma unroll
            for (int it = 0; it < 4; ++it) { const int item = tid + 512 * it, vc8 = item & 31, t = item >> 5; const int c = h * 256 + vc8 * 8;
                const f32x4 o0 = *(const LAS f32x4*)(OS + t * 260 + vc8 * 8), o1 = *(const LAS f32x4*)(OS + t * 260 + vc8 * 8 + 4);
                const u32x4 rv = rvr[it];
                const f32x4 g0 = *(const f32x4*)(gng + c), g1 = *(const f32x4*)(gng + c + 4);
                float o[8];
#pragma unroll
                for (int i = 0; i < 8; ++i) { const unsigned rw = rv[i >> 1]; const float rf = (i & 1) ? bfhi(rw) : bflo(rw);
                    const float sil = rf * sigmoidf_(rf); o[i] = sil * ((i < 4) ? o0[i & 3] * g0[i & 3] : o1[i & 3] * g1[i & 3]); }
                u32x4 ov; ov.x = pk2(o[0], o[1]); ov.y = pk2(o[2], o[3]); ov.z = pk2(o[4], o[5]); ov.w = pk2(o[6], o[7]);
                *(u32x4*)(MIX + (size_t)(tok0 + t) * DM + c) = ov; }
            __syncthreads();
        }
    }
}

__device__ __forceinline__ void build_moe_tables(Frame& F) {
    unsigned* cnt = (unsigned*)(F.ws + WS_CTL) + CW_CNT;
    if (F.tid < 64) {
        const int e = F.tid; const int c = (e < NEXP) ? (int)xb_ld(cnt + 64 * e) : 0; const int mt = (c + 255) >> 8;
        int inc = mt;
#pragma unroll
        for (int d = 1; d < 32; d <<= 1) { const int o = __shfl_up(inc, d); if ((e & 63) >= d) inc += o; }
        const int first = inc - mt;
        if (e < NEXP) { F.MISC[MI_PBASE + e] = (unsigned)(first * 256); F.MISC[MI_CNT + e] = (unsigned)c;
            for (int q = 0; q < mt; ++q) F.MISC[MI_T2E + first + q] = (unsigned)e;
            if (e == NEXP - 1) F.MISC[MI_NMT] = (unsigned)inc; }
    }
    __syncthreads();
}

__device__ __forceinline__ void p4a(Frame& F, const Params& p) {
    const bf16_t* XMID = (const bf16_t*)(F.ws + WS_XMID); const float* WrT = (const float*)(F.ws + WS_WRT); const float* br = p.in[I_BR];
    float* RSTD = (float*)(F.ws + WS_RSTD); unsigned* TOKE = (unsigned*)(F.ws + WS_TOKE); float* GATES = (float*)(F.ws + WS_GATES);
    unsigned* cnt = (unsigned*)(F.ws + WS_CTL) + CW_CNT;
    unsigned char* HF8 = F.ws + WS_HF8; unsigned short* LIST = (unsigned short*)(F.ws + WS_LIST); const float* gf = p.in[I_NFG];
    LAS float* RED = (LAS float*)(F.lds); LAS float* SSQ2 = (LAS float*)(F.lds + 32768); LAS float* LGT = (LAS float*)(F.lds + 33792); LAS float* RS = (LAS float*)(F.lds + 38016);
    const int tid = F.tid, lane = F.lane, w = F.wave, m = lane & 31, kh = lane >> 5;
    if (tid < 32) F.MISC[MI_LCNT + tid] = 0u;
    __syncthreads();
    bf16x8 bh[16], bl[16];
    { const float* bp = WrT + (size_t)m * DM + 256 * w + 128 * kh;
#pragma unroll
      for (int c = 0; c < 16; ++c) { const f32x4 w0 = *(const f32x4*)(bp + 8 * c), w1 = *(const f32x4*)(bp + 8 * c + 4);
          u32x4 hi, lo; hi.x = pk2(w0[0], w0[1]); hi.y = pk2(w0[2], w0[3]); hi.z = pk2(w1[0], w1[1]); hi.w = pk2(w1[2], w1[3]);
          lo.x = pk2(w0[0] - bflo(hi.x), w0[1] - bfhi(hi.x)); lo.y = pk2(w0[2] - bflo(hi.y), w0[3] - bfhi(hi.y)); lo.z = pk2(w1[0] - bflo(hi.z), w1[1] - bfhi(hi.z)); lo.w = pk2(w1[2] - bflo(hi.w), w1[3] - bfhi(hi.w));
          bh[c] = as_bf16x8(hi); bl[c] = as_bf16x8(lo); } }
    LAS float* RSA = (LAS float*)(F.lds + 38400);
    int ui = 0;
    for (int ut = blockIdx.x; ut < T / 32; ut += F.G, ++ui) {
        const int m0 = 32 * ut; const int kw = 256 * w + 128 * kh;
        f32x16 acc;
#pragma unroll
        for (int q = 0; q < 16; ++q) acc[q] = 0.f;
        float ss = 0.f;
        const bf16_t* ap = XMID + (size_t)(m0 + m) * DM + kw;
        u32x4 ar[16];
#pragma unroll
        for (int c = 0; c < 16; ++c) ar[c] = *(const u32x4*)(ap + 8 * c);
#pragma unroll
        for (int c = 0; c < 16; ++c) { const u32x4 r0 = ar[c];
            const f32x4 a0 = (f32x4){bflo(r0.x), bfhi(r0.x), bflo(r0.y), bfhi(r0.y)}, a1 = (f32x4){bflo(r0.z), bfhi(r0.z), bflo(r0.w), bfhi(r0.w)};
            acc = __builtin_amdgcn_mfma_f32_32x32x16_bf16(as_bf16x8(r0), bh[c], acc, 0, 0, 0);
            acc = __builtin_amdgcn_mfma_f32_32x32x16_bf16(as_bf16x8(r0), bl[c], acc, 0, 0, 0);
            ss += (a0[0] * a0[0] + a0[1] * a0[1]) + (a0[2] * a0[2] + a0[3] * a0[3]) + (a1[0] * a1[0] + a1[1] * a1[1]) + (a1[2] * a1[2] + a1[3] * a1[3]); }
        ss += __shfl_xor(ss, 32);
#pragma unroll
        for (int q = 0; q < 16; ++q) RED[(w * 16 + q) * 64 + lane] = acc[q];
        if (kh == 0) SSQ2[w * 32 + m] = ss;
        __syncthreads();
#pragma unroll
        for (int it = 0; it < 2; ++it) { const int o = tid + 512 * it, reg = o >> 6, ln = o & 63, nn = ln & 31, h2 = ln >> 5; const int mm = (reg & 3) + 8 * (reg >> 2) + 4 * h2;
            float v = 0.f, s2 = 0.f;
#pragma unroll
            for (int w2 = 0; w2 < 8; ++w2) { v += RED[(w2 * 16 + reg) * 64 + ln]; s2 += SSQ2[w2 * 32 + mm]; }
            const float rs = rsqrtf_(s2 * (1.0f / DM) + 1e-6f);
            LGT[mm * 33 + nn] = v * rs + br[nn]; if (nn == 0) { RS[mm] = rs; RSA[32 * ui + mm] = rs; } }
        __syncthreads();
        int ex[4]; unsigned ls[4]; float gt[4];
        if (tid < 32) {
            float l[32];
#pragma unroll
            for (int i = 0; i < 32; ++i) l[i] = LGT[tid * 33 + i];
            float val[4];
#pragma unroll
            for (int k = 0; k < 4; ++k) { float best = -3.0e38f; int bi = 0;
#pragma unroll
                for (int i = 0; i < 32; ++i) if (l[i] > best) { best = l[i]; bi = i; }
                ex[k] = bi; val[k] = best;
#pragma unroll
                for (int i = 0; i < 32; ++i) if (i == bi) l[i] = -3.0e38f; }
            float s = 0.f;
#pragma unroll
            for (int k = 0; k < 4; ++k) { gt[k] = __expf(val[k] - val[0]); s += gt[k]; }
            const float inv = __builtin_amdgcn_rcpf(s);
#pragma unroll
            for (int k = 0; k < 4; ++k) { gt[k] *= inv; ls[k] = __hip_atomic_fetch_add((LAS unsigned*)(F.MISC + MI_LCNT + ex[k]), 1u, __ATOMIC_RELAXED, __HIP_MEMORY_SCOPE_WORKGROUP); }
        }
        __syncthreads();
        if (tid < 32) { const unsigned c = F.MISC[MI_LCNT + tid]; F.MISC[MI_LBASE + tid] = c ? xb_add(cnt + 64 * tid, c) : 0u; F.MISC[MI_LCNT + tid] = 0u; }
        __syncthreads();
        if (tid < 32) { const int tok = m0 + tid;
#pragma unroll
            for (int k = 0; k < 4; ++k) { const unsigned slot = F.MISC[MI_LBASE + ex[k]] + ls[k]; TOKE[tok * 4 + k] = (unsigned)ex[k] | (slot << 8); GATES[tok * 4 + k] = gt[k]; LIST[(size_t)ex[k] * 16384 + (slot & ~255u) + ((slot & 63u) << 2) + ((slot >> 6) & 3u)] = (unsigned short)tok; }
            RSTD[tok] = RS[tid]; }
        __syncthreads();
    }
    { const int ntok = 32 * ui; const int l = lane;
      f32x4 gv[8];
#pragma unroll
      for (int j = 0; j < 4; ++j) { gv[2 * j] = *(const f32x4*)(gf + 8 * l + 512 * j) * 16.0f; gv[2 * j + 1] = *(const f32x4*)(gf + 8 * l + 512 * j + 4) * 16.0f; }
      u32x4 xn[4];
      int jt = w;
      if (jt < ntok) { const size_t tk = (size_t)32 * (blockIdx.x + (jt >> 5) * F.G) + (jt & 31);
#pragma unroll
          for (int j = 0; j < 4; ++j) xn[j] = *(const u32x4*)(XMID + tk * DM + 8 * l + 512 * j); }
      for (; jt < ntok; jt += 8) {
          const size_t tk = (size_t)32 * (blockIdx.x + (jt >> 5) * F.G) + (jt & 31); const float rs = RSA[jt]; u32x2 o[4];
#pragma unroll
          for (int j = 0; j < 4; ++j) { const u32x4 xr = xn[j]; const f32x4 a = (f32x4){bflo(xr.x), bfhi(xr.x), bflo(xr.y), bfhi(xr.y)} * rs * gv[2 * j], b = (f32x4){bflo(xr.z), bfhi(xr.z), bflo(xr.w), bfhi(xr.w)} * rs * gv[2 * j + 1];
              o[j].x = pk4_fp8(a[0], a[1], a[2], a[3]); o[j].y = pk4_fp8(b[0], b[1], b[2], b[3]); }
          const int j2 = jt + 8;
          if (j2 < ntok) { const size_t t2 = (size_t)32 * (blockIdx.x + (j2 >> 5) * F.G) + (j2 & 31);
#pragma unroll
              for (int j = 0; j < 4; ++j) xn[j] = *(const u32x4*)(XMID + t2 * DM + 8 * l + 512 * j); }
#pragma unroll
          for (int j = 0; j < 4; ++j) *(u32x2*)(HF8 + tk * DM + 8 * l + 512 * j) = o[j]; } }
}

__device__ __forceinline__ void p4b(Frame& F, const Params& p) {
    build_moe_tables(F);
    const bf16_t* XMID = (const bf16_t*)(F.ws + WS_XMID); const float* RSTD = (const float*)(F.ws + WS_RSTD); const unsigned* TOKE = (const unsigned*)(F.ws + WS_TOKE);
    const float* gf = p.in[I_NFG]; unsigned char* ABUF = F.ws + WS_ABUF;
    const int l = F.lane;
    u32x4 xn[4]; float rsn = 0.f; unsigned ten[4] = {0u, 0u, 0u, 0u};
    if (F.gw < T) { rsn = RSTD[F.gw];
#pragma unroll
        for (int k = 0; k < 4; ++k) ten[k] = TOKE[F.gw * 4 + k];
#pragma unroll
        for (int j = 0; j < 4; ++j) xn[j] = *(const u32x4*)(XMID + (size_t)F.gw * DM + 8 * l + 512 * j); }
    f32x4 gv[8];
#pragma unroll
    for (int j = 0; j < 4; ++j) { gv[2 * j] = *(const f32x4*)(gf + 8 * l + 512 * j) * 16.0f; gv[2 * j + 1] = *(const f32x4*)(gf + 8 * l + 512 * j + 4) * 16.0f; }
    for (int tok = F.gw; tok < T; tok += F.NGW) {
        const float rs = rsn; unsigned te[4]; u32x2 o[4];
#pragma unroll
        for (int k = 0; k < 4; ++k) te[k] = ten[k];
#pragma unroll
        for (int j = 0; j < 4; ++j) { const u32x4 xr = xn[j]; const f32x4 a = (f32x4){bflo(xr.x), bfhi(xr.x), bflo(xr.y), bfhi(xr.y)} * rs * gv[2 * j], b = (f32x4){bflo(xr.z), bfhi(xr.z), bflo(xr.w), bfhi(xr.w)} * rs * gv[2 * j + 1];
            o[j].x = pk4_fp8(a[0], a[1], a[2], a[3]); o[j].y = pk4_fp8(b[0], b[1], b[2], b[3]); }
        const int t2 = tok + F.NGW;
        if (t2 < T) { rsn = RSTD[t2];
#pragma unroll
            for (int k = 0; k < 4; ++k) ten[k] = TOKE[t2 * 4 + k];
#pragma unroll
            for (int j = 0; j < 4; ++j) xn[j] = *(const u32x4*)(XMID + (size_t)t2 * DM + 8 * l + 512 * j); }
#pragma unroll
        for (int k = 0; k < 4; ++k) { const size_t row = (size_t)F.MISC[MI_PBASE + (te[k] & 255u)] + (te[k] >> 8);
#pragma unroll
            for (int j = 0; j < 4; ++j) *(u32x2*)(ABUF + row * DM + 8 * l + 512 * j) = o[j]; }
    }
}

__device__ __forceinline__ void p7(Frame& F, const Params& p) {
    build_moe_tables(F);
    const bf16_t* XMID = (const bf16_t*)(F.ws + WS_XMID); const unsigned* TOKE = (const unsigned*)(F.ws + WS_TOKE); const float* GATES = (const float*)(F.ws + WS_GATES);
    const unsigned char* Y = F.ws + WS_Y; const float* gfin = p.in[I_NFINAL];
    const int l = F.lane;
    u32x4 xn[4]; u32x2 yn[4][4]; float gkn[4] = {0.f, 0.f, 0.f, 0.f};
#define P7_FETCH(tk) do { \
        _Pragma("unroll") for (int k = 0; k < 4; ++k) { const unsigned te = TOKE[(tk) * 4 + k]; gkn[k] = GATES[(tk) * 4 + k]; const size_t row = (size_t)F.MISC[MI_PBASE + (te & 255u)] + (te >> 8); \
            _Pragma("unroll") for (int j = 0; j < 4; ++j) yn[k][j] = *(const u32x2*)(Y + row * DM + 8 * l + 512 * j); } \
        _Pragma("unroll") for (int j = 0; j < 4; ++j) xn[j] = *(const u32x4*)(XMID + (size_t)(tk) * DM + 8 * l + 512 * j); } while (0)
    if (F.gw < T) P7_FETCH(F.gw);
    f32x4 g0[4], g1[4];
#pragma unroll
    for (int j = 0; j < 4; ++j) { g0[j] = *(const f32x4*)(gfin + 8 * l + 512 * j); g1[j] = *(const f32x4*)(gfin + 8 * l + 512 * j + 4); }
    for (int tok = F.gw; tok < T; tok += F.NGW) {
        f32x4 xv[8];
#pragma unroll
        for (int j = 0; j < 4; ++j) { const u32x4 xr = xn[j]; xv[2 * j] = (f32x4){bflo(xr.x), bfhi(xr.x), bflo(xr.y), bfhi(xr.y)}; xv[2 * j + 1] = (f32x4){bflo(xr.z), bfhi(xr.z), bflo(xr.w), bfhi(xr.w)}; }
#pragma unroll
        for (int k = 0; k < 4; ++k)
#pragma unroll
            for (int j = 0; j < 4; ++j) { const u32x2 y2 = yn[k][j]; const float gk = gkn[k] * (1.0f / 32.0f);
                xv[2 * j][0] += gk * fp8f(y2.x, 0); xv[2 * j][1] += gk * fp8f(y2.x, 1); xv[2 * j][2] += gk * fp8f(y2.x, 2); xv[2 * j][3] += gk * fp8f(y2.x, 3);
                xv[2 * j + 1][0] += gk * fp8f(y2.y, 0); xv[2 * j + 1][1] += gk * fp8f(y2.y, 1); xv[2 * j + 1][2] += gk * fp8f(y2.y, 2); xv[2 * j + 1][3] += gk * fp8f(y2.y, 3); }
        const int t2 = tok + F.NGW;
        if (t2 < T) P7_FETCH(t2);
        float ss = 0.f;
#pragma unroll
        for (int j = 0; j < 8; ++j) ss += (xv[j][0] * xv[j][0] + xv[j][1] * xv[j][1]) + (xv[j][2] * xv[j][2] + xv[j][3] * xv[j][3]);
        const float rs = rsqrtf_(wave_sum(ss) * (1.0f / DM) + 1e-6f);
#pragma unroll
        for (int j = 0; j < 4; ++j) { *(f32x4*)(p.out + (size_t)tok * DM + 8 * l + 512 * j) = xv[2 * j] * rs * g0[j]; *(f32x4*)(p.out + (size_t)tok * DM + 8 * l + 512 * j + 4) = xv[2 * j + 1] * rs * g1[j]; }
    }
#undef P7_FETCH
}

#ifdef PROBE_STREAM
__device__ __forceinline__ void probe_stream(Frame& F, const Params& p) {
    const f32x4* src = (const f32x4*)p.in[I_WGU]; const size_t n4 = (size_t)32 * 2048 * 4096 / 4;
    const f32x4* src2 = (const f32x4*)p.in[I_WDN]; const size_t m4 = (size_t)32 * 2048 * 2048 / 4;
    f32x4 acc = (f32x4){0.f, 0.f, 0.f, 0.f};
    for (size_t base = (size_t)F.gw * 1024; base < n4; base += (size_t)F.NGW * 1024) {
        f32x4 v[16];
#pragma unroll
        for (int i = 0; i < 16; ++i) v[i] = src[base + i * 64 + F.lane];
#pragma unroll
        for (int i = 0; i < 16; ++i) acc += v[i]; }
    for (size_t base = (size_t)F.gw * 1024; base < m4; base += (size_t)F.NGW * 1024) {
        f32x4 v[16];
#pragma unroll
        for (int i = 0; i < 16; ++i) v[i] = src2[base + i * 64 + F.lane];
#pragma unroll
        for (int i = 0; i < 16; ++i) acc += v[i]; }
    if (acc[0] + acc[1] + acc[2] + acc[3] == 12345.678f) p.out[0] = 1.0f;
}
#endif
#ifdef PROBE_ORDER
__device__ __forceinline__ void probe_order(Frame& F, const Params& p) {
    volatile LAS unsigned* flag = F.MISC + 2000;
    if (F.wave < 4) {
        const unsigned* hot = (const unsigned*)p.in[I_X] + (size_t)blockIdx.x * 16384;
        unsigned idx = F.tid & 255, sm = 0;
        for (int it = 0; it < 600; ++it) {
            const unsigned b = idx * 4 + (it & 3) * 1024;
            const unsigned v0 = hot[b & 16383], v1 = hot[(b + 4096) & 16383], v2 = hot[(b + 8192) & 16383], v3 = hot[(b + 12288) & 16383];
            sm += v0 + v1 + v2 + v3; idx = (idx + (sm & 3)) & 255;
        }
        if (sm == 0x12345678u) p.out[0] = 1.0f;
        *flag = 1u;
    } else {
#if PROBE_ORDER == 2
        const f32x4* src = (const f32x4*)p.in[I_WGU];
        f32x4 acc = (f32x4){0.f, 0.f, 0.f, 0.f}; unsigned it = 0;
        const unsigned sw = blockIdx.x * 4 + (F.wave - 4);
        while (*flag == 0u) {
            const size_t base = (((size_t)it * 1024 + sw) * 1024) & (((size_t)1 << 26) - 1);
            f32x4 v[16];
#pragma unroll
            for (int i = 0; i < 16; ++i) v[i] = src[base + i * 64 + F.lane];
#pragma unroll
            for (int i = 0; i < 16; ++i) acc += v[i];
            ++it;
        }
        if (acc[0] + acc[1] + acc[2] + acc[3] == 12345.678f) p.out[1] = 1.0f;
#endif
    }
    __syncthreads();
}
#endif
constexpr int NPHASE = 11;
constexpr int HOST_DN_EXPERTS = 24;
constexpr int CONV_EXPERTS = 28, CONV_END = CONV_EXPERTS * 8192, CONV_P1 = 2048 * 81;
#ifndef KROT5
#define KROT5 false
#endif
#ifndef KROT6
#define KROT6 false
#endif
#ifndef STAG5
#define STAG5 0
#endif
#ifndef STAG6
#define STAG6 0
#endif
__global__ void __launch_bounds__(512, 2) mk_fwd(Params p) {
    extern __shared__ __attribute__((aligned(16))) unsigned char lds_raw[];
    Frame F;
    F.lds = (LAS unsigned char*)lds_raw; F.MISC = (volatile LAS unsigned*)(F.lds + MISC_OFF);
    F.wave = __builtin_amdgcn_readfirstlane((int)threadIdx.x >> 6);
#define FRESH() do { F.lane = fresh_lane(); F.tid = F.wave * 64 + F.lane; } while (0)
    FRESH();
    F.G = gridDim.x; F.gw = (int)blockIdx.x * 8 + F.wave; F.NGW = F.G * 8; F.ws = p.ws;
    for (int u = F.tid; u < (LDS_BYTES - MISC_OFF) / 4; u += 512) F.MISC[u] = 0u;
    __syncthreads();
    const int lo = p.ph_lo, hi = p.ph_hi;
    XcdBarrier bar; bar.bar = (unsigned*)(F.ws + WS_CTL) + CW_BAR; bar.x = 0; bar.st = F.MISC;
    if (hi - lo > 1) bar = xcd_barrier_post((unsigned*)(F.ws + WS_CTL) + CW_BAR, F.MISC, F.tid == 0);
#ifndef PHASE_MASK
#define PHASE_MASK 0x7ff
#endif
#define IN(k) (((PHASE_MASK >> (k)) & 1) && lo <= (k) && (k) < hi)
#define SEAM(k) do { if (IN(k) && IN((k) + 1)) xcd_barrier(bar, F.wave == 0 && fresh_lane() == 0); } while (0)
#ifndef REPEAT_MASK
#define REPEAT_MASK 0
#endif
#define REP(k) for (int rep_ = 0; rep_ < (((REPEAT_MASK >> (k)) & 1) ? 2 : 1); ++rep_)
    LAS unsigned char* ring = F.lds;
#ifdef PROBE_STREAM
    if (IN(0)) { probe_stream(F, p); }
#endif
#ifdef PROBE_ORDER
    if (IN(0)) { probe_order(F, p); }
#endif
    if (IN(0)) { REP(11) { FRESH(); p0a(F, p); } REP(12) { FRESH(); p0b(F, p); } SEAM(0); }
    if (IN(1)) REP(1) {

#ifdef SIM_FP8
        pg8::Gemm g{F.ws + WS_MIX, F.ws + WS_WINT};
#else
        pg8::Gemm g{F.ws + WS_H, F.ws + WS_WINT};
#endif
 using GS = pg8::GShape<DM * 2, DM * 2, DM * 2, 0>; pg8::StaticOrder S; S.init(T, ZC, F.G, (int)blockIdx.x);
        pg8::EpiBf16 E{(bf16_t*)(F.ws + WS_Z), ZC, nullptr, 0};
        pg8::ConvGU cv{p.in[I_WGU], F.ws + WS_WGUT, F.gw, CONV_END, F.NGW, 0};
        pg8::gemm_phase<pg8::EpiBf16, pg8::StaticOrder, GS, true, false, 0, pg8::ConvGU>(ring, g, S, E, F.wave, cv); SEAM(1); }
    if (IN(2)) REP(2) { FRESH(); p2a(F, p); SEAM(2); }
    if (IN(3)) REP(3) { FRESH(); p2b(F, p); SEAM(3); }
    if (IN(4)) REP(4) { FRESH(); p2c(F, p); SEAM(4); }
    if (IN(5)) REP(5) {
        pg8::Gemm g{F.ws + WS_MIX, F.ws + WS_WOUTT}; using GS = pg8::GShape<DM * 2, DM * 2, DM * 2, 0>; pg8::StaticOrder S; S.init(T, DM, F.G, (int)blockIdx.x);
        pg8::EpiBf16Res E{(bf16_t*)(F.ws + WS_XMID), p.in[I_X], DM};
        pg8::ConvGU cv{p.in[I_WGU], F.ws + WS_WGUT, CONV_P1 + F.gw, CONV_END, F.NGW, 0};
        pg8::gemm_phase<pg8::EpiBf16Res, pg8::StaticOrder, GS, true, false, 0, pg8::ConvGU>(ring, g, S, E, F.wave, cv); SEAM(5); }
    if (IN(6)) { FRESH(); p4a(F, p); SEAM(6); }
    if (IN(8)) {
        FRESH(); build_moe_tables(F);
        pg8::Gemm g{F.ws + WS_HF8, F.ws + WS_WGUT}; using GS = pg8::GShape<DM, DM, DM, (size_t)4096 * DM>;
        pg8::MoeOrder S{__builtin_amdgcn_readfirstlane((int)F.MISC[MI_NMT]), 16, F.G, (int)blockIdx.x, (const LAS int*)(F.lds + MISC_OFF + 4 * MI_T2E)};
        pg8::EpiSwiGLU8 E{F.ws + WS_ACT, DM, p.in[I_BGU]};
        pg8::Gather gi{(const unsigned short*)(F.ws + WS_LIST), (const LAS unsigned*)(F.lds + MISC_OFF + 4 * MI_PBASE), (const LAS unsigned*)(F.lds + MISC_OFF + 4 * MI_CNT)};
        pg8::EpiHost<3> eh{p.in[I_WDN], F.ws + WS_WDT, F.gw, HOST_DN_EXPERTS * 4096, F.NGW, DM, 5, 0, 0, {0, 0, 0}};
        pg8::gemm_phase<pg8::EpiSwiGLU8, pg8::MoeOrder, GS, true, true, STAG5, pg8::NoConv, pg8::EpiHost<3>, KROT5, pg8::Gather>(ring, g, S, E, F.wave, pg8::NoConv(), eh, gi); SEAM(8); }
#if (REPEAT_MASK & 0x100)
    if (IN(8)) {
        FRESH(); build_moe_tables(F);
        pg8::Gemm g{F.ws + WS_ABUF, F.ws + WS_WGUT}; using GS = pg8::GShape<DM, DM, DM, (size_t)4096 * DM>;
        pg8::MoeOrder S{__builtin_amdgcn_readfirstlane((int)F.MISC[MI_NMT]), 16, F.G, (int)blockIdx.x, (const LAS int*)(F.lds + MISC_OFF + 4 * MI_T2E)};
        pg8::EpiSwiGLU8 E{F.ws + WS_Y, DM, p.in[I_BGU]};
#if P5DUP == 2
        pg8::Gemm g2{F.ws + WS_HF8, F.ws + WS_WGUT};
        pg8::Gather gi{(const unsigned short*)(F.ws + WS_LIST), (const LAS unsigned*)(F.lds + MISC_OFF + 4 * MI_PBASE), (const LAS unsigned*)(F.lds + MISC_OFF + 4 * MI_CNT)};
        pg8::gemm_phase<pg8::EpiSwiGLU8, pg8::MoeOrder, GS, true, true, STAG5, pg8::NoConv, pg8::NoHost, false, pg8::Gather>(ring, g2, S, E, F.wave, pg8::NoConv(), pg8::NoHost(), gi); SEAM(8); }
#else
        pg8::gemm_phase<pg8::EpiSwiGLU8, pg8::MoeOrder, GS, true, true, STAG5>(ring, g, S, E, F.wave); SEAM(8); }
#endif
#endif
    if (IN(9)) {
        FRESH(); build_moe_tables(F);
        pg8::Gemm g{F.ws + WS_ACT, F.ws + WS_WDT}; using GS = pg8::GShape<DM, DM, DM, (size_t)DM * DM>;
        pg8::MoeOrder S{__builtin_amdgcn_readfirstlane((int)F.MISC[MI_NMT]), 8, F.G, (int)blockIdx.x, (const LAS int*)(F.lds + MISC_OFF + 4 * MI_T2E)};
        pg8::EpiFp8S E{F.ws + WS_Y, DM, p.in[I_BDN], DM, 1.0f / 2048.0f, 32.0f};
        pg8::gemm_phase<pg8::EpiFp8S, pg8::MoeOrder, GS, true, true, STAG6, pg8::NoConv, pg8::NoHost, KROT6>(ring, g, S, E, F.wave); SEAM(9); }
#if (REPEAT_MASK & 0x200)
    if (IN(9)) {
        FRESH(); build_moe_tables(F);
#ifdef P6_PITCH
        pg8::Gemm g{F.ws + WS_ACT, F.ws + WS_WDT}; using GS = pg8::GShape<P6_PITCH, P6_PITCH, DM, (size_t)DM * DM>;
#else
        pg8::Gemm g{F.ws + WS_ACT, F.ws + WS_WDT}; using GS = pg8::GShape<DM, DM, DM, (size_t)DM * DM>;
#endif
        pg8::MoeOrder S{__builtin_amdgcn_readfirstlane((int)F.MISC[MI_NMT]), 8, F.G, (int)blockIdx.x, (const LAS int*)(F.lds + MISC_OFF + 4 * MI_T2E)};
#ifdef P6_NOSTORE
        pg8::EpiNull_<P6_NOSTORE - 1> E{};

#ifndef P6_FLP
#define P6_FLP false
#endif
        pg8::gemm_phase<pg8::EpiNull_<P6_NOSTORE - 1>, pg8::MoeOrder, GS, true, true, STAG6, pg8::NoConv, pg8::NoHost, false, pg8::NoGather, P6_FLP>(ring, g, S, E, F.wave); SEAM(9); }
#elif defined(P6_MODE)
        pg8::EpiFp8S_<P6_MODE> E{F.ws + WS_Y, DM, p.in[I_BDN], DM, 1.0f / 2048.0f, 32.0f};
        pg8::gemm_phase<pg8::EpiFp8S_<P6_MODE>, pg8::MoeOrder, GS, true, true, STAG6>(ring, g, S, E, F.wave); SEAM(9); }
#else
        pg8::EpiFp8S E{F.ws + WS_Y, DM, p.in[I_BDN], DM, 1.0f / 2048.0f, 32.0f};
        pg8::gemm_phase<pg8::EpiFp8S, pg8::MoeOrder, GS, true, true, STAG6>(ring, g, S, E, F.wave); SEAM(9); }
#endif
#endif
    if (IN(10)) REP(10) { FRESH(); p7(F, p); if (((REPEAT_MASK >> 10) & 1)) xcd_barrier(bar, F.wave == 0 && fresh_lane() == 0); }
#undef IN
#undef SEAM
}
#ifndef STAGE
#define STAGE 4
#endif
#ifndef PER_PHASE_LAUNCH
#define PER_PHASE_LAUNCH 0
#endif

#if STAGE < 4
__global__ void adapt_z_kernel(const bf16_t* Z, float* z) {
    const long idx = (long)blockIdx.x * blockDim.x + threadIdx.x; const long t = idx / ZC; const int c = (int)(idx % ZC);
    z[t * INC + (c < 3072 ? c : c + 16)] = bf2f(Z[idx]);
}
__global__ void adapt_bf16_kernel(const bf16_t* src, float* dst) { const long idx = (long)blockIdx.x * blockDim.x + threadIdx.x; dst[idx] = bf2f(src[idx]); }
#endif

static void launch_mk(Params& a, int lo, int hi, int grid, hipStream_t stream) {
#if PER_PHASE_LAUNCH
    for (int k = lo; k < hi; ++k) { a.ph_lo = k; a.ph_hi = k + 1; hipLaunchKernelGGL(mk_fwd, dim3(grid), dim3(512), LDS_BYTES, stream, a); }
#else
    a.ph_lo = lo; a.ph_hi = hi; hipLaunchKernelGGL(mk_fwd, dim3(grid), dim3(512), LDS_BYTES, stream, a);
#endif
}

extern "C" void kernel_launch(void* const* d_in, const int* in_sizes, int n_in, void* d_out, int out_size, void* d_ws, size_t ws_size, hipStream_t stream) {
    static int grid = 0;
    if (grid == 0) {
        int dev = 0, cus = 0;
        if (hipGetDevice(&dev) != hipSuccess || hipDeviceGetAttribute(&cus, hipDeviceAttributeMultiprocessorCount, dev) != hipSuccess) { grid = -1; return; }
        if (hipFuncSetAttribute((const void*)mk_fwd, hipFuncAttributeMaxDynamicSharedMemorySize, LDS_BYTES) != hipSuccess) { grid = -1; return; }
        int per_cu = 0;
        (void)hipOccupancyMaxActiveBlocksPerMultiprocessor(&per_cu, (const void*)mk_fwd, 512, LDS_BYTES);
        (void)hipGetLastError();
        grid = cus < 256 ? cus : 256;
        if (per_cu < 1) fprintf(stderr, "kernel_launch: occupancy query reports %d\n", per_cu);
    }
    if (grid < 0) return;
    (void)hipMemsetAsync((char*)d_ws + WS_CTL, 0, CTL_ZERO_BYTES, stream);
    Params a{};
    for (int i = 0; i < 22; ++i) a.in[i] = (const float*)d_in[i];
    a.out = (float*)d_out; a.ws = (unsigned char*)d_ws;
#if STAGE >= 4
    launch_mk(a, 0, NPHASE, grid, stream);
#else
    const float* x = a.in[I_X];
    char* ws = (char*)d_ws + WS_ABUF; size_t off = 0;
    auto alloc = [&](size_t bytes) { void* p = ws + off; off += (bytes + 255) & ~(size_t)255; return p; };
    int* counts = (int*)alloc(256);
    float* z = (float*)alloc((size_t)T * INC * 4);
    float* ogla = (float*)alloc((size_t)T * 1024 * 4);
    float* xc = (float*)alloc((size_t)T * 1024 * 4);
    float* za = (float*)alloc((size_t)T * 1024 * 4);
    float* zi = (float*)alloc((size_t)T * 1024 * 4);
    float* mix = (float*)alloc((size_t)T * DM * 4);
    float* xmid = (float*)alloc((size_t)T * DM * 4);
    float* hf = (float*)alloc((size_t)T * DM * 4);
    float* logits = (float*)alloc((size_t)T * 32 * 4);
    float* gates = (float*)alloc((size_t)T * 4 * 4);
    int* list = (int*)alloc((size_t)NEXP * T * 4);
    float* act = (float*)alloc((size_t)T * 4 * DM * 4);
    float* y = (float*)alloc((size_t)T * 4 * DM * 4);
    (void)hipMemsetAsync(counts, 0, 256, stream);
#if STAGE == 1
    launch_mk(a, 0, 2, grid, stream);
    adapt_z_kernel<<<(unsigned)((size_t)T * ZC / 256), 256, 0, stream>>>((const bf16_t*)((char*)d_ws + WS_Z), z);
    gla_naive_kernel<<<64, 256, 0, stream>>>(z, (const float*)((char*)d_ws + WS_LG), ogla);
    gla_out_kernel<<<T, 256, 0, stream>>>(ogla, z, a.in[I_GNG], mix);
    lru_conv_kernel<<<T * 1024 / 256, 256, 0, stream>>>(z, a.in[I_CW], a.in[I_CB], xc);
    for (int h = 0; h < 4; ++h) {
        GemmArgs g{}; g.A = xc + h * 256; g.lda = 1024; g.ldb = 256; g.ldc = 1024; g.M = T; g.N = 256; g.K = 256; g.a_div = 1;
        g.B = a.in[I_WA] + (size_t)h * 65536; g.C = za + h * 256;
        sgemm_kernel<0><<<dim3(2, T / 128, 1), 256, 0, stream>>>(g);
        g.B = a.in[I_WI] + (size_t)h * 65536; g.C = zi + h * 256;
        sgemm_kernel<0><<<dim3(2, T / 128, 1), 256, 0, stream>>>(g);
    }
    lru_gate_kernel<<<T * 1024 / 256, 256, 0, stream>>>(xc, za, zi, a.in[I_BA], a.in[I_BI], a.in[I_AP]);
    lru_scan_kernel<<<2048 / 64, 64, 0, stream>>>(za, zi, z, mix);
#endif
#if STAGE == 2
    launch_mk(a, 0, 5, grid, stream);
    adapt_bf16_kernel<<<(unsigned)((size_t)T * DM / 256), 256, 0, stream>>>((const bf16_t*)((char*)d_ws + WS_MIX), mix);
#endif
#if STAGE <= 2
    { GemmArgs g{}; g.A = mix; g.lda = DM; g.B = a.in[I_WOUT]; g.ldb = DM; g.C = xmid; g.ldc = DM; g.M = T; g.N = DM; g.K = DM; g.a_div = 1; g.resid = x; g.ldr = DM;
      sgemm_kernel<1><<<dim3(DM / 128, T / 128, 1), 256, 0, stream>>>(g); }
#else
    launch_mk(a, 0, 6, grid, stream);
    xmid = (float*)((char*)d_ws + WS_XMID);
#endif
    rmsnorm_kernel<<<T, 256, 0, stream>>>(xmid, a.in[I_NFG], hf);
    { GemmArgs g{}; g.A = hf; g.lda = DM; g.B = a.in[I_WR]; g.ldb = 32; g.C = logits; g.ldc = 32; g.M = T; g.N = 32; g.K = DM; g.a_div = 1; g.bias = a.in[I_BR];
      sgemm_kernel<0><<<dim3(1, T / 128, 1), 256, 0, stream>>>(g); }
    route_kernel<<<T / 256, 256, 0, stream>>>(logits, counts, list, gates);
    { GemmArgs g{}; g.A = hf; g.lda = DM; g.B = a.in[I_WGU]; g.ldb = 4096; g.C = act; g.ldc = DM; g.M = 0; g.N = 4096; g.K = DM; g.a_div = 4; g.bias = a.in[I_BGU];
      g.rowlist = list; g.count = counts; g.strideB_e = (long)DM * 4096; g.strideBias_e = 4096; g.list_stride = T;
      sgemm_kernel<2><<<dim3(2048 / 64, T / 128, NEXP), 256, 0, stream>>>(g); }
    { GemmArgs g{}; g.A = act; g.lda = DM; g.B = a.in[I_WDN]; g.ldb = DM; g.C = y; g.ldc = DM; g.M = 0; g.N = DM; g.K = DM; g.a_div = 1; g.bias = a.in[I_BDN];
      g.rowlist = list; g.count = counts; g.strideB_e = (long)DM * DM; g.strideBias_e = DM; g.list_stride = T;
      sgemm_kernel<0><<<dim3(DM / 128, T / 128, NEXP), 256, 0, stream>>>(g); }
    final_kernel<<<T, 256, 0, stream>>>(xmid, y, gates, a.in[I_NFINAL], (float*)d_out);
#endif
}
```

```cpp
#define STAGE 4
#define PER_PHASE_LAUNCH 0
#define REPEAT_MASK 0
#include <hip/hip_runtime.h>
#include <stdint.h>
#include <stdio.h>

#define GAS __attribute__((address_space(1)))
#define LAS __attribute__((address_space(3)))
typedef unsigned short bf16_t;
typedef short bf16x8 __attribute__((ext_vector_type(8)));
typedef short bf16x4 __attribute__((ext_vector_type(4)));
typedef float f32x4 __attribute__((ext_vector_type(4)));
typedef float f32x2 __attribute__((ext_vector_type(2)));
typedef float f32x16 __attribute__((ext_vector_type(16)));
typedef unsigned u32x4 __attribute__((ext_vector_type(4)));
typedef unsigned u32x2 __attribute__((ext_vector_type(2)));
typedef int i32x8 __attribute__((ext_vector_type(8)));
typedef int i32x4 __attribute__((ext_vector_type(4)));
typedef int i32x32 __attribute__((ext_vector_type(32)));

constexpr int T = 16384, SEQL = 8192, DM = 2048, INC = 5136, ZC = 5120, NEXP = 32;
constexpr int ZQ = 0, ZK = 512, ZV = 1024, ZR = 2048, ZLX = 3072, ZLG = 4096;
constexpr int MPAD_MAX = 65536 + NEXP * 256;
constexpr int NCHUNK = 256;

constexpr size_t MiB = 1u << 20;
constexpr size_t WS_CTL = 0, CTL_ZERO_BYTES = 128 * 1024;
constexpr size_t WS_WINT = 1 * MiB;
constexpr size_t WS_WOUTT = WS_WINT + 20 * MiB;
constexpr size_t WS_WGUT = WS_WOUTT + 8 * MiB;
constexpr size_t WS_WDT = WS_WGUT + 512 * MiB;
constexpr size_t WS_WAT = WS_WDT + 256 * MiB;
constexpr size_t WS_WIT = WS_WAT + 512 * 1024;
constexpr size_t WS_WRT = WS_WIT + 512 * 1024;
constexpr size_t WS_WGLT = WS_WRT + 512 * 1024;
constexpr size_t WS_H = WS_WRT + 1 * MiB;
constexpr size_t WS_LG = WS_H + 64 * MiB;
constexpr size_t WS_Z = WS_LG + 32 * MiB;
constexpr size_t WS_AN = WS_Z + 160 * MiB;
constexpr size_t WS_DN = WS_AN + 128 * MiB;
constexpr size_t WS_SP = WS_DN + 1 * MiB;
constexpr size_t WS_AUA = WS_SP + 64 * MiB;
constexpr size_t WS_AUU = WS_AUA + 64 * MiB;
constexpr size_t WS_SUMA = WS_AUU + 64 * MiB;
constexpr size_t WS_SUMH = WS_SUMA + 1 * MiB;
constexpr size_t WS_MIX = WS_SUMH + 1 * MiB;
constexpr size_t WS_XMID = WS_MIX + 64 * MiB;
constexpr size_t WS_RSTD = WS_XMID + 128 * MiB;
constexpr size_t WS_TOKE = WS_RSTD + 1 * MiB;
constexpr size_t WS_GATES = WS_TOKE + 1 * MiB;
constexpr size_t WS_ABUF = WS_GATES + 1 * MiB;
constexpr size_t WS_HF8 = WS_ABUF, WS_LIST = WS_ABUF + 64 * MiB;
constexpr size_t WS_ACT = WS_ABUF + 288 * MiB;
constexpr size_t WS_Y = WS_ACT + 288 * MiB;
constexpr size_t WS_END = WS_Y + 288 * MiB;
constexpr int CW_BAR = 4096;
constexpr int CW_CNT = 16384;

constexpr int RING_BYTES = 131072;
constexpr int SCR_BYTES = 135168;
constexpr int MISC_OFF = SCR_BYTES;
constexpr int LDS_BYTES = 147456;
constexpr int MI_PBASE = 16, MI_NMT = 48, MI_LCNT = 64, MI_LBASE = 96, MI_T2E = 128, MI_CNT = 480;

#define LDS_WAIT() asm volatile("s_waitcnt lgkmcnt(0)" ::: "memory")
#define VM_WAIT() asm volatile("s_waitcnt vmcnt(0)" ::: "memory")

typedef __bf16 bf16v2_t __attribute__((ext_vector_type(2)));
__device__ __forceinline__ unsigned pk2(float lo, float hi) { const f32x2 v = {lo, hi}; return __builtin_bit_cast(unsigned, __builtin_convertvector(v, bf16v2_t)); }
#ifdef SIM_FP8
__device__ __forceinline__ float q8_(float x, float sc) { int p = 0; p = __builtin_amdgcn_cvt_pk_fp8_f32(__builtin_amdgcn_fmed3f(x * sc, -448.0f, 448.0f), 0.0f, p, false); return __builtin_amdgcn_cvt_f32_fp8(p, 0) * (1.0f / sc); }
#define PK2A(a, b) pk2(q8_(a, 16.0f), q8_(b, 16.0f))
#define PK2W(a, b) pk2(q8_(a, 512.0f), q8_(b, 512.0f))
#else
#define PK2A(a, b) pk2(a, b)
#define PK2W(a, b) pk2(a, b)
#endif
__device__ __forceinline__ unsigned f2bf(float f) { return pk2(f, 0.0f) & 0xffffu; }
__device__ __forceinline__ float bf2f(unsigned short b) { return __builtin_bit_cast(float, (unsigned)b << 16); }
__device__ __forceinline__ float bflo(unsigned w) { return __builtin_bit_cast(float, w << 16); }
__device__ __forceinline__ float bfhi(unsigned w) { return __builtin_bit_cast(float, w & 0xffff0000u); }
__device__ __forceinline__ float clamp448(float x) { return __builtin_amdgcn_fmed3f(x, -448.0f, 448.0f); }
__device__ __forceinline__ unsigned pk4_fp8(float a, float b, float c, float d) {
    int p = 0; p = __builtin_amdgcn_cvt_pk_fp8_f32(clamp448(a), clamp448(b), p, false); p = __builtin_amdgcn_cvt_pk_fp8_f32(clamp448(c), clamp448(d), p, true); return (unsigned)p; }
__device__ __forceinline__ unsigned pk4_fp8_nc(float a, float b, float c, float d) {
    int p = 0; p = __builtin_amdgcn_cvt_pk_fp8_f32(a, b, p, false); p = __builtin_amdgcn_cvt_pk_fp8_f32(c, d, p, true); return (unsigned)p; }
__device__ __forceinline__ float fp8f(unsigned w, int b) { return b == 0 ? __builtin_amdgcn_cvt_f32_fp8((int)w, 0) : b == 1 ? __builtin_amdgcn_cvt_f32_fp8((int)w, 1) : b == 2 ? __builtin_amdgcn_cvt_f32_fp8((int)w, 2) : __builtin_amdgcn_cvt_f32_fp8((int)w, 3); }
__device__ __forceinline__ float wave_sum(float v) {
#pragma unroll
    for (int o = 1; o < 64; o <<= 1) v += __shfl_xor(v, o);
    return v;
}
__device__ __forceinline__ int fresh_lane() { int l; asm volatile("v_mbcnt_lo_u32_b32 %0, -1, 0\n\tv_mbcnt_hi_u32_b32 %0, -1, %0" : "=v"(l)); return l; }
__device__ __forceinline__ float sigmoidf_(float x) { return __builtin_amdgcn_rcpf(1.0f + __expf(-x)); }
__device__ __forceinline__ float rsqrtf_(float x) { return __builtin_amdgcn_rsqf(x); }

#define XB_TMO      128
#define XB_XCNT(j)  (256  + 64 * (j))
#define XB_XSUB(j)  (1280 + 64 * (j))
#define XB_XGEN(j)  (2304 + 64 * (j))
#define XB_TOP      3328
#define XB_TOPGEN   3392
#define XCD_BAR_WORDS 3456
#define XB_SPIN_CAP (1u << 18)

__device__ __forceinline__ unsigned xb_ld(unsigned* p)              { return __hip_atomic_load(p, __ATOMIC_RELAXED, __HIP_MEMORY_SCOPE_AGENT); }
__device__ __forceinline__ unsigned xb_add(unsigned* p, unsigned v) { return __hip_atomic_fetch_add(p, v, __ATOMIC_RELAXED, __HIP_MEMORY_SCOPE_AGENT); }
__device__ __forceinline__ unsigned xb_xcc_id() { return (unsigned)__builtin_amdgcn_s_getreg((3 << 11) | 20) & 0xFu; }
#define XB_SPIN(cond, bar) do { unsigned _sp = 0; while (cond) { __builtin_amdgcn_s_sleep(1); \
    if ((++_sp & 255u) == 0u) { if (xb_ld(&(bar)[XB_TMO])) break; if (_sp > XB_SPIN_CAP) { atomicAdd(&(bar)[XB_TMO], 1u); break; } } } } while (0)

struct XcdBarrier { unsigned* bar; unsigned x; volatile LAS unsigned* st; };

__device__ __forceinline__ XcdBarrier xcd_barrier_post(unsigned* bar, volatile LAS unsigned* st, bool t0) {
    XcdBarrier b; b.bar = bar; b.x = xb_xcc_id(); b.st = st;
    if (t0) (void)xb_add(&bar[XB_XCNT(b.x)], 1u);
    return b;
}
__device__ __forceinline__ void xcd_barrier_complete(unsigned* bar, unsigned x, unsigned& nloc, unsigned& nx) {
    const unsigned G = gridDim.x * gridDim.y * gridDim.z;
    unsigned sum, cnt, mine, sp = 0u;
    for (;;) {
        sum = 0u; cnt = 0u; mine = 0u;
#pragma unroll
        for (unsigned j = 0; j < 16; ++j) { const unsigned c = xb_ld(&bar[XB_XCNT(j)]); sum += c; cnt += (c > 0u) ? 1u : 0u; mine = (j == x) ? c : mine; }
        if (sum == G) break;
        __builtin_amdgcn_s_sleep(1);
        if ((++sp & 255u) == 0u) { if (xb_ld(&bar[XB_TMO])) break; if (sp > XB_SPIN_CAP) { atomicAdd(&bar[XB_TMO], 1u); break; } }
    }
    nloc = mine > 0u ? mine : 1u; nx = cnt > 0u ? cnt : 1u;
}
__device__ __forceinline__ void xcd_barrier(const XcdBarrier& b, bool t0) {
    asm volatile("s_waitcnt vmcnt(0)" ::: "memory");
    __syncthreads();
    if (t0) {
        unsigned* bar = b.bar;
        __builtin_amdgcn_s_waitcnt(0);
        unsigned nloc = b.st[0], nx = b.st[1];
        if (nloc == 0u) { xcd_barrier_complete(bar, b.x, nloc, nx); b.st[0] = nloc; b.st[1] = nx; }
        const unsigned old = xb_add(&bar[XB_XSUB(b.x)], 1u);
        const unsigned gen = old / nloc;
        if (old + 1u == (gen + 1u) * nloc) {
            __builtin_amdgcn_fence(__ATOMIC_RELEASE, "agent");
            asm volatile("s_waitcnt vmcnt(0)" ::: "memory");
            const unsigned og = xb_add(&bar[XB_TOP], 1u);
            const unsigned tg = og / nx;
            if (og + 1u == (tg + 1u) * nx) xb_add(&bar[XB_TOPGEN], 1u);
            else XB_SPIN(xb_ld(&bar[XB_TOPGEN]) == tg, bar);
            __builtin_amdgcn_fence(__ATOMIC_ACQUIRE, "agent");
            xb_add(&bar[XB_XGEN(b.x)], 1u);
            asm volatile("s_waitcnt vmcnt(0)" ::: "memory");
        } else {
            XB_SPIN(xb_ld(&bar[XB_XGEN(b.x)]) == gen, bar);
            __builtin_amdgcn_fence(__ATOMIC_ACQUIRE, "agent");
            asm volatile("s_waitcnt vmcnt(0)" ::: "memory");
        }
    }
    __syncthreads();
}

namespace pg8 {
#ifndef PG8_WGM
#define PG8_WGM 4
#endif
constexpr int BM = 256, BK = 64, HALF = 128, HTB = HALF * BK * 2, STAGE_BYTES = 8 * HTB, NXCD = 8, WGM = PG8_WGM;
__host__ __device__ __forceinline__ int lds_byte(int r, int c) { const int st = (r >> 4) * 2 + (c >> 5), rr = r & 15, cc = c & 31, ob = rr * 64 + cc * 2; return st * 1024 + (ob ^ (((ob >> 9) & 1) << 5)); }
__host__ __device__ __forceinline__ void stage_rc(int b, int& R, int& C) { const int st = b / 1024, sb = b % 1024, swz = sb ^ (((sb >> 9) & 1) << 5); R = (st >> 1) * 16 + swz / 64; C = (st & 1) * 32 + (swz % 64) / 2; }
__host__ __device__ __forceinline__ int perm32(int rho) { const int n = rho >> 4, i = rho & 15; return 8 * (i >> 2) + 4 * n + (i & 3); }

struct Unit { int pm, pn, e; };
struct Gemm { const void* A; const void* Bt; };
template <int LDA_, int LDB_, int KB_, size_t SB_> struct GShape { static constexpr int LDA = LDA_, LDB = LDB_, KB = KB_; static constexpr size_t SB = SB_; };

__device__ __forceinline__ bool order_map(int L, int nM, int nN, int& pm, int& pn) {
    const int nwg = nM * nN; if (L >= nwg) return false;
    int wgid = L; { const int q = nwg / NXCD, r = nwg % NXCD, xcd = wgid % NXCD, off = wgid / NXCD; wgid = (xcd < r ? xcd * (q + 1) : r * (q + 1) + (xcd - r) * q) + off; }
    const int nig = WGM * nN, gid = wgid / nig, fm = gid * WGM, gsz = (nM - fm) < WGM ? (nM - fm) : WGM;
    pm = fm + ((wgid % nig) % gsz); pn = (wgid % nig) / gsz; return true;
}
struct StaticOrder {
    int nM, nN, G, c;
    __device__ void init(int M, int N, int G_, int c_) { nM = M / BM; nN = N / BM; G = G_; c = c_; }
    __device__ __forceinline__ bool next(int i, Unit& u) const { u.e = 0; return order_map(i * G + c, nM, nN, u.pm, u.pn); }
};
struct MoeOrder {
    int nM, nN, G, c; const LAS int* t2e;
    __device__ __forceinline__ bool next(int i, Unit& u) const { if (!order_map(i * G + c, nM, nN, u.pm, u.pn)) return false; u.e = __builtin_amdgcn_readfirstlane(t2e[u.pm]); return true; }
};

__device__ __forceinline__ unsigned cvt_pk_bf16(float lo, float hi) { return pk2(lo, hi); }

struct EpiBf16 {
    static constexpr bool PERM = true; static constexpr int NSTORES = 16;
    bf16_t* O; int ldc; const float* bias; int bias_stride;
    __device__ __forceinline__ void operator()(const f32x4 (&acc)[2][2][4][2], const Unit& u, int wr, int wc, int fr, int fq) const {
        const int row0 = u.pm * BM + wr * 64 + fr; const int col0 = u.pn * BM + wc * 32 + 8 * fq;
        f32x4 bv[2][2];
#pragma unroll
        for (int bj = 0; bj < 2; ++bj)
#pragma unroll
            for (int n = 0; n < 2; ++n) bv[bj][n] = bias ? *(const f32x4*)(bias + (size_t)u.e * bias_stride + col0 + bj * HALF + 4 * n) : (f32x4){0.f, 0.f, 0.f, 0.f};
#pragma unroll
        for (int ai = 0; ai < 2; ++ai)
#pragma unroll
            for (int m = 0; m < 4; ++m) { bf16_t* rowp = O + (size_t)(row0 + ai * HALF + m * 16) * ldc + col0;
#pragma unroll
                for (int bj = 0; bj < 2; ++bj) { const f32x4 v0 = acc[ai][bj][m][0] + bv[bj][0], v1 = acc[ai][bj][m][1] + bv[bj][1];
                    u32x4 w; w.x = cvt_pk_bf16(v0[0], v0[1]); w.y = cvt_pk_bf16(v0[2], v0[3]); w.z = cvt_pk_bf16(v1[0], v1[1]); w.w = cvt_pk_bf16(v1[2], v1[3]);
                    *(u32x4*)(rowp + bj * HALF) = w; } }
    }
};
struct EpiF32Res {
    static constexpr bool PERM = false;
    float* C; const float* resid; int ldc;
    __device__ __forceinline__ void operator()(const f32x4 (&acc)[2][2][4][2], const Unit& u, int wr, int wc, int fr, int fq) const {
        const int row0 = u.pm * BM + wr * 64 + fr, col0 = u.pn * BM + wc * 32 + 4 * fq;
#pragma unroll
        for (int ai = 0; ai < 2; ++ai)
#pragma unroll
            for (int m = 0; m < 4; ++m) { const size_t off = (size_t)(row0 + ai * HALF + m * 16) * ldc + col0;
#pragma unroll
                for (int bj = 0; bj < 2; ++bj)
#pragma unroll
                    for (int n = 0; n < 2; ++n) { const f32x4 r = *(const f32x4*)(resid + off + bj * HALF + n * 16); *(f32x4*)(C + off + bj * HALF + n * 16) = acc[ai][bj][m][n] + r; } }
    }
};
struct EpiSwiGLU {
    static constexpr bool PERM = true;
    bf16_t* O; int ldc; const float* bias;
    __device__ __forceinline__ void operator()(const f32x4 (&acc)[2][2][4][2], const Unit& u, int wr, int wc, int fr, int fq) const {
        const int row0 = u.pm * BM + wr * 64 + fr; const int j0 = u.pn * HALF + wc * 32 + 8 * fq;
        const float* be = bias + (size_t)u.e * 4096;
        f32x4 bg[2], bu[2];
#pragma unroll
        for (int n = 0; n < 2; ++n) { bg[n] = *(const f32x4*)(be + j0 + 4 * n); bu[n] = *(const f32x4*)(be + 2048 + j0 + 4 * n); }
#pragma unroll
        for (int ai = 0; ai < 2; ++ai)
#pragma unroll
            for (int m = 0; m < 4; ++m) { bf16_t* rowp = O + (size_t)(row0 + ai * HALF + m * 16) * ldc + j0;
                float o[8];
#pragma unroll
                for (int n = 0; n < 2; ++n) { const f32x4 g = acc[ai][0][m][n] + bg[n], up = acc[ai][1][m][n] + bu[n];
#pragma unroll
                    for (int q = 0; q < 4; ++q) { const float gt = fminf(g[q], 7.0f), ut = fminf(fmaxf(up[q], -7.0f), 7.0f);
                        const float glu = gt * __builtin_amdgcn_rcpf(1.0f + __expf(-1.702f * gt)); o[4 * n + q] = (ut + 1.0f) * glu; } }
                u32x4 w; w.x = cvt_pk_bf16(o[0], o[1]); w.y = cvt_pk_bf16(o[2], o[3]); w.z = cvt_pk_bf16(o[4], o[5]); w.w = cvt_pk_bf16(o[6], o[7]);
                *(u32x4*)rowp = w; }
    }
};

struct EpiBf16Res {
    static constexpr bool PERM = true; static constexpr int NSTORES = 16;
    bf16_t* O; const float* resid; int ldc;
    __device__ __forceinline__ void operator()(const f32x4 (&acc)[2][2][4][2], const Unit& u, int wr, int wc, int fr, int fq) const {
        const int row0 = u.pm * BM + wr * 64 + fr; const int col0 = u.pn * BM + wc * 32 + 8 * fq;
        f32x4 rb[3][4];
#define EBR_OFF(g) ((size_t)(row0 + ((g) >> 2) * HALF + ((g) & 3) * 16) * ldc + col0)
#define EBR_LOAD(g) do { const size_t off_ = EBR_OFF(g); _Pragma("unroll") for (int bj = 0; bj < 2; ++bj) { rb[(g) % 3][2 * bj] = *(const f32x4*)(resid + off_ + bj * HALF); rb[(g) % 3][2 * bj + 1] = *(const f32x4*)(resid + off_ + bj * HALF + 4); } } while (0)
        EBR_LOAD(0); EBR_LOAD(1);
#pragma unroll
        for (int g = 0; g < 8; ++g) {
            if (g + 2 < 8) EBR_LOAD(g + 2);
            const size_t off = EBR_OFF(g); const int ai = g >> 2, m = g & 3;
#pragma unroll
            for (int bj = 0; bj < 2; ++bj) { const f32x4 v0 = acc[ai][bj][m][0] + rb[g % 3][2 * bj], v1 = acc[ai][bj][m][1] + rb[g % 3][2 * bj + 1];
                u32x4 w; w.x = cvt_pk_bf16(v0[0], v0[1]); w.y = cvt_pk_bf16(v0[2], v0[3]); w.z = cvt_pk_bf16(v1[0], v1[1]); w.w = cvt_pk_bf16(v1[2], v1[3]);
                *(u32x4*)(O + off + bj * HALF) = w; } }
#undef EBR_LOAD
#undef EBR_OFF
    }
};
#ifndef USE_BIAS_LDS
#define USE_BIAS_LDS 0
#endif
template <int MODE = 0> struct EpiFp8S_ {
    static constexpr int NSTORES = 16;
    static constexpr bool PERM = true, BIAS_LDS = (USE_BIAS_LDS != 0);
    unsigned char* O; int ldc; const float* bias; int bias_stride; float scale, oscale;
    __device__ __forceinline__ const char* bias_base(const Unit& u) const { return (const char*)(bias + (size_t)u.e * bias_stride + u.pn * BM); }
    __device__ static __forceinline__ unsigned bias_voff(int i) { return (unsigned)i * 4u; }
    __device__ __forceinline__ void operator()(const f32x4 (&acc)[2][2][4][2], const Unit& u, int wr, int wc, int fr, int fq, const LAS float* bl) const {
        const int row0 = u.pm * BM + wr * 64 + fr; const int col0 = u.pn * BM + wc * 32 + 8 * fq;
        f32x4 bv[2][2];
#pragma unroll
        for (int bj = 0; bj < 2; ++bj)
#pragma unroll
            for (int n = 0; n < 2; ++n) { if constexpr (MODE == 2) bv[bj][n] = (f32x4){oscale, oscale, oscale, oscale}; else if constexpr (BIAS_LDS) bv[bj][n] = *(const LAS f32x4*)(bl + wc * 32 + 8 * fq + bj * HALF + 4 * n) * oscale; else bv[bj][n] = *(const f32x4*)(bias + (size_t)u.e * bias_stride + col0 + bj * HALF + 4 * n) * oscale; }
        const float sc = scale * oscale;
#pragma unroll
        for (int ai = 0; ai < 2; ++ai)
#pragma unroll
            for (int m = 0; m < 4; ++m) { unsigned char* rowp = O + (size_t)(row0 + ai * HALF + m * 16) * ldc + col0;
#pragma unroll
                for (int bj = 0; bj < 2; ++bj) { const f32x4 v0 = acc[ai][bj][m][0] * sc + bv[bj][0], v1 = acc[ai][bj][m][1] * sc + bv[bj][1];
                    u32x2 w; w.x = pk4_fp8(v0[0], v0[1], v0[2], v0[3]); w.y = pk4_fp8(v1[0], v1[1], v1[2], v1[3]);
                    if constexpr (MODE == 1) { if (u.pm < 0) *(u32x2*)(rowp + bj * HALF) = w; else asm volatile("" :: "v"(w)); } else *(u32x2*)(rowp + bj * HALF) = w; } }
    }
};
using EpiFp8S = EpiFp8S_<0>;
struct EpiSwiGLU8 {
    static constexpr bool PERM = true, BIAS_LDS = (USE_BIAS_LDS != 0); static constexpr int NSTORES = 8;
    unsigned char* O; int ldc; const float* bias;
    struct Bias { f32x4 bg[2], bu[2];
        __device__ __forceinline__ void pin() { asm volatile("" : "+v"(bg[0]), "+v"(bg[1]), "+v"(bu[0]), "+v"(bu[1])); } };
    __device__ __forceinline__ const char* bias_base(const Unit& u) const { return (const char*)(bias + (size_t)u.e * 4096 + u.pn * HALF); }
    __device__ static __forceinline__ unsigned bias_voff(int i) { return (unsigned)(i < 128 ? i : 2048 - 128 + i) * 4u; }
    __device__ __forceinline__ void load_bias(const Unit& u, int wc, int fq, Bias& b, const LAS float* bl) const {
        const int j0 = wc * 32 + 8 * fq;
        if constexpr (BIAS_LDS) {
#pragma unroll
            for (int n = 0; n < 2; ++n) { b.bg[n] = *(const LAS f32x4*)(bl + j0 + 4 * n); b.bu[n] = *(const LAS f32x4*)(bl + 128 + j0 + 4 * n); }
        } else { const float* be = bias + (size_t)u.e * 4096 + u.pn * HALF + j0;
#pragma unroll
            for (int n = 0; n < 2; ++n) { b.bg[n] = *(const f32x4*)(be + 4 * n); b.bu[n] = *(const f32x4*)(be + 2048 + 4 * n); } } }
    __device__ __forceinline__ void operator()(const f32x4 (&acc)[2][2][4][2], const Unit& u, int wr, int wc, int fr, int fq, const LAS float* bl) const { Bias b; load_bias(u, wc, fq, b, bl); apply(acc, u, wr, wc, fr, fq, b); }
    __device__ __forceinline__ void apply(const f32x4 (&acc)[2][2][4][2], const Unit& u, int wr, int wc, int fr, int fq, const Bias& b) const {
        const int row0 = u.pm * BM + wr * 64 + fr; const int j0 = u.pn * HALF + wc * 32 + 8 * fq;
        const f32x4 (&bg)[2] = b.bg; const f32x4 (&bu)[2] = b.bu;
#pragma unroll
        for (int ai = 0; ai < 2; ++ai)
#pragma unroll
            for (int m = 0; m < 4; ++m) { unsigned char* rowp = O + (size_t)(row0 + ai * HALF + m * 16) * ldc + j0;
                float o[8];
#pragma unroll
                for (int n = 0; n < 2; ++n) { const f32x4 g = acc[ai][0][m][n] * (1.0f / 8192.0f) + bg[n], up = acc[ai][1][m][n] * (1.0f / 8192.0f) + bu[n];
#pragma unroll
                    for (int q = 0; q < 4; ++q) { const float gt = fminf(g[q], 7.0f), ut = __builtin_amdgcn_fmed3f(up[q], -7.0f, 7.0f);
                        const float glu = gt * __builtin_amdgcn_rcpf(1.0f + __builtin_amdgcn_exp2f(-2.4554669595930156f * gt)); o[4 * n + q] = __builtin_fmaf(ut, 4.0f, 4.0f) * glu; } }
                u32x2 w; w.x = pk4_fp8_nc(o[0], o[1], o[2], o[3]); w.y = pk4_fp8_nc(o[4], o[5], o[6], o[7]);
                *(u32x2*)rowp = w; }
    }
};
template <int ALL> struct EpiNull_ { static constexpr bool PERM = true;
    __device__ __forceinline__ void operator()(const f32x4 (&acc)[2][2][4][2], const Unit& u, int wr, int wc, int fr, int fq) const {
        if constexpr (ALL == 0) asm volatile("" :: "v"(acc[0][0][0][0]), "v"(acc[1][1][3][1]));
        else {
#pragma unroll
        for (int a = 0; a < 2; ++a)
#pragma unroll
            for (int b = 0; b < 2; ++b) asm volatile("" :: "v"(acc[a][b][0][0]), "v"(acc[a][b][0][1]), "v"(acc[a][b][1][0]), "v"(acc[a][b][1][1]), "v"(acc[a][b][2][0]), "v"(acc[a][b][2][1]), "v"(acc[a][b][3][0]), "v"(acc[a][b][3][1])); } } };
using EpiNull = EpiNull_<1>;
struct EpiBf16S {
    static constexpr bool PERM = true;
    bf16_t* O; int ldc; const float* bias; int bias_stride; float scale;
    __device__ __forceinline__ void operator()(const f32x4 (&acc)[2][2][4][2], const Unit& u, int wr, int wc, int fr, int fq) const {
        const int row0 = u.pm * BM + wr * 64 + fr; const int col0 = u.pn * BM + wc * 32 + 8 * fq;
        f32x4 bv[2][2];
#pragma unroll
        for (int bj = 0; bj < 2; ++bj)
#pragma unroll
            for (int n = 0; n < 2; ++n) bv[bj][n] = *(const f32x4*)(bias + (size_t)u.e * bias_stride + col0 + bj * HALF + 4 * n);
#pragma unroll
        for (int ai = 0; ai < 2; ++ai)
#pragma unroll
            for (int m = 0; m < 4; ++m) { bf16_t* rowp = O + (size_t)(row0 + ai * HALF + m * 16) * ldc + col0;
#pragma unroll
                for (int bj = 0; bj < 2; ++bj) { const f32x4 v0 = acc[ai][bj][m][0] * scale + bv[bj][0], v1 = acc[ai][bj][m][1] * scale + bv[bj][1];
                    u32x4 w; w.x = cvt_pk_bf16(v0[0], v0[1]); w.y = cvt_pk_bf16(v0[2], v0[3]); w.z = cvt_pk_bf16(v1[0], v1[1]); w.w = cvt_pk_bf16(v1[2], v1[3]);
                    *(u32x4*)(rowp + bj * HALF) = w; } }
    }
};

__device__ __forceinline__ i32x8 pg8_get8(const i32x32& v, int idx) { i32x8 r;
#pragma unroll
    for (int j = 0; j < 8; ++j) r[j] = v[8 * idx + j];
    return r; }
__device__ __forceinline__ i32x4 pg8_get4(const i32x32& v, int idx) { i32x4 r;
#pragma unroll
    for (int j = 0; j < 4; ++j) r[j] = v[4 * idx + j];
    return r; }
struct NoHost { static constexpr bool ON = false; static constexpr int N = 0; };
template <int N_> struct EpiHost {
    static constexpr bool ON = true; static constexpr int N = N_;
    const float* W; unsigned char* WT; int cid, cend, cstride; int ldw, cbs, gu, e0; int pend[N_];
    __device__ __forceinline__ void issue(unsigned (&x)[16 * N_], int lane) {
        const unsigned vo = (unsigned)lane * 4u; const size_t rowb = (size_t)ldw * 4;
#pragma unroll
        for (int j = 0; j < N_; ++j) { const int id = cid < cend ? cid : cend - 1; pend[j] = id; cid += cstride;
            const int cb = id & ((1 << cbs) - 1), kb = (id >> cbs) & 127, e = e0 + (id >> (cbs + 7));
            const char* rb = (const char*)(W + (size_t)e * DM * ldw + (size_t)(16 * kb) * ldw + 64 * cb);
#pragma unroll
            for (int i = 0; i < 16; ++i) asm volatile("s_nop 4\n\tglobal_load_dword %0, %1, %2" : "=v"(x[16 * j + i]) : "v"(vo), "s"(rb + (size_t)i * rowb) : "memory"); }
    }
    __device__ __forceinline__ void finish(const unsigned (&x)[16 * N_], int lane) const {
#pragma unroll
        for (int j = 0; j < N_; ++j) { const int id = pend[j]; const int cb = id & ((1 << cbs) - 1), kb = (id >> cbs) & 127, e = e0 + (id >> (cbs + 7)); const int n0 = 64 * cb;
            const int drow0 = !gu ? n0 : (n0 < 2048) ? (256 * (n0 >> 7) + (n0 & 127)) : (256 * ((n0 - 2048) >> 7) + 128 + ((n0 - 2048) & 127));
            u32x4 o;
#pragma unroll
            for (int q = 0; q < 4; ++q) o[q] = pk4_fp8(__builtin_bit_cast(float, x[16 * j + 4 * q]) * 512.0f, __builtin_bit_cast(float, x[16 * j + 4 * q + 1]) * 512.0f, __builtin_bit_cast(float, x[16 * j + 4 * q + 2]) * 512.0f, __builtin_bit_cast(float, x[16 * j + 4 * q + 3]) * 512.0f);
            *(u32x4*)(WT + (size_t)e * ldw * DM + (size_t)(drow0 + lane) * DM + 16 * kb) = o; }
    }
};
struct NoGather { static constexpr bool ON = false; };
struct Gather { static constexpr bool ON = true; const unsigned short* list; const LAS unsigned* pbase; const LAS unsigned* cnt; };
__device__ __forceinline__ unsigned gather_clamp(unsigned P, int r0, int cn) { const unsigned lo = (r0 < cn) ? (P & 0xffffu) : 0u, hi = (r0 + 64 < cn) ? (P >> 16) : 0u; return lo | (hi << 16); }
struct NoConv { static constexpr bool ON = false; };
struct ConvGU {
    static constexpr bool ON = true;
    const float* W; unsigned char* WT; int cid, cend, cstride, pend; const char* rbase;
    __device__ __forceinline__ void issue(unsigned (&x)[16], int lane) {
        const int id = cid < cend ? cid : cend - 1; pend = id; cid += cstride;
        const int e = id >> 13, kb = (id >> 6) & 127, cb = id & 63;
        const char* rb = (const char*)(W + (size_t)e * DM * 4096 + (size_t)(16 * kb) * 4096 + 64 * cb);
        const unsigned vo = (unsigned)lane * 4u; rbase = rb;
#pragma unroll
        for (int i = 0; i < 8; ++i) asm volatile("s_nop 4\n\tglobal_load_dword %0, %1, %2" : "=v"(x[i]) : "v"(vo), "s"(rb + (size_t)i * 16384) : "memory");
    }
    __device__ __forceinline__ void issue_b(unsigned (&x)[16], int lane) {
        const unsigned vo = (unsigned)lane * 4u;
#pragma unroll
        for (int i = 8; i < 16; ++i) asm volatile("s_nop 4\n\tglobal_load_dword %0, %1, %2" : "=v"(x[i]) : "v"(vo), "s"(rbase + (size_t)i * 16384) : "memory");
    }
    __device__ __forceinline__ void finish(const unsigned (&x)[16], int lane) const {
        const int id = pend; const int e = id >> 13, kb = (id >> 6) & 127, cb = id & 63; const int n0 = 64 * cb;
        const int drow0 = (n0 < 2048) ? (256 * (n0 >> 7) + (n0 & 127)) : (256 * ((n0 - 2048) >> 7) + 128 + ((n0 - 2048) & 127));
        u32x4 o;
#pragma unroll
        for (int q = 0; q < 4; ++q) o[q] = pk4_fp8(__builtin_bit_cast(float, x[4 * q]) * 512.0f, __builtin_bit_cast(float, x[4 * q + 1]) * 512.0f, __builtin_bit_cast(float, x[4 * q + 2]) * 512.0f, __builtin_bit_cast(float, x[4 * q + 3]) * 512.0f);
        *(u32x4*)(WT + (size_t)e * 4096 * DM + (size_t)(drow0 + lane) * DM + 16 * kb) = o;
    }
};
#define PG8_X16A(x, b) "+v"(x[b+0]), "+v"(x[b+1]), "+v"(x[b+2]), "+v"(x[b+3]), "+v"(x[b+4]), "+v"(x[b+5]), "+v"(x[b+6]), "+v"(x[b+7]), "+v"(x[b+8]), "+v"(x[b+9]), "+v"(x[b+10]), "+v"(x[b+11]), "+v"(x[b+12]), "+v"(x[b+13]), "+v"(x[b+14]), "+v"(x[b+15])
#define PG8_X16(x) "+v"(x[0]), "+v"(x[1]), "+v"(x[2]), "+v"(x[3]), "+v"(x[4]), "+v"(x[5]), "+v"(x[6]), "+v"(x[7]), "+v"(x[8]), "+v"(x[9]), "+v"(x[10]), "+v"(x[11]), "+v"(x[12]), "+v"(x[13]), "+v"(x[14]), "+v"(x[15])

template <class E, class = void> struct epi_nstores { static constexpr int value = 0; };
template <class E> struct epi_nstores<E, decltype((void)E::NSTORES)> { static constexpr int value = E::NSTORES; };
template <class E, class = void> struct epi_takes_bl { static constexpr bool value = false; };
template <class E> struct epi_takes_bl<E, decltype((void)E::BIAS_LDS)> { static constexpr bool value = true; };
template <class E, class = void> struct has_bias_lds { static constexpr bool value = false; };
template <class E> struct has_bias_lds<E, decltype((void)E::BIAS_LDS)> { static constexpr bool value = E::BIAS_LDS; };
constexpr int BIAS_LDS_OFF = MISC_OFF + 4096;
#ifndef CV_XMASK
#define CV_XMASK 0
#endif
template <class Epi, class Sched, class GS, bool ALIGN_EPI = true, bool F8 = false, int STAGGER_TICKS = 0, class CV = NoConv, class EH = NoHost, bool KROT = false, class GI = NoGather, bool FLP = false>
__device__ __forceinline__ void gemm_phase(LAS unsigned char* lds, const Gemm g, const Sched& S, const Epi& E, int wave, CV cv = CV(), EH eh = EH(), GI gi = GI()) {
    const int wid = wave, lane = fresh_lane(), tid = wid * 64 + lane, wr = wid >> 2, wc = wid & 3, fr = lane & 15, fq = lane >> 4;
    constexpr int nt = GS::KB / 128;
    unsigned voffA, voffB;
    { int R, C; stage_rc(tid * 16, R, C); const int Rb = Epi::PERM ? ((R & ~31) + perm32(R & 31)) : R;
      voffA = (unsigned)(R * GS::LDA + C * 2); voffB = (unsigned)(Rb * GS::LDB + C * 2);
      if constexpr (FLP) { const int b = tid * 16; voffA = (unsigned)((b >> 7) * GS::LDA + (b & 127)); voffB = (unsigned)((b >> 7) * GS::LDB + (b & 127)); } }
    constexpr size_t pstepA = (size_t)64 * GS::LDA, pstepB = (size_t)64 * GS::LDB;
    constexpr size_t kstep = (size_t)(BK * 2);
    constexpr size_t hstepA = (size_t)HALF * GS::LDA, hstepB = (size_t)HALF * GS::LDB;
    constexpr size_t tstepA = 2 * hstepA, tstepB = 2 * hstepB;
    const unsigned ldsw = (unsigned)wid * 1024u;
    const unsigned ldsb = (unsigned)(size_t)lds + ldsw;
    const int aoff = lds_byte(wr * 64 + fr, F8 ? fq * 16 : fq * 8), boff = lds_byte(wc * 32 + fr, F8 ? fq * 16 : fq * 8);
    const int kofs = F8 ? 16 : 1024;
#define PG8_SA(b, h) (((b) * 2 + (h)) * HTB)
#define PG8_SB(b, h) ((4 + (b) * 2 + (h)) * HTB)
#define PG8_STAGE(bufoff, gbase, voff) do { _Pragma("unroll") for (int _i = 0; _i < 2; ++_i) { unsigned _keep; \
        asm volatile("s_mov_b32 %0, m0\n\ts_mov_b32 m0, %3\n\ts_nop 3\n\tglobal_load_lds_dwordx4 %1, %2\n\ts_mov_b32 m0, %0" \
            : "=&s"(_keep) : "v"(voff##_v), "s"((const char*)(gbase) + _i * pstep##voff), "s"(ldsb + (unsigned)((bufoff) + _i * 8192)) : "memory"); } } while (0)
#define PG8_STAGE_GA(bufoff, kp, vlo, vhi) do { unsigned _keep; \
        asm volatile("s_mov_b32 %0, m0\n\ts_mov_b32 m0, %3\n\ts_nop 3\n\tglobal_load_lds_dwordx4 %1, %2\n\ts_mov_b32 m0, %0" : "=&s"(_keep) : "v"(vlo), "s"((const char*)(kp)), "s"(ldsb + (unsigned)(bufoff)) : "memory"); \
        asm volatile("s_mov_b32 %0, m0\n\ts_mov_b32 m0, %3\n\ts_nop 3\n\tglobal_load_lds_dwordx4 %1, %2\n\ts_mov_b32 m0, %0" : "=&s"(_keep) : "v"(vhi), "s"((const char*)(kp)), "s"(ldsb + (unsigned)((bufoff) + 8192)) : "memory"); } while (0)
#define PG8_STA(bufoff, kp, h, nx) do { if constexpr (GI::ON) { const unsigned _p = (nx) ? nvP[h] : voP[h]; const unsigned _lo = ((_p & 0xffffu) << 11) + gcb, _hi = ((_p >> 16) << 11) + gcb; PG8_STAGE_GA(bufoff, kp, _lo, _hi); } \
        else PG8_STAGE(bufoff, (kp) + (h) * hstepA, voffA); } while (0)
#define pstepvoffA pstepA
#define pstepvoffB pstepB
#define voffA_v voffA
#define voffB_v voffB
#define PG8_LD16(p) (*(const LAS i32x4*)(p))
#define PG8_SET8(V, idx, lo, hi) do { _Pragma("unroll") for (int _j = 0; _j < 4; ++_j) { V[8 * (idx) + _j] = (lo)[_j]; V[8 * (idx) + 4 + _j] = (hi)[_j]; } } while (0)
#define PG8_GET8(V, idx) pg8_get8(V, idx)
#define PG8_GETLO(V, idx) __builtin_bit_cast(bf16x8, pg8_get4(V, 2 * (idx)))
#define PG8_GETHI(V, idx) __builtin_bit_cast(bf16x8, pg8_get4(V, 2 * (idx) + 1))
#define PG8_LDA(dst, b, h) do { _Pragma("unroll") for (int m = 0; m < 4; ++m) { const i32x4 _lo = PG8_LD16(lds + PG8_SA(b, h) + aoff + m * 2048), _hi = PG8_LD16(lds + PG8_SA(b, h) + aoff + m * 2048 + kofs); \
        PG8_SET8(AV, m, _lo, _hi); } } while (0)
#define PG8_LDB(dst, b, h) do { _Pragma("unroll") for (int n = 0; n < 2; ++n) { const i32x4 _lo = PG8_LD16(lds + PG8_SB(b, h) + boff + n * 2048), _hi = PG8_LD16(lds + PG8_SB(b, h) + boff + n * 2048 + kofs); \
        PG8_SET8(BV, (dst) + n, _lo, _hi); } } while (0)
#define PG8_MMA(ai, bj, At, Bt) do { __builtin_amdgcn_s_setprio(1); \
        if constexpr (F8) { _Pragma("unroll") for (int m = 0; m < 4; ++m) _Pragma("unroll") for (int n = 0; n < 2; ++n) \
            acc[ai][bj][m][n] = __builtin_amdgcn_mfma_scale_f32_16x16x128_f8f6f4(PG8_GET8(BV, (Bt) + n), PG8_GET8(AV, m), acc[ai][bj][m][n], 0, 0, 0, 0, 0, 0); } \
        else { _Pragma("unroll") for (int m = 0; m < 4; ++m) _Pragma("unroll") for (int n = 0; n < 2; ++n) { \
            acc[ai][bj][m][n] = __builtin_amdgcn_mfma_f32_16x16x32_bf16(PG8_GETLO(BV, (Bt) + n), PG8_GETLO(AV, m), acc[ai][bj][m][n], 0, 0, 0); \
            acc[ai][bj][m][n] = __builtin_amdgcn_mfma_f32_16x16x32_bf16(PG8_GETHI(BV, (Bt) + n), PG8_GETHI(AV, m), acc[ai][bj][m][n], 0, 0, 0); } } \
        __builtin_amdgcn_s_setprio(0); } while (0)
#define PG8_WAIT_V(n) asm volatile("s_waitcnt vmcnt(" #n ")" ::: "memory")
#define PG8_WAIT_L(n) asm volatile("s_waitcnt lgkmcnt(" #n ")" ::: "memory")
#define PG8_BAR __builtin_amdgcn_s_barrier()
#define PG8_SCHED __builtin_amdgcn_sched_barrier(0)
    Unit cur, nxt; int ui = 0;
    if (!S.next(0, cur)) return;
    constexpr bool BL = has_bias_lds<Epi>::value;
    constexpr int NST = EH::ON ? EH::N : epi_nstores<Epi>::value;
#define PG8_WAIT_VN(n) asm volatile("s_waitcnt vmcnt(%0)" :: "n"(n) : "memory")
    static_assert(!(BL && CV::ON), "the counted waits below know one or the other");
    unsigned bx = 0;
    unsigned cx[16];
    if constexpr (CV::ON) { cv.issue(cx, lane); cv.issue_b(cx, lane); asm volatile("s_waitcnt vmcnt(0)" ::: "memory"); asm volatile("" : PG8_X16(cx) :: "memory"); }
    if constexpr (STAGGER_TICKS > 0) {
        if (blockIdx.x & 1) { const unsigned long long t0 = __builtin_amdgcn_s_memrealtime(); while (__builtin_amdgcn_s_memrealtime() - t0 < (unsigned long long)STAGGER_TICKS) __builtin_amdgcn_s_sleep(8); } }
    i32x32 AV, BV;
    constexpr int At = 0, B0 = 0, B1 = 2;
    static_assert(!GI::ON || GS::LDA == 2048, "gather: 2 KiB token rows");
    int tfetch = 0; if constexpr (GI::ON) asm volatile("s_mov_b32 %0, 0" : "=s"(tfetch));
    unsigned voP[2] = {0u, 0u}, nvP[2] = {0u, 0u}, gcb = 0u;
    if constexpr (GI::ON) { int R, C; stage_rc(tid * 16, R, C); gcb = (unsigned)(C * 2);
        const int lb = cur.pm * BM - __builtin_amdgcn_readfirstlane((int)gi.pbase[cur.e]), cn = __builtin_amdgcn_readfirstlane((int)gi.cnt[cur.e]);
        const u32x2 pr = *(const u32x2*)(gi.list + (size_t)cur.e * 16384 + lb + 4 * R);
        voP[0] = gather_clamp(pr.x, lb + R, cn); voP[1] = gather_clamp(pr.y, lb + R + 128, cn); }
    const char* cA = GI::ON ? (const char*)g.A : (const char*)g.A + (size_t)cur.pm * tstepA; const char* cB = (const char*)g.Bt + (size_t)cur.e * GS::SB + (size_t)cur.pn * tstepB;
#define PG8_KO(u) (KROT ? ((((u).pn & 7) * 2 + ((u).pm & 3) * 4) * (nt / 16)) & (nt - 1) : 0)
    int ko = PG8_KO(cur);
    { const char* pA = cA + (size_t)ko * kstep; const char* pB = cB + (size_t)ko * kstep;
    PG8_STAGE(PG8_SB(0, 0), pB, voffB); PG8_SCHED; PG8_STAGE(PG8_SB(0, 1), pB + hstepB, voffB); PG8_SCHED; PG8_STA(PG8_SA(0, 0), pA, 0, false); PG8_SCHED; PG8_STA(PG8_SA(0, 1), pA, 1, false); PG8_SCHED;
    if (wr == 1) PG8_BAR;
    PG8_WAIT_V(2); PG8_BAR;
    PG8_STAGE(PG8_SB(1, 0), pB + kstep, voffB); PG8_SCHED; PG8_STA(PG8_SA(1, 0), pA + kstep, 0, false); PG8_SCHED; PG8_STAGE(PG8_SB(1, 1), pB + hstepB + kstep, voffB); PG8_SCHED; }
    PG8_WAIT_V(6); PG8_BAR; PG8_SCHED;
    f32x4 acc[2][2][4][2];
#pragma unroll
    for (int a = 0; a < 2; ++a)
#pragma unroll
        for (int b = 0; b < 2; ++b)
#pragma unroll
            for (int m = 0; m < 4; ++m)
#pragma unroll
                for (int n = 0; n < 2; ++n) acc[a][b][m][n] = (f32x4){0.f, 0.f, 0.f, 0.f};
    for (;;) {
        const bool has_next = S.next(ui + 1, nxt);
        const char* nA = (has_next && !GI::ON) ? (const char*)g.A + (size_t)nxt.pm * tstepA : cA;
        const char* nB = has_next ? (const char*)g.Bt + (size_t)nxt.e * GS::SB + (size_t)nxt.pn * tstepB : cB;
        const int nko = has_next ? PG8_KO(nxt) : ko;
        for (int t = 0; t < nt; t += 2) {
            const bool last = (t == nt - 2);
            const int kt = KROT ? ((ko + t) & (nt - 1)) : t, kt2 = KROT ? ((ko + t + 2) & (nt - 1)) : t + 2;
            const char* a1 = cA + (size_t)(kt + 1) * kstep;
            const char* a2 = last ? nA + (size_t)nko * kstep : cA + (size_t)kt2 * kstep; const char* b2 = last ? nB + (size_t)nko * kstep : cB + (size_t)kt2 * kstep;
            const char* a3 = a2 + kstep; const char* b3 = b2 + kstep;
            PG8_LDB(B0, 0, 0); PG8_LDB(B1, 0, 1); PG8_SCHED; PG8_LDA(At, 0, 0); PG8_STA(PG8_SA(1, 1), a1, 1, false);
            PG8_WAIT_V(8);
            if constexpr (CV::ON) asm volatile("" : PG8_X16(cx));
            PG8_WAIT_L(0); PG8_BAR;
            const bool xon = CV::ON && ((t & CV_XMASK) == 0);
            if constexpr (CV::ON) { if (xon) { cv.finish(cx, lane); cv.issue(cx, lane); } }
            if constexpr (GI::ON) { if (t == tfetch && has_next) {
                int R, C; stage_rc((wid * 64 + fresh_lane()) * 16, R, C); const unsigned lvo = (unsigned)R * 8u;
                const char* lp = (const char*)(gi.list + (size_t)nxt.e * 16384 + (nxt.pm * BM - __builtin_amdgcn_readfirstlane((int)gi.pbase[nxt.e])));
                u32x2 pr; asm volatile("s_nop 4\n\tglobal_load_dwordx2 %0, %1, %2" : "=&v"(pr) : "v"(lvo), "s"(lp) : "memory"); nvP[0] = pr.x; nvP[1] = pr.y; } }
            if constexpr (BL) { if (last) { const unsigned bvo = Epi::bias_voff((wid * 64 + fresh_lane()) & 255);
                asm volatile("s_nop 4\n\tglobal_load_dword %0, %1, %2" : "=v"(bx) : "v"(bvo), "s"(E.bias_base(cur)) : "memory"); } }
            PG8_MMA(0, 0, At, B0); PG8_MMA(0, 1, At, B1); PG8_BAR; PG8_SCHED;
            PG8_LDA(At, 0, 1); PG8_STAGE(PG8_SB(0, 0), b2, voffB); PG8_STAGE(PG8_SB(0, 1), b2 + hstepB, voffB); PG8_STA(PG8_SA(0, 0), a2, 0, last);
            if (xon) PG8_WAIT_V(17); else if (BL && last) PG8_WAIT_V(9); else if (GI::ON && t == tfetch && has_next) PG8_WAIT_V(9); else PG8_WAIT_V(8);
            PG8_WAIT_L(0); PG8_BAR;
            if constexpr (CV::ON) { if (xon) cv.issue_b(cx, lane); }
            PG8_MMA(1, 0, At, B0); PG8_MMA(1, 1, At, B1); PG8_BAR; PG8_SCHED;
            PG8_LDB(B0, 1, 0); PG8_LDB(B1, 1, 1); PG8_SCHED; PG8_LDA(At, 1, 0); PG8_STA(PG8_SA(0, 1), a2, 1, last);
            if (xon) PG8_WAIT_V(25); else PG8_WAIT_V(8);
            if constexpr (GI::ON) { if (t == tfetch && has_next) { asm volatile("" : "+v"(nvP[0]), "+v"(nvP[1]));
                int R, C; stage_rc((wid * 64 + fresh_lane()) * 16, R, C); const int lb = nxt.pm * BM - __builtin_amdgcn_readfirstlane((int)gi.pbase[nxt.e]), cn = __builtin_amdgcn_readfirstlane((int)gi.cnt[nxt.e]);
                nvP[0] = gather_clamp(nvP[0], lb + R, cn); nvP[1] = gather_clamp(nvP[1], lb + R + 128, cn); } }
            if constexpr (BL) { if (last) { asm volatile("" : "+v"(bx));
                *(LAS unsigned*)(lds + BIAS_LDS_OFF + 4 * ((wid * 64 + fresh_lane()) & 255)) = bx; } }
            PG8_WAIT_L(0); PG8_BAR; PG8_MMA(0, 0, At, B0); PG8_MMA(0, 1, At, B1); PG8_BAR; PG8_SCHED;
            PG8_LDA(At, 1, 1); PG8_STAGE(PG8_SB(1, 0), b3, voffB); PG8_STAGE(PG8_SB(1, 1), b3 + hstepB, voffB); PG8_STA(PG8_SA(1, 0), a3, 0, last);
            if constexpr (CV::ON) { if (xon) PG8_WAIT_V(16); else PG8_WAIT_V(8); } else PG8_WAIT_V(8);
            PG8_WAIT_L(0); PG8_BAR; PG8_MMA(1, 0, At, B0); PG8_MMA(1, 1, At, B1); PG8_BAR; PG8_SCHED;
        }
        if constexpr (ALIGN_EPI) { if (wr == 0) PG8_BAR; }
        { const int l2 = fresh_lane();
          const LAS float* bl = (const LAS float*)(lds + BIAS_LDS_OFF);
          if constexpr (EH::ON) {
              unsigned ex[16 * EH::N]; typename Epi::Bias eb;
              if constexpr (BL) { eh.issue(ex, l2); E.load_bias(cur, wc, l2 >> 4, eb, bl); }
              else { E.load_bias(cur, wc, l2 >> 4, eb, bl); eb.pin(); eh.issue(ex, l2); }
              E.apply(acc, cur, wr, wc, l2 & 15, l2 >> 4, eb);
              asm volatile("s_waitcnt vmcnt(0)" ::: "memory");
              if constexpr (EH::N == 3) asm volatile("" : PG8_X16A(ex, 0), PG8_X16A(ex, 16), PG8_X16A(ex, 32) :: "memory");
              else asm volatile("" : PG8_X16A(ex, 0), PG8_X16A(ex, 16), PG8_X16A(ex, 32), PG8_X16A(ex, 48) :: "memory");
              eh.finish(ex, l2);
          } else if constexpr (epi_takes_bl<Epi>::value) E(acc, cur, wr, wc, l2 & 15, l2 >> 4, bl);
          else E(acc, cur, wr, wc, l2 & 15, l2 >> 4); }
        if (!has_next) break;
#pragma unroll
        for (int a = 0; a < 2; ++a)
#pragma unroll
            for (int b = 0; b < 2; ++b)
#pragma unroll
                for (int m = 0; m < 4; ++m)
#pragma unroll
                    for (int n = 0; n < 2; ++n) acc[a][b][m][n] = (f32x4){0.f, 0.f, 0.f, 0.f};
        cur = nxt; cA = nA; cB = nB; ko = nko; ++ui;
        if constexpr (GI::ON) {
#pragma unroll
            for (int i = 0; i < 2; ++i) voP[i] = nvP[i]; }
        if constexpr (ALIGN_EPI) { if (wr == 1) PG8_BAR; }
    }
    if constexpr (CV::ON) { asm volatile("s_waitcnt vmcnt(0)" ::: "memory"); asm volatile("" : PG8_X16(cx) :: "memory"); cv.finish(cx, lane); }
    else PG8_WAIT_V(0);
    if constexpr (!ALIGN_EPI) { if (wr == 0) PG8_BAR; }
    PG8_BAR;
#undef PG8_SA
#undef PG8_KO
#undef PG8_SB
#undef PG8_STAGE
#undef PG8_STAGE_GA
#undef PG8_STA
#undef pstepvoffA
#undef pstepvoffB
#undef voffA_v
#undef voffB_v
#undef PG8_LDA
#undef PG8_LD16
#undef PG8_SET8
#undef PG8_GET8
#undef PG8_GETLO
#undef PG8_GETHI
#undef PG8_LDB
#undef PG8_MMA
#undef PG8_WAIT_V
#undef PG8_WAIT_VN
#undef PG8_WAIT_L
#undef PG8_BAR
#undef PG8_SCHED
}
}
struct Params {
    const float* in[22];
    float* out; unsigned char* ws;
    int ph_lo, ph_hi;
};
enum { I_X = 0, I_NMG, I_WIN, I_GWG, I_GBG, I_GNG, I_CW, I_CB, I_WA, I_BA, I_WI, I_BI, I_AP, I_WOUT, I_NFG, I_WR, I_BR, I_WGU, I_BGU, I_WDN, I_BDN, I_NFINAL };

struct Frame {
    LAS unsigned char* lds; volatile LAS unsigned* MISC;
    int tid, lane, wave, G, gw, NGW;
    unsigned char* ws;
};

__device__ __forceinline__ float gelu_tanh_f(float x) {
    const float u = 0.7978845608028654f * (x + 0.044715f * x * x * x);
    const float e = __expf(2.0f * u);
    const float th = 1.0f - 2.0f * __builtin_amdgcn_rcpf(e + 1.0f);
    return 0.5f * x * (1.0f + th);
}
__device__ __forceinline__ float log_sigmoid_f(float s) { return fminf(s, 0.f) - __logf(1.0f + __expf(-fabsf(s))); }

__device__ __forceinline__ void p0_item(const float* W, int ldw, int col0, bf16_t* WT, int ldt, size_t drow0, int k0, LAS float* scr, int lane) {
    (void)scr;
    const float* src = W + (size_t)k0 * ldw + col0 + lane;
    float v[64];
#pragma unroll
    for (int i = 0; i < 64; ++i) v[i] = src[(size_t)i * ldw];
    bf16_t* dst = WT + (drow0 + lane) * (size_t)ldt + k0;
#pragma unroll
    for (int c = 0; c < 8; ++c) { u32x4 o; o.x = pk2(v[8 * c], v[8 * c + 1]); o.y = pk2(v[8 * c + 2], v[8 * c + 3]); o.z = pk2(v[8 * c + 4], v[8 * c + 5]); o.w = pk2(v[8 * c + 6], v[8 * c + 7]);
        *(u32x4*)(dst + 8 * c) = o; }
}

__device__ __forceinline__ void p0_item8(const float* W, int ldw, int col0, unsigned char* WT, int ldt, size_t drow0, int k0, int lane) {
    const float* src = W + (size_t)k0 * ldw + col0 + lane;
    float v[64];
#pragma unroll
    for (int i = 0; i < 64; ++i) v[i] = src[(size_t)i * ldw];
    unsigned char* dst = WT + (drow0 + lane) * (size_t)ldt + k0;
#pragma unroll
    for (int c = 0; c < 4; ++c) { u32x4 o;
#pragma unroll
        for (int q = 0; q < 4; ++q) o[q] = pk4_fp8(v[16 * c + 4 * q] * 512.0f, v[16 * c + 4 * q + 1] * 512.0f, v[16 * c + 4 * q + 2] * 512.0f, v[16 * c + 4 * q + 3] * 512.0f);
        *(u32x4*)(dst + 16 * c) = o; }
}

constexpr int CONV_EXPERTS_P0 = 28, HOST_DN_EXPERTS_P0 = 24;
struct CoopTile { const float* W; int ldw; int col0; unsigned char* WT; int ldt_b; int mode; int k0; int gu; int drow0; };
__device__ __forceinline__ void coop_load(const CoopTile& t, int w, int l, f32x4 (&v)[16]) {
    if (t.mode == 0) {
#pragma unroll
        for (int i = 0; i < 8; ++i) { const float* r = t.W + (size_t)(t.k0 + 8 * w + i) * t.ldw + t.col0 + 4 * l; v[2 * i] = *(const f32x4*)r; v[2 * i + 1] = *(const f32x4*)(r + 256); }
    } else {
#pragma unroll
        for (int i = 0; i < 16; ++i) v[i] = *(const f32x4*)(t.W + (size_t)(t.k0 + 16 * w + i) * t.ldw + t.col0 + 4 * l);
    }
}
__device__ __forceinline__ void coop_to_lds(const CoopTile& t, int w, int l, const f32x4 (&v)[16], LAS unsigned char* buf) {
    const int sw = (w ^ (l & 7)) * 16;
    if (t.mode == 0) {
#pragma unroll
        for (int jp = 0; jp < 2; ++jp)
#pragma unroll
            for (int j = 0; j < 4; ++j) { u32x4 o; if (t.ldw == INC) { o.x = PK2W(v[0 + jp][j], v[2 + jp][j]); o.y = PK2W(v[4 + jp][j], v[6 + jp][j]); o.z = PK2W(v[8 + jp][j], v[10 + jp][j]); o.w = PK2W(v[12 + jp][j], v[14 + jp][j]); } else { o.x = pk2(v[0 + jp][j], v[2 + jp][j]); o.y = pk2(v[4 + jp][j], v[6 + jp][j]); o.z = pk2(v[8 + jp][j], v[10 + jp][j]); o.w = pk2(v[12 + jp][j], v[14 + jp][j]); }
                *(LAS u32x4*)(buf + (256 * jp + 4 * l + j) * 128 + sw) = o; }
    } else {
#pragma unroll
        for (int j = 0; j < 4; ++j) { u32x4 o;
#pragma unroll
            for (int q = 0; q < 4; ++q) o[q] = pk4_fp8(v[4 * q][j] * 512.0f, v[4 * q + 1][j] * 512.0f, v[4 * q + 2][j] * 512.0f, v[4 * q + 3][j] * 512.0f);
            *(LAS u32x4*)(buf + (4 * l + j) * 128 + sw) = o; }
    }
}
__device__ __forceinline__ void coop_store(const CoopTile& t, int w, int l, const LAS unsigned char* buf) {
    const int nrows = t.mode == 0 ? 512 : 256; const int cp = l & 7;
    for (int n = 8 * w + (l >> 3); n < nrows; n += 64) {
        const u32x4 o = *(const LAS u32x4*)(buf + n * 128 + cp * 16); const int c = cp ^ ((n >> 2) & 7);
        int drow;
        if (t.gu) { const int g = t.col0 + n; drow = (g < 2048) ? (256 * (g >> 7) + (g & 127)) : (256 * ((g - 2048) >> 7) + 128 + ((g - 2048) & 127)); } else drow = t.drow0 + n;
        *(u32x4*)(t.WT + (size_t)drow * t.ldt_b + (t.mode == 0 ? 2 * t.k0 : t.k0) + 16 * c) = o; }
}
__device__ __forceinline__ bool coop_tile(const Params& p, unsigned char* ws, int it, CoopTile& t) {
    constexpr int N_GU = (32 - CONV_EXPERTS_P0) * 256, N_DN = (32 - HOST_DN_EXPERTS_P0) * 128, N_INA = 32 * 6, N_INB = 32 * 4, N_OUT = 32 * 4;
    int r = it;
    if (r < N_GU) { const int e = CONV_EXPERTS_P0 + (r >> 8), q = r & 255, kb = q >> 4, nb = q & 15; t = CoopTile{p.in[I_WGU] + (size_t)e * DM * 4096, 4096, 256 * nb, ws + WS_WGUT + (size_t)e * 4096 * DM, DM, 1, 128 * kb, 1, 0}; return true; } r -= N_GU;
    if (r < N_DN) { const int e = HOST_DN_EXPERTS_P0 + (r >> 7), q = r & 127, kb = q >> 3, nb = q & 7; t = CoopTile{p.in[I_WDN] + (size_t)e * DM * DM, DM, 256 * nb, ws + WS_WDT + (size_t)e * DM * DM, DM, 1, 128 * kb, 0, 256 * nb}; return true; } r -= N_DN;
    if (r < N_INA) { const int kb = r / 6, nb = r % 6; t = CoopTile{p.in[I_WIN], INC, 512 * nb, ws + WS_WINT, DM * 2, 0, 64 * kb, 0, 512 * nb}; return true; } r -= N_INA;
    if (r < N_INB) { const int kb = r >> 2, nb = r & 3; t = CoopTile{p.in[I_WIN], INC, 3088 + 512 * nb, ws + WS_WINT, DM * 2, 0, 64 * kb, 0, 3072 + 512 * nb}; return true; } r -= N_INB;
    if (r < N_OUT) { const int kb = r >> 2, nb = r & 3; t = CoopTile{p.in[I_WOUT], DM, 512 * nb, ws + WS_WOUTT, DM * 2, 0, 64 * kb, 0, 512 * nb}; return true; }
    return false;
}
__device__ __forceinline__ void p0a(Frame& F, const Params& p) {
    const int w = F.wave, l = F.lane;
    CoopTile cur, nxt; f32x4 v[16];
    int it = blockIdx.x; bool have = coop_tile(p, F.ws, it, cur);
    if (have) coop_load(cur, w, l, v);
    { bf16_t* WaT = (bf16_t*)(F.ws + WS_WAT); bf16_t* WiT = (bf16_t*)(F.ws + WS_WIT);
      for (int r = F.gw; r < 128; r += F.NGW) { const int which = r >> 6, h = (r >> 4) & 3, kb = (r >> 2) & 3, nb = r & 3;
          p0_item((which ? p.in[I_WI] : p.in[I_WA]) + (size_t)h * 65536, 256, 64 * nb, (which ? WiT : WaT) + (size_t)h * 65536, 256, (size_t)64 * nb, 64 * kb, nullptr, F.lane); } }
    { bf16_t* WglT = (bf16_t*)(F.ws + WS_WGLT); const float* w_in = p.in[I_WIN];
      for (int idx = (int)blockIdx.x * 512 + F.tid; idx < 16 * DM; idx += F.G * 512) { const int cc = idx >> 11, k = idx & 2047; WglT[idx] = (bf16_t)f2bf(w_in[(size_t)k * INC + 3072 + cc]); } }
    { float* WrT = (float*)(F.ws + WS_WRT); const float* wr = p.in[I_WR]; const float* gf = p.in[I_NFG];
      for (int idx = (int)blockIdx.x * 512 + F.tid; idx < 32 * DM; idx += F.G * 512) { const int n = idx >> 11, k = idx & 2047; WrT[idx] = wr[k * 32 + n] * gf[k]; } }
    int par = 0;
    while (have) {
        LAS unsigned char* buf = F.lds + par * 65536;
        coop_to_lds(cur, w, l, v, buf);
        it += F.G; const bool hn = coop_tile(p, F.ws, it, nxt);
        if (hn) coop_load(nxt, w, l, v);
        __syncthreads();
        coop_store(cur, w, l, buf);
        cur = nxt; have = hn; par ^= 1;
    }
    __syncthreads();
}
__device__ __forceinline__ void p0b(Frame& F, const Params& p) {
    const float* x = p.in[I_X]; const float* g1 = p.in[I_NMG]; bf16_t* H = (bf16_t*)(F.ws + WS_H);
    const int l = F.lane;
    f32x4 gv[8], xn[8];
#pragma unroll
    for (int j = 0; j < 4; ++j) { gv[2 * j] = *(const f32x4*)(g1 + 8 * l + 512 * j); gv[2 * j + 1] = *(const f32x4*)(g1 + 8 * l + 512 * j + 4); }
#pragma unroll
    for (int j = 0; j < 4; ++j) { xn[2 * j] = (F.gw < T) ? *(const f32x4*)(x + (size_t)F.gw * DM + 8 * l + 512 * j) : (f32x4){0.f, 0.f, 0.f, 0.f}; xn[2 * j + 1] = (F.gw < T) ? *(const f32x4*)(x + (size_t)F.gw * DM + 8 * l + 512 * j + 4) : (f32x4){0.f, 0.f, 0.f, 0.f}; }
    for (int m = F.gw; m < T; m += F.NGW) {
        f32x4 xv[8]; float ss = 0.f;
#pragma unroll
        for (int j = 0; j < 8; ++j) { xv[j] = xn[j]; ss += (xv[j][0] * xv[j][0] + xv[j][1] * xv[j][1]) + (xv[j][2] * xv[j][2] + xv[j][3] * xv[j][3]); }
        if (m + F.NGW < T) {
#pragma unroll
            for (int j = 0; j < 4; ++j) { xn[2 * j] = *(const f32x4*)(x + (size_t)(m + F.NGW) * DM + 8 * l + 512 * j); xn[2 * j + 1] = *(const f32x4*)(x + (size_t)(m + F.NGW) * DM + 8 * l + 512 * j + 4); } }
        const float rs = rsqrtf_(wave_sum(ss) * (1.0f / DM) + 1e-6f);
#pragma unroll
        for (int j = 0; j < 4; ++j) { const f32x4 a = xv[2 * j] * rs * gv[2 * j], b = xv[2 * j + 1] * rs * gv[2 * j + 1];
            u32x4 o; o.x = pk2(a[0], a[1]); o.y = pk2(a[2], a[3]); o.z = pk2(b[0], b[1]); o.w = pk2(b[2], b[3]);
            *(u32x4*)(H + (size_t)m * DM + 8 * l + 512 * j) = o;
#ifdef SIM_FP8
            o.x = PK2A(a[0], a[1]); o.y = PK2A(a[2], a[3]); o.z = PK2A(b[0], b[1]); o.w = PK2A(b[2], b[3]); *(u32x4*)((bf16_t*)(F.ws + WS_MIX) + (size_t)m * DM + 8 * l + 512 * j) = o;
#endif
            }
    }
}

struct GlaW { float wcol[16], bcol; };
__device__ __forceinline__ void gla_load_w(const float* wg, const float* bgp, int h, int tid, GlaW& gw_) {
    const int kk = tid & 127;
#pragma unroll
    for (int c = 0; c < 16; ++c) gw_.wcol[c] = wg[c * 512 + h * 128 + kk];
    gw_.bcol = bgp[h * 128 + kk];
}
__device__ __forceinline__ void gla_cumsum(const LAS float* GL, const GlaW& gw_, LAS float* BC, LAS float* SEG, int tid) {
    const int seg = tid >> 7, kk = tid & 127;
    const float (&wcol)[16] = gw_.wcol; const float bcol = gw_.bcol;
    float v[16];
#pragma unroll
    for (int i = 0; i < 16; ++i) { const LAS f32x4* g4 = (const LAS f32x4*)(GL + (16 * seg + i) * 16); float sacc = bcol;
#pragma unroll
        for (int c4 = 0; c4 < 4; ++c4) { const f32x4 gq = g4[c4]; sacc += gq[0] * wcol[4 * c4] + gq[1] * wcol[4 * c4 + 1] + gq[2] * wcol[4 * c4 + 2] + gq[3] * wcol[4 * c4 + 3]; }
        v[i] = log_sigmoid_f(sacc) * 0.0625f; }
#pragma unroll
    for (int i = 1; i < 16; ++i) v[i] += v[i - 1];
    SEG[seg * 128 + kk] = v[15];
    __syncthreads();
    float off = 0.f;
#pragma unroll
    for (int s = 0; s < 3; ++s) off += (s < seg) ? SEG[s * 128 + kk] : 0.f;
#pragma unroll
    for (int i = 0; i < 16; ++i) BC[(16 * seg + i) * 128 + kk] = v[i] + off;
    __syncthreads();
}
__device__ __forceinline__ bf16x8 as_bf16x8(u32x4 v) { return __builtin_bit_cast(bf16x8, v); }
__device__ __forceinline__ bf16x8 cat4(bf16x4 lo, bf16x4 hi) { return __builtin_shufflevector(lo, hi, 0, 1, 2, 3, 4, 5, 6, 7); }

__device__ __forceinline__ void p2a(Frame& F, const Params& p) {
    const bf16_t* Z = (const bf16_t*)(F.ws + WS_Z);
    bf16_t* AN = (bf16_t*)(F.ws + WS_AN); float* DN = (float*)(F.ws + WS_DN);
    const bf16_t* WaT = (const bf16_t*)(F.ws + WS_WAT); const bf16_t* WiT = (const bf16_t*)(F.ws + WS_WIT);
    LAS float* BC = (LAS float*)(F.lds); LAS float* SEG = (LAS float*)(F.lds + 32768);
    LAS bf16_t* KDT = (LAS bf16_t*)(F.lds + 34816); LAS bf16_t* VT = (LAS bf16_t*)(F.lds + 53248); LAS bf16_t* XC = (LAS bf16_t*)(F.lds + 90112);
    const int w = F.wave;
    LAS float* GLR = (LAS float*)(F.lds + 90112);
    LAS float* GL = (LAS float*)(F.lds + 124928);
    const float* wg = p.in[I_GWG]; const float* bgp = p.in[I_GBG];
    for (int unit = blockIdx.x; unit < NCHUNK; unit += F.G) {
        const int b = unit >> 7, n = unit & 127, tok0 = b * SEQL + 64 * n;
        {
            const int lane = fresh_lane(), r16 = lane & 15, q4 = lane >> 4;
            const bf16_t* Hb = (const bf16_t*)(F.ws + WS_H) + (size_t)(tok0 + r16) * DM + 256 * w + 8 * q4;
            const bf16_t* Wb = (const bf16_t*)(F.ws + WS_WGLT) + (size_t)r16 * DM + 256 * w + 8 * q4;
            f32x4 gacc[4];
#pragma unroll
            for (int mb = 0; mb < 4; ++mb) gacc[mb] = (f32x4){0.f, 0.f, 0.f, 0.f};
#pragma unroll
            for (int sb = 0; sb < 2; ++sb) { bf16x8 af[4][4], bfr[4];
#pragma unroll
                for (int s4 = 0; s4 < 4; ++s4) { bfr[s4] = *(const bf16x8*)(Wb + 32 * (4 * sb + s4));
#pragma unroll
                    for (int mb = 0; mb < 4; ++mb) af[s4][mb] = *(const bf16x8*)(Hb + (size_t)(16 * mb) * DM + 32 * (4 * sb + s4)); }
#pragma unroll
                for (int s4 = 0; s4 < 4; ++s4)
#pragma unroll
                    for (int mb = 0; mb < 4; ++mb) gacc[mb] = __builtin_amdgcn_mfma_f32_16x16x32_bf16(af[s4][mb], bfr[s4], gacc[mb], 0, 0, 0); }
#pragma unroll
            for (int mb = 0; mb < 4; ++mb)
#pragma unroll
                for (int q = 0; q < 4; ++q) GLR[(w * 64 + 16 * mb + 4 * q4 + q) * 16 + r16] = gacc[mb][q];
            __syncthreads();
            const int tid2 = w * 64 + lane;
#pragma unroll
            for (int it = 0; it < 2; ++it) { const int o = tid2 + 512 * it; float sacc = 0.f;
#pragma unroll
                for (int w2 = 0; w2 < 8; ++w2) sacc += GLR[w2 * 1024 + o];
                GL[o] = sacc; ((float*)(F.ws + WS_LG))[(size_t)tok0 * 16 + o] = sacc; }
            __syncthreads();
        }
        for (int h = 0; h < 4; ++h) {
            int lane = fresh_lane(), tid = F.wave * 64 + lane;
            int r = lane & 31, hh = lane >> 5;
            GlaW gw_; gla_load_w(wg, bgp, h, tid, gw_);
            u32x4 kvr[2], vvr[4];
#pragma unroll
            for (int it = 0; it < 2; ++it) { const int item = tid + 512 * it, t = item & 63, kk8 = item >> 6; kvr[it] = *(const u32x4*)(Z + (size_t)(tok0 + t) * ZC + ZK + h * 128 + kk8 * 8); }
#pragma unroll
            for (int it = 0; it < 4; ++it) { const int item = tid + 512 * it, t = item & 63, vc8 = item >> 6; vvr[it] = *(const u32x4*)(Z + (size_t)(tok0 + t) * ZC + ZV + h * 256 + vc8 * 8); }
            gla_cumsum(GL, gw_, BC, SEG, tid);
            const int uh = (b * 4 + h) * 128 + n;
            if (tid < 128) DN[(size_t)uh * 128 + tid] = __expf(BC[63 * 128 + tid]);
#pragma unroll
            for (int it = 0; it < 2; ++it) { const int item = tid + 512 * it, t = item & 63, kk8 = item >> 6;
                const u32x4 kv = kvr[it];
#pragma unroll
                for (int i = 0; i < 8; ++i) { const int kk = kk8 * 8 + i; const unsigned wv = kv[i >> 1]; const float kf = (i & 1) ? bfhi(wv) : bflo(wv);
                    const float d = __expf(BC[63 * 128 + kk] - BC[t * 128 + kk]); KDT[kk * 72 + t] = (bf16_t)f2bf(kf * d); } }
#pragma unroll
            for (int it = 0; it < 4; ++it) { const int item = tid + 512 * it, t = item & 63, vc8 = item >> 6;
                const u32x4 vv = vvr[it];
#pragma unroll
                for (int i = 0; i < 8; ++i) { const unsigned wv = vv[i >> 1]; VT[(vc8 * 8 + i) * 72 + t] = (bf16_t)((i & 1) ? (wv >> 16) : (wv & 0xffffu)); } }
#ifndef P2A_NO_LRU
            u32x4 lv[7]; f32x4 cwv[4][2], cbv[2];
            { const float* cw = p.in[I_CW]; const float* cb = p.in[I_CB]; const int c8 = tid & 31, tq = tid >> 5, chc = h * 256 + c8 * 8;
#pragma unroll
              for (int i = 0; i < 7; ++i) { const int sq = 64 * n + 4 * tq - 3 + i;
                  lv[i] = (sq >= 0) ? *(const u32x4*)(Z + (size_t)(tok0 + 4 * tq - 3 + i) * ZC + ZLX + chc) : (u32x4){0u, 0u, 0u, 0u}; }
#pragma unroll
              for (int i = 0; i < 4; ++i) { cwv[i][0] = *(const f32x4*)(cw + i * 1024 + chc); cwv[i][1] = *(const f32x4*)(cw + i * 1024 + chc + 4); }
              cbv[0] = *(const f32x4*)(cb + chc); cbv[1] = *(const f32x4*)(cb + chc + 4); }
#endif
            __syncthreads();
            {
                f32x16 acc[4];
#pragma unroll
                for (int mb = 0; mb < 4; ++mb)
#pragma unroll
                    for (int q = 0; q < 16; ++q) acc[mb][q] = 0.f;
#pragma unroll
                for (int s = 0; s < 4; ++s) { const bf16x8 bfr = *(const LAS bf16x8*)(VT + (32 * w + r) * 72 + 16 * s + 8 * hh);
#pragma unroll
                    for (int mb = 0; mb < 4; ++mb) { const bf16x8 afr = *(const LAS bf16x8*)(KDT + (32 * mb + r) * 72 + 16 * s + 8 * hh);
                        acc[mb] = __builtin_amdgcn_mfma_f32_32x32x16_bf16(afr, bfr, acc[mb], 0, 0, 0); } }
                bf16_t* base = AN + (size_t)uh * 32768;
#pragma unroll
                for (int mb = 0; mb < 4; ++mb)
#pragma unroll
                    for (int s2 = 0; s2 < 2; ++s2) { u32x4 o;
#pragma unroll
                        for (int q = 0; q < 4; ++q) o[q] = pk2(acc[mb][8 * s2 + 2 * q], acc[mb][8 * s2 + 2 * q + 1]);
                        *(u32x4*)(base + (((mb * 8 + w) * 2 + s2) * 64 + lane) * 8) = o; }
            }
#ifndef P2A_NO_LRU
            {
                {
                    const int c8 = tid & 31, tq = tid >> 5;
#pragma unroll
                    for (int it = 0; it < 4; ++it) { float xc[8];
#pragma unroll
                        for (int q = 0; q < 4; ++q) { xc[q] = cbv[0][q]; xc[4 + q] = cbv[1][q]; }
#pragma unroll
                        for (int i = 0; i < 4; ++i) { const u32x4 l4 = lv[it + i];
                            xc[0] += bflo(l4[0]) * cwv[i][0][0]; xc[1] += bfhi(l4[0]) * cwv[i][0][1]; xc[2] += bflo(l4[1]) * cwv[i][0][2]; xc[3] += bfhi(l4[1]) * cwv[i][0][3];
                            xc[4] += bflo(l4[2]) * cwv[i][1][0]; xc[5] += bfhi(l4[2]) * cwv[i][1][1]; xc[6] += bflo(l4[3]) * cwv[i][1][2]; xc[7] += bfhi(l4[3]) * cwv[i][1][3]; }
                        u32x4 o; o.x = pk2(xc[0], xc[1]); o.y = pk2(xc[2], xc[3]); o.z = pk2(xc[4], xc[5]); o.w = pk2(xc[6], xc[7]);
                        *(LAS u32x4*)(XC + (4 * tq + it) * 264 + c8 * 8) = o; }
                }
                __builtin_amdgcn_sched_barrier(0);
                bf16x8 ba[16], bi[16];
                { const bf16_t* wa = WaT + (size_t)h * 65536 + (size_t)(32 * w + r) * 256 + 8 * hh;
                  const bf16_t* wi = WiT + (size_t)h * 65536 + (size_t)(32 * w + r) * 256 + 8 * hh;
#pragma unroll
                  for (int s = 0; s < 16; ++s) { ba[s] = *(const bf16x8*)(wa + 16 * s); bi[s] = *(const bf16x8*)(wi + 16 * s); } }
                const int ch = h * 256 + 32 * w + r;
                const float ba_ = p.in[I_BA][ch], bi_ = p.in[I_BI][ch]; const float L = p.in[I_AP][ch];
                __syncthreads();
                f32x16 aa[2], ai[2];
#pragma unroll
                for (int mb = 0; mb < 2; ++mb)
#pragma unroll
                    for (int q = 0; q < 16; ++q) { aa[mb][q] = 0.f; ai[mb][q] = 0.f; }
#pragma unroll
                for (int s = 0; s < 16; ++s) {
#pragma unroll
                    for (int mb = 0; mb < 2; ++mb) { const bf16x8 af = *(const LAS bf16x8*)(XC + (32 * mb + r) * 264 + 16 * s + 8 * hh);
                        aa[mb] = __builtin_amdgcn_mfma_f32_32x32x16_bf16(af, ba[s], aa[mb], 0, 0, 0); } }
                __builtin_amdgcn_sched_barrier(0);
#pragma unroll
                for (int s = 0; s < 16; ++s) {
#pragma unroll
                    for (int mb = 0; mb < 2; ++mb) { const bf16x8 af = *(const LAS bf16x8*)(XC + (32 * mb + r) * 264 + 16 * s + 8 * hh);
                        ai[mb] = __builtin_amdgcn_mfma_f32_32x32x16_bf16(af, bi[s], ai[mb], 0, 0, 0); } }
                const float sp = fmaxf(-L, 0.f) + log1pf(__expf(-fabsf(L)));
#pragma unroll
                for (int mb = 0; mb < 2; ++mb)
#pragma unroll
                    for (int q = 0; q < 16; ++q) { const int t = 32 * mb + (q & 3) + 8 * (q >> 2) + 4 * hh;
                        if ((q & 3) == 0) __builtin_amdgcn_sched_barrier(0);
                        const float ga = sigmoidf_(aa[mb][q] + ba_), gi = sigmoidf_(ai[mb][q] + bi_);
                        const float la = -8.0f * ga * sp; const float a = __expf(la);
                        const float xcv = bf2f(XC[t * 264 + 32 * w + r]);
                        aa[mb][q] = a; ai[mb][q] = xcv * gi * __builtin_amdgcn_sqrtf(fmaxf(1.0f - a * a, 0.f)); }
#pragma unroll
                for (int mb = 0; mb < 2; ++mb)
#pragma unroll
                    for (int g = 0; g < 4; ++g)
#pragma unroll
                        for (int i = 1; i < 4; ++i) { const int q = 4 * g + i; ai[mb][q] = aa[mb][q] * ai[mb][q - 1] + ai[mb][q]; aa[mb][q] = aa[mb][q] * aa[mb][q - 1]; }
                LAS bf16_t* HL = (LAS bf16_t*)(F.lds); LAS bf16_t* AC = (LAS bf16_t*)(F.lds + 34816);
                float carryH = 0.f, carryP = 1.f;
#pragma unroll
                for (int mb = 0; mb < 2; ++mb)
#pragma unroll
                    for (int g = 0; g < 4; ++g) { const float myP = aa[mb][4 * g + 3], myH = ai[mb][4 * g + 3];
                        const float pP = __shfl_xor(myP, 32), pH = __shfl_xor(myH, 32);
                        const float fP = hh ? pP : myP, fH = hh ? pH : myH, sP = hh ? myP : pP, sH = hh ? myH : pH;
                        const float c1H = fP * carryH + fH, c1P = carryP * fP;
                        const float Cin = hh ? c1H : carryH, Pin = hh ? c1P : carryP;
                        carryH = sP * c1H + sH; carryP = c1P * sP;
#pragma unroll
                        for (int i = 0; i < 4; ++i) { const int q = 4 * g + i, t = 32 * mb + 8 * g + 4 * hh + i;
                            HL[t * 264 + 32 * w + r] = (bf16_t)f2bf(ai[mb][q] + aa[mb][q] * Cin); AC[t * 264 + 32 * w + r] = (bf16_t)f2bf(aa[mb][q] * Pin); } }
                if (hh == 0) { float* SUMA = (float*)(F.ws + WS_SUMA); float* SUMH = (float*)(F.ws + WS_SUMH); SUMA[unit * 1024 + ch] = carryP; SUMH[unit * 1024 + ch] = carryH; }
                __syncthreads();
                { bf16_t* HLOC = (bf16_t*)(F.ws + WS_AUA); bf16_t* ACUM = (bf16_t*)(F.ws + WS_AUU);
#pragma unroll
                  for (int it = 0; it < 4; ++it) { const int item = tid + 512 * it, c8 = item & 31, t = item >> 5; const size_t o = (size_t)(tok0 + t) * 1024 + h * 256 + c8 * 8;
                      *(u32x4*)(HLOC + o) = *(const LAS u32x4*)(HL + t * 264 + c8 * 8); *(u32x4*)(ACUM + o) = *(const LAS u32x4*)(AC + t * 264 + c8 * 8); } }
            }
#endif
            __syncthreads();
        }
    }
}

__device__ __forceinline__ void p2b(Frame& F, const Params& p) {
    const bf16_t* AN = (const bf16_t*)(F.ws + WS_AN); const float* DN = (const float*)(F.ws + WS_DN); bf16_t* SP = (bf16_t*)(F.ws + WS_SP);
    if (F.tid < 128) {
        for (int st = (int)blockIdx.x * 128 + F.tid; st < 32768; st += F.G * 128) {
            const int bh = st >> 12, rem = st & 4095, ln = rem & 63, s2 = (rem >> 6) & 1, w = (rem >> 7) & 7, mb = (rem >> 10) & 3;
            const int kk0 = 32 * mb + 16 * s2 + 4 * (ln >> 5);
            const int offS = (((mb * 8 + w) * 2 + s2) * 64 + ln) * 8;
            f32x4 S0 = (f32x4){0.f, 0.f, 0.f, 0.f}, S1 = S0;
            for (int n0 = 0; n0 < 128; n0 += 16) {
                u32x4 av[16]; f32x4 d0[16], d1[16];
#pragma unroll
                for (int i = 0; i < 16; ++i) { const size_t uh = (size_t)bh * 128 + n0 + i;
                    av[i] = *(const u32x4*)(AN + uh * 32768 + offS);
                    d0[i] = *(const f32x4*)(DN + uh * 128 + kk0); d1[i] = *(const f32x4*)(DN + uh * 128 + kk0 + 8); }
#pragma unroll
                for (int i = 0; i < 16; ++i) { const size_t uh = (size_t)bh * 128 + n0 + i;
                    u32x4 o; o.x = pk2(S0[0], S0[1]); o.y = pk2(S0[2], S0[3]); o.z = pk2(S1[0], S1[1]); o.w = pk2(S1[2], S1[3]);
                    *(u32x4*)(SP + uh * 32768 + offS) = o;
                    const f32x4 a0 = (f32x4){bflo(av[i].x), bfhi(av[i].x), bflo(av[i].y), bfhi(av[i].y)}, a1 = (f32x4){bflo(av[i].z), bfhi(av[i].z), bflo(av[i].w), bfhi(av[i].w)};
                    S0 = d0[i] * S0 + a0; S1 = d1[i] * S1 + a1; } }
        }
    } else if (F.wave == 2) {
        const float* SUMA = (const float*)(F.ws + WS_SUMA); float* SUMH = (float*)(F.ws + WS_SUMH);
        for (int wv = (int)blockIdx.x; wv < 64; wv += F.G) {
            const int seg = F.lane >> 4, sid = wv * 16 + (F.lane & 15), b = sid >> 9, ch = 2 * (sid & 511);
            const size_t o0 = (size_t)(b * 128 + seg * 32) * 1024 + ch;
            f32x2 a[32], hv[32];
#pragma unroll
            for (int q = 0; q < 32; ++q) { a[q] = *(const f32x2*)(SUMA + o0 + (size_t)q * 1024); hv[q] = *(const f32x2*)(SUMH + o0 + (size_t)q * 1024); }
            f32x2 A = (f32x2){1.f, 1.f}, H = (f32x2){0.f, 0.f};
#pragma unroll
            for (int q = 0; q < 32; ++q) { H = a[q] * H + hv[q]; A = a[q] * A; }
            f32x2 hc = (f32x2){0.f, 0.f};
#pragma unroll
            for (int k = 0; k < 3; ++k) { const int src = k * 16 + (F.lane & 15);
                const f32x2 Ak = (f32x2){__shfl(A.x, src), __shfl(A.y, src)}, Hk = (f32x2){__shfl(H.x, src), __shfl(H.y, src)};
                if (k < seg) hc = Ak * hc + Hk; }
#pragma unroll
            for (int q = 0; q < 32; ++q) { *(f32x2*)(SUMH + o0 + (size_t)q * 1024) = hc; hc = a[q] * hc + hv[q]; }
        }
    }
}

__device__ __forceinline__ void p2c(Frame& F, const Params& p) {
    const bf16_t* Z = (const bf16_t*)(F.ws + WS_Z); const float* GLOW = (const float*)(F.ws + WS_LG); const bf16_t* SP = (const bf16_t*)(F.ws + WS_SP);
    LAS float* GL = (LAS float*)(F.lds + 124928); const float* wg = p.in[I_GWG]; const float* bgp = p.in[I_GBG];
    bf16_t* MIX = (bf16_t*)(F.ws + WS_MIX);
    LAS float* BC = (LAS float*)(F.lds); LAS float* SEG = (LAS float*)(F.lds + 32768);
    LAS bf16_t* QE = (LAS bf16_t*)(F.lds + 34816); LAS bf16_t* KE = (LAS bf16_t*)(F.lds + 52224); LAS bf16_t* VT = (LAS bf16_t*)(F.lds + 69632);
    LAS float* SSQ = (LAS float*)(F.lds + 106496); LAS float* OS = (LAS float*)(F.lds);
    const int w = F.wave;
    const float* gng = p.in[I_GNG];
    for (int unit = blockIdx.x; unit < NCHUNK; unit += F.G) {
        const int b = unit >> 7, n = unit & 127, tok0 = b * SEQL + 64 * n;
        const int lane = fresh_lane(), tid = w * 64 + lane, r = lane & 31, hh = lane >> 5;
        const f32x2 gq = *(const f32x2*)(GLOW + (size_t)tok0 * 16 + 2 * tid);
        { const float* SUMH = (const float*)(F.ws + WS_SUMH);
          const int ch = 2 * tid; const f32x2 hc = *(const f32x2*)(SUMH + (size_t)unit * 1024 + ch);
          const bf16_t* HLOC = (const bf16_t*)(F.ws + WS_AUA); const bf16_t* ACUM = (const bf16_t*)(F.ws + WS_AUU);
          unsigned hv[16], av[16], lgw[16];
#pragma unroll
          for (int i = 0; i < 16; ++i) { const size_t tok = (size_t)tok0 + i;
              hv[i] = *(const unsigned*)(HLOC + tok * 1024 + ch); av[i] = *(const unsigned*)(ACUM + tok * 1024 + ch); lgw[i] = *(const unsigned*)(Z + tok * ZC + ZLG + ch); }
#pragma unroll 1
          for (int t0 = 0; t0 < 64; t0 += 16) {
              unsigned hc_[16], ac_[16], lc_[16];
#pragma unroll
              for (int i = 0; i < 16; ++i) { hc_[i] = hv[i]; ac_[i] = av[i]; lc_[i] = lgw[i]; }
              if (t0 + 16 < 64) {
#pragma unroll
                  for (int i = 0; i < 16; ++i) { const size_t tok = (size_t)tok0 + t0 + 16 + i;
                      hv[i] = *(const unsigned*)(HLOC + tok * 1024 + ch); av[i] = *(const unsigned*)(ACUM + tok * 1024 + ch); lgw[i] = *(const unsigned*)(Z + tok * ZC + ZLG + ch); } }
#pragma unroll
              for (int i = 0; i < 16; ++i) { const size_t tok = (size_t)tok0 + t0 + i;
                  const float h0 = bflo(hc_[i]) + bflo(ac_[i]) * hc.x, h1 = bfhi(hc_[i]) + bfhi(ac_[i]) * hc.y;
                  *(unsigned*)(MIX + tok * DM + 1024 + ch) = pk2(h0 * gelu_tanh_f(bflo(lc_[i])), h1 * gelu_tanh_f(bfhi(lc_[i]))); } } }
        *(LAS f32x2*)(GL + 2 * tid) = gq;
        __syncthreads();
        for (int h = 0; h < 4; ++h) {
            const int uh = (b * 4 + h) * 128 + n;
            GlaW gw_; gla_load_w(wg, bgp, h, tid, gw_);
            u32x4 qvr[2], kvr[2], vvr[4];
#pragma unroll
            for (int it = 0; it < 2; ++it) { const int item = tid + 512 * it, kk8 = item & 15, t = item >> 4;
                qvr[it] = *(const u32x4*)(Z + (size_t)(tok0 + t) * ZC + ZQ + h * 128 + kk8 * 8); kvr[it] = *(const u32x4*)(Z + (size_t)(tok0 + t) * ZC + ZK + h * 128 + kk8 * 8); }
#pragma unroll
            for (int it = 0; it < 4; ++it) { const int item = tid + 512 * it, t = item & 63, vc8 = item >> 6; vvr[it] = *(const u32x4*)(Z + (size_t)(tok0 + t) * ZC + ZV + h * 256 + vc8 * 8); }
            gla_cumsum(GL, gw_, BC, SEG, tid);
            bf16x8 sf[4][2];
            { const bf16_t* spu = SP + (size_t)uh * 32768;
#pragma unroll
              for (int mb = 0; mb < 4; ++mb)
#pragma unroll
                  for (int s2 = 0; s2 < 2; ++s2) sf[mb][s2] = *(const bf16x8*)(spu + (((mb * 8 + w) * 2 + s2) * 64 + lane) * 8); }
#pragma unroll
            for (int it = 0; it < 2; ++it) { const int item = tid + 512 * it, kk8 = item & 15, t = item >> 4;
                const u32x4 qv = qvr[it];
                const u32x4 kv = kvr[it];
                const f32x4 b0 = *(const LAS f32x4*)(BC + t * 128 + kk8 * 8), b1 = *(const LAS f32x4*)(BC + t * 128 + kk8 * 8 + 4);
                float qe[8], ke[8];
#pragma unroll
                for (int i = 0; i < 8; ++i) { const float bb = (i < 4) ? b0[i & 3] : b1[i & 3]; const unsigned qw = qv[i >> 1], kw = kv[i >> 1];
                    const float qf = (i & 1) ? bfhi(qw) : bflo(qw), kf = (i & 1) ? bfhi(kw) : bflo(kw);
                    qe[i] = qf * 0.08838834764831845f * __expf(bb); ke[i] = kf * __expf(-bb); }
                u32x4 oq, ok; oq.x = pk2(qe[0], qe[1]); oq.y = pk2(qe[2], qe[3]); oq.z = pk2(qe[4], qe[5]); oq.w = pk2(qe[6], qe[7]);
                ok.x = pk2(ke[0], ke[1]); ok.y = pk2(ke[2], ke[3]); ok.z = pk2(ke[4], ke[5]); ok.w = pk2(ke[6], ke[7]);
                *(LAS u32x4*)(QE + t * 136 + kk8 * 8) = oq; *(LAS u32x4*)(KE + t * 136 + kk8 * 8) = ok; }
#pragma unroll
            for (int it = 0; it < 4; ++it) { const int item = tid + 512 * it, t = item & 63, vc8 = item >> 6;
                const u32x4 vv = vvr[it];
#pragma unroll
                for (int i = 0; i < 8; ++i) { const unsigned wv = vv[i >> 1]; VT[(vc8 * 8 + i) * 72 + t] = (bf16_t)((i & 1) ? (wv >> 16) : (wv & 0xffffu)); } }
            __syncthreads();
            f32x16 oacc[2];
            {
                f32x16 P00, P01, P11;
#pragma unroll
                for (int q = 0; q < 16; ++q) { P00[q] = 0.f; P01[q] = 0.f; P11[q] = 0.f; oacc[0][q] = 0.f; oacc[1][q] = 0.f; }
#pragma unroll
                for (int s = 0; s < 8; ++s) {
                    const bf16x8 a0 = *(const LAS bf16x8*)(KE + r * 136 + 16 * s + 8 * hh), a1 = *(const LAS bf16x8*)(KE + (32 + r) * 136 + 16 * s + 8 * hh);
                    const bf16x8 b0 = *(const LAS bf16x8*)(QE + r * 136 + 16 * s + 8 * hh), b1 = *(const LAS bf16x8*)(QE + (32 + r) * 136 + 16 * s + 8 * hh);
                    P00 = __builtin_amdgcn_mfma_f32_32x32x16_bf16(a0, b0, P00, 0, 0, 0);
                    P01 = __builtin_amdgcn_mfma_f32_32x32x16_bf16(a0, b1, P01, 0, 0, 0);
                    P11 = __builtin_amdgcn_mfma_f32_32x32x16_bf16(a1, b1, P11, 0, 0, 0); }
#pragma unroll
                for (int q = 0; q < 16; ++q) { const int jl = (q & 3) + 8 * (q >> 2) + 4 * hh; if (jl > r) { P00[q] = 0.f; P11[q] = 0.f; } }
                bf16x8 F00[2], F01[2], F11[2];
#pragma unroll
                for (int s2 = 0; s2 < 2; ++s2) {
                    u32x4 t0, t1, t2;
#pragma unroll
                    for (int q = 0; q < 4; ++q) { t0[q] = pk2(P00[8 * s2 + 2 * q], P00[8 * s2 + 2 * q + 1]); t1[q] = pk2(P01[8 * s2 + 2 * q], P01[8 * s2 + 2 * q + 1]); t2[q] = pk2(P11[8 * s2 + 2 * q], P11[8 * s2 + 2 * q + 1]); }
                    F00[s2] = as_bf16x8(t0); F01[s2] = as_bf16x8(t1); F11[s2] = as_bf16x8(t2); }
#pragma unroll
                for (int mb = 0; mb < 4; ++mb)
#pragma unroll
                    for (int s2 = 0; s2 < 2; ++s2) { const bf16x8 af = sf[mb][s2];
                        const int kkb = 32 * mb + 16 * s2 + 4 * hh;
#pragma unroll
                        for (int ib = 0; ib < 2; ++ib) { const bf16x4 lo = *(const LAS bf16x4*)(QE + (32 * ib + r) * 136 + kkb), hi = *(const LAS bf16x4*)(QE + (32 * ib + r) * 136 + kkb + 8);
                            oacc[ib] = __builtin_amdgcn_mfma_f32_32x32x16_bf16(af, cat4(lo, hi), oacc[ib], 0, 0, 0); } }
#pragma unroll
                for (int s2 = 0; s2 < 2; ++s2) {
                    const int tb0 = 16 * s2 + 4 * hh, tb1 = 32 + 16 * s2 + 4 * hh;
                    const bf16x8 v0 = cat4(*(const LAS bf16x4*)(VT + (32 * w + r) * 72 + tb0), *(const LAS bf16x4*)(VT + (32 * w + r) * 72 + tb0 + 8));
                    const bf16x8 v1 = cat4(*(const LAS bf16x4*)(VT + (32 * w + r) * 72 + tb1), *(const LAS bf16x4*)(VT + (32 * w + r) * 72 + tb1 + 8));
                    oacc[0] = __builtin_amdgcn_mfma_f32_32x32x16_bf16(v0, F00[s2], oacc[0], 0, 0, 0);
                    oacc[1] = __builtin_amdgcn_mfma_f32_32x32x16_bf16(v0, F01[s2], oacc[1], 0, 0, 0);
                    oacc[1] = __builtin_amdgcn_mfma_f32_32x32x16_bf16(v1, F11[s2], oacc[1], 0, 0, 0); }
            }
            u32x4 rvr[4];
#pragma unroll
            for (int it = 0; it < 4; ++it) { const int item = tid + 512 * it, vc8 = item & 31, t = item >> 5; rvr[it] = *(const u32x4*)(Z + (size_t)(tok0 + t) * ZC + ZR + h * 256 + vc8 * 8); }
#pragma unroll
            for (int ib = 0; ib < 2; ++ib) { float sq = 0.f;
#pragma unroll
                for (int q = 0; q < 16; ++q) sq += oacc[ib][q] * oacc[ib][q];
                sq += __shfl_xor(sq, 32);
                if (hh == 0) SSQ[w * 64 + 32 * ib + r] = sq; }
            __syncthreads();
#pragma unroll
            for (int ib = 0; ib < 2; ++ib) { float tot = 0.f;
#pragma unroll
                for (int w2 = 0; w2 < 8; ++w2) tot += SSQ[w2 * 64 + 32 * ib + r];
                const float rs = rsqrtf_(tot * (1.0f / 256.0f) + 1e-6f);
#pragma unroll
                for (int g = 0; g < 4; ++g) *(LAS f32x4*)(OS + (32 * ib + r) * 260 + 32 * w + 8 * g + 4 * hh) =
                    (f32x4){oacc[ib][4 * g] * rs, oacc[ib][4 * g + 1] * rs, oacc[ib][4 * g + 2] * rs, oacc[ib][4 * g + 3] * rs}; }
            __syncthreads();
#pragma unroll
            for (int it = 0; it < 4; ++it) { const int item = tid + 512 * it, vc8 = item & 31, t = item >> 5; const int c = h * 256 + vc8 * 8;
                const f32x4 o0 = *(const LAS f32x4*)(OS + t * 260 + vc8 * 8), o1 = *(const LAS f32x4*)(OS + t * 260 + vc8 * 8 + 4);
                const u32x4 rv = rvr[it];
                const f32x4 g0 = *(const f32x4*)(gng + c), g1 = *(const f32x4*)(gng + c + 4);
                float o[8];
#pragma unroll
                for (int i = 0; i < 8; ++i) { const unsigned rw = rv[i >> 1]; const float rf = (i & 1) ? bfhi(rw) : bflo(rw);
                    const float sil = rf * sigmoidf_(rf); o[i] = sil * ((i < 4) ? o0[i & 3] * g0[i & 3] : o1[i & 3] * g1[i & 3]); }
                u32x4 ov; ov.x = pk2(o[0], o[1]); ov.y = pk2(o[2], o[3]); ov.z = pk2(o[4], o[5]); ov.w = pk2(o[6], o[7]);
                *(u32x4*)(MIX + (size_t)(tok0 + t) * DM + c) = ov; }
            __syncthreads();
        }
    }
}

__device__ __forceinline__ void build_moe_tables(Frame& F) {
    unsigned* cnt = (unsigned*)(F.ws + WS_CTL) + CW_CNT;
    if (F.tid < 64) {
        const int e = F.tid; const int c = (e < NEXP) ? (int)xb_ld(cnt + 64 * e) : 0; const int mt = (c + 255) >> 8;
        int inc = mt;
#pragma unroll
        for (int d = 1; d < 32; d <<= 1) { const int o = __shfl_up(inc, d); if ((e & 63) >= d) inc += o; }
        const int first = inc - mt;
        if (e < NEXP) { F.MISC[MI_PBASE + e] = (unsigned)(first * 256); F.MISC[MI_CNT + e] = (unsigned)c;
            for (int q = 0; q < mt; ++q) F.MISC[MI_T2E + first + q] = (unsigned)e;
            if (e == NEXP - 1) F.MISC[MI_NMT] = (unsigned)inc; }
    }
    __syncthreads();
}

__device__ __forceinline__ void p4a(Frame& F, const Params& p) {
    const bf16_t* XMID = (const bf16_t*)(F.ws + WS_XMID); const float* WrT = (const float*)(F.ws + WS_WRT); const float* br = p.in[I_BR];
    float* RSTD = (float*)(F.ws + WS_RSTD); unsigned* TOKE = (unsigned*)(F.ws + WS_TOKE); float* GATES = (float*)(F.ws + WS_GATES);
    unsigned* cnt = (unsigned*)(F.ws + WS_CTL) + CW_CNT;
    unsigned char* HF8 = F.ws + WS_HF8; unsigned short* LIST = (unsigned short*)(F.ws + WS_LIST); const float* gf = p.in[I_NFG];
    LAS float* RED = (LAS float*)(F.lds); LAS float* SSQ2 = (LAS float*)(F.lds + 32768); LAS float* LGT = (LAS float*)(F.lds + 33792); LAS float* RS = (LAS float*)(F.lds + 38016);
    const int tid = F.tid, lane = F.lane, w = F.wave, m = lane & 31, kh = lane >> 5;
    if (tid < 32) F.MISC[MI_LCNT + tid] = 0u;
    __syncthreads();
    bf16x8 bh[16], bl[16];
    { const float* bp = WrT + (size_t)m * DM + 256 * w + 128 * kh;
#pragma unroll
      for (int c = 0; c < 16; ++c) { const f32x4 w0 = *(const f32x4*)(bp + 8 * c), w1 = *(const f32x4*)(bp + 8 * c + 4);
          u32x4 hi, lo; hi.x = pk2(w0[0], w0[1]); hi.y = pk2(w0[2], w0[3]); hi.z = pk2(w1[0], w1[1]); hi.w = pk2(w1[2], w1[3]);
          lo.x = pk2(w0[0] - bflo(hi.x), w0[1] - bfhi(hi.x)); lo.y = pk2(w0[2] - bflo(hi.y), w0[3] - bfhi(hi.y)); lo.z = pk2(w1[0] - bflo(hi.z), w1[1] - bfhi(hi.z)); lo.w = pk2(w1[2] - bflo(hi.w), w1[3] - bfhi(hi.w));
          bh[c] = as_bf16x8(hi); bl[c] = as_bf16x8(lo); } }
    LAS float* RSA = (LAS float*)(F.lds + 38400);
    int ui = 0;
    for (int ut = blockIdx.x; ut < T / 32; ut += F.G, ++ui) {
        const int m0 = 32 * ut; const int kw = 256 * w + 128 * kh;
        f32x16 acc;
#pragma unroll
        for (int q = 0; q < 16; ++q) acc[q] = 0.f;
        float ss = 0.f;
        const bf16_t* ap = XMID + (size_t)(m0 + m) * DM + kw;
        u32x4 ar[16];
#pragma unroll
        for (int c = 0; c < 16; ++c) ar[c] = *(const u32x4*)(ap + 8 * c);
#pragma unroll
        for (int c = 0; c < 16; ++c) { const u32x4 r0 = ar[c];
            const f32x4 a0 = (f32x4){bflo(r0.x), bfhi(r0.x), bflo(r0.y), bfhi(r0.y)}, a1 = (f32x4){bflo(r0.z), bfhi(r0.z), bflo(r0.w), bfhi(r0.w)};
            acc = __builtin_amdgcn_mfma_f32_32x32x16_bf16(as_bf16x8(r0), bh[c], acc, 0, 0, 0);
            acc = __builtin_amdgcn_mfma_f32_32x32x16_bf16(as_bf16x8(r0), bl[c], acc, 0, 0, 0);
            ss += (a0[0] * a0[0] + a0[1] * a0[1]) + (a0[2] * a0[2] + a0[3] * a0[3]) + (a1[0] * a1[0] + a1[1] * a1[1]) + (a1[2] * a1[2] + a1[3] * a1[3]); }
        ss += __shfl_xor(ss, 32);
#pragma unroll
        for (int q = 0; q < 16; ++q) RED[(w * 16 + q) * 64 + lane] = acc[q];
        if (kh == 0) SSQ2[w * 32 + m] = ss;
        __syncthreads();
#pragma unroll
        for (int it = 0; it < 2; ++it) { const int o = tid + 512 * it, reg = o >> 6, ln = o & 63, nn = ln & 31, h2 = ln >> 5; const int mm = (reg & 3) + 8 * (reg >> 2) + 4 * h2;
            float v = 0.f, s2 = 0.f;
#pragma unroll
            for (int w2 = 0; w2 < 8; ++w2) { v += RED[(w2 * 16 + reg) * 64 + ln]; s2 += SSQ2[w2 * 32 + mm]; }
            const float rs = rsqrtf_(s2 * (1.0f / DM) + 1e-6f);
            LGT[mm * 33 + nn] = v * rs + br[nn]; if (nn == 0) { RS[mm] = rs; RSA[32 * ui + mm] = rs; } }
        __syncthreads();
        int ex[4]; unsigned ls[4]; float gt[4];
        if (tid < 32) {
            float l[32];
#pragma unroll
            for (int i = 0; i < 32; ++i) l[i] = LGT[tid * 33 + i];
            float val[4];
#pragma unroll
            for (int k = 0; k < 4; ++k) { float best = -3.0e38f; int bi = 0;
#pragma unroll
                for (int i = 0; i < 32; ++i) if (l[i] > best) { best = l[i]; bi = i; }
                ex[k] = bi; val[k] = best;
#pragma unroll
                for (int i = 0; i < 32; ++i) if (i == bi) l[i] = -3.0e38f; }
            float s = 0.f;
#pragma unroll
            for (int k = 0; k < 4; ++k) { gt[k] = __expf(val[k] - val[0]); s += gt[k]; }
            const float inv = __builtin_amdgcn_rcpf(s);
#pragma unroll
            for (int k = 0; k < 4; ++k) { gt[k] *= inv; ls[k] = __hip_atomic_fetch_add((LAS unsigned*)(F.MISC + MI_LCNT + ex[k]), 1u, __ATOMIC_RELAXED, __HIP_MEMORY_SCOPE_WORKGROUP); }
        }
        __syncthreads();
        if (tid < 32) { const unsigned c = F.MISC[MI_LCNT + tid]; F.MISC[MI_LBASE + tid] = c ? xb_add(cnt + 64 * tid, c) : 0u; F.MISC[MI_LCNT + tid] = 0u; }
        __syncthreads();
        if (tid < 32) { const int tok = m0 + tid;
#pragma unroll
            for (int k = 0; k < 4; ++k) { const unsigned slot = F.MISC[MI_LBASE + ex[k]] + ls[k]; TOKE[tok * 4 + k] = (unsigned)ex[k] | (slot << 8); GATES[tok * 4 + k] = gt[k]; LIST[(size_t)ex[k] * 16384 + (slot & ~255u) + ((slot & 63u) << 2) + ((slot >> 6) & 3u)] = (unsigned short)tok; }
            RSTD[tok] = RS[tid]; }
        __syncthreads();
    }
    { const int ntok = 32 * ui; const int l = lane;
      f32x4 gv[8];
#pragma unroll
      for (int j = 0; j < 4; ++j) { gv[2 * j] = *(const f32x4*)(gf + 8 * l + 512 * j) * 16.0f; gv[2 * j + 1] = *(const f32x4*)(gf + 8 * l + 512 * j + 4) * 16.0f; }
      u32x4 xn[4];
      int jt = w;
      if (jt < ntok) { const size_t tk = (size_t)32 * (blockIdx.x + (jt >> 5) * F.G) + (jt & 31);
#pragma unroll
          for (int j = 0; j < 4; ++j) xn[j] = *(const u32x4*)(XMID + tk * DM + 8 * l + 512 * j); }
      for (; jt < ntok; jt += 8) {
          const size_t tk = (size_t)32 * (blockIdx.x + (jt >> 5) * F.G) + (jt & 31); const float rs = RSA[jt]; u32x2 o[4];
#pragma unroll
          for (int j = 0; j < 4; ++j) { const u32x4 xr = xn[j]; const f32x4 a = (f32x4){bflo(xr.x), bfhi(xr.x), bflo(xr.y), bfhi(xr.y)} * rs * gv[2 * j], b = (f32x4){bflo(xr.z), bfhi(xr.z), bflo(xr.w), bfhi(xr.w)} * rs * gv[2 * j + 1];
              o[j].x = pk4_fp8(a[0], a[1], a[2], a[3]); o[j].y = pk4_fp8(b[0], b[1], b[2], b[3]); }
          const int j2 = jt + 8;
          if (j2 < ntok) { const size_t t2 = (size_t)32 * (blockIdx.x + (j2 >> 5) * F.G) + (j2 & 31);
#pragma unroll
              for (int j = 0; j < 4; ++j) xn[j] = *(const u32x4*)(XMID + t2 * DM + 8 * l + 512 * j); }
#pragma unroll
          for (int j = 0; j < 4; ++j) *(u32x2*)(HF8 + tk * DM + 8 * l + 512 * j) = o[j]; } }
}

__device__ __forceinline__ void p4b(Frame& F, const Params& p) {
    build_moe_tables(F);
    const bf16_t* XMID = (const bf16_t*)(F.ws + WS_XMID); const float* RSTD = (const float*)(F.ws + WS_RSTD); const unsigned* TOKE = (const unsigned*)(F.ws + WS_TOKE);
    const float* gf = p.in[I_NFG]; unsigned char* ABUF = F.ws + WS_ABUF;
    const int l = F.lane;
    u32x4 xn[4]; float rsn = 0.f; unsigned ten[4] = {0u, 0u, 0u, 0u};
    if (F.gw < T) { rsn = RSTD[F.gw];
#pragma unroll
        for (int k = 0; k < 4; ++k) ten[k] = TOKE[F.gw * 4 + k];
#pragma unroll
        for (int j = 0; j < 4; ++j) xn[j] = *(const u32x4*)(XMID + (size_t)F.gw * DM + 8 * l + 512 * j); }
    f32x4 gv[8];
#pragma unroll
    for (int j = 0; j < 4; ++j) { gv[2 * j] = *(const f32x4*)(gf + 8 * l + 512 * j) * 16.0f; gv[2 * j + 1] = *(const f32x4*)(gf + 8 * l + 512 * j + 4) * 16.0f; }
    for (int tok = F.gw; tok < T; tok += F.NGW) {
        const float rs = rsn; unsigned te[4]; u32x2 o[4];
#pragma unroll
        for (int k = 0; k < 4; ++k) te[k] = ten[k];
#pragma unroll
        for (int j = 0; j < 4; ++j) { const u32x4 xr = xn[j]; const f32x4 a = (f32x4){bflo(xr.x), bfhi(xr.x), bflo(xr.y), bfhi(xr.y)} * rs * gv[2 * j], b = (f32x4){bflo(xr.z), bfhi(xr.z), bflo(xr.w), bfhi(xr.w)} * rs * gv[2 * j + 1];
            o[j].x = pk4_fp8(a[0], a[1], a[2], a[3]); o[j].y = pk4_fp8(b[0], b[1], b[2], b[3]); }
        const int t2 = tok + F.NGW;
        if (t2 < T) { rsn = RSTD[t2];
#pragma unroll
            for (int k = 0; k < 4; ++k) ten[k] = TOKE[t2 * 4 + k];
#pragma unroll
            for (int j = 0; j < 4; ++j) xn[j] = *(const u32x4*)(XMID + (size_t)t2 * DM + 8 * l + 512 * j); }
#pragma unroll
        for (int k = 0; k < 4; ++k) { const size_t row = (size_t)F.MISC[MI_PBASE + (te[k] & 255u)] + (te[k] >> 8);
#pragma unroll
            for (int j = 0; j < 4; ++j) *(u32x2*)(ABUF + row * DM + 8 * l + 512 * j) = o[j]; }
    }
}

__device__ __forceinline__ void p7(Frame& F, const Params& p) {
    build_moe_tables(F);
    const bf16_t* XMID = (const bf16_t*)(F.ws + WS_XMID); const unsigned* TOKE = (const unsigned*)(F.ws + WS_TOKE); const float* GATES = (const float*)(F.ws + WS_GATES);
    const unsigned char* Y = F.ws + WS_Y; const float* gfin = p.in[I_NFINAL];
    const int l = F.lane;
    u32x4 xn[4]; u32x2 yn[4][4]; float gkn[4] = {0.f, 0.f, 0.f, 0.f};
#define P7_FETCH(tk) do { \
        _Pragma("unroll") for (int k = 0; k < 4; ++k) { const unsigned te = TOKE[(tk) * 4 + k]; gkn[k] = GATES[(tk) * 4 + k]; const size_t row = (size_t)F.MISC[MI_PBASE + (te & 255u)] + (te >> 8); \
            _Pragma("unroll") for (int j = 0; j < 4; ++j) yn[k][j] = *(const u32x2*)(Y + row * DM + 8 * l + 512 * j); } \
        _Pragma("unroll") for (int j = 0; j < 4; ++j) xn[j] = *(const u32x4*)(XMID + (size_t)(tk) * DM + 8 * l + 512 * j); } while (0)
    if (F.gw < T) P7_FETCH(F.gw);
    f32x4 g0[4], g1[4];
#pragma unroll
    for (int j = 0; j < 4; ++j) { g0[j] = *(const f32x4*)(gfin + 8 * l + 512 * j); g1[j] = *(const f32x4*)(gfin + 8 * l + 512 * j + 4); }
    for (int tok = F.gw; tok < T; tok += F.NGW) {
        f32x4 xv[8];
#pragma unroll
        for (int j = 0; j < 4; ++j) { const u32x4 xr = xn[j]; xv[2 * j] = (f32x4){bflo(xr.x), bfhi(xr.x), bflo(xr.y), bfhi(xr.y)}; xv[2 * j + 1] = (f32x4){bflo(xr.z), bfhi(xr.z), bflo(xr.w), bfhi(xr.w)}; }
#pragma unroll
        for (int k = 0; k < 4; ++k)
#pragma unroll
            for (int j = 0; j < 4; ++j) { const u32x2 y2 = yn[k][j]; const float gk = gkn[k] * (1.0f / 32.0f);
                xv[2 * j][0] += gk * fp8f(y2.x, 0); xv[2 * j][1] += gk * fp8f(y2.x, 1); xv[2 * j][2] += gk * fp8f(y2.x, 2); xv[2 * j][3] += gk * fp8f(y2.x, 3);
                xv[2 * j + 1][0] += gk * fp8f(y2.y, 0); xv[2 * j + 1][1] += gk * fp8f(y2.y, 1); xv[2 * j + 1][2] += gk * fp8f(y2.y, 2); xv[2 * j + 1][3] += gk * fp8f(y2.y, 3); }
        const int t2 = tok + F.NGW;
        if (t2 < T) P7_FETCH(t2);
        float ss = 0.f;
#pragma unroll
        for (int j = 0; j < 8; ++j) ss += (xv[j][0] * xv[j][0] + xv[j][1] * xv[j][1]) + (xv[j][2] * xv[j][2] + xv[j][3] * xv[j][3]);
        const float rs = rsqrtf_(wave_sum(ss) * (1.0f / DM) + 1e-6f);
#pragma unroll
        for (int j = 0; j < 4; ++j) { *(f32x4*)(p.out + (size_t)tok * DM + 8 * l + 512 * j) = xv[2 * j] * rs * g0[j]; *(f32x4*)(p.out + (size_t)tok * DM + 8 * l + 512 * j + 4) = xv[2 * j + 1] * rs * g1[j]; }
    }
#undef P7_FETCH
}

#ifdef PROBE_STREAM
__device__ __forceinline__ void probe_stream(Frame& F, const Params& p) {
    const f32x4* src = (const f32x4*)p.in[I_WGU]; const size_t n4 = (size_t)32 * 2048 * 4096 / 4;
    const f32x4* src2 = (const f32x4*)p.in[I_WDN]; const size_t m4 = (size_t)32 * 2048 * 2048 / 4;
    f32x4 acc = (f32x4){0.f, 0.f, 0.f, 0.f};
    for (size_t base = (size_t)F.gw * 1024; base < n4; base += (size_t)F.NGW * 1024) {
        f32x4 v[16];
#pragma unroll
        for (int i = 0; i < 16; ++i) v[i] = src[base + i * 64 + F.lane];
#pragma unroll
        for (int i = 0; i < 16; ++i) acc += v[i]; }
    for (size_t base = (size_t)F.gw * 1024; base < m4; base += (size_t)F.NGW * 1024) {
        f32x4 v[16];
#pragma unroll
        for (int i = 0; i < 16; ++i) v[i] = src2[base + i * 64 + F.lane];
#pragma unroll
        for (int i = 0; i < 16; ++i) acc += v[i]; }
    if (acc[0] + acc[1] + acc[2] + acc[3] == 12345.678f) p.out[0] = 1.0f;
}
#endif
#ifdef PROBE_ORDER
__device__ __forceinline__ void probe_order(Frame& F, const Params& p) {
    volatile LAS unsigned* flag = F.MISC + 2000;
    if (F.wave < 4) {
        const unsigned* hot = (const unsigned*)p.in[I_X] + (size_t)blockIdx.x * 16384;
        unsigned idx = F.tid & 255, sm = 0;
        for (int it = 0; it < 600; ++it) {
            const unsigned b = idx * 4 + (it & 3) * 1024;
            const unsigned v0 = hot[b & 16383], v1 = hot[(b + 4096) & 16383], v2 = hot[(b + 8192) & 16383], v3 = hot[(b + 12288) & 16383];
            sm += v0 + v1 + v2 + v3; idx = (idx + (sm & 3)) & 255;
        }
        if (sm == 0x12345678u) p.out[0] = 1.0f;
        *flag = 1u;
    } else {
#if PROBE_ORDER == 2
        const f32x4* src = (const f32x4*)p.in[I_WGU];
        f32x4 acc = (f32x4){0.f, 0.f, 0.f, 0.f}; unsigned it = 0;
        const unsigned sw = blockIdx.x * 4 + (F.wave - 4);
        while (*flag == 0u) {
            const size_t base = (((size_t)it * 1024 + sw) * 1024) & (((size_t)1 << 26) - 1);
            f32x4 v[16];
#pragma unroll
            for (int i = 0; i < 16; ++i) v[i] = src[base + i * 64 + F.lane];
#pragma unroll
            for (int i = 0; i < 16; ++i) acc += v[i];
            ++it;
        }
        if (acc[0] + acc[1] + acc[2] + acc[3] == 12345.678f) p.out[1] = 1.0f;
#endif
    }
    __syncthreads();
}
#endif
constexpr int NPHASE = 11;
constexpr int HOST_DN_EXPERTS = 24;
constexpr int CONV_EXPERTS = 28, CONV_END = CONV_EXPERTS * 8192, CONV_P1 = 2048 * 81;
#ifndef KROT5
#define KROT5 false
#endif
#ifndef KROT6
#define KROT6 false
#endif
#ifndef STAG5
#define STAG5 0
#endif
#ifndef STAG6
#define STAG6 0
#endif
__global__ void __launch_bounds__(512, 2) mk_fwd(Params p) {
    extern __shared__ __attribute__((aligned(16))) unsigned char lds_raw[];
    Frame F;
    F.lds = (LAS unsigned char*)lds_raw; F.MISC = (volatile LAS unsigned*)(F.lds + MISC_OFF);
    F.wave = __builtin_amdgcn_readfirstlane((int)threadIdx.x >> 6);
#define FRESH() do { F.lane = fresh_lane(); F.tid = F.wave * 64 + F.lane; } while (0)
    FRESH();
    F.G = gridDim.x; F.gw = (int)blockIdx.x * 8 + F.wave; F.NGW = F.G * 8; F.ws = p.ws;
    for (int u = F.tid; u < (LDS_BYTES - MISC_OFF) / 4; u += 512) F.MISC[u] = 0u;
    __syncthreads();
    const int lo = p.ph_lo, hi = p.ph_hi;
    XcdBarrier bar; bar.bar = (unsigned*)(F.ws + WS_CTL) + CW_BAR; bar.x = 0; bar.st = F.MISC;
    if (hi - lo > 1) bar = xcd_barrier_post((unsigned*)(F.ws + WS_CTL) + CW_BAR, F.MISC, F.tid == 0);
#ifndef PHASE_MASK
#define PHASE_MASK 0x7ff
#endif
#define IN(k) (((PHASE_MASK >> (k)) & 1) && lo <= (k) && (k) < hi)
#define SEAM(k) do { if (IN(k) && IN((k) + 1)) xcd_barrier(bar, F.wave == 0 && fresh_lane() == 0); } while (0)
#ifndef REPEAT_MASK
#define REPEAT_MASK 0
#endif
#define REP(k) for (int rep_ = 0; rep_ < (((REPEAT_MASK >> (k)) & 1) ? 2 : 1); ++rep_)
    LAS unsigned char* ring = F.lds;
#ifdef PROBE_STREAM
    if (IN(0)) { probe_stream(F, p); }
#endif
#ifdef PROBE_ORDER
    if (IN(0)) { probe_order(F, p); }
#endif
    if (IN(0)) { REP(11) { FRESH(); p0a(F, p); } REP(12) { FRESH(); p0b(F, p); } SEAM(0); }
    if (IN(1)) REP(1) {

#ifdef SIM_FP8
        pg8::Gemm g{F.ws + WS_MIX, F.ws + WS_WINT};
#else
        pg8::Gemm g{F.ws + WS_H, F.ws + WS_WINT};
#endif
 using GS = pg8::GShape<DM * 2, DM * 2, DM * 2, 0>; pg8::StaticOrder S; S.init(T, ZC, F.G, (int)blockIdx.x);
        pg8::EpiBf16 E{(bf16_t*)(F.ws + WS_Z), ZC, nullptr, 0};
        pg8::ConvGU cv{p.in[I_WGU], F.ws + WS_WGUT, F.gw, CONV_END, F.NGW, 0};
        pg8::gemm_phase<pg8::EpiBf16, pg8::StaticOrder, GS, true, false, 0, pg8::ConvGU>(ring, g, S, E, F.wave, cv); SEAM(1); }
    if (IN(2)) REP(2) { FRESH(); p2a(F, p); SEAM(2); }
    if (IN(3)) REP(3) { FRESH(); p2b(F, p); SEAM(3); }
    if (IN(4)) REP(4) { FRESH(); p2c(F, p); SEAM(4); }
    if (IN(5)) REP(5) {
        pg8::Gemm g{F.ws + WS_MIX, F.ws + WS_WOUTT}; using GS = pg8::GShape<DM * 2, DM * 2, DM * 2, 0>; pg8::StaticOrder S; S.init(T, DM, F.G, (int)blockIdx.x);
        pg8::EpiBf16Res E{(bf16_t*)(F.ws + WS_XMID), p.in[I_X], DM};
        pg8::ConvGU cv{p.in[I_WGU], F.ws + WS_WGUT, CONV_P1 + F.gw, CONV_END, F.NGW, 0};
        pg8::gemm_phase<pg8::EpiBf16Res, pg8::StaticOrder, GS, true, false, 0, pg8::ConvGU>(ring, g, S, E, F.wave, cv); SEAM(5); }
    if (IN(6)) { FRESH(); p4a(F, p); SEAM(6); }
    if (IN(8)) {
        FRESH(); build_moe_tables(F);
        pg8::Gemm g{F.ws + WS_HF8, F.ws + WS_WGUT}; using GS = pg8::GShape<DM, DM, DM, (size_t)4096 * DM>;
        pg8::MoeOrder S{__builtin_amdgcn_readfirstlane((int)F.MISC[MI_NMT]), 16, F.G, (int)blockIdx.x, (const LAS int*)(F.lds + MISC_OFF + 4 * MI_T2E)};
        pg8::EpiSwiGLU8 E{F.ws + WS_ACT, DM, p.in[I_BGU]};
        pg8::Gather gi{(const unsigned short*)(F.ws + WS_LIST), (const LAS unsigned*)(F.lds + MISC_OFF + 4 * MI_PBASE), (const LAS unsigned*)(F.lds + MISC_OFF + 4 * MI_CNT)};
        pg8::EpiHost<3> eh{p.in[I_WDN], F.ws + WS_WDT, F.gw, HOST_DN_EXPERTS * 4096, F.NGW, DM, 5, 0, 0, {0, 0, 0}};
        pg8::gemm_phase<pg8::EpiSwiGLU8, pg8::MoeOrder, GS, true, true, STAG5, pg8::NoConv, pg8::EpiHost<3>, KROT5, pg8::Gather>(ring, g, S, E, F.wave, pg8::NoConv(), eh, gi); SEAM(8); }
#if (REPEAT_MASK & 0x100)
    if (IN(8)) {
        FRESH(); build_moe_tables(F);
        pg8::Gemm g{F.ws + WS_ABUF, F.ws + WS_WGUT}; using GS = pg8::GShape<DM, DM, DM, (size_t)4096 * DM>;
        pg8::MoeOrder S{__builtin_amdgcn_readfirstlane((int)F.MISC[MI_NMT]), 16, F.G, (int)blockIdx.x, (const LAS int*)(F.lds + MISC_OFF + 4 * MI_T2E)};
        pg8::EpiSwiGLU8 E{F.ws + WS_Y, DM, p.in[I_BGU]};
#if P5DUP == 2
        pg8::Gemm g2{F.ws + WS_HF8, F.ws + WS_WGUT};
        pg8::Gather gi{(const unsigned short*)(F.ws + WS_LIST), (const LAS unsigned*)(F.lds + MISC_OFF + 4 * MI_PBASE), (const LAS unsigned*)(F.lds + MISC_OFF + 4 * MI_CNT)};
        pg8::gemm_phase<pg8::EpiSwiGLU8, pg8::MoeOrder, GS, true, true, STAG5, pg8::NoConv, pg8::NoHost, false, pg8::Gather>(ring, g2, S, E, F.wave, pg8::NoConv(), pg8::NoHost(), gi); SEAM(8); }
#else
        pg8::gemm_phase<pg8::EpiSwiGLU8, pg8::MoeOrder, GS, true, true, STAG5>(ring, g, S, E, F.wave); SEAM(8); }
#endif
#endif
    if (IN(9)) {
        FRESH(); build_moe_tables(F);
        pg8::Gemm g{F.ws + WS_ACT, F.ws + WS_WDT}; using GS = pg8::GShape<DM, DM, DM, (size_t)DM * DM>;
        pg8::MoeOrder S{__builtin_amdgcn_readfirstlane((int)F.MISC[MI_NMT]), 8, F.G, (int)blockIdx.x, (const LAS int*)(F.lds + MISC_OFF + 4 * MI_T2E)};
        pg8::EpiFp8S E{F.ws + WS_Y, DM, p.in[I_BDN], DM, 1.0f / 2048.0f, 32.0f};
        pg8::gemm_phase<pg8::EpiFp8S, pg8::MoeOrder, GS, true, true, STAG6, pg8::NoConv, pg8::NoHost, KROT6>(ring, g, S, E, F.wave); SEAM(9); }
#if (REPEAT_MASK & 0x200)
    if (IN(9)) {
        FRESH(); build_moe_tables(F);
#ifdef P6_PITCH
        pg8::Gemm g{F.ws + WS_ACT, F.ws + WS_WDT}; using GS = pg8::GShape<P6_PITCH, P6_PITCH, DM, (size_t)DM * DM>;
#else
        pg8::Gemm g{F.ws + WS_ACT, F.ws + WS_WDT}; using GS = pg8::GShape<DM, DM, DM, (size_t)DM * DM>;
#endif
        pg8::MoeOrder S{__builtin_amdgcn_readfirstlane((int)F.MISC[MI_NMT]), 8, F.G, (int)blockIdx.x, (const LAS int*)(F.lds + MISC_OFF + 4 * MI_T2E)};
#ifdef P6_NOSTORE
        pg8::EpiNull_<P6_NOSTORE - 1> E{};

#ifndef P6_FLP
#define P6_FLP false
#endif
        pg8::gemm_phase<pg8::EpiNull_<P6_NOSTORE - 1>, pg8::MoeOrder, GS, true, true, STAG6, pg8::NoConv, pg8::NoHost, false, pg8::NoGather, P6_FLP>(ring, g, S, E, F.wave); SEAM(9); }
#elif defined(P6_MODE)
        pg8::EpiFp8S_<P6_MODE> E{F.ws + WS_Y, DM, p.in[I_BDN], DM, 1.0f / 2048.0f, 32.0f};
        pg8::gemm_phase<pg8::EpiFp8S_<P6_MODE>, pg8::MoeOrder, GS, true, true, STAG6>(ring, g, S, E, F.wave); SEAM(9); }
#else
        pg8::EpiFp8S E{F.ws + WS_Y, DM, p.in[I_BDN], DM, 1.0f / 2048.0f, 32.0f};
        pg8::gemm_phase<pg8::EpiFp8S, pg8::MoeOrder, GS, true, true, STAG6>(ring, g, S, E, F.wave); SEAM(9); }
#endif
#endif
    if (IN(10)) REP(10) { FRESH(); p7(F, p); if (((REPEAT_MASK >> 10) & 1)) xcd_barrier(bar, F.wave == 0 && fresh_lane() == 0); }
#undef IN
#undef SEAM
}
#ifndef STAGE
#define STAGE 4
#endif
#ifndef PER_PHASE_LAUNCH
#define PER_PHASE_LAUNCH 0
#endif

#if STAGE < 4
__global__ void adapt_z_kernel(const bf16_t* Z, float* z) {
    const long idx = (long)blockIdx.x * blockDim.x + threadIdx.x; const long t = idx / ZC; const int c = (int)(idx % ZC);
    z[t * INC + (c < 3072 ? c : c + 16)] = bf2f(Z[idx]);
}
__global__ void adapt_bf16_kernel(const bf16_t* src, float* dst) { const long idx = (long)blockIdx.x * blockDim.x + threadIdx.x; dst[idx] = bf2f(src[idx]); }
#endif

static void launch_mk(Params& a, int lo, int hi, int grid, hipStream_t stream) {
#if PER_PHASE_LAUNCH
    for (int k = lo; k < hi; ++k) { a.ph_lo = k; a.ph_hi = k + 1; hipLaunchKernelGGL(mk_fwd, dim3(grid), dim3(512), LDS_BYTES, stream, a); }
#else
    a.ph_lo = lo; a.ph_hi = hi; hipLaunchKernelGGL(mk_fwd, dim3(grid), dim3(512), LDS_BYTES, stream, a);
#endif
}

extern "C" void kernel_launch(void* const* d_in, const int* in_sizes, int n_in, void* d_out, int out_size, void* d_ws, size_t ws_size, hipStream_t stream) {
    static int grid = 0;
    if (grid == 0) {
        int dev = 0, cus = 0;
        if (hipGetDevice(&dev) != hipSuccess || hipDeviceGetAttribute(&cus, hipDeviceAttributeMultiprocessorCount, dev) != hipSuccess) { grid = -1; return; }
        if (hipFuncSetAttribute((const void*)mk_fwd, hipFuncAttributeMaxDynamicSharedMemorySize, LDS_BYTES) != hipSuccess) { grid = -1; return; }
        int per_cu = 0;
        (void)hipOccupancyMaxActiveBlocksPerMultiprocessor(&per_cu, (const void*)mk_fwd, 512, LDS_BYTES);
        (void)hipGetLastError();
        grid = cus < 256 ? cus : 256;
        if (per_cu < 1) fprintf(stderr, "kernel_launch: occupancy query reports %d\n", per_cu);
    }
    if (grid < 0) return;
    (void)hipMemsetAsync((char*)d_ws + WS_CTL, 0, CTL_ZERO_BYTES, stream);
    Params a{};
    for (int i = 0; i < 22; ++i) a.in[i] = (const float*)d_in[i];
    a.out = (float*)d_out; a.ws = (unsigned char*)d_ws;
#if STAGE >= 4
    launch_mk(a, 0, NPHASE, grid, stream);
#else
    const float* x = a.in[I_X];
    char* ws = (char*)d_ws + WS_ABUF; size_t off = 0;
    auto alloc = [&](size_t bytes) { void* p = ws + off; off += (bytes + 255) & ~(size_t)255; return p; };
    int* counts = (int*)alloc(256);
    float* z = (float*)alloc((size_t)T * INC * 4);
    float* ogla = (float*)alloc((size_t)T * 1024 * 4);
    float* xc = (float*)alloc((size_t)T * 1024 * 4);
    float* za = (float*)alloc((size_t)T * 1024 * 4);
    float* zi = (float*)alloc((size_t)T * 1024 * 4);
    float* mix = (float*)alloc((size_t)T * DM * 4);
    float* xmid = (float*)alloc((size_t)T * DM * 4);
    float* hf = (float*)alloc((size_t)T * DM * 4);
    float* logits = (float*)alloc((size_t)T * 32 * 4);
    float* gates = (float*)alloc((size_t)T * 4 * 4);
    int* list = (int*)alloc((size_t)NEXP * T * 4);
    float* act = (float*)alloc((size_t)T * 4 * DM * 4);
    float* y = (float*)alloc((size_t)T * 4 * DM * 4);
    (void)hipMemsetAsync(counts, 0, 256, stream);
#if STAGE == 1
    launch_mk(a, 0, 2, grid, stream);
    adapt_z_kernel<<<(unsigned)((size_t)T * ZC / 256), 256, 0, stream>>>((const bf16_t*)((char*)d_ws + WS_Z), z);
    gla_naive_kernel<<<64, 256, 0, stream>>>(z, (const float*)((char*)d_ws + WS_LG), ogla);
    gla_out_kernel<<<T, 256, 0, stream>>>(ogla, z, a.in[I_GNG], mix);
    lru_conv_kernel<<<T * 1024 / 256, 256, 0, stream>>>(z, a.in[I_CW], a.in[I_CB], xc);
    for (int h = 0; h < 4; ++h) {
        GemmArgs g{}; g.A = xc + h * 256; g.lda = 1024; g.ldb = 256; g.ldc = 1024; g.M = T; g.N = 256; g.K = 256; g.a_div = 1;
        g.B = a.in[I_WA] + (size_t)h * 65536; g.C = za + h * 256;
        sgemm_kernel<0><<<dim3(2, T / 128, 1), 256, 0, stream>>>(g);
        g.B = a.in[I_WI] + (size_t)h * 65536; g.C = zi + h * 256;
        sgemm_kernel<0><<<dim3(2, T / 128, 1), 256, 0, stream>>>(g);
    }
    lru_gate_kernel<<<T * 1024 / 256, 256, 0, stream>>>(xc, za, zi, a.in[I_BA], a.in[I_BI], a.in[I_AP]);
    lru_scan_kernel<<<2048 / 64, 64, 0, stream>>>(za, zi, z, mix);
#endif
#if STAGE == 2
    launch_mk(a, 0, 5, grid, stream);
    adapt_bf16_kernel<<<(unsigned)((size_t)T * DM / 256), 256, 0, stream>>>((const bf16_t*)((char*)d_ws + WS_MIX), mix);
#endif
#if STAGE <= 2
    { GemmArgs g{}; g.A = mix; g.lda = DM; g.B = a.in[I_WOUT]; g.ldb = DM; g.C = xmid; g.ldc = DM; g.M = T; g.N = DM; g.K = DM; g.a_div = 1; g.resid = x; g.ldr = DM;
      sgemm_kernel<1><<<dim3(DM / 128, T / 128, 1), 256, 0, stream>>>(g); }
#else
    launch_mk(a, 0, 6, grid, stream);
    xmid = (float*)((char*)d_ws + WS_XMID);
#endif
    rmsnorm_kernel<<<T, 256, 0, stream>>>(xmid, a.in[I_NFG], hf);
    { GemmArgs g{}; g.A = hf; g.lda = DM; g.B = a.in[I_WR]; g.ldb = 32; g.C = logits; g.ldc = 32; g.M = T; g.N = 32; g.K = DM; g.a_div = 1; g.bias = a.in[I_BR];
      sgemm_kernel<0><<<dim3(1, T / 128, 1), 256, 0, stream>>>(g); }
    route_kernel<<<T / 256, 256, 0, stream>>>(logits, counts, list, gates);
    { GemmArgs g{}; g.A = hf; g.lda = DM; g.B = a.in[I_WGU]; g.ldb = 4096; g.C = act; g.ldc = DM; g.M = 0; g.N = 4096; g.K = DM; g.a_div = 4; g.bias = a.in[I_BGU];
      g.rowlist = list; g.count = counts; g.strideB_e = (long)DM * 4096; g.strideBias_e = 4096; g.list_stride = T;
      sgemm_kernel<2><<<dim3(2048 / 64, T / 128, NEXP), 256, 0, stream>>>(g); }
    { GemmArgs g{}; g.A = act; g.lda = DM; g.B = a.in[I_WDN]; g.ldb = DM; g.C = y; g.ldc = DM; g.M = 0; g.N = DM; g.K = DM; g.a_div = 1; g.bias = a.in[I_BDN];
      g.rowlist = list; g.count = counts; g.strideB_e = (long)DM * DM; g.strideBias_e = DM; g.list_stride = T;
      sgemm_kernel<0><<<dim3(DM / 128, T / 128, NEXP), 256, 0, stream>>>(g); }
    final_kernel<<<T, 256, 0, stream>>>(xmid, y, gates, a.in[I_NFINAL], (float*)d_out);
#endif
}
```
